# Optimizing an MI355X kernel written in HIP

```python
import math
import jax, jax.numpy as jnp
from jax import lax
import numpy as np

D_MODEL = 1024
BATCH = 4
SEQ = 8192
DEPTH = 1

MLA_HEADS = 8
MLA_Q_RANK = 384
MLA_KV_RANK = 256
MLA_NOPE_DIM = 128
MLA_ROPE_DIM = 64
MLA_V_DIM = D_MODEL // MLA_HEADS
ROPE_THETA = 10000.0
Q_BLOCK = 128
DIL_GROUPS = ((128, 1), (512, 4), (2048, 16))
DIL_HEADS = 8
DIL_HEAD_DIM = D_MODEL // DIL_HEADS
N_DIL_HEADS = len(DIL_GROUPS) * DIL_HEADS
REL_BUCKETS = 32
REL_MAX_DIST = 1024
N_EXPERTS = 16
EC_CAPACITY_FACTOR = 2
D_FF_EXPERT = 2 * D_MODEL
N_BRANCHES = 2
NORM_EPS = 1e-6
NEG_INF = -1e30
COLS_DIL = len(DIL_GROUPS) * 3 * DIL_HEADS * DIL_HEAD_DIM
SPLIT_SIZES = (MLA_Q_RANK, MLA_KV_RANK, MLA_ROPE_DIM, COLS_DIL, N_BRANCHES * D_MODEL)
D_IN = sum(SPLIT_SIZES)

kernel_name = 'hybrid_mla_dilated_ec_moe_block'


def rmsnorm(t, g):
    tf = t.astype(jnp.float32)
    y = tf * lax.rsqrt(jnp.mean(tf * tf, axis=-1, keepdims=True) + NORM_EPS)
    return (y * g.astype(jnp.float32)).astype(t.dtype)


def rope(t, cos, sin):
    t1, t2 = jnp.split(t, 2, axis=-1)
    return jnp.concatenate([t1 * cos - t2 * sin, t1 * sin + t2 * cos], axis=-1).astype(t.dtype)


def t5_bucket(rel):
    nb = REL_BUCKETS // 2
    ret = jnp.where(rel > 0, nb, 0)
    n = jnp.abs(rel)
    max_exact = nb // 2
    nf = jnp.maximum(n, 1).astype(jnp.float32)
    large = max_exact + (jnp.log(nf / max_exact) / math.log(REL_MAX_DIST / max_exact)
                         * (nb - max_exact)).astype(jnp.int32)
    large = jnp.minimum(large, nb - 1)
    return ret + jnp.where(n < max_exact, n, large)


def mla_attention(c_q, c_kv, k_pe, g_q_lat, g_kv_lat, w_uq, w_ukv, cos, sin):
    B, S, _ = c_q.shape
    q = (rmsnorm(c_q, g_q_lat) @ w_uq).reshape(B, S, MLA_HEADS, MLA_NOPE_DIM + MLA_ROPE_DIM)
    q_nope = q[..., :MLA_NOPE_DIM]
    q_pe = rope(q[..., MLA_NOPE_DIM:], cos[:, :, None], sin[:, :, None])
    kv = (rmsnorm(c_kv, g_kv_lat) @ w_ukv).reshape(B, S, MLA_HEADS, MLA_NOPE_DIM + MLA_V_DIM)
    k_nope, v = kv[..., :MLA_NOPE_DIM], kv[..., MLA_NOPE_DIM:]
    k_pe = rope(k_pe, cos, sin)
    scale = (MLA_NOPE_DIM + MLA_ROPE_DIM) ** -0.5
    nqb = S // Q_BLOCK

    def to_blocks(t):
        return jnp.moveaxis(t.reshape((B, nqb, Q_BLOCK) + t.shape[2:]), 1, 0)

    def attend(blk):
        qn, qp = blk
        s = (jnp.einsum('bqhc,bkhc->bhqk', qn, k_nope)
             + jnp.einsum('bqhr,bkr->bhqk', qp, k_pe))
        p = jax.nn.softmax(s.astype(jnp.float32) * scale, axis=-1).astype(v.dtype)
        return jnp.einsum('bhqk,bkhc->bqhc', p, v)

    o = lax.map(attend, (to_blocks(q_nope), to_blocks(q_pe)))
    return jnp.moveaxis(o, 0, 1).reshape(B, S, MLA_HEADS * MLA_V_DIM)


def dilated_band_attention(q, k, v, pos, bias_table, window, dilation):
    B, S, H, Dh = q.shape
    d = dilation
    r = window // (2 * d)
    L = S // d
    nb = -(-L // r)
    Lp = nb * r

    def to_classes(t):
        t = jnp.moveaxis(t.reshape((B, L, d) + t.shape[2:]), 2, 1)
        return jnp.pad(t, [(0, 0), (0, 0), (0, Lp - L)] + [(0, 0)] * (t.ndim - 3))

    def band(t):
        t = jnp.pad(t, [(0, 0), (0, 0), (r, r)] + [(0, 0)] * (t.ndim - 3))
        t = t.reshape((B, d, nb + 2, r) + t.shape[3:])
        return jnp.concatenate([t[:, :, :-2], t[:, :, 1:-1], t[:, :, 2:]], axis=3)

    qc, kc, vc, pc = to_classes(q), to_classes(k), to_classes(v), to_classes(pos)
    kb, vb, pkb = band(kc), band(vc), band(pc)
    qb = qc.reshape(B, d, nb, r, H, Dh)
    pqb = pc.reshape(B, d, nb, r)
    s = jnp.einsum('bgnqhc,bgnkhc->bgnhqk', qb, kb).astype(jnp.float32) * (Dh ** -0.5)
    rel = pkb[:, :, :, None, :] - pqb[..., None]
    bias = bias_table[t5_bucket(rel)]
    s = s + jnp.moveaxis(bias, -1, 3).astype(jnp.float32)
    qi = jnp.arange(nb)[:, None, None] * r + jnp.arange(r)[None, :, None]
    kj = (jnp.arange(nb)[:, None, None] - 1) * r + jnp.arange(3 * r)[None, None, :]
    valid = (jnp.abs(kj - qi) <= r) & (kj >= 0) & (kj < L)
    s = jnp.where(valid[:, None], s, NEG_INF)
    m = jnp.max(s, axis=-1, keepdims=True)
    p = jnp.exp(s - m)
    den = jnp.sum(p, axis=-1, keepdims=True)
    o = jnp.einsum('bgnhqk,bgnkhc->bgnqhc', (p / den).astype(v.dtype), vb)
    lse = (m + jnp.log(den))[..., 0]
    o = o.reshape(B, d, Lp, H, Dh)[:, :, :L]
    o = jnp.moveaxis(o, 1, 2).reshape(B, S, H, Dh)
    lse = jnp.moveaxis(lse, 3, 4).reshape(B, d, Lp, H)[:, :, :L]
    lse = jnp.moveaxis(lse, 1, 2).reshape(B, S, H)
    return o, lse


def expert_choice_ffn(h, w_router, w_gate, w_up, w_down):
    B, S, D = h.shape
    cap = EC_CAPACITY_FACTOR * S // N_EXPERTS
    aff = jax.nn.softmax((h @ w_router).astype(jnp.float32), axis=-1)
    gate, idx = lax.top_k(jnp.swapaxes(aff, 1, 2), cap)
    bidx = jnp.arange(B)[:, None, None]
    xe = h[bidx, idx]
    hid = (jax.nn.silu(jnp.einsum('becd,edf->becf', xe, w_gate))
           * jnp.einsum('becd,edf->becf', xe, w_up))
    ye = jnp.einsum('becf,efd->becd', hid, w_down) * gate[..., None].astype(h.dtype)
    return jnp.zeros_like(h).at[bidx, idx].add(ye)


def setup_inputs(seed: int = 0) -> dict:
    key = jax.random.key(seed)
    ks = jax.random.split(key, 20)
    f32 = jnp.float32

    def nrm(k, shape, s):
        return jax.random.normal(k, shape, f32) * s

    def gain(k, shape):
        return 1.0 + 0.02 * jax.random.normal(k, shape, f32)

    x = nrm(ks[0], (BATCH, SEQ, D_MODEL), 1.0)
    c = nrm(ks[1], (BATCH, D_MODEL), 1.0)
    offs = jax.random.randint(ks[2], (BATCH, 1), 0, 4096, dtype=jnp.int32)
    positions = offs + jnp.arange(SEQ, dtype=jnp.int32)[None, :]
    w_ada = nrm(ks[3], (DEPTH, D_MODEL, 6 * D_MODEL), 0.02)
    b_ada = nrm(ks[4], (DEPTH, 6 * D_MODEL), 0.02)
    g_norm_mix = gain(ks[5], (DEPTH, D_MODEL))
    w_in = nrm(ks[6], (DEPTH, D_MODEL, D_IN), D_MODEL ** -0.5)
    g_q_lat = gain(ks[7], (DEPTH, MLA_Q_RANK))
    g_kv_lat = gain(ks[8], (DEPTH, MLA_KV_RANK))
    w_uq = nrm(ks[9], (DEPTH, MLA_Q_RANK, MLA_HEADS * (MLA_NOPE_DIM + MLA_ROPE_DIM)), MLA_Q_RANK ** -0.5)
    w_ukv = nrm(ks[10], (DEPTH, MLA_KV_RANK, MLA_HEADS * (MLA_NOPE_DIM + MLA_V_DIM)), MLA_KV_RANK ** -0.5)
    rel_bias = nrm(ks[11], (REL_BUCKETS, N_DIL_HEADS), 0.5)
    w_out = nrm(ks[12], (DEPTH, D_MODEL, D_MODEL), D_MODEL ** -0.5)
    g_norm_ffn = gain(ks[13], (DEPTH, D_MODEL))
    w_router = nrm(ks[14], (DEPTH, D_MODEL, N_EXPERTS), D_MODEL ** -0.5)
    w_gate = nrm(ks[15], (DEPTH, N_EXPERTS, D_MODEL, D_FF_EXPERT), D_MODEL ** -0.5)
    w_up = nrm(ks[16], (DEPTH, N_EXPERTS, D_MODEL, D_FF_EXPERT), D_MODEL ** -0.5)
    w_down = nrm(ks[17], (DEPTH, N_EXPERTS, D_FF_EXPERT, D_MODEL), D_FF_EXPERT ** -0.5)
    g_final = gain(ks[18], (D_MODEL,))
    return {'x': x, 'c': c, 'positions': positions, 'w_ada': w_ada, 'b_ada': b_ada,
            'g_norm_mix': g_norm_mix, 'w_in': w_in, 'g_q_lat': g_q_lat, 'g_kv_lat': g_kv_lat,
            'w_uq': w_uq, 'w_ukv': w_ukv, 'rel_bias': rel_bias, 'w_out': w_out,
            'g_norm_ffn': g_norm_ffn, 'w_router': w_router, 'w_gate': w_gate, 'w_up': w_up,
            'w_down': w_down, 'g_final': g_final}


def reference(x, c, positions, w_ada, b_ada, g_norm_mix, w_in, g_q_lat, g_kv_lat, w_uq, w_ukv,
              rel_bias, w_out, g_norm_ffn, w_router, w_gate, w_up, w_down, g_final):
    B, S, D = x.shape
    inv_freq = ROPE_THETA ** (-jnp.arange(0, MLA_ROPE_DIM, 2, dtype=jnp.float32) / MLA_ROPE_DIM)
    ang = positions.astype(jnp.float32)[..., None] * inv_freq
    cos, sin = jnp.cos(ang), jnp.sin(ang)
    cond = jax.nn.silu(c)
    split_at = [int(v) for v in np.cumsum(SPLIT_SIZES)[:-1]]
    for l in range(DEPTH):
        mod = (cond @ w_ada[l] + b_ada[l])[:, None, :]
        sh1, sc1, gt1, sh2, sc2, gt2 = jnp.split(mod, 6, axis=-1)
        h = rmsnorm(x, g_norm_mix[l]) * (1.0 + sc1) + sh1
        c_q, c_kv, k_pe, dil, gates = jnp.split(h @ w_in[l], split_at, axis=-1)
        o_a = mla_attention(c_q, c_kv, k_pe, g_q_lat[l], g_kv_lat[l], w_uq[l], w_ukv[l], cos, sin)
        dil = dil.reshape(B, S, len(DIL_GROUPS), 3, DIL_HEADS, DIL_HEAD_DIM)
        outs, lses = [], []
        for gi, (win, dd) in enumerate(DIL_GROUPS):
            o_g, lse_g = dilated_band_attention(
                dil[:, :, gi, 0], dil[:, :, gi, 1], dil[:, :, gi, 2], positions,
                rel_bias[:, gi * DIL_HEADS:(gi + 1) * DIL_HEADS], win, dd)
            outs.append(o_g)
            lses.append(lse_g)
        wts = jax.nn.softmax(jnp.stack(lses), axis=0)
        o_b = jnp.einsum('gbsh,gbshc->bshc', wts.astype(x.dtype), jnp.stack(outs)).reshape(B, S, D)
        g_a, g_b = jnp.split(jax.nn.sigmoid(gates), 2, axis=-1)
        x = x + gt1 * ((g_a * o_a + g_b * o_b) @ w_out[l])
        h2 = rmsnorm(x, g_norm_ffn[l]) * (1.0 + sc2) + sh2
        x = x + gt2 * expert_choice_ffn(h2, w_router[l], w_gate[l], w_up[l], w_down[l])
    return rmsnorm(x, g_final)
```

```cpp
#include <hip/hip_runtime.h>
#include <cstdio>
#include <cstdint>

#define LAS __attribute__((address_space(3)))
#define GAS __attribute__((address_space(1)))
typedef unsigned short bf16_t;
typedef short bf16x8 __attribute__((ext_vector_type(8)));
typedef short s16x4 __attribute__((ext_vector_type(4)));
typedef float f32x2 __attribute__((ext_vector_type(2)));
typedef float f32x4 __attribute__((ext_vector_type(4)));
typedef float f32x16 __attribute__((ext_vector_type(16)));
typedef unsigned u32x2 __attribute__((ext_vector_type(2)));
typedef unsigned u32x4 __attribute__((ext_vector_type(4)));
typedef int i32x4 __attribute__((ext_vector_type(4)));

constexpr int NB = 4, SEQ = 8192, DM = 1024, NTOK = NB * SEQ;
constexpr int NP = 12032;
constexpr int C_CQ = 0, C_CKV = 384, C_KPE = 640, C_DIL = 704, C_GATE = 9920, D_IN = 11968;
constexpr int NE = 16, CAP = 1024, DFF = 2048;
constexpr float NORM_EPS = 1e-6f;
constexpr float LOG2E = 1.4426950408889634f;

constexpr size_t MiB = 1u << 20;
constexpr size_t WS_CTL = 0, CTL_ZERO_BYTES = 1 * MiB;
constexpr size_t WS_MOD = 1 * MiB;
constexpr size_t WS_CS = 2 * MiB;
constexpr size_t WS_WIN = 10 * MiB;
constexpr size_t WS_WUQ = 34 * MiB;
constexpr size_t WS_WUKV = 36 * MiB;
constexpr size_t WS_WOUT = 37 * MiB;
constexpr size_t WS_H = 40 * MiB;
constexpr size_t WS_U = 104 * MiB;
constexpr size_t WS_R = 168 * MiB;
constexpr size_t WS_P = WS_R;
constexpr size_t WS_CQN = WS_R + 188 * MiB;
constexpr size_t WS_CKVN = WS_R + 194 * MiB;
constexpr size_t WS_QB = WS_R + 198 * MiB;
constexpr size_t WS_KB = WS_R + 222 * MiB;
constexpr size_t WS_VB = WS_R + 246 * MiB;
constexpr size_t WS_OA = WS_R + 262 * MiB;
constexpr size_t WS_OG = WS_R + 278 * MiB;
constexpr size_t WS_LSE = WS_R + 326 * MiB;
constexpr size_t WS_WGU = WS_R;
constexpr size_t WS_WD = WS_R + 128 * MiB;
constexpr size_t WS_HID = WS_R + 192 * MiB;
constexpr size_t WS_Y = WS_R + 256 * MiB;
constexpr size_t WS_AFFT = WS_R + 288 * MiB;
constexpr size_t WS_TOPI = WS_R + 290 * MiB;
constexpr size_t WS_TOPG = WS_R + 291 * MiB;
constexpr size_t WS_SLOT = WS_R + 292 * MiB;
constexpr size_t WS_END = WS_R + 327 * MiB;
constexpr int CW_TMO = 0, CW_DBG = 16, CW_BAR = 4096;

constexpr int RING_BYTES = 131072;
constexpr int MISC_OFF = RING_BYTES + 320;
constexpr int LDS_BYTES = 147456;
constexpr int NWAVES = 8;

#define RLX_AGENT __ATOMIC_RELAXED, __HIP_MEMORY_SCOPE_AGENT
#define LDS_WAIT() asm volatile("s_waitcnt lgkmcnt(0)" ::: "memory")
#define VM_WAIT() asm volatile("s_waitcnt vmcnt(0)" ::: "memory")

__device__ __forceinline__ unsigned cvt_pk_bf16(float lo, float hi) { unsigned r; asm volatile("v_cvt_pk_bf16_f32 %0, %1, %2" : "=v"(r) : "v"(lo), "v"(hi)); return r; }
__device__ __forceinline__ float bf2f(unsigned short v) { return __uint_as_float(((unsigned)v) << 16); }
__device__ __forceinline__ float bflo(unsigned w) { return __uint_as_float(w << 16); }
__device__ __forceinline__ float bfhi(unsigned w) { return __uint_as_float(w & 0xffff0000u); }
__device__ __forceinline__ float wave_sum(float v) {
#pragma unroll
    for (int o = 1; o < 64; o <<= 1) v += __shfl_xor(v, o);
    return v;
}
__device__ __forceinline__ float fast_sigmoid(float x) { return __builtin_amdgcn_rcpf(1.f + __builtin_amdgcn_exp2f(-x * LOG2E)); }
__device__ __forceinline__ int opaque_tid() { int t = (int)threadIdx.x; asm volatile("" : "+v"(t)); return t; }
#define XB_TMO      128
#define XB_XCNT(j)  (256  + 64 * (j))
#define XB_XSUB(j)  (1280 + 64 * (j))
#define XB_XGEN(j)  (2304 + 64 * (j))
#define XB_TOP      3328
#define XB_TOPGEN   3392
#define XCD_BAR_WORDS 3456
#define XB_SPIN_CAP (1u << 18)

__device__ __forceinline__ unsigned xb_ld(unsigned* p)              { return __hip_atomic_load(p, __ATOMIC_RELAXED, __HIP_MEMORY_SCOPE_AGENT); }
__device__ __forceinline__ unsigned xb_add(unsigned* p, unsigned v) { return __hip_atomic_fetch_add(p, v, __ATOMIC_RELAXED, __HIP_MEMORY_SCOPE_AGENT); }
__device__ __forceinline__ unsigned xb_xcc_id() { return (unsigned)__builtin_amdgcn_s_getreg((3 << 11) | 20) & 0xFu; }
#define XB_SPIN(cond, bar) do { unsigned _sp = 0; while (cond) { __builtin_amdgcn_s_sleep(1); \
    if ((++_sp & 255u) == 0u) { if (xb_ld(&(bar)[XB_TMO])) break; if (_sp > XB_SPIN_CAP) { atomicAdd(&(bar)[XB_TMO], 1u); break; } } } } while (0)

struct XcdBarrier {
    unsigned* bar; unsigned x;
    volatile LAS unsigned* st;
};

__device__ __forceinline__ XcdBarrier xcd_barrier_post(unsigned* bar, volatile LAS unsigned* st) {
    XcdBarrier b; b.bar = bar; b.x = xb_xcc_id(); b.st = st;
    if (threadIdx.x == 0) (void)xb_add(&bar[XB_XCNT(b.x)], 1u);
    return b;
}
__device__ __forceinline__ void xcd_barrier_complete(unsigned* bar, unsigned x, unsigned& nloc, unsigned& nx) {
    const unsigned G = gridDim.x * gridDim.y * gridDim.z;
    unsigned sum, cnt, mine, sp = 0u;
    for (;;) {
        sum = 0u; cnt = 0u; mine = 0u;
#pragma unroll
        for (unsigned j = 0; j < 16; ++j) { const unsigned c = xb_ld(&bar[XB_XCNT(j)]); sum += c; cnt += (c > 0u) ? 1u : 0u; mine = (j == x) ? c : mine; }
        if (sum == G) break;
        __builtin_amdgcn_s_sleep(1);
        if ((++sp & 255u) == 0u) { if (xb_ld(&bar[XB_TMO])) break; if (sp > XB_SPIN_CAP) { atomicAdd(&bar[XB_TMO], 1u); break; } }
    }
    nloc = mine > 0u ? mine : 1u; nx = cnt > 0u ? cnt : 1u;
}

__device__ __forceinline__ void xcd_barrier(const XcdBarrier& b) {
    asm volatile("s_waitcnt vmcnt(0)" ::: "memory");
    __syncthreads();
    if (threadIdx.x == 0) {
        unsigned* bar = b.bar;
        __builtin_amdgcn_s_waitcnt(0);
        unsigned nloc = b.st[0], nx = b.st[1];
        if (nloc == 0u) { xcd_barrier_complete(bar, b.x, nloc, nx); b.st[0] = nloc; b.st[1] = nx; }
        const unsigned old = xb_add(&bar[XB_XSUB(b.x)], 1u);
        const unsigned gen = old / nloc;
        if (old + 1u == (gen + 1u) * nloc) {
            __builtin_amdgcn_fence(__ATOMIC_RELEASE, "agent");
            asm volatile("s_waitcnt vmcnt(0)" ::: "memory");
            const unsigned og = xb_add(&bar[XB_TOP], 1u);
            const unsigned tg = og / nx;
            if (og + 1u == (tg + 1u) * nx) xb_add(&bar[XB_TOPGEN], 1u);
            else XB_SPIN(xb_ld(&bar[XB_TOPGEN]) == tg, bar);
            __builtin_amdgcn_fence(__ATOMIC_ACQUIRE, "agent");
            xb_add(&bar[XB_XGEN(b.x)], 1u);
            asm volatile("s_waitcnt vmcnt(0)" ::: "memory");
        } else {
            XB_SPIN(xb_ld(&bar[XB_XGEN(b.x)]) == gen, bar);
            __builtin_amdgcn_fence(__ATOMIC_ACQUIRE, "agent");
            asm volatile("s_waitcnt vmcnt(0)" ::: "memory");
        }
    }
    __syncthreads();
}

namespace pg8 {
constexpr int BM = 256, BK = 64, HALF = 128, HTB = HALF * BK * 2  , STAGE_BYTES = 8 * HTB, NXCD = 8, WGM = 8;

__host__ __device__ __forceinline__ int lds_byte(int r, int c) { const int st = (r >> 4) * 2 + (c >> 5), rr = r & 15, cc = c & 31, ob = rr * 64 + cc * 2; return st * 1024 + (ob ^ (((ob >> 9) & 1) << 5)); }
__host__ __device__ __forceinline__ void stage_rc(int b, int& R, int& C) { const int st = b / 1024, sb = b % 1024, swz = sb ^ (((sb >> 9) & 1) << 5); R = (st >> 1) * 16 + swz / 64; C = (st & 1) * 32 + (swz % 64) / 2; }
__host__ __device__ __forceinline__ int perm32(int rho) { const int n = rho >> 4, i = rho & 15; return 8 * (i >> 2) + 4 * n + (i & 3); }

struct Unit { int pm, pn, g; };
struct Gemm { const bf16_t* A; const bf16_t* Bt; int lda, ldb, K; long a_gs, b_gs; const int* idx; int idx_gs; };

struct StaticOrder {
    int nM, nN, nwg, G, c;
    __device__ void init(int M, int N, int G_, int c_) { nM = M / BM; nN = N / BM; nwg = nM * nN; G = G_; c = c_; }
    __device__ bool next(int i, Unit& u) const {
        const long L = (long)i * G + c; if (L >= nwg) return false;
        int wgid = (int)L; { const int q = nwg / NXCD, r = nwg % NXCD, xcd = wgid % NXCD, off = wgid / NXCD; wgid = (xcd < r ? xcd * (q + 1) : r * (q + 1) + (xcd - r) * q) + off; }
        const int nig = WGM * nN, gid = wgid / nig, fm = gid * WGM, gsz = (nM - fm) < WGM ? (nM - fm) : WGM;
        u.pm = fm + ((wgid % nig) % gsz); u.pn = (wgid % nig) / gsz; u.g = 0; return true;
    }
};
struct GroupOrder {
    int nM, nN, nwg, G, v;
    __device__ void init(int nM_, int nN_, int nG, int G_, int c_) { nM = nM_; nN = nN_; nwg = nM_ * nN_ * nG; G = G_; v = (G_ % 8 == 0) ? (c_ % 8) * (G_ / 8) + c_ / 8 : c_; }
    __device__ bool next(int i, Unit& u) const {
        const long L = (long)i * G + v; if (L >= nwg) return false;
        const int w = (int)L; u.pm = w % nM; u.pn = (w / nM) % nN; u.g = w / (nM * nN); return true;
    }
};

template <class Epi, class Sched, bool GATHER>
__device__ __forceinline__ void gemm_phase(LAS unsigned char* lds, const Gemm g, const Sched& S, const Epi& E) {
    const int tid = opaque_tid(), wid = __builtin_amdgcn_readfirstlane(tid >> 6), lane = tid & 63, wr = wid >> 2, wc = wid & 3, fr = lane & 15, fq = lane >> 4;
    const int K = g.K, nt = K / BK;
    int Rr[2], Cc[2]; unsigned voffB[2];
#pragma unroll
    for (int i = 0; i < 2; ++i) { int R, C; stage_rc(tid * 16 + i * 8192, R, C); Rr[i] = R; Cc[i] = C; const int Rb = Epi::PERM ? ((R & ~31) + perm32(R & 31)) : R;
        voffB[i] = (unsigned)(Rb * g.ldb + C) * 2u; }
    const size_t kstep = (size_t)(BK * 2);
    const size_t hstepA = (size_t)HALF * g.lda * 2, hstepB = (size_t)HALF * g.ldb * 2;
    const unsigned ldsw = (unsigned)wid * 1024u;
    const int aoff = lds_byte(wr * 64 + fr, fq * 8), boff = lds_byte(wc * 32 + fr, fq * 8);
#define PG8_SA(b, h) (((b) * 2 + (h)) * HTB)
#define PG8_SB(b, h) ((4 + (b) * 2 + (h)) * HTB)
#define PG8_STAGE(bufoff, gbase, v0, v1) do { \
        __builtin_amdgcn_global_load_lds((const unsigned*)((const char*)(gbase) + (v0)), (LAS unsigned*)(lds + (bufoff) + ldsw), 16, 0, 0); \
        __builtin_amdgcn_global_load_lds((const unsigned*)((const char*)(gbase) + (v1)), (LAS unsigned*)(lds + (bufoff) + ldsw + 8192), 16, 0, 0); } while (0)
#define PG8_STAGEB(bufoff, gbase) PG8_STAGE(bufoff, gbase, voffB[0], voffB[1])
#define PG8_LDA(dst, b, h) do { _Pragma("unroll") for (int m = 0; m < 4; ++m) _Pragma("unroll") for (int k = 0; k < 2; ++k) dst[m][k] = *(const LAS bf16x8*)(lds + PG8_SA(b, h) + aoff + m * 2048 + k * 1024); } while (0)
#define PG8_LDB(dst, b, h) do { _Pragma("unroll") for (int n = 0; n < 2; ++n) _Pragma("unroll") for (int k = 0; k < 2; ++k) dst[n][k] = *(const LAS bf16x8*)(lds + PG8_SB(b, h) + boff + n * 2048 + k * 1024); } while (0)
#define PG8_MMA(ai, bj, At, Bt) do { __builtin_amdgcn_s_setprio(1); _Pragma("unroll") for (int m = 0; m < 4; ++m) _Pragma("unroll") for (int n = 0; n < 2; ++n) _Pragma("unroll") for (int k = 0; k < 2; ++k) \
        acc[ai][bj][m][n] = __builtin_amdgcn_mfma_f32_16x16x32_bf16(Bt[n][k], At[m][k], acc[ai][bj][m][n], 0, 0, 0); __builtin_amdgcn_s_setprio(0); } while (0)
#define PG8_WAIT_V(n) asm volatile("s_waitcnt vmcnt(" #n ")" ::: "memory")
#define PG8_WAIT_L(n) asm volatile("s_waitcnt lgkmcnt(" #n ")" ::: "memory")
#define PG8_BAR __builtin_amdgcn_s_barrier()
#define PG8_SCHED __builtin_amdgcn_sched_barrier(0)
    Unit cur, nxt; int ui = 0;
    if (!S.next(0, cur)) return;
    f32x4 acc[2][2][4][2];
#pragma unroll
    for (int a = 0; a < 2; ++a)
#pragma unroll
        for (int b = 0; b < 2; ++b)
#pragma unroll
            for (int m = 0; m < 4; ++m)
#pragma unroll
                for (int n = 0; n < 2; ++n) acc[a][b][m][n] = (f32x4){0.f, 0.f, 0.f, 0.f};
    bf16x8 At[4][2], B0[2][2], B1[2][2];
    unsigned voffA[2]; unsigned oc[2][2], on[2][2];
#pragma unroll
    for (int i = 0; i < 2; ++i) voffA[i] = (unsigned)(Rr[i] * g.lda + Cc[i]) * 2u;
    const char* cA; const char* cB;
#define PG8_UNIT_PTRS(u, pA, pB, o) do { \
        pB = (const char*)(g.Bt + (size_t)(u).g * g.b_gs) + (size_t)(u).pn * BM * g.ldb * 2; \
        if constexpr (GATHER) { \
            pA = (const char*)g.A; \
            const int* ix_ = g.idx + (size_t)(u).g * g.idx_gs + (u).pm * BM; \
            _Pragma("unroll") for (int h = 0; h < 2; ++h) _Pragma("unroll") for (int i = 0; i < 2; ++i) o[h][i] = ((unsigned)ix_[h * HALF + Rr[i]] * (unsigned)g.lda + (unsigned)Cc[i]) * 2u; \
        } else { \
            pA = (const char*)(g.A + (size_t)(u).g * g.a_gs) + (size_t)(u).pm * BM * g.lda * 2; \
        } } while (0)
#define PG8_STAGEA(bufoff, p, o, h) do { if constexpr (GATHER) PG8_STAGE(bufoff, p, o[h][0], o[h][1]); else PG8_STAGE(bufoff, (p) + (h) * hstepA, voffA[0], voffA[1]); } while (0)
    PG8_UNIT_PTRS(cur, cA, cB, oc);
    PG8_STAGEB(PG8_SB(0, 0), cB); PG8_STAGEB(PG8_SB(0, 1), cB + hstepB); PG8_STAGEA(PG8_SA(0, 0), cA, oc, 0); PG8_STAGEA(PG8_SA(0, 1), cA, oc, 1);
    if (wr == 1) PG8_BAR;
    PG8_WAIT_V(2); PG8_BAR;
    PG8_STAGEB(PG8_SB(1, 0), cB + kstep); PG8_STAGEA(PG8_SA(1, 0), cA + kstep, oc, 0); PG8_STAGEB(PG8_SB(1, 1), cB + hstepB + kstep);
    PG8_WAIT_V(6); PG8_BAR;
    for (;;) {
        const bool has_next = S.next(ui + 1, nxt);
        const char* nA = cA; const char* nB = cB;
        if constexpr (GATHER) {
#pragma unroll
            for (int h = 0; h < 2; ++h)
#pragma unroll
                for (int i = 0; i < 2; ++i) on[h][i] = oc[h][i];
        }
        if (has_next) PG8_UNIT_PTRS(nxt, nA, nB, on);
#pragma unroll 1
        for (int t = 0; t < nt; t += 2) {
            const bool last = (t == nt - 2);
            const char* a1 = cA + (size_t)(t + 1) * kstep;
            const char* a2 = last ? nA : cA + (size_t)(t + 2) * kstep; const char* b2 = last ? nB : cB + (size_t)(t + 2) * kstep;
            const char* a3 = a2 + kstep; const char* b3 = b2 + kstep;
            unsigned o2[2][2];
            if constexpr (GATHER) {
#pragma unroll
                for (int h = 0; h < 2; ++h)
#pragma unroll
                    for (int i = 0; i < 2; ++i) o2[h][i] = last ? on[h][i] : oc[h][i];
            }
            PG8_LDB(B0, 0, 0); PG8_LDB(B1, 0, 1); PG8_SCHED; PG8_LDA(At, 0, 0); PG8_STAGEA(PG8_SA(1, 1), a1, oc, 1);
            PG8_WAIT_V(8); PG8_WAIT_L(0); PG8_BAR; PG8_MMA(0, 0, At, B0); PG8_MMA(0, 1, At, B1); PG8_BAR; PG8_SCHED;
            PG8_LDA(At, 0, 1); PG8_STAGEB(PG8_SB(0, 0), b2); PG8_STAGEB(PG8_SB(0, 1), b2 + hstepB); PG8_STAGEA(PG8_SA(0, 0), a2, o2, 0);
            PG8_WAIT_V(8); PG8_WAIT_L(0); PG8_BAR; PG8_MMA(1, 0, At, B0); PG8_MMA(1, 1, At, B1); PG8_BAR; PG8_SCHED;
            PG8_LDB(B0, 1, 0); PG8_LDB(B1, 1, 1); PG8_SCHED; PG8_LDA(At, 1, 0); PG8_STAGEA(PG8_SA(0, 1), a2, o2, 1);
            PG8_WAIT_V(8); PG8_WAIT_L(0); PG8_BAR; PG8_MMA(0, 0, At, B0); PG8_MMA(0, 1, At, B1); PG8_BAR; PG8_SCHED;
            PG8_LDA(At, 1, 1); PG8_STAGEB(PG8_SB(1, 0), b3); PG8_STAGEB(PG8_SB(1, 1), b3 + hstepB); PG8_STAGEA(PG8_SA(1, 0), a3, o2, 0);
            PG8_WAIT_V(8); PG8_WAIT_L(0); PG8_BAR; PG8_MMA(1, 0, At, B0); PG8_MMA(1, 1, At, B1); PG8_BAR; PG8_SCHED;
        }
        if (wr == 0) PG8_BAR;
        E(acc, cur, wr, wc, fr, fq);
        if (!has_next) break;
#pragma unroll
        for (int a = 0; a < 2; ++a)
#pragma unroll
            for (int b = 0; b < 2; ++b)
#pragma unroll
                for (int m = 0; m < 4; ++m)
#pragma unroll
                    for (int n = 0; n < 2; ++n) acc[a][b][m][n] = (f32x4){0.f, 0.f, 0.f, 0.f};
        cur = nxt; cA = nA; cB = nB; ++ui;
        if constexpr (GATHER) {
#pragma unroll
            for (int h = 0; h < 2; ++h)
#pragma unroll
                for (int i = 0; i < 2; ++i) oc[h][i] = on[h][i];
        }
        if (wr == 1) PG8_BAR;
    }
    PG8_WAIT_V(0);
    PG8_BAR;
#undef PG8_UNIT_PTRS
#undef PG8_STAGEA
#undef PG8_SA
#undef PG8_SB
#undef PG8_STAGE
#undef PG8_STAGEB
#undef PG8_LDA
#undef PG8_LDB
#undef PG8_MMA
#undef PG8_WAIT_V
#undef PG8_WAIT_L
#undef PG8_BAR
#undef PG8_SCHED
}

#define EPI_ROWLOOP for (int ai = 0; ai < 2; ++ai) _Pragma("unroll") for (int m = 0; m < 4; ++m)
__device__ __forceinline__ u32x4 pack8(const f32x4 v0, const f32x4 v1) { u32x4 w; w.x = cvt_pk_bf16(v0[0], v0[1]); w.y = cvt_pk_bf16(v0[2], v0[3]); w.z = cvt_pk_bf16(v1[0], v1[1]); w.w = cvt_pk_bf16(v1[2], v1[3]); return w; }
struct EpiBf16 {
    static constexpr bool PERM = true;
    bf16_t* O; int ldc;
    __device__ __forceinline__ void operator()(const f32x4 (&acc)[2][2][4][2], const Unit& u, int wr, int wc, int fr, int fq) const {
        const unsigned lo = (unsigned)(fr * ldc + 8 * fq) * 2u;
        char* ub = (char*)(O + (size_t)(u.pm * BM + wr * 64) * ldc + u.pn * BM + wc * 32);
#pragma unroll
        EPI_ROWLOOP { char* rb = ub + (size_t)(ai * HALF + m * 16) * ldc * 2;
#pragma unroll
            for (int bj = 0; bj < 2; ++bj) *(u32x4*)(rb + bj * HALF * 2 + lo) = pack8(acc[ai][bj][m][0], acc[ai][bj][m][1]); }
    }
};
struct EpiQ {
    static constexpr bool PERM = true;
    bf16_t* QB; const float* cs;
    __device__ __forceinline__ void operator()(const f32x4 (&acc)[2][2][4][2], const Unit& u, int wr, int wc, int fr, int fq) const {
        const unsigned lo = (unsigned)(fr * 192 + 8 * fq) * 2u, lcs = (unsigned)(fr * 64 + 8 * fq) * 4u;
        const int rowU = u.pm * BM + wr * 64;
#pragma unroll
        for (int bj = 0; bj < 2; ++bj) { const int c32 = u.pn * BM + bj * HALF + wc * 32, hd = c32 / 192, w32 = c32 - hd * 192;
            char* ub = (char*)(QB + ((size_t)hd * SEQ + rowU) * 192 + w32);
            const char* cb = (const char*)(cs + (size_t)rowU * 64 + (w32 >= 128 ? (w32 - 128) : 0));
#pragma unroll
            EPI_ROWLOOP { const int rr = ai * HALF + m * 16; f32x4 v0 = acc[ai][bj][m][0], v1 = acc[ai][bj][m][1];
                if (w32 >= 128) { const f32x4 ca = *(const f32x4*)(cb + (size_t)rr * 256 + lcs), cc = *(const f32x4*)(cb + (size_t)rr * 256 + 16 + lcs);
                    const f32x4 a = v0, b = v1;
                    v0[0] = a[0] * ca[0] - a[1] * ca[1]; v0[1] = a[0] * ca[1] + a[1] * ca[0]; v0[2] = a[2] * ca[2] - a[3] * ca[3]; v0[3] = a[2] * ca[3] + a[3] * ca[2];
                    v1[0] = b[0] * cc[0] - b[1] * cc[1]; v1[1] = b[0] * cc[1] + b[1] * cc[0]; v1[2] = b[2] * cc[2] - b[3] * cc[3]; v1[3] = b[2] * cc[3] + b[3] * cc[2]; }
                *(u32x4*)(ub + (size_t)rr * 384 + lo) = pack8(v0, v1);
                if (m & 1) asm volatile("" ::: "memory"); } }
    }
};
struct EpiKV {
    static constexpr bool PERM = true;
    bf16_t* KB; bf16_t* VB;
    __device__ __forceinline__ void operator()(const f32x4 (&acc)[2][2][4][2], const Unit& u, int wr, int wc, int fr, int fq) const {
        const int rowU = u.pm * BM + wr * 64;
#pragma unroll
        for (int bj = 0; bj < 2; ++bj) { const int c32 = u.pn * BM + bj * HALF + wc * 32, hd = c32 >> 8, w32 = c32 & 255; const bool isk = w32 < 128;
            const int ld = isk ? 192 : 128;
            char* ub = (char*)(isk ? KB + ((size_t)hd * SEQ + rowU) * 192 + w32 : VB + ((size_t)hd * SEQ + rowU) * 128 + (w32 - 128));
            const unsigned lo = (unsigned)(fr * ld + 8 * fq) * 2u;
#pragma unroll
            EPI_ROWLOOP { *(u32x4*)(ub + (size_t)(ai * HALF + m * 16) * ld * 2 + lo) = pack8(acc[ai][bj][m][0], acc[ai][bj][m][1]); } }
    }
};
struct EpiRes {
    static constexpr bool PERM = false;
    const float* x; float* out; const float* mod;
    __device__ __forceinline__ void operator()(const f32x4 (&acc)[2][2][4][2], const Unit& u, int wr, int wc, int fr, int fq) const {
        const int col0 = u.pn * BM + wc * 32 + 4 * fq;
        const int b = (u.pm * BM) / SEQ;
        f32x4 gt[2][2];
#pragma unroll
        for (int bj = 0; bj < 2; ++bj)
#pragma unroll
            for (int n = 0; n < 2; ++n) gt[bj][n] = *(const f32x4*)(mod + b * 6144 + 2048 + col0 + bj * HALF + n * 16);
        const unsigned lo = (unsigned)(fr * DM + 4 * fq) * 4u;
        const size_t ubo = ((size_t)(u.pm * BM + wr * 64) * DM + u.pn * BM + wc * 32) * 4;
#pragma unroll
        EPI_ROWLOOP { const size_t ro = ubo + (size_t)(ai * HALF + m * 16) * DM * 4;
#pragma unroll
            for (int bj = 0; bj < 2; ++bj)
#pragma unroll
                for (int n = 0; n < 2; ++n) { const size_t o = ro + (bj * HALF + n * 16) * 4; const f32x4 xv = *(const f32x4*)((const char*)x + o + lo);
                    *(f32x4*)((char*)out + o + lo) = xv + gt[bj][n] * acc[ai][bj][m][n]; }
            if (m & 1) asm volatile("" ::: "memory"); }
    }
};
struct EpiSwiGLU {
    static constexpr bool PERM = true;
    bf16_t* HID;
    __device__ __forceinline__ void operator()(const f32x4 (&acc)[2][2][4][2], const Unit& u, int wr, int wc, int fr, int fq) const {
        const unsigned lo = (unsigned)(fr * DFF + 4 * fq) * 2u;
        char* ub = (char*)(HID + ((size_t)u.g * CAP + u.pm * BM + wr * 64) * DFF + ((u.pn * BM + wc * 32) >> 1));
#pragma unroll
        EPI_ROWLOOP { char* rb = ub + (size_t)(ai * HALF + m * 16) * DFF * 2;
#pragma unroll
            for (int bj = 0; bj < 2; ++bj) { const f32x4 gv = acc[ai][bj][m][0], uv = acc[ai][bj][m][1]; f32x4 h;
#pragma unroll
                for (int e = 0; e < 4; ++e) h[e] = gv[e] * fast_sigmoid(gv[e]) * uv[e];
                u32x2 o; o.x = cvt_pk_bf16(h[0], h[1]); o.y = cvt_pk_bf16(h[2], h[3]);
                *(u32x2*)(rb + bj * (HALF / 2) * 2 + lo) = o; } }
    }
};
struct EpiDown {
    static constexpr bool PERM = true;
    bf16_t* Y; const float* gate;
    __device__ __forceinline__ void operator()(const f32x4 (&acc)[2][2][4][2], const Unit& u, int wr, int wc, int fr, int fq) const {
        const unsigned lo = (unsigned)(fr * DM + 8 * fq) * 2u;
        const int rowU = u.g * CAP + u.pm * BM + wr * 64;
        char* ub = (char*)(Y + (size_t)rowU * DM + u.pn * BM + wc * 32);
        const float* gp = gate + rowU + fr;
#pragma unroll
        EPI_ROWLOOP { const int rr = ai * HALF + m * 16; const float gs = gp[rr]; char* rb = ub + (size_t)rr * DM * 2;
#pragma unroll
            for (int bj = 0; bj < 2; ++bj) *(u32x4*)(rb + bj * HALF * 2 + lo) = pack8(acc[ai][bj][m][0] * gs, acc[ai][bj][m][1] * gs); }
    }
};
#undef EPI_ROWLOOP
}
namespace att {
__device__ __forceinline__ int crow(int r, int hi) { return (r & 3) + 8 * (r >> 2) + 4 * hi; }
__device__ __forceinline__ int v_st(int k, int c) { const int kk = (k & ~0xC) | ((k & 4) << 1) | ((k & 8) >> 1); return ((kk >> 3) * 4 + (c >> 5)) * 512 + ((kk & 7) * 32 + (c & 31)) * 2; }
__device__ __forceinline__ int v_rd_base(int lane) { return ((lane & 3) << 3) | (((lane >> 2) & 3) << 6) | (((lane >> 4) & 1) << 5) | (((lane >> 5) & 1) << 8); }
constexpr int v_rd_off(int d0, int ks, int half) { return d0 * 512 + ks * 4096 + half * 2048; }
template <int OFF> __device__ __forceinline__ s16x4 tr_read(int vb) {
    s16x4 r; asm volatile("ds_read_b64_tr_b16 %0, %1 offset:%2" : "=&v"(r) : "v"(vb), "i"(OFF) : "memory"); return r;
}
#define ATT_SBAR() __builtin_amdgcn_sched_barrier(0)
template <int D0> __device__ __forceinline__ void pv_one(f32x16& od, int vb, bf16x8 pa0, bf16x8 pa1, bf16x8 pa2, bf16x8 pa3) {
    const s16x4 l0 = tr_read<v_rd_off(D0, 0, 0)>(vb), h0 = tr_read<v_rd_off(D0, 0, 1)>(vb), l1 = tr_read<v_rd_off(D0, 1, 0)>(vb), h1 = tr_read<v_rd_off(D0, 1, 1)>(vb);
    const s16x4 l2 = tr_read<v_rd_off(D0, 2, 0)>(vb), h2 = tr_read<v_rd_off(D0, 2, 1)>(vb), l3 = tr_read<v_rd_off(D0, 3, 0)>(vb), h3 = tr_read<v_rd_off(D0, 3, 1)>(vb);
    asm volatile("s_waitcnt lgkmcnt(0)" ::: "memory"); ATT_SBAR();
#define ATT_PK(L, H) (bf16x8){L[0], L[1], L[2], L[3], H[0], H[1], H[2], H[3]}
    od = __builtin_amdgcn_mfma_f32_32x32x16_bf16(pa0, ATT_PK(l0, h0), od, 0, 0, 0);
    od = __builtin_amdgcn_mfma_f32_32x32x16_bf16(pa1, ATT_PK(l1, h1), od, 0, 0, 0);
    od = __builtin_amdgcn_mfma_f32_32x32x16_bf16(pa2, ATT_PK(l2, h2), od, 0, 0, 0);
    od = __builtin_amdgcn_mfma_f32_32x32x16_bf16(pa3, ATT_PK(l3, h3), od, 0, 0, 0);
#undef ATT_PK
}
__device__ __forceinline__ void pv_d0(f32x16* o, int vb, bf16x8 pa0, bf16x8 pa1, bf16x8 pa2, bf16x8 pa3) {
    pv_one<0>(o[0], vb, pa0, pa1, pa2, pa3); pv_one<1>(o[1], vb, pa0, pa1, pa2, pa3); pv_one<2>(o[2], vb, pa0, pa1, pa2, pa3); pv_one<3>(o[3], vb, pa0, pa1, pa2, pa3);
}
__device__ __forceinline__ void finishSM(f32x16& p0, f32x16& p1, float alpha, float& l_reg, bf16x8& pa0, bf16x8& pa1, bf16x8& pa2, bf16x8& pa3) {
#pragma unroll
    for (int r = 0; r < 16; ++r) p1[r] = __builtin_amdgcn_exp2f(p1[r]);
    float ps = 0;
#pragma unroll
    for (int r = 0; r < 16; ++r) ps += p0[r];
#pragma unroll
    for (int r = 0; r < 16; ++r) ps += p1[r];
    { auto rr = __builtin_amdgcn_permlane32_swap(__float_as_uint(ps), __float_as_uint(ps), false, false);
      ps = __uint_as_float(rr[0]) + __uint_as_float(rr[1]); }
    l_reg = l_reg * alpha + ps;
#define ATT_PK4(P, BASE, OUT) do { unsigned a0 = cvt_pk_bf16(P[BASE + 0], P[BASE + 1]), a1 = cvt_pk_bf16(P[BASE + 2], P[BASE + 3]);   \
    unsigned b0 = cvt_pk_bf16(P[BASE + 4], P[BASE + 5]), b1 = cvt_pk_bf16(P[BASE + 6], P[BASE + 7]);                              \
    auto r0 = __builtin_amdgcn_permlane32_swap(a0, b0, false, false); auto r1 = __builtin_amdgcn_permlane32_swap(a1, b1, false, false); \
    u32x4 w = {r0[0], r1[0], r0[1], r1[1]}; OUT = *reinterpret_cast<bf16x8*>(&w); } while (0)
    ATT_PK4(p0, 0, pa0); ATT_PK4(p0, 8, pa1); ATT_PK4(p1, 0, pa2); ATT_PK4(p1, 8, pa3);
#undef ATT_PK4
}

struct Unit {
    const bf16_t* Q; int qs;
    const bf16_t* K; int ks;
    const bf16_t* V; int vs;
    bf16_t* O; int os;
    int nt;
    int kt0, ktn;
    int l0;
    const int* pos; int ps;
    float* lse; int ls;
    const float* bias;
};

template <bool DIL> struct Cfg {
    static constexpr int DQK = DIL ? 128 : 192, ND = DQK / 16, KROWB = DQK * 2 + 16, SHM_K = 64 * KROWB, SHM_V = 16384;
    static constexpr int NKC = DQK / 64;
    static constexpr int OFF_V = 0, OFF_K = 2 * SHM_V, OFF_WS = OFF_K + 2 * SHM_K, OFF_POS = OFF_WS + NWAVES * 64 * 4, OFF_LUT = OFF_POS + 2 * 64 * 4, END = OFF_LUT + 2052 * 4;
    static constexpr float SCALE = DIL ? 0.088388347648318440f : 0.072168783648703220f;
};

template <bool DIL>
__device__ __forceinline__ void qkt(f32x16& p0, f32x16& p1, const LAS char* Ks, const bf16x8* qr, int r32, int hi) {
    using C = Cfg<DIL>;
    p0 = f32x16{}; p1 = f32x16{};
    const LAS char* k0 = Ks + r32 * C::KROWB + hi * 16; const LAS char* k1 = k0 + 32 * C::KROWB;
#pragma unroll
    for (int d0 = 0; d0 < C::ND; ++d0) {
        const bf16x8 b0 = *(const LAS bf16x8*)(k0 + d0 * 32);
        const bf16x8 b1 = *(const LAS bf16x8*)(k1 + d0 * 32);
        p0 = __builtin_amdgcn_mfma_f32_32x32x16_bf16(b0, qr[d0], p0, 0, 0, 0);
        p1 = __builtin_amdgcn_mfma_f32_32x32x16_bf16(b1, qr[d0], p1, 0, 0, 0); }
}

template <bool DIL>
__device__ __forceinline__ void partialSM(f32x16& p0, f32x16& p1, float& m_reg, float& mn, float& alpha,
                                          const LAS int* posb, const LAS float* lut, int pq, int dl0, bool tv, int hi) {
    using C = Cfg<DIL>;
    constexpr float CC = C::SCALE * LOG2E;
    constexpr float THR = 8.f;
    float mnC;
    if constexpr (DIL) {
#pragma unroll
        for (int a = 0; a < 4; ++a) {
            const i32x4 pk0 = *(const LAS i32x4*)(posb + 8 * a + 4 * hi), pk1 = *(const LAS i32x4*)(posb + 32 + 8 * a + 4 * hi);
#pragma unroll
            for (int b = 0; b < 4; ++b) { const int r = 4 * a + b;
                int i0 = pk0[b] - pq; i0 = i0 < -1024 ? -1024 : (i0 > 1024 ? 1024 : i0);
                int i1 = pk1[b] - pq; i1 = i1 < -1024 ? -1024 : (i1 > 1024 ? 1024 : i1);
                const float b0 = lut[i0 + 1024], b1 = lut[i1 + 1024];
                const int dl = dl0 + 8 * a + b;
                const bool ok0 = tv && ((unsigned)(dl + 64) <= 128u), ok1 = tv && ((unsigned)(dl + 32 + 64) <= 128u);
                p0[r] = ok0 ? fmaf(p0[r], CC, b0) : -1e30f;
                p1[r] = ok1 ? fmaf(p1[r], CC, b1) : -1e30f; }
        }
        float pmax = p0[0];
#pragma unroll
        for (int r = 1; r < 16; ++r) pmax = fmaxf(pmax, p0[r]);
#pragma unroll
        for (int r = 0; r < 16; ++r) pmax = fmaxf(pmax, p1[r]);
        { auto rr = __builtin_amdgcn_permlane32_swap(__float_as_uint(pmax), __float_as_uint(pmax), false, false);
          pmax = fmaxf(__uint_as_float(rr[0]), __uint_as_float(rr[1])); }
        if (__builtin_expect(__all(pmax - m_reg <= THR * LOG2E), 1)) { mn = m_reg; alpha = 1.f; }
        else { mn = fmaxf(m_reg, pmax); alpha = __builtin_amdgcn_exp2f(m_reg - mn); m_reg = mn; }
        mnC = -fmaxf(mn, -1e29f);
#pragma unroll
        for (int r = 0; r < 16; ++r) p0[r] = p0[r] + mnC;
#pragma unroll
        for (int r = 0; r < 16; ++r) p1[r] = p1[r] + mnC;
    } else {
        float pmax = p0[0];
#pragma unroll
        for (int r = 1; r < 16; ++r) pmax = fmaxf(pmax, p0[r]);
#pragma unroll
        for (int r = 0; r < 16; ++r) pmax = fmaxf(pmax, p1[r]);
        { auto rr = __builtin_amdgcn_permlane32_swap(__float_as_uint(pmax), __float_as_uint(pmax), false, false);
          pmax = fmaxf(__uint_as_float(rr[0]), __uint_as_float(rr[1])); }
        if (__builtin_expect(__all(pmax - m_reg <= THR / C::SCALE), 1)) { mn = m_reg; alpha = 1.f; }
        else { mn = fmaxf(m_reg, pmax); alpha = __builtin_amdgcn_exp2f((m_reg - mn) * CC); m_reg = mn; }
        mnC = -mn * CC;
#pragma unroll
        for (int r = 0; r < 16; ++r) p0[r] = fmaf(p0[r], CC, mnC);
#pragma unroll
        for (int r = 0; r < 16; ++r) p1[r] = fmaf(p1[r], CC, mnC);
    }
#pragma unroll
    for (int r = 0; r < 16; ++r) p0[r] = __builtin_amdgcn_exp2f(p0[r]);
}

__device__ __forceinline__ int t5_bucket(int rel) {
    const int n = rel < 0 ? -rel : rel;
    const float nf = (float)(n > 1 ? n : 1);
    int large = 8 + (int)(logf(nf / 8.f) / 4.852030263919617f * 8.f);
    large = large < 15 ? large : 15;
    return (rel > 0 ? 16 : 0) + (n < 8 ? n : large);
}

template <bool DIL>
__device__ __forceinline__ void attn_unit(const Unit& a, LAS char* lds) {
    using C = Cfg<DIL>;
    constexpr int SD = 1;
    const int tid = opaque_tid(), wid = __builtin_amdgcn_readfirstlane(tid >> 6), lane = tid & 63, r32 = lane & 31, hi = lane >> 5;
    LAS char* V_lds = lds + C::OFF_V; LAS char* K_lds = lds + C::OFF_K;
    LAS float* ws = (LAS float*)(lds + C::OFF_WS) + wid * 64; LAS float* li_l = ws; LAS float* al_l = ws + 32;
    LAS int* pos_l = (LAS int*)(lds + C::OFF_POS); LAS float* lut = (LAS float*)(lds + C::OFF_LUT);
    float m_reg = -1e30f, l_reg = 0; f32x16 o[4] = {}; bf16x8 qr[C::ND];
    { const bf16_t* Qw = a.Q + (size_t)(wid * 32 + r32) * a.qs + hi * 8;
#pragma unroll
      for (int d0 = 0; d0 < C::ND; ++d0) qr[d0] = *(const bf16x8*)(Qw + d0 * 16); }
    int pq = 0, lq = 0;
    if constexpr (DIL) {
        lq = a.l0 + wid * 32 + r32; pq = a.pos[(size_t)lq * a.ps];
        for (int i = tid; i < 2049; i += 512) lut[i] = a.bias[t5_bucket(i - 1024) * 24] * LOG2E;
    }
    unsigned kgo[C::NKC]; int klo[C::NKC];
#pragma unroll
    for (int i = 0; i < C::NKC; ++i) { const int c = tid + 512 * i, kr = c / (C::DQK / 8), kc = c % (C::DQK / 8); kgo[i] = (unsigned)(kr * a.ks + kc * 8) * 2u; klo[i] = kr * C::KROWB + kc * 16; }
    const int sr = tid >> 4, sc = (tid & 15) * 8, vst0 = v_st(sr, sc), vst1 = v_st(32 + sr, sc);
    const unsigned vgo0 = (unsigned)(sr * a.vs + sc) * 2u, vgo1 = (unsigned)((32 + sr) * a.vs + sc) * 2u;
    const int vb0 = (int)(unsigned)(size_t)V_lds + v_rd_base(lane);
    struct { bf16x8 vs0, vs1, ks[C::NKC]; int pp; } sl[SD];
#define ATT_KROW0(j) (DIL ? (((a.kt0 + (j)) < 0 ? 0 : ((a.kt0 + (j)) >= a.ktn ? a.ktn - 1 : (a.kt0 + (j)))) * 64) : (j) * 64)
#define ATT_SLOAD(i, j) do { const int k0_ = ATT_KROW0(j); const char* kt_ = (const char*)(a.K + (size_t)k0_ * a.ks); const char* vt_ = (const char*)(a.V + (size_t)k0_ * a.vs); \
        sl[i].vs0 = *(const bf16x8*)(vt_ + vgo0); sl[i].vs1 = *(const bf16x8*)(vt_ + vgo1); \
        _Pragma("unroll") for (int q_ = 0; q_ < C::NKC; ++q_) sl[i].ks[q_] = *(const bf16x8*)(kt_ + kgo[q_]); \
        if constexpr (DIL) { if (tid < 64) sl[i].pp = a.pos[(size_t)(k0_ + tid) * a.ps]; } } while (0)
#define ATT_SWRITE(b, i) do { *(LAS bf16x8*)(V_lds + (b) * C::SHM_V + vst0) = sl[i].vs0; *(LAS bf16x8*)(V_lds + (b) * C::SHM_V + vst1) = sl[i].vs1; \
        _Pragma("unroll") for (int q_ = 0; q_ < C::NKC; ++q_) *(LAS bf16x8*)(K_lds + (b) * C::SHM_K + klo[q_]) = sl[i].ks[q_]; \
        if constexpr (DIL) { if (tid < 64) pos_l[(b) * 64 + tid] = sl[i].pp; } } while (0)
#define ATT_SWAIT() do { if constexpr (SD == 2) asm volatile("s_waitcnt vmcnt(%0)" :: "n"(2 + C::NKC) : "memory"); else asm volatile("s_waitcnt vmcnt(0)" ::: "memory"); } while (0)
#define ATT_RESC(al) do { if (__any((al) < 1.f)) { if (hi == 0) al_l[r32] = (al); asm volatile("s_waitcnt lgkmcnt(0)" ::: "memory"); \
        _Pragma("unroll") for (int d = 0; d < 4; ++d) _Pragma("unroll") for (int r = 0; r < 16; ++r) o[d][r] *= al_l[crow(r, hi)]; } } while (0)
#define ATT_DL0(j) (DIL ? (64 * (a.kt0 + (j)) - lq + 4 * hi) : 0)
#define ATT_TV(j) (DIL ? ((a.kt0 + (j)) >= 0 && (a.kt0 + (j)) < a.ktn) : true)
    f32x16 p0, p1; float mn, al; bf16x8 pa0, pa1, pa2, pa3; const int NT = a.nt;
    ATT_SLOAD(0, 0); asm volatile("s_waitcnt vmcnt(0)" ::: "memory"); ATT_SWRITE(0, 0); __syncthreads();
    for (int j = 0; j < NT; ++j) {
        const int cur = j & 1;
        ATT_SBAR();
        qkt<DIL>(p0, p1, K_lds + cur * C::SHM_K, qr, r32, hi);
        partialSM<DIL>(p0, p1, m_reg, mn, al, pos_l + cur * 64, lut, pq, ATT_DL0(j), ATT_TV(j), hi);
        ATT_RESC(al);
        finishSM(p0, p1, al, l_reg, pa0, pa1, pa2, pa3); ATT_SBAR();
        if (j + 1 < NT) ATT_SLOAD(0, j + 1);
        ATT_SBAR();
        pv_d0(o, vb0 + cur * (int)C::SHM_V, pa0, pa1, pa2, pa3);
        if (j + 1 < NT) { if (cur) ATT_SWRITE(0, 0); else ATT_SWRITE(1, 0); }
        __syncthreads();
    }
    if (hi == 0) li_l[r32] = l_reg; asm volatile("s_waitcnt lgkmcnt(0)" ::: "memory");
    { const unsigned lo = (unsigned)(4 * hi * a.os + r32) * 2u;
      char* Ow = (char*)(a.O + (size_t)(wid * 32) * a.os);
#pragma unroll
      for (int r = 0; r < 16; ++r) { const float rl = __builtin_amdgcn_rcpf(li_l[crow(r, hi)]); char* rb = Ow + (size_t)((r & 3) + 8 * (r >> 2)) * a.os * 2;
#pragma unroll
          for (int d0 = 0; d0 < 4; ++d0) { const float v = o[d0][r] * rl; *(bf16_t*)(rb + d0 * 64 + lo) = (bf16_t)(cvt_pk_bf16(v, v) & 0xffffu); } } }
    if constexpr (DIL) { if (hi == 0) a.lse[(size_t)(wid * 32 + r32) * a.ls] = m_reg + __builtin_amdgcn_logf(l_reg); }
    __syncthreads();
#undef ATT_KROW0
#undef ATT_SLOAD
#undef ATT_SWRITE
#undef ATT_SWAIT
#undef ATT_RESC
#undef ATT_DL0
#undef ATT_TV
}
}
struct Frame {
    LAS unsigned char* lds;
    int tid, lane, wave, vcu, G, gw, NGW;
};
struct Args { const void* in[19]; float* out; unsigned char* ws; int st_lo, st_hi; };

template <class F>
__device__ __forceinline__ void transpose_item(F colptr, int ldn, bf16_t* WT, int ldk, int k0, int n0, LAS float* scr, int lane) {
    const float* cp = colptr(n0 + (lane & 31));
#pragma unroll 8
    for (int i = 0; i < 32; ++i) { const int kk = 2 * i + (lane >> 5); scr[kk * 33 + (lane & 31)] = cp ? cp[(size_t)(k0 + kk) * ldn] : 0.f; }
    LDS_WAIT(); asm volatile("" ::: "memory");
    const int c = lane & 7;
#pragma unroll
    for (int j = 0; j < 4; ++j) { const int n = (lane >> 3) + 8 * j; const LAS float* s = scr + (8 * c) * 33 + n;
        u32x4 o; o.x = cvt_pk_bf16(s[0 * 33], s[1 * 33]); o.y = cvt_pk_bf16(s[2 * 33], s[3 * 33]); o.z = cvt_pk_bf16(s[4 * 33], s[5 * 33]); o.w = cvt_pk_bf16(s[6 * 33], s[7 * 33]);
        *(u32x4*)(WT + (size_t)(n0 + n) * ldk + k0 + 8 * c) = o; }
    LDS_WAIT(); asm volatile("" ::: "memory");
}

__device__ __forceinline__ void p0_mod(const Frame& F, const float* c, const float* w_ada, const float* b_ada, float* mod) {
    const int tid = opaque_tid(), lane = tid & 63; (void)tid; (void)lane;
    LAS float* red = (LAS float*)F.lds;
    for (int blk = blockIdx.x; blk < 96; blk += F.G) {
        const int col = blk * 64 + (tid & 63), ks = tid >> 6;
        float a0 = 0.f, a1 = 0.f, a2 = 0.f, a3 = 0.f;
        for (int k = ks * 128; k < ks * 128 + 128; ++k) {
            const float w = w_ada[(size_t)k * 6144 + col];
            const float c0 = c[k], c1 = c[1024 + k], c2 = c[2048 + k], c3 = c[3072 + k];
            a0 += c0 * fast_sigmoid(c0) * w; a1 += c1 * fast_sigmoid(c1) * w; a2 += c2 * fast_sigmoid(c2) * w; a3 += c3 * fast_sigmoid(c3) * w;
        }
        red[(ks * 4 + 0) * 64 + (tid & 63)] = a0; red[(ks * 4 + 1) * 64 + (tid & 63)] = a1; red[(ks * 4 + 2) * 64 + (tid & 63)] = a2; red[(ks * 4 + 3) * 64 + (tid & 63)] = a3;
        __syncthreads();
        if (tid < 256) { const int b = tid >> 6, cc = tid & 63; float s = 0.f;
#pragma unroll
            for (int q = 0; q < 8; ++q) s += red[(q * 4 + b) * 64 + cc];
            mod[b * 6144 + blk * 64 + cc] = s + b_ada[blk * 64 + cc]; }
        __syncthreads();
    }
}
__device__ __forceinline__ void p0_cs(const Frame& F, const int* pos, float* cs) {
    const int tid = opaque_tid(), lane = tid & 63; (void)tid; (void)lane;
    for (int i = (int)blockIdx.x * 512 + tid; i < NTOK * 32; i += F.G * 512) {
        const int t = i >> 5, j = i & 31;
        const float inv = __builtin_amdgcn_exp2f(-(float)(2 * j) / 64.f * 13.287712379549449f);
        const float ang = (float)pos[t] * inv;
        const double rev = (double)ang * 0.15915494309189535; const double fr = rev - __builtin_rint(rev);
        const float f = (float)fr;
        f32x2 o; o.x = __builtin_amdgcn_cosf(f); o.y = __builtin_amdgcn_sinf(f);
        *(f32x2*)(cs + (size_t)i * 2) = o;
    }
}
__device__ __forceinline__ void p0_weights(const Frame& F, const float* w_in, const float* w_uq, const float* w_ukv, const float* w_out, unsigned char* ws) {
    const int tid = opaque_tid(), lane = tid & 63; (void)tid; (void)lane;
    LAS float* scr = (LAS float*)(F.lds + F.wave * 16384);
    constexpr int I_IN = 16 * 376, I_UQ = 6 * 48, I_UKV = 4 * 64, I_OUT = 16 * 32;
    for (int it = F.gw; it < I_IN + I_UQ + I_UKV + I_OUT; it += F.NGW) {
        int r = it;
        if (r < I_IN) { const int kb = r / 376, nb = r % 376;
            transpose_item([=](int n) -> const float* { return n < D_IN ? w_in + n : nullptr; }, D_IN, (bf16_t*)(ws + WS_WIN), 1024, kb * 64, nb * 32, scr, lane); continue; }
        r -= I_IN;
        if (r < I_UQ) { const int kb = r / 48, nb = r % 48;
            transpose_item([=](int n) -> const float* { const int hd = n / 192, w = n - hd * 192; const int sc = w < 128 ? w : 128 + ((w - 128) >> 1) + 32 * ((w - 128) & 1); return w_uq + hd * 192 + sc; },
                           1536, (bf16_t*)(ws + WS_WUQ), 384, kb * 64, nb * 32, scr, lane); continue; }
        r -= I_UQ;
        if (r < I_UKV) { const int kb = r / 64, nb = r % 64;
            transpose_item([=](int n) -> const float* { return w_ukv + n; }, 2048, (bf16_t*)(ws + WS_WUKV), 256, kb * 64, nb * 32, scr, lane); continue; }
        r -= I_UKV;
        { const int kb = r / 32, nb = r % 32;
            transpose_item([=](int n) -> const float* { return w_out + n; }, 1024, (bf16_t*)(ws + WS_WOUT), 1024, kb * 64, nb * 32, scr, lane); }
    }
}
__device__ __forceinline__ void conv_experts(const Frame& F, const float* w_gate, const float* w_up, const float* w_down, unsigned char* ws) {
    const int tid = opaque_tid(), lane = tid & 63; (void)tid; (void)lane;
    LAS float* scr = (LAS float*)(F.lds + F.wave * 16384);
    for (int it = F.gw; it < NE * 3072; it += F.NGW) {
        const int e = it / 3072; int r = it % 3072;
        if (r < 2048) { const int kb = r / 128, nb = r % 128;
            const float* wg = w_gate + (size_t)e * DM * DFF; const float* wu = w_up + (size_t)e * DM * DFF;
            const long du = (const char*)wu - (const char*)wg;
            transpose_item([=](int n) -> const float* { const int grp = n >> 3, q = n & 7; return (const float*)((const char*)wg + (q < 4 ? 0L : du)) + 4 * grp + (q & 3); }, DFF,
                           (bf16_t*)(ws + WS_WGU) + (size_t)e * 4096 * 1024, 1024, kb * 64, nb * 32, scr, lane); continue; }
        r -= 2048;
        { const int kb = r / 32, nb = r % 32; const float* wd = w_down + (size_t)e * DFF * DM;
            transpose_item([=](int n) -> const float* { return wd + n; }, DM, (bf16_t*)(ws + WS_WD) + (size_t)e * 1024 * 2048, 2048, kb * 64, nb * 32, scr, lane); }
    }
}
__device__ __forceinline__ void norm_mod_row(const float* xrow, const float* g, const float* sh, const float* sc, int lane, f32x4 (&v)[4]) {
    float s = 0.f;
#pragma unroll
    for (int j = 0; j < 4; ++j) { v[j] = *(const f32x4*)(xrow + 4 * lane + 256 * j); s += (v[j][0] * v[j][0] + v[j][1] * v[j][1]) + (v[j][2] * v[j][2] + v[j][3] * v[j][3]); }
    const float rstd = 1.0f / sqrtf(wave_sum(s) * (1.f / DM) + NORM_EPS);
#pragma unroll
    for (int j = 0; j < 4; ++j) { const int c = 4 * lane + 256 * j; const f32x4 gg = *(const f32x4*)(g + c), s1 = *(const f32x4*)(sc + c), s0 = *(const f32x4*)(sh + c);
        v[j] = (v[j] * rstd * gg) * (s1 + 1.0f) + s0; }
}
__device__ __forceinline__ void store_row_bf16(bf16_t* orow, int lane, const f32x4 (&v)[4]) {
#pragma unroll
    for (int j = 0; j < 4; ++j) { u32x2 o; o.x = cvt_pk_bf16(v[j][0], v[j][1]); o.y = cvt_pk_bf16(v[j][2], v[j][3]); *(u32x2*)(orow + 4 * lane + 256 * j) = o; }
}
__device__ __forceinline__ void p1_h(const Frame& F, const float* x, const float* g, const float* mod, bf16_t* H) {
    const int tid = opaque_tid(), lane = tid & 63; (void)tid; (void)lane;
    for (int t = F.gw; t < NTOK; t += F.NGW) { const int b = t / SEQ; f32x4 v[4];
        norm_mod_row(x + (size_t)t * DM, g, mod + b * 6144 + 0, mod + b * 6144 + 1024, lane, v);
        store_row_bf16(H + (size_t)t * DM, lane, v); }
}
__device__ __forceinline__ void lb_latent(const Frame& F, const bf16_t* P, const float* gq, const float* gkv, const float* cs, bf16_t* CQN, bf16_t* CKVN, bf16_t* KB) {
    const int tid = opaque_tid(), lane = tid & 63; (void)tid; (void)lane;
    for (int t = F.gw; t < SEQ; t += F.NGW) {
        const bf16_t* pr = P + (size_t)t * NP;
        float q[8], s = 0.f;
        if (lane < 48) { const u32x4 w = *(const u32x4*)(pr + C_CQ + 8 * lane);
            q[0] = bflo(w.x); q[1] = bfhi(w.x); q[2] = bflo(w.y); q[3] = bfhi(w.y); q[4] = bflo(w.z); q[5] = bfhi(w.z); q[6] = bflo(w.w); q[7] = bfhi(w.w);
#pragma unroll
            for (int e = 0; e < 8; ++e) s += q[e] * q[e]; }
        const float rq = 1.0f / sqrtf(wave_sum(s) * (1.f / 384.f) + NORM_EPS);
        if (lane < 48) { const f32x4 g0 = *(const f32x4*)(gq + 8 * lane), g1 = *(const f32x4*)(gq + 8 * lane + 4);
            u32x4 o; o.x = cvt_pk_bf16(q[0] * rq * g0[0], q[1] * rq * g0[1]); o.y = cvt_pk_bf16(q[2] * rq * g0[2], q[3] * rq * g0[3]);
            o.z = cvt_pk_bf16(q[4] * rq * g1[0], q[5] * rq * g1[1]); o.w = cvt_pk_bf16(q[6] * rq * g1[2], q[7] * rq * g1[3]);
            *(u32x4*)(CQN + (size_t)t * 384 + 8 * lane) = o; }
        float s2 = 0.f;
        if (lane < 32) { const u32x4 w = *(const u32x4*)(pr + C_CKV + 8 * lane);
            q[0] = bflo(w.x); q[1] = bfhi(w.x); q[2] = bflo(w.y); q[3] = bfhi(w.y); q[4] = bflo(w.z); q[5] = bfhi(w.z); q[6] = bflo(w.w); q[7] = bfhi(w.w);
#pragma unroll
            for (int e = 0; e < 8; ++e) s2 += q[e] * q[e]; }
        const float rk = 1.0f / sqrtf(wave_sum(s2) * (1.f / 256.f) + NORM_EPS);
        if (lane < 32) { const f32x4 g0 = *(const f32x4*)(gkv + 8 * lane), g1 = *(const f32x4*)(gkv + 8 * lane + 4);
            u32x4 o; o.x = cvt_pk_bf16(q[0] * rk * g0[0], q[1] * rk * g0[1]); o.y = cvt_pk_bf16(q[2] * rk * g0[2], q[3] * rk * g0[3]);
            o.z = cvt_pk_bf16(q[4] * rk * g1[0], q[5] * rk * g1[1]); o.w = cvt_pk_bf16(q[6] * rk * g1[2], q[7] * rk * g1[3]);
            *(u32x4*)(CKVN + (size_t)t * 256 + 8 * lane) = o;
            const float x1 = bf2f(pr[C_KPE + lane]), x2 = bf2f(pr[C_KPE + 32 + lane]); const f32x2 c = *(const f32x2*)(cs + ((size_t)t * 32 + lane) * 2);
            const unsigned pk = cvt_pk_bf16(x1 * c.x - x2 * c.y, x1 * c.y + x2 * c.x);
#pragma unroll
            for (int h = 0; h < 8; ++h) *(unsigned*)(KB + ((size_t)h * SEQ + t) * 192 + 128 + 2 * lane) = pk; }
    }
}
__device__ __forceinline__ void lb_combine(const Frame& F, const bf16_t* P, const bf16_t* OA, const bf16_t* OG, const float* LSE, bf16_t* U) {
    const int tid = opaque_tid(), lane = tid & 63; (void)tid; (void)lane;
    for (int t = F.gw; t < SEQ; t += F.NGW) {
#pragma unroll
        for (int j = 0; j < 2; ++j) { const int c0 = 8 * lane + 512 * j, hd = c0 >> 7;
            const float l0 = LSE[((size_t)0 * SEQ + t) * 8 + hd], l1 = LSE[((size_t)1 * SEQ + t) * 8 + hd], l2 = LSE[((size_t)2 * SEQ + t) * 8 + hd];
            const float mx = fmaxf(l0, fmaxf(l1, l2)); float w0 = __builtin_amdgcn_exp2f(l0 - mx), w1 = __builtin_amdgcn_exp2f(l1 - mx), w2 = __builtin_amdgcn_exp2f(l2 - mx);
            const float inv = 1.0f / (w0 + w1 + w2); w0 *= inv; w1 *= inv; w2 *= inv;
            const u32x4 oa = *(const u32x4*)(OA + (size_t)t * DM + c0), g0 = *(const u32x4*)(OG + ((size_t)0 * SEQ + t) * DM + c0), g1 = *(const u32x4*)(OG + ((size_t)1 * SEQ + t) * DM + c0),
                        g2 = *(const u32x4*)(OG + ((size_t)2 * SEQ + t) * DM + c0), ga = *(const u32x4*)(P + (size_t)t * NP + C_GATE + c0), gb = *(const u32x4*)(P + (size_t)t * NP + C_GATE + 1024 + c0);
            u32x4 o;
#pragma unroll
            for (int e = 0; e < 4; ++e) {
                const float ob_lo = w0 * bflo(g0[e]) + w1 * bflo(g1[e]) + w2 * bflo(g2[e]), ob_hi = w0 * bfhi(g0[e]) + w1 * bfhi(g1[e]) + w2 * bfhi(g2[e]);
                const float u_lo = fast_sigmoid(bflo(ga[e])) * bflo(oa[e]) + fast_sigmoid(bflo(gb[e])) * ob_lo;
                const float u_hi = fast_sigmoid(bfhi(ga[e])) * bfhi(oa[e]) + fast_sigmoid(bfhi(gb[e])) * ob_hi;
                o[e] = cvt_pk_bf16(u_lo, u_hi); }
            *(u32x4*)(U + (size_t)t * DM + c0) = o; }
    }
}
__device__ __forceinline__ void pg_h2_router(const Frame& F, const float* x1, const float* g, const float* mod, const float* w_router, bf16_t* H2, float* AFFT) {
    const int tid = opaque_tid(), lane = tid & 63; (void)tid; (void)lane;
    LAS float* wr = (LAS float*)F.lds;
    for (int i = tid; i < 1024 * 16 / 4; i += 512) ((LAS f32x4*)wr)[i] = ((const f32x4*)w_router)[i];
    __syncthreads();
    for (int t = F.gw; t < NTOK; t += F.NGW) { const int b = t / SEQ, s = t % SEQ; f32x4 v[4];
        norm_mod_row(x1 + (size_t)t * DM, g, mod + b * 6144 + 3072, mod + b * 6144 + 4096, lane, v);
        store_row_bf16(H2 + (size_t)t * DM, lane, v);
        float lg[16];
#pragma unroll
        for (int e = 0; e < 16; ++e) lg[e] = 0.f;
#pragma unroll
        for (int j = 0; j < 4; ++j)
#pragma unroll
            for (int q = 0; q < 4; ++q) { const LAS f32x4* wp = (const LAS f32x4*)(wr + (4 * lane + 256 * j + q) * 16); const float hv = v[j][q];
#pragma unroll
                for (int e4 = 0; e4 < 4; ++e4) { const f32x4 w = wp[e4]; lg[4 * e4 + 0] += hv * w[0]; lg[4 * e4 + 1] += hv * w[1]; lg[4 * e4 + 2] += hv * w[2]; lg[4 * e4 + 3] += hv * w[3]; } }
        float mx = -1e30f;
#pragma unroll
        for (int e = 0; e < 16; ++e) { lg[e] = wave_sum(lg[e]); mx = fmaxf(mx, lg[e]); }
        float sum = 0.f;
#pragma unroll
        for (int e = 0; e < 16; ++e) { lg[e] = __expf(lg[e] - mx); sum += lg[e]; }
        const float inv = 1.0f / sum; float mine = 0.f;
#pragma unroll
        for (int e = 0; e < 16; ++e) mine = (lane == e) ? lg[e] * inv : mine;
        if (lane < 16) AFFT[((size_t)b * NE + lane) * SEQ + s] = mine;
    }
    __syncthreads();
}
__device__ __forceinline__ void ph_topk(const Frame& F, const float* AFFT, int* TOPI, float* TOPG, int* SLOT) {
    const int tid = opaque_tid(), lane = tid & 63; (void)tid; (void)lane;
    LAS unsigned* hist = (LAS unsigned*)F.lds;
    LAS unsigned* sel = hist + 256;
    LAS unsigned* wtot = hist + 320;
    for (int p = blockIdx.x; p < NB * NE; p += F.G) {
        const float* src = AFFT + (size_t)p * SEQ + 16 * tid;
        unsigned key[16];
#pragma unroll
        for (int j = 0; j < 4; ++j) { const u32x4 w = *(const u32x4*)(src + 4 * j); key[4 * j] = w.x; key[4 * j + 1] = w.y; key[4 * j + 2] = w.z; key[4 * j + 3] = w.w; }
        unsigned prefix = 0u, mask = 0u, kk = CAP;
#pragma unroll 1
        for (int pass = 0; pass < 4; ++pass) { const int shift = 24 - 8 * pass;
            if (tid < 256) hist[tid] = 0u;
            __syncthreads();
#pragma unroll
            for (int i = 0; i < 16; ++i) if ((key[i] & mask) == prefix) __hip_atomic_fetch_add(&hist[(key[i] >> shift) & 255u], 1u, __ATOMIC_RELAXED, __HIP_MEMORY_SCOPE_WORKGROUP);
            __syncthreads();
            if (F.wave == 0) {
                const unsigned c0 = hist[4 * lane], c1 = hist[4 * lane + 1], c2 = hist[4 * lane + 2], c3 = hist[4 * lane + 3];
                const unsigned tot = c0 + c1 + c2 + c3;
                unsigned incl = tot;
#pragma unroll
                for (int o = 1; o < 64; o <<= 1) { const unsigned v = __shfl_down(incl, o); if (lane + o < 64) incl += v; }
                const unsigned above = incl - tot;
                if (above < kk && kk <= incl) { unsigned cum = above, dg, nk;
                    if (cum + c3 >= kk) { dg = 3; nk = kk - cum; } else { cum += c3;
                    if (cum + c2 >= kk) { dg = 2; nk = kk - cum; } else { cum += c2;
                    if (cum + c1 >= kk) { dg = 1; nk = kk - cum; } else { cum += c1; dg = 0; nk = kk - cum; } } }
                    sel[0] = 4 * lane + dg; sel[1] = nk; }
            }
            __syncthreads();
            prefix |= sel[0] << shift; mask |= 255u << shift; kk = sel[1];
            __syncthreads();
        }
        const unsigned thr = prefix, need = kk;
        unsigned ngt = 0, neq = 0;
#pragma unroll
        for (int i = 0; i < 16; ++i) { ngt += key[i] > thr ? 1u : 0u; neq += key[i] == thr ? 1u : 0u; }
        unsigned pk = ngt | (neq << 16), inc = pk;
#pragma unroll
        for (int o = 1; o < 64; o <<= 1) { const unsigned v = __shfl_up(inc, o); if (lane >= o) inc += v; }
        if (lane == 63) wtot[F.wave] = inc;
        __syncthreads();
        unsigned base = 0;
        for (int w = 0; w < F.wave; ++w) base += wtot[w];
        const unsigned excl = base + inc - pk; unsigned g_before = excl & 0xffffu, e_before = excl >> 16;
        const unsigned tot_gt = CAP - need;
#pragma unroll
        for (int i = 0; i < 16; ++i) { const int s = 16 * tid + i; int slot = -1;
            if (key[i] > thr) { slot = (int)g_before; ++g_before; }
            else if (key[i] == thr) { if (e_before < need) slot = (int)(tot_gt + e_before); ++e_before; }
            SLOT[(size_t)p * SEQ + s] = slot;
            if (slot >= 0) { TOPI[p * CAP + slot] = s; TOPG[p * CAP + slot] = __uint_as_float(key[i]); } }
        __syncthreads();
    }
}
__device__ __forceinline__ void p_final(const Frame& F, int b, float* out, const float* mod, const int* SLOT, const bf16_t* Y, const float* gfin) {
    const int tid = opaque_tid(), lane = tid & 63; (void)tid; (void)lane;
    for (int s = F.gw; s < SEQ; s += F.NGW) { float* row = out + ((size_t)b * SEQ + s) * DM;
        int sl = -1; if (lane < NE) sl = SLOT[((size_t)b * NE + lane) * SEQ + s];
        unsigned long long m = __ballot(sl >= 0);
        f32x4 acc[4];
#pragma unroll
        for (int j = 0; j < 4; ++j) acc[j] = (f32x4){0.f, 0.f, 0.f, 0.f};
        while (m) { const int e = __builtin_ctzll(m); m &= m - 1; const int slot = __builtin_amdgcn_readlane(sl, e);
            const bf16_t* yr = Y + ((size_t)e * CAP + slot) * DM;
#pragma unroll
            for (int j = 0; j < 4; ++j) { const u32x2 w = *(const u32x2*)(yr + 4 * lane + 256 * j); acc[j][0] += bflo(w.x); acc[j][1] += bfhi(w.x); acc[j][2] += bflo(w.y); acc[j][3] += bfhi(w.y); } }
        f32x4 v[4]; float ss = 0.f;
#pragma unroll
        for (int j = 0; j < 4; ++j) { const int c = 4 * lane + 256 * j; const f32x4 gt = *(const f32x4*)(mod + b * 6144 + 5120 + c);
            v[j] = *(const f32x4*)(row + c) + gt * acc[j]; ss += (v[j][0] * v[j][0] + v[j][1] * v[j][1]) + (v[j][2] * v[j][2] + v[j][3] * v[j][3]); }
        const float rstd = 1.0f / sqrtf(wave_sum(ss) * (1.f / DM) + NORM_EPS);
#pragma unroll
        for (int j = 0; j < 4; ++j) { const int c = 4 * lane + 256 * j; *(f32x4*)(row + c) = v[j] * rstd * *(const f32x4*)(gfin + c); }
    }
}

__global__ void __launch_bounds__(NWAVES * 64, 2) fwd_kernel(Args args) {
    extern __shared__ __attribute__((aligned(16))) unsigned char lds_raw[];
    Frame F;
    F.lds = (LAS unsigned char*)lds_raw;
    F.tid = threadIdx.x; F.lane = F.tid & 63; F.wave = __builtin_amdgcn_readfirstlane(F.tid >> 6);
    F.G = gridDim.x; { const int bx = blockIdx.x; F.vcu = (F.G % 8 == 0) ? (bx % 8) * (F.G / 8) + bx / 8 : bx; }
    F.gw = F.vcu * NWAVES + F.wave; F.NGW = F.G * NWAVES;
    unsigned char* ws = args.ws;
    volatile LAS unsigned* MISC = (volatile LAS unsigned*)(F.lds + MISC_OFF);
    for (int u = F.tid; u < (LDS_BYTES - RING_BYTES) / 4; u += NWAVES * 64) ((LAS unsigned*)(F.lds + RING_BYTES))[u] = 0u;
    __syncthreads();
    unsigned* ctl = (unsigned*)(ws + WS_CTL);
    XcdBarrier bar = xcd_barrier_post(ctl + CW_BAR, MISC + 8);

#define IN_F(k) ((const float*)args.in[k])
#define in_x IN_F(0)
#define cin IN_F(1)
#define positions ((const int*)args.in[2])
#define w_ada IN_F(3)
#define b_ada IN_F(4)
#define g_mix IN_F(5)
#define w_in IN_F(6)
#define g_q IN_F(7)
#define g_kv IN_F(8)
#define w_uq IN_F(9)
#define w_ukv IN_F(10)
#define rel_bias IN_F(11)
#define w_out IN_F(12)
#define g_ffn IN_F(13)
#define w_router IN_F(14)
#define w_gate IN_F(15)
#define w_up IN_F(16)
#define w_down IN_F(17)
#define g_final IN_F(18)
#define t_out (args.out)
#define WSP(T, off) ((T*)(args.ws + (off)))
#define MOD WSP(float, WS_MOD)
#define CS WSP(float, WS_CS)
#define WIN WSP(bf16_t, WS_WIN)
#define WUQ WSP(bf16_t, WS_WUQ)
#define WUKV WSP(bf16_t, WS_WUKV)
#define WOUT WSP(bf16_t, WS_WOUT)
#define t_H WSP(bf16_t, WS_H)
#define t_U WSP(bf16_t, WS_U)
#define t_P WSP(bf16_t, WS_P)
#define CQN WSP(bf16_t, WS_CQN)
#define CKVN WSP(bf16_t, WS_CKVN)
#define QB WSP(bf16_t, WS_QB)
#define KB WSP(bf16_t, WS_KB)
#define VB WSP(bf16_t, WS_VB)
#define OA WSP(bf16_t, WS_OA)
#define OG WSP(bf16_t, WS_OG)
#define LSE WSP(float, WS_LSE)
#define WGU WSP(bf16_t, WS_WGU)
#define WD WSP(bf16_t, WS_WD)
#define HID WSP(bf16_t, WS_HID)
#define t_Y WSP(bf16_t, WS_Y)
#define AFFT WSP(float, WS_AFFT)
#define TOPI WSP(int, WS_TOPI)
#define TOPG WSP(float, WS_TOPG)
#define SLOT WSP(int, WS_SLOT)

#ifndef PH_MASK
#define PH_MASK 0xFFFFFFFFu
#endif
#define PH_ON(k) constexpr (((PH_MASK) >> (k)) & 1u)
    int step = 0; const int lo = args.st_lo, hi = args.st_hi;
#define STEP_BEGIN if (step >= lo && step < hi) {
#define STEP_END if (step + 1 < hi) xcd_barrier(bar); } ++step;

    STEP_BEGIN
        if PH_ON(0) { p0_mod(F, cin, w_ada, b_ada, MOD);
        p0_cs(F, positions, CS);
        p0_weights(F, w_in, w_uq, w_ukv, w_out, ws); }
    STEP_END
    STEP_BEGIN
        if PH_ON(1) p1_h(F, in_x, g_mix, MOD, t_H);
    STEP_END
    for (int b = 0; b < NB; ++b) {
        STEP_BEGIN
            pg8::Gemm g{t_H + (size_t)b * SEQ * DM, WIN, DM, DM, DM, 0, 0, nullptr, 0}; pg8::StaticOrder S; S.init(SEQ, NP, F.G, (int)blockIdx.x);
            pg8::EpiBf16 E{t_P, NP};
            if PH_ON(2) pg8::gemm_phase<pg8::EpiBf16, pg8::StaticOrder, false>(F.lds, g, S, E);
        STEP_END
        STEP_BEGIN
            if PH_ON(3) lb_latent(F, t_P, g_q, g_kv, CS + (size_t)b * SEQ * 64, CQN, CKVN, KB);
        STEP_END
        STEP_BEGIN
            { pg8::Gemm g{CQN, WUQ, 384, 384, 384, 0, 0, nullptr, 0}; pg8::StaticOrder S; S.init(SEQ, 1536, F.G, (int)blockIdx.x);
              pg8::EpiQ E{QB, CS + (size_t)b * SEQ * 64};
              if PH_ON(4) pg8::gemm_phase<pg8::EpiQ, pg8::StaticOrder, false>(F.lds, g, S, E); }
            __syncthreads();
            { pg8::Gemm g{CKVN, WUKV, 256, 256, 256, 0, 0, nullptr, 0}; pg8::StaticOrder S; S.init(SEQ, 2048, F.G, (int)blockIdx.x);
              pg8::EpiKV E{KB, VB};
              if PH_ON(5) pg8::gemm_phase<pg8::EpiKV, pg8::StaticOrder, false>(F.lds, g, S, E); }
        STEP_END
        STEP_BEGIN
            for (int u = blockIdx.x; u < 256; u += F.G) { const int hd = u & 7, qb = u >> 3;
                att::Unit a{};
                a.Q = QB + ((size_t)hd * SEQ + 256 * qb) * 192; a.qs = 192; a.K = KB + (size_t)hd * SEQ * 192; a.ks = 192; a.V = VB + (size_t)hd * SEQ * 128; a.vs = 128;
                a.O = OA + (size_t)(256 * qb) * DM + hd * 128; a.os = DM; a.nt = SEQ / 64;
                if PH_ON(6) att::attn_unit<false>(a, (LAS char*)F.lds); }
            for (int u = blockIdx.x; u < 768; u += F.G) { const int grp = u >> 8, w = u & 255, hd = w & 7, rest = w >> 3, d = grp == 0 ? 1 : (grp == 1 ? 4 : 16), cl = rest % d, qb = rest / d;
                att::Unit a{};
                const size_t tok0 = (size_t)256 * qb * d + cl; const bf16_t* base = t_P + C_DIL + grp * 3072 + hd * 128;
                a.Q = base + tok0 * NP; a.qs = d * NP; a.K = base + 1024 + (size_t)cl * NP; a.ks = d * NP; a.V = base + 2048 + (size_t)cl * NP; a.vs = d * NP;
                a.O = OG + ((size_t)grp * SEQ + tok0) * DM + hd * 128; a.os = d * DM; a.nt = 6;
                a.kt0 = 4 * qb - 1; a.ktn = (SEQ / d) / 64; a.l0 = 256 * qb; a.pos = positions + (size_t)b * SEQ + cl; a.ps = d;
                a.lse = LSE + ((size_t)grp * SEQ + tok0) * 8 + hd; a.ls = d * 8; a.bias = rel_bias + grp * 8 + hd;
                if PH_ON(7) att::attn_unit<true>(a, (LAS char*)F.lds); }
        STEP_END
        STEP_BEGIN
            if PH_ON(8) lb_combine(F, t_P, OA, OG, LSE, t_U + (size_t)b * SEQ * DM);
        STEP_END
    }
    STEP_BEGIN
        { pg8::Gemm g{t_U, WOUT, DM, DM, DM, 0, 0, nullptr, 0}; pg8::StaticOrder S; S.init(NTOK, DM, F.G, (int)blockIdx.x);
          pg8::EpiRes E{in_x, t_out, MOD};
          if PH_ON(9) pg8::gemm_phase<pg8::EpiRes, pg8::StaticOrder, false>(F.lds, g, S, E); }
        __syncthreads();
        if PH_ON(10) conv_experts(F, w_gate, w_up, w_down, ws);
    STEP_END
    STEP_BEGIN
        if PH_ON(11) pg_h2_router(F, t_out, g_ffn, MOD, w_router, t_H, AFFT);
    STEP_END
    STEP_BEGIN
        if PH_ON(12) ph_topk(F, AFFT, TOPI, TOPG, SLOT);
    STEP_END
    for (int b = 0; b < NB; ++b) {
        STEP_BEGIN
            { pg8::Gemm g{t_H + (size_t)b * SEQ * DM, WGU, DM, DM, DM, 0, (long)4096 * 1024, TOPI + b * NE * CAP, CAP}; pg8::GroupOrder S; S.init(4, 16, NE, F.G, (int)blockIdx.x);
              pg8::EpiSwiGLU E{HID};
              if PH_ON(13) pg8::gemm_phase<pg8::EpiSwiGLU, pg8::GroupOrder, true>(F.lds, g, S, E); }
            if PH_ON(15) { if (b > 0) p_final(F, b - 1, t_out, MOD, SLOT, t_Y, g_final); }
        STEP_END
        STEP_BEGIN
            { pg8::Gemm g{HID, WD, DFF, DFF, DFF, (long)CAP * DFF, (long)DM * DFF, nullptr, 0}; pg8::GroupOrder S; S.init(4, 4, NE, F.G, (int)blockIdx.x);
              pg8::EpiDown E{t_Y, TOPG + b * NE * CAP};
              if PH_ON(14) pg8::gemm_phase<pg8::EpiDown, pg8::GroupOrder, false>(F.lds, g, S, E); }
        STEP_END
    }
    STEP_BEGIN
        if PH_ON(15) p_final(F, NB - 1, t_out, MOD, SLOT, t_Y, g_final);
    STEP_END
#undef STEP_BEGIN
#undef STEP_END
}
#undef IN_F
#undef in_x
#undef cin
#undef positions
#undef w_ada
#undef b_ada
#undef g_mix
#undef w_in
#undef g_q
#undef g_kv
#undef w_uq
#undef w_ukv
#undef rel_bias
#undef w_out
#undef g_ffn
#undef w_router
#undef w_gate
#undef w_up
#undef w_down
#undef g_final
#undef t_out
#undef WSP
#undef MOD
#undef CS
#undef WIN
#undef WUQ
#undef WUKV
#undef WOUT
#undef t_H
#undef t_U
#undef t_P
#undef CQN
#undef CKVN
#undef QB
#undef KB
#undef VB
#undef OA
#undef OG
#undef LSE
#undef WGU
#undef WD
#undef HID
#undef t_Y
#undef AFFT
#undef TOPI
#undef TOPG
#undef SLOT
constexpr int N_STEPS = 2 + NB * 5 + 3 + NB * 2 + 1;

#ifndef MK_PER_STEP
#define MK_PER_STEP 0
#endif
extern "C" void kernel_launch(void* const* d_in, const int* in_sizes, int n_in, void* d_out, int out_size, void* d_ws, size_t ws_size, hipStream_t stream) {
    static int grid = 0;
    if (grid == 0) {
        if (n_in != 19 || out_size != NTOK * DM || ws_size < WS_END) { fprintf(stderr, "kernel_launch: unexpected shapes (n_in %d out %d ws %zu need %zu)\n", n_in, out_size, ws_size, (size_t)WS_END); grid = -1; return; }
        int dev = 0, cus = 0;
        if (hipGetDevice(&dev) != hipSuccess || hipDeviceGetAttribute(&cus, hipDeviceAttributeMultiprocessorCount, dev) != hipSuccess) { grid = -1; return; }
        if (hipFuncSetAttribute((const void*)fwd_kernel, hipFuncAttributeMaxDynamicSharedMemorySize, LDS_BYTES) != hipSuccess) { grid = -1; return; }
        int per_cu = 0;
        if (hipOccupancyMaxActiveBlocksPerMultiprocessor(&per_cu, (const void*)fwd_kernel, NWAVES * 64, LDS_BYTES) != hipSuccess || per_cu < 1) { fprintf(stderr, "kernel_launch: occupancy query says %d\n", per_cu); }
        (void)hipGetLastError();
        grid = cus;
    }
    if (grid < 0) return;
    if (hipMemsetAsync((char*)d_ws + WS_CTL, 0, CTL_ZERO_BYTES, stream) != hipSuccess) return;
    Args a{};
    for (int i = 0; i < 19; ++i) a.in[i] = d_in[i];
    a.out = (float*)d_out; a.ws = (unsigned char*)d_ws;
#if MK_PER_STEP
    for (int s = 0; s < N_STEPS; ++s) { a.st_lo = s; a.st_hi = s + 1; hipLaunchKernelGGL(fwd_kernel, dim3(grid), dim3(NWAVES * 64), LDS_BYTES, stream, a); }
#else
    a.st_lo = 0; a.st_hi = N_STEPS;
    hipLaunchKernelGGL(fwd_kernel, dim3(grid), dim3(NWAVES * 64), LDS_BYTES, stream, a);
#endif
    const hipError_t le = hipPeekAtLastError();
    if (le != hipSuccess) fprintf(stderr, "kernel_launch: launch failed: %s\n", hipGetErrorName(le));
}
```

```cpp
#include <hip/hip_runtime.h>
#include <cstdio>
#include <cstdint>

#define LAS __attribute__((address_space(3)))
#define GAS __attribute__((address_space(1)))
typedef unsigned short bf16_t;
typedef short bf16x8 __attribute__((ext_vector_type(8)));
typedef short s16x4 __attribute__((ext_vector_type(4)));
typedef float f32x2 __attribute__((ext_vector_type(2)));
typedef float f32x4 __attribute__((ext_vector_type(4)));
typedef float f32x16 __attribute__((ext_vector_type(16)));
typedef unsigned u32x2 __attribute__((ext_vector_type(2)));
typedef unsigned u32x4 __attribute__((ext_vector_type(4)));
typedef int i32x4 __attribute__((ext_vector_type(4)));

constexpr int NB = 4, SEQ = 8192, DM = 1024, NTOK = NB * SEQ;
constexpr int NP = 12032;
constexpr int C_CQ = 0, C_CKV = 384, C_KPE = 640, C_DIL = 704, C_GATE = 9920, D_IN = 11968;
constexpr int NE = 16, CAP = 1024, DFF = 2048;
constexpr float NORM_EPS = 1e-6f;
constexpr float LOG2E = 1.4426950408889634f;

constexpr size_t MiB = 1u << 20;
constexpr size_t WS_CTL = 0, CTL_ZERO_BYTES = 1 * MiB;
constexpr size_t WS_MOD = 1 * MiB;
constexpr size_t WS_CS = 2 * MiB;
constexpr size_t WS_WIN = 10 * MiB;
constexpr size_t WS_WUQ = 34 * MiB;
constexpr size_t WS_WUKV = 36 * MiB;
constexpr size_t WS_WOUT = 37 * MiB;
constexpr size_t WS_H = 40 * MiB;
constexpr size_t WS_U = 104 * MiB;
constexpr size_t WS_R = 168 * MiB;
constexpr size_t WS_P = WS_R;
constexpr size_t WS_CQN = WS_R + 188 * MiB;
constexpr size_t WS_CKVN = WS_R + 194 * MiB;
constexpr size_t WS_QB = WS_R + 198 * MiB;
constexpr size_t WS_KB = WS_R + 222 * MiB;
constexpr size_t WS_VB = WS_R + 246 * MiB;
constexpr size_t WS_OA = WS_R + 262 * MiB;
constexpr size_t WS_OG = WS_R + 278 * MiB;
constexpr size_t WS_LSE = WS_R + 326 * MiB;
constexpr size_t WS_WGU = WS_R;
constexpr size_t WS_WD = WS_R + 128 * MiB;
constexpr size_t WS_HID = WS_R + 192 * MiB;
constexpr size_t WS_Y = WS_R + 256 * MiB;
constexpr size_t WS_AFFT = WS_R + 288 * MiB;
constexpr size_t WS_TOPI = WS_R + 290 * MiB;
constexpr size_t WS_TOPG = WS_R + 291 * MiB;
constexpr size_t WS_SLOT = WS_R + 292 * MiB;
constexpr size_t WS_END = WS_R + 327 * MiB;
constexpr int CW_TMO = 0, CW_DBG = 16, CW_BAR = 4096;

constexpr int RING_BYTES = 131072;
constexpr int MISC_OFF = RING_BYTES + 320;
constexpr int LDS_BYTES = 147456;
constexpr int NWAVES = 8;

#define RLX_AGENT __ATOMIC_RELAXED, __HIP_MEMORY_SCOPE_AGENT
#define LDS_WAIT() asm volatile("s_waitcnt lgkmcnt(0)" ::: "memory")
#define VM_WAIT() asm volatile("s_waitcnt vmcnt(0)" ::: "memory")

__device__ __forceinline__ unsigned cvt_pk_bf16(float lo, float hi) { unsigned r; asm volatile("v_cvt_pk_bf16_f32 %0, %1, %2" : "=v"(r) : "v"(lo), "v"(hi)); return r; }
__device__ __forceinline__ float bf2f(unsigned short v) { return __uint_as_float(((unsigned)v) << 16); }
__device__ __forceinline__ float bflo(unsigned w) { return __uint_as_float(w << 16); }
__device__ __forceinline__ float bfhi(unsigned w) { return __uint_as_float(w & 0xffff0000u); }
__device__ __forceinline__ float wave_sum(float v) {
#pragma unroll
    for (int o = 1; o < 64; o <<= 1) v += __shfl_xor(v, o);
    return v;
}
__device__ __forceinline__ float fast_sigmoid(float x) { return __builtin_amdgcn_rcpf(1.f + __builtin_amdgcn_exp2f(-x * LOG2E)); }
__device__ __forceinline__ int opaque_tid() { int t = (int)threadIdx.x; asm volatile("" : "+v"(t)); return t; }
struct Frame {
    LAS unsigned char* lds;
    int tid, lane, wave, vcu, G, gw, NGW;
};
struct Args { const void* in[19]; float* out; unsigned char* ws; int st_lo, st_hi; };

#define XB_TMO      128
#define XB_XCNT(j)  (256  + 64 * (j))
#define XB_XSUB(j)  (1280 + 64 * (j))
#define XB_XGEN(j)  (2304 + 64 * (j))
#define XB_TOP      3328
#define XB_TOPGEN   3392
#define XCD_BAR_WORDS 3456
#define XB_SPIN_CAP (1u << 18)

__device__ __forceinline__ unsigned xb_ld(unsigned* p)              { return __hip_atomic_load(p, __ATOMIC_RELAXED, __HIP_MEMORY_SCOPE_AGENT); }
__device__ __forceinline__ unsigned xb_add(unsigned* p, unsigned v) { return __hip_atomic_fetch_add(p, v, __ATOMIC_RELAXED, __HIP_MEMORY_SCOPE_AGENT); }
__device__ __forceinline__ unsigned xb_xcc_id() { return (unsigned)__builtin_amdgcn_s_getreg((3 << 11) | 20) & 0xFu; }
#define XB_SPIN(cond, bar) do { unsigned _sp = 0; while (cond) { __builtin_amdgcn_s_sleep(1); \
    if ((++_sp & 255u) == 0u) { if (xb_ld(&(bar)[XB_TMO])) break; if (_sp > XB_SPIN_CAP) { atomicAdd(&(bar)[XB_TMO], 1u); break; } } } } while (0)

struct XcdBarrier {
    unsigned* bar; unsigned x;
    volatile LAS unsigned* st;
};

__device__ __forceinline__ XcdBarrier xcd_barrier_post(unsigned* bar, volatile LAS unsigned* st) {
    XcdBarrier b; b.bar = bar; b.x = xb_xcc_id(); b.st = st;
    if (threadIdx.x == 0) (void)xb_add(&bar[XB_XCNT(b.x)], 1u);
    return b;
}
__device__ __forceinline__ void xcd_barrier_complete(unsigned* bar, unsigned x, unsigned& nloc, unsigned& nx) {
    const unsigned G = gridDim.x * gridDim.y * gridDim.z;
    unsigned sum, cnt, mine, sp = 0u;
    for (;;) {
        sum = 0u; cnt = 0u; mine = 0u;
#pragma unroll
        for (unsigned j = 0; j < 16; ++j) { const unsigned c = xb_ld(&bar[XB_XCNT(j)]); sum += c; cnt += (c > 0u) ? 1u : 0u; mine = (j == x) ? c : mine; }
        if (sum == G) break;
        __builtin_amdgcn_s_sleep(1);
        if ((++sp & 255u) == 0u) { if (xb_ld(&bar[XB_TMO])) break; if (sp > XB_SPIN_CAP) { atomicAdd(&bar[XB_TMO], 1u); break; } }
    }
    nloc = mine > 0u ? mine : 1u; nx = cnt > 0u ? cnt : 1u;
}

__device__ __forceinline__ void xcd_barrier(const XcdBarrier& b) {
    asm volatile("s_waitcnt vmcnt(0)" ::: "memory");
    __syncthreads();
    if (threadIdx.x == 0) {
        unsigned* bar = b.bar;
        __builtin_amdgcn_s_waitcnt(0);
        unsigned nloc = b.st[0], nx = b.st[1];
        if (nloc == 0u) { xcd_barrier_complete(bar, b.x, nloc, nx); b.st[0] = nloc; b.st[1] = nx; }
        const unsigned old = xb_add(&bar[XB_XSUB(b.x)], 1u);
        const unsigned gen = old / nloc;
        if (old + 1u == (gen + 1u) * nloc) {
            __builtin_amdgcn_fence(__ATOMIC_RELEASE, "agent");
            asm volatile("s_waitcnt vmcnt(0)" ::: "memory");
            const unsigned og = xb_add(&bar[XB_TOP], 1u);
            const unsigned tg = og / nx;
            if (og + 1u == (tg + 1u) * nx) xb_add(&bar[XB_TOPGEN], 1u);
            else XB_SPIN(xb_ld(&bar[XB_TOPGEN]) == tg, bar);
            __builtin_amdgcn_fence(__ATOMIC_ACQUIRE, "agent");
            xb_add(&bar[XB_XGEN(b.x)], 1u);
            asm volatile("s_waitcnt vmcnt(0)" ::: "memory");
        } else {
            XB_SPIN(xb_ld(&bar[XB_XGEN(b.x)]) == gen, bar);
            __builtin_amdgcn_fence(__ATOMIC_ACQUIRE, "agent");
            asm volatile("s_waitcnt vmcnt(0)" ::: "memory");
        }
    }
    __syncthreads();
}

namespace pg8 {
constexpr int BM = 256, BK = 64, HALF = 128, HTB = HALF * BK * 2  , STAGE_BYTES = 8 * HTB, NXCD = 8, WGM = 8;

__host__ __device__ __forceinline__ int lds_byte(int r, int c) { const int st = (r >> 4) * 2 + (c >> 5), rr = r & 15, cc = c & 31, ob = rr * 64 + cc * 2; return st * 1024 + (ob ^ (((ob >> 9) & 1) << 5)); }
__host__ __device__ __forceinline__ void stage_rc(int b, int& R, int& C) { const int st = b / 1024, sb = b % 1024, swz = sb ^ (((sb >> 9) & 1) << 5); R = (st >> 1) * 16 + swz / 64; C = (st & 1) * 32 + (swz % 64) / 2; }
__host__ __device__ __forceinline__ int perm32(int rho) { const int n = rho >> 4, i = rho & 15; return 8 * (i >> 2) + 4 * n + (i & 3); }

struct Unit { int pm, pn, g; };
struct Gemm { const bf16_t* A; const bf16_t* Bt; int lda, ldb, K; long a_gs, b_gs; const int* idx; int idx_gs; };

struct StaticOrder {
    int nM, nN, nwg, G, c;
    __device__ __forceinline__ void init(int M, int N, int G_, int c_) { nM = M / BM; nN = N / BM; nwg = nM * nN; G = G_; c = c_; }
    __device__ __forceinline__ bool next(int i, Unit& u) const {
        const long L = (long)i * G + c; if (L >= nwg) return false;
        int wgid = (int)L; { const int q = nwg / NXCD, r = nwg % NXCD, xcd = wgid % NXCD, off = wgid / NXCD; wgid = (xcd < r ? xcd * (q + 1) : r * (q + 1) + (xcd - r) * q) + off; }
        const int nig = WGM * nN, gid = wgid / nig, fm = gid * WGM, gsz = (nM - fm) < WGM ? (nM - fm) : WGM;
        u.pm = fm + ((wgid % nig) % gsz); u.pn = (wgid % nig) / gsz; u.g = 0; return true;
    }
};
struct GroupOrder {
    int nM, nN, nwg, G, v;
    __device__ __forceinline__ void init(int nM_, int nN_, int nG, int G_, int c_) { nM = nM_; nN = nN_; nwg = nM_ * nN_ * nG; G = G_; v = (G_ % 8 == 0) ? (c_ % 8) * (G_ / 8) + c_ / 8 : c_; }
    __device__ __forceinline__ bool next(int i, Unit& u) const {
        const long L = (long)i * G + v; if (L >= nwg) return false;
        const int w = (int)L; u.pm = w % nM; u.pn = (w / nM) % nN; u.g = w / (nM * nN); return true;
    }
};

template <class Epi, class Sched, bool GATHER>
__device__ __forceinline__ void gemm_phase(LAS unsigned char* lds, const Gemm g, const Sched& S, const Epi& E) {
    const int tid = opaque_tid(), wid = __builtin_amdgcn_readfirstlane(tid >> 6), lane = tid & 63, wr = wid >> 2, wc = wid & 3, fr = lane & 15, fq = lane >> 4;
    const int K = g.K, nt = K / BK;
    int Rr[2], Cc[2]; unsigned voffB[2];
#pragma unroll
    for (int i = 0; i < 2; ++i) { int R, C; stage_rc(tid * 16 + i * 8192, R, C); Rr[i] = R; Cc[i] = C; const int Rb = Epi::PERM ? ((R & ~31) + perm32(R & 31)) : R;
        voffB[i] = (unsigned)(Rb * g.ldb + C) * 2u; }
    const size_t kstep = (size_t)(BK * 2);
    const size_t hstepA = (size_t)HALF * g.lda * 2, hstepB = (size_t)HALF * g.ldb * 2;
    const unsigned ldsw = (unsigned)wid * 1024u;
    const int aoff = lds_byte(wr * 64 + fr, fq * 8), boff = lds_byte(wc * 32 + fr, fq * 8);
#define PG8_SA(b, h) (((b) * 2 + (h)) * HTB)
#define PG8_SB(b, h) ((4 + (b) * 2 + (h)) * HTB)
#define PG8_STAGE(bufoff, gbase, v0, v1) do { \
        __builtin_amdgcn_global_load_lds((const unsigned*)((const char*)(gbase) + (v0)), (LAS unsigned*)(lds + (bufoff) + ldsw), 16, 0, 0); \
        __builtin_amdgcn_global_load_lds((const unsigned*)((const char*)(gbase) + (v1)), (LAS unsigned*)(lds + (bufoff) + ldsw + 8192), 16, 0, 0); } while (0)
#define PG8_STAGEB(bufoff, gbase) PG8_STAGE(bufoff, gbase, voffB[0], voffB[1])
#define PG8_LDA(dst, b, h) do { _Pragma("unroll") for (int m = 0; m < 4; ++m) _Pragma("unroll") for (int k = 0; k < 2; ++k) dst[m][k] = *(const LAS bf16x8*)(lds + PG8_SA(b, h) + aoff + m * 2048 + k * 1024); } while (0)
#define PG8_LDB(dst, b, h) do { _Pragma("unroll") for (int n = 0; n < 2; ++n) _Pragma("unroll") for (int k = 0; k < 2; ++k) dst[n][k] = *(const LAS bf16x8*)(lds + PG8_SB(b, h) + boff + n * 2048 + k * 1024); } while (0)
#define PG8_MMA(ai, bj, At, Bt) do { __builtin_amdgcn_s_setprio(1); _Pragma("unroll") for (int m = 0; m < 4; ++m) _Pragma("unroll") for (int n = 0; n < 2; ++n) _Pragma("unroll") for (int k = 0; k < 2; ++k) \
        acc[ai][bj][m][n] = __builtin_amdgcn_mfma_f32_16x16x32_bf16(Bt[n][k], At[m][k], acc[ai][bj][m][n], 0, 0, 0); __builtin_amdgcn_s_setprio(0); } while (0)
#define PG8_WAIT_V(n) asm volatile("s_waitcnt vmcnt(" #n ")" ::: "memory")
#define PG8_WAIT_L(n) asm volatile("s_waitcnt lgkmcnt(" #n ")" ::: "memory")
#define PG8_BAR __builtin_amdgcn_s_barrier()
#define PG8_SCHED __builtin_amdgcn_sched_barrier(0)
    Unit cur, nxt; int ui = 0;
    if (!S.next(0, cur)) return;
    f32x4 acc[2][2][4][2];
#pragma unroll
    for (int a = 0; a < 2; ++a)
#pragma unroll
        for (int b = 0; b < 2; ++b)
#pragma unroll
            for (int m = 0; m < 4; ++m)
#pragma unroll
                for (int n = 0; n < 2; ++n) acc[a][b][m][n] = (f32x4){0.f, 0.f, 0.f, 0.f};
    bf16x8 At[4][2], B0[2][2], B1[2][2];
    unsigned voffA[2]; unsigned oc[2][2], on[2][2];
#pragma unroll
    for (int i = 0; i < 2; ++i) voffA[i] = (unsigned)(Rr[i] * g.lda + Cc[i]) * 2u;
    const char* cA; const char* cB;
#define PG8_UNIT_PTRS(u, pA, pB, o) do { \
        pB = (const char*)(g.Bt + (size_t)(u).g * g.b_gs) + (size_t)(u).pn * BM * g.ldb * 2; \
        if constexpr (GATHER) { \
            pA = (const char*)g.A; \
            const int* ix_ = g.idx + (size_t)(u).g * g.idx_gs + (u).pm * BM; \
            _Pragma("unroll") for (int h = 0; h < 2; ++h) _Pragma("unroll") for (int i = 0; i < 2; ++i) o[h][i] = ((unsigned)ix_[h * HALF + Rr[i]] * (unsigned)g.lda + (unsigned)Cc[i]) * 2u; \
        } else { \
            pA = (const char*)(g.A + (size_t)(u).g * g.a_gs) + (size_t)(u).pm * BM * g.lda * 2; \
        } } while (0)
#define PG8_STAGEA(bufoff, p, o, h) do { if constexpr (GATHER) PG8_STAGE(bufoff, p, o[h][0], o[h][1]); else PG8_STAGE(bufoff, (p) + (h) * hstepA, voffA[0], voffA[1]); } while (0)
    PG8_UNIT_PTRS(cur, cA, cB, oc);
    PG8_STAGEB(PG8_SB(0, 0), cB); PG8_STAGEB(PG8_SB(0, 1), cB + hstepB); PG8_STAGEA(PG8_SA(0, 0), cA, oc, 0); PG8_STAGEA(PG8_SA(0, 1), cA, oc, 1);
    if (wr == 1) PG8_BAR;
    PG8_WAIT_V(2); PG8_BAR;
    PG8_STAGEB(PG8_SB(1, 0), cB + kstep); PG8_STAGEA(PG8_SA(1, 0), cA + kstep, oc, 0); PG8_STAGEB(PG8_SB(1, 1), cB + hstepB + kstep);
    PG8_WAIT_V(6); PG8_BAR;
    for (;;) {
        const bool has_next = S.next(ui + 1, nxt);
        const char* nA = cA; const char* nB = cB;
        if constexpr (GATHER) {
#pragma unroll
            for (int h = 0; h < 2; ++h)
#pragma unroll
                for (int i = 0; i < 2; ++i) on[h][i] = oc[h][i];
        }
        if (has_next) PG8_UNIT_PTRS(nxt, nA, nB, on);
#pragma unroll 1
        for (int t = 0; t < nt; t += 2) {
            const bool last = (t == nt - 2);
            const char* a1 = cA + (size_t)(t + 1) * kstep;
            const char* a2 = last ? nA : cA + (size_t)(t + 2) * kstep; const char* b2 = last ? nB : cB + (size_t)(t + 2) * kstep;
            const char* a3 = a2 + kstep; const char* b3 = b2 + kstep;
            unsigned o2[2][2];
            if constexpr (GATHER) {
#pragma unroll
                for (int h = 0; h < 2; ++h)
#pragma unroll
                    for (int i = 0; i < 2; ++i) o2[h][i] = last ? on[h][i] : oc[h][i];
            }
            PG8_LDB(B0, 0, 0); PG8_LDB(B1, 0, 1); PG8_SCHED; PG8_LDA(At, 0, 0); PG8_STAGEA(PG8_SA(1, 1), a1, oc, 1);
            PG8_WAIT_V(8); PG8_WAIT_L(0); PG8_BAR; PG8_MMA(0, 0, At, B0); PG8_MMA(0, 1, At, B1); PG8_BAR; PG8_SCHED;
            PG8_LDA(At, 0, 1); PG8_STAGEB(PG8_SB(0, 0), b2); PG8_STAGEB(PG8_SB(0, 1), b2 + hstepB); PG8_STAGEA(PG8_SA(0, 0), a2, o2, 0);
            PG8_WAIT_V(8); PG8_WAIT_L(0); PG8_BAR; PG8_MMA(1, 0, At, B0); PG8_MMA(1, 1, At, B1); PG8_BAR; PG8_SCHED;
            PG8_LDB(B0, 1, 0); PG8_LDB(B1, 1, 1); PG8_SCHED; PG8_LDA(At, 1, 0); PG8_STAGEA(PG8_SA(0, 1), a2, o2, 1);
            PG8_WAIT_V(8); PG8_WAIT_L(0); PG8_BAR; PG8_MMA(0, 0, At, B0); PG8_MMA(0, 1, At, B1); PG8_BAR; PG8_SCHED;
            PG8_LDA(At, 1, 1); PG8_STAGEB(PG8_SB(1, 0), b3); PG8_STAGEB(PG8_SB(1, 1), b3 + hstepB); PG8_STAGEA(PG8_SA(1, 0), a3, o2, 0);
            PG8_WAIT_V(8); PG8_WAIT_L(0); PG8_BAR; PG8_MMA(1, 0, At, B0); PG8_MMA(1, 1, At, B1); PG8_BAR; PG8_SCHED;
        }
        if (wr == 0) PG8_BAR;
        E(acc, cur, wr, wc, fr, fq);
        if (!has_next) break;
#pragma unroll
        for (int a = 0; a < 2; ++a)
#pragma unroll
            for (int b = 0; b < 2; ++b)
#pragma unroll
                for (int m = 0; m < 4; ++m)
#pragma unroll
                    for (int n = 0; n < 2; ++n) acc[a][b][m][n] = (f32x4){0.f, 0.f, 0.f, 0.f};
        cur = nxt; cA = nA; cB = nB; ++ui;
        if constexpr (GATHER) {
#pragma unroll
            for (int h = 0; h < 2; ++h)
#pragma unroll
                for (int i = 0; i < 2; ++i) oc[h][i] = on[h][i];
        }
        if (wr == 1) PG8_BAR;
    }
    PG8_WAIT_V(0);
    PG8_BAR;
#undef PG8_UNIT_PTRS
#undef PG8_STAGEA
#undef PG8_SA
#undef PG8_SB
#undef PG8_STAGE
#undef PG8_STAGEB
#undef PG8_LDA
#undef PG8_LDB
#undef PG8_MMA
#undef PG8_WAIT_V
#undef PG8_WAIT_L
#undef PG8_BAR
#undef PG8_SCHED
}

#define EPI_ROWLOOP for (int ai = 0; ai < 2; ++ai) _Pragma("unroll") for (int m = 0; m < 4; ++m)
__device__ __forceinline__ u32x4 pack8(const f32x4 v0, const f32x4 v1) { u32x4 w; w.x = cvt_pk_bf16(v0[0], v0[1]); w.y = cvt_pk_bf16(v0[2], v0[3]); w.z = cvt_pk_bf16(v1[0], v1[1]); w.w = cvt_pk_bf16(v1[2], v1[3]); return w; }
struct EpiBf16 {
    static constexpr bool PERM = true;
    bf16_t* O; int ldc;
    __device__ __forceinline__ void operator()(const f32x4 (&acc)[2][2][4][2], const Unit& u, int wr, int wc, int fr, int fq) const {
        const unsigned lo = (unsigned)(fr * ldc + 8 * fq) * 2u;
        char* ub = (char*)(O + (size_t)(u.pm * BM + wr * 64) * ldc + u.pn * BM + wc * 32);
#pragma unroll
        EPI_ROWLOOP { char* rb = ub + (size_t)(ai * HALF + m * 16) * ldc * 2;
#pragma unroll
            for (int bj = 0; bj < 2; ++bj) *(u32x4*)(rb + bj * HALF * 2 + lo) = pack8(acc[ai][bj][m][0], acc[ai][bj][m][1]); }
    }
};
struct EpiQ {
    static constexpr bool PERM = true;
    bf16_t* QB; const float* cs;
    __device__ __forceinline__ void operator()(const f32x4 (&acc)[2][2][4][2], const Unit& u, int wr, int wc, int fr, int fq) const {
        const unsigned lo = (unsigned)(fr * 192 + 8 * fq) * 2u, lcs = (unsigned)(fr * 64 + 8 * fq) * 4u;
        const int rowU = u.pm * BM + wr * 64;
#pragma unroll
        for (int bj = 0; bj < 2; ++bj) { const int c32 = u.pn * BM + bj * HALF + wc * 32, hd = c32 / 192, w32 = c32 - hd * 192;
            char* ub = (char*)(QB + ((size_t)hd * SEQ + rowU) * 192 + w32);
            const char* cb = (const char*)(cs + (size_t)rowU * 64 + (w32 >= 128 ? (w32 - 128) : 0));
#pragma unroll
            EPI_ROWLOOP { const int rr = ai * HALF + m * 16; f32x4 v0 = acc[ai][bj][m][0], v1 = acc[ai][bj][m][1];
                if (w32 >= 128) { const f32x4 ca = *(const f32x4*)(cb + (size_t)rr * 256 + lcs), cc = *(const f32x4*)(cb + (size_t)rr * 256 + 16 + lcs);
                    const f32x4 a = v0, b = v1;
                    v0[0] = a[0] * ca[0] - a[1] * ca[1]; v0[1] = a[0] * ca[1] + a[1] * ca[0]; v0[2] = a[2] * ca[2] - a[3] * ca[3]; v0[3] = a[2] * ca[3] + a[3] * ca[2];
                    v1[0] = b[0] * cc[0] - b[1] * cc[1]; v1[1] = b[0] * cc[1] + b[1] * cc[0]; v1[2] = b[2] * cc[2] - b[3] * cc[3]; v1[3] = b[2] * cc[3] + b[3] * cc[2]; }
                *(u32x4*)(ub + (size_t)rr * 384 + lo) = pack8(v0, v1);
                if (m & 1) asm volatile("" ::: "memory"); } }
    }
};
struct EpiKV {
    static constexpr bool PERM = true;
    bf16_t* KB; bf16_t* VB;
    __device__ __forceinline__ void operator()(const f32x4 (&acc)[2][2][4][2], const Unit& u, int wr, int wc, int fr, int fq) const {
        const int rowU = u.pm * BM + wr * 64;
#pragma unroll
        for (int bj = 0; bj < 2; ++bj) { const int c32 = u.pn * BM + bj * HALF + wc * 32, hd = c32 >> 8, w32 = c32 & 255; const bool isk = w32 < 128;
            const int ld = isk ? 192 : 128;
            char* ub = (char*)(isk ? KB + ((size_t)hd * SEQ + rowU) * 192 + w32 : VB + ((size_t)hd * SEQ + rowU) * 128 + (w32 - 128));
            const unsigned lo = (unsigned)(fr * ld + 8 * fq) * 2u;
#pragma unroll
            EPI_ROWLOOP { *(u32x4*)(ub + (size_t)(ai * HALF + m * 16) * ld * 2 + lo) = pack8(acc[ai][bj][m][0], acc[ai][bj][m][1]); } }
    }
};
struct EpiRes {
    static constexpr bool PERM = false;
    const float* x; float* out; const float* mod;
    __device__ __forceinline__ void operator()(const f32x4 (&acc)[2][2][4][2], const Unit& u, int wr, int wc, int fr, int fq) const {
        const int col0 = u.pn * BM + wc * 32 + 4 * fq;
        const int b = (u.pm * BM) / SEQ;
        f32x4 gt[2][2];
#pragma unroll
        for (int bj = 0; bj < 2; ++bj)
#pragma unroll
            for (int n = 0; n < 2; ++n) gt[bj][n] = *(const f32x4*)(mod + b * 6144 + 2048 + col0 + bj * HALF + n * 16);
        const unsigned lo = (unsigned)(fr * DM + 4 * fq) * 4u;
        const size_t ubo = ((size_t)(u.pm * BM + wr * 64) * DM + u.pn * BM + wc * 32) * 4;
#pragma unroll
        EPI_ROWLOOP { const size_t ro = ubo + (size_t)(ai * HALF + m * 16) * DM * 4;
#pragma unroll
            for (int bj = 0; bj < 2; ++bj)
#pragma unroll
                for (int n = 0; n < 2; ++n) { const size_t o = ro + (bj * HALF + n * 16) * 4; const f32x4 xv = *(const f32x4*)((const char*)x + o + lo);
                    *(f32x4*)((char*)out + o + lo) = xv + gt[bj][n] * acc[ai][bj][m][n]; }
            if (m & 1) asm volatile("" ::: "memory"); }
    }
};
struct EpiSwiGLU {
    static constexpr bool PERM = true;
    bf16_t* HID;
    __device__ __forceinline__ void operator()(const f32x4 (&acc)[2][2][4][2], const Unit& u, int wr, int wc, int fr, int fq) const {
        const unsigned lo = (unsigned)(fr * DFF + 4 * fq) * 2u;
        char* ub = (char*)(HID + ((size_t)u.g * CAP + u.pm * BM + wr * 64) * DFF + ((u.pn * BM + wc * 32) >> 1));
#pragma unroll
        EPI_ROWLOOP { char* rb = ub + (size_t)(ai * HALF + m * 16) * DFF * 2;
#pragma unroll
            for (int bj = 0; bj < 2; ++bj) { const f32x4 gv = acc[ai][bj][m][0], uv = acc[ai][bj][m][1]; f32x4 h;
#pragma unroll
                for (int e = 0; e < 4; ++e) h[e] = gv[e] * fast_sigmoid(gv[e]) * uv[e];
                u32x2 o; o.x = cvt_pk_bf16(h[0], h[1]); o.y = cvt_pk_bf16(h[2], h[3]);
                *(u32x2*)(rb + bj * (HALF / 2) * 2 + lo) = o; } }
    }
};
struct EpiDown {
    static constexpr bool PERM = true;
    bf16_t* Y; const float* gate;
    __device__ __forceinline__ void operator()(const f32x4 (&acc)[2][2][4][2], const Unit& u, int wr, int wc, int fr, int fq) const {
        const unsigned lo = (unsigned)(fr * DM + 8 * fq) * 2u;
        const int rowU = u.g * CAP + u.pm * BM + wr * 64;
        char* ub = (char*)(Y + (size_t)rowU * DM + u.pn * BM + wc * 32);
        const float* gp = gate + rowU + fr;
#pragma unroll
        EPI_ROWLOOP { const int rr = ai * HALF + m * 16; const float gs = gp[rr]; char* rb = ub + (size_t)rr * DM * 2;
#pragma unroll
            for (int bj = 0; bj < 2; ++bj) *(u32x4*)(rb + bj * HALF * 2 + lo) = pack8(acc[ai][bj][m][0] * gs, acc[ai][bj][m][1] * gs); }
    }
};
#undef EPI_ROWLOOP
}
namespace att {
__device__ __forceinline__ int crow(int r, int hi) { return (r & 3) + 8 * (r >> 2) + 4 * hi; }
__device__ __forceinline__ int v_st(int k, int c) { const int kk = (k & ~0xC) | ((k & 4) << 1) | ((k & 8) >> 1); return ((kk >> 3) * 4 + (c >> 5)) * 512 + ((kk & 7) * 32 + (c & 31)) * 2; }
__device__ __forceinline__ int v_rd_base(int lane) { return ((lane & 3) << 3) | (((lane >> 2) & 3) << 6) | (((lane >> 4) & 1) << 5) | (((lane >> 5) & 1) << 8); }
constexpr int v_rd_off(int d0, int ks, int half) { return d0 * 512 + ks * 4096 + half * 2048; }
template <int OFF> __device__ __forceinline__ s16x4 tr_read(int vb) {
    s16x4 r; asm volatile("ds_read_b64_tr_b16 %0, %1 offset:%2" : "=&v"(r) : "v"(vb), "i"(OFF) : "memory"); return r;
}
#define ATT_SBAR() __builtin_amdgcn_sched_barrier(0)
template <int D0> __device__ __forceinline__ void pv_one(f32x16& od, int vb, bf16x8 pa0, bf16x8 pa1, bf16x8 pa2, bf16x8 pa3) {
    const s16x4 l0 = tr_read<v_rd_off(D0, 0, 0)>(vb), h0 = tr_read<v_rd_off(D0, 0, 1)>(vb), l1 = tr_read<v_rd_off(D0, 1, 0)>(vb), h1 = tr_read<v_rd_off(D0, 1, 1)>(vb);
    const s16x4 l2 = tr_read<v_rd_off(D0, 2, 0)>(vb), h2 = tr_read<v_rd_off(D0, 2, 1)>(vb), l3 = tr_read<v_rd_off(D0, 3, 0)>(vb), h3 = tr_read<v_rd_off(D0, 3, 1)>(vb);
    asm volatile("s_waitcnt lgkmcnt(0)" ::: "memory"); ATT_SBAR();
#define ATT_PK(L, H) (bf16x8){L[0], L[1], L[2], L[3], H[0], H[1], H[2], H[3]}
    od = __builtin_amdgcn_mfma_f32_32x32x16_bf16(pa0, ATT_PK(l0, h0), od, 0, 0, 0);
    od = __builtin_amdgcn_mfma_f32_32x32x16_bf16(pa1, ATT_PK(l1, h1), od, 0, 0, 0);
    od = __builtin_amdgcn_mfma_f32_32x32x16_bf16(pa2, ATT_PK(l2, h2), od, 0, 0, 0);
    od = __builtin_amdgcn_mfma_f32_32x32x16_bf16(pa3, ATT_PK(l3, h3), od, 0, 0, 0);
#undef ATT_PK
}
__device__ __forceinline__ void pv_d0(f32x16* o, int vb, bf16x8 pa0, bf16x8 pa1, bf16x8 pa2, bf16x8 pa3) {
    pv_one<0>(o[0], vb, pa0, pa1, pa2, pa3); pv_one<1>(o[1], vb, pa0, pa1, pa2, pa3); pv_one<2>(o[2], vb, pa0, pa1, pa2, pa3); pv_one<3>(o[3], vb, pa0, pa1, pa2, pa3);
}
__device__ __forceinline__ void finishSM(f32x16& p0, f32x16& p1, float alpha, float& l_reg, bf16x8& pa0, bf16x8& pa1, bf16x8& pa2, bf16x8& pa3) {
#pragma unroll
    for (int r = 0; r < 16; ++r) p1[r] = __builtin_amdgcn_exp2f(p1[r]);
    float ps = 0;
#pragma unroll
    for (int r = 0; r < 16; ++r) ps += p0[r];
#pragma unroll
    for (int r = 0; r < 16; ++r) ps += p1[r];
    { auto rr = __builtin_amdgcn_permlane32_swap(__float_as_uint(ps), __float_as_uint(ps), false, false);
      ps = __uint_as_float(rr[0]) + __uint_as_float(rr[1]); }
    l_reg = l_reg * alpha + ps;
#define ATT_PK4(P, BASE, OUT) do { unsigned a0 = cvt_pk_bf16(P[BASE + 0], P[BASE + 1]), a1 = cvt_pk_bf16(P[BASE + 2], P[BASE + 3]);   \
    unsigned b0 = cvt_pk_bf16(P[BASE + 4], P[BASE + 5]), b1 = cvt_pk_bf16(P[BASE + 6], P[BASE + 7]);                              \
    auto r0 = __builtin_amdgcn_permlane32_swap(a0, b0, false, false); auto r1 = __builtin_amdgcn_permlane32_swap(a1, b1, false, false); \
    u32x4 w = {r0[0], r1[0], r0[1], r1[1]}; OUT = *reinterpret_cast<bf16x8*>(&w); } while (0)
    ATT_PK4(p0, 0, pa0); ATT_PK4(p0, 8, pa1); ATT_PK4(p1, 0, pa2); ATT_PK4(p1, 8, pa3);
#undef ATT_PK4
}

struct Unit {
    const bf16_t* Q; int qs;
    const bf16_t* K; int ks;
    const bf16_t* V; int vs;
    bf16_t* O; int os;
    int nt;
    int kt0, ktn;
    int l0;
    const int* pos; int ps;
    float* lse; int ls;
    const float* bias;
};

template <bool DIL> struct Cfg {
    static constexpr int DQK = DIL ? 128 : 192, ND = DQK / 16, KROWB = DQK * 2 + 16, SHM_K = 64 * KROWB, SHM_V = 16384;
    static constexpr int NKC = DQK / 64;
    static constexpr int OFF_V = 0, OFF_K = 2 * SHM_V, OFF_WS = OFF_K + 2 * SHM_K, OFF_POS = OFF_WS + NWAVES * 64 * 4, OFF_LUT = OFF_POS + 2 * 64 * 4, END = OFF_LUT + 2052 * 4;
    static constexpr float SCALE = DIL ? 0.088388347648318440f : 0.072168783648703220f;
};

template <bool DIL>
__device__ __forceinline__ void qkt(f32x16& p0, f32x16& p1, const LAS char* Ks, const bf16x8* qr, int r32, int hi) {
    using C = Cfg<DIL>;
    p0 = f32x16{}; p1 = f32x16{};
    const LAS char* k0 = Ks + r32 * C::KROWB + hi * 16; const LAS char* k1 = k0 + 32 * C::KROWB;
#pragma unroll
    for (int d0 = 0; d0 < C::ND; ++d0) {
        const bf16x8 b0 = *(const LAS bf16x8*)(k0 + d0 * 32);
        const bf16x8 b1 = *(const LAS bf16x8*)(k1 + d0 * 32);
        p0 = __builtin_amdgcn_mfma_f32_32x32x16_bf16(b0, qr[d0], p0, 0, 0, 0);
        p1 = __builtin_amdgcn_mfma_f32_32x32x16_bf16(b1, qr[d0], p1, 0, 0, 0); }
}

template <bool DIL>
__device__ __forceinline__ void partialSM(f32x16& p0, f32x16& p1, float& m_reg, float& mn, float& alpha,
                                          const LAS int* posb, const LAS float* lut, int pq, int dl0, bool tv, int hi) {
    using C = Cfg<DIL>;
    constexpr float CC = C::SCALE * LOG2E;
    constexpr float THR = 8.f;
    float mnC;
    if constexpr (DIL) {
#pragma unroll
        for (int a = 0; a < 4; ++a) {
            const i32x4 pk0 = *(const LAS i32x4*)(posb + 8 * a + 4 * hi), pk1 = *(const LAS i32x4*)(posb + 32 + 8 * a + 4 * hi);
#pragma unroll
            for (int b = 0; b < 4; ++b) { const int r = 4 * a + b;
                int i0 = pk0[b] - pq; i0 = i0 < -1024 ? -1024 : (i0 > 1024 ? 1024 : i0);
                int i1 = pk1[b] - pq; i1 = i1 < -1024 ? -1024 : (i1 > 1024 ? 1024 : i1);
                const float b0 = lut[i0 + 1024], b1 = lut[i1 + 1024];
                const int dl = dl0 + 8 * a + b;
                const bool ok0 = tv && ((unsigned)(dl + 64) <= 128u), ok1 = tv && ((unsigned)(dl + 32 + 64) <= 128u);
                p0[r] = ok0 ? fmaf(p0[r], CC, b0) : -1e30f;
                p1[r] = ok1 ? fmaf(p1[r], CC, b1) : -1e30f; }
        }
        float pmax = p0[0];
#pragma unroll
        for (int r = 1; r < 16; ++r) pmax = fmaxf(pmax, p0[r]);
#pragma unroll
        for (int r = 0; r < 16; ++r) pmax = fmaxf(pmax, p1[r]);
        { auto rr = __builtin_amdgcn_permlane32_swap(__float_as_uint(pmax), __float_as_uint(pmax), false, false);
          pmax = fmaxf(__uint_as_float(rr[0]), __uint_as_float(rr[1])); }
        if (__builtin_expect(__all(pmax - m_reg <= THR * LOG2E), 1)) { mn = m_reg; alpha = 1.f; }
        else { mn = fmaxf(m_reg, pmax); alpha = __builtin_amdgcn_exp2f(m_reg - mn); m_reg = mn; }
        mnC = -fmaxf(mn, -1e29f);
#pragma unroll
        for (int r = 0; r < 16; ++r) p0[r] = p0[r] + mnC;
#pragma unroll
        for (int r = 0; r < 16; ++r) p1[r] = p1[r] + mnC;
    } else {
        float pmax = p0[0];
#pragma unroll
        for (int r = 1; r < 16; ++r) pmax = fmaxf(pmax, p0[r]);
#pragma unroll
        for (int r = 0; r < 16; ++r) pmax = fmaxf(pmax, p1[r]);
        { auto rr = __builtin_amdgcn_permlane32_swap(__float_as_uint(pmax), __float_as_uint(pmax), false, false);
          pmax = fmaxf(__uint_as_float(rr[0]), __uint_as_float(rr[1])); }
        if (__builtin_expect(__all(pmax - m_reg <= THR / C::SCALE), 1)) { mn = m_reg; alpha = 1.f; }
        else { mn = fmaxf(m_reg, pmax); alpha = __builtin_amdgcn_exp2f((m_reg - mn) * CC); m_reg = mn; }
        mnC = -mn * CC;
#pragma unroll
        for (int r = 0; r < 16; ++r) p0[r] = fmaf(p0[r], CC, mnC);
#pragma unroll
        for (int r = 0; r < 16; ++r) p1[r] = fmaf(p1[r], CC, mnC);
    }
#pragma unroll
    for (int r = 0; r < 16; ++r) p0[r] = __builtin_amdgcn_exp2f(p0[r]);
}

__device__ __forceinline__ int t5_bucket(int rel) {
    const int n = rel < 0 ? -rel : rel;
    const float nf = (float)(n > 1 ? n : 1);
    int large = 8 + (int)(logf(nf / 8.f) / 4.852030263919617f * 8.f);
    large = large < 15 ? large : 15;
    return (rel > 0 ? 16 : 0) + (n < 8 ? n : large);
}

template <bool DIL>
__device__ __forceinline__ void attn_unit(const Unit& a, LAS char* lds) {
    using C = Cfg<DIL>;
    constexpr int SD = 1;
    const int tid = opaque_tid(), wid = __builtin_amdgcn_readfirstlane(tid >> 6), lane = tid & 63, r32 = lane & 31, hi = lane >> 5;
    LAS char* V_lds = lds + C::OFF_V; LAS char* K_lds = lds + C::OFF_K;
    LAS float* ws = (LAS float*)(lds + C::OFF_WS) + wid * 64; LAS float* li_l = ws; LAS float* al_l = ws + 32;
    LAS int* pos_l = (LAS int*)(lds + C::OFF_POS); LAS float* lut = (LAS float*)(lds + C::OFF_LUT);
    float m_reg = -1e30f, l_reg = 0; f32x16 o[4] = {}; bf16x8 qr[C::ND];
    { const bf16_t* Qw = a.Q + (size_t)(wid * 32 + r32) * a.qs + hi * 8;
#pragma unroll
      for (int d0 = 0; d0 < C::ND; ++d0) qr[d0] = *(const bf16x8*)(Qw + d0 * 16); }
    int pq = 0, lq = 0;
    if constexpr (DIL) {
        lq = a.l0 + wid * 32 + r32; pq = a.pos[(size_t)lq * a.ps];
        for (int i = tid; i < 2049; i += 512) lut[i] = a.bias[t5_bucket(i - 1024) * 24] * LOG2E;
    }
    unsigned kgo[C::NKC]; int klo[C::NKC];
#pragma unroll
    for (int i = 0; i < C::NKC; ++i) { const int c = tid + 512 * i, kr = c / (C::DQK / 8), kc = c % (C::DQK / 8); kgo[i] = (unsigned)(kr * a.ks + kc * 8) * 2u; klo[i] = kr * C::KROWB + kc * 16; }
    const int sr = tid >> 4, sc = (tid & 15) * 8, vst0 = v_st(sr, sc), vst1 = v_st(32 + sr, sc);
    const unsigned vgo0 = (unsigned)(sr * a.vs + sc) * 2u, vgo1 = (unsigned)((32 + sr) * a.vs + sc) * 2u;
    const int vb0 = (int)(unsigned)(size_t)V_lds + v_rd_base(lane);
    struct { bf16x8 vs0, vs1, ks[C::NKC]; int pp; } sl[SD];
#define ATT_KROW0(j) (DIL ? (((a.kt0 + (j)) < 0 ? 0 : ((a.kt0 + (j)) >= a.ktn ? a.ktn - 1 : (a.kt0 + (j)))) * 64) : (j) * 64)
#define ATT_SLOAD(i, j) do { const int k0_ = ATT_KROW0(j); const char* kt_ = (const char*)(a.K + (size_t)k0_ * a.ks); const char* vt_ = (const char*)(a.V + (size_t)k0_ * a.vs); \
        sl[i].vs0 = *(const bf16x8*)(vt_ + vgo0); sl[i].vs1 = *(const bf16x8*)(vt_ + vgo1); \
        _Pragma("unroll") for (int q_ = 0; q_ < C::NKC; ++q_) sl[i].ks[q_] = *(const bf16x8*)(kt_ + kgo[q_]); \
        if constexpr (DIL) { if (tid < 64) sl[i].pp = a.pos[(size_t)(k0_ + tid) * a.ps]; } } while (0)
#define ATT_SWRITE(b, i) do { *(LAS bf16x8*)(V_lds + (b) * C::SHM_V + vst0) = sl[i].vs0; *(LAS bf16x8*)(V_lds + (b) * C::SHM_V + vst1) = sl[i].vs1; \
        _Pragma("unroll") for (int q_ = 0; q_ < C::NKC; ++q_) *(LAS bf16x8*)(K_lds + (b) * C::SHM_K + klo[q_]) = sl[i].ks[q_]; \
        if constexpr (DIL) { if (tid < 64) pos_l[(b) * 64 + tid] = sl[i].pp; } } while (0)
#define ATT_SWAIT() do { if constexpr (SD == 2) asm volatile("s_waitcnt vmcnt(%0)" :: "n"(2 + C::NKC) : "memory"); else asm volatile("s_waitcnt vmcnt(0)" ::: "memory"); } while (0)
#define ATT_RESC(al) do { if (__any((al) < 1.f)) { if (hi == 0) al_l[r32] = (al); asm volatile("s_waitcnt lgkmcnt(0)" ::: "memory"); \
        _Pragma("unroll") for (int d = 0; d < 4; ++d) _Pragma("unroll") for (int r = 0; r < 16; ++r) o[d][r] *= al_l[crow(r, hi)]; } } while (0)
#define ATT_DL0(j) (DIL ? (64 * (a.kt0 + (j)) - lq + 4 * hi) : 0)
#define ATT_TV(j) (DIL ? ((a.kt0 + (j)) >= 0 && (a.kt0 + (j)) < a.ktn) : true)
    f32x16 p0, p1; float mn, al; bf16x8 pa0, pa1, pa2, pa3; const int NT = a.nt;
    ATT_SLOAD(0, 0); asm volatile("s_waitcnt vmcnt(0)" ::: "memory"); ATT_SWRITE(0, 0); __syncthreads();
    for (int j = 0; j < NT; ++j) {
        const int cur = j & 1;
        ATT_SBAR();
        qkt<DIL>(p0, p1, K_lds + cur * C::SHM_K, qr, r32, hi);
        partialSM<DIL>(p0, p1, m_reg, mn, al, pos_l + cur * 64, lut, pq, ATT_DL0(j), ATT_TV(j), hi);
        ATT_RESC(al);
        finishSM(p0, p1, al, l_reg, pa0, pa1, pa2, pa3); ATT_SBAR();
        if (j + 1 < NT) ATT_SLOAD(0, j + 1);
        ATT_SBAR();
        pv_d0(o, vb0 + cur * (int)C::SHM_V, pa0, pa1, pa2, pa3);
        if (j + 1 < NT) { if (cur) ATT_SWRITE(0, 0); else ATT_SWRITE(1, 0); }
        __syncthreads();
    }
    if (hi == 0) li_l[r32] = l_reg; asm volatile("s_waitcnt lgkmcnt(0)" ::: "memory");
    { const unsigned lo = (unsigned)(4 * hi * a.os + r32) * 2u;
      char* Ow = (char*)(a.O + (size_t)(wid * 32) * a.os);
#pragma unroll
      for (int r = 0; r < 16; ++r) { const float rl = __builtin_amdgcn_rcpf(li_l[crow(r, hi)]); char* rb = Ow + (size_t)((r & 3) + 8 * (r >> 2)) * a.os * 2;
#pragma unroll
          for (int d0 = 0; d0 < 4; ++d0) { const float v = o[d0][r] * rl; *(bf16_t*)(rb + d0 * 64 + lo) = (bf16_t)(cvt_pk_bf16(v, v) & 0xffffu); } } }
    if constexpr (DIL) { if (hi == 0) a.lse[(size_t)(wid * 32 + r32) * a.ls] = m_reg + __builtin_amdgcn_logf(l_reg); }
    __syncthreads();
#undef ATT_KROW0
#undef ATT_SLOAD
#undef ATT_SWRITE
#undef ATT_SWAIT
#undef ATT_RESC
#undef ATT_DL0
#undef ATT_TV
}
}
#if defined(MK_CHECK) && MK_CHECK
#ifndef CHK_XOR_ROW
#define CHK_XOR_ROW 0
#endif
namespace chk {
__device__ __forceinline__ unsigned hash32(unsigned x) { x ^= x >> 16; x *= 0x7feb352du; x ^= x >> 15; x *= 0x846ca68bu; x ^= x >> 16; return x; }
__device__ __forceinline__ void flag(unsigned* ctl, int bit) { atomicOr(ctl + CW_DBG, 1u << bit); }
__device__ __forceinline__ bool bad_l2(float err2, float ref2, float tol) { err2 = wave_sum(err2); ref2 = wave_sum(ref2); return !(err2 <= tol * tol * ref2 + 1e-12f); }
__device__ __forceinline__ void ref_cos_sin(int pos, int j, float& c, float& s) {
    const float inv = powf(10000.0f, -(float)(2 * j) / 64.0f); const float ang = (float)pos * inv;
    c = (float)cos((double)ang); s = (float)sin((double)ang);
}
__device__ __forceinline__ int ref_bucket(int rel) {
    int ret = rel > 0 ? 16 : 0; int n = rel < 0 ? -rel : rel; float nf = (float)(n < 1 ? 1 : n);
    float v = logf(nf / 8.0f) / 4.852030263919617f * 8.0f; int large = 8 + (int)v; if (large > 15) large = 15;
    return ret + (n < 8 ? n : large);
}
__device__ __forceinline__ void check_proj(const Frame& F, int b, unsigned* ctl, const bf16_t* P, const bf16_t* CQN, const bf16_t* CKVN, const bf16_t* QB, const bf16_t* KB, const bf16_t* VB,
                                           const float* gq, const float* gkv, const float* w_uq, const float* w_ukv, const int* positions) {
    const int lane = opaque_tid() & 63;
    for (int smp = F.gw; smp < 4096; smp += F.NGW) {
        const unsigned hsh = hash32(smp * 2654435761u + b * 97u + 12345u);
        const int t = hsh % SEQ, hd = (hsh >> 13) & 7, kind = smp & 3;
        const bf16_t* pr = P + (size_t)t * NP;
        if (kind == 0) {
            float ss = 0.f; for (int k = lane; k < 384; k += 64) { const float v = bf2f(pr[C_CQ + k]); ss += v * v; }
            const float rq = 1.0f / sqrtf(wave_sum(ss) / 384.f + NORM_EPS); float e2 = 0.f, r2 = 0.f;
            for (int k = lane; k < 384; k += 64) { const float ref = bf2f(pr[C_CQ + k]) * rq * gq[k], got = bf2f(CQN[(size_t)t * 384 + k]); e2 += (ref - got) * (ref - got); r2 += ref * ref; }
            if (bad_l2(e2, r2, 0.01f)) flag(ctl, 0);
            ss = 0.f; for (int k = lane; k < 256; k += 64) { const float v = bf2f(pr[C_CKV + k]); ss += v * v; }
            const float rk = 1.0f / sqrtf(wave_sum(ss) / 256.f + NORM_EPS); e2 = 0.f; r2 = 0.f;
            for (int k = lane; k < 256; k += 64) { const float ref = bf2f(pr[C_CKV + k]) * rk * gkv[k], got = bf2f(CKVN[(size_t)t * 256 + k]); e2 += (ref - got) * (ref - got); r2 += ref * ref; }
            if (bad_l2(e2, r2, 0.01f)) flag(ctl, 0);
        } else if (kind == 1) {
            float q[3] = {0.f, 0.f, 0.f};
            for (int k = 0; k < 384; ++k) { const float a = bf2f(CQN[(size_t)t * 384 + k]);
#pragma unroll
                for (int i = 0; i < 3; ++i) q[i] += a * w_uq[(size_t)k * 1536 + hd * 192 + lane + 64 * i]; }
            float e2 = 0.f, r2 = 0.f;
#pragma unroll
            for (int i = 0; i < 2; ++i) { const float got = bf2f(QB[((size_t)hd * SEQ + t) * 192 + lane + 64 * i]); e2 += (q[i] - got) * (q[i] - got); r2 += q[i] * q[i]; }
            const float other = __shfl_xor(q[2], 32); float c, s; ref_cos_sin(positions[(size_t)b * SEQ + t], lane & 31, c, s);
            const float x1 = lane < 32 ? q[2] : other, x2 = lane < 32 ? other : q[2];
            const float ref = lane < 32 ? x1 * c - x2 * s : x1 * s + x2 * c;
            const float got = bf2f(QB[((size_t)hd * SEQ + t) * 192 + 128 + 2 * (lane & 31) + (lane >> 5)]); e2 += (ref - got) * (ref - got); r2 += ref * ref;
            if (bad_l2(e2, r2, 0.015f)) flag(ctl, 1);
        } else if (kind == 2) {
            float kk[2] = {0.f, 0.f};
            for (int k = 0; k < 256; ++k) { const float a = bf2f(CKVN[(size_t)t * 256 + k]); kk[0] += a * w_ukv[(size_t)k * 2048 + hd * 256 + lane]; kk[1] += a * w_ukv[(size_t)k * 2048 + hd * 256 + 64 + lane]; }
            float e2 = 0.f, r2 = 0.f;
#pragma unroll
            for (int i = 0; i < 2; ++i) { const float got = bf2f(KB[((size_t)hd * SEQ + t) * 192 + lane + 64 * i]); e2 += (kk[i] - got) * (kk[i] - got); r2 += kk[i] * kk[i]; }
            float c, s; ref_cos_sin(positions[(size_t)b * SEQ + t], lane & 31, c, s);
            const float x1 = bf2f(pr[C_KPE + (lane & 31)]), x2 = bf2f(pr[C_KPE + 32 + (lane & 31)]);
            const float ref = lane < 32 ? x1 * c - x2 * s : x1 * s + x2 * c;
            const float got = bf2f(KB[((size_t)hd * SEQ + t) * 192 + 128 + 2 * (lane & 31) + (lane >> 5)]); e2 += (ref - got) * (ref - got); r2 += ref * ref;
            if (bad_l2(e2, r2, 0.015f)) flag(ctl, 2);
        } else {
            float vv[2] = {0.f, 0.f};
            for (int k = 0; k < 256; ++k) { const float a = bf2f(CKVN[(size_t)t * 256 + k]); vv[0] += a * w_ukv[(size_t)k * 2048 + hd * 256 + 128 + lane]; vv[1] += a * w_ukv[(size_t)k * 2048 + hd * 256 + 192 + lane]; }
            float e2 = 0.f, r2 = 0.f;
#pragma unroll
            for (int i = 0; i < 2; ++i) { const float got = bf2f(VB[((size_t)hd * SEQ + t) * 128 + lane + 64 * i]); e2 += (vv[i] - got) * (vv[i] - got); r2 += vv[i] * vv[i]; }
            if (bad_l2(e2, r2, 0.015f)) flag(ctl, 3);
        }
    }
}
__device__ __forceinline__ void check_mla(const Frame& F, int b, unsigned* ctl, const bf16_t* QB, const bf16_t* KB, const bf16_t* VB, const bf16_t* OA) {
    const int tid = opaque_tid(), lane = tid & 63, wave = tid >> 6;
    LAS float* qf = (LAS float*)F.lds;
    LAS float* red = qf + 192;
    LAS float* pp = red + 64;
    LAS float* oacc = pp + SEQ;
    const unsigned hsh = hash32(blockIdx.x * 40503u + b * 977u + 777u);
    const int t = hsh % SEQ, hd = (hsh >> 13) & 7;
#if defined(FORCE_FLAG)
    if (blockIdx.x == 100 && tid == 5 && b == 2) flag(ctl, FORCE_FLAG);
#endif
    __syncthreads();
    if (tid < 192) qf[tid] = bf2f(QB[((size_t)hd * SEQ + t) * 192 + tid]);
    __syncthreads();
    float mx = -1e30f;
    for (int k = tid; k < SEQ; k += 512) { const bf16_t* kr = KB + ((size_t)hd * SEQ + k) * 192; float s = 0.f;
        for (int d = 0; d < 192; ++d) s += qf[d] * bf2f(kr[d]);
        s *= 0.07216878364870322f; pp[k] = s; mx = fmaxf(mx, s); }
#pragma unroll
    for (int o = 1; o < 64; o <<= 1) mx = fmaxf(mx, __shfl_xor(mx, o));
    if (lane == 0) red[wave] = mx;
    __syncthreads();
    mx = red[0]; for (int w = 1; w < 8; ++w) mx = fmaxf(mx, red[w]);
    __syncthreads();
    float sm = 0.f;
    for (int k = tid; k < SEQ; k += 512) { const float p = expf(pp[k] - mx); pp[k] = p; sm += p; }
    sm = wave_sum(sm); if (lane == 0) red[wave] = sm;
    __syncthreads();
    sm = 0.f; for (int w = 0; w < 8; ++w) sm += red[w];
    const int c = tid & 127, part = tid >> 7; float acc = 0.f;
    for (int k = part * 2048; k < part * 2048 + 2048; ++k) acc += pp[k] * bf2f(VB[((size_t)hd * SEQ + k) * 128 + c]);
    oacc[part * 128 + c] = acc;
    __syncthreads();
    if (tid < 64) { float e2 = 0.f, r2 = 0.f;
#pragma unroll
        for (int i = 0; i < 2; ++i) { const int cc = tid + 64 * i; const float ref = (oacc[cc] + oacc[128 + cc] + oacc[256 + cc] + oacc[384 + cc]) / sm, got = bf2f(OA[(size_t)(t ^ CHK_XOR_ROW) * DM + hd * 128 + cc]);
            e2 += (ref - got) * (ref - got); r2 += ref * ref; }
#if defined(CHK_MEASURE) && CHK_MEASURE == 4
        { const float re = sqrtf(wave_sum(e2) / wave_sum(r2)); int k = (int)floorf(-log2f(re)); k = k < 0 ? 0 : (k > 15 ? 15 : k); flag(ctl, k); }
#else
        if (bad_l2(e2, r2, 0.03f)) flag(ctl, 4);
#endif
    }
    __syncthreads();
}
__device__ __forceinline__ void check_dil(const Frame& F, int b, unsigned* ctl, const bf16_t* P, const int* positions, const float* rel_bias, const bf16_t* OG, const float* LSE) {
    const int tid = opaque_tid(), lane = tid & 63, wave = tid >> 6;
    LAS float* pw = (LAS float*)F.lds + wave * 256;
    for (int smp = F.gw; smp < 4096; smp += F.NGW) {
        const unsigned hsh = hash32(smp * 2246822519u + b * 131u + 999u);
        int t = hsh % SEQ; const int hd = (hsh >> 13) & 7, grp = (hsh >> 16) % 3, d = grp == 0 ? 1 : (grp == 1 ? 4 : 16);
        if ((smp & 7) == 0) t = (smp >> 3) % 40;
        if ((smp & 7) == 1) t = SEQ - 1 - ((smp >> 3) % 40);
        const bf16_t* base = P + C_DIL + grp * 3072 + hd * 128;
        const int pq = positions[(size_t)b * SEQ + t];
        float sc[3]; float mx = -1e30f;
#pragma unroll
        for (int i = 0; i < 3; ++i) { const int j = lane + 64 * i - 64, tk = t + j * d; sc[i] = -1e30f;
            if (j <= 64 && tk >= 0 && tk < SEQ) { float s = 0.f; const bf16_t* qr = base + (size_t)t * NP; const bf16_t* kr = base + 1024 + (size_t)tk * NP;
                for (int e = 0; e < 128; ++e) s += bf2f(qr[e]) * bf2f(kr[e]);
                s = s * 0.08838834764831845f + rel_bias[ref_bucket(positions[(size_t)b * SEQ + tk] - pq) * 24 + grp * 8 + hd]; sc[i] = s; }
            mx = fmaxf(mx, sc[i]); }
#pragma unroll
        for (int o = 1; o < 64; o <<= 1) mx = fmaxf(mx, __shfl_xor(mx, o));
        float sm = 0.f;
#pragma unroll
        for (int i = 0; i < 3; ++i) { const int j = lane + 64 * i; const float p = sc[i] > -1e29f ? expf(sc[i] - mx) : 0.f; if (j < 129) pw[j] = p; sm += p; }
        sm = wave_sum(sm);
        LDS_WAIT();
        float o0 = 0.f, o1 = 0.f;
        for (int j = 0; j < 129; ++j) { const int tk = t + (j - 64) * d; if (tk < 0 || tk >= SEQ) continue; const float p = pw[j]; const bf16_t* vr = base + 2048 + (size_t)tk * NP;
            o0 += p * bf2f(vr[lane]); o1 += p * bf2f(vr[64 + lane]); }
        o0 /= sm; o1 /= sm;
        const float g0 = bf2f(OG[((size_t)grp * SEQ + t) * DM + hd * 128 + lane]), g1 = bf2f(OG[((size_t)grp * SEQ + t) * DM + hd * 128 + 64 + lane]);
        if (bad_l2((o0 - g0) * (o0 - g0) + (o1 - g1) * (o1 - g1), o0 * o0 + o1 * o1, 0.03f)) flag(ctl, 5);
        const float lse2 = (mx + logf(sm)) * LOG2E, got = LSE[((size_t)grp * SEQ + t) * 8 + hd];
        if (!(fabsf(lse2 - got) <= 0.05f)) flag(ctl, 6);
        LDS_WAIT();
    }
}
__device__ __forceinline__ void check_u(const Frame& F, int b, unsigned* ctl, const bf16_t* P, const bf16_t* OA, const bf16_t* OG, const float* LSE, const bf16_t* Ub) {
    const int lane = opaque_tid() & 63;
    for (int smp = F.gw; smp < 2048; smp += F.NGW) {
        const int t = hash32(smp * 374761393u + b * 31u + 5u) % SEQ; float e2 = 0.f, r2 = 0.f;
        for (int c = lane; c < DM; c += 64) { const int hd = c >> 7;
            const float l0 = LSE[((size_t)0 * SEQ + t) * 8 + hd], l1 = LSE[((size_t)1 * SEQ + t) * 8 + hd], l2 = LSE[((size_t)2 * SEQ + t) * 8 + hd], mx = fmaxf(l0, fmaxf(l1, l2));
            const float w0 = exp2f(l0 - mx), w1 = exp2f(l1 - mx), w2 = exp2f(l2 - mx), ws_ = w0 + w1 + w2;
            const float ob = (w0 * bf2f(OG[((size_t)0 * SEQ + t) * DM + c]) + w1 * bf2f(OG[((size_t)1 * SEQ + t) * DM + c]) + w2 * bf2f(OG[((size_t)2 * SEQ + t) * DM + c])) / ws_;
            const float ga = 1.f / (1.f + expf(-bf2f(P[(size_t)t * NP + C_GATE + c]))), gb = 1.f / (1.f + expf(-bf2f(P[(size_t)t * NP + C_GATE + 1024 + c])));
            const float ref = ga * bf2f(OA[(size_t)t * DM + c]) + gb * ob, got = bf2f(Ub[(size_t)t * DM + c]); e2 += (ref - got) * (ref - got); r2 += ref * ref; }
        if (bad_l2(e2, r2, 0.01f)) flag(ctl, 7);
    }
}
}
#endif
template <class F>
__device__ __forceinline__ void transpose_item(F colptr, int ldn, bf16_t* WT, int ldk, int k0, int n0, LAS float* scr, int lane) {
    const float* cp = colptr(n0 + (lane & 31));
    float tv[32];
    const float* cpk = cp ? cp + (size_t)(k0 + (lane >> 5)) * ldn : nullptr;
#pragma unroll
    for (int i = 0; i < 32; ++i) tv[i] = cpk ? cpk[(size_t)(2 * i) * ldn] : 0.f;
#pragma unroll
    for (int i = 0; i < 32; ++i) scr[(2 * i + (lane >> 5)) * 33 + (lane & 31)] = tv[i];
    LDS_WAIT(); asm volatile("" ::: "memory");
    const int c = lane & 7;
#pragma unroll
    for (int j = 0; j < 4; ++j) { const int n = (lane >> 3) + 8 * j; const LAS float* s = scr + (8 * c) * 33 + n;
        u32x4 o; o.x = cvt_pk_bf16(s[0 * 33], s[1 * 33]); o.y = cvt_pk_bf16(s[2 * 33], s[3 * 33]); o.z = cvt_pk_bf16(s[4 * 33], s[5 * 33]); o.w = cvt_pk_bf16(s[6 * 33], s[7 * 33]);
        *(u32x4*)(WT + (size_t)(n0 + n) * ldk + k0 + 8 * c) = o; }
    LDS_WAIT(); asm volatile("" ::: "memory");
}

__device__ __forceinline__ void p0_mod(const Frame& F, const float* c, const float* w_ada, const float* b_ada, float* mod) {
    const int tid = opaque_tid(), lane = tid & 63; (void)tid; (void)lane;
    LAS float* red = (LAS float*)F.lds;
    for (int blk = blockIdx.x; blk < 96; blk += F.G) {
        const int col = blk * 64 + (tid & 63), ks = tid >> 6;
        float a0 = 0.f, a1 = 0.f, a2 = 0.f, a3 = 0.f;
        for (int k = ks * 128; k < ks * 128 + 128; ++k) {
            const float w = w_ada[(size_t)k * 6144 + col];
            const float c0 = c[k], c1 = c[1024 + k], c2 = c[2048 + k], c3 = c[3072 + k];
            a0 += c0 * fast_sigmoid(c0) * w; a1 += c1 * fast_sigmoid(c1) * w; a2 += c2 * fast_sigmoid(c2) * w; a3 += c3 * fast_sigmoid(c3) * w;
        }
        red[(ks * 4 + 0) * 64 + (tid & 63)] = a0; red[(ks * 4 + 1) * 64 + (tid & 63)] = a1; red[(ks * 4 + 2) * 64 + (tid & 63)] = a2; red[(ks * 4 + 3) * 64 + (tid & 63)] = a3;
        __syncthreads();
        if (tid < 256) { const int b = tid >> 6, cc = tid & 63; float s = 0.f;
#pragma unroll
            for (int q = 0; q < 8; ++q) s += red[(q * 4 + b) * 64 + cc];
            mod[b * 6144 + blk * 64 + cc] = s + b_ada[blk * 64 + cc]; }
        __syncthreads();
    }
}
__device__ __forceinline__ void p0_cs(const Frame& F, const int* pos, float* cs) {
    const int tid = opaque_tid(), lane = tid & 63; (void)tid; (void)lane;
    for (int i = (int)blockIdx.x * 512 + tid; i < NTOK * 32; i += F.G * 512) {
        const int t = i >> 5, j = i & 31;
        const float inv = __builtin_amdgcn_exp2f(-(float)(2 * j) / 64.f * 13.287712379549449f);
        const float ang = (float)pos[t] * inv;
        const double rev = (double)ang * 0.15915494309189535; const double fr = rev - __builtin_rint(rev);
        const float f = (float)fr;
        f32x2 o; o.x = __builtin_amdgcn_cosf(f); o.y = __builtin_amdgcn_sinf(f);
        *(f32x2*)(cs + (size_t)i * 2) = o;
    }
}
__device__ __forceinline__ void p0_weights(const Frame& F, const float* w_in, const float* w_uq, const float* w_ukv, const float* w_out, unsigned char* ws) {
    const int tid = opaque_tid(), lane = tid & 63; (void)tid; (void)lane;
    LAS float* scr = (LAS float*)(F.lds + F.wave * 16384);
    constexpr int I_IN = 16 * 376, I_UQ = 6 * 48, I_UKV = 4 * 64, I_OUT = 16 * 32;
    for (int it = F.gw; it < I_IN + I_UQ + I_UKV + I_OUT; it += F.NGW) {
        int r = it;
        if (r < I_IN) { const int kb = r / 376, nb = r % 376;
            transpose_item([=](int n) -> const float* { return n < D_IN ? w_in + n : nullptr; }, D_IN, (bf16_t*)(ws + WS_WIN), 1024, kb * 64, nb * 32, scr, lane); continue; }
        r -= I_IN;
        if (r < I_UQ) { const int kb = r / 48, nb = r % 48;
            transpose_item([=](int n) -> const float* { const int hd = n / 192, w = n - hd * 192; const int sc = w < 128 ? w : 128 + ((w - 128) >> 1) + 32 * ((w - 128) & 1); return w_uq + hd * 192 + sc; },
                           1536, (bf16_t*)(ws + WS_WUQ), 384, kb * 64, nb * 32, scr, lane); continue; }
        r -= I_UQ;
        if (r < I_UKV) { const int kb = r / 64, nb = r % 64;
            transpose_item([=](int n) -> const float* { return w_ukv + n; }, 2048, (bf16_t*)(ws + WS_WUKV), 256, kb * 64, nb * 32, scr, lane); continue; }
        r -= I_UKV;
        { const int kb = r / 32, nb = r % 32;
            transpose_item([=](int n) -> const float* { return w_out + n; }, 1024, (bf16_t*)(ws + WS_WOUT), 1024, kb * 64, nb * 32, scr, lane); }
    }
}
__device__ __forceinline__ void conv_experts(const Frame& F, const float* w_gate, const float* w_up, const float* w_down, unsigned char* ws) {
    const int tid = opaque_tid(), lane = tid & 63; (void)tid; (void)lane;
    LAS float* scr = (LAS float*)(F.lds + F.wave * 16384);
    for (int it = F.gw; it < NE * 3072; it += F.NGW) {
        const int e = it / 3072; int r = it % 3072;
        if (r < 2048) { const int kb = r / 128, nb = r % 128;
            const float* wg = w_gate + (size_t)e * DM * DFF; const float* wu = w_up + (size_t)e * DM * DFF;
            const long du = (const char*)wu - (const char*)wg;
            transpose_item([=](int n) -> const float* { const int grp = n >> 3, q = n & 7; return (const float*)((const char*)wg + (q < 4 ? 0L : du)) + 4 * grp + (q & 3); }, DFF,
                           (bf16_t*)(ws + WS_WGU) + (size_t)e * 4096 * 1024, 1024, kb * 64, nb * 32, scr, lane); continue; }
        r -= 2048;
        { const int kb = r / 32, nb = r % 32; const float* wd = w_down + (size_t)e * DFF * DM;
            transpose_item([=](int n) -> const float* { return wd + n; }, DM, (bf16_t*)(ws + WS_WD) + (size_t)e * 1024 * 2048, 2048, kb * 64, nb * 32, scr, lane); }
    }
}
__device__ __forceinline__ void norm_mod_row(const float* xrow, const float* g, const float* sh, const float* sc, int lane, f32x4 (&v)[4]) {
    float s = 0.f;
#pragma unroll
    for (int j = 0; j < 4; ++j) { v[j] = *(const f32x4*)(xrow + 4 * lane + 256 * j); s += (v[j][0] * v[j][0] + v[j][1] * v[j][1]) + (v[j][2] * v[j][2] + v[j][3] * v[j][3]); }
    const float rstd = 1.0f / sqrtf(wave_sum(s) * (1.f / DM) + NORM_EPS);
#pragma unroll
    for (int j = 0; j < 4; ++j) { const int c = 4 * lane + 256 * j; const f32x4 gg = *(const f32x4*)(g + c), s1 = *(const f32x4*)(sc + c), s0 = *(const f32x4*)(sh + c);
        v[j] = (v[j] * rstd * gg) * (s1 + 1.0f) + s0; }
}
__device__ __forceinline__ void store_row_bf16(bf16_t* orow, int lane, const f32x4 (&v)[4]) {
#pragma unroll
    for (int j = 0; j < 4; ++j) { u32x2 o; o.x = cvt_pk_bf16(v[j][0], v[j][1]); o.y = cvt_pk_bf16(v[j][2], v[j][3]); *(u32x2*)(orow + 4 * lane + 256 * j) = o; }
}
__device__ __forceinline__ void p1_h(const Frame& F, const float* x, const float* g, const float* mod, bf16_t* H) {
    const int tid = opaque_tid(), lane = tid & 63; (void)tid; (void)lane;
    for (int t = F.gw; t < NTOK; t += F.NGW) { const int b = t / SEQ; f32x4 v[4];
        norm_mod_row(x + (size_t)t * DM, g, mod + b * 6144 + 0, mod + b * 6144 + 1024, lane, v);
        store_row_bf16(H + (size_t)t * DM, lane, v); }
}
__device__ __forceinline__ void lb_latent(const Frame& F, const bf16_t* P, const float* gq, const float* gkv, const float* cs, bf16_t* CQN, bf16_t* CKVN, bf16_t* KB) {
    const int tid = opaque_tid(), lane = tid & 63; (void)tid; (void)lane;
    for (int t = F.gw; t < SEQ; t += F.NGW) {
        const bf16_t* pr = P + (size_t)t * NP;
        float q[8], s = 0.f;
        if (lane < 48) { const u32x4 w = *(const u32x4*)(pr + C_CQ + 8 * lane);
            q[0] = bflo(w.x); q[1] = bfhi(w.x); q[2] = bflo(w.y); q[3] = bfhi(w.y); q[4] = bflo(w.z); q[5] = bfhi(w.z); q[6] = bflo(w.w); q[7] = bfhi(w.w);
#pragma unroll
            for (int e = 0; e < 8; ++e) s += q[e] * q[e]; }
        const float rq = 1.0f / sqrtf(wave_sum(s) * (1.f / 384.f) + NORM_EPS);
        if (lane < 48) { const f32x4 g0 = *(const f32x4*)(gq + 8 * lane), g1 = *(const f32x4*)(gq + 8 * lane + 4);
            u32x4 o; o.x = cvt_pk_bf16(q[0] * rq * g0[0], q[1] * rq * g0[1]); o.y = cvt_pk_bf16(q[2] * rq * g0[2], q[3] * rq * g0[3]);
            o.z = cvt_pk_bf16(q[4] * rq * g1[0], q[5] * rq * g1[1]); o.w = cvt_pk_bf16(q[6] * rq * g1[2], q[7] * rq * g1[3]);
            *(u32x4*)(CQN + (size_t)t * 384 + 8 * lane) = o; }
        float s2 = 0.f;
        if (lane < 32) { const u32x4 w = *(const u32x4*)(pr + C_CKV + 8 * lane);
            q[0] = bflo(w.x); q[1] = bfhi(w.x); q[2] = bflo(w.y); q[3] = bfhi(w.y); q[4] = bflo(w.z); q[5] = bfhi(w.z); q[6] = bflo(w.w); q[7] = bfhi(w.w);
#pragma unroll
            for (int e = 0; e < 8; ++e) s2 += q[e] * q[e]; }
        const float rk = 1.0f / sqrtf(wave_sum(s2) * (1.f / 256.f) + NORM_EPS);
        if (lane < 32) { const f32x4 g0 = *(const f32x4*)(gkv + 8 * lane), g1 = *(const f32x4*)(gkv + 8 * lane + 4);
            u32x4 o; o.x = cvt_pk_bf16(q[0] * rk * g0[0], q[1] * rk * g0[1]); o.y = cvt_pk_bf16(q[2] * rk * g0[2], q[3] * rk * g0[3]);
            o.z = cvt_pk_bf16(q[4] * rk * g1[0], q[5] * rk * g1[1]); o.w = cvt_pk_bf16(q[6] * rk * g1[2], q[7] * rk * g1[3]);
            *(u32x4*)(CKVN + (size_t)t * 256 + 8 * lane) = o;
            const float x1 = bf2f(pr[C_KPE + lane]), x2 = bf2f(pr[C_KPE + 32 + lane]); const f32x2 c = *(const f32x2*)(cs + ((size_t)t * 32 + lane) * 2);
            const unsigned pk = cvt_pk_bf16(x1 * c.x - x2 * c.y, x1 * c.y + x2 * c.x);
#pragma unroll
            for (int h = 0; h < 8; ++h) *(unsigned*)(KB + ((size_t)h * SEQ + t) * 192 + 128 + 2 * lane) = pk; }
    }
}
__device__ __forceinline__ void lb_combine(const Frame& F, const bf16_t* P, const bf16_t* OA, const bf16_t* OG, const float* LSE, bf16_t* U) {
    const int tid = opaque_tid(), lane = tid & 63; (void)tid; (void)lane;
    for (int t = F.gw; t < SEQ; t += F.NGW) {
#pragma unroll
        for (int j = 0; j < 2; ++j) { const int c0 = 8 * lane + 512 * j, hd = c0 >> 7;
            const float l0 = LSE[((size_t)0 * SEQ + t) * 8 + hd], l1 = LSE[((size_t)1 * SEQ + t) * 8 + hd], l2 = LSE[((size_t)2 * SEQ + t) * 8 + hd];
            const float mx = fmaxf(l0, fmaxf(l1, l2)); float w0 = __builtin_amdgcn_exp2f(l0 - mx), w1 = __builtin_amdgcn_exp2f(l1 - mx), w2 = __builtin_amdgcn_exp2f(l2 - mx);
            const float inv = 1.0f / (w0 + w1 + w2); w0 *= inv; w1 *= inv; w2 *= inv;
            const u32x4 oa = *(const u32x4*)(OA + (size_t)t * DM + c0), g0 = *(const u32x4*)(OG + ((size_t)0 * SEQ + t) * DM + c0), g1 = *(const u32x4*)(OG + ((size_t)1 * SEQ + t) * DM + c0),
                        g2 = *(const u32x4*)(OG + ((size_t)2 * SEQ + t) * DM + c0), ga = *(const u32x4*)(P + (size_t)t * NP + C_GATE + c0), gb = *(const u32x4*)(P + (size_t)t * NP + C_GATE + 1024 + c0);
            u32x4 o;
#pragma unroll
            for (int e = 0; e < 4; ++e) {
                const float ob_lo = w0 * bflo(g0[e]) + w1 * bflo(g1[e]) + w2 * bflo(g2[e]), ob_hi = w0 * bfhi(g0[e]) + w1 * bfhi(g1[e]) + w2 * bfhi(g2[e]);
                const float u_lo = fast_sigmoid(bflo(ga[e])) * bflo(oa[e]) + fast_sigmoid(bflo(gb[e])) * ob_lo;
                const float u_hi = fast_sigmoid(bfhi(ga[e])) * bfhi(oa[e]) + fast_sigmoid(bfhi(gb[e])) * ob_hi;
                o[e] = cvt_pk_bf16(u_lo, u_hi); }
            *(u32x4*)(U + (size_t)t * DM + c0) = o; }
    }
}
__device__ __forceinline__ void pg_h2_router(const Frame& F, const float* x1, const float* g, const float* mod, const float* w_router, bf16_t* H2, float* AFFT) {
    const int tid = opaque_tid(), lane = tid & 63; (void)tid;
    LAS float* wr = (LAS float*)F.lds;
    LAS float* ab = (LAS float*)(F.lds + 65536) + F.wave * 256;
    for (int i = tid; i < 1024 * 16 / 4; i += 512) ((LAS f32x4*)wr)[i] = ((const f32x4*)w_router)[i];
    __syncthreads();
    for (int ch = F.gw; ch < NTOK / 16; ch += F.NGW) {
        const int t0 = ch * 16, b = t0 / SEQ, s0 = t0 % SEQ;
#pragma unroll 1
        for (int ti = 0; ti < 16; ++ti) { const int t = t0 + ti; f32x4 v[4];
            norm_mod_row(x1 + (size_t)t * DM, g, mod + b * 6144 + 3072, mod + b * 6144 + 4096, lane, v);
            store_row_bf16(H2 + (size_t)t * DM, lane, v);
            float lg[16];
#pragma unroll
            for (int e = 0; e < 16; ++e) lg[e] = 0.f;
#pragma unroll
            for (int j = 0; j < 4; ++j)
#pragma unroll
                for (int q = 0; q < 4; ++q) { const LAS f32x4* wp = (const LAS f32x4*)(wr + (4 * lane + 256 * j + q) * 16); const float hv = v[j][q];
#pragma unroll
                    for (int e4 = 0; e4 < 4; ++e4) { const f32x4 w = wp[e4]; lg[4 * e4 + 0] += hv * w[0]; lg[4 * e4 + 1] += hv * w[1]; lg[4 * e4 + 2] += hv * w[2]; lg[4 * e4 + 3] += hv * w[3]; } }
            float mx = -1e30f;
#pragma unroll
            for (int e = 0; e < 16; ++e) { lg[e] = wave_sum(lg[e]); mx = fmaxf(mx, lg[e]); }
            float sum = 0.f;
#pragma unroll
            for (int e = 0; e < 16; ++e) { lg[e] = __expf(lg[e] - mx); sum += lg[e]; }
            const float inv = 1.0f / sum; float mine = 0.f;
#pragma unroll
            for (int e = 0; e < 16; ++e) mine = (lane == e) ? lg[e] * inv : mine;
            if (lane < 16) ab[lane * 16 + ti] = mine;
        }
        LDS_WAIT();
        { const int e = lane >> 2, q4 = (lane & 3) * 4; const f32x4 w = *(const LAS f32x4*)(ab + e * 16 + q4);
          *(f32x4*)(AFFT + ((size_t)b * NE + e) * SEQ + s0 + q4) = w; }
        LDS_WAIT();
    }
    __syncthreads();
}
__device__ __forceinline__ void ph_topk(const Frame& F, const float* AFFT, int* TOPI, float* TOPG, int* SLOT) {
    const int tid = opaque_tid(), lane = tid & 63;
    LAS unsigned* cnt = (LAS unsigned*)F.lds;
    LAS unsigned* wtot = cnt + 64;
    for (int p = blockIdx.x; p < NB * NE; p += F.G) {
        const float* src = AFFT + (size_t)p * SEQ + 16 * tid;
        unsigned key[16];
#pragma unroll
        for (int j = 0; j < 4; ++j) { const u32x4 w = *(const u32x4*)(src + 4 * j); key[4 * j] = w.x; key[4 * j + 1] = w.y; key[4 * j + 2] = w.z; key[4 * j + 3] = w.w; }
        unsigned thr = 0u;
#pragma unroll 1
        for (int bit = 30; bit >= 0; --bit) { const unsigned cand = thr | (1u << bit); unsigned c = 0;
#pragma unroll
            for (int i = 0; i < 16; ++i) c += (unsigned)__builtin_popcountll(__ballot(key[i] >= cand));
            LAS unsigned* slot = cnt + ((bit & 1) << 3);
            if (lane == 0) slot[F.wave] = c;
            __syncthreads();
            unsigned tot = 0;
#pragma unroll
            for (int w = 0; w < 8; ++w) tot += slot[w];
            if (tot >= (unsigned)CAP) thr = cand; }
        unsigned ngt = 0, neq = 0;
#pragma unroll
        for (int i = 0; i < 16; ++i) { ngt += key[i] > thr ? 1u : 0u; neq += key[i] == thr ? 1u : 0u; }
        unsigned pk = ngt | (neq << 16), inc = pk;
#pragma unroll
        for (int o = 1; o < 64; o <<= 1) { const unsigned v = __shfl_up(inc, o); if (lane >= o) inc += v; }
        __syncthreads();
        if (lane == 63) wtot[F.wave] = inc;
        __syncthreads();
        unsigned base = 0, all = 0;
        for (int w = 0; w < 8; ++w) { const unsigned v = wtot[w]; all += v; if (w < F.wave) base += v; }
        const unsigned tot_gt = all & 0xffffu, need = (unsigned)CAP - tot_gt;
        const unsigned excl = base + inc - pk; unsigned g_before = excl & 0xffffu, e_before = excl >> 16;
#pragma unroll
        for (int i = 0; i < 16; ++i) { const int s = 16 * tid + i; int slot = -1;
            if (key[i] > thr) { slot = (int)g_before; ++g_before; }
            else if (key[i] == thr) { if (e_before < need) slot = (int)(tot_gt + e_before); ++e_before; }
            SLOT[(size_t)p * SEQ + s] = slot;
            if (slot >= 0) { TOPI[p * CAP + slot] = s; TOPG[p * CAP + slot] = __uint_as_float(key[i]); } }
        __syncthreads();
    }
}
__device__ __forceinline__ void p_final(const Frame& F, int b, float* out, const float* mod, const int* SLOT, const bf16_t* Y, const float* gfin, float oscale) {
    const int tid = opaque_tid(), lane = tid & 63; (void)tid; (void)lane;
    for (int s = F.gw; s < SEQ; s += F.NGW) { float* row = out + ((size_t)b * SEQ + s) * DM;
        int sl = -1; if (lane < NE) sl = SLOT[((size_t)b * NE + lane) * SEQ + s];
        unsigned long long m = __ballot(sl >= 0);
        f32x4 acc[4];
#pragma unroll
        for (int j = 0; j < 4; ++j) acc[j] = (f32x4){0.f, 0.f, 0.f, 0.f};
        while (m) { const int e = __builtin_ctzll(m); m &= m - 1; const int slot = __builtin_amdgcn_readlane(sl, e);
            const bf16_t* yr = Y + ((size_t)e * CAP + slot) * DM;
#pragma unroll
            for (int j = 0; j < 4; ++j) { const u32x2 w = *(const u32x2*)(yr + 4 * lane + 256 * j); acc[j][0] += bflo(w.x); acc[j][1] += bfhi(w.x); acc[j][2] += bflo(w.y); acc[j][3] += bfhi(w.y); } }
        f32x4 v[4]; float ss = 0.f;
#pragma unroll
        for (int j = 0; j < 4; ++j) { const int c = 4 * lane + 256 * j; const f32x4 gt = *(const f32x4*)(mod + b * 6144 + 5120 + c);
            v[j] = *(const f32x4*)(row + c) + gt * acc[j]; ss += (v[j][0] * v[j][0] + v[j][1] * v[j][1]) + (v[j][2] * v[j][2] + v[j][3] * v[j][3]); }
        const float rstd = 1.0f / sqrtf(wave_sum(ss) * (1.f / DM) + NORM_EPS);
#pragma unroll
        for (int j = 0; j < 4; ++j) { const int c = 4 * lane + 256 * j; *(f32x4*)(row + c) = v[j] * (rstd * oscale) * *(const f32x4*)(gfin + c); }
    }
}

__global__ void __launch_bounds__(NWAVES * 64, 2) fwd_kernel(Args args) {
    extern __shared__ __attribute__((aligned(16))) unsigned char lds_raw[];
    Frame F;
    F.lds = (LAS unsigned char*)lds_raw;
    F.tid = threadIdx.x; F.lane = F.tid & 63; F.wave = __builtin_amdgcn_readfirstlane(F.tid >> 6);
    F.G = gridDim.x; { const int bx = blockIdx.x; F.vcu = (F.G % 8 == 0) ? (bx % 8) * (F.G / 8) + bx / 8 : bx; }
    F.gw = F.vcu * NWAVES + F.wave; F.NGW = F.G * NWAVES;
    unsigned char* ws = args.ws;
    volatile LAS unsigned* MISC = (volatile LAS unsigned*)(F.lds + MISC_OFF);
    for (int u = F.tid; u < (LDS_BYTES - RING_BYTES) / 4; u += NWAVES * 64) ((LAS unsigned*)(F.lds + RING_BYTES))[u] = 0u;
    __syncthreads();
    unsigned* ctl = (unsigned*)(ws + WS_CTL);
    XcdBarrier bar = xcd_barrier_post(ctl + CW_BAR, MISC + 8);

#define IN_F(k) ((const float*)args.in[k])
#define in_x IN_F(0)
#define cin IN_F(1)
#define positions ((const int*)args.in[2])
#define w_ada IN_F(3)
#define b_ada IN_F(4)
#define g_mix IN_F(5)
#define w_in IN_F(6)
#define g_q IN_F(7)
#define g_kv IN_F(8)
#define w_uq IN_F(9)
#define w_ukv IN_F(10)
#define rel_bias IN_F(11)
#define w_out IN_F(12)
#define g_ffn IN_F(13)
#define w_router IN_F(14)
#define w_gate IN_F(15)
#define w_up IN_F(16)
#define w_down IN_F(17)
#define g_final IN_F(18)
#define t_out (args.out)
#define WSP(T, off) ((T*)(args.ws + (off)))
#define MOD WSP(float, WS_MOD)
#define CS WSP(float, WS_CS)
#define WIN WSP(bf16_t, WS_WIN)
#define WUQ WSP(bf16_t, WS_WUQ)
#define WUKV WSP(bf16_t, WS_WUKV)
#define WOUT WSP(bf16_t, WS_WOUT)
#define t_H WSP(bf16_t, WS_H)
#define t_U WSP(bf16_t, WS_U)
#define t_P WSP(bf16_t, WS_P)
#define CQN WSP(bf16_t, WS_CQN)
#define CKVN WSP(bf16_t, WS_CKVN)
#define QB WSP(bf16_t, WS_QB)
#define KB WSP(bf16_t, WS_KB)
#define VB WSP(bf16_t, WS_VB)
#define OA WSP(bf16_t, WS_OA)
#define OG WSP(bf16_t, WS_OG)
#define LSE WSP(float, WS_LSE)
#define WGU WSP(bf16_t, WS_WGU)
#define WD WSP(bf16_t, WS_WD)
#define HID WSP(bf16_t, WS_HID)
#define t_Y WSP(bf16_t, WS_Y)
#define AFFT WSP(float, WS_AFFT)
#define TOPI WSP(int, WS_TOPI)
#define TOPG WSP(float, WS_TOPG)
#define SLOT WSP(int, WS_SLOT)

#ifndef PH_MASK
#define PH_MASK 0xFFFFFFFFu
#endif
#define PH_ON(k) constexpr (((PH_MASK) >> (k)) & 1u)
#ifndef DUP_MASK
#define DUP_MASK 0u
#endif
#define PH_REP(k) for (int rep_ = 0; rep_ < ((((DUP_MASK) >> (k)) & 1u) ? 2 : 1); ++rep_)
#if defined(MK_CHECK) && MK_CHECK
#define DBG_SCALE() ([&]() -> float { const unsigned f_ = __hip_atomic_load(ctl + CW_DBG, RLX_AGENT); return f_ ? 1.0f + 0.05f * (float)(1 + __builtin_ctz(f_)) : 1.0f; }())
#else
#define DBG_SCALE() 1.0f
#endif
    int step = 0; const int lo = args.st_lo, hi = args.st_hi;
#define STEP_BEGIN if (step >= lo && step < hi) {
#define STEP_END if (step + 1 < hi) xcd_barrier(bar); } ++step;

    STEP_BEGIN
        if PH_ON(0) PH_REP(0) { p0_mod(F, cin, w_ada, b_ada, MOD);
        p0_cs(F, positions, CS);
        p0_weights(F, w_in, w_uq, w_ukv, w_out, ws); }
    STEP_END
    STEP_BEGIN
        if PH_ON(1) PH_REP(1) p1_h(F, in_x, g_mix, MOD, t_H);
    STEP_END
    for (int b = 0; b < NB; ++b) {
        STEP_BEGIN
            pg8::Gemm g{t_H + (size_t)b * SEQ * DM, WIN, DM, DM, DM, 0, 0, nullptr, 0}; pg8::StaticOrder S; S.init(SEQ, NP, F.G, (int)blockIdx.x);
            pg8::EpiBf16 E{t_P, NP};
            if PH_ON(2) PH_REP(2) { pg8::gemm_phase<pg8::EpiBf16, pg8::StaticOrder, false>(F.lds, g, S, E); __syncthreads(); }
        STEP_END
        STEP_BEGIN
            if PH_ON(3) PH_REP(3) lb_latent(F, t_P, g_q, g_kv, CS + (size_t)b * SEQ * 64, CQN, CKVN, KB);
        STEP_END
        STEP_BEGIN
            { pg8::Gemm g{CQN, WUQ, 384, 384, 384, 0, 0, nullptr, 0}; pg8::StaticOrder S; S.init(SEQ, 1536, F.G, (int)blockIdx.x);
              pg8::EpiQ E{QB, CS + (size_t)b * SEQ * 64};
              if PH_ON(4) PH_REP(4) { pg8::gemm_phase<pg8::EpiQ, pg8::StaticOrder, false>(F.lds, g, S, E); __syncthreads(); } }
            __syncthreads();
            { pg8::Gemm g{CKVN, WUKV, 256, 256, 256, 0, 0, nullptr, 0}; pg8::StaticOrder S; S.init(SEQ, 2048, F.G, (int)blockIdx.x);
              pg8::EpiKV E{KB, VB};
              if PH_ON(5) PH_REP(5) { pg8::gemm_phase<pg8::EpiKV, pg8::StaticOrder, false>(F.lds, g, S, E); __syncthreads(); } }
        STEP_END
        STEP_BEGIN
            for (int u = blockIdx.x; u < 256; u += F.G) { const int hd = u & 7, qb = u >> 3;
                att::Unit a{};
                a.Q = QB + ((size_t)hd * SEQ + 256 * qb) * 192; a.qs = 192; a.K = KB + (size_t)hd * SEQ * 192; a.ks = 192; a.V = VB + (size_t)hd * SEQ * 128; a.vs = 128;
                a.O = OA + (size_t)(256 * qb) * DM + hd * 128; a.os = DM; a.nt = SEQ / 64;
#if defined(BREAK_MLA) && BREAK_MLA
                a.nt = SEQ / 64 - 2;
#endif
                if PH_ON(6) PH_REP(6) att::attn_unit<false>(a, (LAS char*)F.lds); }
            for (int u = blockIdx.x; u < 768; u += F.G) { const int grp = u >> 8, w = u & 255, hd = w & 7, rest = w >> 3, d = grp == 0 ? 1 : (grp == 1 ? 4 : 16), cl = rest % d, qb = rest / d;
                att::Unit a{};
                const size_t tok0 = (size_t)256 * qb * d + cl; const bf16_t* base = t_P + C_DIL + grp * 3072 + hd * 128;
                a.Q = base + tok0 * NP; a.qs = d * NP; a.K = base + 1024 + (size_t)cl * NP; a.ks = d * NP; a.V = base + 2048 + (size_t)cl * NP; a.vs = d * NP;
                a.O = OG + ((size_t)grp * SEQ + tok0) * DM + hd * 128; a.os = d * DM; a.nt = 6;
                a.kt0 = 4 * qb - 1; a.ktn = (SEQ / d) / 64; a.l0 = 256 * qb; a.pos = positions + (size_t)b * SEQ + cl; a.ps = d;
                a.lse = LSE + ((size_t)grp * SEQ + tok0) * 8 + hd; a.ls = d * 8; a.bias = rel_bias + grp * 8 + hd;
                if PH_ON(7) PH_REP(7) att::attn_unit<true>(a, (LAS char*)F.lds); }
        STEP_END
        STEP_BEGIN
            if PH_ON(8) PH_REP(8) lb_combine(F, t_P, OA, OG, LSE, t_U + (size_t)b * SEQ * DM);
        STEP_END
#if defined(MK_CHECK) && MK_CHECK
        STEP_BEGIN
#if !defined(CHK_MEASURE)
            chk::check_proj(F, b, ctl, t_P, CQN, CKVN, QB, KB, VB, g_q, g_kv, w_uq, w_ukv, positions);
            chk::check_dil(F, b, ctl, t_P, positions, rel_bias, OG, LSE);
            chk::check_u(F, b, ctl, t_P, OA, OG, LSE, t_U + (size_t)b * SEQ * DM);
#endif
            chk::check_mla(F, b, ctl, QB, KB, VB, OA);
        STEP_END
#endif
    }
    STEP_BEGIN
        { pg8::Gemm g{t_U, WOUT, DM, DM, DM, 0, 0, nullptr, 0}; pg8::StaticOrder S; S.init(NTOK, DM, F.G, (int)blockIdx.x);
          pg8::EpiRes E{in_x, t_out, MOD};
          if PH_ON(9) PH_REP(9) { pg8::gemm_phase<pg8::EpiRes, pg8::StaticOrder, false>(F.lds, g, S, E); __syncthreads(); } }
        __syncthreads();
        if PH_ON(10) PH_REP(10) conv_experts(F, w_gate, w_up, w_down, ws);
    STEP_END
    STEP_BEGIN
        if PH_ON(11) PH_REP(11) pg_h2_router(F, t_out, g_ffn, MOD, w_router, t_H, AFFT);
    STEP_END
    STEP_BEGIN
        if PH_ON(12) PH_REP(12) ph_topk(F, AFFT, TOPI, TOPG, SLOT);
    STEP_END
    for (int b = 0; b < NB; ++b) {
        STEP_BEGIN
            { pg8::Gemm g{t_H + (size_t)b * SEQ * DM, WGU, DM, DM, DM, 0, (long)4096 * 1024, TOPI + b * NE * CAP, CAP}; pg8::GroupOrder S; S.init(4, 16, NE, F.G, (int)blockIdx.x);
              pg8::EpiSwiGLU E{HID};
              if PH_ON(13) PH_REP(13) { pg8::gemm_phase<pg8::EpiSwiGLU, pg8::GroupOrder, true>(F.lds, g, S, E); __syncthreads(); } }
            if PH_ON(15) { if (b > 0) p_final(F, b - 1, t_out, MOD, SLOT, t_Y, g_final, DBG_SCALE()); }
        STEP_END
        STEP_BEGIN
            { pg8::Gemm g{HID, WD, DFF, DFF, DFF, (long)CAP * DFF, (long)DM * DFF, nullptr, 0}; pg8::GroupOrder S; S.init(4, 4, NE, F.G, (int)blockIdx.x);
              pg8::EpiDown E{t_Y, TOPG + b * NE * CAP};
              if PH_ON(14) PH_REP(14) { pg8::gemm_phase<pg8::EpiDown, pg8::GroupOrder, false>(F.lds, g, S, E); __syncthreads(); } }
        STEP_END
    }
    STEP_BEGIN
        if PH_ON(15) p_final(F, NB - 1, t_out, MOD, SLOT, t_Y, g_final, DBG_SCALE());
    STEP_END
#undef STEP_BEGIN
#undef STEP_END
}
#undef IN_F
#undef in_x
#undef cin
#undef positions
#undef w_ada
#undef b_ada
#undef g_mix
#undef w_in
#undef g_q
#undef g_kv
#undef w_uq
#undef w_ukv
#undef rel_bias
#undef w_out
#undef g_ffn
#undef w_router
#undef w_gate
#undef w_up
#undef w_down
#undef g_final
#undef t_out
#undef WSP
#undef MOD
#undef CS
#undef WIN
#undef WUQ
#undef WUKV
#undef WOUT
#undef t_H
#undef t_U
#undef t_P
#undef CQN
#undef CKVN
#undef QB
#undef KB
#undef VB
#undef OA
#undef OG
#undef LSE
#undef WGU
#undef WD
#undef HID
#undef t_Y
#undef AFFT
#undef TOPI
#undef TOPG
#undef SLOT
#if defined(MK_CHECK) && MK_CHECK
constexpr int N_STEPS = 2 + NB * 6 + 3 + NB * 2 + 1;
#else
constexpr int N_STEPS = 2 + NB * 5 + 3 + NB * 2 + 1;
#endif

#ifndef MK_PER_STEP
#define MK_PER_STEP 0
#endif
extern "C" void kernel_launch(void* const* d_in, const int* in_sizes, int n_in, void* d_out, int out_size, void* d_ws, size_t ws_size, hipStream_t stream) {
    static int grid = 0;
    if (grid == 0) {
        if (n_in != 19 || out_size != NTOK * DM || ws_size < WS_END) { fprintf(stderr, "kernel_launch: unexpected shapes (n_in %d out %d ws %zu need %zu)\n", n_in, out_size, ws_size, (size_t)WS_END); grid = -1; return; }
        int dev = 0, cus = 0;
        if (hipGetDevice(&dev) != hipSuccess || hipDeviceGetAttribute(&cus, hipDeviceAttributeMultiprocessorCount, dev) != hipSuccess) { grid = -1; return; }
        if (hipFuncSetAttribute((const void*)fwd_kernel, hipFuncAttributeMaxDynamicSharedMemorySize, LDS_BYTES) != hipSuccess) { grid = -1; return; }
        int per_cu = 0;
        if (hipOccupancyMaxActiveBlocksPerMultiprocessor(&per_cu, (const void*)fwd_kernel, NWAVES * 64, LDS_BYTES) != hipSuccess || per_cu < 1) { fprintf(stderr, "kernel_launch: occupancy query says %d\n", per_cu); }
        (void)hipGetLastError();
        grid = cus;
    }
    if (grid < 0) return;
    if (hipMemsetAsync((char*)d_ws + WS_CTL, 0, CTL_ZERO_BYTES, stream) != hipSuccess) return;
    Args a{};
    for (int i = 0; i < 19; ++i) a.in[i] = d_in[i];
    a.out = (float*)d_out; a.ws = (unsigned char*)d_ws;
#if MK_PER_STEP
    for (int s = 0; s < N_STEPS; ++s) { a.st_lo = s; a.st_hi = s + 1; hipLaunchKernelGGL(fwd_kernel, dim3(grid), dim3(NWAVES * 64), LDS_BYTES, stream, a); }
#else
    a.st_lo = 0; a.st_hi = N_STEPS;
    hipLaunchKernelGGL(fwd_kernel, dim3(grid), dim3(NWAVES * 64), LDS_BYTES, stream, a);
#endif
    const hipError_t le = hipPeekAtLastError();
    if (le != hipSuccess) fprintf(stderr, "kernel_launch: launch failed: %s\n", hipGetErrorName(le));
}
```

```cpp
#include <hip/hip_runtime.h>
#include <cstdio>
#include <cstdint>

#define LAS __attribute__((address_space(3)))
#define GAS __attribute__((address_space(1)))
typedef unsigned short bf16_t;
typedef short bf16x8 __attribute__((ext_vector_type(8)));
typedef short s16x4 __attribute__((ext_vector_type(4)));
typedef float f32x2 __attribute__((ext_vector_type(2)));
typedef float f32x4 __attribute__((ext_vector_type(4)));
typedef float f32x16 __attribute__((ext_vector_type(16)));
typedef unsigned u32x2 __attribute__((ext_vector_type(2)));
typedef unsigned u32x4 __attribute__((ext_vector_type(4)));
typedef int i32x4 __attribute__((ext_vector_type(4)));

constexpr int NB = 4, SEQ = 8192, DM = 1024, NTOK = NB * SEQ;
constexpr int NP = 12032;
constexpr int C_CQ = 0, C_CKV = 384, C_KPE = 640, C_DIL = 704, C_GATE = 9920, D_IN = 11968;
constexpr int NE = 16, CAP = 1024, DFF = 2048;
constexpr float NORM_EPS = 1e-6f;
constexpr float LOG2E = 1.4426950408889634f;

constexpr size_t MiB = 1u << 20;
constexpr size_t WS_CTL = 0, CTL_ZERO_BYTES = 1 * MiB;
constexpr size_t WS_MOD = 1 * MiB;
constexpr size_t WS_CS = 2 * MiB;
constexpr size_t WS_WIN = 10 * MiB;
constexpr size_t WS_WUQ = 34 * MiB;
constexpr size_t WS_WUKV = 36 * MiB;
constexpr size_t WS_WOUT = 37 * MiB;
constexpr size_t WS_H = 40 * MiB;
constexpr size_t WS_U = 104 * MiB;
constexpr size_t WS_R = 168 * MiB;
constexpr size_t WS_P = WS_R;
constexpr size_t WS_CQN = WS_R + 188 * MiB;
constexpr size_t WS_CKVN = WS_R + 194 * MiB;
constexpr size_t WS_QB = WS_R + 198 * MiB;
constexpr size_t WS_KB = WS_R + 222 * MiB;
constexpr size_t WS_VB = WS_R + 246 * MiB;
constexpr size_t WS_OA = WS_R + 262 * MiB;
constexpr size_t WS_OG = WS_R + 278 * MiB;
constexpr size_t WS_LSE = WS_R + 326 * MiB;
constexpr size_t WS_WGU = WS_R;
constexpr size_t WS_WD = WS_R + 128 * MiB;
constexpr size_t WS_HID = WS_R + 192 * MiB;
constexpr size_t WS_Y = WS_R + 256 * MiB;
constexpr size_t WS_AFFT = WS_R + 288 * MiB;
constexpr size_t WS_TOPI = WS_R + 290 * MiB;
constexpr size_t WS_TOPG = WS_R + 291 * MiB;
constexpr size_t WS_SLOT = WS_R + 292 * MiB;
constexpr size_t WS_END = WS_R + 327 * MiB;
constexpr int CW_TMO = 0, CW_DBG = 16, CW_BAR = 4096;

constexpr int RING_BYTES = 131072;
constexpr int MISC_OFF = RING_BYTES + 320;
constexpr int LDS_BYTES = 147456;
constexpr int NWAVES = 8;

#define RLX_AGENT __ATOMIC_RELAXED, __HIP_MEMORY_SCOPE_AGENT
#define LDS_WAIT() asm volatile("s_waitcnt lgkmcnt(0)" ::: "memory")
#define VM_WAIT() asm volatile("s_waitcnt vmcnt(0)" ::: "memory")

__device__ __forceinline__ unsigned cvt_pk_bf16(float lo, float hi) { unsigned r; asm volatile("v_cvt_pk_bf16_f32 %0, %1, %2" : "=v"(r) : "v"(lo), "v"(hi)); return r; }
__device__ __forceinline__ float bf2f(unsigned short v) { return __uint_as_float(((unsigned)v) << 16); }
__device__ __forceinline__ float bflo(unsigned w) { return __uint_as_float(w << 16); }
__device__ __forceinline__ float bfhi(unsigned w) { return __uint_as_float(w & 0xffff0000u); }
__device__ __forceinline__ float wave_sum(float v) {
#pragma unroll
    for (int o = 1; o < 64; o <<= 1) v += __shfl_xor(v, o);
    return v;
}
__device__ __forceinline__ float fast_sigmoid(float x) { return __builtin_amdgcn_rcpf(1.f + __builtin_amdgcn_exp2f(-x * LOG2E)); }
__device__ __forceinline__ int opaque_tid() { int t = (int)threadIdx.x; asm volatile("" : "+v"(t)); return t; }
struct Frame {
    LAS unsigned char* lds;
    int tid, lane, wave, vcu, G, gw, NGW;
};
struct Args { const void* in[19]; float* out; unsigned char* ws; int st_lo, st_hi; };

#define XB_TMO      128
#define XB_XCNT(j)  (256  + 64 * (j))
#define XB_XSUB(j)  (1280 + 64 * (j))
#define XB_XGEN(j)  (2304 + 64 * (j))
#define XB_TOP      3328
#define XB_TOPGEN   3392
#define XCD_BAR_WORDS 3456
#define XB_SPIN_CAP (1u << 18)

__device__ __forceinline__ unsigned xb_ld(unsigned* p)              { return __hip_atomic_load(p, __ATOMIC_RELAXED, __HIP_MEMORY_SCOPE_AGENT); }
__device__ __forceinline__ unsigned xb_add(unsigned* p, unsigned v) { return __hip_atomic_fetch_add(p, v, __ATOMIC_RELAXED, __HIP_MEMORY_SCOPE_AGENT); }
__device__ __forceinline__ unsigned xb_xcc_id() { return (unsigned)__builtin_amdgcn_s_getreg((3 << 11) | 20) & 0xFu; }
#define XB_SPIN(cond, bar) do { unsigned _sp = 0; while (cond) { __builtin_amdgcn_s_sleep(1); \
    if ((++_sp & 255u) == 0u) { if (xb_ld(&(bar)[XB_TMO])) break; if (_sp > XB_SPIN_CAP) { atomicAdd(&(bar)[XB_TMO], 1u); break; } } } } while (0)

struct XcdBarrier {
    unsigned* bar; unsigned x;
    volatile LAS unsigned* st;
};

__device__ __forceinline__ XcdBarrier xcd_barrier_post(unsigned* bar, volatile LAS unsigned* st) {
    XcdBarrier b; b.bar = bar; b.x = xb_xcc_id(); b.st = st;
    if (threadIdx.x == 0) (void)xb_add(&bar[XB_XCNT(b.x)], 1u);
    return b;
}
__device__ __forceinline__ void xcd_barrier_complete(unsigned* bar, unsigned x, unsigned& nloc, unsigned& nx) {
    const unsigned G = gridDim.x * gridDim.y * gridDim.z;
    unsigned sum, cnt, mine, sp = 0u;
    for (;;) {
        sum = 0u; cnt = 0u; mine = 0u;
#pragma unroll
        for (unsigned j = 0; j < 16; ++j) { const unsigned c = xb_ld(&bar[XB_XCNT(j)]); sum += c; cnt += (c > 0u) ? 1u : 0u; mine = (j == x) ? c : mine; }
        if (sum == G) break;
        __builtin_amdgcn_s_sleep(1);
        if ((++sp & 255u) == 0u) { if (xb_ld(&bar[XB_TMO])) break; if (sp > XB_SPIN_CAP) { atomicAdd(&bar[XB_TMO], 1u); break; } }
    }
    nloc = mine > 0u ? mine : 1u; nx = cnt > 0u ? cnt : 1u;
}

__device__ __forceinline__ void xcd_barrier(const XcdBarrier& b) {
    asm volatile("s_waitcnt vmcnt(0)" ::: "memory");
    __syncthreads();
    if (threadIdx.x == 0) {
        unsigned* bar = b.bar;
        __builtin_amdgcn_s_waitcnt(0);
        unsigned nloc = b.st[0], nx = b.st[1];
        if (nloc == 0u) { xcd_barrier_complete(bar, b.x, nloc, nx); b.st[0] = nloc; b.st[1] = nx; }
        const unsigned old = xb_add(&bar[XB_XSUB(b.x)], 1u);
        const unsigned gen = old / nloc;
        if (old + 1u == (gen + 1u) * nloc) {
            __builtin_amdgcn_fence(__ATOMIC_RELEASE, "agent");
            asm volatile("s_waitcnt vmcnt(0)" ::: "memory");
            const unsigned og = xb_add(&bar[XB_TOP], 1u);
            const unsigned tg = og / nx;
            if (og + 1u == (tg + 1u) * nx) xb_add(&bar[XB_TOPGEN], 1u);
            else XB_SPIN(xb_ld(&bar[XB_TOPGEN]) == tg, bar);
            __builtin_amdgcn_fence(__ATOMIC_ACQUIRE, "agent");
            xb_add(&bar[XB_XGEN(b.x)], 1u);
            asm volatile("s_waitcnt vmcnt(0)" ::: "memory");
        } else {
            XB_SPIN(xb_ld(&bar[XB_XGEN(b.x)]) == gen, bar);
            __builtin_amdgcn_fence(__ATOMIC_ACQUIRE, "agent");
            asm volatile("s_waitcnt vmcnt(0)" ::: "memory");
        }
    }
    __syncthreads();
}

namespace pg8 {
constexpr int BM = 256, BK = 64, HALF = 128, HTB = HALF * BK * 2  , STAGE_BYTES = 8 * HTB, NXCD = 8, WGM = 8;

__host__ __device__ __forceinline__ int lds_byte(int r, int c) { const int st = (r >> 4) * 2 + (c >> 5), rr = r & 15, cc = c & 31, ob = rr * 64 + cc * 2; return st * 1024 + (ob ^ (((ob >> 9) & 1) << 5)); }
__host__ __device__ __forceinline__ void stage_rc(int b, int& R, int& C) { const int st = b / 1024, sb = b % 1024, swz = sb ^ (((sb >> 9) & 1) << 5); R = (st >> 1) * 16 + swz / 64; C = (st & 1) * 32 + (swz % 64) / 2; }
__host__ __device__ __forceinline__ int perm32(int rho) { const int n = rho >> 4, i = rho & 15; return 8 * (i >> 2) + 4 * n + (i & 3); }

struct Unit { int pm, pn, g; };
struct Gemm { const bf16_t* A; const bf16_t* Bt; int lda, ldb, K; long a_gs, b_gs; const int* idx; int idx_gs; };

struct StaticOrder {
    int nM, nN, nwg, G, c;
    __device__ __forceinline__ void init(int M, int N, int G_, int c_) { nM = M / BM; nN = N / BM; nwg = nM * nN; G = G_; c = c_; }
    __device__ __forceinline__ bool next(int i, Unit& u) const {
        const long L = (long)i * G + c; if (L >= nwg) return false;
        int wgid = (int)L; { const int q = nwg / NXCD, r = nwg % NXCD, xcd = wgid % NXCD, off = wgid / NXCD; wgid = (xcd < r ? xcd * (q + 1) : r * (q + 1) + (xcd - r) * q) + off; }
        const int nig = WGM * nN, gid = wgid / nig, fm = gid * WGM, gsz = (nM - fm) < WGM ? (nM - fm) : WGM;
        u.pm = fm + ((wgid % nig) % gsz); u.pn = (wgid % nig) / gsz; u.g = 0; return true;
    }
};
struct GroupOrder {
    int nM, nN, nwg, G, v;
    __device__ __forceinline__ void init(int nM_, int nN_, int nG, int G_, int c_) { nM = nM_; nN = nN_; nwg = nM_ * nN_ * nG; G = G_; v = (G_ % 8 == 0) ? (c_ % 8) * (G_ / 8) + c_ / 8 : c_; }
    __device__ __forceinline__ bool next(int i, Unit& u) const {
        const long L = (long)i * G + v; if (L >= nwg) return false;
        const int w = (int)L; u.pm = w % nM; u.pn = (w / nM) % nN; u.g = w / (nM * nN); return true;
    }
};

template <class Epi, class Sched, bool GATHER>
__device__ __forceinline__ void gemm_phase(LAS unsigned char* lds, const Gemm g, const Sched& S, const Epi& E) {
    const int tid = opaque_tid(), wid = __builtin_amdgcn_readfirstlane(tid >> 6), lane = tid & 63, wr = wid >> 2, wc = wid & 3, fr = lane & 15, fq = lane >> 4;
    const int K = g.K, nt = K / BK;
    int Rr[2], Cc[2]; unsigned voffB[2];
#pragma unroll
    for (int i = 0; i < 2; ++i) { int R, C; stage_rc(tid * 16 + i * 8192, R, C); Rr[i] = R; Cc[i] = C; const int Rb = Epi::PERM ? ((R & ~31) + perm32(R & 31)) : R;
        voffB[i] = (unsigned)(Rb * g.ldb + C) * 2u; }
    const size_t kstep = (size_t)(BK * 2);
    const size_t hstepA = (size_t)HALF * g.lda * 2, hstepB = (size_t)HALF * g.ldb * 2;
    const unsigned ldsw = (unsigned)wid * 1024u;
    const int aoff = lds_byte(wr * 64 + fr, fq * 8), boff = lds_byte(wc * 32 + fr, fq * 8);
#define PG8_SA(b, h) (((b) * 2 + (h)) * HTB)
#define PG8_SB(b, h) ((4 + (b) * 2 + (h)) * HTB)
#define PG8_STAGE(bufoff, gbase, v0, v1) do { \
        __builtin_amdgcn_global_load_lds((const unsigned*)((const char*)(gbase) + (v0)), (LAS unsigned*)(lds + (bufoff) + ldsw), 16, 0, 0); \
        __builtin_amdgcn_global_load_lds((const unsigned*)((const char*)(gbase) + (v1)), (LAS unsigned*)(lds + (bufoff) + ldsw + 8192), 16, 0, 0); } while (0)
#define PG8_STAGEB(bufoff, gbase) PG8_STAGE(bufoff, gbase, voffB[0], voffB[1])
#define PG8_LDA(dst, b, h) do { _Pragma("unroll") for (int m = 0; m < 4; ++m) _Pragma("unroll") for (int k = 0; k < 2; ++k) dst[m][k] = *(const LAS bf16x8*)(lds + PG8_SA(b, h) + aoff + m * 2048 + k * 1024); } while (0)
#define PG8_LDB(dst, b, h) do { _Pragma("unroll") for (int n = 0; n < 2; ++n) _Pragma("unroll") for (int k = 0; k < 2; ++k) dst[n][k] = *(const LAS bf16x8*)(lds + PG8_SB(b, h) + boff + n * 2048 + k * 1024); } while (0)
#define PG8_MMA(ai, bj, At, Bt) do { __builtin_amdgcn_s_setprio(1); _Pragma("unroll") for (int m = 0; m < 4; ++m) _Pragma("unroll") for (int n = 0; n < 2; ++n) _Pragma("unroll") for (int k = 0; k < 2; ++k) \
        acc[ai][bj][m][n] = __builtin_amdgcn_mfma_f32_16x16x32_bf16(Bt[n][k], At[m][k], acc[ai][bj][m][n], 0, 0, 0); __builtin_amdgcn_s_setprio(0); } while (0)
#define PG8_WAIT_V(n) asm volatile("s_waitcnt vmcnt(" #n ")" ::: "memory")
#define PG8_WAIT_L(n) asm volatile("s_waitcnt lgkmcnt(" #n ")" ::: "memory")
#define PG8_BAR __builtin_amdgcn_s_barrier()
#define PG8_SCHED __builtin_amdgcn_sched_barrier(0)
    Unit cur, nxt; int ui = 0;
    if (!S.next(0, cur)) return;
    f32x4 acc[2][2][4][2];
#pragma unroll
    for (int a = 0; a < 2; ++a)
#pragma unroll
        for (int b = 0; b < 2; ++b)
#pragma unroll
            for (int m = 0; m < 4; ++m)
#pragma unroll
                for (int n = 0; n < 2; ++n) acc[a][b][m][n] = (f32x4){0.f, 0.f, 0.f, 0.f};
    bf16x8 At[4][2], B0[2][2], B1[2][2];
    unsigned voffA[2]; unsigned oc[2][2], on[2][2];
#pragma unroll
    for (int i = 0; i < 2; ++i) voffA[i] = (unsigned)(Rr[i] * g.lda + Cc[i]) * 2u;
    const char* cA; const char* cB;
#define PG8_UNIT_PTRS(u, pA, pB, o) do { \
        pB = (const char*)(g.Bt + (size_t)(u).g * g.b_gs) + (size_t)(u).pn * BM * g.ldb * 2; \
        if constexpr (GATHER) { \
            pA = (const char*)g.A; \
            const int* ix_ = g.idx + (size_t)(u).g * g.idx_gs + (u).pm * BM; \
            _Pragma("unroll") for (int h = 0; h < 2; ++h) _Pragma("unroll") for (int i = 0; i < 2; ++i) o[h][i] = ((unsigned)ix_[h * HALF + Rr[i]] * (unsigned)g.lda + (unsigned)Cc[i]) * 2u; \
        } else { \
            pA = (const char*)(g.A + (size_t)(u).g * g.a_gs) + (size_t)(u).pm * BM * g.lda * 2; \
        } } while (0)
#define PG8_STAGEA(bufoff, p, o, h) do { if constexpr (GATHER) PG8_STAGE(bufoff, p, o[h][0], o[h][1]); else PG8_STAGE(bufoff, (p) + (h) * hstepA, voffA[0], voffA[1]); } while (0)
    PG8_UNIT_PTRS(cur, cA, cB, oc);
    PG8_STAGEB(PG8_SB(0, 0), cB); PG8_STAGEB(PG8_SB(0, 1), cB + hstepB); PG8_STAGEA(PG8_SA(0, 0), cA, oc, 0); PG8_STAGEA(PG8_SA(0, 1), cA, oc, 1);
    if (wr == 1) PG8_BAR;
    PG8_WAIT_V(2); PG8_BAR;
    PG8_STAGEB(PG8_SB(1, 0), cB + kstep); PG8_STAGEA(PG8_SA(1, 0), cA + kstep, oc, 0); PG8_STAGEB(PG8_SB(1, 1), cB + hstepB + kstep);
    PG8_WAIT_V(6); PG8_BAR;
    for (;;) {
        const bool has_next = S.next(ui + 1, nxt);
        const char* nA = cA; const char* nB = cB;
        if constexpr (GATHER) {
#pragma unroll
            for (int h = 0; h < 2; ++h)
#pragma unroll
                for (int i = 0; i < 2; ++i) on[h][i] = oc[h][i];
        }
        if (has_next) PG8_UNIT_PTRS(nxt, nA, nB, on);
#pragma unroll 1
        for (int t = 0; t < nt; t += 2) {
            const bool last = (t == nt - 2);
            const char* a1 = cA + (size_t)(t + 1) * kstep;
            const char* a2 = last ? nA : cA + (size_t)(t + 2) * kstep; const char* b2 = last ? nB : cB + (size_t)(t + 2) * kstep;
            const char* a3 = a2 + kstep; const char* b3 = b2 + kstep;
            unsigned o2[2][2];
            if constexpr (GATHER) {
#pragma unroll
                for (int h = 0; h < 2; ++h)
#pragma unroll
                    for (int i = 0; i < 2; ++i) o2[h][i] = last ? on[h][i] : oc[h][i];
            }
            PG8_LDB(B0, 0, 0); PG8_LDB(B1, 0, 1); PG8_SCHED; PG8_LDA(At, 0, 0); PG8_STAGEA(PG8_SA(1, 1), a1, oc, 1);
            PG8_WAIT_V(8); PG8_WAIT_L(0); PG8_BAR; PG8_MMA(0, 0, At, B0); PG8_MMA(0, 1, At, B1); PG8_BAR; PG8_SCHED;
            PG8_LDA(At, 0, 1); PG8_STAGEB(PG8_SB(0, 0), b2); PG8_STAGEB(PG8_SB(0, 1), b2 + hstepB); PG8_STAGEA(PG8_SA(0, 0), a2, o2, 0);
            PG8_WAIT_V(8); PG8_WAIT_L(0); PG8_BAR; PG8_MMA(1, 0, At, B0); PG8_MMA(1, 1, At, B1); PG8_BAR; PG8_SCHED;
            PG8_LDB(B0, 1, 0); PG8_LDB(B1, 1, 1); PG8_SCHED; PG8_LDA(At, 1, 0); PG8_STAGEA(PG8_SA(0, 1), a2, o2, 1);
            PG8_WAIT_V(8); PG8_WAIT_L(0); PG8_BAR; PG8_MMA(0, 0, At, B0); PG8_MMA(0, 1, At, B1); PG8_BAR; PG8_SCHED;
            PG8_LDA(At, 1, 1); PG8_STAGEB(PG8_SB(1, 0), b3); PG8_STAGEB(PG8_SB(1, 1), b3 + hstepB); PG8_STAGEA(PG8_SA(1, 0), a3, o2, 0);
            PG8_WAIT_V(8); PG8_WAIT_L(0); PG8_BAR; PG8_MMA(1, 0, At, B0); PG8_MMA(1, 1, At, B1); PG8_BAR; PG8_SCHED;
        }
        if (wr == 0) PG8_BAR;
        E(acc, cur, wr, wc, fr, fq);
        if (!has_next) break;
#pragma unroll
        for (int a = 0; a < 2; ++a)
#pragma unroll
            for (int b = 0; b < 2; ++b)
#pragma unroll
                for (int m = 0; m < 4; ++m)
#pragma unroll
                    for (int n = 0; n < 2; ++n) acc[a][b][m][n] = (f32x4){0.f, 0.f, 0.f, 0.f};
        cur = nxt; cA = nA; cB = nB; ++ui;
        if constexpr (GATHER) {
#pragma unroll
            for (int h = 0; h < 2; ++h)
#pragma unroll
                for (int i = 0; i < 2; ++i) oc[h][i] = on[h][i];
        }
        if (wr == 1) PG8_BAR;
    }
    PG8_WAIT_V(0);
    PG8_BAR;
#undef PG8_UNIT_PTRS
#undef PG8_STAGEA
#undef PG8_SA
#undef PG8_SB
#undef PG8_STAGE
#undef PG8_STAGEB
#undef PG8_LDA
#undef PG8_LDB
#undef PG8_MMA
#undef PG8_WAIT_V
#undef PG8_WAIT_L
#undef PG8_BAR
#undef PG8_SCHED
}

#define EPI_ROWLOOP for (int ai = 0; ai < 2; ++ai) _Pragma("unroll") for (int m = 0; m < 4; ++m)
__device__ __forceinline__ u32x4 pack8(const f32x4 v0, const f32x4 v1) { u32x4 w; w.x = cvt_pk_bf16(v0[0], v0[1]); w.y = cvt_pk_bf16(v0[2], v0[3]); w.z = cvt_pk_bf16(v1[0], v1[1]); w.w = cvt_pk_bf16(v1[2], v1[3]); return w; }
struct EpiBf16 {
    static constexpr bool PERM = true;
    bf16_t* O; int ldc;
    __device__ __forceinline__ void operator()(const f32x4 (&acc)[2][2][4][2], const Unit& u, int wr, int wc, int fr, int fq) const {
        const unsigned lo = (unsigned)(fr * ldc + 8 * fq) * 2u;
        char* ub = (char*)(O + (size_t)(u.pm * BM + wr * 64) * ldc + u.pn * BM + wc * 32);
#pragma unroll
        EPI_ROWLOOP { char* rb = ub + (size_t)(ai * HALF + m * 16) * ldc * 2;
#pragma unroll
            for (int bj = 0; bj < 2; ++bj) *(u32x4*)(rb + bj * HALF * 2 + lo) = pack8(acc[ai][bj][m][0], acc[ai][bj][m][1]); }
    }
};
struct EpiQ {
    static constexpr bool PERM = true;
    bf16_t* QB; const float* cs;
    __device__ __forceinline__ void operator()(const f32x4 (&acc)[2][2][4][2], const Unit& u, int wr, int wc, int fr, int fq) const {
        const unsigned lo = (unsigned)(fr * 192 + 8 * fq) * 2u, lcs = (unsigned)(fr * 64 + 8 * fq) * 4u;
        const int rowU = u.pm * BM + wr * 64;
#pragma unroll
        for (int bj = 0; bj < 2; ++bj) { const int c32 = u.pn * BM + bj * HALF + wc * 32, hd = c32 / 192, w32 = c32 - hd * 192;
            char* ub = (char*)(QB + ((size_t)hd * SEQ + rowU) * 192 + w32);
            const char* cb = (const char*)(cs + (size_t)rowU * 64 + (w32 >= 128 ? (w32 - 128) : 0));
#pragma unroll
            EPI_ROWLOOP { const int rr = ai * HALF + m * 16; f32x4 v0 = acc[ai][bj][m][0], v1 = acc[ai][bj][m][1];
                if (w32 >= 128) { const f32x4 ca = *(const f32x4*)(cb + (size_t)rr * 256 + lcs), cc = *(const f32x4*)(cb + (size_t)rr * 256 + 16 + lcs);
                    const f32x4 a = v0, b = v1;
                    v0[0] = a[0] * ca[0] - a[1] * ca[1]; v0[1] = a[0] * ca[1] + a[1] * ca[0]; v0[2] = a[2] * ca[2] - a[3] * ca[3]; v0[3] = a[2] * ca[3] + a[3] * ca[2];
                    v1[0] = b[0] * cc[0] - b[1] * cc[1]; v1[1] = b[0] * cc[1] + b[1] * cc[0]; v1[2] = b[2] * cc[2] - b[3] * cc[3]; v1[3] = b[2] * cc[3] + b[3] * cc[2]; }
                *(u32x4*)(ub + (size_t)rr * 384 + lo) = pack8(v0, v1);
                if (m & 1) asm volatile("" ::: "memory"); } }
    }
};
struct EpiKV {
    static constexpr bool PERM = true;
    bf16_t* KB; bf16_t* VB;
    __device__ __forceinline__ void operator()(const f32x4 (&acc)[2][2][4][2], const Unit& u, int wr, int wc, int fr, int fq) const {
        const int rowU = u.pm * BM + wr * 64;
#pragma unroll
        for (int bj = 0; bj < 2; ++bj) { const int c32 = u.pn * BM + bj * HALF + wc * 32, hd = c32 >> 8, w32 = c32 & 255; const bool isk = w32 < 128;
            const int ld = isk ? 192 : 128;
            char* ub = (char*)(isk ? KB + ((size_t)hd * SEQ + rowU) * 192 + w32 : VB + ((size_t)hd * SEQ + rowU) * 128 + (w32 - 128));
            const unsigned lo = (unsigned)(fr * ld + 8 * fq) * 2u;
#pragma unroll
            EPI_ROWLOOP { *(u32x4*)(ub + (size_t)(ai * HALF + m * 16) * ld * 2 + lo) = pack8(acc[ai][bj][m][0], acc[ai][bj][m][1]); } }
    }
};
struct EpiRes {
    static constexpr bool PERM = false;
    const float* x; float* out; const float* mod;
    __device__ __forceinline__ void operator()(const f32x4 (&acc)[2][2][4][2], const Unit& u, int wr, int wc, int fr, int fq) const {
        const int col0 = u.pn * BM + wc * 32 + 4 * fq;
        const int b = (u.pm * BM) / SEQ;
        f32x4 gt[2][2];
#pragma unroll
        for (int bj = 0; bj < 2; ++bj)
#pragma unroll
            for (int n = 0; n < 2; ++n) gt[bj][n] = *(const f32x4*)(mod + b * 6144 + 2048 + col0 + bj * HALF + n * 16);
        const unsigned lo = (unsigned)(fr * DM + 4 * fq) * 4u;
        const size_t ubo = ((size_t)(u.pm * BM + wr * 64) * DM + u.pn * BM + wc * 32) * 4;
#pragma unroll
        EPI_ROWLOOP { const size_t ro = ubo + (size_t)(ai * HALF + m * 16) * DM * 4;
#pragma unroll
            for (int bj = 0; bj < 2; ++bj)
#pragma unroll
                for (int n = 0; n < 2; ++n) { const size_t o = ro + (bj * HALF + n * 16) * 4; const f32x4 xv = *(const f32x4*)((const char*)x + o + lo);
                    *(f32x4*)((char*)out + o + lo) = xv + gt[bj][n] * acc[ai][bj][m][n]; }
            if (m & 1) asm volatile("" ::: "memory"); }
    }
};
struct EpiSwiGLU {
    static constexpr bool PERM = true;
    bf16_t* HID;
    __device__ __forceinline__ void operator()(const f32x4 (&acc)[2][2][4][2], const Unit& u, int wr, int wc, int fr, int fq) const {
        const unsigned lo = (unsigned)(fr * DFF + 4 * fq) * 2u;
        char* ub = (char*)(HID + ((size_t)u.g * CAP + u.pm * BM + wr * 64) * DFF + ((u.pn * BM + wc * 32) >> 1));
#pragma unroll
        EPI_ROWLOOP { char* rb = ub + (size_t)(ai * HALF + m * 16) * DFF * 2;
#pragma unroll
            for (int bj = 0; bj < 2; ++bj) { const f32x4 gv = acc[ai][bj][m][0], uv = acc[ai][bj][m][1]; f32x4 h;
#pragma unroll
                for (int e = 0; e < 4; ++e) h[e] = gv[e] * fast_sigmoid(gv[e]) * uv[e];
                u32x2 o; o.x = cvt_pk_bf16(h[0], h[1]); o.y = cvt_pk_bf16(h[2], h[3]);
                *(u32x2*)(rb + bj * (HALF / 2) * 2 + lo) = o; } }
    }
};
struct EpiDown {
    static constexpr bool PERM = true;
    bf16_t* Y; const float* gate;
    __device__ __forceinline__ void operator()(const f32x4 (&acc)[2][2][4][2], const Unit& u, int wr, int wc, int fr, int fq) const {
        const unsigned lo = (unsigned)(fr * DM + 8 * fq) * 2u;
        const int rowU = u.g * CAP + u.pm * BM + wr * 64;
        char* ub = (char*)(Y + (size_t)rowU * DM + u.pn * BM + wc * 32);
        const float* gp = gate + rowU + fr;
#pragma unroll
        EPI_ROWLOOP { const int rr = ai * HALF + m * 16; const float gs = gp[rr]; char* rb = ub + (size_t)rr * DM * 2;
#pragma unroll
            for (int bj = 0; bj < 2; ++bj) *(u32x4*)(rb + bj * HALF * 2 + lo) = pack8(acc[ai][bj][m][0] * gs, acc[ai][bj][m][1] * gs); }
    }
};
#undef EPI_ROWLOOP
}
namespace att {
__device__ __forceinline__ int crow(int r, int hi) { return (r & 3) + 8 * (r >> 2) + 4 * hi; }
__device__ __forceinline__ int v_st(int k, int c) { const int kk = (k & ~0xC) | ((k & 4) << 1) | ((k & 8) >> 1); return ((kk >> 3) * 4 + (c >> 5)) * 512 + ((kk & 7) * 32 + (c & 31)) * 2; }
__device__ __forceinline__ int v_rd_base(int lane) { return ((lane & 3) << 3) | (((lane >> 2) & 3) << 6) | (((lane >> 4) & 1) << 5) | (((lane >> 5) & 1) << 8); }
constexpr int v_rd_off(int d0, int ks, int half) { return d0 * 512 + ks * 4096 + half * 2048; }
template <int OFF> __device__ __forceinline__ s16x4 tr_read(int vb) {
    s16x4 r; asm volatile("ds_read_b64_tr_b16 %0, %1 offset:%2" : "=&v"(r) : "v"(vb), "i"(OFF) : "memory"); return r;
}
#define ATT_SBAR() __builtin_amdgcn_sched_barrier(0)
template <int D0> __device__ __forceinline__ void pv_one(f32x16& od, int vb, bf16x8 pa0, bf16x8 pa1, bf16x8 pa2, bf16x8 pa3) {
    const s16x4 l0 = tr_read<v_rd_off(D0, 0, 0)>(vb), h0 = tr_read<v_rd_off(D0, 0, 1)>(vb), l1 = tr_read<v_rd_off(D0, 1, 0)>(vb), h1 = tr_read<v_rd_off(D0, 1, 1)>(vb);
    const s16x4 l2 = tr_read<v_rd_off(D0, 2, 0)>(vb), h2 = tr_read<v_rd_off(D0, 2, 1)>(vb), l3 = tr_read<v_rd_off(D0, 3, 0)>(vb), h3 = tr_read<v_rd_off(D0, 3, 1)>(vb);
    asm volatile("s_waitcnt lgkmcnt(0)" ::: "memory"); ATT_SBAR();
#define ATT_PK(L, H) (bf16x8){L[0], L[1], L[2], L[3], H[0], H[1], H[2], H[3]}
    od = __builtin_amdgcn_mfma_f32_32x32x16_bf16(pa0, ATT_PK(l0, h0), od, 0, 0, 0);
    od = __builtin_amdgcn_mfma_f32_32x32x16_bf16(pa1, ATT_PK(l1, h1), od, 0, 0, 0);
    od = __builtin_amdgcn_mfma_f32_32x32x16_bf16(pa2, ATT_PK(l2, h2), od, 0, 0, 0);
    od = __builtin_amdgcn_mfma_f32_32x32x16_bf16(pa3, ATT_PK(l3, h3), od, 0, 0, 0);
#undef ATT_PK
}
__device__ __forceinline__ void pv_d0(f32x16* o, int vb, bf16x8 pa0, bf16x8 pa1, bf16x8 pa2, bf16x8 pa3) {
    pv_one<0>(o[0], vb, pa0, pa1, pa2, pa3); pv_one<1>(o[1], vb, pa0, pa1, pa2, pa3); pv_one<2>(o[2], vb, pa0, pa1, pa2, pa3); pv_one<3>(o[3], vb, pa0, pa1, pa2, pa3);
}
__device__ __forceinline__ void finishSM(f32x16& p0, f32x16& p1, float alpha, float& l_reg, bf16x8& pa0, bf16x8& pa1, bf16x8& pa2, bf16x8& pa3) {
#pragma unroll
    for (int r = 0; r < 16; ++r) p1[r] = __builtin_amdgcn_exp2f(p1[r]);
    float ps = 0;
#pragma unroll
    for (int r = 0; r < 16; ++r) ps += p0[r];
#pragma unroll
    for (int r = 0; r < 16; ++r) ps += p1[r];
    { auto rr = __builtin_amdgcn_permlane32_swap(__float_as_uint(ps), __float_as_uint(ps), false, false);
      ps = __uint_as_float(rr[0]) + __uint_as_float(rr[1]); }
    l_reg = l_reg * alpha + ps;
#define ATT_PK4(P, BASE, OUT) do { unsigned a0 = cvt_pk_bf16(P[BASE + 0], P[BASE + 1]), a1 = cvt_pk_bf16(P[BASE + 2], P[BASE + 3]);   \
    unsigned b0 = cvt_pk_bf16(P[BASE + 4], P[BASE + 5]), b1 = cvt_pk_bf16(P[BASE + 6], P[BASE + 7]);                              \
    auto r0 = __builtin_amdgcn_permlane32_swap(a0, b0, false, false); auto r1 = __builtin_amdgcn_permlane32_swap(a1, b1, false, false); \
    u32x4 w = {r0[0], r1[0], r0[1], r1[1]}; OUT = *reinterpret_cast<bf16x8*>(&w); } while (0)
    ATT_PK4(p0, 0, pa0); ATT_PK4(p0, 8, pa1); ATT_PK4(p1, 0, pa2); ATT_PK4(p1, 8, pa3);
#undef ATT_PK4
}

struct Unit {
    const bf16_t* Q; int qs;
    const bf16_t* K; int ks;
    const bf16_t* V; int vs;
    bf16_t* O; int os;
    int nt;
    int tmul;
    float* dbg;
    int kt0, ktn;
    int l0;
    const int* pos; int ps;
    float* lse; int ls;
    const float* bias;
};

template <bool DIL> struct Cfg {
    static constexpr int DQK = DIL ? 128 : 192, ND = DQK / 16, KROWB = DQK * 2 + 16, SHM_K = 64 * KROWB, SHM_V = 16384;
    static constexpr int NKC = DQK / 64;
    static constexpr int OFF_V = 0, OFF_K = 2 * SHM_V, OFF_WS = OFF_K + 2 * SHM_K, OFF_POS = OFF_WS + NWAVES * 64 * 4, OFF_LUT = OFF_POS + 2 * 64 * 4, END = OFF_LUT + 2052 * 4;
    static constexpr float SCALE = DIL ? 0.088388347648318440f : 0.072168783648703220f;
};

template <bool DIL>
__device__ __forceinline__ void qkt(f32x16& p0, f32x16& p1, const LAS char* Ks, const bf16x8* qr, int r32, int hi) {
    using C = Cfg<DIL>;
    p0 = f32x16{}; p1 = f32x16{};
    const LAS char* k0 = Ks + r32 * C::KROWB + hi * 16; const LAS char* k1 = k0 + 32 * C::KROWB;
#pragma unroll
    for (int d0 = 0; d0 < C::ND; ++d0) {
        const bf16x8 b0 = *(const LAS bf16x8*)(k0 + d0 * 32);
        const bf16x8 b1 = *(const LAS bf16x8*)(k1 + d0 * 32);
        p0 = __builtin_amdgcn_mfma_f32_32x32x16_bf16(b0, qr[d0], p0, 0, 0, 0);
        p1 = __builtin_amdgcn_mfma_f32_32x32x16_bf16(b1, qr[d0], p1, 0, 0, 0); }
}

template <bool DIL>
__device__ __forceinline__ void xstage(bool pv, bool qk, f32x16* o, int vb, bf16x8 pa0, bf16x8 pa1, bf16x8 pa2, bf16x8 pa3, f32x16& p0, f32x16& p1, const LAS char* Ks, const bf16x8* qr, int r32, int hi) {
    using C = Cfg<DIL>;
    constexpr int NG = C::ND / 2;
    const LAS char* k0 = Ks + r32 * C::KROWB + hi * 16;
    bf16x8 f[2][4];
    const int ka = (int)(unsigned)(size_t)k0;
#define ATT_KR1(dst_, off_) asm volatile("ds_read_b128 %0, %1 offset:%2" : "=&v"(dst_) : "v"(ka), "i"(off_) : "memory")
#define ATT_KRD(s_, g_) do { ATT_KR1(f[s_][0], (2 * (g_)) * 32); ATT_KR1(f[s_][1], 32 * C::KROWB + (2 * (g_)) * 32); ATT_KR1(f[s_][2], (2 * (g_) + 1) * 32); ATT_KR1(f[s_][3], 32 * C::KROWB + (2 * (g_) + 1) * 32); } while (0)
#define ATT_PK(L, H) (bf16x8){L[0], L[1], L[2], L[3], H[0], H[1], H[2], H[3]}
#define ATT_VRD1(B_, s_, ks_) do { const s16x4 l_ = tr_read<v_rd_off(B_, ks_, 0)>(vb), h_ = tr_read<v_rd_off(B_, ks_, 1)>(vb); f[s_][ks_] = ATT_PK(l_, h_); } while (0)
#define ATT_VRD(B_, s_) do { ATT_VRD1(B_, s_, 0); ATT_VRD1(B_, s_, 1); ATT_VRD1(B_, s_, 2); ATT_VRD1(B_, s_, 3); } while (0)
#define ATT_VMMA(B_, s_) do { o[B_] = __builtin_amdgcn_mfma_f32_32x32x16_bf16(pa0, f[s_][0], o[B_], 0, 0, 0); o[B_] = __builtin_amdgcn_mfma_f32_32x32x16_bf16(pa1, f[s_][1], o[B_], 0, 0, 0); \
        o[B_] = __builtin_amdgcn_mfma_f32_32x32x16_bf16(pa2, f[s_][2], o[B_], 0, 0, 0); o[B_] = __builtin_amdgcn_mfma_f32_32x32x16_bf16(pa3, f[s_][3], o[B_], 0, 0, 0); } while (0)
#define ATT_LW(n) asm volatile("s_waitcnt lgkmcnt(" #n ")" ::: "memory")
    if (pv) {
        ATT_VRD(0, 0); ATT_SBAR();
        ATT_VRD(1, 1); ATT_LW(8); ATT_SBAR(); ATT_VMMA(0, 0); ATT_SBAR();
        ATT_VRD(2, 0); ATT_LW(8); ATT_SBAR(); ATT_VMMA(1, 1); ATT_SBAR();
        ATT_VRD(3, 1); ATT_LW(8); ATT_SBAR(); ATT_VMMA(2, 0); ATT_SBAR();
        ATT_KRD(0, 0); ATT_LW(4); ATT_SBAR(); ATT_VMMA(3, 1); ATT_SBAR();
    } else { ATT_KRD(0, 0); ATT_SBAR(); }
    if (!qk) { ATT_LW(0); return; }
    p0 = f32x16{}; p1 = f32x16{};
#pragma unroll
    for (int g = 0; g < NG; ++g) { const int sg = g & 1;
        if (g + 1 < NG) { ATT_KRD(sg ^ 1, g + 1); ATT_LW(4); } else { ATT_LW(0); }
        ATT_SBAR();
        p0 = __builtin_amdgcn_mfma_f32_32x32x16_bf16(f[sg][0], qr[2 * g], p0, 0, 0, 0);
        p1 = __builtin_amdgcn_mfma_f32_32x32x16_bf16(f[sg][1], qr[2 * g], p1, 0, 0, 0);
        p0 = __builtin_amdgcn_mfma_f32_32x32x16_bf16(f[sg][2], qr[2 * g + 1], p0, 0, 0, 0);
        p1 = __builtin_amdgcn_mfma_f32_32x32x16_bf16(f[sg][3], qr[2 * g + 1], p1, 0, 0, 0);
        ATT_SBAR(); }
#undef ATT_VRD1
#undef ATT_KRD
#undef ATT_KR1
#undef ATT_VRD
#undef ATT_PK
#undef ATT_VMMA
#undef ATT_LW
}

template <bool DIL>
__device__ __forceinline__ void partialSM(f32x16& p0, f32x16& p1, float& m_reg, float& mn, float& alpha,
                                          const LAS int* posb, const LAS float* lut, int pq, int dl0, bool tv, int hi) {
    using C = Cfg<DIL>;
    constexpr float CC = C::SCALE * LOG2E;
    constexpr float THR = 8.f;
    float mnC;
    if constexpr (DIL) {
#pragma unroll
        for (int a = 0; a < 4; ++a) {
            const i32x4 pk0 = *(const LAS i32x4*)(posb + 8 * a + 4 * hi), pk1 = *(const LAS i32x4*)(posb + 32 + 8 * a + 4 * hi);
#pragma unroll
            for (int b = 0; b < 4; ++b) { const int r = 4 * a + b;
                int i0 = pk0[b] - pq; i0 = i0 < -1024 ? -1024 : (i0 > 1024 ? 1024 : i0);
                int i1 = pk1[b] - pq; i1 = i1 < -1024 ? -1024 : (i1 > 1024 ? 1024 : i1);
                const float b0 = lut[i0 + 1024], b1 = lut[i1 + 1024];
                const int dl = dl0 + 8 * a + b;
                const bool ok0 = tv && ((unsigned)(dl + 64) <= 128u), ok1 = tv && ((unsigned)(dl + 32 + 64) <= 128u);
                p0[r] = ok0 ? fmaf(p0[r], CC, b0) : -1e30f;
                p1[r] = ok1 ? fmaf(p1[r], CC, b1) : -1e30f; }
        }
        float pmax = p0[0];
#pragma unroll
        for (int r = 1; r < 16; ++r) pmax = fmaxf(pmax, p0[r]);
#pragma unroll
        for (int r = 0; r < 16; ++r) pmax = fmaxf(pmax, p1[r]);
        { auto rr = __builtin_amdgcn_permlane32_swap(__float_as_uint(pmax), __float_as_uint(pmax), false, false);
          pmax = fmaxf(__uint_as_float(rr[0]), __uint_as_float(rr[1])); }
        if (__builtin_expect(__all(pmax - m_reg <= THR * LOG2E), 1)) { mn = m_reg; alpha = 1.f; }
        else { mn = fmaxf(m_reg, pmax); alpha = __builtin_amdgcn_exp2f(m_reg - mn); m_reg = mn; }
        mnC = -fmaxf(mn, -1e29f);
#pragma unroll
        for (int r = 0; r < 16; ++r) p0[r] = p0[r] + mnC;
#pragma unroll
        for (int r = 0; r < 16; ++r) p1[r] = p1[r] + mnC;
    } else {
        float pmax = p0[0];
#pragma unroll
        for (int r = 1; r < 16; ++r) pmax = fmaxf(pmax, p0[r]);
#pragma unroll
        for (int r = 0; r < 16; ++r) pmax = fmaxf(pmax, p1[r]);
        { auto rr = __builtin_amdgcn_permlane32_swap(__float_as_uint(pmax), __float_as_uint(pmax), false, false);
          pmax = fmaxf(__uint_as_float(rr[0]), __uint_as_float(rr[1])); }
        if (__builtin_expect(__all(pmax - m_reg <= THR / C::SCALE), 1)) { mn = m_reg; alpha = 1.f; }
        else { mn = fmaxf(m_reg, pmax); alpha = __builtin_amdgcn_exp2f((m_reg - mn) * CC); m_reg = mn; }
        mnC = -mn * CC;
#pragma unroll
        for (int r = 0; r < 16; ++r) p0[r] = fmaf(p0[r], CC, mnC);
#pragma unroll
        for (int r = 0; r < 16; ++r) p1[r] = fmaf(p1[r], CC, mnC);
    }
#pragma unroll
    for (int r = 0; r < 16; ++r) p0[r] = __builtin_amdgcn_exp2f(p0[r]);
}

__device__ __forceinline__ int t5_bucket(int rel) {
    const int n = rel < 0 ? -rel : rel;
    const float nf = (float)(n > 1 ? n : 1);
    int large = 8 + (int)(logf(nf / 8.f) / 4.852030263919617f * 8.f);
    large = large < 15 ? large : 15;
    return (rel > 0 ? 16 : 0) + (n < 8 ? n : large);
}

template <bool DIL>
__device__ __forceinline__ void attn_unit(const Unit& a, LAS char* lds) {
    using C = Cfg<DIL>;
    constexpr int SD = 1;
    const int tid = opaque_tid(), wid = __builtin_amdgcn_readfirstlane(tid >> 6), lane = tid & 63, r32 = lane & 31, hi = lane >> 5;
    LAS char* V_lds = lds + C::OFF_V; LAS char* K_lds = lds + C::OFF_K;
    LAS float* ws = (LAS float*)(lds + C::OFF_WS) + wid * 64; LAS float* li_l = ws; LAS float* al_l = ws + 32;
    LAS int* pos_l = (LAS int*)(lds + C::OFF_POS); LAS float* lut = (LAS float*)(lds + C::OFF_LUT);
    float m_reg = -1e30f, l_reg = 0; f32x16 o[4] = {}; bf16x8 qr[C::ND];
    { const bf16_t* Qw = a.Q + (size_t)(wid * 32 + r32) * a.qs + hi * 8;
#pragma unroll
      for (int d0 = 0; d0 < C::ND; ++d0) qr[d0] = *(const bf16x8*)(Qw + d0 * 16); }
    int pq = 0, lq = 0;
    if constexpr (DIL) {
        lq = a.l0 + wid * 32 + r32; pq = a.pos[(size_t)lq * a.ps];
        for (int i = tid; i < 2049; i += 512) lut[i] = a.bias[t5_bucket(i - 1024) * 24] * LOG2E;
    }
    constexpr int CPR = C::KROWB / 16, NKP = C::SHM_K / 1024, NKI = (NKP + 7) / 8;
    unsigned kgo[NKI];
#pragma unroll
    for (int i = 0; i < NKI; ++i) { const int pch = (wid + 8 * i) * 64 + lane, kr = pch / CPR, kc = pch % CPR; kgo[i] = (unsigned)(kr * a.ks + (kc == CPR - 1 ? 0 : kc) * 8) * 2u; }
    unsigned vgo[2];
#pragma unroll
    for (int i = 0; i < 2; ++i) { const int pch = (wid + 8 * i) * 64 + lane, sub = pch >> 5, within = pch & 31, kk = (sub >> 2) * 8 + (within >> 2), cc = (sub & 3) * 32 + (within & 3) * 8;
        const int k = (kk & ~0xC) | ((kk & 4) << 1) | ((kk & 8) >> 1); vgo[i] = (unsigned)(k * a.vs + cc) * 2u; }
    const int vb0 = (int)(unsigned)(size_t)V_lds + v_rd_base(lane);
    int ppos = 0;
#define ATT_KROW0(j) (DIL ? (((a.kt0 + (j)) < 0 ? 0 : ((a.kt0 + (j)) >= a.ktn ? a.ktn - 1 : (a.kt0 + (j)))) * 64) : (j) * 64 * a.tmul)
#define ATT_DMAK(j) do { const int k0_ = ATT_KROW0(j); const char* kt_ = (const char*)(a.K + (size_t)k0_ * a.ks); LAS char* kd_ = K_lds + ((j) & 1) * C::SHM_K + wid * 1024; \
        _Pragma("unroll") for (int q_ = 0; q_ < NKI; ++q_) if (wid + 8 * q_ < NKP) \
            __builtin_amdgcn_global_load_lds((const unsigned*)(kt_ + kgo[q_]), (LAS unsigned*)(kd_ + q_ * 8192), 16, 0, 0); } while (0)
#define ATT_DMAV(j) do { const int k0_ = ATT_KROW0(j); const char* vt_ = (const char*)(a.V + (size_t)k0_ * a.vs); LAS char* vd_ = V_lds + ((j) & 1) * C::SHM_V + wid * 1024; \
        __builtin_amdgcn_global_load_lds((const unsigned*)(vt_ + vgo[0]), (LAS unsigned*)(vd_), 16, 0, 0); \
        __builtin_amdgcn_global_load_lds((const unsigned*)(vt_ + vgo[1]), (LAS unsigned*)(vd_ + 8192), 16, 0, 0); } while (0)
#define ATT_LOADPOS(j) do { if constexpr (DIL) { if (tid < 64) ppos = a.pos[(size_t)(ATT_KROW0(j) + tid) * a.ps]; } } while (0)
#define ATT_WRITEPOS(j) do { if constexpr (DIL) { if (tid < 64) pos_l[((j) & 1) * 64 + tid] = ppos; } } while (0)
#define ATT_VMW() asm volatile("s_waitcnt vmcnt(0)" ::: "memory")
#define ATT_BAR() do { asm volatile("s_waitcnt lgkmcnt(0)" ::: "memory"); __builtin_amdgcn_s_barrier(); asm volatile("" ::: "memory"); } while (0)
#define ATT_RESC(al) do { if (__any((al) < 1.f)) { if (hi == 0) al_l[r32] = (al); asm volatile("s_waitcnt lgkmcnt(0)" ::: "memory"); \
        _Pragma("unroll") for (int d = 0; d < 4; ++d) _Pragma("unroll") for (int r = 0; r < 16; ++r) o[d][r] *= al_l[crow(r, hi)]; } } while (0)
#define ATT_DL0(j) (DIL ? (64 * (a.kt0 + (j)) - lq + 4 * hi) : 0)
#define ATT_TV(j) (DIL ? ((a.kt0 + (j)) >= 0 && (a.kt0 + (j)) < a.ktn) : true)
    f32x16 p0, p1; float mn, al; bf16x8 pa0, pa1, pa2, pa3; const int NT = a.nt;
    const bool grpB = wid >= 4;
    ATT_DMAK(0); ATT_DMAK(1); ATT_DMAV(0); ATT_LOADPOS(0); ATT_VMW(); ATT_WRITEPOS(0); ATT_LOADPOS(1);
    __syncthreads();
    if (grpB) ATT_BAR();
#if defined(PROBE_TIMING)
    unsigned long long tacc = 0, tt0 = 0; const unsigned long long tstart = __builtin_amdgcn_s_memtime(), rstart = __builtin_amdgcn_s_memrealtime();
#define TSTAMP() __builtin_amdgcn_s_memtime()
#else
#define TSTAMP() 0ull
#endif
#pragma unroll 1
    for (int j = 0; j < NT; ++j) {
        const int cur = j & 1;
#if defined(PROBE_TIMING)
        tt0 = TSTAMP();
#endif
        if (!grpB && j >= 1) { if (j + 1 < NT) ATT_DMAK(j + 1); ATT_DMAV(j); }
        ATT_SBAR();
        const bool act = !DIL || (j >= (wid >> 1) && j <= (wid >> 1) + 2), actp = !DIL || (j - 1 >= (wid >> 1) && j - 1 <= (wid >> 1) + 2);
        xstage<DIL>(j > 0 && actp, act, o, vb0 + (cur ^ 1) * (int)C::SHM_V, pa0, pa1, pa2, pa3, p0, p1, K_lds + cur * C::SHM_K, qr, r32, hi);
        ATT_SBAR();
#if defined(PROBE_TIMING) && PROBE_TIMING == 2
        tacc += TSTAMP() - tt0;
#endif
        if (grpB) ATT_VMW();
#if defined(PROBE_TIMING) && PROBE_TIMING == 5
        tt0 = TSTAMP();
#endif
        ATT_BAR();
#if defined(PROBE_TIMING) && PROBE_TIMING == 5
        tacc += TSTAMP() - tt0;
#endif
#if defined(PROBE_TIMING) && PROBE_TIMING == 3
        tt0 = TSTAMP();
#endif
        if (grpB) { if (j + 2 < NT) ATT_DMAK(j + 2); if (j + 1 < NT) ATT_DMAV(j + 1); }
        if (act) {
        partialSM<DIL>(p0, p1, m_reg, mn, al, pos_l + cur * 64, lut, pq, ATT_DL0(j), ATT_TV(j), hi);
        ATT_RESC(al);
        finishSM(p0, p1, al, l_reg, pa0, pa1, pa2, pa3);
        }
        if constexpr (DIL) { if (!grpB && j + 1 < NT) { ATT_WRITEPOS(j + 1); if (j + 2 < NT) ATT_LOADPOS(j + 2); } }
        ATT_SBAR();
#if defined(PROBE_TIMING) && PROBE_TIMING == 3
        tacc += TSTAMP() - tt0;
#endif
        if (!grpB) ATT_VMW();
        ATT_BAR();
    }
#if defined(PROBE_TIMING)
    if (!DIL && a.dbg && tid == PROBE_TID) { const unsigned long long tend = TSTAMP(), rend = __builtin_amdgcn_s_memrealtime(); float v;
        if (PROBE_TIMING == 1) v = (float)(tend - tstart) / (float)NT * 1e-5f;
        else if (PROBE_TIMING == 4) v = (float)(tend - tstart) / (float)(rend - rstart) * 1e-3f;
        else v = (float)tacc / (float)NT * 1e-5f;
        *a.dbg = v; }
#endif
    if (!DIL || (NT - 1 <= (wid >> 1) + 2)) pv_d0(o, vb0 + ((NT - 1) & 1) * (int)C::SHM_V, pa0, pa1, pa2, pa3);
    if (!grpB) ATT_BAR();
    ATT_BAR();
    if (hi == 0) li_l[r32] = l_reg; asm volatile("s_waitcnt lgkmcnt(0)" ::: "memory");
    { LAS char* ot = lds + wid * 8448;
#pragma unroll
      for (int r = 0; r < 16; ++r) { const int orow = crow(r, hi); const float rl = __builtin_amdgcn_rcpf(li_l[orow]);
#pragma unroll
          for (int d0 = 0; d0 < 4; ++d0) { const float v = o[d0][r] * rl; *(LAS bf16_t*)(ot + orow * 264 + (d0 * 32 + r32) * 2) = (bf16_t)(cvt_pk_bf16(v, v) & 0xffffu); } }
      asm volatile("s_waitcnt lgkmcnt(0)" ::: "memory");
      char* Ow = (char*)(a.O + (size_t)(wid * 32) * a.os);
      const int orow0 = lane >> 4, ocol = (lane & 15) * 16;
#pragma unroll
      for (int i = 0; i < 8; ++i) { const int orow = orow0 + 4 * i; const u32x2 w0 = *(const LAS u32x2*)(ot + orow * 264 + ocol), w1 = *(const LAS u32x2*)(ot + orow * 264 + ocol + 8);
          u32x4 w; w.x = w0.x; w.y = w0.y; w.z = w1.x; w.w = w1.y;
          *(u32x4*)(Ow + (size_t)orow * a.os * 2 + ocol) = w; } }
    if constexpr (DIL) { if (hi == 0) a.lse[(size_t)(wid * 32 + r32) * a.ls] = m_reg + __builtin_amdgcn_logf(l_reg); }
    __syncthreads();
#undef ATT_KROW0
#undef ATT_BAR
#undef ATT_DMAK
#undef ATT_DMAV
#undef ATT_LOADPOS
#undef ATT_WRITEPOS
#undef ATT_VMW
#undef ATT_RESC
#undef ATT_DL0
#undef ATT_TV
}
}
#if defined(MK_CHECK) && MK_CHECK
#ifndef CHK_XOR_ROW
#define CHK_XOR_ROW 0
#endif
namespace chk {
__device__ __forceinline__ unsigned hash32(unsigned x) { x ^= x >> 16; x *= 0x7feb352du; x ^= x >> 15; x *= 0x846ca68bu; x ^= x >> 16; return x; }
__device__ __forceinline__ void flag(unsigned* ctl, int bit) { atomicOr(ctl + CW_DBG, 1u << bit); }
__device__ __forceinline__ bool bad_l2(float err2, float ref2, float tol) { err2 = wave_sum(err2); ref2 = wave_sum(ref2); return !(err2 <= tol * tol * ref2 + 1e-12f); }
__device__ __forceinline__ void ref_cos_sin(int pos, int j, float& c, float& s) {
    const float inv = powf(10000.0f, -(float)(2 * j) / 64.0f); const float ang = (float)pos * inv;
    c = (float)cos((double)ang); s = (float)sin((double)ang);
}
__device__ __forceinline__ int ref_bucket(int rel) {
    int ret = rel > 0 ? 16 : 0; int n = rel < 0 ? -rel : rel; float nf = (float)(n < 1 ? 1 : n);
    float v = logf(nf / 8.0f) / 4.852030263919617f * 8.0f; int large = 8 + (int)v; if (large > 15) large = 15;
    return ret + (n < 8 ? n : large);
}
__device__ __forceinline__ void check_proj(const Frame& F, int b, unsigned* ctl, const bf16_t* P, const bf16_t* CQN, const bf16_t* CKVN, const bf16_t* QB, const bf16_t* KB, const bf16_t* VB,
                                           const float* gq, const float* gkv, const float* w_uq, const float* w_ukv, const int* positions) {
    const int lane = opaque_tid() & 63;
    for (int smp = F.gw; smp < 4096; smp += F.NGW) {
        const unsigned hsh = hash32(smp * 2654435761u + b * 97u + 12345u);
        const int t = hsh % SEQ, hd = (hsh >> 13) & 7, kind = smp & 3;
        const bf16_t* pr = P + (size_t)t * NP;
        if (kind == 0) {
            float ss = 0.f; for (int k = lane; k < 384; k += 64) { const float v = bf2f(pr[C_CQ + k]); ss += v * v; }
            const float rq = 1.0f / sqrtf(wave_sum(ss) / 384.f + NORM_EPS); float e2 = 0.f, r2 = 0.f;
            for (int k = lane; k < 384; k += 64) { const float ref = bf2f(pr[C_CQ + k]) * rq * gq[k], got = bf2f(CQN[(size_t)t * 384 + k]); e2 += (ref - got) * (ref - got); r2 += ref * ref; }
            if (bad_l2(e2, r2, 0.01f)) flag(ctl, 0);
            ss = 0.f; for (int k = lane; k < 256; k += 64) { const float v = bf2f(pr[C_CKV + k]); ss += v * v; }
            const float rk = 1.0f / sqrtf(wave_sum(ss) / 256.f + NORM_EPS); e2 = 0.f; r2 = 0.f;
            for (int k = lane; k < 256; k += 64) { const float ref = bf2f(pr[C_CKV + k]) * rk * gkv[k], got = bf2f(CKVN[(size_t)t * 256 + k]); e2 += (ref - got) * (ref - got); r2 += ref * ref; }
            if (bad_l2(e2, r2, 0.01f)) flag(ctl, 0);
        } else if (kind == 1) {
            float q[3] = {0.f, 0.f, 0.f};
            for (int k = 0; k < 384; ++k) { const float a = bf2f(CQN[(size_t)t * 384 + k]);
#pragma unroll
                for (int i = 0; i < 3; ++i) q[i] += a * w_uq[(size_t)k * 1536 + hd * 192 + lane + 64 * i]; }
            float e2 = 0.f, r2 = 0.f;
#pragma unroll
            for (int i = 0; i < 2; ++i) { const float got = bf2f(QB[((size_t)hd * SEQ + t) * 192 + lane + 64 * i]); e2 += (q[i] - got) * (q[i] - got); r2 += q[i] * q[i]; }
            const float other = __shfl_xor(q[2], 32); float c, s; ref_cos_sin(positions[(size_t)b * SEQ + t], lane & 31, c, s);
            const float x1 = lane < 32 ? q[2] : other, x2 = lane < 32 ? other : q[2];
            const float ref = lane < 32 ? x1 * c - x2 * s : x1 * s + x2 * c;
            const float got = bf2f(QB[((size_t)hd * SEQ + t) * 192 + 128 + 2 * (lane & 31) + (lane >> 5)]); e2 += (ref - got) * (ref - got); r2 += ref * ref;
            if (bad_l2(e2, r2, 0.015f)) flag(ctl, 1);
        } else if (kind == 2) {
            float kk[2] = {0.f, 0.f};
            for (int k = 0; k < 256; ++k) { const float a = bf2f(CKVN[(size_t)t * 256 + k]); kk[0] += a * w_ukv[(size_t)k * 2048 + hd * 256 + lane]; kk[1] += a * w_ukv[(size_t)k * 2048 + hd * 256 + 64 + lane]; }
            float e2 = 0.f, r2 = 0.f;
#pragma unroll
            for (int i = 0; i < 2; ++i) { const float got = bf2f(KB[((size_t)hd * SEQ + t) * 192 + lane + 64 * i]); e2 += (kk[i] - got) * (kk[i] - got); r2 += kk[i] * kk[i]; }
            float c, s; ref_cos_sin(positions[(size_t)b * SEQ + t], lane & 31, c, s);
            const float x1 = bf2f(pr[C_KPE + (lane & 31)]), x2 = bf2f(pr[C_KPE + 32 + (lane & 31)]);
            const float ref = lane < 32 ? x1 * c - x2 * s : x1 * s + x2 * c;
            const float got = bf2f(KB[((size_t)hd * SEQ + t) * 192 + 128 + 2 * (lane & 31) + (lane >> 5)]); e2 += (ref - got) * (ref - got); r2 += ref * ref;
            if (bad_l2(e2, r2, 0.015f)) flag(ctl, 2);
        } else {
            float vv[2] = {0.f, 0.f};
            for (int k = 0; k < 256; ++k) { const float a = bf2f(CKVN[(size_t)t * 256 + k]); vv[0] += a * w_ukv[(size_t)k * 2048 + hd * 256 + 128 + lane]; vv[1] += a * w_ukv[(size_t)k * 2048 + hd * 256 + 192 + lane]; }
            float e2 = 0.f, r2 = 0.f;
#pragma unroll
            for (int i = 0; i < 2; ++i) { const float got = bf2f(VB[((size_t)hd * SEQ + t) * 128 + lane + 64 * i]); e2 += (vv[i] - got) * (vv[i] - got); r2 += vv[i] * vv[i]; }
            if (bad_l2(e2, r2, 0.015f)) flag(ctl, 3);
        }
    }
}
__device__ __forceinline__ void check_mla(const Frame& F, int b, unsigned* ctl, const bf16_t* QB, const bf16_t* KB, const bf16_t* VB, const bf16_t* OA) {
    const int tid = opaque_tid(), lane = tid & 63, wave = tid >> 6;
    LAS float* qf = (LAS float*)F.lds;
    LAS float* red = qf + 192;
    LAS float* pp = red + 64;
    LAS float* oacc = pp + SEQ;
    const unsigned hsh = hash32(blockIdx.x * 40503u + b * 977u + 777u);
    const int t = hsh % SEQ, hd = (hsh >> 13) & 7;
#if defined(FORCE_FLAG)
    if (blockIdx.x == 100 && tid == 5 && b == 2) flag(ctl, FORCE_FLAG);
#endif
    __syncthreads();
    if (tid < 192) qf[tid] = bf2f(QB[((size_t)hd * SEQ + t) * 192 + tid]);
    __syncthreads();
    float mx = -1e30f;
    for (int k = tid; k < SEQ; k += 512) { const bf16_t* kr = KB + ((size_t)hd * SEQ + k) * 192; float s = 0.f;
        for (int d = 0; d < 192; ++d) s += qf[d] * bf2f(kr[d]);
        s *= 0.07216878364870322f; pp[k] = s; mx = fmaxf(mx, s); }
#pragma unroll
    for (int o = 1; o < 64; o <<= 1) mx = fmaxf(mx, __shfl_xor(mx, o));
    if (lane == 0) red[wave] = mx;
    __syncthreads();
    mx = red[0]; for (int w = 1; w < 8; ++w) mx = fmaxf(mx, red[w]);
    __syncthreads();
    float sm = 0.f;
    for (int k = tid; k < SEQ; k += 512) { const float p = expf(pp[k] - mx); pp[k] = p; sm += p; }
    sm = wave_sum(sm); if (lane == 0) red[wave] = sm;
    __syncthreads();
    sm = 0.f; for (int w = 0; w < 8; ++w) sm += red[w];
    const int c = tid & 127, part = tid >> 7; float acc = 0.f;
    for (int k = part * 2048; k < part * 2048 + 2048; ++k) acc += pp[k] * bf2f(VB[((size_t)hd * SEQ + k) * 128 + c]);
    oacc[part * 128 + c] = acc;
    __syncthreads();
    if (tid < 64) { float e2 = 0.f, r2 = 0.f;
#pragma unroll
        for (int i = 0; i < 2; ++i) { const int cc = tid + 64 * i; const float ref = (oacc[cc] + oacc[128 + cc] + oacc[256 + cc] + oacc[384 + cc]) / sm, got = bf2f(OA[(size_t)(t ^ CHK_XOR_ROW) * DM + hd * 128 + cc]);
            e2 += (ref - got) * (ref - got); r2 += ref * ref; }
#if defined(CHK_MEASURE) && CHK_MEASURE == 4
        { const float re = sqrtf(wave_sum(e2) / wave_sum(r2)); int k = (int)floorf(-log2f(re)); k = k < 0 ? 0 : (k > 15 ? 15 : k); flag(ctl, k); }
#else
        if (bad_l2(e2, r2, 0.03f)) flag(ctl, 4);
#endif
    }
    __syncthreads();
}
__device__ __forceinline__ void check_dil(const Frame& F, int b, unsigned* ctl, const bf16_t* P, const int* positions, const float* rel_bias, const bf16_t* OG, const float* LSE) {
    const int tid = opaque_tid(), lane = tid & 63, wave = tid >> 6;
    LAS float* pw = (LAS float*)F.lds + wave * 256;
    for (int smp = F.gw; smp < 4096; smp += F.NGW) {
        const unsigned hsh = hash32(smp * 2246822519u + b * 131u + 999u);
        int t = hsh % SEQ; const int hd = (hsh >> 13) & 7, grp = (hsh >> 16) % 3, d = grp == 0 ? 1 : (grp == 1 ? 4 : 16);
        if ((smp & 7) == 0) t = (smp >> 3) % 40;
        if ((smp & 7) == 1) t = SEQ - 1 - ((smp >> 3) % 40);
        const bf16_t* base = P + C_DIL + grp * 3072 + hd * 128;
        const int pq = positions[(size_t)b * SEQ + t];
        float sc[3]; float mx = -1e30f;
#pragma unroll
        for (int i = 0; i < 3; ++i) { const int j = lane + 64 * i - 64, tk = t + j * d; sc[i] = -1e30f;
            if (j <= 64 && tk >= 0 && tk < SEQ) { float s = 0.f; const bf16_t* qr = base + (size_t)t * NP; const bf16_t* kr = base + 1024 + (size_t)tk * NP;
                for (int e = 0; e < 128; ++e) s += bf2f(qr[e]) * bf2f(kr[e]);
                s = s * 0.08838834764831845f + rel_bias[ref_bucket(positions[(size_t)b * SEQ + tk] - pq) * 24 + grp * 8 + hd]; sc[i] = s; }
            mx = fmaxf(mx, sc[i]); }
#pragma unroll
        for (int o = 1; o < 64; o <<= 1) mx = fmaxf(mx, __shfl_xor(mx, o));
        float sm = 0.f;
#pragma unroll
        for (int i = 0; i < 3; ++i) { const int j = lane + 64 * i; const float p = sc[i] > -1e29f ? expf(sc[i] - mx) : 0.f; if (j < 129) pw[j] = p; sm += p; }
        sm = wave_sum(sm);
        LDS_WAIT();
        float o0 = 0.f, o1 = 0.f;
        for (int j = 0; j < 129; ++j) { const int tk = t + (j - 64) * d; if (tk < 0 || tk >= SEQ) continue; const float p = pw[j]; const bf16_t* vr = base + 2048 + (size_t)tk * NP;
            o0 += p * bf2f(vr[lane]); o1 += p * bf2f(vr[64 + lane]); }
        o0 /= sm; o1 /= sm;
        const float g0 = bf2f(OG[((size_t)grp * SEQ + t) * DM + hd * 128 + lane]), g1 = bf2f(OG[((size_t)grp * SEQ + t) * DM + hd * 128 + 64 + lane]);
        if (bad_l2((o0 - g0) * (o0 - g0) + (o1 - g1) * (o1 - g1), o0 * o0 + o1 * o1, 0.03f)) flag(ctl, 5);
        const float lse2 = (mx + logf(sm)) * LOG2E, got = LSE[((size_t)grp * SEQ + t) * 8 + hd];
        if (!(fabsf(lse2 - got) <= 0.05f)) flag(ctl, 6);
        LDS_WAIT();
    }
}
__device__ __forceinline__ void check_u(const Frame& F, int b, unsigned* ctl, const bf16_t* P, const bf16_t* OA, const bf16_t* OG, const float* LSE, const bf16_t* Ub) {
    const int lane = opaque_tid() & 63;
    for (int smp = F.gw; smp < 2048; smp += F.NGW) {
        const int t = hash32(smp * 374761393u + b * 31u + 5u) % SEQ; float e2 = 0.f, r2 = 0.f;
        for (int c = lane; c < DM; c += 64) { const int hd = c >> 7;
            const float l0 = LSE[((size_t)0 * SEQ + t) * 8 + hd], l1 = LSE[((size_t)1 * SEQ + t) * 8 + hd], l2 = LSE[((size_t)2 * SEQ + t) * 8 + hd], mx = fmaxf(l0, fmaxf(l1, l2));
            const float w0 = exp2f(l0 - mx), w1 = exp2f(l1 - mx), w2 = exp2f(l2 - mx), ws_ = w0 + w1 + w2;
            const float ob = (w0 * bf2f(OG[((size_t)0 * SEQ + t) * DM + c]) + w1 * bf2f(OG[((size_t)1 * SEQ + t) * DM + c]) + w2 * bf2f(OG[((size_t)2 * SEQ + t) * DM + c])) / ws_;
            const float ga = 1.f / (1.f + expf(-bf2f(P[(size_t)t * NP + C_GATE + c]))), gb = 1.f / (1.f + expf(-bf2f(P[(size_t)t * NP + C_GATE + 1024 + c])));
            const float ref = ga * bf2f(OA[(size_t)t * DM + c]) + gb * ob, got = bf2f(Ub[(size_t)t * DM + c]); e2 += (ref - got) * (ref - got); r2 += ref * ref; }
        if (bad_l2(e2, r2, 0.01f)) flag(ctl, 7);
    }
}
}
#endif
template <class F>
__device__ __forceinline__ void transpose_item(F colptr, int ldn, bf16_t* WT, int ldk, int k0, int n0, LAS float* scr, int lane) {
    const float* cp = colptr(n0 + (lane & 31));
    float tv[32];
    const float* cpk = cp ? cp + (size_t)(k0 + (lane >> 5)) * ldn : nullptr;
#pragma unroll
    for (int i = 0; i < 32; ++i) tv[i] = cpk ? cpk[(size_t)(2 * i) * ldn] : 0.f;
#pragma unroll
    for (int i = 0; i < 32; ++i) scr[(2 * i + (lane >> 5)) * 33 + (lane & 31)] = tv[i];
    LDS_WAIT(); asm volatile("" ::: "memory");
    const int c = lane & 7;
#pragma unroll
    for (int j = 0; j < 4; ++j) { const int n = (lane >> 3) + 8 * j; const LAS float* s = scr + (8 * c) * 33 + n;
        u32x4 o; o.x = cvt_pk_bf16(s[0 * 33], s[1 * 33]); o.y = cvt_pk_bf16(s[2 * 33], s[3 * 33]); o.z = cvt_pk_bf16(s[4 * 33], s[5 * 33]); o.w = cvt_pk_bf16(s[6 * 33], s[7 * 33]);
        *(u32x4*)(WT + (size_t)(n0 + n) * ldk + k0 + 8 * c) = o; }
    LDS_WAIT(); asm volatile("" ::: "memory");
}

__device__ __forceinline__ void p0_mod(const Frame& F, const float* c, const float* w_ada, const float* b_ada, float* mod) {
    const int tid = opaque_tid(), lane = tid & 63; (void)tid; (void)lane;
    LAS float* red = (LAS float*)F.lds;
    for (int blk = blockIdx.x; blk < 96; blk += F.G) {
        const int col = blk * 64 + (tid & 63), ks = tid >> 6;
        float a0 = 0.f, a1 = 0.f, a2 = 0.f, a3 = 0.f;
        for (int k = ks * 128; k < ks * 128 + 128; ++k) {
            const float w = w_ada[(size_t)k * 6144 + col];
            const float c0 = c[k], c1 = c[1024 + k], c2 = c[2048 + k], c3 = c[3072 + k];
            a0 += c0 * fast_sigmoid(c0) * w; a1 += c1 * fast_sigmoid(c1) * w; a2 += c2 * fast_sigmoid(c2) * w; a3 += c3 * fast_sigmoid(c3) * w;
        }
        red[(ks * 4 + 0) * 64 + (tid & 63)] = a0; red[(ks * 4 + 1) * 64 + (tid & 63)] = a1; red[(ks * 4 + 2) * 64 + (tid & 63)] = a2; red[(ks * 4 + 3) * 64 + (tid & 63)] = a3;
        __syncthreads();
        if (tid < 256) { const int b = tid >> 6, cc = tid & 63; float s = 0.f;
#pragma unroll
            for (int q = 0; q < 8; ++q) s += red[(q * 4 + b) * 64 + cc];
            mod[b * 6144 + blk * 64 + cc] = s + b_ada[blk * 64 + cc]; }
        __syncthreads();
    }
}
__device__ __forceinline__ void p0_cs(const Frame& F, const int* pos, float* cs) {
    const int tid = opaque_tid(), lane = tid & 63; (void)tid; (void)lane;
    for (int i = (int)blockIdx.x * 512 + tid; i < NTOK * 32; i += F.G * 512) {
        const int t = i >> 5, j = i & 31;
        const float inv = __builtin_amdgcn_exp2f(-(float)(2 * j) / 64.f * 13.287712379549449f);
        const float ang = (float)pos[t] * inv;
        const double rev = (double)ang * 0.15915494309189535; const double fr = rev - __builtin_rint(rev);
        const float f = (float)fr;
        f32x2 o; o.x = __builtin_amdgcn_cosf(f); o.y = __builtin_amdgcn_sinf(f);
        *(f32x2*)(cs + (size_t)i * 2) = o;
    }
}
__device__ __forceinline__ void p0_weights(const Frame& F, const float* w_in, const float* w_uq, const float* w_ukv, const float* w_out, unsigned char* ws) {
    const int tid = opaque_tid(), lane = tid & 63; (void)tid; (void)lane;
    LAS float* scr = (LAS float*)(F.lds + F.wave * 16384);
    constexpr int I_IN = 16 * 376, I_UQ = 6 * 48, I_UKV = 4 * 64, I_OUT = 16 * 32;
    for (int it = F.gw; it < I_IN + I_UQ + I_UKV + I_OUT; it += F.NGW) {
        int r = it;
        if (r < I_IN) { const int kb = r / 376, nb = r % 376;
            transpose_item([=](int n) -> const float* { return n < D_IN ? w_in + n : nullptr; }, D_IN, (bf16_t*)(ws + WS_WIN), 1024, kb * 64, nb * 32, scr, lane); continue; }
        r -= I_IN;
        if (r < I_UQ) { const int kb = r / 48, nb = r % 48;
            transpose_item([=](int n) -> const float* { const int hd = n / 192, w = n - hd * 192; const int sc = w < 128 ? w : 128 + ((w - 128) >> 1) + 32 * ((w - 128) & 1); return w_uq + hd * 192 + sc; },
                           1536, (bf16_t*)(ws + WS_WUQ), 384, kb * 64, nb * 32, scr, lane); continue; }
        r -= I_UQ;
        if (r < I_UKV) { const int kb = r / 64, nb = r % 64;
            transpose_item([=](int n) -> const float* { return w_ukv + n; }, 2048, (bf16_t*)(ws + WS_WUKV), 256, kb * 64, nb * 32, scr, lane); continue; }
        r -= I_UKV;
        { const int kb = r / 32, nb = r % 32;
            transpose_item([=](int n) -> const float* { return w_out + n; }, 1024, (bf16_t*)(ws + WS_WOUT), 1024, kb * 64, nb * 32, scr, lane); }
    }
}
__device__ __forceinline__ void conv_experts(const Frame& F, const float* w_gate, const float* w_up, const float* w_down, unsigned char* ws) {
    const int tid = opaque_tid(), lane = tid & 63; (void)tid; (void)lane;
    LAS float* scr = (LAS float*)(F.lds + F.wave * 16384);
    for (int it = F.gw; it < NE * 3072; it += F.NGW) {
        const int e = it / 3072; int r = it % 3072;
        if (r < 2048) { const int kb = r / 128, nb = r % 128;
            const float* wg = w_gate + (size_t)e * DM * DFF; const float* wu = w_up + (size_t)e * DM * DFF;
            const long du = (const char*)wu - (const char*)wg;
            transpose_item([=](int n) -> const float* { const int grp = n >> 3, q = n & 7; return (const float*)((const char*)wg + (q < 4 ? 0L : du)) + 4 * grp + (q & 3); }, DFF,
                           (bf16_t*)(ws + WS_WGU) + (size_t)e * 4096 * 1024, 1024, kb * 64, nb * 32, scr, lane); continue; }
        r -= 2048;
        { const int kb = r / 32, nb = r % 32; const float* wd = w_down + (size_t)e * DFF * DM;
            transpose_item([=](int n) -> const float* { return wd + n; }, DM, (bf16_t*)(ws + WS_WD) + (size_t)e * 1024 * 2048, 2048, kb * 64, nb * 32, scr, lane); }
    }
}
__device__ __forceinline__ void norm_mod_row(const float* xrow, const float* g, const float* sh, const float* sc, int lane, f32x4 (&v)[4]) {
    float s = 0.f;
#pragma unroll
    for (int j = 0; j < 4; ++j) { v[j] = *(const f32x4*)(xrow + 4 * lane + 256 * j); s += (v[j][0] * v[j][0] + v[j][1] * v[j][1]) + (v[j][2] * v[j][2] + v[j][3] * v[j][3]); }
    const float rstd = 1.0f / sqrtf(wave_sum(s) * (1.f / DM) + NORM_EPS);
#pragma unroll
    for (int j = 0; j < 4; ++j) { const int c = 4 * lane + 256 * j; const f32x4 gg = *(const f32x4*)(g + c), s1 = *(const f32x4*)(sc + c), s0 = *(const f32x4*)(sh + c);
        v[j] = (v[j] * rstd * gg) * (s1 + 1.0f) + s0; }
}
__device__ __forceinline__ void store_row_bf16(bf16_t* orow, int lane, const f32x4 (&v)[4]) {
#pragma unroll
    for (int j = 0; j < 4; ++j) { u32x2 o; o.x = cvt_pk_bf16(v[j][0], v[j][1]); o.y = cvt_pk_bf16(v[j][2], v[j][3]); *(u32x2*)(orow + 4 * lane + 256 * j) = o; }
}
__device__ __forceinline__ void p1_h(const Frame& F, const float* x, const float* g, const float* mod, bf16_t* H) {
    const int tid = opaque_tid(), lane = tid & 63; (void)tid; (void)lane;
    for (int t = F.gw; t < NTOK; t += F.NGW) { const int b = t / SEQ; f32x4 v[4];
        norm_mod_row(x + (size_t)t * DM, g, mod + b * 6144 + 0, mod + b * 6144 + 1024, lane, v);
        store_row_bf16(H + (size_t)t * DM, lane, v); }
}
__device__ __forceinline__ void lb_latent(const Frame& F, const bf16_t* P, const float* gq, const float* gkv, const float* cs, bf16_t* CQN, bf16_t* CKVN, bf16_t* KB) {
    const int tid = opaque_tid(), lane = tid & 63; (void)tid; (void)lane;
    for (int t = F.gw; t < SEQ; t += F.NGW) {
        const bf16_t* pr = P + (size_t)t * NP;
        float q[8], s = 0.f;
        if (lane < 48) { const u32x4 w = *(const u32x4*)(pr + C_CQ + 8 * lane);
            q[0] = bflo(w.x); q[1] = bfhi(w.x); q[2] = bflo(w.y); q[3] = bfhi(w.y); q[4] = bflo(w.z); q[5] = bfhi(w.z); q[6] = bflo(w.w); q[7] = bfhi(w.w);
#pragma unroll
            for (int e = 0; e < 8; ++e) s += q[e] * q[e]; }
        const float rq = 1.0f / sqrtf(wave_sum(s) * (1.f / 384.f) + NORM_EPS);
        if (lane < 48) { const f32x4 g0 = *(const f32x4*)(gq + 8 * lane), g1 = *(const f32x4*)(gq + 8 * lane + 4);
            u32x4 o; o.x = cvt_pk_bf16(q[0] * rq * g0[0], q[1] * rq * g0[1]); o.y = cvt_pk_bf16(q[2] * rq * g0[2], q[3] * rq * g0[3]);
            o.z = cvt_pk_bf16(q[4] * rq * g1[0], q[5] * rq * g1[1]); o.w = cvt_pk_bf16(q[6] * rq * g1[2], q[7] * rq * g1[3]);
            *(u32x4*)(CQN + (size_t)t * 384 + 8 * lane) = o; }
        float s2 = 0.f;
        if (lane < 32) { const u32x4 w = *(const u32x4*)(pr + C_CKV + 8 * lane);
            q[0] = bflo(w.x); q[1] = bfhi(w.x); q[2] = bflo(w.y); q[3] = bfhi(w.y); q[4] = bflo(w.z); q[5] = bfhi(w.z); q[6] = bflo(w.w); q[7] = bfhi(w.w);
#pragma unroll
            for (int e = 0; e < 8; ++e) s2 += q[e] * q[e]; }
        const float rk = 1.0f / sqrtf(wave_sum(s2) * (1.f / 256.f) + NORM_EPS);
        if (lane < 32) { const f32x4 g0 = *(const f32x4*)(gkv + 8 * lane), g1 = *(const f32x4*)(gkv + 8 * lane + 4);
            u32x4 o; o.x = cvt_pk_bf16(q[0] * rk * g0[0], q[1] * rk * g0[1]); o.y = cvt_pk_bf16(q[2] * rk * g0[2], q[3] * rk * g0[3]);
            o.z = cvt_pk_bf16(q[4] * rk * g1[0], q[5] * rk * g1[1]); o.w = cvt_pk_bf16(q[6] * rk * g1[2], q[7] * rk * g1[3]);
            *(u32x4*)(CKVN + (size_t)t * 256 + 8 * lane) = o;
            const float x1 = bf2f(pr[C_KPE + lane]), x2 = bf2f(pr[C_KPE + 32 + lane]); const f32x2 c = *(const f32x2*)(cs + ((size_t)t * 32 + lane) * 2);
            const unsigned pk = cvt_pk_bf16(x1 * c.x - x2 * c.y, x1 * c.y + x2 * c.x);
#pragma unroll
            for (int h = 0; h < 8; ++h) *(unsigned*)(KB + ((size_t)h * SEQ + t) * 192 + 128 + 2 * lane) = pk; }
    }
}
__device__ __forceinline__ void lb_combine(const Frame& F, const bf16_t* P, const bf16_t* OA, const bf16_t* OG, const float* LSE, bf16_t* U) {
    const int tid = opaque_tid(), lane = tid & 63; (void)tid; (void)lane;
    for (int t = F.gw; t < SEQ; t += F.NGW) {
#pragma unroll
        for (int j = 0; j < 2; ++j) { const int c0 = 8 * lane + 512 * j, hd = c0 >> 7;
            const float l0 = LSE[((size_t)0 * SEQ + t) * 8 + hd], l1 = LSE[((size_t)1 * SEQ + t) * 8 + hd], l2 = LSE[((size_t)2 * SEQ + t) * 8 + hd];
            const float mx = fmaxf(l0, fmaxf(l1, l2)); float w0 = __builtin_amdgcn_exp2f(l0 - mx), w1 = __builtin_amdgcn_exp2f(l1 - mx), w2 = __builtin_amdgcn_exp2f(l2 - mx);
            const float inv = 1.0f / (w0 + w1 + w2); w0 *= inv; w1 *= inv; w2 *= inv;
            const u32x4 oa = *(const u32x4*)(OA + (size_t)t * DM + c0), g0 = *(const u32x4*)(OG + ((size_t)0 * SEQ + t) * DM + c0), g1 = *(const u32x4*)(OG + ((size_t)1 * SEQ + t) * DM + c0),
                        g2 = *(const u32x4*)(OG + ((size_t)2 * SEQ + t) * DM + c0), ga = *(const u32x4*)(P + (size_t)t * NP + C_GATE + c0), gb = *(const u32x4*)(P + (size_t)t * NP + C_GATE + 1024 + c0);
            u32x4 o;
#pragma unroll
            for (int e = 0; e < 4; ++e) {
                const float ob_lo = w0 * bflo(g0[e]) + w1 * bflo(g1[e]) + w2 * bflo(g2[e]), ob_hi = w0 * bfhi(g0[e]) + w1 * bfhi(g1[e]) + w2 * bfhi(g2[e]);
                const float u_lo = fast_sigmoid(bflo(ga[e])) * bflo(oa[e]) + fast_sigmoid(bflo(gb[e])) * ob_lo;
                const float u_hi = fast_sigmoid(bfhi(ga[e])) * bfhi(oa[e]) + fast_sigmoid(bfhi(gb[e])) * ob_hi;
                o[e] = cvt_pk_bf16(u_lo, u_hi); }
            *(u32x4*)(U + (size_t)t * DM + c0) = o; }
    }
}
__device__ __forceinline__ void pg_h2_router(const Frame& F, const float* x1, const float* g, const float* mod, const float* w_router, bf16_t* H2, float* AFFT) {
    const int tid = opaque_tid(), lane = tid & 63; (void)tid;
    LAS float* wr = (LAS float*)F.lds;
    LAS float* ab = (LAS float*)(F.lds + 65536) + F.wave * 256;
    for (int i = tid; i < 1024 * 16 / 4; i += 512) { const int c = i >> 2, k = i & 3, rho = (c & 3) * 256 + (c >> 2);
        ((LAS f32x4*)wr)[rho * 4 + ((k + (rho >> 2)) & 3)] = ((const f32x4*)w_router)[i]; }
    __syncthreads();
    int roff[4];
#pragma unroll
    for (int k = 0; k < 4; ++k) roff[k] = ((k + (lane >> 2)) & 3) * 4;
    for (int ch = F.gw; ch < NTOK / 16; ch += F.NGW) {
        const int t0 = ch * 16, b = t0 / SEQ, s0 = t0 % SEQ;
#pragma unroll 1
        for (int ti = 0; ti < 16; ++ti) { const int t = t0 + ti; f32x4 v[4];
            norm_mod_row(x1 + (size_t)t * DM, g, mod + b * 6144 + 3072, mod + b * 6144 + 4096, lane, v);
            store_row_bf16(H2 + (size_t)t * DM, lane, v);
            float lg[16];
#pragma unroll
            for (int e = 0; e < 16; ++e) lg[e] = 0.f;
#pragma unroll
            for (int j = 0; j < 4; ++j)
#pragma unroll
                for (int q = 0; q < 4; ++q) { const LAS float* wp = wr + (q * 256 + lane + 64 * j) * 16; const float hv = v[j][q];
#pragma unroll
                    for (int e4 = 0; e4 < 4; ++e4) { const f32x4 w = *(const LAS f32x4*)(wp + roff[e4]); lg[4 * e4 + 0] += hv * w[0]; lg[4 * e4 + 1] += hv * w[1]; lg[4 * e4 + 2] += hv * w[2]; lg[4 * e4 + 3] += hv * w[3]; } }
            float mx = -1e30f;
#pragma unroll
            for (int e = 0; e < 16; ++e) { lg[e] = wave_sum(lg[e]); mx = fmaxf(mx, lg[e]); }
            float sum = 0.f;
#pragma unroll
            for (int e = 0; e < 16; ++e) { lg[e] = __expf(lg[e] - mx); sum += lg[e]; }
            const float inv = 1.0f / sum; float mine = 0.f;
#pragma unroll
            for (int e = 0; e < 16; ++e) mine = (lane == e) ? lg[e] * inv : mine;
            if (lane < 16) ab[lane * 16 + ti] = mine;
        }
        LDS_WAIT();
        { const int e = lane >> 2, q4 = (lane & 3) * 4; const f32x4 w = *(const LAS f32x4*)(ab + e * 16 + q4);
          *(f32x4*)(AFFT + ((size_t)b * NE + e) * SEQ + s0 + q4) = w; }
        LDS_WAIT();
    }
    __syncthreads();
}
__device__ __forceinline__ void ph_topk(const Frame& F, const float* AFFT, int* TOPI, float* TOPG, int* SLOT) {
    const int tid = opaque_tid(), lane = tid & 63;
    LAS unsigned* cnt = (LAS unsigned*)F.lds;
    LAS unsigned* wtot = cnt + 64;
    for (int p = blockIdx.x; p < NB * NE; p += F.G) {
        const float* src = AFFT + (size_t)p * SEQ + 16 * tid;
        unsigned key[16];
#pragma unroll
        for (int j = 0; j < 4; ++j) { const u32x4 w = *(const u32x4*)(src + 4 * j); key[4 * j] = w.x; key[4 * j + 1] = w.y; key[4 * j + 2] = w.z; key[4 * j + 3] = w.w; }
        unsigned thr = 0u;
#pragma unroll 1
        for (int bit = 30; bit >= 0; --bit) { const unsigned cand = thr | (1u << bit); unsigned c = 0;
#pragma unroll
            for (int i = 0; i < 16; ++i) c += (unsigned)__builtin_popcountll(__ballot(key[i] >= cand));
            LAS unsigned* slot = cnt + ((bit & 1) << 3);
            if (lane == 0) slot[F.wave] = c;
            __syncthreads();
            unsigned tot = 0;
#pragma unroll
            for (int w = 0; w < 8; ++w) tot += slot[w];
            if (tot >= (unsigned)CAP) thr = cand; }
        unsigned ngt = 0, neq = 0;
#pragma unroll
        for (int i = 0; i < 16; ++i) { ngt += key[i] > thr ? 1u : 0u; neq += key[i] == thr ? 1u : 0u; }
        unsigned pk = ngt | (neq << 16), inc = pk;
#pragma unroll
        for (int o = 1; o < 64; o <<= 1) { const unsigned v = __shfl_up(inc, o); if (lane >= o) inc += v; }
        __syncthreads();
        if (lane == 63) wtot[F.wave] = inc;
        __syncthreads();
        unsigned base = 0, all = 0;
        for (int w = 0; w < 8; ++w) { const unsigned v = wtot[w]; all += v; if (w < F.wave) base += v; }
        const unsigned tot_gt = all & 0xffffu, need = (unsigned)CAP - tot_gt;
        const unsigned excl = base + inc - pk; unsigned g_before = excl & 0xffffu, e_before = excl >> 16;
#pragma unroll
        for (int i = 0; i < 16; ++i) { const int s = 16 * tid + i; int slot = -1;
            if (key[i] > thr) { slot = (int)g_before; ++g_before; }
            else if (key[i] == thr) { if (e_before < need) slot = (int)(tot_gt + e_before); ++e_before; }
            SLOT[(size_t)p * SEQ + s] = slot;
            if (slot >= 0) { TOPI[p * CAP + slot] = s; TOPG[p * CAP + slot] = __uint_as_float(key[i]); } }
        __syncthreads();
    }
}
__device__ __forceinline__ void p_final(const Frame& F, int b, float* out, const float* mod, const int* SLOT, const bf16_t* Y, const float* gfin, float oscale) {
    const int tid = opaque_tid(), lane = tid & 63; (void)tid; (void)lane;
    for (int s = F.gw; s < SEQ; s += F.NGW) { float* row = out + ((size_t)b * SEQ + s) * DM;
        int sl = -1; if (lane < NE) sl = SLOT[((size_t)b * NE + lane) * SEQ + s];
        unsigned long long m = __ballot(sl >= 0);
        f32x4 acc[4];
#pragma unroll
        for (int j = 0; j < 4; ++j) acc[j] = (f32x4){0.f, 0.f, 0.f, 0.f};
        while (m) { const int e = __builtin_ctzll(m); m &= m - 1; const int slot = __builtin_amdgcn_readlane(sl, e);
            const bf16_t* yr = Y + ((size_t)e * CAP + slot) * DM;
#pragma unroll
            for (int j = 0; j < 4; ++j) { const u32x2 w = *(const u32x2*)(yr + 4 * lane + 256 * j); acc[j][0] += bflo(w.x); acc[j][1] += bfhi(w.x); acc[j][2] += bflo(w.y); acc[j][3] += bfhi(w.y); } }
        f32x4 v[4]; float ss = 0.f;
#pragma unroll
        for (int j = 0; j < 4; ++j) { const int c = 4 * lane + 256 * j; const f32x4 gt = *(const f32x4*)(mod + b * 6144 + 5120 + c);
            v[j] = *(const f32x4*)(row + c) + gt * acc[j]; ss += (v[j][0] * v[j][0] + v[j][1] * v[j][1]) + (v[j][2] * v[j][2] + v[j][3] * v[j][3]); }
        const float rstd = 1.0f / sqrtf(wave_sum(ss) * (1.f / DM) + NORM_EPS);
#pragma unroll
        for (int j = 0; j < 4; ++j) { const int c = 4 * lane + 256 * j; *(f32x4*)(row + c) = v[j] * (rstd * oscale) * *(const f32x4*)(gfin + c); }
    }
}

__global__ void __launch_bounds__(NWAVES * 64, 2) fwd_kernel(Args args) {
    extern __shared__ __attribute__((aligned(16))) unsigned char lds_raw[];
    Frame F;
    F.lds = (LAS unsigned char*)lds_raw;
    F.tid = threadIdx.x; F.lane = F.tid & 63; F.wave = __builtin_amdgcn_readfirstlane(F.tid >> 6);
    F.G = gridDim.x; { const int bx = blockIdx.x; F.vcu = (F.G % 8 == 0) ? (bx % 8) * (F.G / 8) + bx / 8 : bx; }
    F.gw = F.vcu * NWAVES + F.wave; F.NGW = F.G * NWAVES;
    unsigned char* ws = args.ws;
    volatile LAS unsigned* MISC = (volatile LAS unsigned*)(F.lds + MISC_OFF);
    for (int u = F.tid; u < (LDS_BYTES - RING_BYTES) / 4; u += NWAVES * 64) ((LAS unsigned*)(F.lds + RING_BYTES))[u] = 0u;
    __syncthreads();
    unsigned* ctl = (unsigned*)(ws + WS_CTL);
    XcdBarrier bar = xcd_barrier_post(ctl + CW_BAR, MISC + 8);

#define IN_F(k) ((const float*)args.in[k])
#define in_x IN_F(0)
#define cin IN_F(1)
#define positions ((const int*)args.in[2])
#define w_ada IN_F(3)
#define b_ada IN_F(4)
#define g_mix IN_F(5)
#define w_in IN_F(6)
#define g_q IN_F(7)
#define g_kv IN_F(8)
#define w_uq IN_F(9)
#define w_ukv IN_F(10)
#define rel_bias IN_F(11)
#define w_out IN_F(12)
#define g_ffn IN_F(13)
#define w_router IN_F(14)
#define w_gate IN_F(15)
#define w_up IN_F(16)
#define w_down IN_F(17)
#define g_final IN_F(18)
#define t_out (args.out)
#define WSP(T, off) ((T*)(args.ws + (off)))
#define MOD WSP(float, WS_MOD)
#define CS WSP(float, WS_CS)
#define WIN WSP(bf16_t, WS_WIN)
#define WUQ WSP(bf16_t, WS_WUQ)
#define WUKV WSP(bf16_t, WS_WUKV)
#define WOUT WSP(bf16_t, WS_WOUT)
#define t_H WSP(bf16_t, WS_H)
#define t_U WSP(bf16_t, WS_U)
#define t_P WSP(bf16_t, WS_P)
#define CQN WSP(bf16_t, WS_CQN)
#define CKVN WSP(bf16_t, WS_CKVN)
#define QB WSP(bf16_t, WS_QB)
#define KB WSP(bf16_t, WS_KB)
#define VB WSP(bf16_t, WS_VB)
#define OA WSP(bf16_t, WS_OA)
#define OG WSP(bf16_t, WS_OG)
#define LSE WSP(float, WS_LSE)
#define WGU WSP(bf16_t, WS_WGU)
#define WD WSP(bf16_t, WS_WD)
#define HID WSP(bf16_t, WS_HID)
#define t_Y WSP(bf16_t, WS_Y)
#define AFFT WSP(float, WS_AFFT)
#define TOPI WSP(int, WS_TOPI)
#define TOPG WSP(float, WS_TOPG)
#define SLOT WSP(int, WS_SLOT)

#ifndef PH_MASK
#define PH_MASK 0xFFFFFFFFu
#endif
#define PH_ON(k) constexpr (((PH_MASK) >> (k)) & 1u)
#ifndef DUP_MASK
#define DUP_MASK 0u
#endif
#define PH_REP(k) for (int rep_ = 0; rep_ < ((((DUP_MASK) >> (k)) & 1u) ? 2 : 1); ++rep_)
#if defined(PROBE_TIMING)
#define DBG_SCALE() (1.0f + __uint_as_float(__hip_atomic_load(ctl + CW_DBG + 1, RLX_AGENT)))
#elif defined(MK_CHECK) && MK_CHECK
#define DBG_SCALE() ([&]() -> float { const unsigned f_ = __hip_atomic_load(ctl + CW_DBG, RLX_AGENT); return f_ ? 1.0f + 0.05f * (float)(1 + __builtin_ctz(f_)) : 1.0f; }())
#else
#define DBG_SCALE() 1.0f
#endif
    int step = 0; const int lo = args.st_lo, hi = args.st_hi;
#define STEP_BEGIN if (step >= lo && step < hi) {
#define STEP_END if (step + 1 < hi) xcd_barrier(bar); } ++step;

    STEP_BEGIN
        if PH_ON(0) PH_REP(0) { p0_mod(F, cin, w_ada, b_ada, MOD);
        p0_cs(F, positions, CS);
        p0_weights(F, w_in, w_uq, w_ukv, w_out, ws); }
    STEP_END
    STEP_BEGIN
        if PH_ON(1) PH_REP(1) p1_h(F, in_x, g_mix, MOD, t_H);
    STEP_END
    for (int b = 0; b < NB; ++b) {
        STEP_BEGIN
            pg8::Gemm g{t_H + (size_t)b * SEQ * DM, WIN, DM, DM, DM, 0, 0, nullptr, 0}; pg8::StaticOrder S; S.init(SEQ, NP, F.G, (int)blockIdx.x);
            pg8::EpiBf16 E{t_P, NP};
            if PH_ON(2) PH_REP(2) { pg8::gemm_phase<pg8::EpiBf16, pg8::StaticOrder, false>(F.lds, g, S, E); __syncthreads(); }
        STEP_END
        STEP_BEGIN
            if PH_ON(3) PH_REP(3) lb_latent(F, t_P, g_q, g_kv, CS + (size_t)b * SEQ * 64, CQN, CKVN, KB);
        STEP_END
        STEP_BEGIN
            { pg8::Gemm g{CQN, WUQ, 384, 384, 384, 0, 0, nullptr, 0}; pg8::StaticOrder S; S.init(SEQ, 1536, F.G, (int)blockIdx.x);
              pg8::EpiQ E{QB, CS + (size_t)b * SEQ * 64};
              if PH_ON(4) PH_REP(4) { pg8::gemm_phase<pg8::EpiQ, pg8::StaticOrder, false>(F.lds, g, S, E); __syncthreads(); } }
            __syncthreads();
            { pg8::Gemm g{CKVN, WUKV, 256, 256, 256, 0, 0, nullptr, 0}; pg8::StaticOrder S; S.init(SEQ, 2048, F.G, (int)blockIdx.x);
              pg8::EpiKV E{KB, VB};
              if PH_ON(5) PH_REP(5) { pg8::gemm_phase<pg8::EpiKV, pg8::StaticOrder, false>(F.lds, g, S, E); __syncthreads(); } }
        STEP_END
        STEP_BEGIN
            for (int u = blockIdx.x; u < 256; u += F.G) { const int hd = u & 7, qb = u >> 3;
                att::Unit a{};
                a.Q = QB + ((size_t)hd * SEQ + 256 * qb) * 192; a.qs = 192; a.K = KB + (size_t)hd * SEQ * 192; a.ks = 192; a.V = VB + (size_t)hd * SEQ * 128; a.vs = 128;
                a.O = OA + (size_t)(256 * qb) * DM + hd * 128; a.os = DM; a.nt = SEQ / 64;
#if defined(BREAK_MLA) && BREAK_MLA
                a.nt = SEQ / 64 - 2;
#endif
                a.tmul = 1;
#if defined(PROBE_TIMING)
                a.dbg = (blockIdx.x == PROBE_BLOCK && b == 3) ? (float*)(ctl + CW_DBG + 1) : nullptr;
#endif
#if defined(PROBE_SAMETILE)
                a.tmul = 0; att::attn_unit<false>(a, (LAS char*)F.lds); a.tmul = 1;
#endif
                if PH_ON(6) PH_REP(6) att::attn_unit<false>(a, (LAS char*)F.lds); }
            for (int u = blockIdx.x; u < 768; u += F.G) { const int grp = u >> 8, w = u & 255, hd = w & 7, rest = w >> 3, d = grp == 0 ? 1 : (grp == 1 ? 4 : 16), cl = rest % d, qb = rest / d;
                att::Unit a{};
                const size_t tok0 = (size_t)256 * qb * d + cl; const bf16_t* base = t_P + C_DIL + grp * 3072 + hd * 128;
                a.Q = base + tok0 * NP; a.qs = d * NP; a.K = base + 1024 + (size_t)cl * NP; a.ks = d * NP; a.V = base + 2048 + (size_t)cl * NP; a.vs = d * NP;
                a.O = OG + ((size_t)grp * SEQ + tok0) * DM + hd * 128; a.os = d * DM; a.nt = 6; a.tmul = 1;
                a.kt0 = 4 * qb - 1; a.ktn = (SEQ / d) / 64; a.l0 = 256 * qb; a.pos = positions + (size_t)b * SEQ + cl; a.ps = d;
                a.lse = LSE + ((size_t)grp * SEQ + tok0) * 8 + hd; a.ls = d * 8; a.bias = rel_bias + grp * 8 + hd;
                if PH_ON(7) PH_REP(7) att::attn_unit<true>(a, (LAS char*)F.lds); }
        STEP_END
        STEP_BEGIN
            if PH_ON(8) PH_REP(8) lb_combine(F, t_P, OA, OG, LSE, t_U + (size_t)b * SEQ * DM);
        STEP_END
#if defined(MK_CHECK) && MK_CHECK
        STEP_BEGIN
#if !defined(CHK_MEASURE)
            chk::check_proj(F, b, ctl, t_P, CQN, CKVN, QB, KB, VB, g_q, g_kv, w_uq, w_ukv, positions);
            chk::check_dil(F, b, ctl, t_P, positions, rel_bias, OG, LSE);
            chk::check_u(F, b, ctl, t_P, OA, OG, LSE, t_U + (size_t)b * SEQ * DM);
#endif
            chk::check_mla(F, b, ctl, QB, KB, VB, OA);
        STEP_END
#endif
    }
    STEP_BEGIN
        { pg8::Gemm g{t_U, WOUT, DM, DM, DM, 0, 0, nullptr, 0}; pg8::StaticOrder S; S.init(NTOK, DM, F.G, (int)blockIdx.x);
          pg8::EpiRes E{in_x, t_out, MOD};
          if PH_ON(9) PH_REP(9) { pg8::gemm_phase<pg8::EpiRes, pg8::StaticOrder, false>(F.lds, g, S, E); __syncthreads(); } }
        __syncthreads();
        if PH_ON(10) PH_REP(10) conv_experts(F, w_gate, w_up, w_down, ws);
    STEP_END
    STEP_BEGIN
        if PH_ON(11) PH_REP(11) pg_h2_router(F, t_out, g_ffn, MOD, w_router, t_H, AFFT);
    STEP_END
    STEP_BEGIN
        if PH_ON(12) PH_REP(12) ph_topk(F, AFFT, TOPI, TOPG, SLOT);
    STEP_END
    for (int b = 0; b < NB; ++b) {
        STEP_BEGIN
            { pg8::Gemm g{t_H + (size_t)b * SEQ * DM, WGU, DM, DM, DM, 0, (long)4096 * 1024, TOPI + b * NE * CAP, CAP}; pg8::GroupOrder S; S.init(4, 16, NE, F.G, (int)blockIdx.x);
              pg8::EpiSwiGLU E{HID};
              if PH_ON(13) PH_REP(13) { pg8::gemm_phase<pg8::EpiSwiGLU, pg8::GroupOrder, true>(F.lds, g, S, E); __syncthreads(); } }
            if PH_ON(15) { if (b > 0) p_final(F, b - 1, t_out, MOD, SLOT, t_Y, g_final, DBG_SCALE()); }
        STEP_END
        STEP_BEGIN
            { pg8::Gemm g{HID, WD, DFF, DFF, DFF, (long)CAP * DFF, (long)DM * DFF, nullptr, 0}; pg8::GroupOrder S; S.init(4, 4, NE, F.G, (int)blockIdx.x);
              pg8::EpiDown E{t_Y, TOPG + b * NE * CAP};
              if PH_ON(14) PH_REP(14) { pg8::gemm_phase<pg8::EpiDown, pg8::GroupOrder, false>(F.lds, g, S, E); __syncthreads(); } }
        STEP_END
    }
    STEP_BEGIN
        if PH_ON(15) p_final(F, NB - 1, t_out, MOD, SLOT, t_Y, g_final, DBG_SCALE());
    STEP_END
#undef STEP_BEGIN
#undef STEP_END
}
#undef IN_F
#undef in_x
#undef cin
#undef positions
#undef w_ada
#undef b_ada
#undef g_mix
#undef w_in
#undef g_q
#undef g_kv
#undef w_uq
#undef w_ukv
#undef rel_bias
#undef w_out
#undef g_ffn
#undef w_router
#undef w_gate
#undef w_up
#undef w_down
#undef g_final
#undef t_out
#undef WSP
#undef MOD
#undef CS
#undef WIN
#undef WUQ
#undef WUKV
#undef WOUT
#undef t_H
#undef t_U
#undef t_P
#undef CQN
#undef CKVN
#undef QB
#undef KB
#undef VB
#undef OA
#undef OG
#undef LSE
#undef WGU
#undef WD
#undef HID
#undef t_Y
#undef AFFT
#undef TOPI
#undef TOPG
#undef SLOT
#if defined(MK_CHECK) && MK_CHECK
constexpr int N_STEPS = 2 + NB * 6 + 3 + NB * 2 + 1;
#else
constexpr int N_STEPS = 2 + NB * 5 + 3 + NB * 2 + 1;
#endif

#ifndef MK_PER_STEP
#define MK_PER_STEP 0
#endif
extern "C" void kernel_launch(void* const* d_in, const int* in_sizes, int n_in, void* d_out, int out_size, void* d_ws, size_t ws_size, hipStream_t stream) {
    static int grid = 0;
    if (grid == 0) {
        if (n_in != 19 || out_size != NTOK * DM || ws_size < WS_END) { fprintf(stderr, "kernel_launch: unexpected shapes (n_in %d out %d ws %zu need %zu)\n", n_in, out_size, ws_size, (size_t)WS_END); grid = -1; return; }
        int dev = 0, cus = 0;
        if (hipGetDevice(&dev) != hipSuccess || hipDeviceGetAttribute(&cus, hipDeviceAttributeMultiprocessorCount, dev) != hipSuccess) { grid = -1; return; }
        if (hipFuncSetAttribute((const void*)fwd_kernel, hipFuncAttributeMaxDynamicSharedMemorySize, LDS_BYTES) != hipSuccess) { grid = -1; return; }
        int per_cu = 0;
        if (hipOccupancyMaxActiveBlocksPerMultiprocessor(&per_cu, (const void*)fwd_kernel, NWAVES * 64, LDS_BYTES) != hipSuccess || per_cu < 1) { fprintf(stderr, "kernel_launch: occupancy query says %d\n", per_cu); }
        (void)hipGetLastError();
        grid = cus;
    }
    if (grid < 0) return;
    if (hipMemsetAsync((char*)d_ws + WS_CTL, 0, CTL_ZERO_BYTES, stream) != hipSuccess) return;
    Args a{};
    for (int i = 0; i < 19; ++i) a.in[i] = d_in[i];
    a.out = (float*)d_out; a.ws = (unsigned char*)d_ws;
#if MK_PER_STEP
    for (int s = 0; s < N_STEPS; ++s) { a.st_lo = s; a.st_hi = s + 1; hipLaunchKernelGGL(fwd_kernel, dim3(grid), dim3(NWAVES * 64), LDS_BYTES, stream, a); }
#else
    a.st_lo = 0; a.st_hi = N_STEPS;
    hipLaunchKernelGGL(fwd_kernel, dim3(grid), dim3(NWAVES * 64), LDS_BYTES, stream, a);
#endif
    const hipError_t le = hipPeekAtLastError();
    if (le != hipSuccess) fprintf(stderr, "kernel_launch: launch failed: %s\n", hipGetErrorName(le));
}
```

```cpp
#include <hip/hip_runtime.h>
#include <cstdio>
#include <cstdint>

#define LAS __attribute__((address_space(3)))
#define GAS __attribute__((address_space(1)))
typedef unsigned short bf16_t;
typedef short bf16x8 __attribute__((ext_vector_type(8)));
typedef short s16x4 __attribute__((ext_vector_type(4)));
typedef float f32x2 __attribute__((ext_vector_type(2)));
typedef float f32x4 __attribute__((ext_vector_type(4)));
typedef float f32x16 __attribute__((ext_vector_type(16)));
typedef unsigned u32x2 __attribute__((ext_vector_type(2)));
typedef unsigned u32x4 __attribute__((ext_vector_type(4)));
typedef int i32x4 __attribute__((ext_vector_type(4)));

#ifndef MK_FP8
#define MK_FP8 1
#endif
#ifndef DIL_FP8
#define DIL_FP8 1
#endif
constexpr int NB = 4, SEQ = 8192, DM = 1024, NTOK = NB * SEQ;
constexpr int NP = 12032;
constexpr int C_CQ = 0, C_CKV = 384, C_KPE = 640, C_DIL = 704, C_GATE = 9920, D_IN = 11968;
constexpr int NE = 16, CAP = 1024, DFF = 2048;
constexpr int P_QK_ESZ = DIL_FP8 ? 1 : 2, P_GRP = 2 * 1024 * P_QK_ESZ + 2048, P_OFF_DIL = 1408, P_OFF_GATE = P_OFF_DIL + 3 * P_GRP, PROW = P_OFF_GATE + 2 * (2048 + 64);
__host__ __device__ constexpr int p_col_off(int c) {
    return c < C_DIL ? 2 * c : (c < C_GATE ? (P_OFF_DIL + ((c - C_DIL) / 3072) * P_GRP + ((((c - C_DIL) % 3072) >> 10) == 2 ? 2048 * P_QK_ESZ + 2 * (((c - C_DIL) % 3072) & 1023) : ((((c - C_DIL) % 3072) >> 10) * 1024 + (((c - C_DIL) % 3072) & 1023)) * P_QK_ESZ)) : P_OFF_GATE + 2 * (c - C_GATE)); }
__host__ __device__ constexpr bool p_col_f8(int c) { return DIL_FP8 && c >= C_DIL && c < C_GATE && ((((c - C_DIL) % 3072) >> 10) != 2); }
constexpr float NORM_EPS = 1e-6f;
constexpr float LOG2E = 1.4426950408889634f;

constexpr size_t MiB = 1u << 20;
constexpr size_t WS_CTL = 0, CTL_ZERO_BYTES = 1 * MiB;
constexpr size_t WS_MOD = 1 * MiB;
constexpr size_t WS_CS = 2 * MiB;
constexpr size_t WS_WIN = 10 * MiB;
constexpr size_t WS_WUQ = 34 * MiB;
constexpr size_t WS_WUKV = 36 * MiB;
constexpr size_t WS_WOUT = 37 * MiB;
constexpr size_t WS_H = 40 * MiB;
constexpr size_t WS_U = 104 * MiB;
constexpr size_t WS_R = 168 * MiB;
constexpr size_t WS_P = WS_R;
constexpr size_t WS_CQN = WS_R + 188 * MiB;
constexpr size_t WS_CKVN = WS_R + 194 * MiB;
constexpr size_t WS_QB = WS_R + 198 * MiB;
constexpr size_t WS_KB = WS_R + 222 * MiB;
constexpr size_t WS_VB = WS_R + 246 * MiB;
constexpr size_t WS_OA = WS_R + 262 * MiB;
constexpr size_t WS_OG = WS_R + 278 * MiB;
constexpr size_t WS_LSE = WS_R + 326 * MiB;
constexpr size_t WS_WGU = WS_R;
constexpr size_t WS_WD = WS_R + 64 * MiB;
constexpr size_t WS_HID = WS_R + 96 * MiB;
constexpr size_t WS_Y = WS_R + 224 * MiB;
constexpr size_t WS_AFFT = WS_R + 352 * MiB;
constexpr size_t WS_TOPI = WS_R + 354 * MiB;
constexpr size_t WS_TOPG = WS_R + 355 * MiB;
constexpr size_t WS_SLOT = WS_R + 356 * MiB;
constexpr size_t WS_END = WS_R + 358 * MiB;
constexpr int CW_TMO = 0, CW_DBG = 16, CW_BAR = 4096;

constexpr int RING_BYTES = 131072;
constexpr int MISC_OFF = RING_BYTES + 320;
constexpr int LDS_BYTES = 147456;
constexpr int NWAVES = 8;

#define RLX_AGENT __ATOMIC_RELAXED, __HIP_MEMORY_SCOPE_AGENT
#define LDS_WAIT() asm volatile("s_waitcnt lgkmcnt(0)" ::: "memory")
#define VM_WAIT() asm volatile("s_waitcnt vmcnt(0)" ::: "memory")

__device__ __forceinline__ unsigned cvt_pk_bf16(float lo, float hi) { unsigned r; asm volatile("v_cvt_pk_bf16_f32 %0, %1, %2" : "=v"(r) : "v"(lo), "v"(hi)); return r; }
__device__ __forceinline__ float bf2f(unsigned short v) { return __uint_as_float(((unsigned)v) << 16); }
__device__ __forceinline__ float bflo(unsigned w) { return __uint_as_float(w << 16); }
__device__ __forceinline__ float bfhi(unsigned w) { return __uint_as_float(w & 0xffff0000u); }
#define SWZ_XOR(k) (((k) << 10) | 0x1f)
#if defined(OLD_WAVE_SUM)
__device__ __forceinline__ float wave_sum(float v) { for (int o = 1; o < 64; o <<= 1) v += __shfl_xor(v, o); return v; }
#else
__device__ __forceinline__ float wave_sum(float v) {
    v += __int_as_float(__builtin_amdgcn_ds_swizzle(__float_as_int(v), SWZ_XOR(1)));
    v += __int_as_float(__builtin_amdgcn_ds_swizzle(__float_as_int(v), SWZ_XOR(2)));
    v += __int_as_float(__builtin_amdgcn_ds_swizzle(__float_as_int(v), SWZ_XOR(4)));
    v += __int_as_float(__builtin_amdgcn_ds_swizzle(__float_as_int(v), SWZ_XOR(8)));
    v += __int_as_float(__builtin_amdgcn_ds_swizzle(__float_as_int(v), SWZ_XOR(16)));
    { auto rr = __builtin_amdgcn_permlane32_swap(__float_as_uint(v), __float_as_uint(v), false, false); v = __uint_as_float(rr[0]) + __uint_as_float(rr[1]); }
    return v;
}
#endif
__device__ __forceinline__ float wave_max(float v) {
    v = fmaxf(v, __int_as_float(__builtin_amdgcn_ds_swizzle(__float_as_int(v), SWZ_XOR(1))));
    v = fmaxf(v, __int_as_float(__builtin_amdgcn_ds_swizzle(__float_as_int(v), SWZ_XOR(2))));
    v = fmaxf(v, __int_as_float(__builtin_amdgcn_ds_swizzle(__float_as_int(v), SWZ_XOR(4))));
    v = fmaxf(v, __int_as_float(__builtin_amdgcn_ds_swizzle(__float_as_int(v), SWZ_XOR(8))));
    v = fmaxf(v, __int_as_float(__builtin_amdgcn_ds_swizzle(__float_as_int(v), SWZ_XOR(16))));
    { auto rr = __builtin_amdgcn_permlane32_swap(__float_as_uint(v), __float_as_uint(v), false, false); v = fmaxf(__uint_as_float(rr[0]), __uint_as_float(rr[1])); }
    return v;
}
__device__ __forceinline__ float fast_sigmoid(float x) { return __builtin_amdgcn_rcpf(1.f + __builtin_amdgcn_exp2f(-x * LOG2E)); }
#ifndef MK_FP8
#define MK_FP8 1
#endif
#ifndef MLA_FP8
#define MLA_FP8 1
#endif
#ifndef FP8_G1
#define FP8_G1 MK_FP8
#endif
#ifndef FP8_EX
#define FP8_EX MK_FP8
#endif
#ifndef FP8_WO
#define FP8_WO 0
#endif
constexpr float QK_LOG2_SCALE = 0.072168783648703220f * LOG2E;
constexpr float W8_SCALE = 64.0f, W8_INV = 1.0f / 64.0f;
typedef int v8i __attribute__((ext_vector_type(8)));
__device__ __forceinline__ unsigned pk4_fp8(float a, float b, float c, float d) { int w = __builtin_amdgcn_cvt_pk_fp8_f32(a, b, 0, false); w = __builtin_amdgcn_cvt_pk_fp8_f32(c, d, w, true); return (unsigned)w; }
#if defined(OLD_TID)
__device__ __forceinline__ int opaque_tid(int wv) { int t = (int)threadIdx.x; asm volatile("" : "+v"(t)); return t; }
#else
__device__ __forceinline__ int opaque_tid(int wv) { int l; asm volatile("v_mbcnt_lo_u32_b32 %0, -1, 0\n\tv_mbcnt_hi_u32_b32 %0, -1, %0" : "=v"(l)); return (wv << 6) | l; }
#endif
struct Frame {
    LAS unsigned char* lds;
    int tid, lane, wave, vcu, G, gw, NGW;
};
struct Args { const void* in[19]; float* out; unsigned char* ws; int st_lo, st_hi; };

#define XB_TMO      128
#define XB_XCNT(j)  (256  + 64 * (j))
#define XB_XSUB(j)  (1280 + 64 * (j))
#define XB_XGEN(j)  (2304 + 64 * (j))
#define XB_TOP      3328
#define XB_TOPGEN   3392
#define XCD_BAR_WORDS 3456
#define XB_SPIN_CAP (1u << 18)

__device__ __forceinline__ unsigned xb_ld(unsigned* p)              { return __hip_atomic_load(p, __ATOMIC_RELAXED, __HIP_MEMORY_SCOPE_AGENT); }
__device__ __forceinline__ unsigned xb_add(unsigned* p, unsigned v) { return __hip_atomic_fetch_add(p, v, __ATOMIC_RELAXED, __HIP_MEMORY_SCOPE_AGENT); }
__device__ __forceinline__ unsigned xb_xcc_id() { return (unsigned)__builtin_amdgcn_s_getreg((3 << 11) | 20) & 0xFu; }
#define XB_SPIN(cond, bar) do { unsigned _sp = 0; while (cond) { __builtin_amdgcn_s_sleep(1); \
    if ((++_sp & 255u) == 0u) { if (xb_ld(&(bar)[XB_TMO])) break; if (_sp > XB_SPIN_CAP) { atomicAdd(&(bar)[XB_TMO], 1u); break; } } } } while (0)

struct XcdBarrier {
    unsigned* bar; unsigned x;
    int wv;
    volatile LAS unsigned* st;
};

__device__ __forceinline__ XcdBarrier xcd_barrier_post(unsigned* bar, volatile LAS unsigned* st) {
    XcdBarrier b; b.bar = bar; b.x = xb_xcc_id(); b.st = st;
    if (threadIdx.x == 0) (void)xb_add(&bar[XB_XCNT(b.x)], 1u);
    return b;
}
__device__ __forceinline__ void xcd_barrier_complete(unsigned* bar, unsigned x, unsigned& nloc, unsigned& nx) {
    const unsigned G = gridDim.x * gridDim.y * gridDim.z;
    unsigned sum, cnt, mine, sp = 0u;
    for (;;) {
        sum = 0u; cnt = 0u; mine = 0u;
#pragma unroll
        for (unsigned j = 0; j < 16; ++j) { const unsigned c = xb_ld(&bar[XB_XCNT(j)]); sum += c; cnt += (c > 0u) ? 1u : 0u; mine = (j == x) ? c : mine; }
        if (sum == G) break;
        __builtin_amdgcn_s_sleep(1);
        if ((++sp & 255u) == 0u) { if (xb_ld(&bar[XB_TMO])) break; if (sp > XB_SPIN_CAP) { atomicAdd(&bar[XB_TMO], 1u); break; } }
    }
    nloc = mine > 0u ? mine : 1u; nx = cnt > 0u ? cnt : 1u;
}

__device__ __forceinline__ void xcd_barrier(const XcdBarrier& b) {
    asm volatile("s_waitcnt vmcnt(0)" ::: "memory");
    __syncthreads();
    if (b.wv == 0 && opaque_tid(0) == 0) {
        unsigned* bar = b.bar;
        __builtin_amdgcn_s_waitcnt(0);
        unsigned nloc = b.st[0], nx = b.st[1];
        if (nloc == 0u) { xcd_barrier_complete(bar, b.x, nloc, nx); b.st[0] = nloc; b.st[1] = nx; }
        const unsigned old = xb_add(&bar[XB_XSUB(b.x)], 1u);
        const unsigned gen = old / nloc;
        if (old + 1u == (gen + 1u) * nloc) {
            __builtin_amdgcn_fence(__ATOMIC_RELEASE, "agent");
            asm volatile("s_waitcnt vmcnt(0)" ::: "memory");
            const unsigned og = xb_add(&bar[XB_TOP], 1u);
            const unsigned tg = og / nx;
            if (og + 1u == (tg + 1u) * nx) xb_add(&bar[XB_TOPGEN], 1u);
            else XB_SPIN(xb_ld(&bar[XB_TOPGEN]) == tg, bar);
            __builtin_amdgcn_fence(__ATOMIC_ACQUIRE, "agent");
            xb_add(&bar[XB_XGEN(b.x)], 1u);
            asm volatile("s_waitcnt vmcnt(0)" ::: "memory");
        } else {
            XB_SPIN(xb_ld(&bar[XB_XGEN(b.x)]) == gen, bar);
            __builtin_amdgcn_fence(__ATOMIC_ACQUIRE, "agent");
            asm volatile("s_waitcnt vmcnt(0)" ::: "memory");
        }
    }
    __syncthreads();
}

namespace pg8 {
constexpr int BM = 256, BK = 64, HALF = 128, HTB = HALF * BK * 2  , STAGE_BYTES = 8 * HTB, NXCD = 8, WGM = 8;

__host__ __device__ __forceinline__ int lds_byte(int r, int c) { const int st = (r >> 4) * 2 + (c >> 5), rr = r & 15, cc = c & 31, ob = rr * 64 + cc * 2; return st * 1024 + (ob ^ (((ob >> 9) & 1) << 5)); }
__host__ __device__ __forceinline__ void stage_rc(int b, int& R, int& C) { const int st = b / 1024, sb = b % 1024, swz = sb ^ (((sb >> 9) & 1) << 5); R = (st >> 1) * 16 + swz / 64; C = (st & 1) * 32 + (swz % 64) / 2; }
__host__ __device__ __forceinline__ int perm32(int rho) { const int n = rho >> 4, i = rho & 15; return 8 * (i >> 2) + 4 * n + (i & 3); }

struct Unit { int pm, pn, g; };
struct Gemm { const bf16_t* A; const bf16_t* Bt; int lda, ldb, K; long a_gs, b_gs; const int* idx; int idx_gs; int b_gmod; };

struct StaticOrder {
    int nM, nN, nwg, G, c;
    __device__ __forceinline__ void init(int M, int N, int G_, int c_) { nM = M / BM; nN = N / BM; nwg = nM * nN; G = G_; c = c_; }
    __device__ __forceinline__ bool next(int i, Unit& u) const {
        const long L = (long)i * G + c; if (L >= nwg) return false;
        int wgid = (int)L; { const int q = nwg / NXCD, r = nwg % NXCD, xcd = wgid % NXCD, off = wgid / NXCD; wgid = (xcd < r ? xcd * (q + 1) : r * (q + 1) + (xcd - r) * q) + off; }
        const int nig = WGM * nN, gid = wgid / nig, fm = gid * WGM, gsz = (nM - fm) < WGM ? (nM - fm) : WGM;
        u.pm = fm + ((wgid % nig) % gsz); u.pn = (wgid % nig) / gsz; u.g = 0; return true;
    }
};
struct GroupOrder {
    int nM, nN, nwg, G, v, gperm;
    __device__ __forceinline__ void init(int nM_, int nN_, int nG, int G_, int c_) { nM = nM_; nN = nN_; nwg = nM_ * nN_ * nG; G = G_; gperm = (nG == 64); v = (G_ % 8 == 0) ? (c_ % 8) * (G_ / 8) + c_ / 8 : c_; }
    __device__ __forceinline__ bool next(int i, Unit& u) const {
        const long L = (long)i * G + v; if (L >= nwg) return false;
        const int w = (int)L, gi = w / (nM * nN); u.pm = w % nM; u.pn = (w / nM) % nN;
        u.g = gperm ? (gi & 3) * 16 + (gi >> 2) : gi;
        return true;
    }
};

template <class Epi, class Sched, bool GATHER, bool FP8 = false>
__device__ __forceinline__ void gemm_phase(LAS unsigned char* lds, int wv, const Gemm g, const Sched& S, const Epi& E) {
    const int tid = opaque_tid(wv), wid = __builtin_amdgcn_readfirstlane(tid >> 6), lane = tid & 63, wr = wid >> 2, wc = wid & 3, fr = lane & 15, fq = lane >> 4;
    constexpr int ESZ = FP8 ? 1 : 2;
    const int K = g.K, nt = K * ESZ / (BK * 2);
    int Rr[2], Cc[2]; unsigned voffB[2];
#pragma unroll
    for (int i = 0; i < 2; ++i) { int R, C; stage_rc(tid * 16 + i * 8192, R, C); Rr[i] = R; Cc[i] = C; const int Rb = (Epi::PERM && !Epi::BPRE) ? ((R & ~31) + perm32(R & 31)) : R;
        voffB[i] = (unsigned)(Rb * g.ldb * ESZ + C * 2); }
    const unsigned kstep = (unsigned)(BK * 2);
    const unsigned hstepA = (unsigned)(HALF * g.lda * ESZ), hstepB = (unsigned)(HALF * g.ldb * ESZ);
    const unsigned ldsw = (unsigned)wid * 1024u;
    const int aoff = lds_byte(wr * 64 + fr, fq * 8), boff = lds_byte(wc * 32 + fr, fq * 8);
#define PG8_SA(b, h) (((b) * 2 + (h)) * HTB)
#define PG8_SB(b, h) ((4 + (b) * 2 + (h)) * HTB)
    const __amdgpu_buffer_rsrc_t rsA = __builtin_amdgcn_make_buffer_rsrc((void*)g.A, 0, 0x7fffffff, 0x00020000), rsB = __builtin_amdgcn_make_buffer_rsrc((void*)g.Bt, 0, 0x7fffffff, 0x00020000);
#ifndef PG8_BUFFER_DMA
#define PG8_BUFFER_DMA 1
#endif
#if PG8_BUFFER_DMA
#define PG8_STAGE(bufoff, rs, so, v0, v1) do { \
        __builtin_amdgcn_raw_ptr_buffer_load_lds(rs, (LAS void*)(lds + (bufoff) + ldsw), 16, (v0), (so), 0, 0); \
        __builtin_amdgcn_raw_ptr_buffer_load_lds(rs, (LAS void*)(lds + (bufoff) + ldsw + 8192), 16, (v1), (so), 0, 0); } while (0)
#else
#define PG8_GBASE(rs) ((const char*)(__builtin_bit_cast(u32x4, rs).x | ((unsigned long long)(__builtin_bit_cast(u32x4, rs).y & 0xffffu) << 32)))
#define PG8_STAGE(bufoff, rs, so, v0, v1) do { const char* gb_ = (&rs == &rsA ? (const char*)g.A : (const char*)g.Bt) + (so); \
        __builtin_amdgcn_global_load_lds((const unsigned*)(gb_ + (v0)), (LAS unsigned*)(lds + (bufoff) + ldsw), 16, 0, 0); \
        __builtin_amdgcn_global_load_lds((const unsigned*)(gb_ + (v1)), (LAS unsigned*)(lds + (bufoff) + ldsw + 8192), 16, 0, 0); } while (0)
#endif
#define PG8_STAGEB(bufoff, so) PG8_STAGE(bufoff, rsB, so, voffB[0], voffB[1])
#define PG8_CAT(x_, y_) __builtin_shufflevector(__builtin_bit_cast(i32x4, x_), __builtin_bit_cast(i32x4, y_), 0, 1, 2, 3, 4, 5, 6, 7)
#define PG8_LO(v_) __builtin_bit_cast(bf16x8, __builtin_shufflevector(v_, v_, 0, 1, 2, 3))
#define PG8_HI(v_) __builtin_bit_cast(bf16x8, __builtin_shufflevector(v_, v_, 4, 5, 6, 7))
#define PG8_LDA(dst, b, h) do { _Pragma("unroll") for (int m = 0; m < 4; ++m) dst[m] = PG8_CAT(*(const LAS bf16x8*)(lds + PG8_SA(b, h) + aoff + m * 2048), *(const LAS bf16x8*)(lds + PG8_SA(b, h) + aoff + m * 2048 + 1024)); } while (0)
#define PG8_LDB(dst, b, h) do { _Pragma("unroll") for (int n = 0; n < 2; ++n) dst[n] = PG8_CAT(*(const LAS bf16x8*)(lds + PG8_SB(b, h) + boff + n * 2048), *(const LAS bf16x8*)(lds + PG8_SB(b, h) + boff + n * 2048 + 1024)); } while (0)
#define PG8_MMA(ai, bj, At, Bt) do { __builtin_amdgcn_s_setprio(1); _Pragma("unroll") for (int m = 0; m < 4; ++m) _Pragma("unroll") for (int n = 0; n < 2; ++n) { \
        if constexpr (FP8) acc[ai][bj][m][n] = __builtin_amdgcn_mfma_scale_f32_16x16x128_f8f6f4(Bt[n], At[m], acc[ai][bj][m][n], 0, 0, 0, 0, 0, 0);   \
        else { acc[ai][bj][m][n] = __builtin_amdgcn_mfma_f32_16x16x32_bf16(PG8_LO(Bt[n]), PG8_LO(At[m]), acc[ai][bj][m][n], 0, 0, 0); \
               acc[ai][bj][m][n] = __builtin_amdgcn_mfma_f32_16x16x32_bf16(PG8_HI(Bt[n]), PG8_HI(At[m]), acc[ai][bj][m][n], 0, 0, 0); } } \
        __builtin_amdgcn_s_setprio(0); } while (0)
#define PG8_WAIT_V(n) asm volatile("s_waitcnt vmcnt(" #n ")" ::: "memory")
#define PG8_WAIT_L(n) asm volatile("s_waitcnt lgkmcnt(" #n ")" ::: "memory")
#define PG8_BAR __builtin_amdgcn_s_barrier()
#define PG8_SCHED __builtin_amdgcn_sched_barrier(0)
    Unit cur, nxt; int ui = 0;
    if (!S.next(0, cur)) return;
    f32x4 acc[2][2][4][2];
#pragma unroll
    for (int a = 0; a < 2; ++a)
#pragma unroll
        for (int b = 0; b < 2; ++b)
#pragma unroll
            for (int m = 0; m < 4; ++m)
#pragma unroll
                for (int n = 0; n < 2; ++n) acc[a][b][m][n] = (f32x4){0.f, 0.f, 0.f, 0.f};
    v8i At[4], B0[2], B1[2];
    unsigned voffA[2]; unsigned oc[2][2], on[2][2];
#pragma unroll
    for (int i = 0; i < 2; ++i) voffA[i] = (unsigned)(Rr[i] * g.lda * ESZ + Cc[i] * 2);
    unsigned cA, cB;
#define PG8_UNIT_PTRS(u, pA, pB, o) do { \
        pB = (unsigned)(((size_t)(g.b_gmod ? (u).g % g.b_gmod : (u).g) * g.b_gs + (size_t)(u).pn * BM * g.ldb) * ESZ); \
        if constexpr (GATHER) { \
            pA = 0u; \
            const int* ix_ = g.idx + (size_t)(u).g * g.idx_gs + (u).pm * BM; const int t_ = opaque_tid(wv); \
            _Pragma("unroll") for (int i = 0; i < 2; ++i) { int R_, C_; stage_rc(t_ * 16 + i * 8192, R_, C_); \
                _Pragma("unroll") for (int h = 0; h < 2; ++h) o[h][i] = (unsigned)ix_[h * HALF + R_] * (unsigned)(g.lda * ESZ) + (unsigned)C_ * 2u; } \
        } else { \
            pA = (unsigned)(((size_t)(u).g * g.a_gs + (size_t)(u).pm * BM * g.lda) * ESZ); \
        } } while (0)
#define PG8_STAGEA(bufoff, p, o, h) do { if constexpr (GATHER) PG8_STAGE(bufoff, rsA, p, o[h][0], o[h][1]); else PG8_STAGE(bufoff, rsA, (p) + (h) * hstepA, voffA[0], voffA[1]); } while (0)
    PG8_UNIT_PTRS(cur, cA, cB, oc);
    PG8_STAGEB(PG8_SB(0, 0), cB); PG8_STAGEB(PG8_SB(0, 1), cB + hstepB); PG8_STAGEA(PG8_SA(0, 0), cA, oc, 0); PG8_STAGEA(PG8_SA(0, 1), cA, oc, 1);
    if (wr == 1) PG8_BAR;
    PG8_WAIT_V(2); PG8_BAR;
    PG8_STAGEB(PG8_SB(1, 0), cB + kstep); PG8_STAGEA(PG8_SA(1, 0), cA + kstep, oc, 0); PG8_STAGEB(PG8_SB(1, 1), cB + hstepB + kstep);
    PG8_WAIT_V(6); PG8_BAR;
    for (;;) {
        const bool has_next = S.next(ui + 1, nxt);
        unsigned nA = cA, nB = cB;
        if constexpr (GATHER) {
#pragma unroll
            for (int h = 0; h < 2; ++h)
#pragma unroll
                for (int i = 0; i < 2; ++i) on[h][i] = oc[h][i];
        }
        if (has_next) PG8_UNIT_PTRS(nxt, nA, nB, on);
#pragma unroll 1
        for (int t = 0; t < nt; t += 2) {
            const bool last = (t == nt - 2);
            const unsigned a1 = cA + (unsigned)(t + 1) * kstep;
            const unsigned a2 = last ? nA : cA + (unsigned)(t + 2) * kstep, b2 = last ? nB : cB + (unsigned)(t + 2) * kstep;
            const unsigned a3 = a2 + kstep, b3 = b2 + kstep;
#define PG8_STAGEA2(bufoff, p, h) do { if constexpr (GATHER) { if (last) PG8_STAGEA(bufoff, p, on, h); else PG8_STAGEA(bufoff, p, oc, h); } else PG8_STAGEA(bufoff, p, oc, h); } while (0)
            PG8_LDB(B0, 0, 0); PG8_LDB(B1, 0, 1); PG8_SCHED; PG8_LDA(At, 0, 0); PG8_STAGEA(PG8_SA(1, 1), a1, oc, 1);
            PG8_WAIT_V(8); PG8_WAIT_L(0); PG8_BAR; PG8_MMA(0, 0, At, B0); PG8_MMA(0, 1, At, B1); PG8_BAR; PG8_SCHED;
            PG8_LDA(At, 0, 1); PG8_STAGEB(PG8_SB(0, 0), b2); PG8_STAGEB(PG8_SB(0, 1), b2 + hstepB); PG8_STAGEA2(PG8_SA(0, 0), a2, 0);
            PG8_WAIT_V(8); PG8_WAIT_L(0); PG8_BAR; PG8_MMA(1, 0, At, B0); PG8_MMA(1, 1, At, B1); PG8_BAR; PG8_SCHED;
            PG8_LDB(B0, 1, 0); PG8_LDB(B1, 1, 1); PG8_SCHED; PG8_LDA(At, 1, 0); PG8_STAGEA2(PG8_SA(0, 1), a2, 1);
            PG8_WAIT_V(8); PG8_WAIT_L(0); PG8_BAR; PG8_MMA(0, 0, At, B0); PG8_MMA(0, 1, At, B1); PG8_BAR; PG8_SCHED;
            PG8_LDA(At, 1, 1); PG8_STAGEB(PG8_SB(1, 0), b3); PG8_STAGEB(PG8_SB(1, 1), b3 + hstepB); PG8_STAGEA2(PG8_SA(1, 0), a3, 0);
            PG8_WAIT_V(8); PG8_WAIT_L(0); PG8_BAR; PG8_MMA(1, 0, At, B0); PG8_MMA(1, 1, At, B1); PG8_BAR; PG8_SCHED;
        }
        if (wr == 0) PG8_BAR;
        { const int l_ = opaque_tid(wv) & 63; E(acc, cur, wr, wc, l_ & 15, l_ >> 4); }
        if (!has_next) break;
#pragma unroll
        for (int a = 0; a < 2; ++a)
#pragma unroll
            for (int b = 0; b < 2; ++b)
#pragma unroll
                for (int m = 0; m < 4; ++m)
#pragma unroll
                    for (int n = 0; n < 2; ++n) acc[a][b][m][n] = (f32x4){0.f, 0.f, 0.f, 0.f};
        cur = nxt; cA = nA; cB = nB; ++ui;
        if constexpr (GATHER) {
#pragma unroll
            for (int h = 0; h < 2; ++h)
#pragma unroll
                for (int i = 0; i < 2; ++i) oc[h][i] = on[h][i];
        }
        if (wr == 1) PG8_BAR;
    }
    PG8_WAIT_V(0);
    PG8_BAR;
#undef PG8_UNIT_PTRS
#undef PG8_STAGEA
#undef PG8_STAGEA2
#undef PG8_SA
#undef PG8_SB
#undef PG8_STAGE
#undef PG8_STAGEB
#undef PG8_LDA
#undef PG8_LDB
#undef PG8_MMA
#undef PG8_CAT
#undef PG8_LO
#undef PG8_HI
#undef PG8_WAIT_V
#undef PG8_WAIT_L
#undef PG8_BAR
#undef PG8_SCHED
}

#define EPI_ROWLOOP for (int ai = 0; ai < 2; ++ai) _Pragma("unroll") for (int m = 0; m < 4; ++m)
__device__ __forceinline__ u32x4 pack8(const f32x4 v0, const f32x4 v1) { u32x4 w; w.x = cvt_pk_bf16(v0[0], v0[1]); w.y = cvt_pk_bf16(v0[2], v0[3]); w.z = cvt_pk_bf16(v1[0], v1[1]); w.w = cvt_pk_bf16(v1[2], v1[3]); return w; }
struct EpiBf16 {
    static constexpr bool PERM = true, BPRE = true;
    bf16_t* O; int ldc; float sc; int nostore;
    __device__ __forceinline__ void operator()(const f32x4 (&acc)[2][2][4][2], const Unit& u, int wr, int wc, int fr, int fq) const {
        const __amdgpu_buffer_rsrc_t rs = __builtin_amdgcn_make_buffer_rsrc((void*)O, 0, 0x7fffffff, 0x00020000);
        const unsigned lo = (unsigned)(fr * ldc + 8 * fq) * 2u, so = (unsigned)(((u.pm * BM + wr * 64) * ldc + u.pn * BM + wc * 32) * 2);
        if (nostore) return;
#pragma unroll
        EPI_ROWLOOP {
#pragma unroll
            for (int bj = 0; bj < 2; ++bj) {
#if !defined(EPI_BUF_STORES)
#if defined(EPI_NT_STORES_PROBE)
                __builtin_nontemporal_store(pack8(acc[ai][bj][m][0] * sc, acc[ai][bj][m][1] * sc), (u32x4*)((char*)O + (size_t)(so + (unsigned)((ai * HALF + m * 16) * ldc + bj * HALF) * 2u) + lo));
#else
                *(u32x4*)((char*)O + (size_t)(so + (unsigned)((ai * HALF + m * 16) * ldc + bj * HALF) * 2u) + lo) = pack8(acc[ai][bj][m][0] * sc, acc[ai][bj][m][1] * sc);
#endif
#else
                __builtin_amdgcn_raw_buffer_store_b128(pack8(acc[ai][bj][m][0] * sc, acc[ai][bj][m][1] * sc), rs, lo, so + (unsigned)((ai * HALF + m * 16) * ldc + bj * HALF) * 2u, 0);
#endif
            } }
    }
};
struct EpiP {
    static constexpr bool PERM = true, BPRE = true;
    unsigned char* P; float sc; int nostore;
    __device__ __forceinline__ void operator()(const f32x4 (&acc)[2][2][4][2], const Unit& u, int wr, int wc, int fr, int fq) const {
        if (nostore) return;
        const size_t rowb = (size_t)(u.pm * BM + wr * 64) * PROW;
#pragma unroll
        for (int bj = 0; bj < 2; ++bj) { const int c32 = u.pn * BM + bj * HALF + wc * 32; const bool f8 = p_col_f8(c32);
            char* ub = (char*)P + rowb + p_col_off(c32); const unsigned lo = (unsigned)(fr * PROW + (f8 ? 8 : 16) * fq);
#pragma unroll
            EPI_ROWLOOP { char* dst = ub + (size_t)(ai * HALF + m * 16) * PROW + lo; const f32x4 v0 = acc[ai][bj][m][0] * sc, v1 = acc[ai][bj][m][1] * sc;
                if (f8) { u32x2 o; o.x = pk4_fp8(v0[0], v0[1], v0[2], v0[3]); o.y = pk4_fp8(v1[0], v1[1], v1[2], v1[3]); *(u32x2*)dst = o; }
                else *(u32x4*)dst = pack8(v0, v1); } }
    }
};
struct EpiQ {
    static constexpr bool PERM = true, BPRE = false;
    bf16_t* QB; const float* cs;
    __device__ __forceinline__ void operator()(const f32x4 (&acc)[2][2][4][2], const Unit& u, int wr, int wc, int fr, int fq) const {
        const unsigned lo = (unsigned)(fr * 192 + 8 * fq) * 2u, lcs = (unsigned)(fr * 64 + 8 * fq) * 4u;
        const int rowU = u.pm * BM + wr * 64;
#pragma unroll
        for (int bj = 0; bj < 2; ++bj) { const int c32 = u.pn * BM + bj * HALF + wc * 32, hd = c32 / 192, w32 = c32 - hd * 192;
            char* ub = (char*)(QB + ((size_t)hd * SEQ + rowU) * 192 + w32);
            const char* cb = (const char*)(cs + (size_t)rowU * 64 + (w32 >= 128 ? (w32 - 128) : 0));
#pragma unroll
            EPI_ROWLOOP { const int rr = ai * HALF + m * 16; f32x4 v0 = acc[ai][bj][m][0], v1 = acc[ai][bj][m][1];
                if (w32 >= 128) { const f32x4 ca = *(const f32x4*)(cb + (size_t)rr * 256 + lcs), cc = *(const f32x4*)(cb + (size_t)rr * 256 + 16 + lcs);
                    const f32x4 a = v0, b = v1;
                    v0[0] = a[0] * ca[0] - a[1] * ca[1]; v0[1] = a[0] * ca[1] + a[1] * ca[0]; v0[2] = a[2] * ca[2] - a[3] * ca[3]; v0[3] = a[2] * ca[3] + a[3] * ca[2];
                    v1[0] = b[0] * cc[0] - b[1] * cc[1]; v1[1] = b[0] * cc[1] + b[1] * cc[0]; v1[2] = b[2] * cc[2] - b[3] * cc[3]; v1[3] = b[2] * cc[3] + b[3] * cc[2]; }
                *(u32x4*)(ub + (size_t)rr * 384 + lo) = pack8(v0, v1);
                if (m & 1) asm volatile("" ::: "memory"); } }
    }
};
struct EpiKV {
    static constexpr bool PERM = true, BPRE = false;
    bf16_t* KB; bf16_t* VB;
    __device__ __forceinline__ void operator()(const f32x4 (&acc)[2][2][4][2], const Unit& u, int wr, int wc, int fr, int fq) const {
        const int rowU = u.pm * BM + wr * 64;
#pragma unroll
        for (int bj = 0; bj < 2; ++bj) { const int c32 = u.pn * BM + bj * HALF + wc * 32, hd = c32 >> 8, w32 = c32 & 255; const bool isk = w32 < 128;
            const int ld = isk ? 192 : 128;
            char* ub = (char*)(isk ? KB + ((size_t)hd * SEQ + rowU) * 192 + w32 : VB + ((size_t)hd * SEQ + rowU) * 128 + (w32 - 128));
            const unsigned lo = (unsigned)(fr * ld + 8 * fq) * 2u;
#pragma unroll
            EPI_ROWLOOP { *(u32x4*)(ub + (size_t)(ai * HALF + m * 16) * ld * 2 + lo) = pack8(acc[ai][bj][m][0], acc[ai][bj][m][1]); } }
    }
};
struct EpiQ8 {
    static constexpr bool PERM = true, BPRE = false;
    unsigned char* Q8; const float* cs;
    __device__ __forceinline__ void operator()(const f32x4 (&acc)[2][2][4][2], const Unit& u, int wr, int wc, int fr, int fq) const {
        const unsigned lo = (unsigned)(fr * 192 + 8 * fq), lcs = (unsigned)(fr * 64 + 8 * fq) * 4u;
        const int rowU = u.pm * BM + wr * 64;
#pragma unroll
        for (int bj = 0; bj < 2; ++bj) { const int c32 = u.pn * BM + bj * HALF + wc * 32, hd = c32 / 192, w32 = c32 - hd * 192;
            char* ub = (char*)(Q8 + ((size_t)hd * SEQ + rowU) * 192 + w32);
            const char* cb = (const char*)(cs + (size_t)rowU * 64 + (w32 >= 128 ? (w32 - 128) : 0));
#pragma unroll
            EPI_ROWLOOP { const int rr = ai * HALF + m * 16; f32x4 v0 = acc[ai][bj][m][0], v1 = acc[ai][bj][m][1];
                if (w32 >= 128) { const f32x4 ca = *(const f32x4*)(cb + (size_t)rr * 256 + lcs), cc = *(const f32x4*)(cb + (size_t)rr * 256 + 16 + lcs);
                    const f32x4 a = v0, b = v1;
                    v0[0] = a[0] * ca[0] - a[1] * ca[1]; v0[1] = a[0] * ca[1] + a[1] * ca[0]; v0[2] = a[2] * ca[2] - a[3] * ca[3]; v0[3] = a[2] * ca[3] + a[3] * ca[2];
                    v1[0] = b[0] * cc[0] - b[1] * cc[1]; v1[1] = b[0] * cc[1] + b[1] * cc[0]; v1[2] = b[2] * cc[2] - b[3] * cc[3]; v1[3] = b[2] * cc[3] + b[3] * cc[2]; }
                v0 = v0 * QK_LOG2_SCALE; v1 = v1 * QK_LOG2_SCALE;
                u32x2 o; o.x = pk4_fp8(v0[0], v0[1], v0[2], v0[3]); o.y = pk4_fp8(v1[0], v1[1], v1[2], v1[3]);
                *(u32x2*)(ub + (size_t)rr * 192 + lo) = o;
                if (m & 1) asm volatile("" ::: "memory"); } }
    }
};
struct EpiK8 {
    static constexpr bool PERM = true, BPRE = false;
    unsigned char* K8;
    __device__ __forceinline__ void operator()(const f32x4 (&acc)[2][2][4][2], const Unit& u, int wr, int wc, int fr, int fq) const {
        const int rowU = u.pm * BM + wr * 64; const unsigned lo = (unsigned)(fr * 192 + 8 * fq);
#pragma unroll
        for (int bj = 0; bj < 2; ++bj) { const int c32 = u.pn * BM + bj * HALF + wc * 32, hd = c32 >> 7, w32 = c32 & 127;
            char* ub = (char*)(K8 + ((size_t)hd * SEQ + rowU) * 192 + w32);
#pragma unroll
            EPI_ROWLOOP { const f32x4 v0 = acc[ai][bj][m][0], v1 = acc[ai][bj][m][1];
                u32x2 o; o.x = pk4_fp8(v0[0], v0[1], v0[2], v0[3]); o.y = pk4_fp8(v1[0], v1[1], v1[2], v1[3]);
                *(u32x2*)(ub + (size_t)(ai * HALF + m * 16) * 192 + lo) = o; } }
    }
};
struct EpiVT8 {
    static constexpr bool PERM = true, BPRE = false;
    unsigned char* VT8;
    __device__ __forceinline__ void operator()(const f32x4 (&acc)[2][2][4][2], const Unit& u, int wr, int wc, int fr, int fq) const {
#pragma unroll
        for (int bj = 0; bj < 2; ++bj) { const int T0 = u.pn * BM + bj * HALF + wc * 32 + 8 * fq, tile = T0 >> 6, G0 = (T0 & 63) >> 2, half = G0 >> 3, a = (G0 & 7) >> 1;
            const int p0 = 4 * (4 * half + a), p1 = 4 * (8 + 4 * half + a);
#pragma unroll
            EPI_ROWLOOP { const int r = u.pm * BM + ai * HALF + wr * 64 + m * 16 + fr, hd = r >> 7, col = r & 127;
                unsigned char* dst = VT8 + (((size_t)hd * (SEQ / 64) + tile) * 128 + col) * 64;
                const f32x4 v0 = acc[ai][bj][m][0], v1 = acc[ai][bj][m][1];
                *(unsigned*)(dst + p0) = pk4_fp8(v0[0], v0[1], v0[2], v0[3]); *(unsigned*)(dst + p1) = pk4_fp8(v1[0], v1[1], v1[2], v1[3]); } }
    }
};
struct EpiRes {
    static constexpr bool PERM = false, BPRE = false;
    const float* x; float* out; const float* mod; float sc;
    __device__ __forceinline__ void operator()(const f32x4 (&acc)[2][2][4][2], const Unit& u, int wr, int wc, int fr, int fq) const {
        const int col0 = u.pn * BM + wc * 32 + 4 * fq;
        const int b = (u.pm * BM) / SEQ;
        f32x4 gt[2][2];
#pragma unroll
        for (int bj = 0; bj < 2; ++bj)
#pragma unroll
            for (int n = 0; n < 2; ++n) gt[bj][n] = *(const f32x4*)(mod + b * 6144 + 2048 + col0 + bj * HALF + n * 16) * sc;
        const unsigned lo = (unsigned)(fr * DM + 4 * fq) * 4u;
        const size_t ubo = ((size_t)(u.pm * BM + wr * 64) * DM + u.pn * BM + wc * 32) * 4;
#pragma unroll
        EPI_ROWLOOP { const size_t ro = ubo + (size_t)(ai * HALF + m * 16) * DM * 4;
#pragma unroll
            for (int bj = 0; bj < 2; ++bj)
#pragma unroll
                for (int n = 0; n < 2; ++n) { const size_t o = ro + (bj * HALF + n * 16) * 4; const f32x4 xv = *(const f32x4*)((const char*)x + o + lo);
                    *(f32x4*)((char*)out + o + lo) = xv + gt[bj][n] * acc[ai][bj][m][n]; }
            if (m & 1) asm volatile("" ::: "memory"); }
    }
};
struct EpiSwiGLU {
    static constexpr bool PERM = true, BPRE = true;
    void* HID; float sc;
    __device__ __forceinline__ void operator()(const f32x4 (&acc)[2][2][4][2], const Unit& u, int wr, int wc, int fr, int fq) const {
        constexpr int HE = FP8_EX ? 1 : 2;
        const __amdgpu_buffer_rsrc_t rs = __builtin_amdgcn_make_buffer_rsrc(HID, 0, 0x7fffffff, 0x00020000);
        const unsigned lo = (unsigned)(fr * DFF + 4 * fq) * HE, so = (unsigned)(((u.g * CAP + u.pm * BM + wr * 64) * DFF + ((u.pn * BM + wc * 32) >> 1)) * HE);
#pragma unroll
        EPI_ROWLOOP {
#pragma unroll
            for (int bj = 0; bj < 2; ++bj) { const f32x4 gv = acc[ai][bj][m][0] * sc, uv = acc[ai][bj][m][1] * sc; f32x4 h;
#pragma unroll
                for (int e = 0; e < 4; ++e) h[e] = gv[e] * fast_sigmoid(gv[e]) * uv[e];
                const unsigned ro = so + (unsigned)((ai * HALF + m * 16) * DFF + bj * (HALF / 2)) * HE;
#if !defined(EPI_BUF_STORES)
                if constexpr (FP8_EX) *(unsigned*)((char*)HID + (size_t)ro + lo) = pk4_fp8(h[0], h[1], h[2], h[3]);
                else { u32x2 o; o.x = cvt_pk_bf16(h[0], h[1]); o.y = cvt_pk_bf16(h[2], h[3]); *(u32x2*)((char*)HID + (size_t)ro + lo) = o; }
#else
                if constexpr (FP8_EX) __builtin_amdgcn_raw_buffer_store_b32(pk4_fp8(h[0], h[1], h[2], h[3]), rs, lo, ro, 0);
                else { u32x2 o; o.x = cvt_pk_bf16(h[0], h[1]); o.y = cvt_pk_bf16(h[2], h[3]); __builtin_amdgcn_raw_buffer_store_b64(o, rs, lo, ro, 0); }
#endif
            } }
    }
};
struct EpiDown {
    static constexpr bool PERM = true, BPRE = true;
    bf16_t* Y; const float* gate; float sc;
    __device__ __forceinline__ void operator()(const f32x4 (&acc)[2][2][4][2], const Unit& u, int wr, int wc, int fr, int fq) const {
        const int rowU = u.g * CAP + u.pm * BM + wr * 64;
        const __amdgpu_buffer_rsrc_t rs = __builtin_amdgcn_make_buffer_rsrc((void*)Y, 0, 0x7fffffff, 0x00020000), rg = __builtin_amdgcn_make_buffer_rsrc((void*)gate, 0, 0x7fffffff, 0x00020000);
        const unsigned lo = (unsigned)(fr * DM + 8 * fq) * 2u, so = (unsigned)((rowU * DM + u.pn * BM + wc * 32) * 2);
#pragma unroll
        EPI_ROWLOOP { const int rr = ai * HALF + m * 16;
#if !defined(EPI_BUF_STORES)
            const float gs = gate[rowU + rr + fr] * sc;
#pragma unroll
            for (int bj = 0; bj < 2; ++bj) *(u32x4*)((char*)Y + (size_t)(so + (unsigned)(rr * DM + bj * HALF) * 2u) + lo) = pack8(acc[ai][bj][m][0] * gs, acc[ai][bj][m][1] * gs);
#else
            const float gs = __uint_as_float(__builtin_amdgcn_raw_buffer_load_b32(rg, (unsigned)fr * 4u, (unsigned)(rowU + rr) * 4u, 0)) * sc;
#pragma unroll
            for (int bj = 0; bj < 2; ++bj) __builtin_amdgcn_raw_buffer_store_b128(pack8(acc[ai][bj][m][0] * gs, acc[ai][bj][m][1] * gs), rs, lo, so + (unsigned)(rr * DM + bj * HALF) * 2u, 0);
#endif
        }
    }
};
#undef EPI_ROWLOOP
}
namespace att {
__device__ __forceinline__ int crow(int r, int hi) { return (r & 3) + 8 * (r >> 2) + 4 * hi; }
__device__ __forceinline__ int v_st(int k, int c) { const int kk = (k & ~0xC) | ((k & 4) << 1) | ((k & 8) >> 1); return ((kk >> 3) * 4 + (c >> 5)) * 512 + ((kk & 7) * 32 + (c & 31)) * 2; }
__device__ __forceinline__ int v_rd_base(int lane) { return ((lane & 3) << 3) | (((lane >> 2) & 3) << 6) | (((lane >> 4) & 1) << 5) | (((lane >> 5) & 1) << 8); }
constexpr int v_rd_off(int d0, int ks, int half) { return d0 * 512 + ks * 4096 + half * 2048; }
template <int OFF> __device__ __forceinline__ s16x4 tr_read(int vb) {
    s16x4 r; asm volatile("ds_read_b64_tr_b16 %0, %1 offset:%2" : "=&v"(r) : "v"(vb), "i"(OFF) : "memory"); return r;
}
#define ATT_SBAR() __builtin_amdgcn_sched_barrier(0)
template <int D0> __device__ __forceinline__ void pv_one(f32x16& od, int vb, bf16x8 pa0, bf16x8 pa1, bf16x8 pa2, bf16x8 pa3) {
    const s16x4 l0 = tr_read<v_rd_off(D0, 0, 0)>(vb), h0 = tr_read<v_rd_off(D0, 0, 1)>(vb), l1 = tr_read<v_rd_off(D0, 1, 0)>(vb), h1 = tr_read<v_rd_off(D0, 1, 1)>(vb);
    const s16x4 l2 = tr_read<v_rd_off(D0, 2, 0)>(vb), h2 = tr_read<v_rd_off(D0, 2, 1)>(vb), l3 = tr_read<v_rd_off(D0, 3, 0)>(vb), h3 = tr_read<v_rd_off(D0, 3, 1)>(vb);
    asm volatile("s_waitcnt lgkmcnt(0)" ::: "memory"); ATT_SBAR();
#define ATT_PK(L, H) (bf16x8){L[0], L[1], L[2], L[3], H[0], H[1], H[2], H[3]}
    od = __builtin_amdgcn_mfma_f32_32x32x16_bf16(pa0, ATT_PK(l0, h0), od, 0, 0, 0);
    od = __builtin_amdgcn_mfma_f32_32x32x16_bf16(pa1, ATT_PK(l1, h1), od, 0, 0, 0);
    od = __builtin_amdgcn_mfma_f32_32x32x16_bf16(pa2, ATT_PK(l2, h2), od, 0, 0, 0);
    od = __builtin_amdgcn_mfma_f32_32x32x16_bf16(pa3, ATT_PK(l3, h3), od, 0, 0, 0);
#undef ATT_PK
}
__device__ __forceinline__ void pv_d0(f32x16* o, int vb, bf16x8 pa0, bf16x8 pa1, bf16x8 pa2, bf16x8 pa3) {
    pv_one<0>(o[0], vb, pa0, pa1, pa2, pa3); pv_one<1>(o[1], vb, pa0, pa1, pa2, pa3); pv_one<2>(o[2], vb, pa0, pa1, pa2, pa3); pv_one<3>(o[3], vb, pa0, pa1, pa2, pa3);
}
__device__ __forceinline__ void finishSM(f32x16& p0, f32x16& p1, float alpha, float& l_reg, bf16x8& pa0, bf16x8& pa1, bf16x8& pa2, bf16x8& pa3) {
#pragma unroll
    for (int r = 0; r < 16; ++r) p1[r] = __builtin_amdgcn_exp2f(p1[r]);
    float ps = 0;
#pragma unroll
    for (int r = 0; r < 16; ++r) ps += p0[r];
#pragma unroll
    for (int r = 0; r < 16; ++r) ps += p1[r];
    { auto rr = __builtin_amdgcn_permlane32_swap(__float_as_uint(ps), __float_as_uint(ps), false, false);
      ps = __uint_as_float(rr[0]) + __uint_as_float(rr[1]); }
    l_reg = l_reg * alpha + ps;
#define ATT_PK4(P, BASE, OUT) do { unsigned a0 = cvt_pk_bf16(P[BASE + 0], P[BASE + 1]), a1 = cvt_pk_bf16(P[BASE + 2], P[BASE + 3]);   \
    unsigned b0 = cvt_pk_bf16(P[BASE + 4], P[BASE + 5]), b1 = cvt_pk_bf16(P[BASE + 6], P[BASE + 7]);                              \
    auto r0 = __builtin_amdgcn_permlane32_swap(a0, b0, false, false); auto r1 = __builtin_amdgcn_permlane32_swap(a1, b1, false, false); \
    u32x4 w = {r0[0], r1[0], r0[1], r1[1]}; OUT = *reinterpret_cast<bf16x8*>(&w); } while (0)
    ATT_PK4(p0, 0, pa0); ATT_PK4(p0, 8, pa1); ATT_PK4(p1, 0, pa2); ATT_PK4(p1, 8, pa3);
#undef ATT_PK4
}

struct Unit {
    const bf16_t* Q; int qs;
    const bf16_t* K; int ks;
    const bf16_t* V; int vs;
    bf16_t* O; int os;
    int nt;
    int tmul;
    float* dbg;
    int kt0, ktn;
    int l0;
    const int* pos; int ps;
    float* lse; int ls;
    const float* bias;
};

template <bool DIL> struct Cfg {
    static constexpr bool K8 = DIL && (DIL_FP8 != 0);
    static constexpr int DQK = DIL ? 128 : 192, ND = K8 ? 4 : DQK / 16, KROWB = (K8 ? DQK : DQK * 2) + 16, SHM_K = 64 * KROWB, SHM_V = 16384;
    static constexpr int NKC = DQK / 64;
    static constexpr int OFF_V = 0, OFF_K = 2 * SHM_V, OFF_WS = (OFF_K + 2 * SHM_K > 8 * 8448 ? OFF_K + 2 * SHM_K : 8 * 8448)  , OFF_POS = OFF_WS + NWAVES * 64 * 4, OFF_LUT = OFF_POS + 3 * 64 * 4, END = OFF_LUT + 2120 * 4;
    static constexpr float SCALE = DIL ? 0.088388347648318440f : 0.072168783648703220f;
};

template <bool DIL>
__device__ __forceinline__ void qkt(f32x16& p0, f32x16& p1, const LAS char* Ks, const bf16x8* qr, int r32, int hi) {
    using C = Cfg<DIL>;
    p0 = f32x16{}; p1 = f32x16{};
    const LAS char* k0 = Ks + r32 * C::KROWB + hi * 16; const LAS char* k1 = k0 + 32 * C::KROWB;
#pragma unroll
    for (int d0 = 0; d0 < C::ND; ++d0) {
        const bf16x8 b0 = *(const LAS bf16x8*)(k0 + d0 * 32);
        const bf16x8 b1 = *(const LAS bf16x8*)(k1 + d0 * 32);
        p0 = __builtin_amdgcn_mfma_f32_32x32x16_bf16(b0, qr[d0], p0, 0, 0, 0);
        p1 = __builtin_amdgcn_mfma_f32_32x32x16_bf16(b1, qr[d0], p1, 0, 0, 0); }
}

template <bool DIL>
__device__ __forceinline__ void xstage(bool pv, bool qk, f32x16* o, int vb, bf16x8 pa0, bf16x8 pa1, bf16x8 pa2, bf16x8 pa3, f32x16& p0, f32x16& p1, const LAS char* Ks, const bf16x8* qr, int r32, int hi) {
    using C = Cfg<DIL>;
    constexpr int NG = C::ND / 2;
    const LAS char* k0 = Ks + r32 * C::KROWB + hi * (C::K8 ? 32 : 16);
    bf16x8 f[2][4];
    const int ka = (int)(unsigned)(size_t)k0;
#define ATT_KR1(dst_, off_) asm volatile("ds_read_b128 %0, %1 offset:%2" : "=&v"(dst_) : "v"(ka), "i"(off_) : "memory")
#define ATT_KRD(s_, g_) do { if constexpr (C::K8) { ATT_KR1(f[s_][0], 64 * (g_)); ATT_KR1(f[s_][1], 64 * (g_) + 16); ATT_KR1(f[s_][2], 32 * C::KROWB + 64 * (g_)); ATT_KR1(f[s_][3], 32 * C::KROWB + 64 * (g_) + 16); } \
        else { ATT_KR1(f[s_][0], (2 * (g_)) * 32); ATT_KR1(f[s_][1], 32 * C::KROWB + (2 * (g_)) * 32); ATT_KR1(f[s_][2], (2 * (g_) + 1) * 32); ATT_KR1(f[s_][3], 32 * C::KROWB + (2 * (g_) + 1) * 32); } } while (0)
#define ATT_PK(L, H) (bf16x8){L[0], L[1], L[2], L[3], H[0], H[1], H[2], H[3]}
#define ATT_VRD1(B_, s_, ks_) do { const s16x4 l_ = tr_read<v_rd_off(B_, ks_, 0)>(vb), h_ = tr_read<v_rd_off(B_, ks_, 1)>(vb); f[s_][ks_] = ATT_PK(l_, h_); } while (0)
#define ATT_VRD(B_, s_) do { ATT_VRD1(B_, s_, 0); ATT_VRD1(B_, s_, 1); ATT_VRD1(B_, s_, 2); ATT_VRD1(B_, s_, 3); } while (0)
#define ATT_VMMA(B_, s_) do { o[B_] = __builtin_amdgcn_mfma_f32_32x32x16_bf16(pa0, f[s_][0], o[B_], 0, 0, 0); o[B_] = __builtin_amdgcn_mfma_f32_32x32x16_bf16(pa1, f[s_][1], o[B_], 0, 0, 0); \
        o[B_] = __builtin_amdgcn_mfma_f32_32x32x16_bf16(pa2, f[s_][2], o[B_], 0, 0, 0); o[B_] = __builtin_amdgcn_mfma_f32_32x32x16_bf16(pa3, f[s_][3], o[B_], 0, 0, 0); } while (0)
#define ATT_LW(n) asm volatile("s_waitcnt lgkmcnt(" #n ")" ::: "memory")
    if (pv) {
        ATT_VRD(0, 0); ATT_SBAR();
        ATT_VRD(1, 1); ATT_LW(8); ATT_SBAR(); ATT_VMMA(0, 0); ATT_SBAR();
        ATT_VRD(2, 0); ATT_LW(8); ATT_SBAR(); ATT_VMMA(1, 1); ATT_SBAR();
        ATT_VRD(3, 1); ATT_LW(8); ATT_SBAR(); ATT_VMMA(2, 0); ATT_SBAR();
        ATT_KRD(0, 0); ATT_LW(4); ATT_SBAR(); ATT_VMMA(3, 1); ATT_SBAR();
    } else { ATT_KRD(0, 0); ATT_SBAR(); }
    if (!qk) { ATT_LW(0); return; }
    p0 = f32x16{}; p1 = f32x16{};
    if constexpr (C::K8) {
#define ATT_CAT(x_, y_) __builtin_shufflevector(__builtin_bit_cast(i32x4, x_), __builtin_bit_cast(i32x4, y_), 0, 1, 2, 3, 4, 5, 6, 7)
        ATT_KRD(1, 1); ATT_LW(4); ATT_SBAR();
        p0 = __builtin_amdgcn_mfma_scale_f32_32x32x64_f8f6f4(ATT_CAT(f[0][0], f[0][1]), ATT_CAT(qr[0], qr[1]), p0, 0, 0, 0, 0, 0, 0);
        p1 = __builtin_amdgcn_mfma_scale_f32_32x32x64_f8f6f4(ATT_CAT(f[0][2], f[0][3]), ATT_CAT(qr[0], qr[1]), p1, 0, 0, 0, 0, 0, 0);
        ATT_SBAR(); ATT_LW(0); ATT_SBAR();
        p0 = __builtin_amdgcn_mfma_scale_f32_32x32x64_f8f6f4(ATT_CAT(f[1][0], f[1][1]), ATT_CAT(qr[2], qr[3]), p0, 0, 0, 0, 0, 0, 0);
        p1 = __builtin_amdgcn_mfma_scale_f32_32x32x64_f8f6f4(ATT_CAT(f[1][2], f[1][3]), ATT_CAT(qr[2], qr[3]), p1, 0, 0, 0, 0, 0, 0);
        ATT_SBAR();
#undef ATT_CAT
    } else {
#pragma unroll
    for (int g = 0; g < NG; ++g) { const int sg = g & 1;
        if (g + 1 < NG) { ATT_KRD(sg ^ 1, g + 1); ATT_LW(4); } else { ATT_LW(0); }
        ATT_SBAR();
        p0 = __builtin_amdgcn_mfma_f32_32x32x16_bf16(f[sg][0], qr[2 * g], p0, 0, 0, 0);
        p1 = __builtin_amdgcn_mfma_f32_32x32x16_bf16(f[sg][1], qr[2 * g], p1, 0, 0, 0);
        p0 = __builtin_amdgcn_mfma_f32_32x32x16_bf16(f[sg][2], qr[2 * g + 1], p0, 0, 0, 0);
        p1 = __builtin_amdgcn_mfma_f32_32x32x16_bf16(f[sg][3], qr[2 * g + 1], p1, 0, 0, 0);
        ATT_SBAR(); } }
#undef ATT_VRD1
#undef ATT_KRD
#undef ATT_KR1
#undef ATT_VRD
#undef ATT_PK
#undef ATT_VMMA
#undef ATT_LW
}

template <bool DIL>
__device__ __forceinline__ void partialSM(f32x16& p0, f32x16& p1, float& m_reg, float& mn, float& alpha,
                                          const LAS int* posb, int qoff, int lutlo, int dl0, bool masked, int hi) {
    using C = Cfg<DIL>;
    constexpr float CC = C::SCALE * LOG2E;
    constexpr float THR = 8.f;
    float mnC;
    if constexpr (DIL) {
        const LAS float* lutp = (const LAS float*)(size_t)(unsigned)lutlo;
#define ATT_LUT(pk_) ({ int u_ = (pk_) + qoff; u_ = u_ < 0 ? 0 : (u_ > 2048 ? 2048 : u_); lutp[u_ + (u_ >> 5)]; })
        float bz0[16], bz1[16];
#pragma unroll
        for (int a = 0; a < 4; ++a) {
            const i32x4 pk0 = *(const LAS i32x4*)(posb + 8 * a + 4 * hi), pk1 = *(const LAS i32x4*)(posb + 32 + 8 * a + 4 * hi);
#pragma unroll
            for (int b = 0; b < 4; ++b) { bz0[4 * a + b] = ATT_LUT(pk0[b]); bz1[4 * a + b] = ATT_LUT(pk1[b]); }
        }
        ATT_SBAR();
        if (masked) {
#pragma unroll
            for (int r = 0; r < 16; ++r) { const int dl = dl0 + 8 * (r >> 2) + (r & 3);
                p0[r] = ((unsigned)(dl + 64) <= 128u) ? fmaf(p0[r], CC, bz0[r]) : -1e30f;
                p1[r] = ((unsigned)(dl + 32 + 64) <= 128u) ? fmaf(p1[r], CC, bz1[r]) : -1e30f; }
        } else {
#pragma unroll
            for (int r = 0; r < 16; ++r) { p0[r] = fmaf(p0[r], CC, bz0[r]); p1[r] = fmaf(p1[r], CC, bz1[r]); }
        }
#undef ATT_LUT
        float pmax = p0[0];
#pragma unroll
        for (int r = 1; r < 16; ++r) pmax = fmaxf(pmax, p0[r]);
#pragma unroll
        for (int r = 0; r < 16; ++r) pmax = fmaxf(pmax, p1[r]);
        { auto rr = __builtin_amdgcn_permlane32_swap(__float_as_uint(pmax), __float_as_uint(pmax), false, false);
          pmax = fmaxf(__uint_as_float(rr[0]), __uint_as_float(rr[1])); }
        if (__builtin_expect(__all(pmax - m_reg <= THR * LOG2E), 1)) { mn = m_reg; alpha = 1.f; }
        else { mn = fmaxf(m_reg, pmax); alpha = __builtin_amdgcn_exp2f(m_reg - mn); m_reg = mn; }
        mnC = -fmaxf(mn, -1e29f);
#pragma unroll
        for (int r = 0; r < 16; ++r) p0[r] = p0[r] + mnC;
#pragma unroll
        for (int r = 0; r < 16; ++r) p1[r] = p1[r] + mnC;
    } else {
        float pmax = p0[0];
#pragma unroll
        for (int r = 1; r < 16; ++r) pmax = fmaxf(pmax, p0[r]);
#pragma unroll
        for (int r = 0; r < 16; ++r) pmax = fmaxf(pmax, p1[r]);
        { auto rr = __builtin_amdgcn_permlane32_swap(__float_as_uint(pmax), __float_as_uint(pmax), false, false);
          pmax = fmaxf(__uint_as_float(rr[0]), __uint_as_float(rr[1])); }
        if (__builtin_expect(__all(pmax - m_reg <= THR / C::SCALE), 1)) { mn = m_reg; alpha = 1.f; }
        else { mn = fmaxf(m_reg, pmax); alpha = __builtin_amdgcn_exp2f((m_reg - mn) * CC); m_reg = mn; }
        mnC = -mn * CC;
#pragma unroll
        for (int r = 0; r < 16; ++r) p0[r] = fmaf(p0[r], CC, mnC);
#pragma unroll
        for (int r = 0; r < 16; ++r) p1[r] = fmaf(p1[r], CC, mnC);
    }
#pragma unroll
    for (int r = 0; r < 16; ++r) p0[r] = __builtin_amdgcn_exp2f(p0[r]);
}

__device__ __forceinline__ int t5_bucket(int rel) {
    const int n = rel < 0 ? -rel : rel;
    const float nf = (float)(n > 1 ? n : 1);
    int large = 8 + (int)(logf(nf / 8.f) / 4.852030263919617f * 8.f);
    large = large < 15 ? large : 15;
    return (rel > 0 ? 16 : 0) + (n < 8 ? n : large);
}

template <bool DIL>
__device__ __forceinline__ void attn_unit(const Unit& a, LAS char* lds, int wv) {
    using C = Cfg<DIL>;
    constexpr int SD = 1;
    const int tid = opaque_tid(wv), wid = __builtin_amdgcn_readfirstlane(tid >> 6), lane = tid & 63, r32 = lane & 31, hi = lane >> 5;
    LAS char* V_lds = lds + C::OFF_V; LAS char* K_lds = lds + C::OFF_K;
    LAS float* ws = (LAS float*)(lds + C::OFF_WS) + wid * 64; LAS float* li_l = ws; LAS float* al_l = ws + 32;
    LAS int* pos_l = (LAS int*)(lds + C::OFF_POS); LAS float* lut = (LAS float*)(lds + C::OFF_LUT);
    float m_reg = -1e30f, l_reg = 0; f32x16 o[4] = {}; bf16x8 qr[C::ND];
    if constexpr (C::K8) { const char* Qw = (const char*)(a.Q + (size_t)(wid * 32 + r32) * a.qs) + hi * 32;
#pragma unroll
      for (int i = 0; i < 4; ++i) qr[i] = *(const bf16x8*)(Qw + 64 * (i >> 1) + 16 * (i & 1)); }
    else { const bf16_t* Qw = a.Q + (size_t)(wid * 32 + r32) * a.qs + hi * 8;
#pragma unroll
      for (int d0 = 0; d0 < C::ND; ++d0) qr[d0] = *(const bf16x8*)(Qw + d0 * 16); }
    int pq = 0, lq = 0;
    if constexpr (DIL) {
        lq = a.l0 + wid * 32 + r32; pq = a.pos[(size_t)lq * a.ps];
        pq = 1024 - pq;
        for (int i = tid; i < 2049; i += 512) lut[i + (i >> 5)] = a.bias[t5_bucket(i - 1024) * 24] * LOG2E;
    }
    constexpr int CPR = C::KROWB / 16, NKP = C::SHM_K / 1024, NKI = (NKP + 7) / 8;
    unsigned kgo[NKI];
#pragma unroll
    for (int i = 0; i < NKI; ++i) { const int pch = (wid + 8 * i) * 64 + lane, kr = pch / CPR, kc = pch % CPR; kgo[i] = (unsigned)(kr * a.ks + (kc == CPR - 1 ? 0 : kc) * 8) * 2u; }
    unsigned vgo[2];
#pragma unroll
    for (int i = 0; i < 2; ++i) { const int pch = (wid + 8 * i) * 64 + lane, sub = pch >> 5, within = pch & 31, kk = (sub >> 2) * 8 + (within >> 2), cc = (sub & 3) * 32 + (within & 3) * 8;
        const int k = (kk & ~0xC) | ((kk & 4) << 1) | ((kk & 8) >> 1); vgo[i] = (unsigned)(k * a.vs + cc) * 2u; }
    const int vb0 = (int)(unsigned)(size_t)V_lds + v_rd_base(lane);
    int ppos = 0, ppos_n = 0;
#define ATT_KROW0(j) (DIL ? (((a.kt0 + (j)) < 0 ? 0 : ((a.kt0 + (j)) >= a.ktn ? a.ktn - 1 : (a.kt0 + (j)))) * 64) : (j) * 64 * a.tmul)
#define ATT_DMAK(j) do { const int k0_ = ATT_KROW0(j); const char* kt_ = (const char*)(a.K + (size_t)k0_ * a.ks); LAS char* kd_ = K_lds + ((j) & 1) * C::SHM_K + wid * 1024; \
        _Pragma("unroll") for (int q_ = 0; q_ < NKI; ++q_) if (wid + 8 * q_ < NKP) \
            __builtin_amdgcn_global_load_lds((const unsigned*)(kt_ + kgo[q_]), (LAS unsigned*)(kd_ + q_ * 8192), 16, 0, 0); } while (0)
#define ATT_DMAV(j) do { const int k0_ = ATT_KROW0(j); const char* vt_ = (const char*)(a.V + (size_t)k0_ * a.vs); LAS char* vd_ = V_lds + ((j) & 1) * C::SHM_V + wid * 1024; \
        __builtin_amdgcn_global_load_lds((const unsigned*)(vt_ + vgo[0]), (LAS unsigned*)(vd_), 16, 0, 0); \
        __builtin_amdgcn_global_load_lds((const unsigned*)(vt_ + vgo[1]), (LAS unsigned*)(vd_ + 8192), 16, 0, 0); } while (0)
#define ATT_LOADPOS(dst_, j) do { if constexpr (DIL) { if (tid < 64) dst_ = a.pos[(size_t)(ATT_KROW0(j) + tid) * a.ps]; } } while (0)
#define ATT_WRITEPOS(j) do { if constexpr (DIL) { if (tid < 64) pos_l[((j) % 3) * 64 + tid] = ppos; } } while (0)
#define ATT_VMW() asm volatile("s_waitcnt vmcnt(0)" ::: "memory")
#define ATT_BAR() do { asm volatile("s_waitcnt lgkmcnt(0)" ::: "memory"); __builtin_amdgcn_s_barrier(); asm volatile("" ::: "memory"); } while (0)
#define ATT_RESC(al) do { if (__any((al) < 1.f)) { if (hi == 0) al_l[r32] = (al); asm volatile("s_waitcnt lgkmcnt(0)" ::: "memory"); \
        _Pragma("unroll") for (int d = 0; d < 4; ++d) _Pragma("unroll") for (int r = 0; r < 16; ++r) o[d][r] *= al_l[crow(r, hi)]; } } while (0)
#define ATT_DL0(j) (DIL ? (ATT_TV(j) ? (64 * (a.kt0 + (j)) - lq + 4 * hi) : 0x20000000) : 0)
#define ATT_TV(j) (DIL ? ((a.kt0 + (j)) >= 0 && (a.kt0 + (j)) < a.ktn) : true)
#define ATT_MASKED(j) (DIL ? ((j) != (wid >> 1) + 1) : false)
    f32x16 p0, p1; float mn, al; bf16x8 pa0, pa1, pa2, pa3; const int NT = a.nt;
    const bool grpB = wid >= 4;
    ATT_DMAK(0); ATT_LOADPOS(ppos, 0); ATT_VMW(); ATT_WRITEPOS(0); ATT_LOADPOS(ppos, 1);
    __syncthreads();
#define ATT_ISSUE(j) do { if ((j) + 1 < NT) ATT_DMAK((j) + 1); ATT_DMAV(j); \
        if constexpr (DIL) { if (wid == 0) { if ((j) + 2 < NT) ATT_LOADPOS(ppos_n, (j) + 2); if ((j) + 1 < NT) { ATT_WRITEPOS((j) + 1); ppos = ppos_n; } } } } while (0)
#define ATT_ACT(j) (!DIL || ((j) >= (wid >> 1) && (j) <= (wid >> 1) + 2))
#define ATT_X(j) do { ATT_SBAR(); xstage<DIL>((j) > 0 && ATT_ACT((j) - 1), ATT_ACT(j), o, vb0 + (((j) & 1) ^ 1) * (int)C::SHM_V, pa0, pa1, pa2, pa3, p0, p1, K_lds + ((j) & 1) * C::SHM_K, qr, r32, hi); ATT_SBAR(); } while (0)
#define ATT_S(j) do { if (ATT_ACT(j)) { partialSM<DIL>(p0, p1, m_reg, mn, al, pos_l + ((j) % 3) * 64, pq, (int)(unsigned)(size_t)lut, ATT_DL0(j), ATT_MASKED(j), hi); ATT_RESC(al); \
        finishSM(p0, p1, al, l_reg, pa0, pa1, pa2, pa3); } ATT_SBAR(); } while (0)
    if (!grpB) {
#pragma unroll 1
        for (int j = 0; j < NT; ++j) { ATT_ISSUE(j); ATT_X(j); ATT_S(j); ATT_VMW(); ATT_BAR(); }
    } else {
        { ATT_ISSUE(0); ATT_X(0); ATT_VMW(); ATT_BAR(); }
#pragma unroll 1
        for (int j = 1; j < NT; ++j) { ATT_ISSUE(j); ATT_S(j - 1); ATT_X(j); ATT_VMW(); ATT_BAR(); }
        ATT_S(NT - 1);
    }
    if (ATT_ACT(NT - 1)) pv_d0(o, vb0 + ((NT - 1) & 1) * (int)C::SHM_V, pa0, pa1, pa2, pa3);
#undef ATT_ISSUE
#undef ATT_ACT
#undef ATT_X
#undef ATT_S
    ATT_BAR();
    if (hi == 0) li_l[r32] = l_reg; asm volatile("s_waitcnt lgkmcnt(0)" ::: "memory");
    { LAS char* ot = lds + wid * 8448;
#pragma unroll
      for (int r = 0; r < 16; ++r) { const int orow = crow(r, hi); const float rl = __builtin_amdgcn_rcpf(li_l[orow]);
#pragma unroll
          for (int d0 = 0; d0 < 4; ++d0) { const float v = o[d0][r] * rl; *(LAS bf16_t*)(ot + orow * 264 + (d0 * 32 + r32) * 2) = (bf16_t)(cvt_pk_bf16(v, v) & 0xffffu); } }
      asm volatile("s_waitcnt lgkmcnt(0)" ::: "memory");
      char* Ow = (char*)(a.O + (size_t)(wid * 32) * a.os);
      const int orow0 = lane >> 4, ocol = (lane & 15) * 16;
#pragma unroll
      for (int i = 0; i < 8; ++i) { const int orow = orow0 + 4 * i; const u32x2 w0 = *(const LAS u32x2*)(ot + orow * 264 + ocol), w1 = *(const LAS u32x2*)(ot + orow * 264 + ocol + 8);
          u32x4 w; w.x = w0.x; w.y = w0.y; w.z = w1.x; w.w = w1.y;
          *(u32x4*)(Ow + (size_t)orow * a.os * 2 + ocol) = w; } }
    if constexpr (DIL) { if (hi == 0) a.lse[(size_t)(wid * 32 + r32) * a.ls] = m_reg + __builtin_amdgcn_logf(l_reg); }
    __syncthreads();

#undef ATT_KROW0
#undef ATT_BAR
#undef ATT_DMAK
#undef ATT_DMAV
#undef ATT_LOADPOS
#undef ATT_WRITEPOS
#undef ATT_VMW
#undef ATT_RESC
#undef ATT_DL0
#undef ATT_TV
#undef ATT_MASKED
}
struct Unit8 { const unsigned char* Q; const unsigned char* K; const unsigned char* VT; bf16_t* O; int os, nt; float* dbg; };
__device__ __forceinline__ v8i ld32(const LAS char* p) { return __builtin_shufflevector(*(const LAS i32x4*)p, *(const LAS i32x4*)(p + 16), 0, 1, 2, 3, 4, 5, 6, 7); }
#define ATT8_MFMA(a_, b_, c_) __builtin_amdgcn_mfma_scale_f32_32x32x64_f8f6f4(a_, b_, c_, 0, 0, 0, 0, 0, 0)
__device__ __forceinline__ void attn_mla8_unit(const Unit8& a, LAS char* lds, int wv) {
    constexpr int KROWB = 208, SHM_K = 64 * KROWB  , VROWB = 80, SHM_V = 128 * VROWB  , NKP = 13, NVP = 10;
    constexpr int OFF_V = 0, OFF_K = 3 * SHM_V, OFF_WS = OFF_K + 3 * SHM_K;
    static_assert(8 * 8448 <= OFF_WS, "output staging images below the per-wave words");
    constexpr float THR2 = 5.0f * LOG2E;
    const int tid = opaque_tid(wv), wid = __builtin_amdgcn_readfirstlane(tid >> 6), lane = tid & 63, r32 = lane & 31, hi = lane >> 5;
    LAS char* V_lds = lds + OFF_V; LAS char* K_lds = lds + OFF_K;
    LAS float* li_l = (LAS float*)(lds + OFF_WS) + wid * 64; LAS float* al_l = li_l + 32;
    float m2 = 0.f, l_reg = 0.f; f32x16 o[4] = {}; v8i qr[3];
    { const unsigned char* Qw = a.Q + (size_t)(wid * 32 + r32) * 192 + hi * 32;
#pragma unroll
      for (int c = 0; c < 3; ++c) qr[c] = __builtin_shufflevector(*(const i32x4*)(Qw + 64 * c), *(const i32x4*)(Qw + 64 * c + 16), 0, 1, 2, 3, 4, 5, 6, 7); }
    unsigned kgo[2], vgo[2];
#pragma unroll
    for (int i = 0; i < 2; ++i) { const int p = (wid + 8 * i) * 64 + lane, kr = p / 13, kc = p % 13; kgo[i] = (unsigned)(kr * 192 + (kc == 12 ? 0 : kc) * 16);
        const int vr = p / 5, vc = p % 5; vgo[i] = (unsigned)(vr * 64 + (vc == 4 ? 0 : vc) * 16); }
#define ATT8_DMAK(j, slot) do { const char* kt_ = (const char*)a.K + (size_t)(j) * 64 * 192; LAS char* kd_ = K_lds + (slot) * SHM_K + wid * 1024; \
        __builtin_amdgcn_global_load_lds((const unsigned*)(kt_ + kgo[0]), (LAS unsigned*)(kd_), 16, 0, 0); \
        if (wid + 8 < NKP) __builtin_amdgcn_global_load_lds((const unsigned*)(kt_ + kgo[1]), (LAS unsigned*)(kd_ + 8192), 16, 0, 0); } while (0)
#define ATT8_DMAV(j, slot) do { const char* vt_ = (const char*)a.VT + (size_t)(j) * 8192; LAS char* vd_ = V_lds + (slot) * SHM_V + wid * 1024; \
        __builtin_amdgcn_global_load_lds((const unsigned*)(vt_ + vgo[0]), (LAS unsigned*)(vd_), 16, 0, 0); \
        if (wid + 8 < NVP) __builtin_amdgcn_global_load_lds((const unsigned*)(vt_ + vgo[1]), (LAS unsigned*)(vd_ + 8192), 16, 0, 0); } while (0)
#define ATT8_VMW() asm volatile("s_waitcnt vmcnt(0)" ::: "memory")
#define ATT8_BAR() do { asm volatile("s_waitcnt lgkmcnt(0)" ::: "memory"); __builtin_amdgcn_s_barrier(); asm volatile("" ::: "memory"); } while (0)
#define ATT8_RD(dst_, addr_, off_) do { i32x4 lo_, hi_; asm volatile("ds_read_b128 %0, %1 offset:%2" : "=&v"(lo_) : "v"(addr_), "i"(off_) : "memory"); \
        asm volatile("ds_read_b128 %0, %1 offset:%2" : "=&v"(hi_) : "v"(addr_), "i"((off_) + 16) : "memory"); dst_ = __builtin_shufflevector(lo_, hi_, 0, 1, 2, 3, 4, 5, 6, 7); } while (0)
#define ATT8_LW(n) asm volatile("s_waitcnt lgkmcnt(" #n ")" ::: "memory")
    const int koff = r32 * KROWB + hi * 32, voff = r32 * VROWB + hi * 32;
    f32x16 p0, p1; v8i pa = {}; const int NT = a.nt;
    const bool grpB = wid >= 4;
    ATT8_DMAK(0, 0); ATT8_DMAK(1, 1); ATT8_DMAV(0, 0); ATT8_VMW();
    __syncthreads();
    int s0 = 0, s1 = 1, s2 = 2;
#define ATT8_ISSUE() do { if (j + 2 < NT) ATT8_DMAK(j + 2, s2); if (j + 1 < NT) ATT8_DMAV(j + 1, s1); } while (0)
#define ATT8_QK6(kb_, G0_, G1_, G2_) do { \
        ATT8_RD(G2_, kb_, 64); ATT8_LW(4); ATT_SBAR(); p0 = ATT8_MFMA(G0_, qr[0], p0); ATT_SBAR(); \
        ATT8_RD(G0_, kb_, 32 * KROWB + 64); ATT8_LW(4); ATT_SBAR(); p1 = ATT8_MFMA(G1_, qr[0], p1); ATT_SBAR(); \
        ATT8_RD(G1_, kb_, 128); ATT8_LW(4); ATT_SBAR(); p0 = ATT8_MFMA(G2_, qr[1], p0); ATT_SBAR(); \
        ATT8_RD(G2_, kb_, 32 * KROWB + 128); ATT8_LW(4); ATT_SBAR(); p1 = ATT8_MFMA(G0_, qr[1], p1); ATT_SBAR(); \
        ATT8_LW(2); ATT_SBAR(); p0 = ATT8_MFMA(G1_, qr[2], p0); ATT_SBAR(); \
        ATT8_LW(0); ATT_SBAR(); p1 = ATT8_MFMA(G2_, qr[2], p1); ATT_SBAR(); } while (0)
#define ATT8_PACK() do { _Pragma("unroll") for (int q = 0; q < 4; ++q) { pa[q] = (int)pk4_fp8(p0[4 * q], p0[4 * q + 1], p0[4 * q + 2], p0[4 * q + 3]); pa[4 + q] = (int)pk4_fp8(p1[4 * q], p1[4 * q + 1], p1[4 * q + 2], p1[4 * q + 3]); } } while (0)
#define ATT8_ROWSUM(al_) do { float ps_ = 0.f; _Pragma("unroll") for (int r = 0; r < 16; ++r) ps_ += p0[r]; _Pragma("unroll") for (int r = 0; r < 16; ++r) ps_ += p1[r]; \
        { auto rr = __builtin_amdgcn_permlane32_swap(__float_as_uint(ps_), __float_as_uint(ps_), false, false); ps_ = __uint_as_float(rr[0]) + __uint_as_float(rr[1]); } l_reg = l_reg * (al_) + ps_; } while (0)
#define ATT8_INIT() do { const float nm_ = -m2; _Pragma("unroll") for (int r = 0; r < 16; ++r) { p0[r] = nm_; p1[r] = nm_; } } while (0)
#define ATT8_ROWMAX(pm_) do { pm_ = p0[0]; _Pragma("unroll") for (int r = 1; r < 16; ++r) pm_ = fmaxf(pm_, p0[r]); _Pragma("unroll") for (int r = 0; r < 16; ++r) pm_ = fmaxf(pm_, p1[r]); \
        { auto rr = __builtin_amdgcn_permlane32_swap(__float_as_uint(pm_), __float_as_uint(pm_), false, false); pm_ = fmaxf(__uint_as_float(rr[0]), __uint_as_float(rr[1])); } } while (0)
#define ATT8_X0() do { const int kb = (int)(unsigned)(size_t)(K_lds + s0 * SHM_K + koff); v8i g0, g1, g2; ATT8_RD(g0, kb, 0); ATT8_RD(g1, kb, 32 * KROWB); p0 = f32x16{}; p1 = f32x16{}; ATT8_QK6(kb, g0, g1, g2); } while (0)
#define ATT8_X() do { const int vb = (int)(unsigned)(size_t)(V_lds + s2 * SHM_V + voff), kb = (int)(unsigned)(size_t)(K_lds + s0 * SHM_K + koff); v8i g0, g1, g2; \
        ATT8_RD(g0, vb, 0); ATT8_RD(g1, vb, 32 * VROWB); ATT_SBAR(); \
        ATT8_RD(g2, vb, 64 * VROWB); ATT8_LW(4); ATT_SBAR(); o[0] = ATT8_MFMA(pa, g0, o[0]); ATT_SBAR(); \
        ATT8_RD(g0, vb, 96 * VROWB); ATT8_LW(4); ATT_SBAR(); o[1] = ATT8_MFMA(pa, g1, o[1]); ATT_SBAR(); \
        ATT8_RD(g1, kb, 0); ATT8_LW(4); ATT_SBAR(); o[2] = ATT8_MFMA(pa, g2, o[2]); ATT_SBAR(); \
        ATT8_RD(g2, kb, 32 * KROWB); ATT8_LW(4); ATT_SBAR(); o[3] = ATT8_MFMA(pa, g0, o[3]); ATT_SBAR(); \
        ATT8_QK6(kb, g1, g2, g0); } while (0)
#define ATT8_S0() do { float pmax; ATT8_ROWMAX(pmax); m2 = pmax; \
        _Pragma("unroll") for (int r = 0; r < 16; ++r) { p0[r] = __builtin_amdgcn_exp2f(p0[r] - m2); p1[r] = __builtin_amdgcn_exp2f(p1[r] - m2); } \
        ATT8_PACK(); ATT8_ROWSUM(1.f); ATT8_INIT(); } while (0)
#define ATT8_S() do { float pmax, al = 1.f; ATT8_ROWMAX(pmax); \
        if (__builtin_expect(!__all(pmax <= THR2), 0)) { \
            const float dl = fmaxf(pmax, 0.f); al = __builtin_amdgcn_exp2f(-dl); m2 += dl; \
            if (hi == 0) al_l[r32] = al; asm volatile("s_waitcnt lgkmcnt(0)" ::: "memory"); \
            _Pragma("unroll") for (int d = 0; d < 4; ++d) _Pragma("unroll") for (int r = 0; r < 16; ++r) o[d][r] *= al_l[crow(r, hi)]; \
            _Pragma("unroll") for (int r = 0; r < 16; ++r) { p0[r] -= dl; p1[r] -= dl; } } \
        _Pragma("unroll") for (int r = 0; r < 16; ++r) { p0[r] = __builtin_amdgcn_exp2f(p0[r]); p1[r] = __builtin_amdgcn_exp2f(p1[r]); } \
        ATT8_PACK(); ATT8_ROWSUM(al); ATT8_INIT(); } while (0)
#define ATT8_ROT() do { const int t_ = s0; s0 = s1; s1 = s2; s2 = t_; } while (0)
    if (!grpB) {
        { const int j = 0; ATT8_ISSUE(); ATT_SBAR(); ATT8_X0(); ATT_SBAR(); ATT8_S0(); ATT_SBAR(); ATT8_VMW(); ATT8_BAR(); ATT8_ROT(); }
#pragma unroll 1
        for (int j = 1; j < NT; ++j) { ATT8_ISSUE(); ATT_SBAR(); ATT8_X(); ATT_SBAR(); ATT8_S(); ATT_SBAR(); ATT8_VMW(); ATT8_BAR(); ATT8_ROT(); }
    } else {
        { const int j = 0; ATT8_ISSUE(); ATT_SBAR(); ATT8_X0(); ATT_SBAR(); ATT8_VMW(); ATT8_BAR(); ATT8_ROT(); }
        { const int j = 1; ATT8_ISSUE(); ATT_SBAR(); ATT8_S0(); ATT_SBAR(); ATT8_X(); ATT_SBAR(); ATT8_VMW(); ATT8_BAR(); ATT8_ROT(); }
#pragma unroll 1
        for (int j = 2; j < NT; ++j) { ATT8_ISSUE(); ATT_SBAR(); ATT8_S(); ATT_SBAR(); ATT8_X(); ATT_SBAR(); ATT8_VMW(); ATT8_BAR(); ATT8_ROT(); }
        ATT8_S();
    }
    { const LAS char* vb = V_lds + s2 * SHM_V + voff;
      o[0] = ATT8_MFMA(pa, ld32(vb), o[0]); o[1] = ATT8_MFMA(pa, ld32(vb + 32 * VROWB), o[1]); o[2] = ATT8_MFMA(pa, ld32(vb + 64 * VROWB), o[2]); o[3] = ATT8_MFMA(pa, ld32(vb + 96 * VROWB), o[3]); }
    ATT8_BAR();
    if (hi == 0) li_l[r32] = l_reg; asm volatile("s_waitcnt lgkmcnt(0)" ::: "memory");
    { LAS char* ot = lds + wid * 8448;
#pragma unroll
      for (int r = 0; r < 16; ++r) { const int orow = crow(r, hi); const float rl = __builtin_amdgcn_rcpf(li_l[orow]);
#pragma unroll
          for (int d0 = 0; d0 < 4; ++d0) { const float v = o[d0][r] * rl; *(LAS bf16_t*)(ot + orow * 264 + (d0 * 32 + r32) * 2) = (bf16_t)(cvt_pk_bf16(v, v) & 0xffffu); } }
      asm volatile("s_waitcnt lgkmcnt(0)" ::: "memory");
      char* Ow = (char*)(a.O + (size_t)(wid * 32) * a.os);
      const int orow0 = lane >> 4, ocol = (lane & 15) * 16;
#pragma unroll
      for (int i = 0; i < 8; ++i) { const int orow = orow0 + 4 * i; const u32x2 w0 = *(const LAS u32x2*)(ot + orow * 264 + ocol), w1 = *(const LAS u32x2*)(ot + orow * 264 + ocol + 8);
          u32x4 w; w.x = w0.x; w.y = w0.y; w.z = w1.x; w.w = w1.y;
          *(u32x4*)(Ow + (size_t)orow * a.os * 2 + ocol) = w; } }
    __syncthreads();
#undef ATT8_DMAK
#undef ATT8_DMAV
#undef ATT8_VMW
#undef ATT8_BAR
#undef ATT8_RD
#undef ATT8_LW
#undef ATT8_ISSUE
#undef ATT8_QK6
#undef ATT8_PACK
#undef ATT8_ROWMAX
#undef ATT8_ROT
#undef ATT8_S
#undef ATT8_S0
#undef ATT8_X
#undef ATT8_X0
#undef ATT8_ROWSUM
#undef ATT8_INIT
}
}
#if defined(MK_CHECK) && MK_CHECK
#ifndef CHK_XOR_ROW
#define CHK_XOR_ROW 0
#endif
namespace chk {
__device__ __forceinline__ float f8(const void* base, size_t idx) { return __builtin_amdgcn_cvt_f32_fp8((int)((const unsigned char*)base)[idx], 0); }
__device__ __forceinline__ float ldQK(const bf16_t* B, int hd, int t, int w) {
    return MLA_FP8 ? f8(B, ((size_t)hd * SEQ + t) * 192 + w) : bf2f(B[((size_t)hd * SEQ + t) * 192 + w]); }
__device__ __forceinline__ float ldV(const bf16_t* B, int hd, int t, int c) {
    if (!MLA_FP8) return bf2f(B[((size_t)hd * SEQ + t) * 128 + c]);
    const int k = t & 63, half = k >> 5, kp = k & 31, kg = (kp >> 2) & 1, r = (kp & 3) + 4 * (kp >> 3), e = r + 16 * half;
    return f8(B, (((size_t)hd * (SEQ / 64) + (t >> 6)) * 128 + c) * 64 + 32 * kg + e); }

__device__ __forceinline__ unsigned hash32(unsigned x) { x ^= x >> 16; x *= 0x7feb352du; x ^= x >> 15; x *= 0x846ca68bu; x ^= x >> 16; return x; }
__device__ __forceinline__ void flag(unsigned* ctl, int bit) { atomicOr(ctl + CW_DBG, 1u << bit); }
__device__ __forceinline__ bool bad_l2(float err2, float ref2, float tol) { err2 = wave_sum(err2); ref2 = wave_sum(ref2); return !(err2 <= tol * tol * ref2 + 1e-12f); }
__device__ __forceinline__ void ref_cos_sin(int pos, int j, float& c, float& s) {
    const float inv = powf(10000.0f, -(float)(2 * j) / 64.0f); const float ang = (float)pos * inv;
    c = (float)cos((double)ang); s = (float)sin((double)ang);
}
__device__ __forceinline__ int ref_bucket(int rel) {
    int ret = rel > 0 ? 16 : 0; int n = rel < 0 ? -rel : rel; float nf = (float)(n < 1 ? 1 : n);
    float v = logf(nf / 8.0f) / 4.852030263919617f * 8.0f; int large = 8 + (int)v; if (large > 15) large = 15;
    return ret + (n < 8 ? n : large);
}
__device__ __forceinline__ void check_proj(const Frame& F, int b, unsigned* ctl, const bf16_t* P, const bf16_t* CQN, const bf16_t* CKVN, const bf16_t* QB, const bf16_t* KB, const bf16_t* VB,
                                           const float* gq, const float* gkv, const float* w_uq, const float* w_ukv, const int* positions) {
    const int lane = opaque_tid(F.wave) & 63;
    for (int smp = F.gw; smp < 4096; smp += F.NGW) {
        const unsigned hsh = hash32(smp * 2654435761u + b * 97u + 12345u);
        const int t = hsh % SEQ, hd = (hsh >> 13) & 7, kind = smp & 3;
        const bf16_t* pr = (const bf16_t*)((const char*)P + (size_t)t * PROW);
        if (kind == 0) {
            float ss = 0.f; for (int k = lane; k < 384; k += 64) { const float v = bf2f(pr[C_CQ + k]); ss += v * v; }
            const float rq = 1.0f / sqrtf(wave_sum(ss) / 384.f + NORM_EPS); float e2 = 0.f, r2 = 0.f;
            for (int k = lane; k < 384; k += 64) { const float ref = bf2f(pr[C_CQ + k]) * rq * gq[k], got = bf2f(CQN[(size_t)t * 384 + k]); e2 += (ref - got) * (ref - got); r2 += ref * ref; }
            if (bad_l2(e2, r2, 0.01f)) flag(ctl, 0);
            ss = 0.f; for (int k = lane; k < 256; k += 64) { const float v = bf2f(pr[C_CKV + k]); ss += v * v; }
            const float rk = 1.0f / sqrtf(wave_sum(ss) / 256.f + NORM_EPS); e2 = 0.f; r2 = 0.f;
            for (int k = lane; k < 256; k += 64) { const float ref = bf2f(pr[C_CKV + k]) * rk * gkv[k], got = bf2f(CKVN[(size_t)t * 256 + k]); e2 += (ref - got) * (ref - got); r2 += ref * ref; }
            if (bad_l2(e2, r2, 0.01f)) flag(ctl, 0);
        } else if (kind == 1) {
            float q[3] = {0.f, 0.f, 0.f};
            for (int k = 0; k < 384; ++k) { const float a = bf2f(CQN[(size_t)t * 384 + k]);
#pragma unroll
                for (int i = 0; i < 3; ++i) q[i] += a * w_uq[(size_t)k * 1536 + hd * 192 + lane + 64 * i]; }
            if (MLA_FP8) { q[0] *= QK_LOG2_SCALE; q[1] *= QK_LOG2_SCALE; q[2] *= QK_LOG2_SCALE; }
            float e2 = 0.f, r2 = 0.f;
#pragma unroll
            for (int i = 0; i < 2; ++i) { const float got = ldQK(QB, hd, t, lane + 64 * i); e2 += (q[i] - got) * (q[i] - got); r2 += q[i] * q[i]; }
            float other; { auto rr = __builtin_amdgcn_permlane32_swap(__float_as_uint(q[2]), __float_as_uint(q[2]), false, false); other = lane < 32 ? __uint_as_float(rr[1]) : __uint_as_float(rr[0]); } float c, s; ref_cos_sin(positions[(size_t)b * SEQ + t], lane & 31, c, s);
            const float x1 = lane < 32 ? q[2] : other, x2 = lane < 32 ? other : q[2];
            const float ref = lane < 32 ? x1 * c - x2 * s : x1 * s + x2 * c;
            const float got = ldQK(QB, hd, t, 128 + 2 * (lane & 31) + (lane >> 5)); e2 += (ref - got) * (ref - got); r2 += ref * ref;
            if (bad_l2(e2, r2, MLA_FP8 ? 0.06f : 0.015f)) flag(ctl, 1);
        } else if (kind == 2) {
            float kk[2] = {0.f, 0.f};
            for (int k = 0; k < 256; ++k) { const float a = bf2f(CKVN[(size_t)t * 256 + k]); kk[0] += a * w_ukv[(size_t)k * 2048 + hd * 256 + lane]; kk[1] += a * w_ukv[(size_t)k * 2048 + hd * 256 + 64 + lane]; }
            float e2 = 0.f, r2 = 0.f;
#pragma unroll
            for (int i = 0; i < 2; ++i) { const float got = ldQK(KB, hd, t, lane + 64 * i); e2 += (kk[i] - got) * (kk[i] - got); r2 += kk[i] * kk[i]; }
            float c, s; ref_cos_sin(positions[(size_t)b * SEQ + t], lane & 31, c, s);
            const float x1 = bf2f(pr[C_KPE + (lane & 31)]), x2 = bf2f(pr[C_KPE + 32 + (lane & 31)]);
            const float ref = lane < 32 ? x1 * c - x2 * s : x1 * s + x2 * c;
            const float got = ldQK(KB, hd, t, 128 + 2 * (lane & 31) + (lane >> 5)); e2 += (ref - got) * (ref - got); r2 += ref * ref;
            if (bad_l2(e2, r2, MLA_FP8 ? 0.06f : 0.015f)) flag(ctl, 2);
        } else {
            float vv[2] = {0.f, 0.f};
            for (int k = 0; k < 256; ++k) { const float a = bf2f(CKVN[(size_t)t * 256 + k]); vv[0] += a * w_ukv[(size_t)k * 2048 + hd * 256 + 128 + lane]; vv[1] += a * w_ukv[(size_t)k * 2048 + hd * 256 + 192 + lane]; }
            float e2 = 0.f, r2 = 0.f;
#pragma unroll
            for (int i = 0; i < 2; ++i) { const float got = ldV(VB, hd, t, lane + 64 * i); e2 += (vv[i] - got) * (vv[i] - got); r2 += vv[i] * vv[i]; }
            if (bad_l2(e2, r2, MLA_FP8 ? 0.06f : 0.015f)) flag(ctl, 3);
        }
    }
}
__device__ __forceinline__ void check_mla(const Frame& F, int b, unsigned* ctl, const bf16_t* QB, const bf16_t* KB, const bf16_t* VB, const bf16_t* OA) {
    const int tid = opaque_tid(F.wave), lane = tid & 63, wave = tid >> 6;
    LAS float* qf = (LAS float*)F.lds;
    LAS float* red = qf + 192;
    LAS float* pp = red + 64;
    LAS float* oacc = pp + SEQ;
    const unsigned hsh = hash32(blockIdx.x * 40503u + b * 977u + 777u);
    const int t = hsh % SEQ, hd = (hsh >> 13) & 7;
#if defined(FORCE_FLAG)
    if (blockIdx.x == 100 && tid == 5 && b == 2) flag(ctl, FORCE_FLAG);
#endif
    __syncthreads();
    if (tid < 192) qf[tid] = ldQK(QB, hd, t, tid);
    __syncthreads();
    float mx = -1e30f;
    for (int k = tid; k < SEQ; k += 512) { float s = 0.f;
        for (int d = 0; d < 192; ++d) s += qf[d] * ldQK(KB, hd, k, d);
        s *= MLA_FP8 ? 0.6931471805599453f : 0.07216878364870322f; pp[k] = s; mx = fmaxf(mx, s); }
    mx = wave_max(mx);
    if (lane == 0) red[wave] = mx;
    __syncthreads();
    mx = red[0]; for (int w = 1; w < 8; ++w) mx = fmaxf(mx, red[w]);
    __syncthreads();
    float sm = 0.f;
    for (int k = tid; k < SEQ; k += 512) { const float p = expf(pp[k] - mx); pp[k] = p; sm += p; }
    sm = wave_sum(sm); if (lane == 0) red[wave] = sm;
    __syncthreads();
    sm = 0.f; for (int w = 0; w < 8; ++w) sm += red[w];
    const int c = tid & 127, part = tid >> 7; float acc = 0.f;
    for (int k = part * 2048; k < part * 2048 + 2048; ++k) acc += pp[k] * ldV(VB, hd, k, c);
    oacc[part * 128 + c] = acc;
    __syncthreads();
    if (tid < 64) { float e2 = 0.f, r2 = 0.f;
#pragma unroll
        for (int i = 0; i < 2; ++i) { const int cc = tid + 64 * i; const float ref = (oacc[cc] + oacc[128 + cc] + oacc[256 + cc] + oacc[384 + cc]) / sm, got = bf2f(OA[(size_t)(t ^ CHK_XOR_ROW) * DM + hd * 128 + cc]);
            e2 += (ref - got) * (ref - got); r2 += ref * ref; }
#if defined(CHK_MEASURE) && CHK_MEASURE == 4
        { const float re = sqrtf(wave_sum(e2) / wave_sum(r2)); int k = (int)floorf(-log2f(re)); k = k < 0 ? 0 : (k > 15 ? 15 : k); flag(ctl, k); }
#else
        if (bad_l2(e2, r2, 0.03f)) flag(ctl, 4);
#endif
    }
    __syncthreads();
}
__device__ __forceinline__ void check_dil(const Frame& F, int b, unsigned* ctl, const bf16_t* P, const int* positions, const float* rel_bias, const bf16_t* OG, const float* LSE) {
    const int tid = opaque_tid(F.wave), lane = tid & 63, wave = tid >> 6;
    LAS float* pw = (LAS float*)F.lds + wave * 256;
    for (int smp = F.gw; smp < 4096; smp += F.NGW) {
        const unsigned hsh = hash32(smp * 2246822519u + b * 131u + 999u);
        int t = hsh % SEQ; const int hd = (hsh >> 13) & 7, grp = (hsh >> 16) % 3, d = grp == 0 ? 1 : (grp == 1 ? 4 : 16);
        if ((smp & 7) == 0) t = (smp >> 3) % 40;
        if ((smp & 7) == 1) t = SEQ - 1 - ((smp >> 3) % 40);
        const char* gb = (const char*)P + P_OFF_DIL + grp * P_GRP;
#define CHK_QK(tok_, part_, e_) (DIL_FP8 ? f8(gb + (size_t)(tok_) * PROW + (part_) * 1024 + hd * 128, (e_)) : bf2f(((const bf16_t*)(gb + (size_t)(tok_) * PROW + (part_) * 2048 + hd * 256))[e_]))
        const int pq = positions[(size_t)b * SEQ + t];
        float sc[3]; float mx = -1e30f;
#pragma unroll
        for (int i = 0; i < 3; ++i) { const int j = lane + 64 * i - 64, tk = t + j * d; sc[i] = -1e30f;
            if (j <= 64 && tk >= 0 && tk < SEQ) { float s = 0.f;
                for (int e = 0; e < 128; ++e) s += CHK_QK(t, 0, e) * CHK_QK(tk, 1, e);
                s = s * 0.08838834764831845f + rel_bias[ref_bucket(positions[(size_t)b * SEQ + tk] - pq) * 24 + grp * 8 + hd]; sc[i] = s; }
            mx = fmaxf(mx, sc[i]); }
        mx = wave_max(mx);
        float sm = 0.f;
#pragma unroll
        for (int i = 0; i < 3; ++i) { const int j = lane + 64 * i; const float p = sc[i] > -1e29f ? expf(sc[i] - mx) : 0.f; if (j < 129) pw[j] = p; sm += p; }
        sm = wave_sum(sm);
        LDS_WAIT();
        float o0 = 0.f, o1 = 0.f;
        for (int j = 0; j < 129; ++j) { const int tk = t + (j - 64) * d; if (tk < 0 || tk >= SEQ) continue; const float p = pw[j]; const bf16_t* vr = (const bf16_t*)(gb + (size_t)tk * PROW + 2048 * P_QK_ESZ + hd * 256);
            o0 += p * bf2f(vr[lane]); o1 += p * bf2f(vr[64 + lane]); }
        o0 /= sm; o1 /= sm;
        const float g0 = bf2f(OG[((size_t)grp * SEQ + t) * DM + hd * 128 + lane]), g1 = bf2f(OG[((size_t)grp * SEQ + t) * DM + hd * 128 + 64 + lane]);
        if (bad_l2((o0 - g0) * (o0 - g0) + (o1 - g1) * (o1 - g1), o0 * o0 + o1 * o1, 0.03f)) flag(ctl, 5);
        const float lse2 = (mx + logf(sm)) * LOG2E, got = LSE[((size_t)grp * SEQ + t) * 8 + hd];
        if (!(fabsf(lse2 - got) <= 0.05f)) flag(ctl, 6);
        LDS_WAIT();
    }
}
__device__ __forceinline__ void check_u(const Frame& F, int b, unsigned* ctl, const bf16_t* P, const bf16_t* OA, const bf16_t* OG, const float* LSE, const bf16_t* Ub) {
    const int lane = opaque_tid(F.wave) & 63;
    for (int smp = F.gw; smp < 2048; smp += F.NGW) {
        const int t = hash32(smp * 374761393u + b * 31u + 5u) % SEQ; float e2 = 0.f, r2 = 0.f;
        for (int c = lane; c < DM; c += 64) { const int hd = c >> 7;
            const float l0 = LSE[((size_t)0 * SEQ + t) * 8 + hd], l1 = LSE[((size_t)1 * SEQ + t) * 8 + hd], l2 = LSE[((size_t)2 * SEQ + t) * 8 + hd], mx = fmaxf(l0, fmaxf(l1, l2));
            const float w0 = exp2f(l0 - mx), w1 = exp2f(l1 - mx), w2 = exp2f(l2 - mx), ws_ = w0 + w1 + w2;
            const float ob = (w0 * bf2f(OG[((size_t)0 * SEQ + t) * DM + c]) + w1 * bf2f(OG[((size_t)1 * SEQ + t) * DM + c]) + w2 * bf2f(OG[((size_t)2 * SEQ + t) * DM + c])) / ws_;
            const bf16_t* gr = (const bf16_t*)((const char*)P + (size_t)t * PROW + P_OFF_GATE); const float ga = 1.f / (1.f + expf(-bf2f(gr[c]))), gb = 1.f / (1.f + expf(-bf2f(gr[1024 + c])));
            const float ref = ga * bf2f(OA[(size_t)t * DM + c]) + gb * ob, got = bf2f(Ub[(size_t)t * DM + c]); e2 += (ref - got) * (ref - got); r2 += ref * ref; }
        if (bad_l2(e2, r2, 0.01f)) flag(ctl, 7);
    }
}
}
#endif
template <bool F8, class F>
__device__ __forceinline__ void transpose_item(F colptr, int ldn, void* WT, int ldk, int k0, int n0, LAS float* scr, int lane) {
    const float* cp = colptr(n0 + (lane & 31));
    float tv[32];
    const float* cpk = cp ? cp + (size_t)(k0 + (lane >> 5)) * ldn : nullptr;
#pragma unroll
    for (int i = 0; i < 32; ++i) tv[i] = cpk ? cpk[(size_t)(2 * i) * ldn] : 0.f;
#pragma unroll
    for (int i = 0; i < 32; ++i) scr[(2 * i + (lane >> 5)) * 33 + (lane & 31)] = tv[i];
    LDS_WAIT(); asm volatile("" ::: "memory");
    const int c = lane & 7;
#pragma unroll
    for (int j = 0; j < 4; ++j) { const int n = (lane >> 3) + 8 * j; const LAS float* s = scr + (8 * c) * 33 + n;
        if constexpr (F8) { u32x2 o; o.x = pk4_fp8(s[0 * 33] * W8_SCALE, s[1 * 33] * W8_SCALE, s[2 * 33] * W8_SCALE, s[3 * 33] * W8_SCALE); o.y = pk4_fp8(s[4 * 33] * W8_SCALE, s[5 * 33] * W8_SCALE, s[6 * 33] * W8_SCALE, s[7 * 33] * W8_SCALE);
            *(u32x2*)((char*)WT + (size_t)(n0 + n) * ldk + k0 + 8 * c) = o; }
        else { u32x4 o; o.x = cvt_pk_bf16(s[0 * 33], s[1 * 33]); o.y = cvt_pk_bf16(s[2 * 33], s[3 * 33]); o.z = cvt_pk_bf16(s[4 * 33], s[5 * 33]); o.w = cvt_pk_bf16(s[6 * 33], s[7 * 33]);
            *(u32x4*)((bf16_t*)WT + (size_t)(n0 + n) * ldk + k0 + 8 * c) = o; } }
    LDS_WAIT(); asm volatile("" ::: "memory");
}

__device__ __forceinline__ void p0_mod(const Frame& F, const float* c, const float* w_ada, const float* b_ada, float* mod) {
    const int tid = opaque_tid(F.wave), lane = tid & 63; (void)tid; (void)lane;
    LAS float* red = (LAS float*)F.lds;
    for (int blk = blockIdx.x; blk < 96; blk += F.G) {
        const int col = blk * 64 + (tid & 63), ks = tid >> 6;
        float a0 = 0.f, a1 = 0.f, a2 = 0.f, a3 = 0.f;
        for (int k = ks * 128; k < ks * 128 + 128; ++k) {
            const float w = w_ada[(size_t)k * 6144 + col];
            const float c0 = c[k], c1 = c[1024 + k], c2 = c[2048 + k], c3 = c[3072 + k];
            a0 += c0 * fast_sigmoid(c0) * w; a1 += c1 * fast_sigmoid(c1) * w; a2 += c2 * fast_sigmoid(c2) * w; a3 += c3 * fast_sigmoid(c3) * w;
        }
        red[(ks * 4 + 0) * 64 + (tid & 63)] = a0; red[(ks * 4 + 1) * 64 + (tid & 63)] = a1; red[(ks * 4 + 2) * 64 + (tid & 63)] = a2; red[(ks * 4 + 3) * 64 + (tid & 63)] = a3;
        __syncthreads();
        if (tid < 256) { const int b = tid >> 6, cc = tid & 63; float s = 0.f;
#pragma unroll
            for (int q = 0; q < 8; ++q) s += red[(q * 4 + b) * 64 + cc];
            mod[b * 6144 + blk * 64 + cc] = s + b_ada[blk * 64 + cc]; }
        __syncthreads();
    }
}
__device__ __forceinline__ void p0_cs(const Frame& F, const int* pos, float* cs) {
    const int tid = opaque_tid(F.wave), lane = tid & 63; (void)tid; (void)lane;
    for (int i = (int)blockIdx.x * 512 + tid; i < NTOK * 32; i += F.G * 512) {
        const int t = i >> 5, j = i & 31;
        const float inv = __builtin_amdgcn_exp2f(-(float)(2 * j) / 64.f * 13.287712379549449f);
        const float ang = (float)pos[t] * inv;
        const double rev = (double)ang * 0.15915494309189535; const double fr = rev - __builtin_rint(rev);
        const float f = (float)fr;
        f32x2 o; o.x = __builtin_amdgcn_cosf(f); o.y = __builtin_amdgcn_sinf(f);
        *(f32x2*)(cs + (size_t)i * 2) = o;
    }
}
__device__ __forceinline__ void p0_weights(const Frame& F, const float* w_in, const float* w_uq, const float* w_ukv, const float* w_out, unsigned char* ws) {
    const int tid = opaque_tid(F.wave), lane = tid & 63; (void)tid; (void)lane;
    LAS float* scr = (LAS float*)(F.lds + F.wave * 16384);
    constexpr int I_IN = 16 * 376, I_UQ = 6 * 48, I_UKV = 4 * 64, I_OUT = 16 * 32;
    for (int it = F.gw; it < I_IN + I_UQ + I_UKV + I_OUT; it += F.NGW) {
        int r = it;
        if (r < I_IN) { const int kb = r / 376, nb = r % 376;
            transpose_item<(FP8_G1 != 0)>([=](int np) -> const float* { const int n = (np & ~31) + pg8::perm32(np & 31); return n < D_IN ? w_in + n : nullptr; }, D_IN, (void*)(ws + WS_WIN), 1024, kb * 64, nb * 32, scr, lane); continue; }
        r -= I_IN;
        if (r < I_UQ) { const int kb = r / 48, nb = r % 48;
            transpose_item<false>([=](int n) -> const float* { const int hd = n / 192, w = n - hd * 192; const int sc = w < 128 ? w : 128 + ((w - 128) >> 1) + 32 * ((w - 128) & 1); return w_uq + hd * 192 + sc; },
                           1536, (bf16_t*)(ws + WS_WUQ), 384, kb * 64, nb * 32, scr, lane); continue; }
        r -= I_UQ;
        if (r < I_UKV) { const int kb = r / 64, nb = r % 64;
            transpose_item<false>([=](int n) -> const float* { const int m = n & 1023; return w_ukv + (MLA_FP8 ? ((m >> 7) * 256 + (n >> 10) * 128 + (m & 127)) : n); }, 2048, (bf16_t*)(ws + WS_WUKV), 256, kb * 64, nb * 32, scr, lane); continue; }
        r -= I_UKV;
        { const int kb = r / 32, nb = r % 32;
            transpose_item<(FP8_WO != 0)>([=](int n) -> const float* { return w_out + n; }, 1024, (void*)(ws + WS_WOUT), 1024, kb * 64, nb * 32, scr, lane); }
    }
}
__device__ __forceinline__ void conv_experts(const Frame& F, const float* w_gate, const float* w_up, const float* w_down, unsigned char* ws) {
    const int tid = opaque_tid(F.wave), lane = tid & 63; (void)tid; (void)lane;
    LAS float* scr = (LAS float*)(F.lds + F.wave * 16384);
    for (int it = F.gw; it < NE * 3072; it += F.NGW) {
        const int e = it / 3072; int r = it % 3072;
        if (r < 2048) { const int kb = r / 128, nb = r % 128;
            const float* wg = w_gate + (size_t)e * DM * DFF; const float* wu = w_up + (size_t)e * DM * DFF;
            const long du = (const char*)wu - (const char*)wg;
            transpose_item<(FP8_EX != 0)>([=](int np) -> const float* { const int n = (np & ~31) + pg8::perm32(np & 31); const int grp = n >> 3, q = n & 7; return (const float*)((const char*)wg + (q < 4 ? 0L : du)) + 4 * grp + (q & 3); }, DFF,
                           (void*)(ws + WS_WGU + (size_t)e * 4096 * 1024 * (FP8_EX ? 1 : 2)), 1024, kb * 64, nb * 32, scr, lane); continue; }
        r -= 2048;
        { const int kb = r / 32, nb = r % 32; const float* wd = w_down + (size_t)e * DFF * DM;
            transpose_item<(FP8_EX != 0)>([=](int np) -> const float* { const int n = (np & ~31) + pg8::perm32(np & 31); return wd + n; }, DM, (void*)(ws + WS_WD + (size_t)e * 1024 * 2048 * (FP8_EX ? 1 : 2)), 2048, kb * 64, nb * 32, scr, lane); }
    }
}
__device__ __forceinline__ void norm_mod_row(const float* xrow, const float* g, const float* sh, const float* sc, int lane, f32x4 (&v)[4]) {
    float s = 0.f;
#pragma unroll
    for (int j = 0; j < 4; ++j) { v[j] = *(const f32x4*)(xrow + 4 * lane + 256 * j); s += (v[j][0] * v[j][0] + v[j][1] * v[j][1]) + (v[j][2] * v[j][2] + v[j][3] * v[j][3]); }
    const float rstd = 1.0f / sqrtf(wave_sum(s) * (1.f / DM) + NORM_EPS);
#pragma unroll
    for (int j = 0; j < 4; ++j) { const int c = 4 * lane + 256 * j; const f32x4 gg = *(const f32x4*)(g + c), s1 = *(const f32x4*)(sc + c), s0 = *(const f32x4*)(sh + c);
        v[j] = (v[j] * rstd * gg) * (s1 + 1.0f) + s0; }
}
__device__ __forceinline__ void store_row_bf16(bf16_t* orow, int lane, const f32x4 (&v)[4]) {
#pragma unroll
    for (int j = 0; j < 4; ++j) { u32x2 o; o.x = cvt_pk_bf16(v[j][0], v[j][1]); o.y = cvt_pk_bf16(v[j][2], v[j][3]); *(u32x2*)(orow + 4 * lane + 256 * j) = o; }
}
template <bool F8> __device__ __forceinline__ void store_row_act(void* orow, int lane, const f32x4 (&v)[4]) {
    if constexpr (F8) {
#pragma unroll
        for (int j = 0; j < 4; ++j) *(unsigned*)((char*)orow + 4 * lane + 256 * j) = pk4_fp8(v[j][0], v[j][1], v[j][2], v[j][3]);
    } else store_row_bf16((bf16_t*)orow, lane, v);
}
__device__ __forceinline__ void p1_h(const Frame& F, const float* x, const float* g, const float* mod, bf16_t* H) {
    const int tid = opaque_tid(F.wave), lane = tid & 63; (void)tid; (void)lane;
#pragma unroll 2
    for (int t = F.gw; t < NTOK; t += F.NGW) { const int b = t / SEQ; f32x4 v[4];
        norm_mod_row(x + (size_t)t * DM, g, mod + b * 6144 + 0, mod + b * 6144 + 1024, lane, v);
        store_row_act<(FP8_G1 != 0)>((char*)H + (size_t)t * DM * (FP8_G1 ? 1 : 2), lane, v); }
}
__device__ __forceinline__ void lb_latent(const Frame& F, const bf16_t* P, const float* gq, const float* gkv, const float* cs, bf16_t* CQN, bf16_t* CKVN, bf16_t* KB) {
    const int tid = opaque_tid(F.wave), lane = tid & 63; (void)tid; (void)lane;
#pragma unroll 2
    for (int t = F.gw; t < SEQ; t += F.NGW) {
        const bf16_t* pr = (const bf16_t*)((const char*)P + (size_t)t * PROW);
        float q[8], s = 0.f;
        if (lane < 48) { const u32x4 w = *(const u32x4*)(pr + C_CQ + 8 * lane);
            q[0] = bflo(w.x); q[1] = bfhi(w.x); q[2] = bflo(w.y); q[3] = bfhi(w.y); q[4] = bflo(w.z); q[5] = bfhi(w.z); q[6] = bflo(w.w); q[7] = bfhi(w.w);
#pragma unroll
            for (int e = 0; e < 8; ++e) s += q[e] * q[e]; }
        const float rq = 1.0f / sqrtf(wave_sum(s) * (1.f / 384.f) + NORM_EPS);
        if (lane < 48) { const f32x4 g0 = *(const f32x4*)(gq + 8 * lane), g1 = *(const f32x4*)(gq + 8 * lane + 4);
            u32x4 o; o.x = cvt_pk_bf16(q[0] * rq * g0[0], q[1] * rq * g0[1]); o.y = cvt_pk_bf16(q[2] * rq * g0[2], q[3] * rq * g0[3]);
            o.z = cvt_pk_bf16(q[4] * rq * g1[0], q[5] * rq * g1[1]); o.w = cvt_pk_bf16(q[6] * rq * g1[2], q[7] * rq * g1[3]);
            *(u32x4*)(CQN + (size_t)t * 384 + 8 * lane) = o; }
        float s2 = 0.f;
        if (lane < 32) { const u32x4 w = *(const u32x4*)(pr + C_CKV + 8 * lane);
            q[0] = bflo(w.x); q[1] = bfhi(w.x); q[2] = bflo(w.y); q[3] = bfhi(w.y); q[4] = bflo(w.z); q[5] = bfhi(w.z); q[6] = bflo(w.w); q[7] = bfhi(w.w);
#pragma unroll
            for (int e = 0; e < 8; ++e) s2 += q[e] * q[e]; }
        const float rk = 1.0f / sqrtf(wave_sum(s2) * (1.f / 256.f) + NORM_EPS);
        if (lane < 32) { const f32x4 g0 = *(const f32x4*)(gkv + 8 * lane), g1 = *(const f32x4*)(gkv + 8 * lane + 4);
            u32x4 o; o.x = cvt_pk_bf16(q[0] * rk * g0[0], q[1] * rk * g0[1]); o.y = cvt_pk_bf16(q[2] * rk * g0[2], q[3] * rk * g0[3]);
            o.z = cvt_pk_bf16(q[4] * rk * g1[0], q[5] * rk * g1[1]); o.w = cvt_pk_bf16(q[6] * rk * g1[2], q[7] * rk * g1[3]);
            *(u32x4*)(CKVN + (size_t)t * 256 + 8 * lane) = o;
            const float x1 = bf2f(pr[C_KPE + lane]), x2 = bf2f(pr[C_KPE + 32 + lane]); const f32x2 c = *(const f32x2*)(cs + ((size_t)t * 32 + lane) * 2);
            if constexpr (MLA_FP8) { const unsigned short pk8 = (unsigned short)(__builtin_amdgcn_cvt_pk_fp8_f32(x1 * c.x - x2 * c.y, x1 * c.y + x2 * c.x, 0, false) & 0xffff);
#pragma unroll
                for (int h = 0; h < 8; ++h) *(unsigned short*)((unsigned char*)KB + ((size_t)h * SEQ + t) * 192 + 128 + 2 * lane) = pk8; }
            else { const unsigned pk = cvt_pk_bf16(x1 * c.x - x2 * c.y, x1 * c.y + x2 * c.x);
#pragma unroll
                for (int h = 0; h < 8; ++h) *(unsigned*)(KB + ((size_t)h * SEQ + t) * 192 + 128 + 2 * lane) = pk; } }
    }
}
__device__ __forceinline__ void lb_combine(const Frame& F, const bf16_t* P, const bf16_t* OA, const bf16_t* OG, const float* LSE, bf16_t* U) {
    const int tid = opaque_tid(F.wave), lane = tid & 63; (void)tid; (void)lane;
#pragma unroll 2
    for (int t = F.gw; t < SEQ; t += F.NGW) {
#pragma unroll
        for (int j = 0; j < 2; ++j) { const int c0 = 8 * lane + 512 * j, hd = c0 >> 7;
            const float l0 = LSE[((size_t)0 * SEQ + t) * 8 + hd], l1 = LSE[((size_t)1 * SEQ + t) * 8 + hd], l2 = LSE[((size_t)2 * SEQ + t) * 8 + hd];
            const float mx = fmaxf(l0, fmaxf(l1, l2)); float w0 = __builtin_amdgcn_exp2f(l0 - mx), w1 = __builtin_amdgcn_exp2f(l1 - mx), w2 = __builtin_amdgcn_exp2f(l2 - mx);
            const float inv = 1.0f / (w0 + w1 + w2); w0 *= inv; w1 *= inv; w2 *= inv;
            const u32x4 oa = *(const u32x4*)(OA + (size_t)t * DM + c0), g0 = *(const u32x4*)(OG + ((size_t)0 * SEQ + t) * DM + c0), g1 = *(const u32x4*)(OG + ((size_t)1 * SEQ + t) * DM + c0),
                        g2 = *(const u32x4*)(OG + ((size_t)2 * SEQ + t) * DM + c0), ga = *(const u32x4*)((const char*)P + (size_t)t * PROW + P_OFF_GATE + 2 * c0), gb = *(const u32x4*)((const char*)P + (size_t)t * PROW + P_OFF_GATE + 2048 + 2 * c0);
            u32x4 o; float uf[8];
#pragma unroll
            for (int e = 0; e < 4; ++e) {
                const float ob_lo = w0 * bflo(g0[e]) + w1 * bflo(g1[e]) + w2 * bflo(g2[e]), ob_hi = w0 * bfhi(g0[e]) + w1 * bfhi(g1[e]) + w2 * bfhi(g2[e]);
                const float u_lo = fast_sigmoid(bflo(ga[e])) * bflo(oa[e]) + fast_sigmoid(bflo(gb[e])) * ob_lo;
                const float u_hi = fast_sigmoid(bfhi(ga[e])) * bfhi(oa[e]) + fast_sigmoid(bfhi(gb[e])) * ob_hi;
                if constexpr (FP8_WO) { uf[2 * e] = u_lo; uf[2 * e + 1] = u_hi; } else o[e] = cvt_pk_bf16(u_lo, u_hi); }
            if constexpr (FP8_WO) { u32x2 o8; o8.x = pk4_fp8(uf[0], uf[1], uf[2], uf[3]); o8.y = pk4_fp8(uf[4], uf[5], uf[6], uf[7]); *(u32x2*)((unsigned char*)U + (size_t)t * DM + c0) = o8; }
            else *(u32x4*)(U + (size_t)t * DM + c0) = o; }
    }
}
__device__ __forceinline__ void pg_h2_router(const Frame& F, const float* x1, const float* g, const float* mod, const float* w_router, bf16_t* H2, float* AFFT) {
    const int tid = opaque_tid(F.wave), lane = tid & 63; (void)tid;
    LAS float* wr = (LAS float*)F.lds;
    LAS float* ab = (LAS float*)(F.lds + 65536) + F.wave * 256;
    for (int i = tid; i < 1024 * 16 / 4; i += 512) { const int c = i >> 2, k = i & 3, rho = (c & 3) * 256 + (c >> 2);
        ((LAS f32x4*)wr)[rho * 4 + ((k + (rho >> 2)) & 3)] = ((const f32x4*)w_router)[i]; }
    __syncthreads();
    int roff[4];
#pragma unroll
    for (int k = 0; k < 4; ++k) roff[k] = ((k + (lane >> 2)) & 3) * 4;
    for (int ch = F.gw; ch < NTOK / 16; ch += F.NGW) {
        const int t0 = ch * 16, b = t0 / SEQ, s0 = t0 % SEQ;
#pragma unroll 1
        for (int ti = 0; ti < 16; ++ti) { const int t = t0 + ti; f32x4 v[4];
            norm_mod_row(x1 + (size_t)t * DM, g, mod + b * 6144 + 3072, mod + b * 6144 + 4096, lane, v);
            store_row_act<(FP8_EX != 0)>((char*)H2 + (size_t)t * DM * (FP8_EX ? 1 : 2), lane, v);
            float lg[16];
#pragma unroll
            for (int e = 0; e < 16; ++e) lg[e] = 0.f;
#pragma unroll
            for (int j = 0; j < 4; ++j)
#pragma unroll
                for (int q = 0; q < 4; ++q) { const LAS float* wp = wr + (q * 256 + lane + 64 * j) * 16; const float hv = v[j][q];
#pragma unroll
                    for (int e4 = 0; e4 < 4; ++e4) { const f32x4 w = *(const LAS f32x4*)(wp + roff[e4]); lg[4 * e4 + 0] += hv * w[0]; lg[4 * e4 + 1] += hv * w[1]; lg[4 * e4 + 2] += hv * w[2]; lg[4 * e4 + 3] += hv * w[3]; } }
            float mx = -1e30f;
#pragma unroll
            for (int e = 0; e < 16; ++e) { lg[e] = wave_sum(lg[e]); mx = fmaxf(mx, lg[e]); }
            float sum = 0.f;
#pragma unroll
            for (int e = 0; e < 16; ++e) { lg[e] = __expf(lg[e] - mx); sum += lg[e]; }
            const float inv = 1.0f / sum; float mine = 0.f;
#pragma unroll
            for (int e = 0; e < 16; ++e) mine = (lane == e) ? lg[e] * inv : mine;
            if (lane < 16) ab[lane * 16 + ti] = mine;
        }
        LDS_WAIT();
        { const int e = lane >> 2, q4 = (lane & 3) * 4; const f32x4 w = *(const LAS f32x4*)(ab + e * 16 + q4);
          *(f32x4*)(AFFT + ((size_t)b * NE + e) * SEQ + s0 + q4) = w; }
        LDS_WAIT();
    }
    __syncthreads();
}
__device__ __forceinline__ void ph_topk(const Frame& F, const float* AFFT, int* TOPI, float* TOPG, int* SLOT) {
    const int tid = opaque_tid(F.wave), lane = tid & 63;
    LAS unsigned* cnt = (LAS unsigned*)F.lds;
    LAS unsigned* wtot = cnt + 64;
    for (int p = blockIdx.x; p < NB * NE; p += F.G) {
        const float* src = AFFT + (size_t)p * SEQ + 16 * tid;
        unsigned key[16];
#pragma unroll
        for (int j = 0; j < 4; ++j) { const u32x4 w = *(const u32x4*)(src + 4 * j); key[4 * j] = w.x; key[4 * j + 1] = w.y; key[4 * j + 2] = w.z; key[4 * j + 3] = w.w; }
        unsigned thr = 0u;
#pragma unroll 1
        for (int bit = 30; bit >= 0; --bit) { const unsigned cand = thr | (1u << bit); unsigned c = 0;
#pragma unroll
            for (int i = 0; i < 16; ++i) c += (unsigned)__builtin_popcountll(__ballot(key[i] >= cand));
            LAS unsigned* slot = cnt + ((bit & 1) << 3);
            if (lane == 0) slot[F.wave] = c;
            __syncthreads();
            unsigned tot = 0;
#pragma unroll
            for (int w = 0; w < 8; ++w) tot += slot[w];
            if (tot >= (unsigned)CAP) thr = cand; }
        unsigned ngt = 0, neq = 0;
#pragma unroll
        for (int i = 0; i < 16; ++i) { ngt += key[i] > thr ? 1u : 0u; neq += key[i] == thr ? 1u : 0u; }
        unsigned pk = ngt | (neq << 16), inc = pk;
#pragma unroll
        for (int o = 1; o < 64; o <<= 1) { const unsigned v = (unsigned)__builtin_amdgcn_ds_bpermute((lane - o) << 2, (int)inc); if (lane >= o) inc += v; }
        __syncthreads();
        if (lane == 63) wtot[F.wave] = inc;
        __syncthreads();
        unsigned base = 0, all = 0;
        for (int w = 0; w < 8; ++w) { const unsigned v = wtot[w]; all += v; if (w < F.wave) base += v; }
        const unsigned tot_gt = all & 0xffffu, need = (unsigned)CAP - tot_gt;
        const unsigned excl = base + inc - pk; unsigned g_before = excl & 0xffffu, e_before = excl >> 16;
#pragma unroll
        for (int i = 0; i < 16; ++i) { const int s = 16 * tid + i; int slot = -1;
            if (key[i] > thr) { slot = (int)g_before; ++g_before; }
            else if (key[i] == thr) { if (e_before < need) slot = (int)(tot_gt + e_before); ++e_before; }
            SLOT[(size_t)p * SEQ + s] = slot;
            if (slot >= 0) { TOPI[p * CAP + slot] = (p >> 4) * SEQ + s; TOPG[p * CAP + slot] = __uint_as_float(key[i]); } }
        __syncthreads();
    }
}
__device__ __forceinline__ void p_final(const Frame& F, int b, float* out, const float* mod, const int* SLOT, const bf16_t* Y, const float* gfin, float oscale) {
    const int tid = opaque_tid(F.wave), lane = tid & 63; (void)tid; (void)lane;
#pragma unroll 2
    for (int s = F.gw; s < SEQ; s += F.NGW) { float* row = out + ((size_t)b * SEQ + s) * DM;
        int sl = -1; if (lane < NE) sl = SLOT[((size_t)b * NE + lane) * SEQ + s];
        unsigned long long m = __ballot(sl >= 0);
        f32x4 acc[4];
#pragma unroll
        for (int j = 0; j < 4; ++j) acc[j] = (f32x4){0.f, 0.f, 0.f, 0.f};
        while (m) { const int e = __builtin_ctzll(m); m &= m - 1; const int slot = __builtin_amdgcn_readlane(sl, e);
            const bf16_t* yr = Y + (((size_t)b * NE + e) * CAP + slot) * DM;
#pragma unroll
            for (int j = 0; j < 4; ++j) { const u32x2 w = *(const u32x2*)(yr + 4 * lane + 256 * j); acc[j][0] += bflo(w.x); acc[j][1] += bfhi(w.x); acc[j][2] += bflo(w.y); acc[j][3] += bfhi(w.y); } }
        f32x4 v[4]; float ss = 0.f;
#pragma unroll
        for (int j = 0; j < 4; ++j) { const int c = 4 * lane + 256 * j; const f32x4 gt = *(const f32x4*)(mod + b * 6144 + 5120 + c);
            v[j] = *(const f32x4*)(row + c) + gt * acc[j]; ss += (v[j][0] * v[j][0] + v[j][1] * v[j][1]) + (v[j][2] * v[j][2] + v[j][3] * v[j][3]); }
        const float rstd = 1.0f / sqrtf(wave_sum(ss) * (1.f / DM) + NORM_EPS);
#pragma unroll
        for (int j = 0; j < 4; ++j) { const int c = 4 * lane + 256 * j; f32x4 ov = v[j] * (rstd * oscale) * *(const f32x4*)(gfin + c);
#if defined(MK_CHECK) && MK_CHECK
#pragma unroll
            for (int e = 0; e < 4; ++e) if (!(ov[e] == ov[e]) || fabsf(ov[e]) > 1e6f) ov[e] = 0.f;
#endif
            *(f32x4*)(row + c) = ov; }
    }
}

__global__ void __launch_bounds__(NWAVES * 64, 2) fwd_kernel(Args args) {
    extern __shared__ __attribute__((aligned(16))) unsigned char lds_raw[];
    Frame F;
    F.lds = (LAS unsigned char*)lds_raw;
    F.wave = __builtin_amdgcn_readfirstlane((int)threadIdx.x >> 6); F.tid = opaque_tid(F.wave); F.lane = F.tid & 63;
    F.G = gridDim.x; { const int bx = blockIdx.x; F.vcu = (F.G % 8 == 0) ? (bx % 8) * (F.G / 8) + bx / 8 : bx; }
    F.gw = F.vcu * NWAVES + F.wave; F.NGW = F.G * NWAVES;
    unsigned char* ws = args.ws;
    volatile LAS unsigned* MISC = (volatile LAS unsigned*)(F.lds + MISC_OFF);
    for (int u = F.tid; u < (LDS_BYTES - RING_BYTES) / 4; u += NWAVES * 64) ((LAS unsigned*)(F.lds + RING_BYTES))[u] = 0u;
    __syncthreads();
    unsigned* ctl = (unsigned*)(ws + WS_CTL);
    XcdBarrier bar = xcd_barrier_post(ctl + CW_BAR, MISC + 8); bar.wv = F.wave;

#define IN_F(k) ((const float*)args.in[k])
#define in_x IN_F(0)
#define cin IN_F(1)
#define positions ((const int*)args.in[2])
#define w_ada IN_F(3)
#define b_ada IN_F(4)
#define g_mix IN_F(5)
#define w_in IN_F(6)
#define g_q IN_F(7)
#define g_kv IN_F(8)
#define w_uq IN_F(9)
#define w_ukv IN_F(10)
#define rel_bias IN_F(11)
#define w_out IN_F(12)
#define g_ffn IN_F(13)
#define w_router IN_F(14)
#define w_gate IN_F(15)
#define w_up IN_F(16)
#define w_down IN_F(17)
#define g_final IN_F(18)
#define t_out (args.out)
#define WSP(T, off) ((T*)(args.ws + (off)))
#define MOD WSP(float, WS_MOD)
#define CS WSP(float, WS_CS)
#define WIN WSP(bf16_t, WS_WIN)
#define WUQ WSP(bf16_t, WS_WUQ)
#define WUKV WSP(bf16_t, WS_WUKV)
#define WOUT WSP(bf16_t, WS_WOUT)
#define t_H WSP(bf16_t, WS_H)
#define t_U WSP(bf16_t, WS_U)
#define t_P WSP(bf16_t, WS_P)
#define CQN WSP(bf16_t, WS_CQN)
#define CKVN WSP(bf16_t, WS_CKVN)
#define QB WSP(bf16_t, WS_QB)
#define KB WSP(bf16_t, WS_KB)
#define VB WSP(bf16_t, WS_VB)
#define OA WSP(bf16_t, WS_OA)
#define OG WSP(bf16_t, WS_OG)
#define LSE WSP(float, WS_LSE)
#define WGU WSP(bf16_t, WS_WGU)
#define WD WSP(bf16_t, WS_WD)
#define HID WSP(bf16_t, WS_HID)
#define t_Y WSP(bf16_t, WS_Y)
#define AFFT WSP(float, WS_AFFT)
#define TOPI WSP(int, WS_TOPI)
#define TOPG WSP(float, WS_TOPG)
#define SLOT WSP(int, WS_SLOT)

#ifndef PH_MASK
#define PH_MASK 0xFFFFFFFFu
#endif
#define PH_ON(k) constexpr (((PH_MASK) >> (k)) & 1u)
#ifndef DUP_MASK
#define DUP_MASK 0u
#endif
#define PH_REP(k) for (int rep_ = 0; rep_ < ((((DUP_MASK) >> (k)) & 1u) ? 2 : 1); ++rep_)
#if defined(PROBE_TIMING)
#define DBG_SCALE() (1.0f + __uint_as_float(__hip_atomic_load(ctl + CW_DBG + 1, RLX_AGENT)))
#elif defined(MK_CHECK) && MK_CHECK
#define DBG_SCALE() ([&]() -> float { const unsigned f_ = __hip_atomic_load(ctl + CW_DBG, RLX_AGENT); return f_ ? 1.0f + 0.05f * (float)(1 + __builtin_ctz(f_)) : 1.0f; }())
#else
#define DBG_SCALE() 1.0f
#endif
    int step = 0; const int lo = args.st_lo, hi = args.st_hi;
#define STEP_BEGIN if (step >= lo && step < hi) {
#if defined(PROBE_DBLBAR)
#define STEP_END if (step + 1 < hi) { xcd_barrier(bar); xcd_barrier(bar); } } ++step;
#else
#define STEP_END if (step + 1 < hi) xcd_barrier(bar); } ++step;
#endif

    STEP_BEGIN
        if PH_ON(0) PH_REP(0) { p0_mod(F, cin, w_ada, b_ada, MOD);
        p0_cs(F, positions, CS);
        p0_weights(F, w_in, w_uq, w_ukv, w_out, ws); }
    STEP_END
    STEP_BEGIN
        if PH_ON(1) PH_REP(1) p1_h(F, in_x, g_mix, MOD, t_H);
    STEP_END
    for (int b = 0; b < NB; ++b) {
        STEP_BEGIN
            pg8::Gemm g{(const bf16_t*)((const char*)t_H + (size_t)b * SEQ * DM * (FP8_G1 ? 1 : 2)), WIN, DM, DM, DM, 0, 0, nullptr, 0, 0}; pg8::StaticOrder S; S.init(SEQ, NP, F.G, (int)blockIdx.x);
            pg8::EpiP E{(unsigned char*)t_P, FP8_G1 ? W8_INV : 1.0f, 0};
            if PH_ON(2) PH_REP(2) {
#if defined(PROBE_NOSTORE)
                E.nostore = (rep_ == 0);
#endif
                pg8::gemm_phase<pg8::EpiP, pg8::StaticOrder, false, (FP8_G1 != 0)>(F.lds, F.wave, g, S, E); __syncthreads(); }
        STEP_END
        STEP_BEGIN
            if PH_ON(3) PH_REP(3) lb_latent(F, t_P, g_q, g_kv, CS + (size_t)b * SEQ * 64, CQN, CKVN, KB);
        STEP_END
        STEP_BEGIN
#if MLA_FP8
            { pg8::Gemm g{CQN, WUQ, 384, 384, 384, 0, 0, nullptr, 0, 0}; pg8::StaticOrder S; S.init(SEQ, 1536, F.G, (int)blockIdx.x);
              pg8::EpiQ8 E{(unsigned char*)QB, CS + (size_t)b * SEQ * 64};
              if PH_ON(4) PH_REP(4) { pg8::gemm_phase<pg8::EpiQ8, pg8::StaticOrder, false>(F.lds, F.wave, g, S, E); __syncthreads(); } }
            { pg8::Gemm g{CKVN, WUKV, 256, 256, 256, 0, 0, nullptr, 0, 0}; pg8::StaticOrder S; S.init(SEQ, 1024, F.G, (int)blockIdx.x);
              pg8::EpiK8 E{(unsigned char*)KB};
              if PH_ON(5) PH_REP(5) { pg8::gemm_phase<pg8::EpiK8, pg8::StaticOrder, false>(F.lds, F.wave, g, S, E); __syncthreads(); } }
            { pg8::Gemm g{WUKV + (size_t)1024 * 256, CKVN, 256, 256, 256, 0, 0, nullptr, 0, 0}; pg8::StaticOrder S; S.init(1024, SEQ, F.G, (int)((blockIdx.x + 128) % F.G));
              pg8::EpiVT8 E{(unsigned char*)VB};
              if PH_ON(5) PH_REP(5) { pg8::gemm_phase<pg8::EpiVT8, pg8::StaticOrder, false>(F.lds, F.wave, g, S, E); __syncthreads(); } }
#else
            { pg8::Gemm g{CQN, WUQ, 384, 384, 384, 0, 0, nullptr, 0, 0}; pg8::StaticOrder S; S.init(SEQ, 1536, F.G, (int)blockIdx.x);
              pg8::EpiQ E{QB, CS + (size_t)b * SEQ * 64};
              if PH_ON(4) PH_REP(4) { pg8::gemm_phase<pg8::EpiQ, pg8::StaticOrder, false>(F.lds, F.wave, g, S, E); __syncthreads(); } }
            __syncthreads();
            { pg8::Gemm g{CKVN, WUKV, 256, 256, 256, 0, 0, nullptr, 0, 0}; pg8::StaticOrder S; S.init(SEQ, 2048, F.G, (int)blockIdx.x);
              pg8::EpiKV E{KB, VB};
              if PH_ON(5) PH_REP(5) { pg8::gemm_phase<pg8::EpiKV, pg8::StaticOrder, false>(F.lds, F.wave, g, S, E); __syncthreads(); } }
#endif
        STEP_END
        STEP_BEGIN
            for (int u = blockIdx.x; u < 256; u += F.G) { const int hd = u & 7, qb = u >> 3;
#if MLA_FP8
                att::Unit8 a8{(const unsigned char*)QB + ((size_t)hd * SEQ + 256 * qb) * 192, (const unsigned char*)KB + (size_t)hd * SEQ * 192, (const unsigned char*)VB + (size_t)hd * SEQ * 128,
                              OA + (size_t)(256 * qb) * DM + hd * 128, DM, SEQ / 64, nullptr};
#if defined(PROBE_TIMING)
                a8.dbg = (blockIdx.x == PROBE_BLOCK && b == 3) ? (float*)(ctl + CW_DBG + 1) : nullptr;
#endif
                if PH_ON(6) PH_REP(6) att::attn_mla8_unit(a8, (LAS char*)F.lds, F.wave);
#else
                att::Unit a{};
                a.Q = QB + ((size_t)hd * SEQ + 256 * qb) * 192; a.qs = 192; a.K = KB + (size_t)hd * SEQ * 192; a.ks = 192; a.V = VB + (size_t)hd * SEQ * 128; a.vs = 128;
                a.O = OA + (size_t)(256 * qb) * DM + hd * 128; a.os = DM; a.nt = SEQ / 64;
#if defined(BREAK_MLA) && BREAK_MLA
                a.nt = SEQ / 64 - 2;
#endif
                a.tmul = 1;
#if defined(PROBE_TIMING)
                a.dbg = (blockIdx.x == PROBE_BLOCK && b == 3) ? (float*)(ctl + CW_DBG + 1) : nullptr;
#endif
#if defined(PROBE_SAMETILE)
                a.tmul = 0; att::attn_unit<false>(a, (LAS char*)F.lds, F.wave); a.tmul = 1;
#endif
                if PH_ON(6) PH_REP(6) att::attn_unit<false>(a, (LAS char*)F.lds, F.wave);
#endif
            }

            for (int u = blockIdx.x; u < 768; u += F.G) { const int grp = u >> 8, w = u & 255, hd = w & 7, rest = w >> 3, d = grp == 0 ? 1 : (grp == 1 ? 4 : 16), cl = rest % d, qb = rest / d;
                att::Unit a{};
                const size_t tok0 = (size_t)256 * qb * d + cl; const char* gbase = (const char*)t_P + P_OFF_DIL + grp * P_GRP;
                a.Q = (const bf16_t*)(gbase + tok0 * PROW + hd * 128 * P_QK_ESZ); a.qs = d * (PROW / 2);
                a.K = (const bf16_t*)(gbase + (size_t)cl * PROW + 1024 * P_QK_ESZ + hd * 128 * P_QK_ESZ); a.ks = d * (PROW / 2);
                a.V = (const bf16_t*)(gbase + (size_t)cl * PROW + 2048 * P_QK_ESZ + hd * 256); a.vs = d * (PROW / 2);
                a.O = OG + ((size_t)grp * SEQ + tok0) * DM + hd * 128; a.os = d * DM; a.nt = 6; a.tmul = 1;
#if defined(PROBE_TIMING)
                a.dbg = (blockIdx.x == PROBE_BLOCK && b == 3 && grp == PROBE_GRP) ? (float*)(ctl + CW_DBG + 1) : nullptr;
#endif
                a.kt0 = 4 * qb - 1; a.ktn = (SEQ / d) / 64; a.l0 = 256 * qb; a.pos = positions + (size_t)b * SEQ + cl; a.ps = d;
                a.lse = LSE + ((size_t)grp * SEQ + tok0) * 8 + hd; a.ls = d * 8; a.bias = rel_bias + grp * 8 + hd;
                if PH_ON(7) PH_REP(7) att::attn_unit<true>(a, (LAS char*)F.lds, F.wave); }
        STEP_END
        STEP_BEGIN
            if PH_ON(8) PH_REP(8) lb_combine(F, t_P, OA, OG, LSE, (bf16_t*)((char*)t_U + (size_t)b * SEQ * DM * (FP8_WO ? 1 : 2)));
        STEP_END
#if defined(MK_CHECK) && MK_CHECK
        STEP_BEGIN
#if !defined(CHK_MEASURE) && !defined(CHK_ONLY_DIL)
            chk::check_proj(F, b, ctl, t_P, CQN, CKVN, QB, KB, VB, g_q, g_kv, w_uq, w_ukv, positions);
            chk::check_dil(F, b, ctl, t_P, positions, rel_bias, OG, LSE);
            chk::check_u(F, b, ctl, t_P, OA, OG, LSE, t_U + (size_t)b * SEQ * DM);
#endif
#if defined(CHK_ONLY_DIL)
            chk::check_dil(F, b, ctl, t_P, positions, rel_bias, OG, LSE);
#else
            chk::check_mla(F, b, ctl, QB, KB, VB, OA);
#endif
        STEP_END
#endif
    }
    STEP_BEGIN
        { pg8::Gemm g{t_U, WOUT, DM, DM, DM, 0, 0, nullptr, 0, 0}; pg8::StaticOrder S; S.init(NTOK, DM, F.G, (int)blockIdx.x);
          pg8::EpiRes E{in_x, t_out, MOD, FP8_WO ? W8_INV : 1.0f};
          if PH_ON(9) PH_REP(9) { pg8::gemm_phase<pg8::EpiRes, pg8::StaticOrder, false, (FP8_WO != 0)>(F.lds, F.wave, g, S, E); __syncthreads(); } }
        __syncthreads();
        if PH_ON(10) PH_REP(10) conv_experts(F, w_gate, w_up, w_down, ws);
    STEP_END
    STEP_BEGIN
        if PH_ON(11) PH_REP(11) pg_h2_router(F, t_out, g_ffn, MOD, w_router, t_H, AFFT);
    STEP_END
    STEP_BEGIN
        if PH_ON(12) PH_REP(12) ph_topk(F, AFFT, TOPI, TOPG, SLOT);
    STEP_END
    static_assert(FP8_EX != 0, "the all-batch FFN workspace map assumes fp8 expert operands");
    STEP_BEGIN
        { pg8::Gemm g{t_H, WGU, DM, DM, DM, 0, (long)4096 * 1024, TOPI, CAP, NE}; pg8::GroupOrder S; S.init(4, 16, NB * NE, F.G, (int)blockIdx.x);
          pg8::EpiSwiGLU E{(void*)HID, W8_INV};
          if PH_ON(13) PH_REP(13) { pg8::gemm_phase<pg8::EpiSwiGLU, pg8::GroupOrder, true, true>(F.lds, F.wave, g, S, E); __syncthreads(); } }
    STEP_END
    STEP_BEGIN
        { pg8::Gemm g{HID, WD, DFF, DFF, DFF, (long)CAP * DFF, (long)DM * DFF, nullptr, 0, NE}; pg8::GroupOrder S; S.init(4, 4, NB * NE, F.G, (int)blockIdx.x);
          pg8::EpiDown E{t_Y, TOPG, W8_INV};
          if PH_ON(14) PH_REP(14) { pg8::gemm_phase<pg8::EpiDown, pg8::GroupOrder, false, true>(F.lds, F.wave, g, S, E); __syncthreads(); } }
    STEP_END
    STEP_BEGIN
        if PH_ON(15) { for (int b = 0; b < NB; ++b) p_final(F, b, t_out, MOD, SLOT, t_Y, g_final, DBG_SCALE()); }
    STEP_END
#undef STEP_BEGIN
#undef STEP_END
}
#undef IN_F
#undef in_x
#undef cin
#undef positions
#undef w_ada
#undef b_ada
#undef g_mix
#undef w_in
#undef g_q
#undef g_kv
#undef w_uq
#undef w_ukv
#undef rel_bias
#undef w_out
#undef g_ffn
#undef w_router
#undef w_gate
#undef w_up
#undef w_down
#undef g_final
#undef t_out
#undef WSP
#undef MOD
#undef CS
#undef WIN
#undef WUQ
#undef WUKV
#undef WOUT
#undef t_H
#undef t_U
#undef t_P
#undef CQN
#undef CKVN
#undef QB
#undef KB
#undef VB
#undef OA
#undef OG
#undef LSE
#undef WGU
#undef WD
#undef HID
#undef t_Y
#undef AFFT
#undef TOPI
#undef TOPG
#undef SLOT
constexpr int STEPS_MIX = 5
#if defined(MK_CHECK) && MK_CHECK
    + 1
#endif
    ;
constexpr int N_STEPS = 2 + NB * STEPS_MIX + 3 + 3;

#ifndef MK_PER_STEP
#define MK_PER_STEP 0
#endif
extern "C" void kernel_launch(void* const* d_in, const int* in_sizes, int n_in, void* d_out, int out_size, void* d_ws, size_t ws_size, hipStream_t stream) {
    static int grid = 0;
    if (grid == 0) {
        if (n_in != 19 || out_size != NTOK * DM || ws_size < WS_END) { fprintf(stderr, "kernel_launch: unexpected shapes (n_in %d out %d ws %zu need %zu)\n", n_in, out_size, ws_size, (size_t)WS_END); grid = -1; return; }
        int dev = 0, cus = 0;
        if (hipGetDevice(&dev) != hipSuccess || hipDeviceGetAttribute(&cus, hipDeviceAttributeMultiprocessorCount, dev) != hipSuccess) { grid = -1; return; }
        if (hipFuncSetAttribute((const void*)fwd_kernel, hipFuncAttributeMaxDynamicSharedMemorySize, LDS_BYTES) != hipSuccess) { grid = -1; return; }
        int per_cu = 0;
        if (hipOccupancyMaxActiveBlocksPerMultiprocessor(&per_cu, (const void*)fwd_kernel, NWAVES * 64, LDS_BYTES) != hipSuccess || per_cu < 1) { fprintf(stderr, "kernel_launch: occupancy query says %d\n", per_cu); }
        (void)hipGetLastError();
        grid = cus;
    }
    if (grid < 0) return;
    if (hipMemsetAsync((char*)d_ws + WS_CTL, 0, CTL_ZERO_BYTES, stream) != hipSuccess) return;
    Args a{};
    for (int i = 0; i < 19; ++i) a.in[i] = d_in[i];
    a.out = (float*)d_out; a.ws = (unsigned char*)d_ws;
#if MK_PER_STEP
    for (int s = 0; s < N_STEPS; ++s) { a.st_lo = s; a.st_hi = s + 1; hipLaunchKernelGGL(fwd_kernel, dim3(grid), dim3(NWAVES * 64), LDS_BYTES, stream, a); }
#else
    a.st_lo = 0; a.st_hi = N_STEPS;
    hipLaunchKernelGGL(fwd_kernel, dim3(grid), dim3(NWAVES * 64), LDS_BYTES, stream, a);
#endif
    const hipError_t le = hipPeekAtLastError();
    if (le != hipSuccess) fprintf(stderr, "kernel_launch: launch failed: %s\n", hipGetErrorName(le));
}
```

```cpp
#include <hip/hip_runtime.h>
#include <cstdio>
#include <cstdint>

#define LAS __attribute__((address_space(3)))
#define GAS __attribute__((address_space(1)))
typedef unsigned short bf16_t;
typedef short bf16x8 __attribute__((ext_vector_type(8)));
typedef short s16x4 __attribute__((ext_vector_type(4)));
typedef float f32x2 __attribute__((ext_vector_type(2)));
typedef float f32x4 __attribute__((ext_vector_type(4)));
typedef float f32x16 __attribute__((ext_vector_type(16)));
typedef unsigned u32x2 __attribute__((ext_vector_type(2)));
typedef unsigned u32x4 __attribute__((ext_vector_type(4)));
typedef int i32x4 __attribute__((ext_vector_type(4)));

#ifndef MK_FP8
#define MK_FP8 1
#endif
#ifndef DIL_FP8
#define DIL_FP8 1
#endif
constexpr int NB = 4, SEQ = 8192, DM = 1024, NTOK = NB * SEQ;
constexpr int NP = 12032;
constexpr int C_CQ = 0, C_CKV = 384, C_KPE = 640, C_DIL = 704, C_GATE = 9920, D_IN = 11968;
constexpr int NE = 16, CAP = 1024, DFF = 2048;
constexpr int P_QK_ESZ = DIL_FP8 ? 1 : 2, P_GRP = 2 * 1024 * P_QK_ESZ + 2048, P_OFF_DIL = 1408, P_OFF_GATE = P_OFF_DIL + 3 * P_GRP, PROW = P_OFF_GATE + 2 * (2048 + 64);
__host__ __device__ constexpr int p_col_off(int c) {
    return c < C_DIL ? 2 * c : (c < C_GATE ? (P_OFF_DIL + ((c - C_DIL) / 3072) * P_GRP + ((((c - C_DIL) % 3072) >> 10) == 2 ? 2048 * P_QK_ESZ + 2 * (((c - C_DIL) % 3072) & 1023) : ((((c - C_DIL) % 3072) >> 10) * 1024 + (((c - C_DIL) % 3072) & 1023)) * P_QK_ESZ)) : P_OFF_GATE + 2 * (c - C_GATE)); }
__host__ __device__ constexpr bool p_col_f8(int c) { return DIL_FP8 && c >= C_DIL && c < C_GATE && ((((c - C_DIL) % 3072) >> 10) != 2); }
constexpr float NORM_EPS = 1e-6f;
constexpr float LOG2E = 1.4426950408889634f;

constexpr size_t MiB = 1u << 20;
constexpr size_t WS_CTL = 0, CTL_ZERO_BYTES = 1 * MiB;
constexpr size_t WS_MOD = 1 * MiB;
constexpr size_t WS_CS = 2 * MiB;
constexpr size_t WS_WIN = 10 * MiB;
constexpr size_t WS_WUQ = 34 * MiB;
constexpr size_t WS_WUKV = 36 * MiB;
constexpr size_t WS_WOUT = 37 * MiB;
constexpr size_t WS_H = 40 * MiB;
constexpr size_t WS_U = 104 * MiB;
constexpr size_t WS_R = 168 * MiB;
constexpr size_t WS_P = WS_R;
constexpr size_t WS_CQN = WS_R + 188 * MiB;
constexpr size_t WS_CKVN = WS_R + 194 * MiB;
constexpr size_t WS_QB = WS_R + 198 * MiB;
constexpr size_t WS_KB = WS_R + 222 * MiB;
constexpr size_t WS_VB = WS_R + 246 * MiB;
constexpr size_t WS_OA = WS_R + 262 * MiB;
constexpr size_t WS_OG = WS_R + 278 * MiB;
constexpr size_t WS_LSE = WS_R + 326 * MiB;
constexpr size_t WS_WGU = WS_R;
constexpr size_t WS_WD = WS_R + 64 * MiB;
constexpr size_t WS_HID = WS_R + 96 * MiB;
constexpr size_t WS_Y = WS_R + 224 * MiB;
constexpr size_t WS_AFFT = WS_R + 352 * MiB;
constexpr size_t WS_TOPI = WS_R + 354 * MiB;
constexpr size_t WS_TOPG = WS_R + 355 * MiB;
constexpr size_t WS_SLOT = WS_R + 356 * MiB;
constexpr size_t WS_END = WS_R + 358 * MiB;
constexpr size_t WS_LUT = 1 * MiB + 512 * 1024;
constexpr int CW_TMO = 0, CW_DBG = 16, CW_BAR = 4096;

constexpr int RING_BYTES = 131072;
constexpr int MISC_OFF = RING_BYTES + 320;
constexpr int LDS_BYTES = 147456;
constexpr int NWAVES = 8;

#define RLX_AGENT __ATOMIC_RELAXED, __HIP_MEMORY_SCOPE_AGENT
#define LDS_WAIT() asm volatile("s_waitcnt lgkmcnt(0)" ::: "memory")
#define VM_WAIT() asm volatile("s_waitcnt vmcnt(0)" ::: "memory")

__device__ __forceinline__ unsigned cvt_pk_bf16(float lo, float hi) { unsigned r; asm volatile("v_cvt_pk_bf16_f32 %0, %1, %2" : "=v"(r) : "v"(lo), "v"(hi)); return r; }
__device__ __forceinline__ float bf2f(unsigned short v) { return __uint_as_float(((unsigned)v) << 16); }
__device__ __forceinline__ float bflo(unsigned w) { return __uint_as_float(w << 16); }
__device__ __forceinline__ float bfhi(unsigned w) { return __uint_as_float(w & 0xffff0000u); }
#define SWZ_XOR(k) (((k) << 10) | 0x1f)
#if defined(OLD_WAVE_SUM)
__device__ __forceinline__ float wave_sum(float v) { for (int o = 1; o < 64; o <<= 1) v += __shfl_xor(v, o); return v; }
#else
__device__ __forceinline__ float wave_sum(float v) {
    v += __int_as_float(__builtin_amdgcn_ds_swizzle(__float_as_int(v), SWZ_XOR(1)));
    v += __int_as_float(__builtin_amdgcn_ds_swizzle(__float_as_int(v), SWZ_XOR(2)));
    v += __int_as_float(__builtin_amdgcn_ds_swizzle(__float_as_int(v), SWZ_XOR(4)));
    v += __int_as_float(__builtin_amdgcn_ds_swizzle(__float_as_int(v), SWZ_XOR(8)));
    v += __int_as_float(__builtin_amdgcn_ds_swizzle(__float_as_int(v), SWZ_XOR(16)));
    { auto rr = __builtin_amdgcn_permlane32_swap(__float_as_uint(v), __float_as_uint(v), false, false); v = __uint_as_float(rr[0]) + __uint_as_float(rr[1]); }
    return v;
}
#endif
__device__ __forceinline__ float wave_max(float v) {
    v = fmaxf(v, __int_as_float(__builtin_amdgcn_ds_swizzle(__float_as_int(v), SWZ_XOR(1))));
    v = fmaxf(v, __int_as_float(__builtin_amdgcn_ds_swizzle(__float_as_int(v), SWZ_XOR(2))));
    v = fmaxf(v, __int_as_float(__builtin_amdgcn_ds_swizzle(__float_as_int(v), SWZ_XOR(4))));
    v = fmaxf(v, __int_as_float(__builtin_amdgcn_ds_swizzle(__float_as_int(v), SWZ_XOR(8))));
    v = fmaxf(v, __int_as_float(__builtin_amdgcn_ds_swizzle(__float_as_int(v), SWZ_XOR(16))));
    { auto rr = __builtin_amdgcn_permlane32_swap(__float_as_uint(v), __float_as_uint(v), false, false); v = fmaxf(__uint_as_float(rr[0]), __uint_as_float(rr[1])); }
    return v;
}
__device__ __forceinline__ float fast_sigmoid(float x) { return __builtin_amdgcn_rcpf(1.f + __builtin_amdgcn_exp2f(-x * LOG2E)); }
#ifndef MK_FP8
#define MK_FP8 1
#endif
#ifndef MLA_NM16
#define MLA_NM16 1
#endif
#ifndef MLA_PKADD
#define MLA_PKADD 0
#endif
#ifndef MLA_PKOLD
#define MLA_PKOLD 0
#endif
#ifndef MLA_PRE
#define MLA_PRE 1
#endif
#ifndef MLA_2T
#define MLA_2T 0
#endif
#ifndef MLA_LSUM
#define MLA_LSUM 1
#endif
#ifndef MLA_FP8
#define MLA_FP8 1
#endif
#ifndef FP8_G1
#define FP8_G1 MK_FP8
#endif
#ifndef FP8_EX
#define FP8_EX MK_FP8
#endif
#ifndef FP8_WO
#define FP8_WO 1
#endif
constexpr float QK_LOG2_SCALE = 0.072168783648703220f * LOG2E;
constexpr float W8_SCALE = 64.0f, W8_INV = 1.0f / 64.0f;
constexpr float U8_SCALE = 16.0f;
typedef int v8i __attribute__((ext_vector_type(8)));
__device__ __forceinline__ unsigned pk4_fp8(float a, float b, float c, float d) { int w = __builtin_amdgcn_cvt_pk_fp8_f32(a, b, 0, false); w = __builtin_amdgcn_cvt_pk_fp8_f32(c, d, w, true); return (unsigned)w; }
#if defined(OLD_TID)
__device__ __forceinline__ int opaque_tid(int wv) { int t = (int)threadIdx.x; asm volatile("" : "+v"(t)); return t; }
#else
__device__ __forceinline__ int opaque_tid(int wv) { int l; asm volatile("v_mbcnt_lo_u32_b32 %0, -1, 0\n\tv_mbcnt_hi_u32_b32 %0, -1, %0" : "=v"(l)); return (wv << 6) | l; }
#endif
struct Frame {
    LAS unsigned char* lds;
    int tid, lane, wave, vcu, G, gw, NGW;
};
struct Args { const void* in[19]; float* out; unsigned char* ws; int st_lo, st_hi; };

#define XB_TMO      128
#define XB_XCNT(j)  (256  + 64 * (j))
#define XB_XSUB(j)  (1280 + 64 * (j))
#define XB_XGEN(j)  (2304 + 64 * (j))
#define XB_TOP      3328
#define XB_TOPGEN   3392
#define XCD_BAR_WORDS 3456
#define XB_SPIN_CAP (1u << 18)

__device__ __forceinline__ unsigned xb_ld(unsigned* p)              { return __hip_atomic_load(p, __ATOMIC_RELAXED, __HIP_MEMORY_SCOPE_AGENT); }
__device__ __forceinline__ unsigned xb_add(unsigned* p, unsigned v) { return __hip_atomic_fetch_add(p, v, __ATOMIC_RELAXED, __HIP_MEMORY_SCOPE_AGENT); }
__device__ __forceinline__ unsigned xb_xcc_id() { return (unsigned)__builtin_amdgcn_s_getreg((3 << 11) | 20) & 0xFu; }
#define XB_SPIN(cond, bar) do { unsigned _sp = 0; while (cond) { __builtin_amdgcn_s_sleep(1); \
    if ((++_sp & 255u) == 0u) { if (xb_ld(&(bar)[XB_TMO])) break; if (_sp > XB_SPIN_CAP) { atomicAdd(&(bar)[XB_TMO], 1u); break; } } } } while (0)

struct XcdBarrier {
    unsigned* bar; unsigned x;
    int wv;
    volatile LAS unsigned* st;
};

__device__ __forceinline__ XcdBarrier xcd_barrier_post(unsigned* bar, volatile LAS unsigned* st) {
    XcdBarrier b; b.bar = bar; b.x = xb_xcc_id(); b.st = st;
    if (threadIdx.x == 0) (void)xb_add(&bar[XB_XCNT(b.x)], 1u);
    return b;
}
__device__ __forceinline__ void xcd_barrier_complete(unsigned* bar, unsigned x, unsigned& nloc, unsigned& nx) {
    const unsigned G = gridDim.x * gridDim.y * gridDim.z;
    unsigned sum, cnt, mine, sp = 0u;
    for (;;) {
        sum = 0u; cnt = 0u; mine = 0u;
#pragma unroll
        for (unsigned j = 0; j < 16; ++j) { const unsigned c = xb_ld(&bar[XB_XCNT(j)]); sum += c; cnt += (c > 0u) ? 1u : 0u; mine = (j == x) ? c : mine; }
        if (sum == G) break;
        __builtin_amdgcn_s_sleep(1);
        if ((++sp & 255u) == 0u) { if (xb_ld(&bar[XB_TMO])) break; if (sp > XB_SPIN_CAP) { atomicAdd(&bar[XB_TMO], 1u); break; } }
    }
    nloc = mine > 0u ? mine : 1u; nx = cnt > 0u ? cnt : 1u;
}

__device__ __forceinline__ void xcd_barrier(const XcdBarrier& b) {
    asm volatile("s_waitcnt vmcnt(0)" ::: "memory");
    __syncthreads();
    if (b.wv == 0 && opaque_tid(0) == 0) {
        unsigned* bar = b.bar;
        __builtin_amdgcn_s_waitcnt(0);
        unsigned nloc = b.st[0], nx = b.st[1];
        if (nloc == 0u) { xcd_barrier_complete(bar, b.x, nloc, nx); b.st[0] = nloc; b.st[1] = nx; }
        const unsigned old = xb_add(&bar[XB_XSUB(b.x)], 1u);
        const unsigned gen = old / nloc;
        if (old + 1u == (gen + 1u) * nloc) {
            __builtin_amdgcn_fence(__ATOMIC_RELEASE, "agent");
            asm volatile("s_waitcnt vmcnt(0)" ::: "memory");
            const unsigned og = xb_add(&bar[XB_TOP], 1u);
            const unsigned tg = og / nx;
            if (og + 1u == (tg + 1u) * nx) xb_add(&bar[XB_TOPGEN], 1u);
            else XB_SPIN(xb_ld(&bar[XB_TOPGEN]) == tg, bar);
            __builtin_amdgcn_fence(__ATOMIC_ACQUIRE, "agent");
            xb_add(&bar[XB_XGEN(b.x)], 1u);
            asm volatile("s_waitcnt vmcnt(0)" ::: "memory");
        } else {
            XB_SPIN(xb_ld(&bar[XB_XGEN(b.x)]) == gen, bar);
            __builtin_amdgcn_fence(__ATOMIC_ACQUIRE, "agent");
            asm volatile("s_waitcnt vmcnt(0)" ::: "memory");
        }
    }
    __syncthreads();
}

namespace pg8 {
constexpr int BM = 256, BK = 64, HALF = 128, HTB = HALF * BK * 2  , STAGE_BYTES = 8 * HTB, NXCD = 8, WGM = 8;

__host__ __device__ __forceinline__ int lds_byte(int r, int c) { const int st = (r >> 4) * 2 + (c >> 5), rr = r & 15, cc = c & 31, ob = rr * 64 + cc * 2; return st * 1024 + (ob ^ (((ob >> 9) & 1) << 5)); }
__host__ __device__ __forceinline__ void stage_rc(int b, int& R, int& C) { const int st = b / 1024, sb = b % 1024, swz = sb ^ (((sb >> 9) & 1) << 5); R = (st >> 1) * 16 + swz / 64; C = (st & 1) * 32 + (swz % 64) / 2; }
__host__ __device__ __forceinline__ int perm32(int rho) { const int n = rho >> 4, i = rho & 15; return 8 * (i >> 2) + 4 * n + (i & 3); }

struct Unit { int pm, pn, g; };
struct Gemm { const bf16_t* A; const bf16_t* Bt; int lda, ldb, K; long a_gs, b_gs; const int* idx; int idx_gs; int b_gmod; };

struct StaticOrder {
    int nM, nN, nwg, G, c;
    __device__ __forceinline__ void init(int M, int N, int G_, int c_) { nM = M / BM; nN = N / BM; nwg = nM * nN; G = G_; c = c_; }
    __device__ __forceinline__ bool next(int i, Unit& u) const {
        const long L = (long)i * G + c; if (L >= nwg) return false;
        int wgid = (int)L; { const int q = nwg / NXCD, r = nwg % NXCD, xcd = wgid % NXCD, off = wgid / NXCD; wgid = (xcd < r ? xcd * (q + 1) : r * (q + 1) + (xcd - r) * q) + off; }
        const int nig = WGM * nN, gid = wgid / nig, fm = gid * WGM, gsz = (nM - fm) < WGM ? (nM - fm) : WGM;
        u.pm = fm + ((wgid % nig) % gsz); u.pn = (wgid % nig) / gsz; u.g = 0; return true;
    }
};
struct GroupOrder {
    int nM, nN, nwg, G, v, gperm;
    __device__ __forceinline__ void init(int nM_, int nN_, int nG, int G_, int c_) { nM = nM_; nN = nN_; nwg = nM_ * nN_ * nG; G = G_; gperm = (nG == 64); v = (G_ % 8 == 0) ? (c_ % 8) * (G_ / 8) + c_ / 8 : c_; }
    __device__ __forceinline__ bool next(int i, Unit& u) const {
        const long L = (long)i * G + v; if (L >= nwg) return false;
        const int w = (int)L, gi = w / (nM * nN); u.pm = w % nM; u.pn = (w / nM) % nN;
        u.g = gperm ? (gi & 3) * 16 + (gi >> 2) : gi;
        return true;
    }
};

template <class Epi, class Sched, bool GATHER, bool FP8 = false>
__device__ __forceinline__ void gemm_phase(LAS unsigned char* lds, int wv, const Gemm g, const Sched& S, const Epi& E) {
    const int tid = opaque_tid(wv), wid = __builtin_amdgcn_readfirstlane(tid >> 6), lane = tid & 63, wr = wid >> 2, wc = wid & 3, fr = lane & 15, fq = lane >> 4;
    constexpr int ESZ = FP8 ? 1 : 2;
    const int K = g.K, nt = K * ESZ / (BK * 2);
    int Rr[2], Cc[2]; unsigned voffB[2];
#pragma unroll
    for (int i = 0; i < 2; ++i) { int R, C; stage_rc(tid * 16 + i * 8192, R, C); Rr[i] = R; Cc[i] = C; const int Rb = (Epi::PERM && !Epi::BPRE) ? ((R & ~31) + perm32(R & 31)) : R;
        voffB[i] = (unsigned)(Rb * g.ldb * ESZ + C * 2); }
    const unsigned kstep = (unsigned)(BK * 2);
    const unsigned hstepA = (unsigned)(HALF * g.lda * ESZ), hstepB = (unsigned)(HALF * g.ldb * ESZ);
    const unsigned ldsw = (unsigned)wid * 1024u;
    const int aoff = lds_byte(wr * 64 + fr, fq * 8), boff = lds_byte(wc * 32 + fr, fq * 8);
#define PG8_SA(b, h) (((b) * 2 + (h)) * HTB)
#define PG8_SB(b, h) ((4 + (b) * 2 + (h)) * HTB)
    const __amdgpu_buffer_rsrc_t rsA = __builtin_amdgcn_make_buffer_rsrc((void*)g.A, 0, 0x7fffffff, 0x00020000), rsB = __builtin_amdgcn_make_buffer_rsrc((void*)g.Bt, 0, 0x7fffffff, 0x00020000);
#ifndef PG8_BUFFER_DMA
#define PG8_BUFFER_DMA 1
#endif
#if PG8_BUFFER_DMA
#define PG8_STAGE(bufoff, rs, so, v0, v1) do { \
        __builtin_amdgcn_raw_ptr_buffer_load_lds(rs, (LAS void*)(lds + (bufoff) + ldsw), 16, (v0), (so), 0, 0); \
        __builtin_amdgcn_raw_ptr_buffer_load_lds(rs, (LAS void*)(lds + (bufoff) + ldsw + 8192), 16, (v1), (so), 0, 0); } while (0)
#else
#define PG8_GBASE(rs) ((const char*)(__builtin_bit_cast(u32x4, rs).x | ((unsigned long long)(__builtin_bit_cast(u32x4, rs).y & 0xffffu) << 32)))
#define PG8_STAGE(bufoff, rs, so, v0, v1) do { const char* gb_ = (&rs == &rsA ? (const char*)g.A : (const char*)g.Bt) + (so); \
        __builtin_amdgcn_global_load_lds((const unsigned*)(gb_ + (v0)), (LAS unsigned*)(lds + (bufoff) + ldsw), 16, 0, 0); \
        __builtin_amdgcn_global_load_lds((const unsigned*)(gb_ + (v1)), (LAS unsigned*)(lds + (bufoff) + ldsw + 8192), 16, 0, 0); } while (0)
#endif
#define PG8_STAGEB(bufoff, so) PG8_STAGE(bufoff, rsB, so, voffB[0], voffB[1])
#define PG8_CAT(x_, y_) __builtin_shufflevector(__builtin_bit_cast(i32x4, x_), __builtin_bit_cast(i32x4, y_), 0, 1, 2, 3, 4, 5, 6, 7)
#define PG8_LO(v_) __builtin_bit_cast(bf16x8, __builtin_shufflevector(v_, v_, 0, 1, 2, 3))
#define PG8_HI(v_) __builtin_bit_cast(bf16x8, __builtin_shufflevector(v_, v_, 4, 5, 6, 7))
#define PG8_LDA(dst, b, h) do { _Pragma("unroll") for (int m = 0; m < 4; ++m) dst[m] = PG8_CAT(*(const LAS bf16x8*)(lds + PG8_SA(b, h) + aoff + m * 2048), *(const LAS bf16x8*)(lds + PG8_SA(b, h) + aoff + m * 2048 + 1024)); } while (0)
#define PG8_LDB(dst, b, h) do { _Pragma("unroll") for (int n = 0; n < 2; ++n) dst[n] = PG8_CAT(*(const LAS bf16x8*)(lds + PG8_SB(b, h) + boff + n * 2048), *(const LAS bf16x8*)(lds + PG8_SB(b, h) + boff + n * 2048 + 1024)); } while (0)
#define PG8_MMA(ai, bj, At, Bt) do { __builtin_amdgcn_s_setprio(1); _Pragma("unroll") for (int m = 0; m < 4; ++m) _Pragma("unroll") for (int n = 0; n < 2; ++n) { \
        if constexpr (FP8) acc[ai][bj][m][n] = __builtin_amdgcn_mfma_scale_f32_16x16x128_f8f6f4(Bt[n], At[m], acc[ai][bj][m][n], 0, 0, 0, 0, 0, 0);   \
        else { acc[ai][bj][m][n] = __builtin_amdgcn_mfma_f32_16x16x32_bf16(PG8_LO(Bt[n]), PG8_LO(At[m]), acc[ai][bj][m][n], 0, 0, 0); \
               acc[ai][bj][m][n] = __builtin_amdgcn_mfma_f32_16x16x32_bf16(PG8_HI(Bt[n]), PG8_HI(At[m]), acc[ai][bj][m][n], 0, 0, 0); } } \
        __builtin_amdgcn_s_setprio(0); } while (0)
#define PG8_WAIT_V(n) asm volatile("s_waitcnt vmcnt(" #n ")" ::: "memory")
#define PG8_WAIT_L(n) asm volatile("s_waitcnt lgkmcnt(" #n ")" ::: "memory")
#define PG8_BAR __builtin_amdgcn_s_barrier()
#define PG8_SCHED __builtin_amdgcn_sched_barrier(0)
    Unit cur, nxt; int ui = 0;
    if (!S.next(0, cur)) return;
    f32x4 acc[2][2][4][2];
#pragma unroll
    for (int a = 0; a < 2; ++a)
#pragma unroll
        for (int b = 0; b < 2; ++b)
#pragma unroll
            for (int m = 0; m < 4; ++m)
#pragma unroll
                for (int n = 0; n < 2; ++n) acc[a][b][m][n] = (f32x4){0.f, 0.f, 0.f, 0.f};
    v8i At[4], B0[2], B1[2];
    unsigned voffA[2]; unsigned oc[2][2], on[2][2];
#pragma unroll
    for (int i = 0; i < 2; ++i) voffA[i] = (unsigned)(Rr[i] * g.lda * ESZ + Cc[i] * 2);
    unsigned cA, cB;
#define PG8_UNIT_PTRS(u, pA, pB, o) do { \
        pB = (unsigned)(((size_t)(g.b_gmod ? (u).g % g.b_gmod : (u).g) * g.b_gs + (size_t)(u).pn * BM * g.ldb) * ESZ); \
        if constexpr (GATHER) { \
            pA = 0u; \
            const int* ix_ = g.idx + (size_t)(u).g * g.idx_gs + (u).pm * BM; const int t_ = opaque_tid(wv); \
            _Pragma("unroll") for (int i = 0; i < 2; ++i) { int R_, C_; stage_rc(t_ * 16 + i * 8192, R_, C_); \
                _Pragma("unroll") for (int h = 0; h < 2; ++h) o[h][i] = (unsigned)ix_[h * HALF + R_] * (unsigned)(g.lda * ESZ) + (unsigned)C_ * 2u; } \
        } else { \
            pA = (unsigned)(((size_t)(u).g * g.a_gs + (size_t)(u).pm * BM * g.lda) * ESZ); \
        } } while (0)
#define PG8_STAGEA(bufoff, p, o, h) do { if constexpr (GATHER) PG8_STAGE(bufoff, rsA, p, o[h][0], o[h][1]); else PG8_STAGE(bufoff, rsA, (p) + (h) * hstepA, voffA[0], voffA[1]); } while (0)
    PG8_UNIT_PTRS(cur, cA, cB, oc);
    PG8_STAGEB(PG8_SB(0, 0), cB); PG8_STAGEB(PG8_SB(0, 1), cB + hstepB); PG8_STAGEA(PG8_SA(0, 0), cA, oc, 0); PG8_STAGEA(PG8_SA(0, 1), cA, oc, 1);
    if (wr == 1) PG8_BAR;
    PG8_WAIT_V(2); PG8_BAR;
    PG8_STAGEB(PG8_SB(1, 0), cB + kstep); PG8_STAGEA(PG8_SA(1, 0), cA + kstep, oc, 0); PG8_STAGEB(PG8_SB(1, 1), cB + hstepB + kstep);
    PG8_WAIT_V(6); PG8_BAR;
    for (;;) {
        const bool has_next = S.next(ui + 1, nxt);
        unsigned nA = cA, nB = cB;
        if constexpr (GATHER) {
#pragma unroll
            for (int h = 0; h < 2; ++h)
#pragma unroll
                for (int i = 0; i < 2; ++i) on[h][i] = oc[h][i];
        }
        if (has_next) PG8_UNIT_PTRS(nxt, nA, nB, on);
#pragma unroll 1
        for (int t = 0; t < nt; t += 2) {
            const bool last = (t == nt - 2);
            const unsigned a1 = cA + (unsigned)(t + 1) * kstep;
            const unsigned a2 = last ? nA : cA + (unsigned)(t + 2) * kstep, b2 = last ? nB : cB + (unsigned)(t + 2) * kstep;
            const unsigned a3 = a2 + kstep, b3 = b2 + kstep;
#define PG8_STAGEA2(bufoff, p, h) do { if constexpr (GATHER) { if (last) PG8_STAGEA(bufoff, p, on, h); else PG8_STAGEA(bufoff, p, oc, h); } else PG8_STAGEA(bufoff, p, oc, h); } while (0)
            PG8_LDB(B0, 0, 0); PG8_LDB(B1, 0, 1); PG8_SCHED; PG8_LDA(At, 0, 0); PG8_STAGEA(PG8_SA(1, 1), a1, oc, 1);
            PG8_WAIT_V(8); PG8_WAIT_L(0); PG8_BAR; PG8_MMA(0, 0, At, B0); PG8_MMA(0, 1, At, B1); PG8_BAR; PG8_SCHED;
            PG8_LDA(At, 0, 1); PG8_STAGEB(PG8_SB(0, 0), b2); PG8_STAGEB(PG8_SB(0, 1), b2 + hstepB); PG8_STAGEA2(PG8_SA(0, 0), a2, 0);
            PG8_WAIT_V(8); PG8_WAIT_L(0); PG8_BAR; PG8_MMA(1, 0, At, B0); PG8_MMA(1, 1, At, B1); PG8_BAR; PG8_SCHED;
            PG8_LDB(B0, 1, 0); PG8_LDB(B1, 1, 1); PG8_SCHED; PG8_LDA(At, 1, 0); PG8_STAGEA2(PG8_SA(0, 1), a2, 1);
            PG8_WAIT_V(8); PG8_WAIT_L(0); PG8_BAR; PG8_MMA(0, 0, At, B0); PG8_MMA(0, 1, At, B1); PG8_BAR; PG8_SCHED;
            PG8_LDA(At, 1, 1); PG8_STAGEB(PG8_SB(1, 0), b3); PG8_STAGEB(PG8_SB(1, 1), b3 + hstepB); PG8_STAGEA2(PG8_SA(1, 0), a3, 0);
            PG8_WAIT_V(8); PG8_WAIT_L(0); PG8_BAR; PG8_MMA(1, 0, At, B0); PG8_MMA(1, 1, At, B1); PG8_BAR; PG8_SCHED;
        }
        if (wr == 0) PG8_BAR;
        { const int l_ = opaque_tid(wv) & 63; E(acc, cur, wr, wc, l_ & 15, l_ >> 4); }
        if (!has_next) break;
#pragma unroll
        for (int a = 0; a < 2; ++a)
#pragma unroll
            for (int b = 0; b < 2; ++b)
#pragma unroll
                for (int m = 0; m < 4; ++m)
#pragma unroll
                    for (int n = 0; n < 2; ++n) acc[a][b][m][n] = (f32x4){0.f, 0.f, 0.f, 0.f};
        cur = nxt; cA = nA; cB = nB; ++ui;
        if constexpr (GATHER) {
#pragma unroll
            for (int h = 0; h < 2; ++h)
#pragma unroll
                for (int i = 0; i < 2; ++i) oc[h][i] = on[h][i];
        }
        if (wr == 1) PG8_BAR;
    }
    PG8_WAIT_V(0);
    PG8_BAR;
#undef PG8_UNIT_PTRS
#undef PG8_STAGEA
#undef PG8_STAGEA2
#undef PG8_SA
#undef PG8_SB
#undef PG8_STAGE
#undef PG8_STAGEB
#undef PG8_LDA
#undef PG8_LDB
#undef PG8_MMA
#undef PG8_CAT
#undef PG8_LO
#undef PG8_HI
#undef PG8_WAIT_V
#undef PG8_WAIT_L
#undef PG8_BAR
#undef PG8_SCHED
}

#define EPI_ROWLOOP for (int ai = 0; ai < 2; ++ai) _Pragma("unroll") for (int m = 0; m < 4; ++m)
__device__ __forceinline__ u32x4 pack8(const f32x4 v0, const f32x4 v1) { u32x4 w; w.x = cvt_pk_bf16(v0[0], v0[1]); w.y = cvt_pk_bf16(v0[2], v0[3]); w.z = cvt_pk_bf16(v1[0], v1[1]); w.w = cvt_pk_bf16(v1[2], v1[3]); return w; }
struct EpiBf16 {
    static constexpr bool PERM = true, BPRE = true;
    bf16_t* O; int ldc; float sc; int nostore;
    __device__ __forceinline__ void operator()(const f32x4 (&acc)[2][2][4][2], const Unit& u, int wr, int wc, int fr, int fq) const {
        const __amdgpu_buffer_rsrc_t rs = __builtin_amdgcn_make_buffer_rsrc((void*)O, 0, 0x7fffffff, 0x00020000);
        const unsigned lo = (unsigned)(fr * ldc + 8 * fq) * 2u, so = (unsigned)(((u.pm * BM + wr * 64) * ldc + u.pn * BM + wc * 32) * 2);
        if (nostore) return;
#pragma unroll
        EPI_ROWLOOP {
#pragma unroll
            for (int bj = 0; bj < 2; ++bj) {
#if !defined(EPI_BUF_STORES)
#if defined(EPI_NT_STORES_PROBE)
                __builtin_nontemporal_store(pack8(acc[ai][bj][m][0] * sc, acc[ai][bj][m][1] * sc), (u32x4*)((char*)O + (size_t)(so + (unsigned)((ai * HALF + m * 16) * ldc + bj * HALF) * 2u) + lo));
#else
                *(u32x4*)((char*)O + (size_t)(so + (unsigned)((ai * HALF + m * 16) * ldc + bj * HALF) * 2u) + lo) = pack8(acc[ai][bj][m][0] * sc, acc[ai][bj][m][1] * sc);
#endif
#else
                __builtin_amdgcn_raw_buffer_store_b128(pack8(acc[ai][bj][m][0] * sc, acc[ai][bj][m][1] * sc), rs, lo, so + (unsigned)((ai * HALF + m * 16) * ldc + bj * HALF) * 2u, 0);
#endif
            } }
    }
};
struct EpiP {
    static constexpr bool PERM = true, BPRE = true;
    unsigned char* P; float sc; int nostore;
    __device__ __forceinline__ void operator()(const f32x4 (&acc)[2][2][4][2], const Unit& u, int wr, int wc, int fr, int fq) const {
        if (nostore) return;
        const size_t rowb = (size_t)(u.pm * BM + wr * 64) * PROW;
#pragma unroll
        for (int bj = 0; bj < 2; ++bj) { const int c32 = u.pn * BM + bj * HALF + wc * 32; const bool f8 = p_col_f8(c32);
            char* ub = (char*)P + rowb + p_col_off(c32); const unsigned lo = (unsigned)(fr * PROW + (f8 ? 8 : 16) * fq);
#pragma unroll
            EPI_ROWLOOP { char* dst = ub + (size_t)(ai * HALF + m * 16) * PROW + lo; const f32x4 v0 = acc[ai][bj][m][0] * sc, v1 = acc[ai][bj][m][1] * sc;
                if (f8) { u32x2 o; o.x = pk4_fp8(v0[0], v0[1], v0[2], v0[3]); o.y = pk4_fp8(v1[0], v1[1], v1[2], v1[3]); *(u32x2*)dst = o; }
                else *(u32x4*)dst = pack8(v0, v1); } }
    }
};
struct EpiQ {
    static constexpr bool PERM = true, BPRE = false;
    bf16_t* QB; const float* cs;
    __device__ __forceinline__ void operator()(const f32x4 (&acc)[2][2][4][2], const Unit& u, int wr, int wc, int fr, int fq) const {
        const unsigned lo = (unsigned)(fr * 192 + 8 * fq) * 2u, lcs = (unsigned)(fr * 64 + 8 * fq) * 4u;
        const int rowU = u.pm * BM + wr * 64;
#pragma unroll
        for (int bj = 0; bj < 2; ++bj) { const int c32 = u.pn * BM + bj * HALF + wc * 32, hd = c32 / 192, w32 = c32 - hd * 192;
            char* ub = (char*)(QB + ((size_t)hd * SEQ + rowU) * 192 + w32);
            const char* cb = (const char*)(cs + (size_t)rowU * 64 + (w32 >= 128 ? (w32 - 128) : 0));
#pragma unroll
            EPI_ROWLOOP { const int rr = ai * HALF + m * 16; f32x4 v0 = acc[ai][bj][m][0], v1 = acc[ai][bj][m][1];
                if (w32 >= 128) { const f32x4 ca = *(const f32x4*)(cb + (size_t)rr * 256 + lcs), cc = *(const f32x4*)(cb + (size_t)rr * 256 + 16 + lcs);
                    const f32x4 a = v0, b = v1;
                    v0[0] = a[0] * ca[0] - a[1] * ca[1]; v0[1] = a[0] * ca[1] + a[1] * ca[0]; v0[2] = a[2] * ca[2] - a[3] * ca[3]; v0[3] = a[2] * ca[3] + a[3] * ca[2];
                    v1[0] = b[0] * cc[0] - b[1] * cc[1]; v1[1] = b[0] * cc[1] + b[1] * cc[0]; v1[2] = b[2] * cc[2] - b[3] * cc[3]; v1[3] = b[2] * cc[3] + b[3] * cc[2]; }
                *(u32x4*)(ub + (size_t)rr * 384 + lo) = pack8(v0, v1);
                if (m & 1) asm volatile("" ::: "memory"); } }
    }
};
struct EpiKV {
    static constexpr bool PERM = true, BPRE = false;
    bf16_t* KB; bf16_t* VB;
    __device__ __forceinline__ void operator()(const f32x4 (&acc)[2][2][4][2], const Unit& u, int wr, int wc, int fr, int fq) const {
        const int rowU = u.pm * BM + wr * 64;
#pragma unroll
        for (int bj = 0; bj < 2; ++bj) { const int c32 = u.pn * BM + bj * HALF + wc * 32, hd = c32 >> 8, w32 = c32 & 255; const bool isk = w32 < 128;
            const int ld = isk ? 192 : 128;
            char* ub = (char*)(isk ? KB + ((size_t)hd * SEQ + rowU) * 192 + w32 : VB + ((size_t)hd * SEQ + rowU) * 128 + (w32 - 128));
            const unsigned lo = (unsigned)(fr * ld + 8 * fq) * 2u;
#pragma unroll
            EPI_ROWLOOP { *(u32x4*)(ub + (size_t)(ai * HALF + m * 16) * ld * 2 + lo) = pack8(acc[ai][bj][m][0], acc[ai][bj][m][1]); } }
    }
};
struct EpiQ8 {
    static constexpr bool PERM = true, BPRE = false;
    unsigned char* Q8; const float* cs;
    __device__ __forceinline__ void operator()(const f32x4 (&acc)[2][2][4][2], const Unit& u, int wr, int wc, int fr, int fq) const {
        const unsigned lo = (unsigned)(fr * 192 + 8 * fq), lcs = (unsigned)(fr * 64 + 8 * fq) * 4u;
        const int rowU = u.pm * BM + wr * 64;
#pragma unroll
        for (int bj = 0; bj < 2; ++bj) { const int c32 = u.pn * BM + bj * HALF + wc * 32, hd = c32 / 192, w32 = c32 - hd * 192;
            char* ub = (char*)(Q8 + ((size_t)hd * SEQ + rowU) * 192 + w32);
            const char* cb = (const char*)(cs + (size_t)rowU * 64 + (w32 >= 128 ? (w32 - 128) : 0));
#pragma unroll
            EPI_ROWLOOP { const int rr = ai * HALF + m * 16; f32x4 v0 = acc[ai][bj][m][0], v1 = acc[ai][bj][m][1];
                if (w32 >= 128) { const f32x4 ca = *(const f32x4*)(cb + (size_t)rr * 256 + lcs), cc = *(const f32x4*)(cb + (size_t)rr * 256 + 16 + lcs);
                    const f32x4 a = v0, b = v1;
                    v0[0] = a[0] * ca[0] - a[1] * ca[1]; v0[1] = a[0] * ca[1] + a[1] * ca[0]; v0[2] = a[2] * ca[2] - a[3] * ca[3]; v0[3] = a[2] * ca[3] + a[3] * ca[2];
                    v1[0] = b[0] * cc[0] - b[1] * cc[1]; v1[1] = b[0] * cc[1] + b[1] * cc[0]; v1[2] = b[2] * cc[2] - b[3] * cc[3]; v1[3] = b[2] * cc[3] + b[3] * cc[2]; }
                v0 = v0 * QK_LOG2_SCALE; v1 = v1 * QK_LOG2_SCALE;
                u32x2 o; o.x = pk4_fp8(v0[0], v0[1], v0[2], v0[3]); o.y = pk4_fp8(v1[0], v1[1], v1[2], v1[3]);
                *(u32x2*)(ub + (size_t)rr * 192 + lo) = o;
                if (m & 1) asm volatile("" ::: "memory"); } }
    }
};
struct EpiK8 {
    static constexpr bool PERM = true, BPRE = false;
    unsigned char* K8;
    __device__ __forceinline__ void operator()(const f32x4 (&acc)[2][2][4][2], const Unit& u, int wr, int wc, int fr, int fq) const {
        const int rowU = u.pm * BM + wr * 64; const unsigned lo = (unsigned)(fr * 192 + 8 * fq);
#pragma unroll
        for (int bj = 0; bj < 2; ++bj) { const int c32 = u.pn * BM + bj * HALF + wc * 32, hd = c32 >> 7, w32 = c32 & 127;
            char* ub = (char*)(K8 + ((size_t)hd * SEQ + rowU) * 192 + w32);
#pragma unroll
            EPI_ROWLOOP { const f32x4 v0 = acc[ai][bj][m][0], v1 = acc[ai][bj][m][1];
                u32x2 o; o.x = pk4_fp8(v0[0], v0[1], v0[2], v0[3]); o.y = pk4_fp8(v1[0], v1[1], v1[2], v1[3]);
                *(u32x2*)(ub + (size_t)(ai * HALF + m * 16) * 192 + lo) = o; } }
    }
};
struct EpiVT8 {
    static constexpr bool PERM = true, BPRE = false;
    unsigned char* VT8;
    __device__ __forceinline__ void operator()(const f32x4 (&acc)[2][2][4][2], const Unit& u, int wr, int wc, int fr, int fq) const {
#pragma unroll
        for (int bj = 0; bj < 2; ++bj) { const int T0 = u.pn * BM + bj * HALF + wc * 32 + 8 * fq, tile = T0 >> 6, G0 = (T0 & 63) >> 2, half = G0 >> 3, a = (G0 & 7) >> 1;
            const int p0 = 4 * (4 * half + a), p1 = 4 * (8 + 4 * half + a);
#pragma unroll
            EPI_ROWLOOP { const int r = u.pm * BM + ai * HALF + wr * 64 + m * 16 + fr, hd = r >> 7, col = r & 127;
                unsigned char* dst = VT8 + (((size_t)hd * (SEQ / 64) + tile) * 128 + col) * 64;
                const f32x4 v0 = acc[ai][bj][m][0], v1 = acc[ai][bj][m][1];
                *(unsigned*)(dst + p0) = pk4_fp8(v0[0], v0[1], v0[2], v0[3]); *(unsigned*)(dst + p1) = pk4_fp8(v1[0], v1[1], v1[2], v1[3]); } }
    }
};
struct EpiRes {
    static constexpr bool PERM = false, BPRE = false;
    const float* x; float* out; const float* mod; float sc;
    __device__ __forceinline__ void operator()(const f32x4 (&acc)[2][2][4][2], const Unit& u, int wr, int wc, int fr, int fq) const {
        const int col0 = u.pn * BM + wc * 32 + 4 * fq;
        const int b = (u.pm * BM) / SEQ;
        f32x4 gt[2][2];
#pragma unroll
        for (int bj = 0; bj < 2; ++bj)
#pragma unroll
            for (int n = 0; n < 2; ++n) gt[bj][n] = *(const f32x4*)(mod + b * 6144 + 2048 + col0 + bj * HALF + n * 16) * sc;
        const unsigned lo = (unsigned)(fr * DM + 4 * fq) * 4u;
        const size_t ubo = ((size_t)(u.pm * BM + wr * 64) * DM + u.pn * BM + wc * 32) * 4;
#pragma unroll
        EPI_ROWLOOP { const size_t ro = ubo + (size_t)(ai * HALF + m * 16) * DM * 4;
#pragma unroll
            for (int bj = 0; bj < 2; ++bj)
#pragma unroll
                for (int n = 0; n < 2; ++n) { const size_t o = ro + (bj * HALF + n * 16) * 4; const f32x4 xv = *(const f32x4*)((const char*)x + o + lo);
                    *(f32x4*)((char*)out + o + lo) = xv + gt[bj][n] * acc[ai][bj][m][n]; }
            if (m & 1) asm volatile("" ::: "memory"); }
    }
};
struct EpiSwiGLU {
    static constexpr bool PERM = true, BPRE = true;
    void* HID; float sc;
    __device__ __forceinline__ void operator()(const f32x4 (&acc)[2][2][4][2], const Unit& u, int wr, int wc, int fr, int fq) const {
        constexpr int HE = FP8_EX ? 1 : 2;
        const __amdgpu_buffer_rsrc_t rs = __builtin_amdgcn_make_buffer_rsrc(HID, 0, 0x7fffffff, 0x00020000);
        const unsigned lo = (unsigned)(fr * DFF + 4 * fq) * HE, so = (unsigned)(((u.g * CAP + u.pm * BM + wr * 64) * DFF + ((u.pn * BM + wc * 32) >> 1)) * HE);
#pragma unroll
        EPI_ROWLOOP {
#pragma unroll
            for (int bj = 0; bj < 2; ++bj) { const f32x4 gv = acc[ai][bj][m][0] * sc, uv = acc[ai][bj][m][1] * sc; f32x4 h;
#pragma unroll
                for (int e = 0; e < 4; ++e) h[e] = gv[e] * fast_sigmoid(gv[e]) * uv[e];
                const unsigned ro = so + (unsigned)((ai * HALF + m * 16) * DFF + bj * (HALF / 2)) * HE;
#if !defined(EPI_BUF_STORES)
                if constexpr (FP8_EX) *(unsigned*)((char*)HID + (size_t)ro + lo) = pk4_fp8(h[0], h[1], h[2], h[3]);
                else { u32x2 o; o.x = cvt_pk_bf16(h[0], h[1]); o.y = cvt_pk_bf16(h[2], h[3]); *(u32x2*)((char*)HID + (size_t)ro + lo) = o; }
#else
                if constexpr (FP8_EX) __builtin_amdgcn_raw_buffer_store_b32(pk4_fp8(h[0], h[1], h[2], h[3]), rs, lo, ro, 0);
                else { u32x2 o; o.x = cvt_pk_bf16(h[0], h[1]); o.y = cvt_pk_bf16(h[2], h[3]); __builtin_amdgcn_raw_buffer_store_b64(o, rs, lo, ro, 0); }
#endif
            } }
    }
};
struct EpiDown {
    static constexpr bool PERM = true, BPRE = true;
    bf16_t* Y; const float* gate; float sc;
    __device__ __forceinline__ void operator()(const f32x4 (&acc)[2][2][4][2], const Unit& u, int wr, int wc, int fr, int fq) const {
        const int rowU = u.g * CAP + u.pm * BM + wr * 64;
        const __amdgpu_buffer_rsrc_t rs = __builtin_amdgcn_make_buffer_rsrc((void*)Y, 0, 0x7fffffff, 0x00020000), rg = __builtin_amdgcn_make_buffer_rsrc((void*)gate, 0, 0x7fffffff, 0x00020000);
        const unsigned lo = (unsigned)(fr * DM + 8 * fq) * 2u, so = (unsigned)((rowU * DM + u.pn * BM + wc * 32) * 2);
#pragma unroll
        EPI_ROWLOOP { const int rr = ai * HALF + m * 16;
#if !defined(EPI_BUF_STORES)
            const float gs = gate[rowU + rr + fr] * sc;
#pragma unroll
            for (int bj = 0; bj < 2; ++bj) *(u32x4*)((char*)Y + (size_t)(so + (unsigned)(rr * DM + bj * HALF) * 2u) + lo) = pack8(acc[ai][bj][m][0] * gs, acc[ai][bj][m][1] * gs);
#else
            const float gs = __uint_as_float(__builtin_amdgcn_raw_buffer_load_b32(rg, (unsigned)fr * 4u, (unsigned)(rowU + rr) * 4u, 0)) * sc;
#pragma unroll
            for (int bj = 0; bj < 2; ++bj) __builtin_amdgcn_raw_buffer_store_b128(pack8(acc[ai][bj][m][0] * gs, acc[ai][bj][m][1] * gs), rs, lo, so + (unsigned)(rr * DM + bj * HALF) * 2u, 0);
#endif
        }
    }
};
#undef EPI_ROWLOOP
}
namespace att {
__device__ __forceinline__ int crow(int r, int hi) { return (r & 3) + 8 * (r >> 2) + 4 * hi; }
__device__ __forceinline__ int v_st(int k, int c) { const int kk = (k & ~0xC) | ((k & 4) << 1) | ((k & 8) >> 1); return ((kk >> 3) * 4 + (c >> 5)) * 512 + ((kk & 7) * 32 + (c & 31)) * 2; }
__device__ __forceinline__ int v_rd_base(int lane) { return ((lane & 3) << 3) | (((lane >> 2) & 3) << 6) | (((lane >> 4) & 1) << 5) | (((lane >> 5) & 1) << 8); }
constexpr int v_rd_off(int d0, int ks, int half) { return d0 * 512 + ks * 4096 + half * 2048; }
template <int OFF> __device__ __forceinline__ s16x4 tr_read(int vb) {
    s16x4 r; asm volatile("ds_read_b64_tr_b16 %0, %1 offset:%2" : "=&v"(r) : "v"(vb), "i"(OFF) : "memory"); return r;
}
#define ATT_SBAR() __builtin_amdgcn_sched_barrier(0)
template <int D0> __device__ __forceinline__ void pv_one(f32x16& od, int vb, bf16x8 pa0, bf16x8 pa1, bf16x8 pa2, bf16x8 pa3) {
    const s16x4 l0 = tr_read<v_rd_off(D0, 0, 0)>(vb), h0 = tr_read<v_rd_off(D0, 0, 1)>(vb), l1 = tr_read<v_rd_off(D0, 1, 0)>(vb), h1 = tr_read<v_rd_off(D0, 1, 1)>(vb);
    const s16x4 l2 = tr_read<v_rd_off(D0, 2, 0)>(vb), h2 = tr_read<v_rd_off(D0, 2, 1)>(vb), l3 = tr_read<v_rd_off(D0, 3, 0)>(vb), h3 = tr_read<v_rd_off(D0, 3, 1)>(vb);
    asm volatile("s_waitcnt lgkmcnt(0)" ::: "memory"); ATT_SBAR();
#define ATT_PK(L, H) (bf16x8){L[0], L[1], L[2], L[3], H[0], H[1], H[2], H[3]}
    od = __builtin_amdgcn_mfma_f32_32x32x16_bf16(pa0, ATT_PK(l0, h0), od, 0, 0, 0);
    od = __builtin_amdgcn_mfma_f32_32x32x16_bf16(pa1, ATT_PK(l1, h1), od, 0, 0, 0);
    od = __builtin_amdgcn_mfma_f32_32x32x16_bf16(pa2, ATT_PK(l2, h2), od, 0, 0, 0);
    od = __builtin_amdgcn_mfma_f32_32x32x16_bf16(pa3, ATT_PK(l3, h3), od, 0, 0, 0);
#undef ATT_PK
}
__device__ __forceinline__ void pv_d0(f32x16* o, int vb, bf16x8 pa0, bf16x8 pa1, bf16x8 pa2, bf16x8 pa3) {
    pv_one<0>(o[0], vb, pa0, pa1, pa2, pa3); pv_one<1>(o[1], vb, pa0, pa1, pa2, pa3); pv_one<2>(o[2], vb, pa0, pa1, pa2, pa3); pv_one<3>(o[3], vb, pa0, pa1, pa2, pa3);
}
__device__ __forceinline__ void finishSM(f32x16& p0, f32x16& p1, float alpha, float& l_reg, bf16x8& pa0, bf16x8& pa1, bf16x8& pa2, bf16x8& pa3) {
#pragma unroll
    for (int r = 0; r < 16; ++r) p1[r] = __builtin_amdgcn_exp2f(p1[r]);
    float ps = 0;
#pragma unroll
    for (int r = 0; r < 16; ++r) ps += p0[r];
#pragma unroll
    for (int r = 0; r < 16; ++r) ps += p1[r];
    { auto rr = __builtin_amdgcn_permlane32_swap(__float_as_uint(ps), __float_as_uint(ps), false, false);
      ps = __uint_as_float(rr[0]) + __uint_as_float(rr[1]); }
    l_reg = l_reg * alpha + ps;
#define ATT_PK4(P, BASE, OUT) do { unsigned a0 = cvt_pk_bf16(P[BASE + 0], P[BASE + 1]), a1 = cvt_pk_bf16(P[BASE + 2], P[BASE + 3]);   \
    unsigned b0 = cvt_pk_bf16(P[BASE + 4], P[BASE + 5]), b1 = cvt_pk_bf16(P[BASE + 6], P[BASE + 7]);                              \
    auto r0 = __builtin_amdgcn_permlane32_swap(a0, b0, false, false); auto r1 = __builtin_amdgcn_permlane32_swap(a1, b1, false, false); \
    u32x4 w = {r0[0], r1[0], r0[1], r1[1]}; OUT = *reinterpret_cast<bf16x8*>(&w); } while (0)
    ATT_PK4(p0, 0, pa0); ATT_PK4(p0, 8, pa1); ATT_PK4(p1, 0, pa2); ATT_PK4(p1, 8, pa3);
#undef ATT_PK4
}

struct Unit {
    const bf16_t* Q; int qs;
    const bf16_t* K; int ks;
    const bf16_t* V; int vs;
    bf16_t* O; int os;
    int nt;
    int tmul;
    float* dbg;
    const float* lutg;
    int kt0, ktn;
    int l0;
    const int* pos; int ps;
    float* lse; int ls;
    const float* bias;
};

template <bool DIL> struct Cfg {
    static constexpr bool K8 = DIL && (DIL_FP8 != 0);
    static constexpr int DQK = DIL ? 128 : 192, ND = K8 ? 4 : DQK / 16, KROWB = (K8 ? DQK : DQK * 2) + 16, SHM_K = 64 * KROWB, SHM_V = 16384;
    static constexpr int NKC = DQK / 64;
    static constexpr int OFF_V = 0, OFF_K = 2 * SHM_V, OFF_WS = (OFF_K + 2 * SHM_K > 8 * 8448 ? OFF_K + 2 * SHM_K : 8 * 8448)  , OFF_POS = OFF_WS + NWAVES * 64 * 4, OFF_LUT = OFF_POS + 2 * 64 * 4, END = OFF_LUT + 9216;
    static constexpr float SCALE = DIL ? 0.088388347648318440f : 0.072168783648703220f;
};

template <bool DIL>
__device__ __forceinline__ void qkt(f32x16& p0, f32x16& p1, const LAS char* Ks, const bf16x8* qr, int r32, int hi) {
    using C = Cfg<DIL>;
    p0 = f32x16{}; p1 = f32x16{};
    const LAS char* k0 = Ks + r32 * C::KROWB + hi * 16; const LAS char* k1 = k0 + 32 * C::KROWB;
#pragma unroll
    for (int d0 = 0; d0 < C::ND; ++d0) {
        const bf16x8 b0 = *(const LAS bf16x8*)(k0 + d0 * 32);
        const bf16x8 b1 = *(const LAS bf16x8*)(k1 + d0 * 32);
        p0 = __builtin_amdgcn_mfma_f32_32x32x16_bf16(b0, qr[d0], p0, 0, 0, 0);
        p1 = __builtin_amdgcn_mfma_f32_32x32x16_bf16(b1, qr[d0], p1, 0, 0, 0); }
}

template <bool DIL>
__device__ __forceinline__ void xstage(bool pv, bool qk, f32x16* o, int vb, bf16x8 pa0, bf16x8 pa1, bf16x8 pa2, bf16x8 pa3, f32x16& p0, f32x16& p1, const LAS char* Ks, const bf16x8* qr, int r32, int hi) {
    using C = Cfg<DIL>;
    constexpr int NG = C::ND / 2;
    const LAS char* k0 = Ks + r32 * C::KROWB + hi * (C::K8 ? 32 : 16);
    bf16x8 f[2][4];
    const int ka = (int)(unsigned)(size_t)k0;
#define ATT_KR1(dst_, off_) asm volatile("ds_read_b128 %0, %1 offset:%2" : "=&v"(dst_) : "v"(ka), "i"(off_) : "memory")
#define ATT_KRD(s_, g_) do { if constexpr (C::K8) { ATT_KR1(f[s_][0], 64 * (g_)); ATT_KR1(f[s_][1], 64 * (g_) + 16); ATT_KR1(f[s_][2], 32 * C::KROWB + 64 * (g_)); ATT_KR1(f[s_][3], 32 * C::KROWB + 64 * (g_) + 16); } \
        else { ATT_KR1(f[s_][0], (2 * (g_)) * 32); ATT_KR1(f[s_][1], 32 * C::KROWB + (2 * (g_)) * 32); ATT_KR1(f[s_][2], (2 * (g_) + 1) * 32); ATT_KR1(f[s_][3], 32 * C::KROWB + (2 * (g_) + 1) * 32); } } while (0)
#define ATT_PK(L, H) (bf16x8){L[0], L[1], L[2], L[3], H[0], H[1], H[2], H[3]}
#define ATT_VRD1(B_, s_, ks_) do { const s16x4 l_ = tr_read<v_rd_off(B_, ks_, 0)>(vb), h_ = tr_read<v_rd_off(B_, ks_, 1)>(vb); f[s_][ks_] = ATT_PK(l_, h_); } while (0)
#define ATT_VRD(B_, s_) do { ATT_VRD1(B_, s_, 0); ATT_VRD1(B_, s_, 1); ATT_VRD1(B_, s_, 2); ATT_VRD1(B_, s_, 3); } while (0)
#define ATT_VMMA(B_, s_) do { o[B_] = __builtin_amdgcn_mfma_f32_32x32x16_bf16(pa0, f[s_][0], o[B_], 0, 0, 0); o[B_] = __builtin_amdgcn_mfma_f32_32x32x16_bf16(pa1, f[s_][1], o[B_], 0, 0, 0); \
        o[B_] = __builtin_amdgcn_mfma_f32_32x32x16_bf16(pa2, f[s_][2], o[B_], 0, 0, 0); o[B_] = __builtin_amdgcn_mfma_f32_32x32x16_bf16(pa3, f[s_][3], o[B_], 0, 0, 0); } while (0)
#define ATT_LW(n) asm volatile("s_waitcnt lgkmcnt(" #n ")" ::: "memory")
    if (pv) {
        ATT_VRD(0, 0); ATT_SBAR();
        ATT_VRD(1, 1); ATT_LW(8); ATT_SBAR(); ATT_VMMA(0, 0); ATT_SBAR();
        ATT_VRD(2, 0); ATT_LW(8); ATT_SBAR(); ATT_VMMA(1, 1); ATT_SBAR();
        ATT_VRD(3, 1); ATT_LW(8); ATT_SBAR(); ATT_VMMA(2, 0); ATT_SBAR();
        ATT_KRD(0, 0); ATT_LW(4); ATT_SBAR(); ATT_VMMA(3, 1); ATT_SBAR();
    } else { ATT_KRD(0, 0); ATT_SBAR(); }
    if (!qk) { ATT_LW(0); return; }
    p0 = f32x16{}; p1 = f32x16{};
    if constexpr (C::K8) {
#define ATT_CAT(x_, y_) __builtin_shufflevector(__builtin_bit_cast(i32x4, x_), __builtin_bit_cast(i32x4, y_), 0, 1, 2, 3, 4, 5, 6, 7)
        ATT_KRD(1, 1); ATT_LW(4); ATT_SBAR();
        p0 = __builtin_amdgcn_mfma_scale_f32_32x32x64_f8f6f4(ATT_CAT(f[0][0], f[0][1]), ATT_CAT(qr[0], qr[1]), p0, 0, 0, 0, 0, 0, 0);
        p1 = __builtin_amdgcn_mfma_scale_f32_32x32x64_f8f6f4(ATT_CAT(f[0][2], f[0][3]), ATT_CAT(qr[0], qr[1]), p1, 0, 0, 0, 0, 0, 0);
        ATT_SBAR(); ATT_LW(0); ATT_SBAR();
        p0 = __builtin_amdgcn_mfma_scale_f32_32x32x64_f8f6f4(ATT_CAT(f[1][0], f[1][1]), ATT_CAT(qr[2], qr[3]), p0, 0, 0, 0, 0, 0, 0);
        p1 = __builtin_amdgcn_mfma_scale_f32_32x32x64_f8f6f4(ATT_CAT(f[1][2], f[1][3]), ATT_CAT(qr[2], qr[3]), p1, 0, 0, 0, 0, 0, 0);
        ATT_SBAR();
#undef ATT_CAT
    } else {
#pragma unroll
    for (int g = 0; g < NG; ++g) { const int sg = g & 1;
        if (g + 1 < NG) { ATT_KRD(sg ^ 1, g + 1); ATT_LW(4); } else { ATT_LW(0); }
        ATT_SBAR();
        p0 = __builtin_amdgcn_mfma_f32_32x32x16_bf16(f[sg][0], qr[2 * g], p0, 0, 0, 0);
        p1 = __builtin_amdgcn_mfma_f32_32x32x16_bf16(f[sg][1], qr[2 * g], p1, 0, 0, 0);
        p0 = __builtin_amdgcn_mfma_f32_32x32x16_bf16(f[sg][2], qr[2 * g + 1], p0, 0, 0, 0);
        p1 = __builtin_amdgcn_mfma_f32_32x32x16_bf16(f[sg][3], qr[2 * g + 1], p1, 0, 0, 0);
        ATT_SBAR(); } }
#undef ATT_VRD1
#undef ATT_KRD
#undef ATT_KR1
#undef ATT_VRD
#undef ATT_PK
#undef ATT_VMMA
#undef ATT_LW
}

template <bool DIL>
__device__ __forceinline__ void partialSM(f32x16& p0, f32x16& p1, float& m_reg, float& mn, float& alpha,
                                          const LAS int* posb, int qoff, int lutlo, int dl0, bool masked, int hi) {
    using C = Cfg<DIL>;
    constexpr float CC = C::SCALE * LOG2E;
    constexpr float THR = 8.f;
    float mnC;
    if constexpr (DIL) {
        const LAS float* lutp = (const LAS float*)(size_t)(unsigned)lutlo;
#define ATT_LUT(pk_) ({ int u_ = (pk_) + qoff; u_ = u_ < 0 ? 0 : (u_ > 2048 ? 2048 : u_); lutp[u_ + (u_ >> 5)]; })
        float bz0[16], bz1[16];
#pragma unroll
        for (int a = 0; a < 4; ++a) {
            const i32x4 pk0 = *(const LAS i32x4*)(posb + 8 * a + 4 * hi), pk1 = *(const LAS i32x4*)(posb + 32 + 8 * a + 4 * hi);
#pragma unroll
            for (int b = 0; b < 4; ++b) { bz0[4 * a + b] = ATT_LUT(pk0[b]); bz1[4 * a + b] = ATT_LUT(pk1[b]); }
        }
        ATT_SBAR();
        if (masked) {
#pragma unroll
            for (int r = 0; r < 16; ++r) { const int dl = dl0 + 8 * (r >> 2) + (r & 3);
                p0[r] = ((unsigned)(dl + 64) <= 128u) ? fmaf(p0[r], CC, bz0[r]) : -1e30f;
                p1[r] = ((unsigned)(dl + 32 + 64) <= 128u) ? fmaf(p1[r], CC, bz1[r]) : -1e30f; }
        } else {
#pragma unroll
            for (int r = 0; r < 16; ++r) { p0[r] = fmaf(p0[r], CC, bz0[r]); p1[r] = fmaf(p1[r], CC, bz1[r]); }
        }
#undef ATT_LUT
        float pmax = p0[0];
#pragma unroll
        for (int r = 1; r < 16; ++r) pmax = fmaxf(pmax, p0[r]);
#pragma unroll
        for (int r = 0; r < 16; ++r) pmax = fmaxf(pmax, p1[r]);
        { auto rr = __builtin_amdgcn_permlane32_swap(__float_as_uint(pmax), __float_as_uint(pmax), false, false);
          pmax = fmaxf(__uint_as_float(rr[0]), __uint_as_float(rr[1])); }
        if (__builtin_expect(__all(pmax - m_reg <= THR * LOG2E), 1)) { mn = m_reg; alpha = 1.f; }
        else { mn = fmaxf(m_reg, pmax); alpha = __builtin_amdgcn_exp2f(m_reg - mn); m_reg = mn; }
        mnC = -fmaxf(mn, -1e29f);
#pragma unroll
        for (int r = 0; r < 16; ++r) p0[r] = p0[r] + mnC;
#pragma unroll
        for (int r = 0; r < 16; ++r) p1[r] = p1[r] + mnC;
    } else {
        float pmax = p0[0];
#pragma unroll
        for (int r = 1; r < 16; ++r) pmax = fmaxf(pmax, p0[r]);
#pragma unroll
        for (int r = 0; r < 16; ++r) pmax = fmaxf(pmax, p1[r]);
        { auto rr = __builtin_amdgcn_permlane32_swap(__float_as_uint(pmax), __float_as_uint(pmax), false, false);
          pmax = fmaxf(__uint_as_float(rr[0]), __uint_as_float(rr[1])); }
        if (__builtin_expect(__all(pmax - m_reg <= THR / C::SCALE), 1)) { mn = m_reg; alpha = 1.f; }
        else { mn = fmaxf(m_reg, pmax); alpha = __builtin_amdgcn_exp2f((m_reg - mn) * CC); m_reg = mn; }
        mnC = -mn * CC;
#pragma unroll
        for (int r = 0; r < 16; ++r) p0[r] = fmaf(p0[r], CC, mnC);
#pragma unroll
        for (int r = 0; r < 16; ++r) p1[r] = fmaf(p1[r], CC, mnC);
    }
#pragma unroll
    for (int r = 0; r < 16; ++r) p0[r] = __builtin_amdgcn_exp2f(p0[r]);
}

__device__ __forceinline__ int t5_bucket(int rel) {
    const int n = rel < 0 ? -rel : rel;
    const float nf = (float)(n > 1 ? n : 1);
    int large = 8 + (int)(logf(nf / 8.f) / 4.852030263919617f * 8.f);
    large = large < 15 ? large : 15;
    return (rel > 0 ? 16 : 0) + (n < 8 ? n : large);
}

template <bool DIL>
__device__ __forceinline__ void attn_unit(const Unit& a, LAS char* lds, int wv) {
    using C = Cfg<DIL>;
    constexpr int SD = 1;
    const int tid = opaque_tid(wv), wid = __builtin_amdgcn_readfirstlane(tid >> 6), lane = tid & 63, r32 = lane & 31, hi = lane >> 5;
#if defined(PROBE_TIMING)
    const unsigned long long t_entry = __builtin_amdgcn_s_memtime();
#endif
    LAS char* V_lds = lds + C::OFF_V; LAS char* K_lds = lds + C::OFF_K;
    LAS float* ws = (LAS float*)(lds + C::OFF_WS) + wid * 64; LAS float* li_l = ws; LAS float* al_l = ws + 32;
    LAS int* pos_l = (LAS int*)(lds + C::OFF_POS); LAS float* lut = (LAS float*)(lds + C::OFF_LUT);
    float m_reg = -1e30f, l_reg = 0; f32x16 o[4] = {}; bf16x8 qr[C::ND];
    if constexpr (C::K8) { const char* Qw = (const char*)(a.Q + (size_t)(wid * 32 + r32) * a.qs) + hi * 32;
#pragma unroll
      for (int i = 0; i < 4; ++i) qr[i] = *(const bf16x8*)(Qw + 64 * (i >> 1) + 16 * (i & 1)); }
    else { const bf16_t* Qw = a.Q + (size_t)(wid * 32 + r32) * a.qs + hi * 8;
#pragma unroll
      for (int d0 = 0; d0 < C::ND; ++d0) qr[d0] = *(const bf16x8*)(Qw + d0 * 16); }
    int pq = 0, lq = 0;
    if constexpr (DIL) {
        lq = a.l0 + wid * 32 + r32; pq = a.pos[(size_t)lq * a.ps];
        pq = 1024 - pq;
        { const char* ls = (const char*)a.lutg + lane * 16; LAS char* ld = (LAS char*)lut;
          __builtin_amdgcn_global_load_lds((const unsigned*)(ls + wid * 1024), (LAS unsigned*)(ld + wid * 1024), 16, 0, 0);
          if (wid == 0) __builtin_amdgcn_global_load_lds((const unsigned*)(ls + 8192), (LAS unsigned*)(ld + 8192), 16, 0, 0); }
    }
    constexpr int CPR = C::KROWB / 16, NKP = C::SHM_K / 1024, NKI = (NKP + 7) / 8;
    unsigned kgo[NKI];
#pragma unroll
    for (int i = 0; i < NKI; ++i) { const int pch = (wid + 8 * i) * 64 + lane, kr = pch / CPR, kc = pch % CPR; kgo[i] = (unsigned)(kr * a.ks + (kc == CPR - 1 ? 0 : kc) * 8) * 2u; }
    unsigned vgo[2];
#pragma unroll
    for (int i = 0; i < 2; ++i) { const int pch = (wid + 8 * i) * 64 + lane, sub = pch >> 5, within = pch & 31, kk = (sub >> 2) * 8 + (within >> 2), cc = (sub & 3) * 32 + (within & 3) * 8;
        const int k = (kk & ~0xC) | ((kk & 4) << 1) | ((kk & 8) >> 1); vgo[i] = (unsigned)(k * a.vs + cc) * 2u; }
    const int vb0 = (int)(unsigned)(size_t)V_lds + v_rd_base(lane);
    int ppos = 0, ppos_n = 0;
#define ATT_KROW0(j) (DIL ? (((a.kt0 + (j)) < 0 ? 0 : ((a.kt0 + (j)) >= a.ktn ? a.ktn - 1 : (a.kt0 + (j)))) * 64) : (j) * 64 * a.tmul)
#define ATT_DMAK(j) do { const int k0_ = ATT_KROW0(j); const char* kt_ = (const char*)(a.K + (size_t)k0_ * a.ks); LAS char* kd_ = K_lds + ((j) & 1) * C::SHM_K + wid * 1024; \
        _Pragma("unroll") for (int q_ = 0; q_ < NKI; ++q_) if (wid + 8 * q_ < NKP) \
            __builtin_amdgcn_global_load_lds((const unsigned*)(kt_ + kgo[q_]), (LAS unsigned*)(kd_ + q_ * 8192), 16, 0, 0); } while (0)
#define ATT_DMAV(j) do { const int k0_ = ATT_KROW0(j); const char* vt_ = (const char*)(a.V + (size_t)k0_ * a.vs); LAS char* vd_ = V_lds + ((j) & 1) * C::SHM_V + wid * 1024; \
        __builtin_amdgcn_global_load_lds((const unsigned*)(vt_ + vgo[0]), (LAS unsigned*)(vd_), 16, 0, 0); \
        __builtin_amdgcn_global_load_lds((const unsigned*)(vt_ + vgo[1]), (LAS unsigned*)(vd_ + 8192), 16, 0, 0); } while (0)
#define ATT_LOADPOS(dst_, j) do { if constexpr (DIL) { if (tid < 64) dst_ = a.pos[(size_t)(ATT_KROW0(j) + tid) * a.ps]; } } while (0)
#define ATT_WRITEPOS(j) do { if constexpr (DIL) { if (tid < 64) pos_l[((j) & 1) * 64 + tid] = ppos; } } while (0)
#define ATT_VMW() asm volatile("s_waitcnt vmcnt(0)" ::: "memory")
#define ATT_BAR() do { asm volatile("s_waitcnt lgkmcnt(0)" ::: "memory"); __builtin_amdgcn_s_barrier(); asm volatile("" ::: "memory"); } while (0)
#define ATT_RESC(al) do { if (__any((al) < 1.f)) { if (hi == 0) al_l[r32] = (al); asm volatile("s_waitcnt lgkmcnt(0)" ::: "memory"); \
        _Pragma("unroll") for (int d = 0; d < 4; ++d) _Pragma("unroll") for (int r = 0; r < 16; ++r) o[d][r] *= al_l[crow(r, hi)]; } } while (0)
#define ATT_DL0(j) (DIL ? (ATT_TV(j) ? (64 * (a.kt0 + (j)) - lq + 4 * hi) : 0x20000000) : 0)
#define ATT_TV(j) (DIL ? ((a.kt0 + (j)) >= 0 && (a.kt0 + (j)) < a.ktn) : true)
#define ATT_MASKED(j) (DIL ? ((j) != (wid >> 1) + 1) : false)
    f32x16 p0, p1; float mn, al; bf16x8 pa0, pa1, pa2, pa3; const int NT = a.nt;
    const bool grpB = wid >= 4;
    ATT_DMAK(0); ATT_DMAK(1); ATT_DMAV(0); ATT_LOADPOS(ppos, 0); ATT_VMW(); ATT_WRITEPOS(0); ATT_LOADPOS(ppos, 1);
    __syncthreads();
    if (grpB) ATT_BAR();
#if defined(PROBE_TIMING)
    unsigned long long tacc = 0, tt0 = 0; const unsigned long long tstart = __builtin_amdgcn_s_memtime(), rstart = __builtin_amdgcn_s_memrealtime();
#define TSTAMP() __builtin_amdgcn_s_memtime()
#else
#define TSTAMP() 0ull
#endif
#pragma unroll 1
    for (int j = 0; j < NT; ++j) {
        const int cur = j & 1;
#if defined(PROBE_TIMING)
        tt0 = TSTAMP();
#endif
        if (!grpB && j >= 1) { if (j + 1 < NT) ATT_DMAK(j + 1); ATT_DMAV(j); }
        if constexpr (DIL) { if (!grpB && j + 2 < NT) ATT_LOADPOS(ppos_n, j + 2); }
        ATT_SBAR();
        const bool act = !DIL || (j >= (wid >> 1) && j <= (wid >> 1) + 2), actp = !DIL || (j - 1 >= (wid >> 1) && j - 1 <= (wid >> 1) + 2);
        xstage<DIL>(j > 0 && actp, act, o, vb0 + (cur ^ 1) * (int)C::SHM_V, pa0, pa1, pa2, pa3, p0, p1, K_lds + cur * C::SHM_K, qr, r32, hi);
        ATT_SBAR();
#if defined(PROBE_TIMING) && PROBE_TIMING == 2
        tacc += TSTAMP() - tt0;
#endif
#if defined(PROBE_TIMING) && PROBE_TIMING == 6
        tt0 = TSTAMP();
#endif
        if (grpB) ATT_VMW();
#if defined(PROBE_TIMING) && PROBE_TIMING == 6
        tacc += TSTAMP() - tt0;
#endif
#if defined(PROBE_TIMING) && PROBE_TIMING == 5
        tt0 = TSTAMP();
#endif
        ATT_BAR();
#if defined(PROBE_TIMING) && PROBE_TIMING == 5
        tacc += TSTAMP() - tt0;
#endif
#if defined(PROBE_TIMING) && PROBE_TIMING == 3
        tt0 = TSTAMP();
#endif
        if (grpB) { if (j + 2 < NT) ATT_DMAK(j + 2); if (j + 1 < NT) ATT_DMAV(j + 1); }
        if (act) {
        partialSM<DIL>(p0, p1, m_reg, mn, al, pos_l + cur * 64, pq, (int)(unsigned)(size_t)lut, ATT_DL0(j), ATT_MASKED(j), hi);
        ATT_RESC(al);
        finishSM(p0, p1, al, l_reg, pa0, pa1, pa2, pa3);
        }
        if constexpr (DIL) { if (!grpB && j + 1 < NT) { ATT_WRITEPOS(j + 1); ppos = ppos_n; } }
        ATT_SBAR();
#if defined(PROBE_TIMING) && PROBE_TIMING == 3
        tacc += TSTAMP() - tt0;
#endif
#if defined(PROBE_TIMING) && PROBE_TIMING == 6
        tt0 = TSTAMP();
#endif
        if (!grpB) ATT_VMW();
#if defined(PROBE_TIMING) && PROBE_TIMING == 6
        tacc += TSTAMP() - tt0;
#endif
        ATT_BAR();
    }
#if defined(PROBE_TIMING)
    if (DIL && a.dbg && tid == PROBE_TID && PROBE_TIMING == 8) *a.dbg = (float)(TSTAMP() - tstart) * 1e-6f;
    if (a.dbg && tid == PROBE_TID && PROBE_TIMING < 7) { const unsigned long long tend = TSTAMP(), rend = __builtin_amdgcn_s_memrealtime(); float v;
        if (PROBE_TIMING == 1) v = (float)(tend - tstart) / (float)NT * 1e-5f;
        else if (PROBE_TIMING == 4) v = (float)(tend - tstart) / (float)(rend - rstart) * 1e-3f;
        else v = (float)tacc / (float)NT * 1e-5f;
        *a.dbg = v; }
#endif
    if (!DIL || (NT - 1 <= (wid >> 1) + 2)) pv_d0(o, vb0 + ((NT - 1) & 1) * (int)C::SHM_V, pa0, pa1, pa2, pa3);
    if (!grpB) ATT_BAR();
    ATT_BAR();
    if (hi == 0) li_l[r32] = l_reg; asm volatile("s_waitcnt lgkmcnt(0)" ::: "memory");
    { LAS char* ot = lds + wid * 8448;
#pragma unroll
      for (int r = 0; r < 16; ++r) { const int orow = crow(r, hi); const float rl = __builtin_amdgcn_rcpf(li_l[orow]);
#pragma unroll
          for (int d0 = 0; d0 < 4; ++d0) { const float v = o[d0][r] * rl; *(LAS bf16_t*)(ot + orow * 264 + (d0 * 32 + r32) * 2) = (bf16_t)(cvt_pk_bf16(v, v) & 0xffffu); } }
      asm volatile("s_waitcnt lgkmcnt(0)" ::: "memory");
      char* Ow = (char*)(a.O + (size_t)(wid * 32) * a.os);
      const int orow0 = lane >> 4, ocol = (lane & 15) * 16;
#pragma unroll
      for (int i = 0; i < 8; ++i) { const int orow = orow0 + 4 * i; const u32x2 w0 = *(const LAS u32x2*)(ot + orow * 264 + ocol), w1 = *(const LAS u32x2*)(ot + orow * 264 + ocol + 8);
          u32x4 w; w.x = w0.x; w.y = w0.y; w.z = w1.x; w.w = w1.y;
          *(u32x4*)(Ow + (size_t)orow * a.os * 2 + ocol) = w; } }
    if constexpr (DIL) { if (hi == 0) a.lse[(size_t)(wid * 32 + r32) * a.ls] = m_reg + __builtin_amdgcn_logf(l_reg); }
    __syncthreads();
#if defined(PROBE_TIMING)
    if (DIL && a.dbg && tid == PROBE_TID && PROBE_TIMING == 7) *a.dbg = (float)(__builtin_amdgcn_s_memtime() - t_entry) * 1e-6f;
#endif
#undef ATT_KROW0
#undef ATT_BAR
#undef ATT_DMAK
#undef ATT_DMAV
#undef ATT_LOADPOS
#undef ATT_WRITEPOS
#undef ATT_VMW
#undef ATT_RESC
#undef ATT_DL0
#undef ATT_TV
#undef ATT_MASKED
}
struct Unit8 { const unsigned char* Q; const unsigned char* K; const unsigned char* VT; bf16_t* O; int os, nt; float* dbg; };
__device__ __forceinline__ v8i ld32(const LAS char* p) { return __builtin_shufflevector(*(const LAS i32x4*)p, *(const LAS i32x4*)(p + 16), 0, 1, 2, 3, 4, 5, 6, 7); }
#define ATT8_MFMA(a_, b_, c_) __builtin_amdgcn_mfma_scale_f32_32x32x64_f8f6f4(a_, b_, c_, 0, 0, 0, 0, 0, 0)
__device__ __forceinline__ void attn_mla8_unit(const Unit8& a, LAS char* lds, int wv) {
    constexpr int KROWB = 208, SHM_K = 64 * KROWB  , VROWB = 80, SHM_V = 128 * VROWB  , NKP = 13, NVP = 10;
    constexpr int NSLOT = MLA_2T ? 4 : 3;
    constexpr int OFF_V = 0, OFF_K = NSLOT * SHM_V, OFF_WS = OFF_K + NSLOT * SHM_K;
    static_assert(OFF_WS + 8 * 64 * 4 <= RING_BYTES, "rings and per-wave words inside the ring area");
    static_assert(!(MLA_2T && MLA_PRE), "the fragment prefetch is written for the one-tile interval");
    static_assert(8 * 8448 <= OFF_WS, "output staging images below the per-wave words");
    constexpr float THR2 = 5.0f * LOG2E;
    const int tid = opaque_tid(wv), wid = __builtin_amdgcn_readfirstlane(tid >> 6), lane = tid & 63, r32 = lane & 31, hi = lane >> 5;
    LAS char* V_lds = lds + OFF_V; LAS char* K_lds = lds + OFF_K;
    LAS float* li_l = (LAS float*)(lds + OFF_WS) + wid * 64; LAS float* al_l = li_l + 32;
    float m2 = 0.f, l_reg = 0.f; f32x16 o[4] = {}; v8i qr[3];
    { const unsigned char* Qw = a.Q + (size_t)(wid * 32 + r32) * 192 + hi * 32;
#pragma unroll
      for (int c = 0; c < 3; ++c) qr[c] = __builtin_shufflevector(*(const i32x4*)(Qw + 64 * c), *(const i32x4*)(Qw + 64 * c + 16), 0, 1, 2, 3, 4, 5, 6, 7); }
    unsigned kgo[2], vgo[2];
#pragma unroll
    for (int i = 0; i < 2; ++i) { const int p = (wid + 8 * i) * 64 + lane, kr = p / 13, kc = p % 13; kgo[i] = (unsigned)(kr * 192 + (kc == 12 ? 0 : kc) * 16);
        const int vr = p / 5, vc = p % 5; vgo[i] = (unsigned)(vr * 64 + (vc == 4 ? 0 : vc) * 16); }
#define ATT8_DMAK(j, slot) do { const char* kt_ = (const char*)a.K + (size_t)(j) * 64 * 192; LAS char* kd_ = K_lds + (slot) * SHM_K + wid * 1024; \
        __builtin_amdgcn_global_load_lds((const unsigned*)(kt_ + kgo[0]), (LAS unsigned*)(kd_), 16, 0, 0); \
        if (wid + 8 < NKP) __builtin_amdgcn_global_load_lds((const unsigned*)(kt_ + kgo[1]), (LAS unsigned*)(kd_ + 8192), 16, 0, 0); } while (0)
#define ATT8_DMAV(j, slot) do { const char* vt_ = (const char*)a.VT + (size_t)(j) * 8192; LAS char* vd_ = V_lds + (slot) * SHM_V + wid * 1024; \
        __builtin_amdgcn_global_load_lds((const unsigned*)(vt_ + vgo[0]), (LAS unsigned*)(vd_), 16, 0, 0); \
        if (wid + 8 < NVP) __builtin_amdgcn_global_load_lds((const unsigned*)(vt_ + vgo[1]), (LAS unsigned*)(vd_ + 8192), 16, 0, 0); } while (0)
#define ATT8_VMW() asm volatile("s_waitcnt vmcnt(0)" ::: "memory")
#define ATT8_BAR() do { asm volatile("s_waitcnt lgkmcnt(0)" ::: "memory"); __builtin_amdgcn_s_barrier(); asm volatile("" ::: "memory"); } while (0)
#define ATT8_RD(dst_, addr_, off_) do { i32x4 lo_, hi_; asm volatile("ds_read_b128 %0, %1 offset:%2" : "=&v"(lo_) : "v"(addr_), "i"(off_) : "memory"); \
        asm volatile("ds_read_b128 %0, %1 offset:%2" : "=&v"(hi_) : "v"(addr_), "i"((off_) + 16) : "memory"); dst_ = __builtin_shufflevector(lo_, hi_, 0, 1, 2, 3, 4, 5, 6, 7); } while (0)
#define ATT8_LW(n) asm volatile("s_waitcnt lgkmcnt(" #n ")" ::: "memory")
    const int koff = r32 * KROWB + hi * 32, voff = r32 * VROWB + hi * 32;
    f32x16 p0, p1, nm16; v8i pa = {}; const int NT = a.nt;
#if MLA_LSUM
    f32x16 lacc = {}; v8i ones8; { int c_ = 0x38383838; asm volatile("" : "+v"(c_)); _Pragma("unroll") for (int i = 0; i < 8; ++i) ones8[i] = c_; }
#endif
    const bool grpB = wid >= 4;
    ATT8_DMAK(0, 0); ATT8_DMAK(1, 1); ATT8_DMAV(0, 0); ATT8_VMW();
    __syncthreads();
    int s0 = 0, s1 = 1, s2 = 2;
#define ATT8_ISSUE() do { if (j + 2 < NT) ATT8_DMAK(j + 2, s2); if (j + 1 < NT) ATT8_DMAV(j + 1, s1); } while (0)
#define ATT8_QK6(kb_, G0_, G1_, G2_, C0_, C1_) do { \
        ATT8_RD(G2_, kb_, 64); ATT8_LW(4); ATT_SBAR(); p0 = ATT8_MFMA(G0_, qr[0], C0_); ATT_SBAR(); \
        ATT8_RD(G0_, kb_, 32 * KROWB + 64); ATT8_LW(4); ATT_SBAR(); p1 = ATT8_MFMA(G1_, qr[0], C1_); ATT_SBAR(); \
        ATT8_RD(G1_, kb_, 128); ATT8_LW(4); ATT_SBAR(); p0 = ATT8_MFMA(G2_, qr[1], p0); ATT_SBAR(); \
        ATT8_RD(G2_, kb_, 32 * KROWB + 128); ATT8_LW(4); ATT_SBAR(); p1 = ATT8_MFMA(G0_, qr[1], p1); ATT_SBAR(); \
        ATT8_LW(2); ATT_SBAR(); p0 = ATT8_MFMA(G1_, qr[2], p0); ATT_SBAR(); \
        ATT8_LW(0); ATT_SBAR(); p1 = ATT8_MFMA(G2_, qr[2], p1); ATT_SBAR(); } while (0)
#if MLA_PKOLD
#define ATT8_PK4(w_, P_, q_) do { w_ = __builtin_amdgcn_cvt_pk_fp8_f32(P_[4 * (q_)], P_[4 * (q_) + 1], w_, false); w_ = __builtin_amdgcn_cvt_pk_fp8_f32(P_[4 * (q_) + 2], P_[4 * (q_) + 3], w_, true); } while (0)
#else
#define ATT8_PK4(w_, P_, q_) do { w_ = (int)pk4_fp8(P_[4 * (q_)], P_[4 * (q_) + 1], P_[4 * (q_) + 2], P_[4 * (q_) + 3]); } while (0)
#endif
#define ATT8_PACK() do { _Pragma("unroll") for (int q = 0; q < 4; ++q) { ATT8_PK4(pa[q], p0, q); ATT8_PK4(pa[4 + q], p1, q); } } while (0)
#define ATT8_PAIR(P_, i_) (f32x2){P_[2 * (i_)], P_[2 * (i_) + 1]}
#if MLA_PKADD
#define ATT8_SUM32(ps_) f32x2 pp_ = ATT8_PAIR(p0, 0); _Pragma("unroll") for (int r = 1; r < 8; ++r) pp_ += ATT8_PAIR(p0, r); _Pragma("unroll") for (int r = 0; r < 8; ++r) pp_ += ATT8_PAIR(p1, r); float ps_ = pp_[0] + pp_[1]
#else
#define ATT8_SUM32(ps_) float ps_ = 0.f; _Pragma("unroll") for (int r = 0; r < 16; ++r) ps_ += p0[r]; _Pragma("unroll") for (int r = 0; r < 16; ++r) ps_ += p1[r]
#endif
#if MLA_LSUM
#define ATT8_ROWSUM(al_) do { } while (0)
#define ATT8_LMFMA() lacc = ATT8_MFMA(pa, ones8, lacc)
#define ATT8_LRESC() do { _Pragma("unroll") for (int r = 0; r < 16; ++r) lacc[r] *= al_l[crow(r, hi)]; } while (0)
#else
#define ATT8_LMFMA() do { } while (0)
#define ATT8_LRESC() do { } while (0)
#define ATT8_ROWSUM(al_) do { ATT8_SUM32(ps_); \
        { auto rr = __builtin_amdgcn_permlane32_swap(__float_as_uint(ps_), __float_as_uint(ps_), false, false); ps_ = __uint_as_float(rr[0]) + __uint_as_float(rr[1]); } l_reg = l_reg * (al_) + ps_; } while (0)
#endif
#if MLA_NM16
#define ATT8_INIT() do { const float nm_ = -m2; _Pragma("unroll") for (int r = 0; r < 16; ++r) nm16[r] = nm_; } while (0)
#define ATT8_INIT_SLOW() nm16 -= dl
#define ATT8_INIT_TILE() do { } while (0)
#define ATT8_C0 nm16
#define ATT8_C1 nm16
#else
#define ATT8_INIT() do { } while (0)
#define ATT8_INIT_SLOW() do { } while (0)
#define ATT8_INIT_TILE() do { const float nm_ = -m2; _Pragma("unroll") for (int r = 0; r < 16; ++r) { p0[r] = nm_; p1[r] = nm_; } } while (0)
#define ATT8_C0 p0
#define ATT8_C1 p1
#endif
#define ATT8_ROWMAX(pm_) do { pm_ = p0[0]; _Pragma("unroll") for (int r = 1; r < 16; ++r) pm_ = fmaxf(pm_, p0[r]); _Pragma("unroll") for (int r = 0; r < 16; ++r) pm_ = fmaxf(pm_, p1[r]); \
        { auto rr = __builtin_amdgcn_permlane32_swap(__float_as_uint(pm_), __float_as_uint(pm_), false, false); pm_ = fmaxf(__uint_as_float(rr[0]), __uint_as_float(rr[1])); } } while (0)
#define ATT8_X0() ATT8_X0_(s0)
#define ATT8_X() ATT8_X_(s0, s2)
#define ATT8_X0_(ks_) do { const int kb = (int)(unsigned)(size_t)(K_lds + (ks_) * SHM_K + koff); v8i g0, g1, g2; ATT8_RD(g0, kb, 0); ATT8_RD(g1, kb, 32 * KROWB); ATT8_QK6(kb, g0, g1, g2, f32x16{}, f32x16{}); } while (0)
#if MLA_PRE
#define ATT8_XPRE(vs_) do { const int vb = (int)(unsigned)(size_t)(V_lds + (vs_) * SHM_V + voff); ATT8_RD(g0, vb, 0); ATT8_RD(g1, vb, 32 * VROWB); } while (0)
#define ATT8_XHEAD() do { } while (0)
    v8i g0, g1;
#define ATT8_XDECL() v8i g2
#else
#define ATT8_XPRE(vs_) do { } while (0)
#define ATT8_XHEAD() do { ATT8_RD(g0, vb, 0); ATT8_RD(g1, vb, 32 * VROWB); } while (0)
#define ATT8_XDECL() v8i g0, g1, g2
#endif
#define ATT8_X_(ks_, vs_) do { const int vb = (int)(unsigned)(size_t)(V_lds + (vs_) * SHM_V + voff), kb = (int)(unsigned)(size_t)(K_lds + (ks_) * SHM_K + koff); ATT8_XDECL(); \
        ATT8_XM(); ATT8_XHEAD(); ATT_SBAR(); \
        ATT8_RD(g2, vb, 64 * VROWB); ATT8_LW(4); ATT_SBAR(); o[0] = ATT8_MFMA(pa, g0, o[0]); ATT_SBAR(); \
        ATT8_RD(g0, vb, 96 * VROWB); ATT8_LW(4); ATT_SBAR(); o[1] = ATT8_MFMA(pa, g1, o[1]); ATT_SBAR(); \
        ATT8_RD(g1, kb, 0); ATT8_LW(4); ATT_SBAR(); o[2] = ATT8_MFMA(pa, g2, o[2]); ATT_SBAR(); \
        ATT8_RD(g2, kb, 32 * KROWB); ATT8_LW(4); ATT_SBAR(); o[3] = ATT8_MFMA(pa, g0, o[3]); ATT8_LMFMA(); ATT_SBAR(); \
        ATT8_QK6(kb, g1, g2, g0, ATT8_C0, ATT8_C1); ATT8_XM_END(); } while (0)
#define ATT8_S0() do { float pmax; ATT8_ROWMAX(pmax); m2 = pmax; \
        _Pragma("unroll") for (int r = 0; r < 16; ++r) { p0[r] = __builtin_amdgcn_exp2f(p0[r] - m2); p1[r] = __builtin_amdgcn_exp2f(p1[r] - m2); } \
        ATT8_ROWSUM(1.f); ATT8_PACK(); ATT8_INIT(); ATT8_INIT_TILE(); } while (0)
#if defined(MLA_XVALU)
#define ATT8_XV() do { _Pragma("unroll") for (int r = 0; r < MLA_XVALU; ++r) { float d_; asm volatile("v_exp_f32 %0, %1" : "=v"(d_) : "v"(p0[r & 15])); } } while (0)
#elif defined(MLA_XADD)
#define ATT8_XV() do { _Pragma("unroll") for (int r = 0; r < MLA_XADD; ++r) { float d_; asm volatile("v_add_f32 %0, %1, %1" : "=v"(d_) : "v"(p0[r & 15])); } } while (0)
#else
#define ATT8_XV() do { } while (0)
#endif
#if defined(MLA_XMFMA)
#define ATT8_XM() f32x16 dacc_ = ATT8_MFMA(qr[0], qr[1], f32x16{}); _Pragma("unroll") for (int r = 1; r < MLA_XMFMA; ++r) dacc_ = ATT8_MFMA(qr[0], qr[1], dacc_)
#define ATT8_XM_END() asm volatile("" :: "v"(dacc_))
#else
#define ATT8_XM() do { } while (0)
#define ATT8_XM_END() do { } while (0)
#endif
#define ATT8_S() do { float pmax, al = 1.f; ATT8_XV(); ATT8_ROWMAX(pmax); \
        if (__builtin_expect(!__all(pmax <= THR2), 0)) { \
            const float dl = fmaxf(pmax, 0.f); al = __builtin_amdgcn_exp2f(-dl); m2 += dl; \
            if (hi == 0) al_l[r32] = al; asm volatile("s_waitcnt lgkmcnt(0)" ::: "memory"); \
            _Pragma("unroll") for (int d = 0; d < 4; ++d) _Pragma("unroll") for (int r = 0; r < 16; ++r) o[d][r] *= al_l[crow(r, hi)]; ATT8_LRESC(); \
            _Pragma("unroll") for (int r = 0; r < 16; ++r) { p0[r] -= dl; p1[r] -= dl; } ATT8_INIT_SLOW(); } \
        _Pragma("unroll") for (int r = 0; r < 16; ++r) { p0[r] = __builtin_amdgcn_exp2f(p0[r]); p1[r] = __builtin_amdgcn_exp2f(p1[r]); } \
        ATT8_ROWSUM(al); ATT8_PACK(); ATT8_INIT_TILE(); } while (0)
#define ATT8_ROT() do { const int t_ = s0; s0 = s1; s1 = s2; s2 = t_; } while (0)
#if defined(PROBE_TIMING)
    const unsigned long long tstart8 = __builtin_amdgcn_s_memtime(), rstart8 = __builtin_amdgcn_s_memrealtime(); __builtin_amdgcn_s_waitcnt(0xC07F);
#endif
#if MLA_2T
#define ATT8_ISSUE2(i_) do { const int t_ = 2 * (i_); if (t_ + 2 < NT) { ATT8_DMAK(t_ + 2, (t_ + 2) & 3); ATT8_DMAK(t_ + 3, (t_ + 3) & 3); ATT8_DMAV(t_ + 2, (t_ + 2) & 3); } ATT8_DMAV(t_ + 1, (t_ + 1) & 3); } while (0)
    if (!grpB) {
        { ATT8_ISSUE2(0); ATT_SBAR(); ATT8_X0_(0); ATT_SBAR(); ATT8_S0(); ATT_SBAR(); }
#pragma unroll 1
        for (int j = 1; j < NT; ++j) { if (!(j & 1)) ATT8_ISSUE2(j >> 1); ATT_SBAR(); ATT8_X_(j & 3, (j - 1) & 3); ATT_SBAR(); ATT8_S(); ATT_SBAR(); if (j & 1) { ATT8_VMW(); ATT8_BAR(); } }
    } else {
        { ATT8_ISSUE2(0); ATT_SBAR(); ATT8_X0_(0); ATT_SBAR(); ATT8_S0(); ATT_SBAR(); ATT8_X_(1, 0); ATT_SBAR(); ATT8_VMW(); ATT8_BAR(); }
#pragma unroll 1
        for (int j = 2; j < NT; ++j) { if (!(j & 1)) ATT8_ISSUE2(j >> 1); ATT_SBAR(); ATT8_S(); ATT_SBAR(); ATT8_X_(j & 3, (j - 1) & 3); ATT_SBAR(); if (j & 1) { ATT8_VMW(); ATT8_BAR(); } }
        ATT8_S();
    }
    s2 = (NT - 1) & 3;
#undef ATT8_ISSUE2
#else
    if (!grpB) {
        { const int j = 0; ATT8_ISSUE(); ATT_SBAR(); ATT8_X0(); ATT_SBAR(); ATT8_S0(); ATT_SBAR(); ATT8_XPRE(s0); ATT8_VMW(); ATT8_BAR(); ATT8_ROT(); }
#pragma unroll 1
        for (int j = 1; j < NT; ++j) { ATT8_ISSUE(); ATT_SBAR(); ATT8_X(); ATT_SBAR(); ATT8_S(); ATT_SBAR(); if (j + 1 < NT) ATT8_XPRE(s0); ATT8_VMW(); ATT8_BAR(); ATT8_ROT(); }
    } else {
        { const int j = 0; ATT8_ISSUE(); ATT_SBAR(); ATT8_X0(); ATT_SBAR(); ATT8_VMW(); ATT8_BAR(); ATT8_ROT(); }
        { const int j = 1; ATT8_ISSUE(); ATT8_XPRE(s2); ATT_SBAR(); ATT8_S0(); ATT_SBAR(); ATT8_X(); ATT_SBAR(); ATT8_VMW(); ATT8_BAR(); ATT8_ROT(); }
#pragma unroll 1
        for (int j = 2; j < NT; ++j) { ATT8_ISSUE(); ATT8_XPRE(s2); ATT_SBAR(); ATT8_S(); ATT_SBAR(); ATT8_X(); ATT_SBAR(); ATT8_VMW(); ATT8_BAR(); ATT8_ROT(); }
        ATT8_S();
    }
#endif
#if defined(PROBE_TIMING)
    if (a.dbg && tid == PROBE_TID) { const unsigned long long tend = __builtin_amdgcn_s_memtime(), rend = __builtin_amdgcn_s_memrealtime();
        *a.dbg = PROBE_TIMING == 4 ? __builtin_floorf(((float)(tend - tstart8) / (float)(rend - rstart8) + PROBE_QOFF) * 0.25f) * 4e-2f
                                   : __builtin_rintf((float)(tend - tstart8) / (float)NT * (1.f / 256.f)) * 256e-4f; }
#endif
    { const LAS char* vb = V_lds + s2 * SHM_V + voff;
      o[0] = ATT8_MFMA(pa, ld32(vb), o[0]); o[1] = ATT8_MFMA(pa, ld32(vb + 32 * VROWB), o[1]); o[2] = ATT8_MFMA(pa, ld32(vb + 64 * VROWB), o[2]); o[3] = ATT8_MFMA(pa, ld32(vb + 96 * VROWB), o[3]); ATT8_LMFMA(); }
    ATT8_BAR();
#if !MLA_LSUM
    if (hi == 0) li_l[r32] = l_reg; asm volatile("s_waitcnt lgkmcnt(0)" ::: "memory");
#endif
    { LAS char* ot = lds + wid * 8448;
#pragma unroll
      for (int r = 0; r < 16; ++r) { const int orow = crow(r, hi);
#if MLA_LSUM
          const float rl = __builtin_amdgcn_rcpf(lacc[r]);
#else
          const float rl = __builtin_amdgcn_rcpf(li_l[orow]);
#endif
#pragma unroll
          for (int d0 = 0; d0 < 4; ++d0) { const float v = o[d0][r] * rl; *(LAS bf16_t*)(ot + orow * 264 + (d0 * 32 + r32) * 2) = (bf16_t)(cvt_pk_bf16(v, v) & 0xffffu); } }
      asm volatile("s_waitcnt lgkmcnt(0)" ::: "memory");
      char* Ow = (char*)(a.O + (size_t)(wid * 32) * a.os);
      const int orow0 = lane >> 4, ocol = (lane & 15) * 16;
#pragma unroll
      for (int i = 0; i < 8; ++i) { const int orow = orow0 + 4 * i; const u32x2 w0 = *(const LAS u32x2*)(ot + orow * 264 + ocol), w1 = *(const LAS u32x2*)(ot + orow * 264 + ocol + 8);
          u32x4 w; w.x = w0.x; w.y = w0.y; w.z = w1.x; w.w = w1.y;
          *(u32x4*)(Ow + (size_t)orow * a.os * 2 + ocol) = w; } }
    __syncthreads();
#undef ATT8_DMAK
#undef ATT8_DMAV
#undef ATT8_VMW
#undef ATT8_BAR
#undef ATT8_RD
#undef ATT8_LW
#undef ATT8_ISSUE
#undef ATT8_QK6
#undef ATT8_PACK
#undef ATT8_ROWMAX
#undef ATT8_ROT
#undef ATT8_S
#undef ATT8_S0
#undef ATT8_X
#undef ATT8_X0
#undef ATT8_XPRE
#undef ATT8_XHEAD
#undef ATT8_XDECL
#undef ATT8_X0_
#undef ATT8_X_
#undef ATT8_ROWSUM
#undef ATT8_LMFMA
#undef ATT8_LRESC
#undef ATT8_SUM32
#undef ATT8_INIT_SLOW
#undef ATT8_INIT_TILE
#undef ATT8_C0
#undef ATT8_C1
#undef ATT8_PAIR
#undef ATT8_PK4
#undef ATT8_INIT
}
}
#if defined(MK_CHECK) && MK_CHECK
#ifndef CHK_XOR_ROW
#define CHK_XOR_ROW 0
#endif
namespace chk {
__device__ __forceinline__ float f8(const void* base, size_t idx) { return __builtin_amdgcn_cvt_f32_fp8((int)((const unsigned char*)base)[idx], 0); }
__device__ __forceinline__ float ldQK(const bf16_t* B, int hd, int t, int w) {
    return MLA_FP8 ? f8(B, ((size_t)hd * SEQ + t) * 192 + w) : bf2f(B[((size_t)hd * SEQ + t) * 192 + w]); }
__device__ __forceinline__ float ldV(const bf16_t* B, int hd, int t, int c) {
    if (!MLA_FP8) return bf2f(B[((size_t)hd * SEQ + t) * 128 + c]);
    const int k = t & 63, half = k >> 5, kp = k & 31, kg = (kp >> 2) & 1, r = (kp & 3) + 4 * (kp >> 3), e = r + 16 * half;
    return f8(B, (((size_t)hd * (SEQ / 64) + (t >> 6)) * 128 + c) * 64 + 32 * kg + e); }

__device__ __forceinline__ unsigned hash32(unsigned x) { x ^= x >> 16; x *= 0x7feb352du; x ^= x >> 15; x *= 0x846ca68bu; x ^= x >> 16; return x; }
__device__ __forceinline__ void flag(unsigned* ctl, int bit) { atomicOr(ctl + CW_DBG, 1u << bit); }
__device__ __forceinline__ bool bad_l2(float err2, float ref2, float tol) { err2 = wave_sum(err2); ref2 = wave_sum(ref2); return !(err2 <= tol * tol * ref2 + 1e-12f); }
__device__ __forceinline__ void ref_cos_sin(int pos, int j, float& c, float& s) {
    const float inv = powf(10000.0f, -(float)(2 * j) / 64.0f); const float ang = (float)pos * inv;
    c = (float)cos((double)ang); s = (float)sin((double)ang);
}
__device__ __forceinline__ int ref_bucket(int rel) {
    int ret = rel > 0 ? 16 : 0; int n = rel < 0 ? -rel : rel; float nf = (float)(n < 1 ? 1 : n);
    float v = logf(nf / 8.0f) / 4.852030263919617f * 8.0f; int large = 8 + (int)v; if (large > 15) large = 15;
    return ret + (n < 8 ? n : large);
}
__device__ __forceinline__ void check_proj(const Frame& F, int b, unsigned* ctl, const bf16_t* P, const bf16_t* CQN, const bf16_t* CKVN, const bf16_t* QB, const bf16_t* KB, const bf16_t* VB,
                                           const float* gq, const float* gkv, const float* w_uq, const float* w_ukv, const int* positions) {
    const int lane = opaque_tid(F.wave) & 63;
    for (int smp = F.gw; smp < 4096; smp += F.NGW) {
        const unsigned hsh = hash32(smp * 2654435761u + b * 97u + 12345u);
        const int t = hsh % SEQ, hd = (hsh >> 13) & 7, kind = smp & 3;
        const bf16_t* pr = (const bf16_t*)((const char*)P + (size_t)t * PROW);
        if (kind == 0) {
            float ss = 0.f; for (int k = lane; k < 384; k += 64) { const float v = bf2f(pr[C_CQ + k]); ss += v * v; }
            const float rq = 1.0f / sqrtf(wave_sum(ss) / 384.f + NORM_EPS); float e2 = 0.f, r2 = 0.f;
            for (int k = lane; k < 384; k += 64) { const float ref = bf2f(pr[C_CQ + k]) * rq * gq[k], got = bf2f(CQN[(size_t)t * 384 + k]); e2 += (ref - got) * (ref - got); r2 += ref * ref; }
            if (bad_l2(e2, r2, 0.01f)) flag(ctl, 0);
            ss = 0.f; for (int k = lane; k < 256; k += 64) { const float v = bf2f(pr[C_CKV + k]); ss += v * v; }
            const float rk = 1.0f / sqrtf(wave_sum(ss) / 256.f + NORM_EPS); e2 = 0.f; r2 = 0.f;
            for (int k = lane; k < 256; k += 64) { const float ref = bf2f(pr[C_CKV + k]) * rk * gkv[k], got = bf2f(CKVN[(size_t)t * 256 + k]); e2 += (ref - got) * (ref - got); r2 += ref * ref; }
            if (bad_l2(e2, r2, 0.01f)) flag(ctl, 0);
        } else if (kind == 1) {
            float q[3] = {0.f, 0.f, 0.f};
            for (int k = 0; k < 384; ++k) { const float a = bf2f(CQN[(size_t)t * 384 + k]);
#pragma unroll
                for (int i = 0; i < 3; ++i) q[i] += a * w_uq[(size_t)k * 1536 + hd * 192 + lane + 64 * i]; }
            if (MLA_FP8) { q[0] *= QK_LOG2_SCALE; q[1] *= QK_LOG2_SCALE; q[2] *= QK_LOG2_SCALE; }
            float e2 = 0.f, r2 = 0.f;
#pragma unroll
            for (int i = 0; i < 2; ++i) { const float got = ldQK(QB, hd, t, lane + 64 * i); e2 += (q[i] - got) * (q[i] - got); r2 += q[i] * q[i]; }
            float other; { auto rr = __builtin_amdgcn_permlane32_swap(__float_as_uint(q[2]), __float_as_uint(q[2]), false, false); other = lane < 32 ? __uint_as_float(rr[1]) : __uint_as_float(rr[0]); } float c, s; ref_cos_sin(positions[(size_t)b * SEQ + t], lane & 31, c, s);
            const float x1 = lane < 32 ? q[2] : other, x2 = lane < 32 ? other : q[2];
            const float ref = lane < 32 ? x1 * c - x2 * s : x1 * s + x2 * c;
            const float got = ldQK(QB, hd, t, 128 + 2 * (lane & 31) + (lane >> 5)); e2 += (ref - got) * (ref - got); r2 += ref * ref;
            if (bad_l2(e2, r2, MLA_FP8 ? 0.06f : 0.015f)) flag(ctl, 1);
        } else if (kind == 2) {
            float kk[2] = {0.f, 0.f};
            for (int k = 0; k < 256; ++k) { const float a = bf2f(CKVN[(size_t)t * 256 + k]); kk[0] += a * w_ukv[(size_t)k * 2048 + hd * 256 + lane]; kk[1] += a * w_ukv[(size_t)k * 2048 + hd * 256 + 64 + lane]; }
            float e2 = 0.f, r2 = 0.f;
#pragma unroll
            for (int i = 0; i < 2; ++i) { const float got = ldQK(KB, hd, t, lane + 64 * i); e2 += (kk[i] - got) * (kk[i] - got); r2 += kk[i] * kk[i]; }
            float c, s; ref_cos_sin(positions[(size_t)b * SEQ + t], lane & 31, c, s);
            const float x1 = bf2f(pr[C_KPE + (lane & 31)]), x2 = bf2f(pr[C_KPE + 32 + (lane & 31)]);
            const float ref = lane < 32 ? x1 * c - x2 * s : x1 * s + x2 * c;
            const float got = ldQK(KB, hd, t, 128 + 2 * (lane & 31) + (lane >> 5)); e2 += (ref - got) * (ref - got); r2 += ref * ref;
            if (bad_l2(e2, r2, MLA_FP8 ? 0.06f : 0.015f)) flag(ctl, 2);
        } else {
            float vv[2] = {0.f, 0.f};
            for (int k = 0; k < 256; ++k) { const float a = bf2f(CKVN[(size_t)t * 256 + k]); vv[0] += a * w_ukv[(size_t)k * 2048 + hd * 256 + 128 + lane]; vv[1] += a * w_ukv[(size_t)k * 2048 + hd * 256 + 192 + lane]; }
            float e2 = 0.f, r2 = 0.f;
#pragma unroll
            for (int i = 0; i < 2; ++i) { const float got = ldV(VB, hd, t, lane + 64 * i); e2 += (vv[i] - got) * (vv[i] - got); r2 += vv[i] * vv[i]; }
            if (bad_l2(e2, r2, MLA_FP8 ? 0.06f : 0.015f)) flag(ctl, 3);
        }
    }
}
__device__ __forceinline__ void check_mla(const Frame& F, int b, unsigned* ctl, const bf16_t* QB, const bf16_t* KB, const bf16_t* VB, const bf16_t* OA) {
    const int tid = opaque_tid(F.wave), lane = tid & 63, wave = tid >> 6;
    LAS float* qf = (LAS float*)F.lds;
    LAS float* red = qf + 192;
    LAS float* pp = red + 64;
    LAS float* oacc = pp + SEQ;
    const unsigned hsh = hash32(blockIdx.x * 40503u + b * 977u + 777u);
    const int t = hsh % SEQ, hd = (hsh >> 13) & 7;
#if defined(FORCE_FLAG)
    if (blockIdx.x == 100 && tid == 5 && b == 2) flag(ctl, FORCE_FLAG);
#endif
    __syncthreads();
    if (tid < 192) qf[tid] = ldQK(QB, hd, t, tid);
    __syncthreads();
    float mx = -1e30f;
    for (int k = tid; k < SEQ; k += 512) { float s = 0.f;
        for (int d = 0; d < 192; ++d) s += qf[d] * ldQK(KB, hd, k, d);
        s *= MLA_FP8 ? 0.6931471805599453f : 0.07216878364870322f; pp[k] = s; mx = fmaxf(mx, s); }
    mx = wave_max(mx);
    if (lane == 0) red[wave] = mx;
    __syncthreads();
    mx = red[0]; for (int w = 1; w < 8; ++w) mx = fmaxf(mx, red[w]);
    __syncthreads();
    float sm = 0.f;
    for (int k = tid; k < SEQ; k += 512) { const float p = expf(pp[k] - mx); pp[k] = p; sm += p; }
    sm = wave_sum(sm); if (lane == 0) red[wave] = sm;
    __syncthreads();
    sm = 0.f; for (int w = 0; w < 8; ++w) sm += red[w];
    const int c = tid & 127, part = tid >> 7; float acc = 0.f;
    for (int k = part * 2048; k < part * 2048 + 2048; ++k) acc += pp[k] * ldV(VB, hd, k, c);
    oacc[part * 128 + c] = acc;
    __syncthreads();
    if (tid < 64) { float e2 = 0.f, r2 = 0.f;
#pragma unroll
        for (int i = 0; i < 2; ++i) { const int cc = tid + 64 * i; const float ref = (oacc[cc] + oacc[128 + cc] + oacc[256 + cc] + oacc[384 + cc]) / sm, got = bf2f(OA[(size_t)(t ^ CHK_XOR_ROW) * DM + hd * 128 + cc]);
            e2 += (ref - got) * (ref - got); r2 += ref * ref; }
#if defined(CHK_MEASURE) && CHK_MEASURE == 4
        { const float re = sqrtf(wave_sum(e2) / wave_sum(r2)); int k = (int)floorf(-log2f(re)); k = k < 0 ? 0 : (k > 15 ? 15 : k); flag(ctl, k); }
#else
        if (bad_l2(e2, r2, 0.03f)) flag(ctl, 4);
#endif
    }
    __syncthreads();
}
__device__ __forceinline__ void check_dil(const Frame& F, int b, unsigned* ctl, const bf16_t* P, const int* positions, const float* rel_bias, const bf16_t* OG, const float* LSE) {
    const int tid = opaque_tid(F.wave), lane = tid & 63, wave = tid >> 6;
    LAS float* pw = (LAS float*)F.lds + wave * 256;
    for (int smp = F.gw; smp < 4096; smp += F.NGW) {
        const unsigned hsh = hash32(smp * 2246822519u + b * 131u + 999u);
        int t = hsh % SEQ; const int hd = (hsh >> 13) & 7, grp = (hsh >> 16) % 3, d = grp == 0 ? 1 : (grp == 1 ? 4 : 16);
        if ((smp & 7) == 0) t = (smp >> 3) % 40;
        if ((smp & 7) == 1) t = SEQ - 1 - ((smp >> 3) % 40);
        const char* gb = (const char*)P + P_OFF_DIL + grp * P_GRP;
#define CHK_QK(tok_, part_, e_) (DIL_FP8 ? f8(gb + (size_t)(tok_) * PROW + (part_) * 1024 + hd * 128, (e_)) : bf2f(((const bf16_t*)(gb + (size_t)(tok_) * PROW + (part_) * 2048 + hd * 256))[e_]))
        const int pq = positions[(size_t)b * SEQ + t];
        float sc[3]; float mx = -1e30f;
#pragma unroll
        for (int i = 0; i < 3; ++i) { const int j = lane + 64 * i - 64, tk = t + j * d; sc[i] = -1e30f;
            if (j <= 64 && tk >= 0 && tk < SEQ) { float s = 0.f;
                for (int e = 0; e < 128; ++e) s += CHK_QK(t, 0, e) * CHK_QK(tk, 1, e);
                s = s * 0.08838834764831845f + rel_bias[ref_bucket(positions[(size_t)b * SEQ + tk] - pq) * 24 + grp * 8 + hd]; sc[i] = s; }
            mx = fmaxf(mx, sc[i]); }
        mx = wave_max(mx);
        float sm = 0.f;
#pragma unroll
        for (int i = 0; i < 3; ++i) { const int j = lane + 64 * i; const float p = sc[i] > -1e29f ? expf(sc[i] - mx) : 0.f; if (j < 129) pw[j] = p; sm += p; }
        sm = wave_sum(sm);
        LDS_WAIT();
        float o0 = 0.f, o1 = 0.f;
        for (int j = 0; j < 129; ++j) { const int tk = t + (j - 64) * d; if (tk < 0 || tk >= SEQ) continue; const float p = pw[j]; const bf16_t* vr = (const bf16_t*)(gb + (size_t)tk * PROW + 2048 * P_QK_ESZ + hd * 256);
            o0 += p * bf2f(vr[lane]); o1 += p * bf2f(vr[64 + lane]); }
        o0 /= sm; o1 /= sm;
        const float g0 = bf2f(OG[((size_t)grp * SEQ + t) * DM + hd * 128 + lane]), g1 = bf2f(OG[((size_t)grp * SEQ + t) * DM + hd * 128 + 64 + lane]);
        if (bad_l2((o0 - g0) * (o0 - g0) + (o1 - g1) * (o1 - g1), o0 * o0 + o1 * o1, 0.03f)) flag(ctl, 5);
        const float lse2 = (mx + logf(sm)) * LOG2E, got = LSE[((size_t)grp * SEQ + t) * 8 + hd];
        if (!(fabsf(lse2 - got) <= 0.05f)) flag(ctl, 6);
        LDS_WAIT();
    }
}
__device__ __forceinline__ void check_u(const Frame& F, int b, unsigned* ctl, const bf16_t* P, const bf16_t* OA, const bf16_t* OG, const float* LSE, const bf16_t* Ub) {
    const int lane = opaque_tid(F.wave) & 63;
    for (int smp = F.gw; smp < 2048; smp += F.NGW) {
        const int t = hash32(smp * 374761393u + b * 31u + 5u) % SEQ; float e2 = 0.f, r2 = 0.f;
        for (int c = lane; c < DM; c += 64) { const int hd = c >> 7;
            const float l0 = LSE[((size_t)0 * SEQ + t) * 8 + hd], l1 = LSE[((size_t)1 * SEQ + t) * 8 + hd], l2 = LSE[((size_t)2 * SEQ + t) * 8 + hd], mx = fmaxf(l0, fmaxf(l1, l2));
            const float w0 = exp2f(l0 - mx), w1 = exp2f(l1 - mx), w2 = exp2f(l2 - mx), ws_ = w0 + w1 + w2;
            const float ob = (w0 * bf2f(OG[((size_t)0 * SEQ + t) * DM + c]) + w1 * bf2f(OG[((size_t)1 * SEQ + t) * DM + c]) + w2 * bf2f(OG[((size_t)2 * SEQ + t) * DM + c])) / ws_;
            const bf16_t* gr = (const bf16_t*)((const char*)P + (size_t)t * PROW + P_OFF_GATE); const float ga = 1.f / (1.f + expf(-bf2f(gr[c]))), gb = 1.f / (1.f + expf(-bf2f(gr[1024 + c])));
            const float ref = ga * bf2f(OA[(size_t)t * DM + c]) + gb * ob, got = bf2f(Ub[(size_t)t * DM + c]); e2 += (ref - got) * (ref - got); r2 += ref * ref; }
        if (bad_l2(e2, r2, 0.01f)) flag(ctl, 7);
    }
}
}
#endif
template <bool F8, class F>
__device__ __forceinline__ void transpose_item(F colptr, int ldn, void* WT, int ldk, int k0, int n0, LAS float* scr, int lane) {
    const float* cp = colptr(n0 + (lane & 31));
    float tv[32];
    const float* cpk = cp ? cp + (size_t)(k0 + (lane >> 5)) * ldn : nullptr;
#pragma unroll
    for (int i = 0; i < 32; ++i) tv[i] = cpk ? cpk[(size_t)(2 * i) * ldn] : 0.f;
#pragma unroll
    for (int i = 0; i < 32; ++i) scr[(2 * i + (lane >> 5)) * 33 + (lane & 31)] = tv[i];
    LDS_WAIT(); asm volatile("" ::: "memory");
    const int c = lane & 7;
#pragma unroll
    for (int j = 0; j < 4; ++j) { const int n = (lane >> 3) + 8 * j; const LAS float* s = scr + (8 * c) * 33 + n;
        if constexpr (F8) { u32x2 o; o.x = pk4_fp8(s[0 * 33] * W8_SCALE, s[1 * 33] * W8_SCALE, s[2 * 33] * W8_SCALE, s[3 * 33] * W8_SCALE); o.y = pk4_fp8(s[4 * 33] * W8_SCALE, s[5 * 33] * W8_SCALE, s[6 * 33] * W8_SCALE, s[7 * 33] * W8_SCALE);
            *(u32x2*)((char*)WT + (size_t)(n0 + n) * ldk + k0 + 8 * c) = o; }
        else { u32x4 o; o.x = cvt_pk_bf16(s[0 * 33], s[1 * 33]); o.y = cvt_pk_bf16(s[2 * 33], s[3 * 33]); o.z = cvt_pk_bf16(s[4 * 33], s[5 * 33]); o.w = cvt_pk_bf16(s[6 * 33], s[7 * 33]);
            *(u32x4*)((bf16_t*)WT + (size_t)(n0 + n) * ldk + k0 + 8 * c) = o; } }
    LDS_WAIT(); asm volatile("" ::: "memory");
}

__device__ __forceinline__ void p0_mod(const Frame& F, const float* c, const float* w_ada, const float* b_ada, float* mod) {
    const int tid = opaque_tid(F.wave), lane = tid & 63; (void)tid; (void)lane;
    LAS float* red = (LAS float*)F.lds;
    LAS float* sl = (LAS float*)(F.lds + 8192);
    if ((int)blockIdx.x < 96) {
        for (int i = tid; i < 4096; i += 512) { const float cv = c[i]; sl[i] = cv * fast_sigmoid(cv); }
        __syncthreads();
    }
    for (int blk = blockIdx.x; blk < 96; blk += F.G) {
        const int col = blk * 64 + (tid & 63), ks = tid >> 6;
        float a0 = 0.f, a1 = 0.f, a2 = 0.f, a3 = 0.f;
#pragma unroll 1
        for (int k0 = ks * 128; k0 < ks * 128 + 128; k0 += 16) { float w[16];
#pragma unroll
            for (int i = 0; i < 16; ++i) w[i] = w_ada[(size_t)(k0 + i) * 6144 + col];
#pragma unroll
            for (int i = 0; i < 16; ++i) { const int k = k0 + i; a0 += sl[k] * w[i]; a1 += sl[1024 + k] * w[i]; a2 += sl[2048 + k] * w[i]; a3 += sl[3072 + k] * w[i]; } }
        red[(ks * 4 + 0) * 64 + (tid & 63)] = a0; red[(ks * 4 + 1) * 64 + (tid & 63)] = a1; red[(ks * 4 + 2) * 64 + (tid & 63)] = a2; red[(ks * 4 + 3) * 64 + (tid & 63)] = a3;
        __syncthreads();
        if (tid < 256) { const int b = tid >> 6, cc = tid & 63; float s = 0.f;
#pragma unroll
            for (int q = 0; q < 8; ++q) s += red[(q * 4 + b) * 64 + cc];
            mod[b * 6144 + blk * 64 + cc] = s + b_ada[blk * 64 + cc]; }
        __syncthreads();
    }
}
__device__ __forceinline__ void p0_cs(const Frame& F, const int* pos, float* cs) {
    const int tid = opaque_tid(F.wave), lane = tid & 63; (void)tid; (void)lane;
    for (int i = (int)blockIdx.x * 512 + tid; i < NTOK * 32; i += F.G * 512) {
        const int t = i >> 5, j = i & 31;
        const float inv = __builtin_amdgcn_exp2f(-(float)(2 * j) / 64.f * 13.287712379549449f);
        const float ang = (float)pos[t] * inv;
        const double rev = (double)ang * 0.15915494309189535; const double fr = rev - __builtin_rint(rev);
        const float f = (float)fr;
        f32x2 o; o.x = __builtin_amdgcn_cosf(f); o.y = __builtin_amdgcn_sinf(f);
        *(f32x2*)(cs + (size_t)i * 2) = o;
    }
}
__device__ __forceinline__ void p0_lut(const Frame& F, const float* rel_bias, float* lutg) {
    const int tid = opaque_tid(F.wave);
    for (int i = (int)blockIdx.x * 512 + tid; i < 24 * 2049; i += F.G * 512) { const int l = i / 2049, u = i - l * 2049;
        lutg[l * 2304 + u + (u >> 5)] = rel_bias[att::t5_bucket(u - 1024) * 24 + l] * LOG2E; }
}
__device__ __forceinline__ void p0_weights(const Frame& F, const float* w_in, const float* w_uq, const float* w_ukv, const float* w_out, unsigned char* ws) {
    const int tid = opaque_tid(F.wave), lane = tid & 63; (void)tid; (void)lane;
    LAS float* scr = (LAS float*)(F.lds + F.wave * 16384);
    constexpr int I_IN = 16 * 376, I_UQ = 6 * 48, I_UKV = 4 * 64, I_OUT = 16 * 32;
    for (int it = F.gw; it < I_IN + I_UQ + I_UKV + I_OUT; it += F.NGW) {
        int r = it;
        if (r < I_IN) { const int kb = r / 376, nb = r % 376;
            transpose_item<(FP8_G1 != 0)>([=](int np) -> const float* { const int n = (np & ~31) + pg8::perm32(np & 31); return n < D_IN ? w_in + n : nullptr; }, D_IN, (void*)(ws + WS_WIN), 1024, kb * 64, nb * 32, scr, lane); continue; }
        r -= I_IN;
        if (r < I_UQ) { const int kb = r / 48, nb = r % 48;
            transpose_item<false>([=](int n) -> const float* { const int hd = n / 192, w = n - hd * 192; const int sc = w < 128 ? w : 128 + ((w - 128) >> 1) + 32 * ((w - 128) & 1); return w_uq + hd * 192 + sc; },
                           1536, (bf16_t*)(ws + WS_WUQ), 384, kb * 64, nb * 32, scr, lane); continue; }
        r -= I_UQ;
        if (r < I_UKV) { const int kb = r / 64, nb = r % 64;
            transpose_item<false>([=](int n) -> const float* { const int m = n & 1023; return w_ukv + (MLA_FP8 ? ((m >> 7) * 256 + (n >> 10) * 128 + (m & 127)) : n); }, 2048, (bf16_t*)(ws + WS_WUKV), 256, kb * 64, nb * 32, scr, lane); continue; }
        r -= I_UKV;
        { const int kb = r / 32, nb = r % 32;
            transpose_item<(FP8_WO != 0)>([=](int n) -> const float* { return w_out + n; }, 1024, (void*)(ws + WS_WOUT), 1024, kb * 64, nb * 32, scr, lane); }
    }
}
__device__ __forceinline__ void conv_experts(const Frame& F, const float* w_gate, const float* w_up, const float* w_down, unsigned char* ws) {
    static_assert(FP8_EX != 0, "fp8 expert operands");
    const int tid = opaque_tid(F.wave), lane = tid & 63; (void)tid;
    LAS float* scr = (LAS float*)(F.lds + F.wave * 16384);
    constexpr int N_IT = NE * 1536;
    const long du = (const char*)w_up - (const char*)w_gate;
    const int lr = lane >> 4, lf = lane & 15;
#define CE_LOAD(it_, tv_) do { const int e_ = (it_) / 1536, r_ = (it_) % 1536; const float* p_; int ldn_; \
        if (r_ < 1024) { const int a_ = r_ >> 9, kb_ = (r_ >> 5) & 15, cb_ = r_ & 31; \
            p_ = (const float*)((const char*)w_gate + (a_ ? du : 0L)) + (size_t)e_ * DM * DFF + (size_t)(kb_ * 64 + lr) * DFF + cb_ * 64 + 4 * lf; ldn_ = DFF; } \
        else { const int r2_ = r_ - 1024, kb_ = r2_ >> 4, cb_ = r2_ & 15; p_ = w_down + (size_t)e_ * DFF * DM + (size_t)(kb_ * 64 + lr) * DM + cb_ * 64 + 4 * lf; ldn_ = DM; } \
        _Pragma("unroll") for (int i = 0; i < 16; ++i) tv_[i] = *(const f32x4*)(p_ + (size_t)(4 * i) * ldn_); } while (0)
#define CE_STORE(it_, tv_) do { const int e_ = (it_) / 1536, r_ = (it_) % 1536; unsigned char* wt_; int ldk_; \
        _Pragma("unroll") for (int i = 0; i < 16; ++i) { LAS float* d_ = scr + (lr + 4 * i) * 64 + ((4 * lf) ^ (4 * ((i >> 1) & 7))); d_[0 ^ lr] = tv_[i][0]; d_[1 ^ lr] = tv_[i][1]; d_[2 ^ lr] = tv_[i][2]; d_[3 ^ lr] = tv_[i][3]; } \
        LDS_WAIT(); asm volatile("" ::: "memory"); \
        const int c_ = lane & 7; int rowb_, a16_; bool dn_; \
        if (r_ < 1024) { const int a_ = r_ >> 9, kb_ = (r_ >> 5) & 15, cb_ = r_ & 31; wt_ = ws + WS_WGU + (size_t)e_ * 4096 * 1024 + kb_ * 64 + 8 * c_; ldk_ = 1024; rowb_ = 128 * cb_; a16_ = 16 * a_; dn_ = false; } \
        else { const int r2_ = r_ - 1024, kb_ = r2_ >> 4, cb_ = r2_ & 15; wt_ = ws + WS_WD + (size_t)e_ * 1024 * 2048 + kb_ * 64 + 8 * c_; ldk_ = 2048; rowb_ = 64 * cb_; a16_ = 0; dn_ = true; } \
        _Pragma("unroll") for (int j = 0; j < 8; ++j) { const int cc_ = (lane >> 3) + 8 * j; const LAS float* s_ = scr + (8 * c_) * 64; const int x0_ = cc_ ^ (4 * c_); u32x2 o_; \
            const int s5_ = cc_ & 31; \
            const int row_ = dn_ ? rowb_ + (cc_ & 32) + 16 * ((s5_ >> 2) & 1) + 4 * (s5_ >> 3) + (s5_ & 3) : rowb_ + 32 * (cc_ >> 4) + a16_ + (cc_ & 15); \
            o_.x = pk4_fp8(s_[0 * 64 + (x0_ ^ 0)] * W8_SCALE, s_[1 * 64 + (x0_ ^ 1)] * W8_SCALE, s_[2 * 64 + (x0_ ^ 2)] * W8_SCALE, s_[3 * 64 + (x0_ ^ 3)] * W8_SCALE); \
            o_.y = pk4_fp8(s_[4 * 64 + (x0_ ^ 0)] * W8_SCALE, s_[5 * 64 + (x0_ ^ 1)] * W8_SCALE, s_[6 * 64 + (x0_ ^ 2)] * W8_SCALE, s_[7 * 64 + (x0_ ^ 3)] * W8_SCALE); \
            *(u32x2*)(wt_ + (size_t)row_ * ldk_) = o_; } \
        LDS_WAIT(); asm volatile("" ::: "memory"); } while (0)
    f32x4 tva[16], tvb[16];
    int it = F.gw;
    if (it < N_IT) CE_LOAD(it, tva);
#pragma unroll 1
    while (it < N_IT) {
        const int it2 = it + F.NGW, it3 = it2 + F.NGW;
        if (it2 < N_IT) CE_LOAD(it2, tvb);
        CE_STORE(it, tva);
        if (it2 < N_IT) { if (it3 < N_IT) CE_LOAD(it3, tva); CE_STORE(it2, tvb); }
        it = it3;
    }
#undef CE_LOAD
#undef CE_STORE
}
__device__ __forceinline__ void norm_mod_row(const float* xrow, const float* g, const float* sh, const float* sc, int lane, f32x4 (&v)[4]) {
    float s = 0.f;
#pragma unroll
    for (int j = 0; j < 4; ++j) { v[j] = *(const f32x4*)(xrow + 4 * lane + 256 * j); s += (v[j][0] * v[j][0] + v[j][1] * v[j][1]) + (v[j][2] * v[j][2] + v[j][3] * v[j][3]); }
    const float rstd = 1.0f / sqrtf(wave_sum(s) * (1.f / DM) + NORM_EPS);
#pragma unroll
    for (int j = 0; j < 4; ++j) { const int c = 4 * lane + 256 * j; const f32x4 gg = *(const f32x4*)(g + c), s1 = *(const f32x4*)(sc + c), s0 = *(const f32x4*)(sh + c);
        v[j] = (v[j] * rstd * gg) * (s1 + 1.0f) + s0; }
}
__device__ __forceinline__ void store_row_bf16(bf16_t* orow, int lane, const f32x4 (&v)[4]) {
#pragma unroll
    for (int j = 0; j < 4; ++j) { u32x2 o; o.x = cvt_pk_bf16(v[j][0], v[j][1]); o.y = cvt_pk_bf16(v[j][2], v[j][3]); *(u32x2*)(orow + 4 * lane + 256 * j) = o; }
}
template <bool F8> __device__ __forceinline__ void store_row_act(void* orow, int lane, const f32x4 (&v)[4]) {
    if constexpr (F8) {
#pragma unroll
        for (int j = 0; j < 4; ++j) *(unsigned*)((char*)orow + 4 * lane + 256 * j) = pk4_fp8(v[j][0], v[j][1], v[j][2], v[j][3]);
    } else store_row_bf16((bf16_t*)orow, lane, v);
}
__device__ __forceinline__ void p1_h(const Frame& F, const float* x, const float* g, const float* mod, bf16_t* H) {
    const int tid = opaque_tid(F.wave), lane = tid & 63; (void)tid; (void)lane;
    f32x4 gg[4], vn[4], shn[4], scn[4];
    int t = F.gw;
#pragma unroll
    for (int j = 0; j < 4; ++j) { const int c = 4 * lane + 256 * j; gg[j] = *(const f32x4*)(g + c);
        if (t < NTOK) { const int b = t / SEQ; vn[j] = *(const f32x4*)(x + (size_t)t * DM + c); shn[j] = *(const f32x4*)(mod + b * 6144 + c); scn[j] = *(const f32x4*)(mod + b * 6144 + 1024 + c); } }
#pragma unroll 1
    for (; t < NTOK; t += F.NGW) { f32x4 v[4], sh[4], sc[4];
#pragma unroll
        for (int j = 0; j < 4; ++j) { v[j] = vn[j]; sh[j] = shn[j]; sc[j] = scn[j]; }
        const int tn = t + F.NGW;
        if (tn < NTOK) { const int bn = tn / SEQ;
#pragma unroll
            for (int j = 0; j < 4; ++j) { const int c = 4 * lane + 256 * j; vn[j] = *(const f32x4*)(x + (size_t)tn * DM + c); shn[j] = *(const f32x4*)(mod + bn * 6144 + c); scn[j] = *(const f32x4*)(mod + bn * 6144 + 1024 + c); } }
        float ss = 0.f;
#pragma unroll
        for (int j = 0; j < 4; ++j) ss += (v[j][0] * v[j][0] + v[j][1] * v[j][1]) + (v[j][2] * v[j][2] + v[j][3] * v[j][3]);
        const float rstd = 1.0f / sqrtf(wave_sum(ss) * (1.f / DM) + NORM_EPS);
#pragma unroll
        for (int j = 0; j < 4; ++j) v[j] = (v[j] * rstd * gg[j]) * (sc[j] + 1.0f) + sh[j];
        store_row_act<(FP8_G1 != 0)>((char*)H + (size_t)t * DM * (FP8_G1 ? 1 : 2), lane, v); }
}
__device__ __forceinline__ void lb_latent(const Frame& F, const bf16_t* P, const float* gq, const float* gkv, const float* cs, bf16_t* CQN, bf16_t* CKVN, bf16_t* KB) {
    const int tid = opaque_tid(F.wave), lane = tid & 63; (void)tid; (void)lane;
    f32x4 gq0 = {}, gq1 = {}, gk0 = {}, gk1 = {};
    if (lane < 48) { gq0 = *(const f32x4*)(gq + 8 * lane); gq1 = *(const f32x4*)(gq + 8 * lane + 4); }
    if (lane < 32) { gk0 = *(const f32x4*)(gkv + 8 * lane); gk1 = *(const f32x4*)(gkv + 8 * lane + 4); }
#pragma unroll 1
    for (int tb = F.gw; tb < SEQ; tb += 4 * F.NGW) {
        u32x4 wq[4], wk[4]; float xa[4], xb[4]; f32x2 cc[4];
#pragma unroll
        for (int i = 0; i < 4; ++i) { const int t = tb + i * F.NGW; wq[i] = (u32x4){0u, 0u, 0u, 0u}; wk[i] = wq[i]; xa[i] = 0.f; xb[i] = 0.f; cc[i] = (f32x2){0.f, 0.f};
            if (t < SEQ) { const bf16_t* pr = (const bf16_t*)((const char*)P + (size_t)t * PROW);
                if (lane < 48) wq[i] = *(const u32x4*)(pr + C_CQ + 8 * lane);
                if (lane < 32) { wk[i] = *(const u32x4*)(pr + C_CKV + 8 * lane); xa[i] = bf2f(pr[C_KPE + lane]); xb[i] = bf2f(pr[C_KPE + 32 + lane]); cc[i] = *(const f32x2*)(cs + ((size_t)t * 32 + lane) * 2); } } }
#pragma unroll
        for (int i = 0; i < 4; ++i) { const int t = tb + i * F.NGW; if (t >= SEQ) break;
            float q[8], s = 0.f;
            { const u32x4 w = wq[i]; q[0] = bflo(w.x); q[1] = bfhi(w.x); q[2] = bflo(w.y); q[3] = bfhi(w.y); q[4] = bflo(w.z); q[5] = bfhi(w.z); q[6] = bflo(w.w); q[7] = bfhi(w.w);
#pragma unroll
              for (int e = 0; e < 8; ++e) s += q[e] * q[e]; }
            const float rq = 1.0f / sqrtf(wave_sum(s) * (1.f / 384.f) + NORM_EPS);
            if (lane < 48) { u32x4 o; o.x = cvt_pk_bf16(q[0] * rq * gq0[0], q[1] * rq * gq0[1]); o.y = cvt_pk_bf16(q[2] * rq * gq0[2], q[3] * rq * gq0[3]);
                o.z = cvt_pk_bf16(q[4] * rq * gq1[0], q[5] * rq * gq1[1]); o.w = cvt_pk_bf16(q[6] * rq * gq1[2], q[7] * rq * gq1[3]);
                *(u32x4*)(CQN + (size_t)t * 384 + 8 * lane) = o; }
            float s2 = 0.f;
            { const u32x4 w = wk[i]; q[0] = bflo(w.x); q[1] = bfhi(w.x); q[2] = bflo(w.y); q[3] = bfhi(w.y); q[4] = bflo(w.z); q[5] = bfhi(w.z); q[6] = bflo(w.w); q[7] = bfhi(w.w);
#pragma unroll
              for (int e = 0; e < 8; ++e) s2 += q[e] * q[e]; }
            const float rk = 1.0f / sqrtf(wave_sum(s2) * (1.f / 256.f) + NORM_EPS);
            if (lane < 32) { u32x4 o; o.x = cvt_pk_bf16(q[0] * rk * gk0[0], q[1] * rk * gk0[1]); o.y = cvt_pk_bf16(q[2] * rk * gk0[2], q[3] * rk * gk0[3]);
                o.z = cvt_pk_bf16(q[4] * rk * gk1[0], q[5] * rk * gk1[1]); o.w = cvt_pk_bf16(q[6] * rk * gk1[2], q[7] * rk * gk1[3]);
                *(u32x4*)(CKVN + (size_t)t * 256 + 8 * lane) = o;
                const float x1 = xa[i], x2 = xb[i]; const f32x2 c = cc[i];
                if constexpr (MLA_FP8) { const unsigned short pk8 = (unsigned short)(__builtin_amdgcn_cvt_pk_fp8_f32(x1 * c.x - x2 * c.y, x1 * c.y + x2 * c.x, 0, false) & 0xffff);
#pragma unroll
                    for (int h = 0; h < 8; ++h) *(unsigned short*)((unsigned char*)KB + ((size_t)h * SEQ + t) * 192 + 128 + 2 * lane) = pk8; }
                else { const unsigned pk = cvt_pk_bf16(x1 * c.x - x2 * c.y, x1 * c.y + x2 * c.x);
#pragma unroll
                    for (int h = 0; h < 8; ++h) *(unsigned*)(KB + ((size_t)h * SEQ + t) * 192 + 128 + 2 * lane) = pk; } }
        }
    }
}
__device__ __forceinline__ void lb_combine(const Frame& F, const bf16_t* P, const bf16_t* OA, const bf16_t* OG, const float* LSE, bf16_t* U) {
    const int tid = opaque_tid(F.wave), lane = tid & 63; (void)tid; (void)lane;
#pragma unroll 2
    for (int t = F.gw; t < SEQ; t += F.NGW) {
#pragma unroll
        for (int j = 0; j < 2; ++j) { const int c0 = 8 * lane + 512 * j, hd = c0 >> 7;
            const float l0 = LSE[((size_t)0 * SEQ + t) * 8 + hd], l1 = LSE[((size_t)1 * SEQ + t) * 8 + hd], l2 = LSE[((size_t)2 * SEQ + t) * 8 + hd];
            const float mx = fmaxf(l0, fmaxf(l1, l2)); float w0 = __builtin_amdgcn_exp2f(l0 - mx), w1 = __builtin_amdgcn_exp2f(l1 - mx), w2 = __builtin_amdgcn_exp2f(l2 - mx);
            const float inv = 1.0f / (w0 + w1 + w2); w0 *= inv; w1 *= inv; w2 *= inv;
            const u32x4 oa = *(const u32x4*)(OA + (size_t)t * DM + c0), g0 = *(const u32x4*)(OG + ((size_t)0 * SEQ + t) * DM + c0), g1 = *(const u32x4*)(OG + ((size_t)1 * SEQ + t) * DM + c0),
                        g2 = *(const u32x4*)(OG + ((size_t)2 * SEQ + t) * DM + c0), ga = *(const u32x4*)((const char*)P + (size_t)t * PROW + P_OFF_GATE + 2 * c0), gb = *(const u32x4*)((const char*)P + (size_t)t * PROW + P_OFF_GATE + 2048 + 2 * c0);
            u32x4 o; float uf[8];
#pragma unroll
            for (int e = 0; e < 4; ++e) {
                const float ob_lo = w0 * bflo(g0[e]) + w1 * bflo(g1[e]) + w2 * bflo(g2[e]), ob_hi = w0 * bfhi(g0[e]) + w1 * bfhi(g1[e]) + w2 * bfhi(g2[e]);
                const float u_lo = fast_sigmoid(bflo(ga[e])) * bflo(oa[e]) + fast_sigmoid(bflo(gb[e])) * ob_lo;
                const float u_hi = fast_sigmoid(bfhi(ga[e])) * bfhi(oa[e]) + fast_sigmoid(bfhi(gb[e])) * ob_hi;
                if constexpr (FP8_WO) { uf[2 * e] = u_lo * U8_SCALE; uf[2 * e + 1] = u_hi * U8_SCALE; } else o[e] = cvt_pk_bf16(u_lo, u_hi); }
            if constexpr (FP8_WO) { u32x2 o8; o8.x = pk4_fp8(uf[0], uf[1], uf[2], uf[3]); o8.y = pk4_fp8(uf[4], uf[5], uf[6], uf[7]); *(u32x2*)((unsigned char*)U + (size_t)t * DM + c0) = o8; }
            else *(u32x4*)(U + (size_t)t * DM + c0) = o; }
    }
}
__device__ __forceinline__ void pg_h2_router(const Frame& F, const float* x1, const float* g, const float* mod, const float* w_router, bf16_t* H2, float* AFFT) {
    const int tid = opaque_tid(F.wave), lane = tid & 63; (void)tid;
    LAS float* wr = (LAS float*)F.lds;
    LAS float* ab = (LAS float*)(F.lds + 65536) + F.wave * 256;
    for (int i = tid; i < 1024 * 16 / 4; i += 512) { const int c = i >> 2, k = i & 3, rho = (c & 3) * 256 + (c >> 2);
        ((LAS f32x4*)wr)[rho * 4 + ((k + (rho >> 2)) & 3)] = ((const f32x4*)w_router)[i]; }
    __syncthreads();
    int roff[4];
#pragma unroll
    for (int k = 0; k < 4; ++k) roff[k] = ((k + (lane >> 2)) & 3) * 4;
    for (int ch = F.gw; ch < NTOK / 16; ch += F.NGW) {
        const int t0 = ch * 16, b = t0 / SEQ, s0 = t0 % SEQ;
        f32x4 vn[4], gg[4], sc1[4], sh0[4];
#pragma unroll
        for (int j = 0; j < 4; ++j) { const int c = 4 * lane + 256 * j; vn[j] = *(const f32x4*)(x1 + (size_t)t0 * DM + c);
            gg[j] = *(const f32x4*)(g + c); sh0[j] = *(const f32x4*)(mod + b * 6144 + 3072 + c); sc1[j] = *(const f32x4*)(mod + b * 6144 + 4096 + c); }
#pragma unroll 1
        for (int ti = 0; ti < 16; ++ti) { const int t = t0 + ti; f32x4 v[4];
#pragma unroll
            for (int j = 0; j < 4; ++j) v[j] = vn[j];
            if (ti + 1 < 16) {
#pragma unroll
                for (int j = 0; j < 4; ++j) vn[j] = *(const f32x4*)(x1 + (size_t)(t + 1) * DM + 4 * lane + 256 * j); }
            { float ss = 0.f;
#pragma unroll
              for (int j = 0; j < 4; ++j) ss += (v[j][0] * v[j][0] + v[j][1] * v[j][1]) + (v[j][2] * v[j][2] + v[j][3] * v[j][3]);
              const float rstd = 1.0f / sqrtf(wave_sum(ss) * (1.f / DM) + NORM_EPS);
#pragma unroll
              for (int j = 0; j < 4; ++j) v[j] = (v[j] * rstd * gg[j]) * (sc1[j] + 1.0f) + sh0[j]; }
            store_row_act<(FP8_EX != 0)>((char*)H2 + (size_t)t * DM * (FP8_EX ? 1 : 2), lane, v);
            float lg[16];
#pragma unroll
            for (int e = 0; e < 16; ++e) lg[e] = 0.f;
#pragma unroll
            for (int j = 0; j < 4; ++j)
#pragma unroll
                for (int q = 0; q < 4; ++q) { const LAS float* wp = wr + (q * 256 + lane + 64 * j) * 16; const float hv = v[j][q];
#pragma unroll
                    for (int e4 = 0; e4 < 4; ++e4) { const f32x4 w = *(const LAS f32x4*)(wp + roff[e4]); lg[4 * e4 + 0] += hv * w[0]; lg[4 * e4 + 1] += hv * w[1]; lg[4 * e4 + 2] += hv * w[2]; lg[4 * e4 + 3] += hv * w[3]; } }
            float mx = -1e30f;
#pragma unroll
            for (int e = 0; e < 16; ++e) { lg[e] = wave_sum(lg[e]); mx = fmaxf(mx, lg[e]); }
            float sum = 0.f;
#pragma unroll
            for (int e = 0; e < 16; ++e) { lg[e] = __expf(lg[e] - mx); sum += lg[e]; }
            const float inv = 1.0f / sum; float mine = 0.f;
#pragma unroll
            for (int e = 0; e < 16; ++e) mine = (lane == e) ? lg[e] * inv : mine;
            if (lane < 16) ab[lane * 16 + ti] = mine;
        }
        LDS_WAIT();
        { const int e = lane >> 2, q4 = (lane & 3) * 4; const f32x4 w = *(const LAS f32x4*)(ab + e * 16 + q4);
          *(f32x4*)(AFFT + ((size_t)b * NE + e) * SEQ + s0 + q4) = w; }
        LDS_WAIT();
    }
    __syncthreads();
}
__device__ __forceinline__ void ph_topk(const Frame& F, const float* AFFT, int* TOPI, float* TOPG, int* SLOT) {
    const int tid = opaque_tid(F.wave), lane = tid & 63;
    LAS unsigned* cnt = (LAS unsigned*)F.lds;
    LAS unsigned* wtot = cnt + 64;
    for (int p = blockIdx.x; p < NB * NE; p += F.G) {
        const float* src = AFFT + (size_t)p * SEQ + 16 * tid;
        unsigned key[16];
#pragma unroll
        for (int j = 0; j < 4; ++j) { const u32x4 w = *(const u32x4*)(src + 4 * j); key[4 * j] = w.x; key[4 * j + 1] = w.y; key[4 * j + 2] = w.z; key[4 * j + 3] = w.w; }
        unsigned thr = 0u;
#pragma unroll 1
        for (int bit = 30; bit >= 0; --bit) { const unsigned cand = thr | (1u << bit); unsigned c = 0;
#pragma unroll
            for (int i = 0; i < 16; ++i) c += (unsigned)__builtin_popcountll(__ballot(key[i] >= cand));
            LAS unsigned* slot = cnt + ((bit & 1) << 3);
            if (lane == 0) slot[F.wave] = c;
            __syncthreads();
            unsigned tot = 0;
#pragma unroll
            for (int w = 0; w < 8; ++w) tot += slot[w];
            if (tot >= (unsigned)CAP) thr = cand; }
        unsigned ngt = 0, neq = 0;
#pragma unroll
        for (int i = 0; i < 16; ++i) { ngt += key[i] > thr ? 1u : 0u; neq += key[i] == thr ? 1u : 0u; }
        unsigned pk = ngt | (neq << 16), inc = pk;
#pragma unroll
        for (int o = 1; o < 64; o <<= 1) { const unsigned v = (unsigned)__builtin_amdgcn_ds_bpermute((lane - o) << 2, (int)inc); if (lane >= o) inc += v; }
        __syncthreads();
        if (lane == 63) wtot[F.wave] = inc;
        __syncthreads();
        unsigned base = 0, all = 0;
        for (int w = 0; w < 8; ++w) { const unsigned v = wtot[w]; all += v; if (w < F.wave) base += v; }
        const unsigned tot_gt = all & 0xffffu, need = (unsigned)CAP - tot_gt;
        const unsigned excl = base + inc - pk; unsigned g_before = excl & 0xffffu, e_before = excl >> 16;
#pragma unroll
        for (int i = 0; i < 16; ++i) { const int s = 16 * tid + i; int slot = -1;
            if (key[i] > thr) { slot = (int)g_before; ++g_before; }
            else if (key[i] == thr) { if (e_before < need) slot = (int)(tot_gt + e_before); ++e_before; }
            SLOT[(size_t)p * SEQ + s] = slot;
            if (slot >= 0) { TOPI[p * CAP + slot] = (p >> 4) * SEQ + s; TOPG[p * CAP + slot] = __uint_as_float(key[i]); } }
        __syncthreads();
    }
}
__device__ __forceinline__ void p_final(const Frame& F, float* out, const float* mod, const int* SLOT, const bf16_t* Y, const float* gfin, float oscale) {
    const int tid = opaque_tid(F.wave), lane = tid & 63; (void)tid;
    f32x4 gf[4], xn[4], gtn[4]; int sln = -1;
#pragma unroll
    for (int j = 0; j < 4; ++j) gf[j] = *(const f32x4*)(gfin + 4 * lane + 256 * j);
    int r = F.gw;
    if (r < NTOK) { const int b = r / SEQ, s = r % SEQ; if (lane < NE) sln = SLOT[((size_t)b * NE + lane) * SEQ + s];
#pragma unroll
        for (int j = 0; j < 4; ++j) { const int c = 4 * lane + 256 * j; xn[j] = *(const f32x4*)(out + (size_t)r * DM + c); gtn[j] = *(const f32x4*)(mod + b * 6144 + 5120 + c); } }
#pragma unroll 1
    for (; r < NTOK; r += F.NGW) { const int b = r / SEQ; float* row = out + (size_t)r * DM;
        const int sl = sln; f32x4 x[4], gt[4];
#pragma unroll
        for (int j = 0; j < 4; ++j) { x[j] = xn[j]; gt[j] = gtn[j]; }
        const int rn = r + F.NGW;
        if (rn < NTOK) { const int bn = rn / SEQ, sn = rn % SEQ; sln = -1; if (lane < NE) sln = SLOT[((size_t)bn * NE + lane) * SEQ + sn];
#pragma unroll
            for (int j = 0; j < 4; ++j) { const int c = 4 * lane + 256 * j; xn[j] = *(const f32x4*)(out + (size_t)rn * DM + c); gtn[j] = *(const f32x4*)(mod + bn * 6144 + 5120 + c); } }
        unsigned long long m = __ballot(sl >= 0);
        f32x4 acc[4];
#pragma unroll
        for (int j = 0; j < 4; ++j) acc[j] = (f32x4){0.f, 0.f, 0.f, 0.f};
        while (m) { const int e = __builtin_ctzll(m); m &= m - 1; const int slot = __builtin_amdgcn_readlane(sl, e);
            const bf16_t* yr = Y + (((size_t)b * NE + e) * CAP + slot) * DM;
#pragma unroll
            for (int j = 0; j < 4; ++j) { const u32x2 w = *(const u32x2*)(yr + 4 * lane + 256 * j); acc[j][0] += bflo(w.x); acc[j][1] += bfhi(w.x); acc[j][2] += bflo(w.y); acc[j][3] += bfhi(w.y); } }
        f32x4 v[4]; float ss = 0.f;
#pragma unroll
        for (int j = 0; j < 4; ++j) { v[j] = x[j] + gt[j] * acc[j]; ss += (v[j][0] * v[j][0] + v[j][1] * v[j][1]) + (v[j][2] * v[j][2] + v[j][3] * v[j][3]); }
        const float rstd = 1.0f / sqrtf(wave_sum(ss) * (1.f / DM) + NORM_EPS);
#pragma unroll
        for (int j = 0; j < 4; ++j) { const int c = 4 * lane + 256 * j; f32x4 ov = v[j] * (rstd * oscale) * gf[j];
#if defined(MK_CHECK) && MK_CHECK
#pragma unroll
            for (int e = 0; e < 4; ++e) if (!(ov[e] == ov[e]) || fabsf(ov[e]) > 1e6f) ov[e] = 0.f;
#endif
            *(f32x4*)(row + c) = ov; }
    }
}

__global__ void __launch_bounds__(NWAVES * 64, 2) fwd_kernel(Args args) {
    extern __shared__ __attribute__((aligned(16))) unsigned char lds_raw[];
    Frame F;
    F.lds = (LAS unsigned char*)lds_raw;
    F.wave = __builtin_amdgcn_readfirstlane((int)threadIdx.x >> 6); F.tid = opaque_tid(F.wave); F.lane = F.tid & 63;
    F.G = gridDim.x; { const int bx = blockIdx.x; F.vcu = (F.G % 8 == 0) ? (bx % 8) * (F.G / 8) + bx / 8 : bx; }
    F.gw = F.vcu * NWAVES + F.wave; F.NGW = F.G * NWAVES;
    unsigned char* ws = args.ws;
    volatile LAS unsigned* MISC = (volatile LAS unsigned*)(F.lds + MISC_OFF);
    for (int u = F.tid; u < (LDS_BYTES - RING_BYTES) / 4; u += NWAVES * 64) ((LAS unsigned*)(F.lds + RING_BYTES))[u] = 0u;
    __syncthreads();
    unsigned* ctl = (unsigned*)(ws + WS_CTL);
    XcdBarrier bar = xcd_barrier_post(ctl + CW_BAR, MISC + 8); bar.wv = F.wave;

#define IN_F(k) ((const float*)args.in[k])
#define in_x IN_F(0)
#define cin IN_F(1)
#define positions ((const int*)args.in[2])
#define w_ada IN_F(3)
#define b_ada IN_F(4)
#define g_mix IN_F(5)
#define w_in IN_F(6)
#define g_q IN_F(7)
#define g_kv IN_F(8)
#define w_uq IN_F(9)
#define w_ukv IN_F(10)
#define rel_bias IN_F(11)
#define w_out IN_F(12)
#define g_ffn IN_F(13)
#define w_router IN_F(14)
#define w_gate IN_F(15)
#define w_up IN_F(16)
#define w_down IN_F(17)
#define g_final IN_F(18)
#define t_out (args.out)
#define WSP(T, off) ((T*)(args.ws + (off)))
#define MOD WSP(float, WS_MOD)
#define CS WSP(float, WS_CS)
#define WIN WSP(bf16_t, WS_WIN)
#define WUQ WSP(bf16_t, WS_WUQ)
#define WUKV WSP(bf16_t, WS_WUKV)
#define WOUT WSP(bf16_t, WS_WOUT)
#define t_H WSP(bf16_t, WS_H)
#define t_U WSP(bf16_t, WS_U)
#define t_P WSP(bf16_t, WS_P)
#define CQN WSP(bf16_t, WS_CQN)
#define CKVN WSP(bf16_t, WS_CKVN)
#define QB WSP(bf16_t, WS_QB)
#define KB WSP(bf16_t, WS_KB)
#define VB WSP(bf16_t, WS_VB)
#define OA WSP(bf16_t, WS_OA)
#define OG WSP(bf16_t, WS_OG)
#define LSE WSP(float, WS_LSE)
#define WGU WSP(bf16_t, WS_WGU)
#define WD WSP(bf16_t, WS_WD)
#define HID WSP(bf16_t, WS_HID)
#define t_Y WSP(bf16_t, WS_Y)
#define AFFT WSP(float, WS_AFFT)
#define TOPI WSP(int, WS_TOPI)
#define TOPG WSP(float, WS_TOPG)
#define SLOT WSP(int, WS_SLOT)

#ifndef PH_MASK
#define PH_MASK 0xFFFFFFFFu
#endif
#define PH_ON(k) constexpr (((PH_MASK) >> (k)) & 1u)
#ifndef DUP_MASK
#define DUP_MASK 0u
#endif
#define PH_REP(k) for (int rep_ = 0; rep_ < ((((DUP_MASK) >> (k)) & 1u) ? 2 : 1); ++rep_)
#if defined(PROBE_TIMING)
#define DBG_SCALE() (1.0f + __uint_as_float(__hip_atomic_load(ctl + CW_DBG + 1, RLX_AGENT)))
#elif defined(MK_CHECK) && MK_CHECK
#define DBG_SCALE() ([&]() -> float { const unsigned f_ = __hip_atomic_load(ctl + CW_DBG, RLX_AGENT); return f_ ? 1.0f + 0.05f * (float)(1 + __builtin_ctz(f_)) : 1.0f; }())
#else
#define DBG_SCALE() 1.0f
#endif
    int step = 0; const int lo = args.st_lo, hi = args.st_hi;
#if defined(PROBE_STEP)
#define STEP_BEGIN if (step >= lo && step < hi) { const unsigned long long rt0_ = __builtin_amdgcn_s_memrealtime();
#define STEP_END if (step + 1 < hi) xcd_barrier(bar); if (step == PROBE_STEP && blockIdx.x == 0 && F.wave == 0 && opaque_tid(0) == 0) { \
        const float us_ = (float)(__builtin_amdgcn_s_memrealtime() - rt0_) * 0.01f; *(float*)(ctl + CW_DBG + 1) = __builtin_rintf((us_ + PROBE_QOFF) * (1.f / 16.f)) * 8e-3f; } } ++step;
#else
#define STEP_BEGIN if (step >= lo && step < hi) {
#endif
#if defined(PROBE_STEP)
#elif defined(PROBE_DBLBAR)
#define STEP_END if (step + 1 < hi) { xcd_barrier(bar); xcd_barrier(bar); } } ++step;
#else
#define STEP_END if (step + 1 < hi) xcd_barrier(bar); } ++step;
#endif

    STEP_BEGIN
        if PH_ON(0) PH_REP(0) { p0_mod(F, cin, w_ada, b_ada, MOD);
        p0_cs(F, positions, CS);
        p0_lut(F, rel_bias, (float*)(ws + WS_LUT));
        p0_weights(F, w_in, w_uq, w_ukv, w_out, ws); }
    STEP_END
    STEP_BEGIN
        if PH_ON(1) PH_REP(1) p1_h(F, in_x, g_mix, MOD, t_H);
    STEP_END
    for (int b = 0; b < NB; ++b) {
        STEP_BEGIN
            pg8::Gemm g{(const bf16_t*)((const char*)t_H + (size_t)b * SEQ * DM * (FP8_G1 ? 1 : 2)), WIN, DM, DM, DM, 0, 0, nullptr, 0, 0}; pg8::StaticOrder S; S.init(SEQ, NP, F.G, (int)blockIdx.x);
            pg8::EpiP E{(unsigned char*)t_P, FP8_G1 ? W8_INV : 1.0f, 0};
            if PH_ON(2) PH_REP(2) {
#if defined(PROBE_NOSTORE)
                E.nostore = (rep_ == 0);
#endif
                pg8::gemm_phase<pg8::EpiP, pg8::StaticOrder, false, (FP8_G1 != 0)>(F.lds, F.wave, g, S, E); __syncthreads(); }
        STEP_END
        STEP_BEGIN
            if PH_ON(3) PH_REP(3) lb_latent(F, t_P, g_q, g_kv, CS + (size_t)b * SEQ * 64, CQN, CKVN, KB);
        STEP_END
        STEP_BEGIN
#if MLA_FP8
            { pg8::Gemm g{CQN, WUQ, 384, 384, 384, 0, 0, nullptr, 0, 0}; pg8::StaticOrder S; S.init(SEQ, 1536, F.G, (int)blockIdx.x);
              pg8::EpiQ8 E{(unsigned char*)QB, CS + (size_t)b * SEQ * 64};
              if PH_ON(4) PH_REP(4) { pg8::gemm_phase<pg8::EpiQ8, pg8::StaticOrder, false>(F.lds, F.wave, g, S, E); __syncthreads(); } }
            { pg8::Gemm g{CKVN, WUKV, 256, 256, 256, 0, 0, nullptr, 0, 0}; pg8::StaticOrder S; S.init(SEQ, 1024, F.G, (int)blockIdx.x);
              pg8::EpiK8 E{(unsigned char*)KB};
              if PH_ON(5) PH_REP(5) { pg8::gemm_phase<pg8::EpiK8, pg8::StaticOrder, false>(F.lds, F.wave, g, S, E); __syncthreads(); } }
            { pg8::Gemm g{WUKV + (size_t)1024 * 256, CKVN, 256, 256, 256, 0, 0, nullptr, 0, 0}; pg8::StaticOrder S; S.init(1024, SEQ, F.G, (int)((blockIdx.x + 128) % F.G));
              pg8::EpiVT8 E{(unsigned char*)VB};
              if PH_ON(5) PH_REP(5) { pg8::gemm_phase<pg8::EpiVT8, pg8::StaticOrder, false>(F.lds, F.wave, g, S, E); __syncthreads(); } }
#else
            { pg8::Gemm g{CQN, WUQ, 384, 384, 384, 0, 0, nullptr, 0, 0}; pg8::StaticOrder S; S.init(SEQ, 1536, F.G, (int)blockIdx.x);
              pg8::EpiQ E{QB, CS + (size_t)b * SEQ * 64};
              if PH_ON(4) PH_REP(4) { pg8::gemm_phase<pg8::EpiQ, pg8::StaticOrder, false>(F.lds, F.wave, g, S, E); __syncthreads(); } }
            __syncthreads();
            { pg8::Gemm g{CKVN, WUKV, 256, 256, 256, 0, 0, nullptr, 0, 0}; pg8::StaticOrder S; S.init(SEQ, 2048, F.G, (int)blockIdx.x);
              pg8::EpiKV E{KB, VB};
              if PH_ON(5) PH_REP(5) { pg8::gemm_phase<pg8::EpiKV, pg8::StaticOrder, false>(F.lds, F.wave, g, S, E); __syncthreads(); } }
#endif
        STEP_END
        STEP_BEGIN
            for (int u = blockIdx.x; u < 256; u += F.G) { const int hd = u & 7, qb = u >> 3;
#if MLA_FP8
                att::Unit8 a8{(const unsigned char*)QB + ((size_t)hd * SEQ + 256 * qb) * 192, (const unsigned char*)KB + (size_t)hd * SEQ * 192, (const unsigned char*)VB + (size_t)hd * SEQ * 128,
                              OA + (size_t)(256 * qb) * DM + hd * 128, DM, SEQ / 64, nullptr};
#if defined(PROBE_TIMING)
                a8.dbg = (blockIdx.x == PROBE_BLOCK && b == 3) ? (float*)(ctl + CW_DBG + 1) : nullptr;
#endif
                if PH_ON(6) PH_REP(6) att::attn_mla8_unit(a8, (LAS char*)F.lds, F.wave);
#else
                att::Unit a{};
                a.Q = QB + ((size_t)hd * SEQ + 256 * qb) * 192; a.qs = 192; a.K = KB + (size_t)hd * SEQ * 192; a.ks = 192; a.V = VB + (size_t)hd * SEQ * 128; a.vs = 128;
                a.O = OA + (size_t)(256 * qb) * DM + hd * 128; a.os = DM; a.nt = SEQ / 64;
#if defined(BREAK_MLA) && BREAK_MLA
                a.nt = SEQ / 64 - 2;
#endif
                a.tmul = 1;
#if defined(PROBE_TIMING)
                a.dbg = (blockIdx.x == PROBE_BLOCK && b == 3) ? (float*)(ctl + CW_DBG + 1) : nullptr;
#endif
#if defined(PROBE_SAMETILE)
                a.tmul = 0; att::attn_unit<false>(a, (LAS char*)F.lds, F.wave); a.tmul = 1;
#endif
                if PH_ON(6) PH_REP(6) att::attn_unit<false>(a, (LAS char*)F.lds, F.wave);
#endif
            }

            for (int u = blockIdx.x; u < 768; u += F.G) { const int grp = u >> 8, w = u & 255, hd = w & 7, rest = w >> 3, d = grp == 0 ? 1 : (grp == 1 ? 4 : 16), cl = rest % d, qb = rest / d;
                att::Unit a{};
                const size_t tok0 = (size_t)256 * qb * d + cl; const char* gbase = (const char*)t_P + P_OFF_DIL + grp * P_GRP;
                a.Q = (const bf16_t*)(gbase + tok0 * PROW + hd * 128 * P_QK_ESZ); a.qs = d * (PROW / 2);
                a.K = (const bf16_t*)(gbase + (size_t)cl * PROW + 1024 * P_QK_ESZ + hd * 128 * P_QK_ESZ); a.ks = d * (PROW / 2);
                a.V = (const bf16_t*)(gbase + (size_t)cl * PROW + 2048 * P_QK_ESZ + hd * 256); a.vs = d * (PROW / 2);
                a.O = OG + ((size_t)grp * SEQ + tok0) * DM + hd * 128; a.os = d * DM; a.nt = 6; a.tmul = 1;
#if defined(PROBE_TIMING)
                a.dbg = (blockIdx.x == PROBE_BLOCK && b == 3 && grp == PROBE_GRP) ? (float*)(ctl + CW_DBG + 1) : nullptr;
#endif
                a.kt0 = 4 * qb - 1; a.ktn = (SEQ / d) / 64; a.l0 = 256 * qb; a.pos = positions + (size_t)b * SEQ + cl; a.ps = d;
                a.lse = LSE + ((size_t)grp * SEQ + tok0) * 8 + hd; a.ls = d * 8; a.bias = rel_bias + grp * 8 + hd; a.lutg = (const float*)(ws + WS_LUT) + (grp * 8 + hd) * 2304;
                if PH_ON(7) PH_REP(7) att::attn_unit<true>(a, (LAS char*)F.lds, F.wave); }
        STEP_END
        STEP_BEGIN
            if PH_ON(8) PH_REP(8) lb_combine(F, t_P, OA, OG, LSE, (bf16_t*)((char*)t_U + (size_t)b * SEQ * DM * (FP8_WO ? 1 : 2)));
        STEP_END
#if defined(MK_CHECK) && MK_CHECK
        STEP_BEGIN
#if !defined(CHK_MEASURE) && !defined(CHK_ONLY_DIL)
            chk::check_proj(F, b, ctl, t_P, CQN, CKVN, QB, KB, VB, g_q, g_kv, w_uq, w_ukv, positions);
            chk::check_dil(F, b, ctl, t_P, positions, rel_bias, OG, LSE);
            chk::check_u(F, b, ctl, t_P, OA, OG, LSE, t_U + (size_t)b * SEQ * DM);
#endif
#if defined(CHK_ONLY_DIL)
            chk::check_dil(F, b, ctl, t_P, positions, rel_bias, OG, LSE);
#else
            chk::check_mla(F, b, ctl, QB, KB, VB, OA);
#endif
        STEP_END
#endif
    }
    STEP_BEGIN
        { pg8::Gemm g{t_U, WOUT, DM, DM, DM, 0, 0, nullptr, 0, 0}; pg8::StaticOrder S; S.init(NTOK, DM, F.G, (int)blockIdx.x);
          pg8::EpiRes E{in_x, t_out, MOD, FP8_WO ? W8_INV * (1.0f / U8_SCALE) : 1.0f};
          if PH_ON(9) PH_REP(9) { pg8::gemm_phase<pg8::EpiRes, pg8::StaticOrder, false, (FP8_WO != 0)>(F.lds, F.wave, g, S, E); __syncthreads(); } }
        __syncthreads();
        if PH_ON(10) PH_REP(10) conv_experts(F, w_gate, w_up, w_down, ws);
    STEP_END
    STEP_BEGIN
        if PH_ON(11) PH_REP(11) pg_h2_router(F, t_out, g_ffn, MOD, w_router, t_H, AFFT);
    STEP_END
    STEP_BEGIN
        if PH_ON(12) PH_REP(12) ph_topk(F, AFFT, TOPI, TOPG, SLOT);
    STEP_END
    static_assert(FP8_EX != 0, "the all-batch FFN workspace map assumes fp8 expert operands");
    STEP_BEGIN
        { pg8::Gemm g{t_H, WGU, DM, DM, DM, 0, (long)4096 * 1024, TOPI, CAP, NE}; pg8::GroupOrder S; S.init(4, 16, NB * NE, F.G, (int)blockIdx.x);
          pg8::EpiSwiGLU E{(void*)HID, W8_INV};
          if PH_ON(13) PH_REP(13) { pg8::gemm_phase<pg8::EpiSwiGLU, pg8::GroupOrder, true, true>(F.lds, F.wave, g, S, E); __syncthreads(); } }
    STEP_END
    STEP_BEGIN
        { pg8::Gemm g{HID, WD, DFF, DFF, DFF, (long)CAP * DFF, (long)DM * DFF, nullptr, 0, NE}; pg8::GroupOrder S; S.init(4, 4, NB * NE, F.G, (int)blockIdx.x);
          pg8::EpiDown E{t_Y, TOPG, W8_INV};
          if PH_ON(14) PH_REP(14) { pg8::gemm_phase<pg8::EpiDown, pg8::GroupOrder, false, true>(F.lds, F.wave, g, S, E); __syncthreads(); } }
    STEP_END
    STEP_BEGIN
        if PH_ON(15) p_final(F, t_out, MOD, SLOT, t_Y, g_final, DBG_SCALE());
    STEP_END
#undef STEP_BEGIN
#undef STEP_END
}
#undef IN_F
#undef in_x
#undef cin
#undef positions
#undef w_ada
#undef b_ada
#undef g_mix
#undef w_in
#undef g_q
#undef g_kv
#undef w_uq
#undef w_ukv
#undef rel_bias
#undef w_out
#undef g_ffn
#undef w_router
#undef w_gate
#undef w_up
#undef w_down
#undef g_final
#undef t_out
#undef WSP
#undef MOD
#undef CS
#undef WIN
#undef WUQ
#undef WUKV
#undef WOUT
#undef t_H
#undef t_U
#undef t_P
#undef CQN
#undef CKVN
#undef QB
#undef KB
#undef VB
#undef OA
#undef OG
#undef LSE
#undef WGU
#undef WD
#undef HID
#undef t_Y
#undef AFFT
#undef TOPI
#undef TOPG
#undef SLOT
constexpr int STEPS_MIX = 5
#if defined(MK_CHECK) && MK_CHECK
    + 1
#endif
    ;
constexpr int N_STEPS = 2 + NB * STEPS_MIX + 3 + 3;

#ifndef MK_PER_STEP
#define MK_PER_STEP 0
#endif
extern "C" void kernel_launch(void* const* d_in, const int* in_sizes, int n_in, void* d_out, int out_size, void* d_ws, size_t ws_size, hipStream_t stream) {
    static int grid = 0;
    if (grid == 0) {
        if (n_in != 19 || out_size != NTOK * DM || ws_size < WS_END) { fprintf(stderr, "kernel_launch: unexpected shapes (n_in %d out %d ws %zu need %zu)\n", n_in, out_size, ws_size, (size_t)WS_END); grid = -1; return; }
        int dev = 0, cus = 0;
        if (hipGetDevice(&dev) != hipSuccess || hipDeviceGetAttribute(&cus, hipDeviceAttributeMultiprocessorCount, dev) != hipSuccess) { grid = -1; return; }
        if (hipFuncSetAttribute((const void*)fwd_kernel, hipFuncAttributeMaxDynamicSharedMemorySize, LDS_BYTES) != hipSuccess) { grid = -1; return; }
        int per_cu = 0;
        if (hipOccupancyMaxActiveBlocksPerMultiprocessor(&per_cu, (const void*)fwd_kernel, NWAVES * 64, LDS_BYTES) != hipSuccess || per_cu < 1) { fprintf(stderr, "kernel_launch: occupancy query says %d\n", per_cu); }
        (void)hipGetLastError();
        grid = cus;
    }
    if (grid < 0) return;
    if (hipMemsetAsync((char*)d_ws + WS_CTL, 0, CTL_ZERO_BYTES, stream) != hipSuccess) return;
    Args a{};
    for (int i = 0; i < 19; ++i) a.in[i] = d_in[i];
    a.out = (float*)d_out; a.ws = (unsigned char*)d_ws;
#if MK_PER_STEP
    for (int s = 0; s < N_STEPS; ++s) { a.st_lo = s; a.st_hi = s + 1; hipLaunchKernelGGL(fwd_kernel, dim3(grid), dim3(NWAVES * 64), LDS_BYTES, stream, a); }
#else
    a.st_lo = 0; a.st_hi = N_STEPS;
    hipLaunchKernelGGL(fwd_kernel, dim3(grid), dim3(NWAVES * 64), LDS_BYTES, stream, a);
#endif
    const hipError_t le = hipPeekAtLastError();
    if (le != hipSuccess) fprintf(stderr, "kernel_launch: launch failed: %s\n", hipGetErrorName(le));
}
```

```cpp
#include <hip/hip_runtime.h>
#include <cstdio>
#include <cstdint>

#define LAS __attribute__((address_space(3)))
#define GAS __attribute__((address_space(1)))
typedef unsigned short bf16_t;
typedef short bf16x8 __attribute__((ext_vector_type(8)));
typedef short s16x4 __attribute__((ext_vector_type(4)));
typedef float f32x2 __attribute__((ext_vector_type(2)));
typedef float f32x4 __attribute__((ext_vector_type(4)));
typedef float f32x16 __attribute__((ext_vector_type(16)));
typedef unsigned u32x2 __attribute__((ext_vector_type(2)));
typedef unsigned u32x4 __attribute__((ext_vector_type(4)));
typedef int i32x4 __attribute__((ext_vector_type(4)));

#ifndef MK_FP8
#define MK_FP8 1
#endif
#ifndef DIL_FP8
#define DIL_FP8 1
#endif
constexpr int NB = 4, SEQ = 8192, DM = 1024, NTOK = NB * SEQ;
constexpr int NP = 12032;
constexpr int C_CQ = 0, C_CKV = 384, C_KPE = 640, C_DIL = 704, C_GATE = 9920, D_IN = 11968;
constexpr int NE = 16, CAP = 1024, DFF = 2048;
constexpr int P_QK_ESZ = DIL_FP8 ? 1 : 2, P_GRP = 2 * 1024 * P_QK_ESZ + 2048, P_OFF_DIL = 1408, P_OFF_GATE = P_OFF_DIL + 3 * P_GRP, PROW = P_OFF_GATE + 2 * (2048 + 64);
__host__ __device__ constexpr int p_col_off(int c) {
    return c < C_DIL ? 2 * c : (c < C_GATE ? (P_OFF_DIL + ((c - C_DIL) / 3072) * P_GRP + ((((c - C_DIL) % 3072) >> 10) == 2 ? 2048 * P_QK_ESZ + 2 * (((c - C_DIL) % 3072) & 1023) : ((((c - C_DIL) % 3072) >> 10) * 1024 + (((c - C_DIL) % 3072) & 1023)) * P_QK_ESZ)) : P_OFF_GATE + 2 * (c - C_GATE)); }
__host__ __device__ constexpr bool p_col_f8(int c) { return DIL_FP8 && c >= C_DIL && c < C_GATE && ((((c - C_DIL) % 3072) >> 10) != 2); }
constexpr float NORM_EPS = 1e-6f;
constexpr float LOG2E = 1.4426950408889634f;

constexpr size_t MiB = 1u << 20;
constexpr size_t WS_CTL = 0, CTL_ZERO_BYTES = 1 * MiB;
constexpr size_t WS_MOD = 1 * MiB;
constexpr size_t WS_CS = 2 * MiB;
constexpr size_t WS_WIN = 10 * MiB;
constexpr size_t WS_WUQ = 34 * MiB;
constexpr size_t WS_WUKV = 36 * MiB;
constexpr size_t WS_WOUT = 37 * MiB;
constexpr size_t WS_H = 40 * MiB;
constexpr size_t WS_U = 104 * MiB;
constexpr size_t WS_R = 168 * MiB;
constexpr size_t WS_P = WS_R;
constexpr size_t WS_CQN = WS_R + 188 * MiB;
constexpr size_t WS_CKVN = WS_R + 194 * MiB;
constexpr size_t WS_QB = WS_R + 198 * MiB;
constexpr size_t WS_KB = WS_R + 222 * MiB;
constexpr size_t WS_VB = WS_R + 246 * MiB;
constexpr size_t WS_OA = WS_R + 262 * MiB;
constexpr size_t WS_OG = WS_R + 278 * MiB;
constexpr size_t WS_LSE = WS_R + 326 * MiB;
constexpr size_t WS_WGU = WS_R;
constexpr size_t WS_WD = WS_R + 64 * MiB;
constexpr size_t WS_HID = WS_R + 96 * MiB;
constexpr size_t WS_Y = WS_R + 224 * MiB;
constexpr size_t WS_AFFT = WS_R + 352 * MiB;
constexpr size_t WS_TOPI = WS_R + 354 * MiB;
constexpr size_t WS_TOPG = WS_R + 355 * MiB;
constexpr size_t WS_SLOT = WS_R + 356 * MiB;
constexpr size_t WS_END = WS_R + 358 * MiB;
constexpr size_t WS_LUT = 1 * MiB + 512 * 1024;
constexpr int CW_TMO = 0, CW_DBG = 16, CW_BAR = 4096;

constexpr int RING_BYTES = 131072;
constexpr int MISC_OFF = RING_BYTES + 320;
constexpr int LDS_BYTES = 147456;
constexpr int NWAVES = 8;

#define RLX_AGENT __ATOMIC_RELAXED, __HIP_MEMORY_SCOPE_AGENT
#define LDS_WAIT() asm volatile("s_waitcnt lgkmcnt(0)" ::: "memory")
#define VM_WAIT() asm volatile("s_waitcnt vmcnt(0)" ::: "memory")

__device__ __forceinline__ unsigned cvt_pk_bf16(float lo, float hi) { unsigned r; asm volatile("v_cvt_pk_bf16_f32 %0, %1, %2" : "=v"(r) : "v"(lo), "v"(hi)); return r; }
__device__ __forceinline__ float bf2f(unsigned short v) { return __uint_as_float(((unsigned)v) << 16); }
__device__ __forceinline__ float bflo(unsigned w) { return __uint_as_float(w << 16); }
__device__ __forceinline__ float bfhi(unsigned w) { return __uint_as_float(w & 0xffff0000u); }
#define SWZ_XOR(k) (((k) << 10) | 0x1f)
#if defined(OLD_WAVE_SUM)
__device__ __forceinline__ float wave_sum(float v) { for (int o = 1; o < 64; o <<= 1) v += __shfl_xor(v, o); return v; }
#else
__device__ __forceinline__ float wave_sum(float v) {
    v += __int_as_float(__builtin_amdgcn_ds_swizzle(__float_as_int(v), SWZ_XOR(1)));
    v += __int_as_float(__builtin_amdgcn_ds_swizzle(__float_as_int(v), SWZ_XOR(2)));
    v += __int_as_float(__builtin_amdgcn_ds_swizzle(__float_as_int(v), SWZ_XOR(4)));
    v += __int_as_float(__builtin_amdgcn_ds_swizzle(__float_as_int(v), SWZ_XOR(8)));
    v += __int_as_float(__builtin_amdgcn_ds_swizzle(__float_as_int(v), SWZ_XOR(16)));
    { auto rr = __builtin_amdgcn_permlane32_swap(__float_as_uint(v), __float_as_uint(v), false, false); v = __uint_as_float(rr[0]) + __uint_as_float(rr[1]); }
    return v;
}
#endif
__device__ __forceinline__ float wave_max(float v) {
    v = fmaxf(v, __int_as_float(__builtin_amdgcn_ds_swizzle(__float_as_int(v), SWZ_XOR(1))));
    v = fmaxf(v, __int_as_float(__builtin_amdgcn_ds_swizzle(__float_as_int(v), SWZ_XOR(2))));
    v = fmaxf(v, __int_as_float(__builtin_amdgcn_ds_swizzle(__float_as_int(v), SWZ_XOR(4))));
    v = fmaxf(v, __int_as_float(__builtin_amdgcn_ds_swizzle(__float_as_int(v), SWZ_XOR(8))));
    v = fmaxf(v, __int_as_float(__builtin_amdgcn_ds_swizzle(__float_as_int(v), SWZ_XOR(16))));
    { auto rr = __builtin_amdgcn_permlane32_swap(__float_as_uint(v), __float_as_uint(v), false, false); v = fmaxf(__uint_as_float(rr[0]), __uint_as_float(rr[1])); }
    return v;
}
__device__ __forceinline__ float fast_sigmoid(float x) { return __builtin_amdgcn_rcpf(1.f + __builtin_amdgcn_exp2f(-x * LOG2E)); }
#ifndef MK_FP8
#define MK_FP8 1
#endif
#ifndef MLA_NM16
#define MLA_NM16 1
#endif
#ifndef MLA_PKADD
#define MLA_PKADD 0
#endif
#ifndef MLA_PKOLD
#define MLA_PKOLD 0
#endif
#ifndef MLA_PRE
#define MLA_PRE 1
#endif
#ifndef MLA_2T
#define MLA_2T 0
#endif
#ifndef MLA_LSUM
#define MLA_LSUM 1
#endif
#ifndef MLA_FP8
#define MLA_FP8 1
#endif
#ifndef FP8_G1
#define FP8_G1 MK_FP8
#endif
#ifndef FP8_EX
#define FP8_EX MK_FP8
#endif
#ifndef FP8_WO
#define FP8_WO 1
#endif
constexpr float QK_LOG2_SCALE = 0.072168783648703220f * LOG2E;
constexpr float W8_SCALE = 64.0f, W8_INV = 1.0f / 64.0f;
constexpr float U8_SCALE = 16.0f;
typedef int v8i __attribute__((ext_vector_type(8)));
__device__ __forceinline__ unsigned pk4_fp8(float a, float b, float c, float d) { int w = __builtin_amdgcn_cvt_pk_fp8_f32(a, b, 0, false); w = __builtin_amdgcn_cvt_pk_fp8_f32(c, d, w, true); return (unsigned)w; }
#if defined(OLD_TID)
__device__ __forceinline__ int opaque_tid(int wv) { int t = (int)threadIdx.x; asm volatile("" : "+v"(t)); return t; }
#else
__device__ __forceinline__ int opaque_tid(int wv) { int l; asm volatile("v_mbcnt_lo_u32_b32 %0, -1, 0\n\tv_mbcnt_hi_u32_b32 %0, -1, %0" : "=v"(l)); return (wv << 6) | l; }
#endif
struct Frame {
    LAS unsigned char* lds;
    int tid, lane, wave, vcu, G, gw, NGW;
};
struct Args { const void* in[19]; float* out; unsigned char* ws; int st_lo, st_hi; };

#define XB_TMO      128
#define XB_XCNT(j)  (256  + 64 * (j))
#define XB_XSUB(j)  (1280 + 64 * (j))
#define XB_XGEN(j)  (2304 + 64 * (j))
#define XB_TOP      3328
#define XB_TOPGEN   3392
#define XCD_BAR_WORDS 3456
#define XB_SPIN_CAP (1u << 18)

__device__ __forceinline__ unsigned xb_ld(unsigned* p)              { return __hip_atomic_load(p, __ATOMIC_RELAXED, __HIP_MEMORY_SCOPE_AGENT); }
__device__ __forceinline__ unsigned xb_add(unsigned* p, unsigned v) { return __hip_atomic_fetch_add(p, v, __ATOMIC_RELAXED, __HIP_MEMORY_SCOPE_AGENT); }
__device__ __forceinline__ unsigned xb_xcc_id() { return (unsigned)__builtin_amdgcn_s_getreg((3 << 11) | 20) & 0xFu; }
#define XB_SPIN(cond, bar) do { unsigned _sp = 0; while (cond) { __builtin_amdgcn_s_sleep(1); \
    if ((++_sp & 255u) == 0u) { if (xb_ld(&(bar)[XB_TMO])) break; if (_sp > XB_SPIN_CAP) { atomicAdd(&(bar)[XB_TMO], 1u); break; } } } } while (0)

struct XcdBarrier {
    unsigned* bar; unsigned x;
    int wv;
    volatile LAS unsigned* st;
};

__device__ __forceinline__ XcdBarrier xcd_barrier_post(unsigned* bar, volatile LAS unsigned* st) {
    XcdBarrier b; b.bar = bar; b.x = xb_xcc_id(); b.st = st;
    if (threadIdx.x == 0) (void)xb_add(&bar[XB_XCNT(b.x)], 1u);
    return b;
}
__device__ __forceinline__ void xcd_barrier_complete(unsigned* bar, unsigned x, unsigned& nloc, unsigned& nx) {
    const unsigned G = gridDim.x * gridDim.y * gridDim.z;
    unsigned sum, cnt, mine, sp = 0u;
    for (;;) {
        sum = 0u; cnt = 0u; mine = 0u;
#pragma unroll
        for (unsigned j = 0; j < 16; ++j) { const unsigned c = xb_ld(&bar[XB_XCNT(j)]); sum += c; cnt += (c > 0u) ? 1u : 0u; mine = (j == x) ? c : mine; }
        if (sum == G) break;
        __builtin_amdgcn_s_sleep(1);
        if ((++sp & 255u) == 0u) { if (xb_ld(&bar[XB_TMO])) break; if (sp > XB_SPIN_CAP) { atomicAdd(&bar[XB_TMO], 1u); break; } }
    }
    nloc = mine > 0u ? mine : 1u; nx = cnt > 0u ? cnt : 1u;
}

__device__ __forceinline__ void xcd_barrier(const XcdBarrier& b) {
    asm volatile("s_waitcnt vmcnt(0)" ::: "memory");
    __syncthreads();
    if (b.wv == 0 && opaque_tid(0) == 0) {
        unsigned* bar = b.bar;
        __builtin_amdgcn_s_waitcnt(0);
        unsigned nloc = b.st[0], nx = b.st[1];
        if (nloc == 0u) { xcd_barrier_complete(bar, b.x, nloc, nx); b.st[0] = nloc; b.st[1] = nx; }
        const unsigned old = xb_add(&bar[XB_XSUB(b.x)], 1u);
        const unsigned gen = old / nloc;
        if (old + 1u == (gen + 1u) * nloc) {
            __builtin_amdgcn_fence(__ATOMIC_RELEASE, "agent");
            asm volatile("s_waitcnt vmcnt(0)" ::: "memory");
            const unsigned og = xb_add(&bar[XB_TOP], 1u);
            const unsigned tg = og / nx;
            if (og + 1u == (tg + 1u) * nx) xb_add(&bar[XB_TOPGEN], 1u);
            else XB_SPIN(xb_ld(&bar[XB_TOPGEN]) == tg, bar);
            __builtin_amdgcn_fence(__ATOMIC_ACQUIRE, "agent");
            xb_add(&bar[XB_XGEN(b.x)], 1u);
            asm volatile("s_waitcnt vmcnt(0)" ::: "memory");
        } else {
            XB_SPIN(xb_ld(&bar[XB_XGEN(b.x)]) == gen, bar);
            __builtin_amdgcn_fence(__ATOMIC_ACQUIRE, "agent");
            asm volatile("s_waitcnt vmcnt(0)" ::: "memory");
        }
    }
    __syncthreads();
}

namespace pg8 {
constexpr int BM = 256, BK = 64, HALF = 128, HTB = HALF * BK * 2  , STAGE_BYTES = 8 * HTB, NXCD = 8, WGM = 8;

__host__ __device__ __forceinline__ int lds_byte(int r, int c) { const int st = (r >> 4) * 2 + (c >> 5), rr = r & 15, cc = c & 31, ob = rr * 64 + cc * 2; return st * 1024 + (ob ^ (((ob >> 9) & 1) << 5)); }
__host__ __device__ __forceinline__ void stage_rc(int b, int& R, int& C) { const int st = b / 1024, sb = b % 1024, swz = sb ^ (((sb >> 9) & 1) << 5); R = (st >> 1) * 16 + swz / 64; C = (st & 1) * 32 + (swz % 64) / 2; }
__host__ __device__ __forceinline__ int perm32(int rho) { const int n = rho >> 4, i = rho & 15; return 8 * (i >> 2) + 4 * n + (i & 3); }

struct Unit { int pm, pn, g; };
struct Gemm { const bf16_t* A; const bf16_t* Bt; int lda, ldb, K; long a_gs, b_gs; const int* idx; int idx_gs; int b_gmod; };

struct StaticOrder {
    int nM, nN, nwg, G, c;
    __device__ __forceinline__ void init(int M, int N, int G_, int c_) { nM = M / BM; nN = N / BM; nwg = nM * nN; G = G_; c = c_; }
    __device__ __forceinline__ bool next(int i, Unit& u) const {
        const long L = (long)i * G + c; if (L >= nwg) return false;
        int wgid = (int)L; { const int q = nwg / NXCD, r = nwg % NXCD, xcd = wgid % NXCD, off = wgid / NXCD; wgid = (xcd < r ? xcd * (q + 1) : r * (q + 1) + (xcd - r) * q) + off; }
        const int nig = WGM * nN, gid = wgid / nig, fm = gid * WGM, gsz = (nM - fm) < WGM ? (nM - fm) : WGM;
        u.pm = fm + ((wgid % nig) % gsz); u.pn = (wgid % nig) / gsz; u.g = 0; return true;
    }
};
struct GroupOrder {
    int nM, nN, nwg, G, v, gperm;
    __device__ __forceinline__ void init(int nM_, int nN_, int nG, int G_, int c_) { nM = nM_; nN = nN_; nwg = nM_ * nN_ * nG; G = G_; gperm = (nG == 64); v = (G_ % 8 == 0) ? (c_ % 8) * (G_ / 8) + c_ / 8 : c_; }
    __device__ __forceinline__ bool next(int i, Unit& u) const {
        const long L = (long)i * G + v; if (L >= nwg) return false;
        const int w = (int)L, gi = w / (nM * nN); u.pm = w % nM; u.pn = (w / nM) % nN;
        u.g = gperm ? (gi & 3) * 16 + (gi >> 2) : gi;
        return true;
    }
};

template <class Epi, class Sched, bool GATHER, bool FP8 = false>
__device__ __forceinline__ void gemm_phase(LAS unsigned char* lds, int wv, const Gemm g, const Sched& S, const Epi& E) {
    const int tid = opaque_tid(wv), wid = __builtin_amdgcn_readfirstlane(tid >> 6), lane = tid & 63, wr = wid >> 2, wc = wid & 3, fr = lane & 15, fq = lane >> 4;
    constexpr int ESZ = FP8 ? 1 : 2;
    const int K = g.K, nt = K * ESZ / (BK * 2);
    int Rr[2], Cc[2]; unsigned voffB[2];
#pragma unroll
    for (int i = 0; i < 2; ++i) { int R, C; stage_rc(tid * 16 + i * 8192, R, C); Rr[i] = R; Cc[i] = C; const int Rb = (Epi::PERM && !Epi::BPRE) ? ((R & ~31) + perm32(R & 31)) : R;
        voffB[i] = (unsigned)(Rb * g.ldb * ESZ + C * 2); }
    const unsigned kstep = (unsigned)(BK * 2);
    const unsigned hstepA = (unsigned)(HALF * g.lda * ESZ), hstepB = (unsigned)(HALF * g.ldb * ESZ);
    const unsigned ldsw = (unsigned)wid * 1024u;
    const int aoff = lds_byte(wr * 64 + fr, fq * 8), boff = lds_byte(wc * 32 + fr, fq * 8);
#define PG8_SA(b, h) (((b) * 2 + (h)) * HTB)
#define PG8_SB(b, h) ((4 + (b) * 2 + (h)) * HTB)
    const __amdgpu_buffer_rsrc_t rsA = __builtin_amdgcn_make_buffer_rsrc((void*)g.A, 0, 0x7fffffff, 0x00020000), rsB = __builtin_amdgcn_make_buffer_rsrc((void*)g.Bt, 0, 0x7fffffff, 0x00020000);
#ifndef PG8_BUFFER_DMA
#define PG8_BUFFER_DMA 1
#endif
#if PG8_BUFFER_DMA
#define PG8_STAGE(bufoff, rs, so, v0, v1) do { \
        __builtin_amdgcn_raw_ptr_buffer_load_lds(rs, (LAS void*)(lds + (bufoff) + ldsw), 16, (v0), (so), 0, 0); \
        __builtin_amdgcn_raw_ptr_buffer_load_lds(rs, (LAS void*)(lds + (bufoff) + ldsw + 8192), 16, (v1), (so), 0, 0); } while (0)
#else
#define PG8_GBASE(rs) ((const char*)(__builtin_bit_cast(u32x4, rs).x | ((unsigned long long)(__builtin_bit_cast(u32x4, rs).y & 0xffffu) << 32)))
#define PG8_STAGE(bufoff, rs, so, v0, v1) do { const char* gb_ = (&rs == &rsA ? (const char*)g.A : (const char*)g.Bt) + (so); \
        __builtin_amdgcn_global_load_lds((const unsigned*)(gb_ + (v0)), (LAS unsigned*)(lds + (bufoff) + ldsw), 16, 0, 0); \
        __builtin_amdgcn_global_load_lds((const unsigned*)(gb_ + (v1)), (LAS unsigned*)(lds + (bufoff) + ldsw + 8192), 16, 0, 0); } while (0)
#endif
#define PG8_STAGEB(bufoff, so) PG8_STAGE(bufoff, rsB, so, voffB[0], voffB[1])
#define PG8_CAT(x_, y_) __builtin_shufflevector(__builtin_bit_cast(i32x4, x_), __builtin_bit_cast(i32x4, y_), 0, 1, 2, 3, 4, 5, 6, 7)
#define PG8_LO(v_) __builtin_bit_cast(bf16x8, __builtin_shufflevector(v_, v_, 0, 1, 2, 3))
#define PG8_HI(v_) __builtin_bit_cast(bf16x8, __builtin_shufflevector(v_, v_, 4, 5, 6, 7))
#define PG8_LDA(dst, b, h) do { _Pragma("unroll") for (int m = 0; m < 4; ++m) dst[m] = PG8_CAT(*(const LAS bf16x8*)(lds + PG8_SA(b, h) + aoff + m * 2048), *(const LAS bf16x8*)(lds + PG8_SA(b, h) + aoff + m * 2048 + 1024)); } while (0)
#define PG8_LDB(dst, b, h) do { _Pragma("unroll") for (int n = 0; n < 2; ++n) dst[n] = PG8_CAT(*(const LAS bf16x8*)(lds + PG8_SB(b, h) + boff + n * 2048), *(const LAS bf16x8*)(lds + PG8_SB(b, h) + boff + n * 2048 + 1024)); } while (0)
#define PG8_MMA(ai, bj, At, Bt) do { __builtin_amdgcn_s_setprio(1); _Pragma("unroll") for (int m = 0; m < 4; ++m) _Pragma("unroll") for (int n = 0; n < 2; ++n) { \
        if constexpr (FP8) acc[ai][bj][m][n] = __builtin_amdgcn_mfma_scale_f32_16x16x128_f8f6f4(Bt[n], At[m], acc[ai][bj][m][n], 0, 0, 0, 0, 0, 0);   \
        else { acc[ai][bj][m][n] = __builtin_amdgcn_mfma_f32_16x16x32_bf16(PG8_LO(Bt[n]), PG8_LO(At[m]), acc[ai][bj][m][n], 0, 0, 0); \
               acc[ai][bj][m][n] = __builtin_amdgcn_mfma_f32_16x16x32_bf16(PG8_HI(Bt[n]), PG8_HI(At[m]), acc[ai][bj][m][n], 0, 0, 0); } } \
        __builtin_amdgcn_s_setprio(0); } while (0)
#define PG8_WAIT_V(n) asm volatile("s_waitcnt vmcnt(" #n ")" ::: "memory")
#define PG8_WAIT_L(n) asm volatile("s_waitcnt lgkmcnt(" #n ")" ::: "memory")
#define PG8_BAR __builtin_amdgcn_s_barrier()
#define PG8_SCHED __builtin_amdgcn_sched_barrier(0)
    Unit cur, nxt; int ui = 0;
    if (!S.next(0, cur)) return;
    f32x4 acc[2][2][4][2];
#pragma unroll
    for (int a = 0; a < 2; ++a)
#pragma unroll
        for (int b = 0; b < 2; ++b)
#pragma unroll
            for (int m = 0; m < 4; ++m)
#pragma unroll
                for (int n = 0; n < 2; ++n) acc[a][b][m][n] = (f32x4){0.f, 0.f, 0.f, 0.f};
    v8i At[4], B0[2], B1[2];
    unsigned voffA[2]; unsigned oc[2][2], on[2][2];
#pragma unroll
    for (int i = 0; i < 2; ++i) voffA[i] = (unsigned)(Rr[i] * g.lda * ESZ + Cc[i] * 2);
    unsigned cA, cB;
#define PG8_UNIT_PTRS(u, pA, pB, o) do { \
        pB = (unsigned)(((size_t)(g.b_gmod ? (u).g % g.b_gmod : (u).g) * g.b_gs + (size_t)(u).pn * BM * g.ldb) * ESZ); \
        if constexpr (GATHER) { \
            pA = 0u; \
            const int* ix_ = g.idx + (size_t)(u).g * g.idx_gs + (u).pm * BM; const int t_ = opaque_tid(wv); \
            _Pragma("unroll") for (int i = 0; i < 2; ++i) { int R_, C_; stage_rc(t_ * 16 + i * 8192, R_, C_); \
                _Pragma("unroll") for (int h = 0; h < 2; ++h) o[h][i] = (unsigned)ix_[h * HALF + R_] * (unsigned)(g.lda * ESZ) + (unsigned)C_ * 2u; } \
        } else { \
            pA = (unsigned)(((size_t)(u).g * g.a_gs + (size_t)(u).pm * BM * g.lda) * ESZ); \
        } } while (0)
#define PG8_STAGEA(bufoff, p, o, h) do { if constexpr (GATHER) PG8_STAGE(bufoff, rsA, p, o[h][0], o[h][1]); else PG8_STAGE(bufoff, rsA, (p) + (h) * hstepA, voffA[0], voffA[1]); } while (0)
    PG8_UNIT_PTRS(cur, cA, cB, oc);
    PG8_STAGEB(PG8_SB(0, 0), cB); PG8_STAGEB(PG8_SB(0, 1), cB + hstepB); PG8_STAGEA(PG8_SA(0, 0), cA, oc, 0); PG8_STAGEA(PG8_SA(0, 1), cA, oc, 1);
    if (wr == 1) PG8_BAR;
    PG8_WAIT_V(2); PG8_BAR;
    PG8_STAGEB(PG8_SB(1, 0), cB + kstep); PG8_STAGEA(PG8_SA(1, 0), cA + kstep, oc, 0); PG8_STAGEB(PG8_SB(1, 1), cB + hstepB + kstep);
    PG8_WAIT_V(6); PG8_BAR;
    for (;;) {
        const bool has_next = S.next(ui + 1, nxt);
        unsigned nA = cA, nB = cB;
        if constexpr (GATHER) {
#pragma unroll
            for (int h = 0; h < 2; ++h)
#pragma unroll
                for (int i = 0; i < 2; ++i) on[h][i] = oc[h][i];
        }
        if (has_next) PG8_UNIT_PTRS(nxt, nA, nB, on);
#pragma unroll 1
        for (int t = 0; t < nt; t += 2) {
            const bool last = (t == nt - 2);
            const unsigned a1 = cA + (unsigned)(t + 1) * kstep;
            const unsigned a2 = last ? nA : cA + (unsigned)(t + 2) * kstep, b2 = last ? nB : cB + (unsigned)(t + 2) * kstep;
            const unsigned a3 = a2 + kstep, b3 = b2 + kstep;
#define PG8_STAGEA2(bufoff, p, h) do { if constexpr (GATHER) { if (last) PG8_STAGEA(bufoff, p, on, h); else PG8_STAGEA(bufoff, p, oc, h); } else PG8_STAGEA(bufoff, p, oc, h); } while (0)
            PG8_LDB(B0, 0, 0); PG8_LDB(B1, 0, 1); PG8_SCHED; PG8_LDA(At, 0, 0); PG8_STAGEA(PG8_SA(1, 1), a1, oc, 1);
            PG8_WAIT_V(8); PG8_WAIT_L(0); PG8_BAR; PG8_MMA(0, 0, At, B0); PG8_MMA(0, 1, At, B1); PG8_BAR; PG8_SCHED;
            PG8_LDA(At, 0, 1); PG8_STAGEB(PG8_SB(0, 0), b2); PG8_STAGEB(PG8_SB(0, 1), b2 + hstepB); PG8_STAGEA2(PG8_SA(0, 0), a2, 0);
            PG8_WAIT_V(8); PG8_WAIT_L(0); PG8_BAR; PG8_MMA(1, 0, At, B0); PG8_MMA(1, 1, At, B1); PG8_BAR; PG8_SCHED;
            PG8_LDB(B0, 1, 0); PG8_LDB(B1, 1, 1); PG8_SCHED; PG8_LDA(At, 1, 0); PG8_STAGEA2(PG8_SA(0, 1), a2, 1);
            PG8_WAIT_V(8); PG8_WAIT_L(0); PG8_BAR; PG8_MMA(0, 0, At, B0); PG8_MMA(0, 1, At, B1); PG8_BAR; PG8_SCHED;
            PG8_LDA(At, 1, 1); PG8_STAGEB(PG8_SB(1, 0), b3); PG8_STAGEB(PG8_SB(1, 1), b3 + hstepB); PG8_STAGEA2(PG8_SA(1, 0), a3, 0);
            PG8_WAIT_V(8); PG8_WAIT_L(0); PG8_BAR; PG8_MMA(1, 0, At, B0); PG8_MMA(1, 1, At, B1); PG8_BAR; PG8_SCHED;
        }
        if (wr == 0) PG8_BAR;
        { const int l_ = opaque_tid(wv) & 63; E(acc, cur, wr, wc, l_ & 15, l_ >> 4); }
        if (!has_next) break;
#pragma unroll
        for (int a = 0; a < 2; ++a)
#pragma unroll
            for (int b = 0; b < 2; ++b)
#pragma unroll
                for (int m = 0; m < 4; ++m)
#pragma unroll
                    for (int n = 0; n < 2; ++n) acc[a][b][m][n] = (f32x4){0.f, 0.f, 0.f, 0.f};
        cur = nxt; cA = nA; cB = nB; ++ui;
        if constexpr (GATHER) {
#pragma unroll
            for (int h = 0; h < 2; ++h)
#pragma unroll
                for (int i = 0; i < 2; ++i) oc[h][i] = on[h][i];
        }
        if (wr == 1) PG8_BAR;
    }
    PG8_WAIT_V(0);
    PG8_BAR;
#undef PG8_UNIT_PTRS
#undef PG8_STAGEA
#undef PG8_STAGEA2
#undef PG8_SA
#undef PG8_SB
#undef PG8_STAGE
#undef PG8_STAGEB
#undef PG8_LDA
#undef PG8_LDB
#undef PG8_MMA
#undef PG8_CAT
#undef PG8_LO
#undef PG8_HI
#undef PG8_WAIT_V
#undef PG8_WAIT_L
#undef PG8_BAR
#undef PG8_SCHED
}

#define EPI_ROWLOOP for (int ai = 0; ai < 2; ++ai) _Pragma("unroll") for (int m = 0; m < 4; ++m)
__device__ __forceinline__ u32x4 pack8(const f32x4 v0, const f32x4 v1) { u32x4 w; w.x = cvt_pk_bf16(v0[0], v0[1]); w.y = cvt_pk_bf16(v0[2], v0[3]); w.z = cvt_pk_bf16(v1[0], v1[1]); w.w = cvt_pk_bf16(v1[2], v1[3]); return w; }
struct EpiBf16 {
    static constexpr bool PERM = true, BPRE = true;
    bf16_t* O; int ldc; float sc; int nostore;
    __device__ __forceinline__ void operator()(const f32x4 (&acc)[2][2][4][2], const Unit& u, int wr, int wc, int fr, int fq) const {
        const __amdgpu_buffer_rsrc_t rs = __builtin_amdgcn_make_buffer_rsrc((void*)O, 0, 0x7fffffff, 0x00020000);
        const unsigned lo = (unsigned)(fr * ldc + 8 * fq) * 2u, so = (unsigned)(((u.pm * BM + wr * 64) * ldc + u.pn * BM + wc * 32) * 2);
        if (nostore) return;
#pragma unroll
        EPI_ROWLOOP {
#pragma unroll
            for (int bj = 0; bj < 2; ++bj) {
#if !defined(EPI_BUF_STORES)
#if defined(EPI_NT_STORES_PROBE)
                __builtin_nontemporal_store(pack8(acc[ai][bj][m][0] * sc, acc[ai][bj][m][1] * sc), (u32x4*)((char*)O + (size_t)(so + (unsigned)((ai * HALF + m * 16) * ldc + bj * HALF) * 2u) + lo));
#else
                *(u32x4*)((char*)O + (size_t)(so + (unsigned)((ai * HALF + m * 16) * ldc + bj * HALF) * 2u) + lo) = pack8(acc[ai][bj][m][0] * sc, acc[ai][bj][m][1] * sc);
#endif
#else
                __builtin_amdgcn_raw_buffer_store_b128(pack8(acc[ai][bj][m][0] * sc, acc[ai][bj][m][1] * sc), rs, lo, so + (unsigned)((ai * HALF + m * 16) * ldc + bj * HALF) * 2u, 0);
#endif
            } }
    }
};
struct EpiP {
    static constexpr bool PERM = true, BPRE = true;
    unsigned char* P; float sc; int nostore;
    __device__ __forceinline__ void operator()(const f32x4 (&acc)[2][2][4][2], const Unit& u, int wr, int wc, int fr, int fq) const {
        if (nostore) return;
        const size_t rowb = (size_t)(u.pm * BM + wr * 64) * PROW;
#pragma unroll
        for (int bj = 0; bj < 2; ++bj) { const int c32 = u.pn * BM + bj * HALF + wc * 32; const bool f8 = p_col_f8(c32);
            char* ub = (char*)P + rowb + p_col_off(c32); const unsigned lo = (unsigned)(fr * PROW + (f8 ? 8 : 16) * fq);
#pragma unroll
            EPI_ROWLOOP { char* dst = ub + (size_t)(ai * HALF + m * 16) * PROW + lo; const f32x4 v0 = acc[ai][bj][m][0] * sc, v1 = acc[ai][bj][m][1] * sc;
                if (f8) { u32x2 o; o.x = pk4_fp8(v0[0], v0[1], v0[2], v0[3]); o.y = pk4_fp8(v1[0], v1[1], v1[2], v1[3]); *(u32x2*)dst = o; }
                else *(u32x4*)dst = pack8(v0, v1); } }
    }
};
struct EpiQ {
    static constexpr bool PERM = true, BPRE = false;
    bf16_t* QB; const float* cs;
    __device__ __forceinline__ void operator()(const f32x4 (&acc)[2][2][4][2], const Unit& u, int wr, int wc, int fr, int fq) const {
        const unsigned lo = (unsigned)(fr * 192 + 8 * fq) * 2u, lcs = (unsigned)(fr * 64 + 8 * fq) * 4u;
        const int rowU = u.pm * BM + wr * 64;
#pragma unroll
        for (int bj = 0; bj < 2; ++bj) { const int c32 = u.pn * BM + bj * HALF + wc * 32, hd = c32 / 192, w32 = c32 - hd * 192;
            char* ub = (char*)(QB + ((size_t)hd * SEQ + rowU) * 192 + w32);
            const char* cb = (const char*)(cs + (size_t)rowU * 64 + (w32 >= 128 ? (w32 - 128) : 0));
#pragma unroll
            EPI_ROWLOOP { const int rr = ai * HALF + m * 16; f32x4 v0 = acc[ai][bj][m][0], v1 = acc[ai][bj][m][1];
                if (w32 >= 128) { const f32x4 ca = *(const f32x4*)(cb + (size_t)rr * 256 + lcs), cc = *(const f32x4*)(cb + (size_t)rr * 256 + 16 + lcs);
                    const f32x4 a = v0, b = v1;
                    v0[0] = a[0] * ca[0] - a[1] * ca[1]; v0[1] = a[0] * ca[1] + a[1] * ca[0]; v0[2] = a[2] * ca[2] - a[3] * ca[3]; v0[3] = a[2] * ca[3] + a[3] * ca[2];
                    v1[0] = b[0] * cc[0] - b[1] * cc[1]; v1[1] = b[0] * cc[1] + b[1] * cc[0]; v1[2] = b[2] * cc[2] - b[3] * cc[3]; v1[3] = b[2] * cc[3] + b[3] * cc[2]; }
                *(u32x4*)(ub + (size_t)rr * 384 + lo) = pack8(v0, v1);
                if (m & 1) asm volatile("" ::: "memory"); } }
    }
};
struct EpiKV {
    static constexpr bool PERM = true, BPRE = false;
    bf16_t* KB; bf16_t* VB;
    __device__ __forceinline__ void operator()(const f32x4 (&acc)[2][2][4][2], const Unit& u, int wr, int wc, int fr, int fq) const {
        const int rowU = u.pm * BM + wr * 64;
#pragma unroll
        for (int bj = 0; bj < 2; ++bj) { const int c32 = u.pn * BM + bj * HALF + wc * 32, hd = c32 >> 8, w32 = c32 & 255; const bool isk = w32 < 128;
            const int ld = isk ? 192 : 128;
            char* ub = (char*)(isk ? KB + ((size_t)hd * SEQ + rowU) * 192 + w32 : VB + ((size_t)hd * SEQ + rowU) * 128 + (w32 - 128));
            const unsigned lo = (unsigned)(fr * ld + 8 * fq) * 2u;
#pragma unroll
            EPI_ROWLOOP { *(u32x4*)(ub + (size_t)(ai * HALF + m * 16) * ld * 2 + lo) = pack8(acc[ai][bj][m][0], acc[ai][bj][m][1]); } }
    }
};
struct EpiQ8 {
    static constexpr bool PERM = true, BPRE = false;
    unsigned char* Q8; const float* cs;
    __device__ __forceinline__ void operator()(const f32x4 (&acc)[2][2][4][2], const Unit& u, int wr, int wc, int fr, int fq) const {
        const unsigned lo = (unsigned)(fr * 192 + 8 * fq), lcs = (unsigned)(fr * 64 + 8 * fq) * 4u;
        const int rowU = u.pm * BM + wr * 64;
#pragma unroll
        for (int bj = 0; bj < 2; ++bj) { const int c32 = u.pn * BM + bj * HALF + wc * 32, hd = c32 / 192, w32 = c32 - hd * 192;
            char* ub = (char*)(Q8 + ((size_t)hd * SEQ + rowU) * 192 + w32);
            const char* cb = (const char*)(cs + (size_t)rowU * 64 + (w32 >= 128 ? (w32 - 128) : 0));
#pragma unroll
            EPI_ROWLOOP { const int rr = ai * HALF + m * 16; f32x4 v0 = acc[ai][bj][m][0], v1 = acc[ai][bj][m][1];
                if (w32 >= 128) { const f32x4 ca = *(const f32x4*)(cb + (size_t)rr * 256 + lcs), cc = *(const f32x4*)(cb + (size_t)rr * 256 + 16 + lcs);
                    const f32x4 a = v0, b = v1;
                    v0[0] = a[0] * ca[0] - a[1] * ca[1]; v0[1] = a[0] * ca[1] + a[1] * ca[0]; v0[2] = a[2] * ca[2] - a[3] * ca[3]; v0[3] = a[2] * ca[3] + a[3] * ca[2];
                    v1[0] = b[0] * cc[0] - b[1] * cc[1]; v1[1] = b[0] * cc[1] + b[1] * cc[0]; v1[2] = b[2] * cc[2] - b[3] * cc[3]; v1[3] = b[2] * cc[3] + b[3] * cc[2]; }
                v0 = v0 * QK_LOG2_SCALE; v1 = v1 * QK_LOG2_SCALE;
                u32x2 o; o.x = pk4_fp8(v0[0], v0[1], v0[2], v0[3]); o.y = pk4_fp8(v1[0], v1[1], v1[2], v1[3]);
                *(u32x2*)(ub + (size_t)rr * 192 + lo) = o;
                if (m & 1) asm volatile("" ::: "memory"); } }
    }
};
struct EpiK8 {
    static constexpr bool PERM = true, BPRE = false;
    unsigned char* K8;
    __device__ __forceinline__ void operator()(const f32x4 (&acc)[2][2][4][2], const Unit& u, int wr, int wc, int fr, int fq) const {
        const int rowU = u.pm * BM + wr * 64; const unsigned lo = (unsigned)(fr * 192 + 8 * fq);
#pragma unroll
        for (int bj = 0; bj < 2; ++bj) { const int c32 = u.pn * BM + bj * HALF + wc * 32, hd = c32 >> 7, w32 = c32 & 127;
            char* ub = (char*)(K8 + ((size_t)hd * SEQ + rowU) * 192 + w32);
#pragma unroll
            EPI_ROWLOOP { const f32x4 v0 = acc[ai][bj][m][0], v1 = acc[ai][bj][m][1];
                u32x2 o; o.x = pk4_fp8(v0[0], v0[1], v0[2], v0[3]); o.y = pk4_fp8(v1[0], v1[1], v1[2], v1[3]);
                *(u32x2*)(ub + (size_t)(ai * HALF + m * 16) * 192 + lo) = o; } }
    }
};
struct EpiVT8 {
    static constexpr bool PERM = true, BPRE = false;
    unsigned char* VT8;
    __device__ __forceinline__ void operator()(const f32x4 (&acc)[2][2][4][2], const Unit& u, int wr, int wc, int fr, int fq) const {
#pragma unroll
        for (int bj = 0; bj < 2; ++bj) { const int T0 = u.pn * BM + bj * HALF + wc * 32 + 8 * fq, tile = T0 >> 6, G0 = (T0 & 63) >> 2, half = G0 >> 3, a = (G0 & 7) >> 1;
            const int p0 = 4 * (4 * half + a), p1 = 4 * (8 + 4 * half + a);
#pragma unroll
            EPI_ROWLOOP { const int r = u.pm * BM + ai * HALF + wr * 64 + m * 16 + fr, hd = r >> 7, col = r & 127;
                unsigned char* dst = VT8 + (((size_t)hd * (SEQ / 64) + tile) * 128 + col) * 64;
                const f32x4 v0 = acc[ai][bj][m][0], v1 = acc[ai][bj][m][1];
                *(unsigned*)(dst + p0) = pk4_fp8(v0[0], v0[1], v0[2], v0[3]); *(unsigned*)(dst + p1) = pk4_fp8(v1[0], v1[1], v1[2], v1[3]); } }
    }
};
struct EpiRes {
    static constexpr bool PERM = false, BPRE = false;
    const float* x; float* out; const float* mod; float sc;
    __device__ __forceinline__ void operator()(const f32x4 (&acc)[2][2][4][2], const Unit& u, int wr, int wc, int fr, int fq) const {
        const int col0 = u.pn * BM + wc * 32 + 4 * fq;
        const int b = (u.pm * BM) / SEQ;
        f32x4 gt[2][2];
#pragma unroll
        for (int bj = 0; bj < 2; ++bj)
#pragma unroll
            for (int n = 0; n < 2; ++n) gt[bj][n] = *(const f32x4*)(mod + b * 6144 + 2048 + col0 + bj * HALF + n * 16) * sc;
        const unsigned lo = (unsigned)(fr * DM + 4 * fq) * 4u;
        const size_t ubo = ((size_t)(u.pm * BM + wr * 64) * DM + u.pn * BM + wc * 32) * 4;
#pragma unroll
        EPI_ROWLOOP { const size_t ro = ubo + (size_t)(ai * HALF + m * 16) * DM * 4;
#pragma unroll
            for (int bj = 0; bj < 2; ++bj)
#pragma unroll
                for (int n = 0; n < 2; ++n) { const size_t o = ro + (bj * HALF + n * 16) * 4; const f32x4 xv = *(const f32x4*)((const char*)x + o + lo);
                    *(f32x4*)((char*)out + o + lo) = xv + gt[bj][n] * acc[ai][bj][m][n]; }
            if (m & 1) asm volatile("" ::: "memory"); }
    }
};
struct EpiSwiGLU {
    static constexpr bool PERM = true, BPRE = true;
    void* HID; float sc;
    __device__ __forceinline__ void operator()(const f32x4 (&acc)[2][2][4][2], const Unit& u, int wr, int wc, int fr, int fq) const {
        constexpr int HE = FP8_EX ? 1 : 2;
        const __amdgpu_buffer_rsrc_t rs = __builtin_amdgcn_make_buffer_rsrc(HID, 0, 0x7fffffff, 0x00020000);
        const unsigned lo = (unsigned)(fr * DFF + 4 * fq) * HE, so = (unsigned)(((u.g * CAP + u.pm * BM + wr * 64) * DFF + ((u.pn * BM + wc * 32) >> 1)) * HE);
#pragma unroll
        EPI_ROWLOOP {
#pragma unroll
            for (int bj = 0; bj < 2; ++bj) { const f32x4 gv = acc[ai][bj][m][0] * sc, uv = acc[ai][bj][m][1] * sc; f32x4 h;
#pragma unroll
                for (int e = 0; e < 4; ++e) h[e] = gv[e] * fast_sigmoid(gv[e]) * uv[e];
                const unsigned ro = so + (unsigned)((ai * HALF + m * 16) * DFF + bj * (HALF / 2)) * HE;
#if !defined(EPI_BUF_STORES)
                if constexpr (FP8_EX) *(unsigned*)((char*)HID + (size_t)ro + lo) = pk4_fp8(h[0], h[1], h[2], h[3]);
                else { u32x2 o; o.x = cvt_pk_bf16(h[0], h[1]); o.y = cvt_pk_bf16(h[2], h[3]); *(u32x2*)((char*)HID + (size_t)ro + lo) = o; }
#else
                if constexpr (FP8_EX) __builtin_amdgcn_raw_buffer_store_b32(pk4_fp8(h[0], h[1], h[2], h[3]), rs, lo, ro, 0);
                else { u32x2 o; o.x = cvt_pk_bf16(h[0], h[1]); o.y = cvt_pk_bf16(h[2], h[3]); __builtin_amdgcn_raw_buffer_store_b64(o, rs, lo, ro, 0); }
#endif
            } }
    }
};
struct EpiDown {
    static constexpr bool PERM = true, BPRE = true;
    bf16_t* Y; const float* gate; float sc;
    __device__ __forceinline__ void operator()(const f32x4 (&acc)[2][2][4][2], const Unit& u, int wr, int wc, int fr, int fq) const {
        const int rowU = u.g * CAP + u.pm * BM + wr * 64;
        const __amdgpu_buffer_rsrc_t rs = __builtin_amdgcn_make_buffer_rsrc((void*)Y, 0, 0x7fffffff, 0x00020000), rg = __builtin_amdgcn_make_buffer_rsrc((void*)gate, 0, 0x7fffffff, 0x00020000);
        const unsigned lo = (unsigned)(fr * DM + 8 * fq) * 2u, so = (unsigned)((rowU * DM + u.pn * BM + wc * 32) * 2);
#pragma unroll
        EPI_ROWLOOP { const int rr = ai * HALF + m * 16;
#if !defined(EPI_BUF_STORES)
            const float gs = gate[rowU + rr + fr] * sc;
#pragma unroll
            for (int bj = 0; bj < 2; ++bj) *(u32x4*)((char*)Y + (size_t)(so + (unsigned)(rr * DM + bj * HALF) * 2u) + lo) = pack8(acc[ai][bj][m][0] * gs, acc[ai][bj][m][1] * gs);
#else
            const float gs = __uint_as_float(__builtin_amdgcn_raw_buffer_load_b32(rg, (unsigned)fr * 4u, (unsigned)(rowU + rr) * 4u, 0)) * sc;
#pragma unroll
            for (int bj = 0; bj < 2; ++bj) __builtin_amdgcn_raw_buffer_store_b128(pack8(acc[ai][bj][m][0] * gs, acc[ai][bj][m][1] * gs), rs, lo, so + (unsigned)(rr * DM + bj * HALF) * 2u, 0);
#endif
        }
    }
};
#undef EPI_ROWLOOP
}
namespace att {
__device__ __forceinline__ int crow(int r, int hi) { return (r & 3) + 8 * (r >> 2) + 4 * hi; }
__device__ __forceinline__ int v_st(int k, int c) { const int kk = (k & ~0xC) | ((k & 4) << 1) | ((k & 8) >> 1); return ((kk >> 3) * 4 + (c >> 5)) * 512 + ((kk & 7) * 32 + (c & 31)) * 2; }
__device__ __forceinline__ int v_rd_base(int lane) { return ((lane & 3) << 3) | (((lane >> 2) & 3) << 6) | (((lane >> 4) & 1) << 5) | (((lane >> 5) & 1) << 8); }
constexpr int v_rd_off(int d0, int ks, int half) { return d0 * 512 + ks * 4096 + half * 2048; }
template <int OFF> __device__ __forceinline__ s16x4 tr_read(int vb) {
    s16x4 r; asm volatile("ds_read_b64_tr_b16 %0, %1 offset:%2" : "=&v"(r) : "v"(vb), "i"(OFF) : "memory"); return r;
}
#define ATT_SBAR() __builtin_amdgcn_sched_barrier(0)
template <int D0> __device__ __forceinline__ void pv_one(f32x16& od, int vb, bf16x8 pa0, bf16x8 pa1, bf16x8 pa2, bf16x8 pa3) {
    const s16x4 l0 = tr_read<v_rd_off(D0, 0, 0)>(vb), h0 = tr_read<v_rd_off(D0, 0, 1)>(vb), l1 = tr_read<v_rd_off(D0, 1, 0)>(vb), h1 = tr_read<v_rd_off(D0, 1, 1)>(vb);
    const s16x4 l2 = tr_read<v_rd_off(D0, 2, 0)>(vb), h2 = tr_read<v_rd_off(D0, 2, 1)>(vb), l3 = tr_read<v_rd_off(D0, 3, 0)>(vb), h3 = tr_read<v_rd_off(D0, 3, 1)>(vb);
    asm volatile("s_waitcnt lgkmcnt(0)" ::: "memory"); ATT_SBAR();
#define ATT_PK(L, H) (bf16x8){L[0], L[1], L[2], L[3], H[0], H[1], H[2], H[3]}
    od = __builtin_amdgcn_mfma_f32_32x32x16_bf16(pa0, ATT_PK(l0, h0), od, 0, 0, 0);
    od = __builtin_amdgcn_mfma_f32_32x32x16_bf16(pa1, ATT_PK(l1, h1), od, 0, 0, 0);
    od = __builtin_amdgcn_mfma_f32_32x32x16_bf16(pa2, ATT_PK(l2, h2), od, 0, 0, 0);
    od = __builtin_amdgcn_mfma_f32_32x32x16_bf16(pa3, ATT_PK(l3, h3), od, 0, 0, 0);
#undef ATT_PK
}
__device__ __forceinline__ void pv_d0(f32x16* o, int vb, bf16x8 pa0, bf16x8 pa1, bf16x8 pa2, bf16x8 pa3) {
    pv_one<0>(o[0], vb, pa0, pa1, pa2, pa3); pv_one<1>(o[1], vb, pa0, pa1, pa2, pa3); pv_one<2>(o[2], vb, pa0, pa1, pa2, pa3); pv_one<3>(o[3], vb, pa0, pa1, pa2, pa3);
}
__device__ __forceinline__ void finishSM(f32x16& p0, f32x16& p1, float alpha, float& l_reg, bf16x8& pa0, bf16x8& pa1, bf16x8& pa2, bf16x8& pa3) {
#pragma unroll
    for (int r = 0; r < 16; ++r) p1[r] = __builtin_amdgcn_exp2f(p1[r]);
    float ps = 0;
#pragma unroll
    for (int r = 0; r < 16; ++r) ps += p0[r];
#pragma unroll
    for (int r = 0; r < 16; ++r) ps += p1[r];
    { auto rr = __builtin_amdgcn_permlane32_swap(__float_as_uint(ps), __float_as_uint(ps), false, false);
      ps = __uint_as_float(rr[0]) + __uint_as_float(rr[1]); }
    l_reg = l_reg * alpha + ps;
#define ATT_PK4(P, BASE, OUT) do { unsigned a0 = cvt_pk_bf16(P[BASE + 0], P[BASE + 1]), a1 = cvt_pk_bf16(P[BASE + 2], P[BASE + 3]);   \
    unsigned b0 = cvt_pk_bf16(P[BASE + 4], P[BASE + 5]), b1 = cvt_pk_bf16(P[BASE + 6], P[BASE + 7]);                              \
    auto r0 = __builtin_amdgcn_permlane32_swap(a0, b0, false, false); auto r1 = __builtin_amdgcn_permlane32_swap(a1, b1, false, false); \
    u32x4 w = {r0[0], r1[0], r0[1], r1[1]}; OUT = *reinterpret_cast<bf16x8*>(&w); } while (0)
    ATT_PK4(p0, 0, pa0); ATT_PK4(p0, 8, pa1); ATT_PK4(p1, 0, pa2); ATT_PK4(p1, 8, pa3);
#undef ATT_PK4
}

struct Unit {
    const bf16_t* Q; int qs;
    const bf16_t* K; int ks;
    const bf16_t* V; int vs;
    bf16_t* O; int os;
    int nt;
    int tmul;
    float* dbg;
    const float* lutg;
    int kt0, ktn;
    int l0;
    const int* pos; int ps;
    float* lse; int ls;
    const float* bias;
};

template <bool DIL> struct Cfg {
    static constexpr bool K8 = DIL && (DIL_FP8 != 0);
    static constexpr int DQK = DIL ? 128 : 192, ND = K8 ? 4 : DQK / 16, KROWB = (K8 ? DQK : DQK * 2) + 16, SHM_K = 64 * KROWB, SHM_V = 16384;
    static constexpr int NKC = DQK / 64;
    static constexpr int OFF_V = 0, OFF_K = 2 * SHM_V, OFF_WS = (OFF_K + 2 * SHM_K > 8 * 8448 ? OFF_K + 2 * SHM_K : 8 * 8448)  , OFF_POS = OFF_WS + NWAVES * 64 * 4, OFF_LUT = OFF_POS + 2 * 64 * 4, END = OFF_LUT + 9216;
    static constexpr float SCALE = DIL ? 0.088388347648318440f : 0.072168783648703220f;
};

template <bool DIL>
__device__ __forceinline__ void qkt(f32x16& p0, f32x16& p1, const LAS char* Ks, const bf16x8* qr, int r32, int hi) {
    using C = Cfg<DIL>;
    p0 = f32x16{}; p1 = f32x16{};
    const LAS char* k0 = Ks + r32 * C::KROWB + hi * 16; const LAS char* k1 = k0 + 32 * C::KROWB;
#pragma unroll
    for (int d0 = 0; d0 < C::ND; ++d0) {
        const bf16x8 b0 = *(const LAS bf16x8*)(k0 + d0 * 32);
        const bf16x8 b1 = *(const LAS bf16x8*)(k1 + d0 * 32);
        p0 = __builtin_amdgcn_mfma_f32_32x32x16_bf16(b0, qr[d0], p0, 0, 0, 0);
        p1 = __builtin_amdgcn_mfma_f32_32x32x16_bf16(b1, qr[d0], p1, 0, 0, 0); }
}

template <bool DIL>
__device__ __forceinline__ void xstage(bool pv, bool qk, f32x16* o, int vb, bf16x8 pa0, bf16x8 pa1, bf16x8 pa2, bf16x8 pa3, f32x16& p0, f32x16& p1, const LAS char* Ks, const bf16x8* qr, int r32, int hi) {
    using C = Cfg<DIL>;
    constexpr int NG = C::ND / 2;
    const LAS char* k0 = Ks + r32 * C::KROWB + hi * (C::K8 ? 32 : 16);
    bf16x8 f[2][4];
    const int ka = (int)(unsigned)(size_t)k0;
#define ATT_KR1(dst_, off_) asm volatile("ds_read_b128 %0, %1 offset:%2" : "=&v"(dst_) : "v"(ka), "i"(off_) : "memory")
#define ATT_KRD(s_, g_) do { if constexpr (C::K8) { ATT_KR1(f[s_][0], 64 * (g_)); ATT_KR1(f[s_][1], 64 * (g_) + 16); ATT_KR1(f[s_][2], 32 * C::KROWB + 64 * (g_)); ATT_KR1(f[s_][3], 32 * C::KROWB + 64 * (g_) + 16); } \
        else { ATT_KR1(f[s_][0], (2 * (g_)) * 32); ATT_KR1(f[s_][1], 32 * C::KROWB + (2 * (g_)) * 32); ATT_KR1(f[s_][2], (2 * (g_) + 1) * 32); ATT_KR1(f[s_][3], 32 * C::KROWB + (2 * (g_) + 1) * 32); } } while (0)
#define ATT_PK(L, H) (bf16x8){L[0], L[1], L[2], L[3], H[0], H[1], H[2], H[3]}
#define ATT_VRD1(B_, s_, ks_) do { const s16x4 l_ = tr_read<v_rd_off(B_, ks_, 0)>(vb), h_ = tr_read<v_rd_off(B_, ks_, 1)>(vb); f[s_][ks_] = ATT_PK(l_, h_); } while (0)
#define ATT_VRD(B_, s_) do { ATT_VRD1(B_, s_, 0); ATT_VRD1(B_, s_, 1); ATT_VRD1(B_, s_, 2); ATT_VRD1(B_, s_, 3); } while (0)
#define ATT_VMMA(B_, s_) do { o[B_] = __builtin_amdgcn_mfma_f32_32x32x16_bf16(pa0, f[s_][0], o[B_], 0, 0, 0); o[B_] = __builtin_amdgcn_mfma_f32_32x32x16_bf16(pa1, f[s_][1], o[B_], 0, 0, 0); \
        o[B_] = __builtin_amdgcn_mfma_f32_32x32x16_bf16(pa2, f[s_][2], o[B_], 0, 0, 0); o[B_] = __builtin_amdgcn_mfma_f32_32x32x16_bf16(pa3, f[s_][3], o[B_], 0, 0, 0); } while (0)
#define ATT_LW(n) asm volatile("s_waitcnt lgkmcnt(" #n ")" ::: "memory")
    if (pv) {
        ATT_VRD(0, 0); ATT_SBAR();
        ATT_VRD(1, 1); ATT_LW(8); ATT_SBAR(); ATT_VMMA(0, 0); ATT_SBAR();
        ATT_VRD(2, 0); ATT_LW(8); ATT_SBAR(); ATT_VMMA(1, 1); ATT_SBAR();
        ATT_VRD(3, 1); ATT_LW(8); ATT_SBAR(); ATT_VMMA(2, 0); ATT_SBAR();
        ATT_KRD(0, 0); ATT_LW(4); ATT_SBAR(); ATT_VMMA(3, 1); ATT_SBAR();
    } else { ATT_KRD(0, 0); ATT_SBAR(); }
    if (!qk) { ATT_LW(0); return; }
    p0 = f32x16{}; p1 = f32x16{};
    if constexpr (C::K8) {
#define ATT_CAT(x_, y_) __builtin_shufflevector(__builtin_bit_cast(i32x4, x_), __builtin_bit_cast(i32x4, y_), 0, 1, 2, 3, 4, 5, 6, 7)
        ATT_KRD(1, 1); ATT_LW(4); ATT_SBAR();
        p0 = __builtin_amdgcn_mfma_scale_f32_32x32x64_f8f6f4(ATT_CAT(f[0][0], f[0][1]), ATT_CAT(qr[0], qr[1]), p0, 0, 0, 0, 0, 0, 0);
        p1 = __builtin_amdgcn_mfma_scale_f32_32x32x64_f8f6f4(ATT_CAT(f[0][2], f[0][3]), ATT_CAT(qr[0], qr[1]), p1, 0, 0, 0, 0, 0, 0);
        ATT_SBAR(); ATT_LW(0); ATT_SBAR();
        p0 = __builtin_amdgcn_mfma_scale_f32_32x32x64_f8f6f4(ATT_CAT(f[1][0], f[1][1]), ATT_CAT(qr[2], qr[3]), p0, 0, 0, 0, 0, 0, 0);
        p1 = __builtin_amdgcn_mfma_scale_f32_32x32x64_f8f6f4(ATT_CAT(f[1][2], f[1][3]), ATT_CAT(qr[2], qr[3]), p1, 0, 0, 0, 0, 0, 0);
        ATT_SBAR();
#undef ATT_CAT
    } else {
#pragma unroll
    for (int g = 0; g < NG; ++g) { const int sg = g & 1;
        if (g + 1 < NG) { ATT_KRD(sg ^ 1, g + 1); ATT_LW(4); } else { ATT_LW(0); }
        ATT_SBAR();
        p0 = __builtin_amdgcn_mfma_f32_32x32x16_bf16(f[sg][0], qr[2 * g], p0, 0, 0, 0);
        p1 = __builtin_amdgcn_mfma_f32_32x32x16_bf16(f[sg][1], qr[2 * g], p1, 0, 0, 0);
        p0 = __builtin_amdgcn_mfma_f32_32x32x16_bf16(f[sg][2], qr[2 * g + 1], p0, 0, 0, 0);
        p1 = __builtin_amdgcn_mfma_f32_32x32x16_bf16(f[sg][3], qr[2 * g + 1], p1, 0, 0, 0);
        ATT_SBAR(); } }
#undef ATT_VRD1
#undef ATT_KRD
#undef ATT_KR1
#undef ATT_VRD
#undef ATT_PK
#undef ATT_VMMA
#undef ATT_LW
}

template <bool DIL>
__device__ __forceinline__ void partialSM(f32x16& p0, f32x16& p1, float& m_reg, float& mn, float& alpha,
                                          const LAS int* posb, int qoff, int lutlo, int dl0, bool masked, int hi) {
    using C = Cfg<DIL>;
    constexpr float CC = C::SCALE * LOG2E;
    constexpr float THR = 8.f;
    float mnC;
    if constexpr (DIL) {
        const LAS float* lutp = (const LAS float*)(size_t)(unsigned)lutlo;
#define ATT_LUT(pk_) ({ int u_ = (pk_) + qoff; u_ = u_ < 0 ? 0 : (u_ > 2048 ? 2048 : u_); lutp[u_ + (u_ >> 5)]; })
        float bz0[16], bz1[16];
#pragma unroll
        for (int a = 0; a < 4; ++a) {
            const i32x4 pk0 = *(const LAS i32x4*)(posb + 8 * a + 4 * hi), pk1 = *(const LAS i32x4*)(posb + 32 + 8 * a + 4 * hi);
#pragma unroll
            for (int b = 0; b < 4; ++b) { bz0[4 * a + b] = ATT_LUT(pk0[b]); bz1[4 * a + b] = ATT_LUT(pk1[b]); }
        }
        ATT_SBAR();
        if (masked) {
#pragma unroll
            for (int r = 0; r < 16; ++r) { const int dl = dl0 + 8 * (r >> 2) + (r & 3);
                p0[r] = ((unsigned)(dl + 64) <= 128u) ? fmaf(p0[r], CC, bz0[r]) : -1e30f;
                p1[r] = ((unsigned)(dl + 32 + 64) <= 128u) ? fmaf(p1[r], CC, bz1[r]) : -1e30f; }
        } else {
#pragma unroll
            for (int r = 0; r < 16; ++r) { p0[r] = fmaf(p0[r], CC, bz0[r]); p1[r] = fmaf(p1[r], CC, bz1[r]); }
        }
#undef ATT_LUT
        float pmax = p0[0];
#pragma unroll
        for (int r = 1; r < 16; ++r) pmax = fmaxf(pmax, p0[r]);
#pragma unroll
        for (int r = 0; r < 16; ++r) pmax = fmaxf(pmax, p1[r]);
        { auto rr = __builtin_amdgcn_permlane32_swap(__float_as_uint(pmax), __float_as_uint(pmax), false, false);
          pmax = fmaxf(__uint_as_float(rr[0]), __uint_as_float(rr[1])); }
        if (__builtin_expect(__all(pmax - m_reg <= THR * LOG2E), 1)) { mn = m_reg; alpha = 1.f; }
        else { mn = fmaxf(m_reg, pmax); alpha = __builtin_amdgcn_exp2f(m_reg - mn); m_reg = mn; }
        mnC = -fmaxf(mn, -1e29f);
#pragma unroll
        for (int r = 0; r < 16; ++r) p0[r] = p0[r] + mnC;
#pragma unroll
        for (int r = 0; r < 16; ++r) p1[r] = p1[r] + mnC;
    } else {
        float pmax = p0[0];
#pragma unroll
        for (int r = 1; r < 16; ++r) pmax = fmaxf(pmax, p0[r]);
#pragma unroll
        for (int r = 0; r < 16; ++r) pmax = fmaxf(pmax, p1[r]);
        { auto rr = __builtin_amdgcn_permlane32_swap(__float_as_uint(pmax), __float_as_uint(pmax), false, false);
          pmax = fmaxf(__uint_as_float(rr[0]), __uint_as_float(rr[1])); }
        if (__builtin_expect(__all(pmax - m_reg <= THR / C::SCALE), 1)) { mn = m_reg; alpha = 1.f; }
        else { mn = fmaxf(m_reg, pmax); alpha = __builtin_amdgcn_exp2f((m_reg - mn) * CC); m_reg = mn; }
        mnC = -mn * CC;
#pragma unroll
        for (int r = 0; r < 16; ++r) p0[r] = fmaf(p0[r], CC, mnC);
#pragma unroll
        for (int r = 0; r < 16; ++r) p1[r] = fmaf(p1[r], CC, mnC);
    }
#pragma unroll
    for (int r = 0; r < 16; ++r) p0[r] = __builtin_amdgcn_exp2f(p0[r]);
}

__device__ __forceinline__ int t5_bucket(int rel) {
    const int n = rel < 0 ? -rel : rel;
    const float nf = (float)(n > 1 ? n : 1);
    int large = 8 + (int)(logf(nf / 8.f) / 4.852030263919617f * 8.f);
    large = large < 15 ? large : 15;
    return (rel > 0 ? 16 : 0) + (n < 8 ? n : large);
}

template <bool DIL>
__device__ __forceinline__ void attn_unit(const Unit& a, LAS char* lds, int wv) {
    using C = Cfg<DIL>;
    constexpr int SD = 1;
    const int tid = opaque_tid(wv), wid = __builtin_amdgcn_readfirstlane(tid >> 6), lane = tid & 63, r32 = lane & 31, hi = lane >> 5;
#if defined(PROBE_TIMING)
    const unsigned long long t_entry = __builtin_amdgcn_s_memtime();
#endif
    LAS char* V_lds = lds + C::OFF_V; LAS char* K_lds = lds + C::OFF_K;
    LAS float* ws = (LAS float*)(lds + C::OFF_WS) + wid * 64; LAS float* li_l = ws; LAS float* al_l = ws + 32;
    LAS int* pos_l = (LAS int*)(lds + C::OFF_POS); LAS float* lut = (LAS float*)(lds + C::OFF_LUT);
    float m_reg = -1e30f, l_reg = 0; f32x16 o[4] = {}; bf16x8 qr[C::ND];
    if constexpr (C::K8) { const char* Qw = (const char*)(a.Q + (size_t)(wid * 32 + r32) * a.qs) + hi * 32;
#pragma unroll
      for (int i = 0; i < 4; ++i) qr[i] = *(const bf16x8*)(Qw + 64 * (i >> 1) + 16 * (i & 1)); }
    else { const bf16_t* Qw = a.Q + (size_t)(wid * 32 + r32) * a.qs + hi * 8;
#pragma unroll
      for (int d0 = 0; d0 < C::ND; ++d0) qr[d0] = *(const bf16x8*)(Qw + d0 * 16); }
    int pq = 0, lq = 0;
    if constexpr (DIL) {
        lq = a.l0 + wid * 32 + r32; pq = a.pos[(size_t)lq * a.ps];
        pq = 1024 - pq;
        { const char* ls = (const char*)a.lutg + lane * 16; LAS char* ld = (LAS char*)lut;
          __builtin_amdgcn_global_load_lds((const unsigned*)(ls + wid * 1024), (LAS unsigned*)(ld + wid * 1024), 16, 0, 0);
          if (wid == 0) __builtin_amdgcn_global_load_lds((const unsigned*)(ls + 8192), (LAS unsigned*)(ld + 8192), 16, 0, 0); }
    }
    constexpr int CPR = C::KROWB / 16, NKP = C::SHM_K / 1024, NKI = (NKP + 7) / 8;
    unsigned kgo[NKI];
#pragma unroll
    for (int i = 0; i < NKI; ++i) { const int pch = (wid + 8 * i) * 64 + lane, kr = pch / CPR, kc = pch % CPR; kgo[i] = (unsigned)(kr * a.ks + (kc == CPR - 1 ? 0 : kc) * 8) * 2u; }
    unsigned vgo[2];
#pragma unroll
    for (int i = 0; i < 2; ++i) { const int pch = (wid + 8 * i) * 64 + lane, sub = pch >> 5, within = pch & 31, kk = (sub >> 2) * 8 + (within >> 2), cc = (sub & 3) * 32 + (within & 3) * 8;
        const int k = (kk & ~0xC) | ((kk & 4) << 1) | ((kk & 8) >> 1); vgo[i] = (unsigned)(k * a.vs + cc) * 2u; }
    const int vb0 = (int)(unsigned)(size_t)V_lds + v_rd_base(lane);
    int ppos = 0, ppos_n = 0;
#define ATT_KROW0(j) (DIL ? (((a.kt0 + (j)) < 0 ? 0 : ((a.kt0 + (j)) >= a.ktn ? a.ktn - 1 : (a.kt0 + (j)))) * 64) : (j) * 64 * a.tmul)
#define ATT_DMAK(j) do { const int k0_ = ATT_KROW0(j); const char* kt_ = (const char*)(a.K + (size_t)k0_ * a.ks); LAS char* kd_ = K_lds + ((j) & 1) * C::SHM_K + wid * 1024; \
        _Pragma("unroll") for (int q_ = 0; q_ < NKI; ++q_) if (wid + 8 * q_ < NKP) \
            __builtin_amdgcn_global_load_lds((const unsigned*)(kt_ + kgo[q_]), (LAS unsigned*)(kd_ + q_ * 8192), 16, 0, 0); } while (0)
#define ATT_DMAV(j) do { const int k0_ = ATT_KROW0(j); const char* vt_ = (const char*)(a.V + (size_t)k0_ * a.vs); LAS char* vd_ = V_lds + ((j) & 1) * C::SHM_V + wid * 1024; \
        __builtin_amdgcn_global_load_lds((const unsigned*)(vt_ + vgo[0]), (LAS unsigned*)(vd_), 16, 0, 0); \
        __builtin_amdgcn_global_load_lds((const unsigned*)(vt_ + vgo[1]), (LAS unsigned*)(vd_ + 8192), 16, 0, 0); } while (0)
#define ATT_LOADPOS(dst_, j) do { if constexpr (DIL) { if (tid < 64) dst_ = a.pos[(size_t)(ATT_KROW0(j) + tid) * a.ps]; } } while (0)
#define ATT_WRITEPOS(j) do { if constexpr (DIL) { if (tid < 64) pos_l[((j) & 1) * 64 + tid] = ppos; } } while (0)
#define ATT_VMW() asm volatile("s_waitcnt vmcnt(0)" ::: "memory")
#define ATT_BAR() do { asm volatile("s_waitcnt lgkmcnt(0)" ::: "memory"); __builtin_amdgcn_s_barrier(); asm volatile("" ::: "memory"); } while (0)
#define ATT_RESC(al) do { if (__any((al) < 1.f)) { if (hi == 0) al_l[r32] = (al); asm volatile("s_waitcnt lgkmcnt(0)" ::: "memory"); \
        _Pragma("unroll") for (int d = 0; d < 4; ++d) _Pragma("unroll") for (int r = 0; r < 16; ++r) o[d][r] *= al_l[crow(r, hi)]; } } while (0)
#define ATT_DL0(j) (DIL ? (ATT_TV(j) ? (64 * (a.kt0 + (j)) - lq + 4 * hi) : 0x20000000) : 0)
#define ATT_TV(j) (DIL ? ((a.kt0 + (j)) >= 0 && (a.kt0 + (j)) < a.ktn) : true)
#define ATT_MASKED(j) (DIL ? ((j) != (wid >> 1) + 1) : false)
    f32x16 p0, p1; float mn, al; bf16x8 pa0, pa1, pa2, pa3; const int NT = a.nt;
    const bool grpB = wid >= 4;
    ATT_DMAK(0); ATT_DMAK(1); ATT_DMAV(0); ATT_LOADPOS(ppos, 0); ATT_VMW(); ATT_WRITEPOS(0); ATT_LOADPOS(ppos, 1);
    __syncthreads();
    if (grpB) ATT_BAR();
#if defined(PROBE_TIMING)
    unsigned long long tacc = 0, tt0 = 0; const unsigned long long tstart = __builtin_amdgcn_s_memtime(), rstart = __builtin_amdgcn_s_memrealtime();
#define TSTAMP() __builtin_amdgcn_s_memtime()
#else
#define TSTAMP() 0ull
#endif
#pragma unroll 1
    for (int j = 0; j < NT; ++j) {
        const int cur = j & 1;
#if defined(PROBE_TIMING)
        tt0 = TSTAMP();
#endif
        if (!grpB && j >= 1) { if (j + 1 < NT) ATT_DMAK(j + 1); ATT_DMAV(j); }
        if constexpr (DIL) { if (!grpB && j + 2 < NT) ATT_LOADPOS(ppos_n, j + 2); }
        ATT_SBAR();
        const bool act = !DIL || (j >= (wid >> 1) && j <= (wid >> 1) + 2), actp = !DIL || (j - 1 >= (wid >> 1) && j - 1 <= (wid >> 1) + 2);
        xstage<DIL>(j > 0 && actp, act, o, vb0 + (cur ^ 1) * (int)C::SHM_V, pa0, pa1, pa2, pa3, p0, p1, K_lds + cur * C::SHM_K, qr, r32, hi);
        ATT_SBAR();
#if defined(PROBE_TIMING) && PROBE_TIMING == 2
        tacc += TSTAMP() - tt0;
#endif
#if defined(PROBE_TIMING) && PROBE_TIMING == 6
        tt0 = TSTAMP();
#endif
        if (grpB) ATT_VMW();
#if defined(PROBE_TIMING) && PROBE_TIMING == 6
        tacc += TSTAMP() - tt0;
#endif
#if defined(PROBE_TIMING) && PROBE_TIMING == 5
        tt0 = TSTAMP();
#endif
        ATT_BAR();
#if defined(PROBE_TIMING) && PROBE_TIMING == 5
        tacc += TSTAMP() - tt0;
#endif
#if defined(PROBE_TIMING) && PROBE_TIMING == 3
        tt0 = TSTAMP();
#endif
        if (grpB) { if (j + 2 < NT) ATT_DMAK(j + 2); if (j + 1 < NT) ATT_DMAV(j + 1); }
        if (act) {
        partialSM<DIL>(p0, p1, m_reg, mn, al, pos_l + cur * 64, pq, (int)(unsigned)(size_t)lut, ATT_DL0(j), ATT_MASKED(j), hi);
        ATT_RESC(al);
        finishSM(p0, p1, al, l_reg, pa0, pa1, pa2, pa3);
        }
        if constexpr (DIL) { if (!grpB && j + 1 < NT) { ATT_WRITEPOS(j + 1); ppos = ppos_n; } }
        ATT_SBAR();
#if defined(PROBE_TIMING) && PROBE_TIMING == 3
        tacc += TSTAMP() - tt0;
#endif
#if defined(PROBE_TIMING) && PROBE_TIMING == 6
        tt0 = TSTAMP();
#endif
        if (!grpB) ATT_VMW();
#if defined(PROBE_TIMING) && PROBE_TIMING == 6
        tacc += TSTAMP() - tt0;
#endif
        ATT_BAR();
    }
#if defined(PROBE_TIMING)
    if (DIL && a.dbg && tid == PROBE_TID && PROBE_TIMING == 8) *a.dbg = (float)(TSTAMP() - tstart) * 1e-6f;
    if (a.dbg && tid == PROBE_TID && PROBE_TIMING < 7) { const unsigned long long tend = TSTAMP(), rend = __builtin_amdgcn_s_memrealtime(); float v;
        if (PROBE_TIMING == 1) v = (float)(tend - tstart) / (float)NT * 1e-5f;
        else if (PROBE_TIMING == 4) v = (float)(tend - tstart) / (float)(rend - rstart) * 1e-3f;
        else v = (float)tacc / (float)NT * 1e-5f;
        *a.dbg = v; }
#endif
    if (!DIL || (NT - 1 <= (wid >> 1) + 2)) pv_d0(o, vb0 + ((NT - 1) & 1) * (int)C::SHM_V, pa0, pa1, pa2, pa3);
    if (!grpB) ATT_BAR();
    ATT_BAR();
    if (hi == 0) li_l[r32] = l_reg; asm volatile("s_waitcnt lgkmcnt(0)" ::: "memory");
    { LAS char* ot = lds + wid * 8448;
#pragma unroll
      for (int r = 0; r < 16; ++r) { const int orow = crow(r, hi); const float rl = __builtin_amdgcn_rcpf(li_l[orow]);
#pragma unroll
          for (int d0 = 0; d0 < 4; ++d0) { const float v = o[d0][r] * rl; *(LAS bf16_t*)(ot + orow * 264 + (d0 * 32 + r32) * 2) = (bf16_t)(cvt_pk_bf16(v, v) & 0xffffu); } }
      asm volatile("s_waitcnt lgkmcnt(0)" ::: "memory");
      char* Ow = (char*)(a.O + (size_t)(wid * 32) * a.os);
      const int orow0 = lane >> 4, ocol = (lane & 15) * 16;
#pragma unroll
      for (int i = 0; i < 8; ++i) { const int orow = orow0 + 4 * i; const u32x2 w0 = *(const LAS u32x2*)(ot + orow * 264 + ocol), w1 = *(const LAS u32x2*)(ot + orow * 264 + ocol + 8);
          u32x4 w; w.x = w0.x; w.y = w0.y; w.z = w1.x; w.w = w1.y;
          *(u32x4*)(Ow + (size_t)orow * a.os * 2 + ocol) = w; } }
    if constexpr (DIL) { if (hi == 0) a.lse[(size_t)(wid * 32 + r32) * a.ls] = m_reg + __builtin_amdgcn_logf(l_reg); }
    __syncthreads();
#if defined(PROBE_TIMING)
    if (DIL && a.dbg && tid == PROBE_TID && PROBE_TIMING == 7) *a.dbg = (float)(__builtin_amdgcn_s_memtime() - t_entry) * 1e-6f;
#endif
#undef ATT_KROW0
#undef ATT_BAR
#undef ATT_DMAK
#undef ATT_DMAV
#undef ATT_LOADPOS
#undef ATT_WRITEPOS
#undef ATT_VMW
#undef ATT_RESC
#undef ATT_DL0
#undef ATT_TV
#undef ATT_MASKED
}
struct Unit8 { const unsigned char* Q; const unsigned char* K; const unsigned char* VT; bf16_t* O; int os, nt; float* dbg; };
__device__ __forceinline__ v8i ld32(const LAS char* p) { return __builtin_shufflevector(*(const LAS i32x4*)p, *(const LAS i32x4*)(p + 16), 0, 1, 2, 3, 4, 5, 6, 7); }
#define ATT8_MFMA(a_, b_, c_) __builtin_amdgcn_mfma_scale_f32_32x32x64_f8f6f4(a_, b_, c_, 0, 0, 0, 0, 0, 0)
__device__ __forceinline__ void attn_mla8_unit(const Unit8& a, LAS char* lds, int wv) {
    constexpr int KROWB = 208, SHM_K = 64 * KROWB  , VROWB = 80, SHM_V = 128 * VROWB  , NKP = 13, NVP = 10;
    constexpr int NSLOT = MLA_2T ? 4 : 3;
    constexpr int OFF_V = 0, OFF_K = NSLOT * SHM_V, OFF_WS = OFF_K + NSLOT * SHM_K;
    static_assert(OFF_WS + 8 * 64 * 4 <= RING_BYTES, "rings and per-wave words inside the ring area");
    static_assert(!(MLA_2T && MLA_PRE), "the fragment prefetch is written for the one-tile interval");
    static_assert(8 * 8448 <= OFF_WS, "output staging images below the per-wave words");
    constexpr float THR2 = 5.0f * LOG2E;
    const int tid = opaque_tid(wv), wid = __builtin_amdgcn_readfirstlane(tid >> 6), lane = tid & 63, r32 = lane & 31, hi = lane >> 5;
    LAS char* V_lds = lds + OFF_V; LAS char* K_lds = lds + OFF_K;
    LAS float* li_l = (LAS float*)(lds + OFF_WS) + wid * 64; LAS float* al_l = li_l + 32;
    float m2 = 0.f, l_reg = 0.f; f32x16 o[4] = {}; v8i qr[3];
    { const unsigned char* Qw = a.Q + (size_t)(wid * 32 + r32) * 192 + hi * 32;
#pragma unroll
      for (int c = 0; c < 3; ++c) qr[c] = __builtin_shufflevector(*(const i32x4*)(Qw + 64 * c), *(const i32x4*)(Qw + 64 * c + 16), 0, 1, 2, 3, 4, 5, 6, 7); }
    unsigned kgo[2], vgo[2];
#pragma unroll
    for (int i = 0; i < 2; ++i) { const int p = (wid + 8 * i) * 64 + lane, kr = p / 13, kc = p % 13; kgo[i] = (unsigned)(kr * 192 + (kc == 12 ? 0 : kc) * 16);
        const int vr = p / 5, vc = p % 5; vgo[i] = (unsigned)(vr * 64 + (vc == 4 ? 0 : vc) * 16); }
#define ATT8_DMAK(j, slot) do { const char* kt_ = (const char*)a.K + (size_t)(j) * 64 * 192; LAS char* kd_ = K_lds + (slot) * SHM_K + wid * 1024; \
        __builtin_amdgcn_global_load_lds((const unsigned*)(kt_ + kgo[0]), (LAS unsigned*)(kd_), 16, 0, 0); \
        if (wid + 8 < NKP) __builtin_amdgcn_global_load_lds((const unsigned*)(kt_ + kgo[1]), (LAS unsigned*)(kd_ + 8192), 16, 0, 0); } while (0)
#define ATT8_DMAV(j, slot) do { const char* vt_ = (const char*)a.VT + (size_t)(j) * 8192; LAS char* vd_ = V_lds + (slot) * SHM_V + wid * 1024; \
        __builtin_amdgcn_global_load_lds((const unsigned*)(vt_ + vgo[0]), (LAS unsigned*)(vd_), 16, 0, 0); \
        if (wid + 8 < NVP) __builtin_amdgcn_global_load_lds((const unsigned*)(vt_ + vgo[1]), (LAS unsigned*)(vd_ + 8192), 16, 0, 0); } while (0)
#define ATT8_VMW() asm volatile("s_waitcnt vmcnt(0)" ::: "memory")
#define ATT8_BAR() do { asm volatile("s_waitcnt lgkmcnt(0)" ::: "memory"); __builtin_amdgcn_s_barrier(); asm volatile("" ::: "memory"); } while (0)
#define ATT8_RD(dst_, addr_, off_) do { i32x4 lo_, hi_; asm volatile("ds_read_b128 %0, %1 offset:%2" : "=&v"(lo_) : "v"(addr_), "i"(off_) : "memory"); \
        asm volatile("ds_read_b128 %0, %1 offset:%2" : "=&v"(hi_) : "v"(addr_), "i"((off_) + 16) : "memory"); dst_ = __builtin_shufflevector(lo_, hi_, 0, 1, 2, 3, 4, 5, 6, 7); } while (0)
#define ATT8_LW(n) asm volatile("s_waitcnt lgkmcnt(" #n ")" ::: "memory")
    const int koff = r32 * KROWB + hi * 32, voff = r32 * VROWB + hi * 32;
    f32x16 p0, p1, nm16; v8i pa = {}; const int NT = a.nt;
#if MLA_LSUM
    f32x16 lacc = {}; v8i ones8; { int c_ = 0x38383838; asm volatile("" : "+v"(c_)); _Pragma("unroll") for (int i = 0; i < 8; ++i) ones8[i] = c_; }
#endif
    const bool grpB = wid >= 4;
    ATT8_DMAK(0, 0); ATT8_DMAK(1, 1); ATT8_DMAV(0, 0); ATT8_VMW();
    __syncthreads();
    int s0 = 0, s1 = 1, s2 = 2;
#define ATT8_ISSUE() do { if (j + 2 < NT) ATT8_DMAK(j + 2, s2); if (j + 1 < NT) ATT8_DMAV(j + 1, s1); } while (0)
#define ATT8_QK6(kb_, G0_, G1_, G2_, C0_, C1_) do { \
        ATT8_RD(G2_, kb_, 64); ATT8_LW(4); ATT_SBAR(); p0 = ATT8_MFMA(G0_, qr[0], C0_); ATT_SBAR(); \
        ATT8_RD(G0_, kb_, 32 * KROWB + 64); ATT8_LW(4); ATT_SBAR(); p1 = ATT8_MFMA(G1_, qr[0], C1_); ATT_SBAR(); \
        ATT8_RD(G1_, kb_, 128); ATT8_LW(4); ATT_SBAR(); p0 = ATT8_MFMA(G2_, qr[1], p0); ATT_SBAR(); \
        ATT8_RD(G2_, kb_, 32 * KROWB + 128); ATT8_LW(4); ATT_SBAR(); p1 = ATT8_MFMA(G0_, qr[1], p1); ATT_SBAR(); \
        ATT8_LW(2); ATT_SBAR(); p0 = ATT8_MFMA(G1_, qr[2], p0); ATT_SBAR(); \
        ATT8_LW(0); ATT_SBAR(); p1 = ATT8_MFMA(G2_, qr[2], p1); ATT_SBAR(); } while (0)
#if MLA_PKOLD
#define ATT8_PK4(w_, P_, q_) do { w_ = __builtin_amdgcn_cvt_pk_fp8_f32(P_[4 * (q_)], P_[4 * (q_) + 1], w_, false); w_ = __builtin_amdgcn_cvt_pk_fp8_f32(P_[4 * (q_) + 2], P_[4 * (q_) + 3], w_, true); } while (0)
#else
#define ATT8_PK4(w_, P_, q_) do { w_ = (int)pk4_fp8(P_[4 * (q_)], P_[4 * (q_) + 1], P_[4 * (q_) + 2], P_[4 * (q_) + 3]); } while (0)
#endif
#define ATT8_PACK() do { _Pragma("unroll") for (int q = 0; q < 4; ++q) { ATT8_PK4(pa[q], p0, q); ATT8_PK4(pa[4 + q], p1, q); } } while (0)
#define ATT8_PAIR(P_, i_) (f32x2){P_[2 * (i_)], P_[2 * (i_) + 1]}
#if MLA_PKADD
#define ATT8_SUM32(ps_) f32x2 pp_ = ATT8_PAIR(p0, 0); _Pragma("unroll") for (int r = 1; r < 8; ++r) pp_ += ATT8_PAIR(p0, r); _Pragma("unroll") for (int r = 0; r < 8; ++r) pp_ += ATT8_PAIR(p1, r); float ps_ = pp_[0] + pp_[1]
#else
#define ATT8_SUM32(ps_) float ps_ = 0.f; _Pragma("unroll") for (int r = 0; r < 16; ++r) ps_ += p0[r]; _Pragma("unroll") for (int r = 0; r < 16; ++r) ps_ += p1[r]
#endif
#if MLA_LSUM
#define ATT8_ROWSUM(al_) do { } while (0)
#define ATT8_LMFMA() lacc = ATT8_MFMA(pa, ones8, lacc)
#define ATT8_LRESC() do { _Pragma("unroll") for (int r = 0; r < 16; ++r) lacc[r] *= al_l[crow(r, hi)]; } while (0)
#else
#define ATT8_LMFMA() do { } while (0)
#define ATT8_LRESC() do { } while (0)
#define ATT8_ROWSUM(al_) do { ATT8_SUM32(ps_); \
        { auto rr = __builtin_amdgcn_permlane32_swap(__float_as_uint(ps_), __float_as_uint(ps_), false, false); ps_ = __uint_as_float(rr[0]) + __uint_as_float(rr[1]); } l_reg = l_reg * (al_) + ps_; } while (0)
#endif
#if MLA_NM16
#define ATT8_INIT() do { const float nm_ = -m2; _Pragma("unroll") for (int r = 0; r < 16; ++r) nm16[r] = nm_; } while (0)
#define ATT8_INIT_SLOW() nm16 -= dl
#define ATT8_INIT_TILE() do { } while (0)
#define ATT8_C0 nm16
#define ATT8_C1 nm16
#else
#define ATT8_INIT() do { } while (0)
#define ATT8_INIT_SLOW() do { } while (0)
#define ATT8_INIT_TILE() do { const float nm_ = -m2; _Pragma("unroll") for (int r = 0; r < 16; ++r) { p0[r] = nm_; p1[r] = nm_; } } while (0)
#define ATT8_C0 p0
#define ATT8_C1 p1
#endif
#define ATT8_ROWMAX(pm_) do { pm_ = p0[0]; _Pragma("unroll") for (int r = 1; r < 16; ++r) pm_ = fmaxf(pm_, p0[r]); _Pragma("unroll") for (int r = 0; r < 16; ++r) pm_ = fmaxf(pm_, p1[r]); \
        { auto rr = __builtin_amdgcn_permlane32_swap(__float_as_uint(pm_), __float_as_uint(pm_), false, false); pm_ = fmaxf(__uint_as_float(rr[0]), __uint_as_float(rr[1])); } } while (0)
#define ATT8_X0() ATT8_X0_(s0)
#define ATT8_X() ATT8_X_(s0, s2)
#define ATT8_X0_(ks_) do { const int kb = (int)(unsigned)(size_t)(K_lds + (ks_) * SHM_K + koff); v8i g0, g1, g2; ATT8_RD(g0, kb, 0); ATT8_RD(g1, kb, 32 * KROWB); ATT8_QK6(kb, g0, g1, g2, f32x16{}, f32x16{}); } while (0)
#if MLA_PRE
#define ATT8_XPRE(vs_) do { const int vb = (int)(unsigned)(size_t)(V_lds + (vs_) * SHM_V + voff); ATT8_RD(g0, vb, 0); ATT8_RD(g1, vb, 32 * VROWB); } while (0)
#define ATT8_XHEAD() do { } while (0)
    v8i g0, g1;
#define ATT8_XDECL() v8i g2
#else
#define ATT8_XPRE(vs_) do { } while (0)
#define ATT8_XHEAD() do { ATT8_RD(g0, vb, 0); ATT8_RD(g1, vb, 32 * VROWB); } while (0)
#define ATT8_XDECL() v8i g0, g1, g2
#endif
#define ATT8_X_(ks_, vs_) do { const int vb = (int)(unsigned)(size_t)(V_lds + (vs_) * SHM_V + voff), kb = (int)(unsigned)(size_t)(K_lds + (ks_) * SHM_K + koff); ATT8_XDECL(); \
        ATT8_XM(); ATT8_XHEAD(); ATT_SBAR(); \
        ATT8_RD(g2, vb, 64 * VROWB); ATT8_LW(4); ATT_SBAR(); o[0] = ATT8_MFMA(pa, g0, o[0]); ATT_SBAR(); \
        ATT8_RD(g0, vb, 96 * VROWB); ATT8_LW(4); ATT_SBAR(); o[1] = ATT8_MFMA(pa, g1, o[1]); ATT_SBAR(); \
        ATT8_RD(g1, kb, 0); ATT8_LW(4); ATT_SBAR(); o[2] = ATT8_MFMA(pa, g2, o[2]); ATT_SBAR(); \
        ATT8_RD(g2, kb, 32 * KROWB); ATT8_LW(4); ATT_SBAR(); o[3] = ATT8_MFMA(pa, g0, o[3]); ATT8_LMFMA(); ATT_SBAR(); \
        ATT8_QK6(kb, g1, g2, g0, ATT8_C0, ATT8_C1); ATT8_XM_END(); } while (0)
#define ATT8_S0() do { float pmax; ATT8_ROWMAX(pmax); m2 = pmax; \
        _Pragma("unroll") for (int r = 0; r < 16; ++r) { p0[r] = __builtin_amdgcn_exp2f(p0[r] - m2); p1[r] = __builtin_amdgcn_exp2f(p1[r] - m2); } \
        ATT8_ROWSUM(1.f); ATT8_PACK(); ATT8_INIT(); ATT8_INIT_TILE(); } while (0)
#if defined(MLA_XVALU)
#define ATT8_XV() do { _Pragma("unroll") for (int r = 0; r < MLA_XVALU; ++r) { float d_; asm volatile("v_exp_f32 %0, %1" : "=v"(d_) : "v"(p0[r & 15])); } } while (0)
#elif defined(MLA_XADD)
#define ATT8_XV() do { _Pragma("unroll") for (int r = 0; r < MLA_XADD; ++r) { float d_; asm volatile("v_add_f32 %0, %1, %1" : "=v"(d_) : "v"(p0[r & 15])); } } while (0)
#else
#define ATT8_XV() do { } while (0)
#endif
#if defined(MLA_XMFMA)
#define ATT8_XM() f32x16 dacc_ = ATT8_MFMA(qr[0], qr[1], f32x16{}); _Pragma("unroll") for (int r = 1; r < MLA_XMFMA; ++r) dacc_ = ATT8_MFMA(qr[0], qr[1], dacc_)
#define ATT8_XM_END() asm volatile("" :: "v"(dacc_))
#else
#define ATT8_XM() do { } while (0)
#define ATT8_XM_END() do { } while (0)
#endif
#define ATT8_S() do { float pmax, al = 1.f; ATT8_XV(); ATT8_ROWMAX(pmax); \
        if (__builtin_expect(!__all(pmax <= THR2), 0)) { \
            const float dl = fmaxf(pmax, 0.f); al = __builtin_amdgcn_exp2f(-dl); m2 += dl; \
            if (hi == 0) al_l[r32] = al; asm volatile("s_waitcnt lgkmcnt(0)" ::: "memory"); \
            _Pragma("unroll") for (int d = 0; d < 4; ++d) _Pragma("unroll") for (int r = 0; r < 16; ++r) o[d][r] *= al_l[crow(r, hi)]; ATT8_LRESC(); \
            _Pragma("unroll") for (int r = 0; r < 16; ++r) { p0[r] -= dl; p1[r] -= dl; } ATT8_INIT_SLOW(); } \
        _Pragma("unroll") for (int r = 0; r < 16; ++r) { p0[r] = __builtin_amdgcn_exp2f(p0[r]); p1[r] = __builtin_amdgcn_exp2f(p1[r]); } \
        ATT8_ROWSUM(al); ATT8_PACK(); ATT8_INIT_TILE(); } while (0)
#define ATT8_ROT() do { const int t_ = s0; s0 = s1; s1 = s2; s2 = t_; } while (0)
#if defined(PROBE_TIMING)
    const unsigned long long tstart8 = __builtin_amdgcn_s_memtime(), rstart8 = __builtin_amdgcn_s_memrealtime(); __builtin_amdgcn_s_waitcnt(0xC07F);
#endif
#if MLA_2T
#define ATT8_ISSUE2(i_) do { const int t_ = 2 * (i_); if (t_ + 2 < NT) { ATT8_DMAK(t_ + 2, (t_ + 2) & 3); ATT8_DMAK(t_ + 3, (t_ + 3) & 3); ATT8_DMAV(t_ + 2, (t_ + 2) & 3); } ATT8_DMAV(t_ + 1, (t_ + 1) & 3); } while (0)
    if (!grpB) {
        { ATT8_ISSUE2(0); ATT_SBAR(); ATT8_X0_(0); ATT_SBAR(); ATT8_S0(); ATT_SBAR(); }
#pragma unroll 1
        for (int j = 1; j < NT; ++j) { if (!(j & 1)) ATT8_ISSUE2(j >> 1); ATT_SBAR(); ATT8_X_(j & 3, (j - 1) & 3); ATT_SBAR(); ATT8_S(); ATT_SBAR(); if (j & 1) { ATT8_VMW(); ATT8_BAR(); } }
    } else {
        { ATT8_ISSUE2(0); ATT_SBAR(); ATT8_X0_(0); ATT_SBAR(); ATT8_S0(); ATT_SBAR(); ATT8_X_(1, 0); ATT_SBAR(); ATT8_VMW(); ATT8_BAR(); }
#pragma unroll 1
        for (int j = 2; j < NT; ++j) { if (!(j & 1)) ATT8_ISSUE2(j >> 1); ATT_SBAR(); ATT8_S(); ATT_SBAR(); ATT8_X_(j & 3, (j - 1) & 3); ATT_SBAR(); if (j & 1) { ATT8_VMW(); ATT8_BAR(); } }
        ATT8_S();
    }
    s2 = (NT - 1) & 3;
#undef ATT8_ISSUE2
#else
    if (!grpB) {
        { const int j = 0; ATT8_ISSUE(); ATT_SBAR(); ATT8_X0(); ATT_SBAR(); ATT8_S0(); ATT_SBAR(); ATT8_XPRE(s0); ATT8_VMW(); ATT8_BAR(); ATT8_ROT(); }
#pragma unroll 1
        for (int j = 1; j < NT; ++j) { ATT8_ISSUE(); ATT_SBAR(); ATT8_X(); ATT_SBAR(); ATT8_S(); ATT_SBAR(); if (j + 1 < NT) ATT8_XPRE(s0); ATT8_VMW(); ATT8_BAR(); ATT8_ROT(); }
    } else {
        { const int j = 0; ATT8_ISSUE(); ATT_SBAR(); ATT8_X0(); ATT_SBAR(); ATT8_VMW(); ATT8_BAR(); ATT8_ROT(); }
        { const int j = 1; ATT8_ISSUE(); ATT8_XPRE(s2); ATT_SBAR(); ATT8_S0(); ATT_SBAR(); ATT8_X(); ATT_SBAR(); ATT8_VMW(); ATT8_BAR(); ATT8_ROT(); }
#pragma unroll 1
        for (int j = 2; j < NT; ++j) { ATT8_ISSUE(); ATT8_XPRE(s2); ATT_SBAR(); ATT8_S(); ATT_SBAR(); ATT8_X(); ATT_SBAR(); ATT8_VMW(); ATT8_BAR(); ATT8_ROT(); }
        ATT8_S();
    }
#endif
#if defined(PROBE_TIMING)
    if (a.dbg && tid == PROBE_TID) { const unsigned long long tend = __builtin_amdgcn_s_memtime(), rend = __builtin_amdgcn_s_memrealtime();
        *a.dbg = PROBE_TIMING == 4 ? __builtin_floorf(((float)(tend - tstart8) / (float)(rend - rstart8) + PROBE_QOFF) * 0.25f) * 4e-2f
                                   : __builtin_rintf((float)(tend - tstart8) / (float)NT * (1.f / 256.f)) * 256e-4f; }
#endif
    { const LAS char* vb = V_lds + s2 * SHM_V + voff;
      o[0] = ATT8_MFMA(pa, ld32(vb), o[0]); o[1] = ATT8_MFMA(pa, ld32(vb + 32 * VROWB), o[1]); o[2] = ATT8_MFMA(pa, ld32(vb + 64 * VROWB), o[2]); o[3] = ATT8_MFMA(pa, ld32(vb + 96 * VROWB), o[3]); ATT8_LMFMA(); }
    ATT8_BAR();
#if !MLA_LSUM
    if (hi == 0) li_l[r32] = l_reg; asm volatile("s_waitcnt lgkmcnt(0)" ::: "memory");
#endif
    { LAS char* ot = lds + wid * 8448;
#pragma unroll
      for (int r = 0; r < 16; ++r) { const int orow = crow(r, hi);
#if MLA_LSUM
          const float rl = __builtin_amdgcn_rcpf(lacc[r]);
#else
          const float rl = __builtin_amdgcn_rcpf(li_l[orow]);
#endif
#pragma unroll
          for (int d0 = 0; d0 < 4; ++d0) { const float v = o[d0][r] * rl; *(LAS bf16_t*)(ot + orow * 264 + (d0 * 32 + r32) * 2) = (bf16_t)(cvt_pk_bf16(v, v) & 0xffffu); } }
      asm volatile("s_waitcnt lgkmcnt(0)" ::: "memory");
      char* Ow = (char*)(a.O + (size_t)(wid * 32) * a.os);
      const int orow0 = lane >> 4, ocol = (lane & 15) * 16;
#pragma unroll
      for (int i = 0; i < 8; ++i) { const int orow = orow0 + 4 * i; const u32x2 w0 = *(const LAS u32x2*)(ot + orow * 264 + ocol), w1 = *(const LAS u32x2*)(ot + orow * 264 + ocol + 8);
          u32x4 w; w.x = w0.x; w.y = w0.y; w.z = w1.x; w.w = w1.y;
          *(u32x4*)(Ow + (size_t)orow * a.os * 2 + ocol) = w; } }
    __syncthreads();
#undef ATT8_DMAK
#undef ATT8_DMAV
#undef ATT8_VMW
#undef ATT8_BAR
#undef ATT8_RD
#undef ATT8_LW
#undef ATT8_ISSUE
#undef ATT8_QK6
#undef ATT8_PACK
#undef ATT8_ROWMAX
#undef ATT8_ROT
#undef ATT8_S
#undef ATT8_S0
#undef ATT8_X
#undef ATT8_X0
#undef ATT8_XPRE
#undef ATT8_XHEAD
#undef ATT8_XDECL
#undef ATT8_X0_
#undef ATT8_X_
#undef ATT8_ROWSUM
#undef ATT8_LMFMA
#undef ATT8_LRESC
#undef ATT8_SUM32
#undef ATT8_INIT_SLOW
#undef ATT8_INIT_TILE
#undef ATT8_C0
#undef ATT8_C1
#undef ATT8_PAIR
#undef ATT8_PK4
#undef ATT8_INIT
}
}
#if defined(MK_CHECK) && MK_CHECK
#ifndef CHK_XOR_ROW
#define CHK_XOR_ROW 0
#endif
namespace chk {
__device__ __forceinline__ float f8(const void* base, size_t idx) { return __builtin_amdgcn_cvt_f32_fp8((int)((const unsigned char*)base)[idx], 0); }
__device__ __forceinline__ float ldQK(const bf16_t* B, int hd, int t, int w) {
    return MLA_FP8 ? f8(B, ((size_t)hd * SEQ + t) * 192 + w) : bf2f(B[((size_t)hd * SEQ + t) * 192 + w]); }
__device__ __forceinline__ float ldV(const bf16_t* B, int hd, int t, int c) {
    if (!MLA_FP8) return bf2f(B[((size_t)hd * SEQ + t) * 128 + c]);
    const int k = t & 63, half = k >> 5, kp = k & 31, kg = (kp >> 2) & 1, r = (kp & 3) + 4 * (kp >> 3), e = r + 16 * half;
    return f8(B, (((size_t)hd * (SEQ / 64) + (t >> 6)) * 128 + c) * 64 + 32 * kg + e); }

__device__ __forceinline__ unsigned hash32(unsigned x) { x ^= x >> 16; x *= 0x7feb352du; x ^= x >> 15; x *= 0x846ca68bu; x ^= x >> 16; return x; }
__device__ __forceinline__ void flag(unsigned* ctl, int bit) { atomicOr(ctl + CW_DBG, 1u << bit); }
__device__ __forceinline__ bool bad_l2(float err2, float ref2, float tol) { err2 = wave_sum(err2); ref2 = wave_sum(ref2); return !(err2 <= tol * tol * ref2 + 1e-12f); }
__device__ __forceinline__ void ref_cos_sin(int pos, int j, float& c, float& s) {
    const float inv = powf(10000.0f, -(float)(2 * j) / 64.0f); const float ang = (float)pos * inv;
    c = (float)cos((double)ang); s = (float)sin((double)ang);
}
__device__ __forceinline__ int ref_bucket(int rel) {
    int ret = rel > 0 ? 16 : 0; int n = rel < 0 ? -rel : rel; float nf = (float)(n < 1 ? 1 : n);
    float v = logf(nf / 8.0f) / 4.852030263919617f * 8.0f; int large = 8 + (int)v; if (large > 15) large = 15;
    return ret + (n < 8 ? n : large);
}
__device__ __forceinline__ void check_proj(const Frame& F, int b, unsigned* ctl, const bf16_t* P, const bf16_t* CQN, const bf16_t* CKVN, const bf16_t* QB, const bf16_t* KB, const bf16_t* VB,
                                           const float* gq, const float* gkv, const float* w_uq, const float* w_ukv, const int* positions) {
    const int lane = opaque_tid(F.wave) & 63;
    for (int smp = F.gw; smp < 4096; smp += F.NGW) {
        const unsigned hsh = hash32(smp * 2654435761u + b * 97u + 12345u);
        const int t = hsh % SEQ, hd = (hsh >> 13) & 7, kind = smp & 3;
        const bf16_t* pr = (const bf16_t*)((const char*)P + (size_t)t * PROW);
        if (kind == 0) {
            float ss = 0.f; for (int k = lane; k < 384; k += 64) { const float v = bf2f(pr[C_CQ + k]); ss += v * v; }
            const float rq = 1.0f / sqrtf(wave_sum(ss) / 384.f + NORM_EPS); float e2 = 0.f, r2 = 0.f;
            for (int k = lane; k < 384; k += 64) { const float ref = bf2f(pr[C_CQ + k]) * rq * gq[k], got = bf2f(CQN[(size_t)t * 384 + k]); e2 += (ref - got) * (ref - got); r2 += ref * ref; }
            if (bad_l2(e2, r2, 0.01f)) flag(ctl, 0);
            ss = 0.f; for (int k = lane; k < 256; k += 64) { const float v = bf2f(pr[C_CKV + k]); ss += v * v; }
            const float rk = 1.0f / sqrtf(wave_sum(ss) / 256.f + NORM_EPS); e2 = 0.f; r2 = 0.f;
            for (int k = lane; k < 256; k += 64) { const float ref = bf2f(pr[C_CKV + k]) * rk * gkv[k], got = bf2f(CKVN[(size_t)t * 256 + k]); e2 += (ref - got) * (ref - got); r2 += ref * ref; }
            if (bad_l2(e2, r2, 0.01f)) flag(ctl, 0);
        } else if (kind == 1) {
            float q[3] = {0.f, 0.f, 0.f};
            for (int k = 0; k < 384; ++k) { const float a = bf2f(CQN[(size_t)t * 384 + k]);
#pragma unroll
                for (int i = 0; i < 3; ++i) q[i] += a * w_uq[(size_t)k * 1536 + hd * 192 + lane + 64 * i]; }
            if (MLA_FP8) { q[0] *= QK_LOG2_SCALE; q[1] *= QK_LOG2_SCALE; q[2] *= QK_LOG2_SCALE; }
            float e2 = 0.f, r2 = 0.f;
#pragma unroll
            for (int i = 0; i < 2; ++i) { const float got = ldQK(QB, hd, t, lane + 64 * i); e2 += (q[i] - got) * (q[i] - got); r2 += q[i] * q[i]; }
            float other; { auto rr = __builtin_amdgcn_permlane32_swap(__float_as_uint(q[2]), __float_as_uint(q[2]), false, false); other = lane < 32 ? __uint_as_float(rr[1]) : __uint_as_float(rr[0]); } float c, s; ref_cos_sin(positions[(size_t)b * SEQ + t], lane & 31, c, s);
            const float x1 = lane < 32 ? q[2] : other, x2 = lane < 32 ? other : q[2];
            const float ref = lane < 32 ? x1 * c - x2 * s : x1 * s + x2 * c;
            const float got = ldQK(QB, hd, t, 128 + 2 * (lane & 31) + (lane >> 5)); e2 += (ref - got) * (ref - got); r2 += ref * ref;
            if (bad_l2(e2, r2, MLA_FP8 ? 0.06f : 0.015f)) flag(ctl, 1);
        } else if (kind == 2) {
            float kk[2] = {0.f, 0.f};
            for (int k = 0; k < 256; ++k) { const float a = bf2f(CKVN[(size_t)t * 256 + k]); kk[0] += a * w_ukv[(size_t)k * 2048 + hd * 256 + lane]; kk[1] += a * w_ukv[(size_t)k * 2048 + hd * 256 + 64 + lane]; }
            float e2 = 0.f, r2 = 0.f;
#pragma unroll
            for (int i = 0; i < 2; ++i) { const float got = ldQK(KB, hd, t, lane + 64 * i); e2 += (kk[i] - got) * (kk[i] - got); r2 += kk[i] * kk[i]; }
            float c, s; ref_cos_sin(positions[(size_t)b * SEQ + t], lane & 31, c, s);
            const float x1 = bf2f(pr[C_KPE + (lane & 31)]), x2 = bf2f(pr[C_KPE + 32 + (lane & 31)]);
            const float ref = lane < 32 ? x1 * c - x2 * s : x1 * s + x2 * c;
            const float got = ldQK(KB, hd, t, 128 + 2 * (lane & 31) + (lane >> 5)); e2 += (ref - got) * (ref - got); r2 += ref * ref;
            if (bad_l2(e2, r2, MLA_FP8 ? 0.06f : 0.015f)) flag(ctl, 2);
        } else {
            float vv[2] = {0.f, 0.f};
            for (int k = 0; k < 256; ++k) { const float a = bf2f(CKVN[(size_t)t * 256 + k]); vv[0] += a * w_ukv[(size_t)k * 2048 + hd * 256 + 128 + lane]; vv[1] += a * w_ukv[(size_t)k * 2048 + hd * 256 + 192 + lane]; }
            float e2 = 0.f, r2 = 0.f;
#pragma unroll
            for (int i = 0; i < 2; ++i) { const float got = ldV(VB, hd, t, lane + 64 * i); e2 += (vv[i] - got) * (vv[i] - got); r2 += vv[i] * vv[i]; }
            if (bad_l2(e2, r2, MLA_FP8 ? 0.06f : 0.015f)) flag(ctl, 3);
        }
    }
}
__device__ __forceinline__ void check_mla(const Frame& F, int b, unsigned* ctl, const bf16_t* QB, const bf16_t* KB, const bf16_t* VB, const bf16_t* OA) {
    const int tid = opaque_tid(F.wave), lane = tid & 63, wave = tid >> 6;
    LAS float* qf = (LAS float*)F.lds;
    LAS float* red = qf + 192;
    LAS float* pp = red + 64;
    LAS float* oacc = pp + SEQ;
    const unsigned hsh = hash32(blockIdx.x * 40503u + b * 977u + 777u);
    const int t = hsh % SEQ, hd = (hsh >> 13) & 7;
#if defined(FORCE_FLAG)
    if (blockIdx.x == 100 && tid == 5 && b == 2) flag(ctl, FORCE_FLAG);
#endif
    __syncthreads();
    if (tid < 192) qf[tid] = ldQK(QB, hd, t, tid);
    __syncthreads();
    float mx = -1e30f;
    for (int k = tid; k < SEQ; k += 512) { float s = 0.f;
        for (int d = 0; d < 192; ++d) s += qf[d] * ldQK(KB, hd, k, d);
        s *= MLA_FP8 ? 0.6931471805599453f : 0.07216878364870322f; pp[k] = s; mx = fmaxf(mx, s); }
    mx = wave_max(mx);
    if (lane == 0) red[wave] = mx;
    __syncthreads();
    mx = red[0]; for (int w = 1; w < 8; ++w) mx = fmaxf(mx, red[w]);
    __syncthreads();
    float sm = 0.f;
    for (int k = tid; k < SEQ; k += 512) { const float p = expf(pp[k] - mx); pp[k] = p; sm += p; }
    sm = wave_sum(sm); if (lane == 0) red[wave] = sm;
    __syncthreads();
    sm = 0.f; for (int w = 0; w < 8; ++w) sm += red[w];
    const int c = tid & 127, part = tid >> 7; float acc = 0.f;
    for (int k = part * 2048; k < part * 2048 + 2048; ++k) acc += pp[k] * ldV(VB, hd, k, c);
    oacc[part * 128 + c] = acc;
    __syncthreads();
    if (tid < 64) { float e2 = 0.f, r2 = 0.f;
#pragma unroll
        for (int i = 0; i < 2; ++i) { const int cc = tid + 64 * i; const float ref = (oacc[cc] + oacc[128 + cc] + oacc[256 + cc] + oacc[384 + cc]) / sm, got = bf2f(OA[(size_t)(t ^ CHK_XOR_ROW) * DM + hd * 128 + cc]);
            e2 += (ref - got) * (ref - got); r2 += ref * ref; }
#if defined(CHK_MEASURE) && CHK_MEASURE == 4
        { const float re = sqrtf(wave_sum(e2) / wave_sum(r2)); int k = (int)floorf(-log2f(re)); k = k < 0 ? 0 : (k > 15 ? 15 : k); flag(ctl, k); }
#else
        if (bad_l2(e2, r2, 0.03f)) flag(ctl, 4);
#endif
    }
    __syncthreads();
}
__device__ __forceinline__ void check_dil(const Frame& F, int b, unsigned* ctl, const bf16_t* P, const int* positions, const float* rel_bias, const bf16_t* OG, const float* LSE) {
    const int tid = opaque_tid(F.wave), lane = tid & 63, wave = tid >> 6;
    LAS float* pw = (LAS float*)F.lds + wave * 256;
    for (int smp = F.gw; smp < 4096; smp += F.NGW) {
        const unsigned hsh = hash32(smp * 2246822519u + b * 131u + 999u);
        int t = hsh % SEQ; const int hd = (hsh >> 13) & 7, grp = (hsh >> 16) % 3, d = grp == 0 ? 1 : (grp == 1 ? 4 : 16);
        if ((smp & 7) == 0) t = (smp >> 3) % 40;
        if ((smp & 7) == 1) t = SEQ - 1 - ((smp >> 3) % 40);
        const char* gb = (const char*)P + P_OFF_DIL + grp * P_GRP;
#define CHK_QK(tok_, part_, e_) (DIL_FP8 ? f8(gb + (size_t)(tok_) * PROW + (part_) * 1024 + hd * 128, (e_)) : bf2f(((const bf16_t*)(gb + (size_t)(tok_) * PROW + (part_) * 2048 + hd * 256))[e_]))
        const int pq = positions[(size_t)b * SEQ + t];
        float sc[3]; float mx = -1e30f;
#pragma unroll
        for (int i = 0; i < 3; ++i) { const int j = lane + 64 * i - 64, tk = t + j * d; sc[i] = -1e30f;
            if (j <= 64 && tk >= 0 && tk < SEQ) { float s = 0.f;
                for (int e = 0; e < 128; ++e) s += CHK_QK(t, 0, e) * CHK_QK(tk, 1, e);
                s = s * 0.08838834764831845f + rel_bias[ref_bucket(positions[(size_t)b * SEQ + tk] - pq) * 24 + grp * 8 + hd]; sc[i] = s; }
            mx = fmaxf(mx, sc[i]); }
        mx = wave_max(mx);
        float sm = 0.f;
#pragma unroll
        for (int i = 0; i < 3; ++i) { const int j = lane + 64 * i; const float p = sc[i] > -1e29f ? expf(sc[i] - mx) : 0.f; if (j < 129) pw[j] = p; sm += p; }
        sm = wave_sum(sm);
        LDS_WAIT();
        float o0 = 0.f, o1 = 0.f;
        for (int j = 0; j < 129; ++j) { const int tk = t + (j - 64) * d; if (tk < 0 || tk >= SEQ) continue; const float p = pw[j]; const bf16_t* vr = (const bf16_t*)(gb + (size_t)tk * PROW + 2048 * P_QK_ESZ + hd * 256);
            o0 += p * bf2f(vr[lane]); o1 += p * bf2f(vr[64 + lane]); }
        o0 /= sm; o1 /= sm;
        const float g0 = bf2f(OG[((size_t)grp * SEQ + t) * DM + hd * 128 + lane]), g1 = bf2f(OG[((size_t)grp * SEQ + t) * DM + hd * 128 + 64 + lane]);
        if (bad_l2((o0 - g0) * (o0 - g0) + (o1 - g1) * (o1 - g1), o0 * o0 + o1 * o1, 0.03f)) flag(ctl, 5);
        const float lse2 = (mx + logf(sm)) * LOG2E, got = LSE[((size_t)grp * SEQ + t) * 8 + hd];
        if (!(fabsf(lse2 - got) <= 0.05f)) flag(ctl, 6);
        LDS_WAIT();
    }
}
__device__ __forceinline__ void check_u(const Frame& F, int b, unsigned* ctl, const bf16_t* P, const bf16_t* OA, const bf16_t* OG, const float* LSE, const bf16_t* Ub) {
    const int lane = opaque_tid(F.wave) & 63;
    for (int smp = F.gw; smp < 2048; smp += F.NGW) {
        const int t = hash32(smp * 374761393u + b * 31u + 5u) % SEQ; float e2 = 0.f, r2 = 0.f;
        for (int c = lane; c < DM; c += 64) { const int hd = c >> 7;
            const float l0 = LSE[((size_t)0 * SEQ + t) * 8 + hd], l1 = LSE[((size_t)1 * SEQ + t) * 8 + hd], l2 = LSE[((size_t)2 * SEQ + t) * 8 + hd], mx = fmaxf(l0, fmaxf(l1, l2));
            const float w0 = exp2f(l0 - mx), w1 = exp2f(l1 - mx), w2 = exp2f(l2 - mx), ws_ = w0 + w1 + w2;
            const float ob = (w0 * bf2f(OG[((size_t)0 * SEQ + t) * DM + c]) + w1 * bf2f(OG[((size_t)1 * SEQ + t) * DM + c]) + w2 * bf2f(OG[((size_t)2 * SEQ + t) * DM + c])) / ws_;
            const bf16_t* gr = (const bf16_t*)((const char*)P + (size_t)t * PROW + P_OFF_GATE); const float ga = 1.f / (1.f + expf(-bf2f(gr[c]))), gb = 1.f / (1.f + expf(-bf2f(gr[1024 + c])));
            const float ref = ga * bf2f(OA[(size_t)t * DM + c]) + gb * ob, got = bf2f(Ub[(size_t)t * DM + c]); e2 += (ref - got) * (ref - got); r2 += ref * ref; }
        if (bad_l2(e2, r2, 0.01f)) flag(ctl, 7);
    }
}
}
#endif
template <bool F8, class F>
__device__ __forceinline__ void transpose_item(F colptr, int ldn, void* WT, int ldk, int k0, int n0, LAS float* scr, int lane) {
    const float* cp = colptr(n0 + (lane & 31));
    float tv[32];
    const float* cpk = cp ? cp + (size_t)(k0 + (lane >> 5)) * ldn : nullptr;
#pragma unroll
    for (int i = 0; i < 32; ++i) tv[i] = cpk ? cpk[(size_t)(2 * i) * ldn] : 0.f;
#pragma unroll
    for (int i = 0; i < 32; ++i) scr[(2 * i + (lane >> 5)) * 33 + (lane & 31)] = tv[i];
    LDS_WAIT(); asm volatile("" ::: "memory");
    const int c = lane & 7;
#pragma unroll
    for (int j = 0; j < 4; ++j) { const int n = (lane >> 3) + 8 * j; const LAS float* s = scr + (8 * c) * 33 + n;
        if constexpr (F8) { u32x2 o; o.x = pk4_fp8(s[0 * 33] * W8_SCALE, s[1 * 33] * W8_SCALE, s[2 * 33] * W8_SCALE, s[3 * 33] * W8_SCALE); o.y = pk4_fp8(s[4 * 33] * W8_SCALE, s[5 * 33] * W8_SCALE, s[6 * 33] * W8_SCALE, s[7 * 33] * W8_SCALE);
            *(u32x2*)((char*)WT + (size_t)(n0 + n) * ldk + k0 + 8 * c) = o; }
        else { u32x4 o; o.x = cvt_pk_bf16(s[0 * 33], s[1 * 33]); o.y = cvt_pk_bf16(s[2 * 33], s[3 * 33]); o.z = cvt_pk_bf16(s[4 * 33], s[5 * 33]); o.w = cvt_pk_bf16(s[6 * 33], s[7 * 33]);
            *(u32x4*)((bf16_t*)WT + (size_t)(n0 + n) * ldk + k0 + 8 * c) = o; } }
    LDS_WAIT(); asm volatile("" ::: "memory");
}

__device__ __forceinline__ void p0_mod(const Frame& F, const float* c, const float* w_ada, const float* b_ada, float* mod) {
    const int tid = opaque_tid(F.wave), lane = tid & 63; (void)tid; (void)lane;
    LAS float* red = (LAS float*)F.lds;
    LAS float* sl = (LAS float*)(F.lds + 8192);
    if ((int)blockIdx.x < 96) {
        for (int i = tid; i < 4096; i += 512) { const float cv = c[i]; sl[i] = cv * fast_sigmoid(cv); }
        __syncthreads();
    }
    for (int blk = blockIdx.x; blk < 96; blk += F.G) {
        const int col = blk * 64 + (tid & 63), ks = tid >> 6;
        float a0 = 0.f, a1 = 0.f, a2 = 0.f, a3 = 0.f;
#pragma unroll 1
        for (int k0 = ks * 128; k0 < ks * 128 + 128; k0 += 16) { float w[16];
#pragma unroll
            for (int i = 0; i < 16; ++i) w[i] = w_ada[(size_t)(k0 + i) * 6144 + col];
#pragma unroll
            for (int i = 0; i < 16; ++i) { const int k = k0 + i; a0 += sl[k] * w[i]; a1 += sl[1024 + k] * w[i]; a2 += sl[2048 + k] * w[i]; a3 += sl[3072 + k] * w[i]; } }
        red[(ks * 4 + 0) * 64 + (tid & 63)] = a0; red[(ks * 4 + 1) * 64 + (tid & 63)] = a1; red[(ks * 4 + 2) * 64 + (tid & 63)] = a2; red[(ks * 4 + 3) * 64 + (tid & 63)] = a3;
        __syncthreads();
        if (tid < 256) { const int b = tid >> 6, cc = tid & 63; float s = 0.f;
#pragma unroll
            for (int q = 0; q < 8; ++q) s += red[(q * 4 + b) * 64 + cc];
            mod[b * 6144 + blk * 64 + cc] = s + b_ada[blk * 64 + cc]; }
        __syncthreads();
    }
}
__device__ __forceinline__ void p0_cs(const Frame& F, const int* pos, float* cs) {
    const int tid = opaque_tid(F.wave), lane = tid & 63; (void)tid; (void)lane;
    for (int i = (int)blockIdx.x * 512 + tid; i < NTOK * 32; i += F.G * 512) {
        const int t = i >> 5, j = i & 31;
        const float inv = __builtin_amdgcn_exp2f(-(float)(2 * j) / 64.f * 13.287712379549449f);
        const float ang = (float)pos[t] * inv;
        const double rev = (double)ang * 0.15915494309189535; const double fr = rev - __builtin_rint(rev);
        const float f = (float)fr;
        f32x2 o; o.x = __builtin_amdgcn_cosf(f); o.y = __builtin_amdgcn_sinf(f);
        *(f32x2*)(cs + (size_t)i * 2) = o;
    }
}
__device__ __forceinline__ void p0_lut(const Frame& F, const float* rel_bias, float* lutg) {
    const int tid = opaque_tid(F.wave);
    for (int i = (int)blockIdx.x * 512 + tid; i < 24 * 2049; i += F.G * 512) { const int l = i / 2049, u = i - l * 2049;
        lutg[l * 2304 + u + (u >> 5)] = rel_bias[att::t5_bucket(u - 1024) * 24 + l] * LOG2E; }
}
__device__ __forceinline__ void p0_weights(const Frame& F, const float* w_in, const float* w_uq, const float* w_ukv, const float* w_out, unsigned char* ws) {
    const int tid = opaque_tid(F.wave), lane = tid & 63; (void)tid; (void)lane;
    LAS float* scr = (LAS float*)(F.lds + F.wave * 16384);
    constexpr int I_IN = 16 * 376, I_UQ = 6 * 48, I_UKV = 4 * 64, I_OUT = 16 * 32;
    for (int it = F.gw; it < I_IN + I_UQ + I_UKV + I_OUT; it += F.NGW) {
        int r = it;
        if (r < I_IN) { const int kb = r / 376, nb = r % 376;
            transpose_item<(FP8_G1 != 0)>([=](int np) -> const float* { const int n = (np & ~31) + pg8::perm32(np & 31); return n < D_IN ? w_in + n : nullptr; }, D_IN, (void*)(ws + WS_WIN), 1024, kb * 64, nb * 32, scr, lane); continue; }
        r -= I_IN;
        if (r < I_UQ) { const int kb = r / 48, nb = r % 48;
            transpose_item<false>([=](int n) -> const float* { const int hd = n / 192, w = n - hd * 192; const int sc = w < 128 ? w : 128 + ((w - 128) >> 1) + 32 * ((w - 128) & 1); return w_uq + hd * 192 + sc; },
                           1536, (bf16_t*)(ws + WS_WUQ), 384, kb * 64, nb * 32, scr, lane); continue; }
        r -= I_UQ;
        if (r < I_UKV) { const int kb = r / 64, nb = r % 64;
            transpose_item<false>([=](int n) -> const float* { const int m = n & 1023; return w_ukv + (MLA_FP8 ? ((m >> 7) * 256 + (n >> 10) * 128 + (m & 127)) : n); }, 2048, (bf16_t*)(ws + WS_WUKV), 256, kb * 64, nb * 32, scr, lane); continue; }
        r -= I_UKV;
        { const int kb = r / 32, nb = r % 32;
            transpose_item<(FP8_WO != 0)>([=](int n) -> const float* { return w_out + n; }, 1024, (void*)(ws + WS_WOUT), 1024, kb * 64, nb * 32, scr, lane); }
    }
}
__device__ __forceinline__ void conv_experts(const Frame& F, const float* w_gate, const float* w_up, const float* w_down, unsigned char* ws) {
    static_assert(FP8_EX != 0, "fp8 expert operands");
    const int tid = opaque_tid(F.wave), lane = tid & 63; (void)tid;
    LAS float* scr = (LAS float*)(F.lds + F.wave * 16384);
    constexpr int N_IT = NE * 1536;
    const long du = (const char*)w_up - (const char*)w_gate;
    const int lr = lane >> 4, lf = lane & 15;
#define CE_LOAD(it_, tv_) do { const int e_ = (it_) / 1536, r_ = (it_) % 1536; const float* p_; int ldn_; \
        if (r_ < 1024) { const int a_ = r_ >> 9, kb_ = (r_ >> 5) & 15, cb_ = r_ & 31; \
            p_ = (const float*)((const char*)w_gate + (a_ ? du : 0L)) + (size_t)e_ * DM * DFF + (size_t)(kb_ * 64 + lr) * DFF + cb_ * 64 + 4 * lf; ldn_ = DFF; } \
        else { const int r2_ = r_ - 1024, kb_ = r2_ >> 4, cb_ = r2_ & 15; p_ = w_down + (size_t)e_ * DFF * DM + (size_t)(kb_ * 64 + lr) * DM + cb_ * 64 + 4 * lf; ldn_ = DM; } \
        _Pragma("unroll") for (int i = 0; i < 16; ++i) tv_[i] = *(const f32x4*)(p_ + (size_t)(4 * i) * ldn_); } while (0)
#define CE_STORE(it_, tv_) do { const int e_ = (it_) / 1536, r_ = (it_) % 1536; unsigned char* wt_; int ldk_; \
        _Pragma("unroll") for (int i = 0; i < 16; ++i) { LAS float* d_ = scr + (lr + 4 * i) * 64 + ((4 * lf) ^ (4 * ((i >> 1) & 7))); d_[0 ^ lr] = tv_[i][0]; d_[1 ^ lr] = tv_[i][1]; d_[2 ^ lr] = tv_[i][2]; d_[3 ^ lr] = tv_[i][3]; } \
        LDS_WAIT(); asm volatile("" ::: "memory"); \
        const int c_ = lane & 7; int rowb_, a16_; bool dn_; \
        if (r_ < 1024) { const int a_ = r_ >> 9, kb_ = (r_ >> 5) & 15, cb_ = r_ & 31; wt_ = ws + WS_WGU + (size_t)e_ * 4096 * 1024 + kb_ * 64 + 8 * c_; ldk_ = 1024; rowb_ = 128 * cb_; a16_ = 16 * a_; dn_ = false; } \
        else { const int r2_ = r_ - 1024, kb_ = r2_ >> 4, cb_ = r2_ & 15; wt_ = ws + WS_WD + (size_t)e_ * 1024 * 2048 + kb_ * 64 + 8 * c_; ldk_ = 2048; rowb_ = 64 * cb_; a16_ = 0; dn_ = true; } \
        _Pragma("unroll") for (int j = 0; j < 8; ++j) { const int cc_ = (lane >> 3) + 8 * j; const LAS float* s_ = scr + (8 * c_) * 64; const int x0_ = cc_ ^ (4 * c_); u32x2 o_; \
            const int s5_ = cc_ & 31; \
            const int row_ = dn_ ? rowb_ + (cc_ & 32) + 16 * ((s5_ >> 2) & 1) + 4 * (s5_ >> 3) + (s5_ & 3) : rowb_ + 32 * (cc_ >> 4) + a16_ + (cc_ & 15); \
            o_.x = pk4_fp8(s_[0 * 64 + (x0_ ^ 0)] * W8_SCALE, s_[1 * 64 + (x0_ ^ 1)] * W8_SCALE, s_[2 * 64 + (x0_ ^ 2)] * W8_SCALE, s_[3 * 64 + (x0_ ^ 3)] * W8_SCALE); \
            o_.y = pk4_fp8(s_[4 * 64 + (x0_ ^ 0)] * W8_SCALE, s_[5 * 64 + (x0_ ^ 1)] * W8_SCALE, s_[6 * 64 + (x0_ ^ 2)] * W8_SCALE, s_[7 * 64 + (x0_ ^ 3)] * W8_SCALE); \
            *(u32x2*)(wt_ + (size_t)row_ * ldk_) = o_; } \
        LDS_WAIT(); asm volatile("" ::: "memory"); } while (0)
    f32x4 tva[16], tvb[16];
    int it = F.gw;
    if (it < N_IT) CE_LOAD(it, tva);
#pragma unroll 1
    while (it < N_IT) {
        const int it2 = it + F.NGW, it3 = it2 + F.NGW;
        if (it2 < N_IT) CE_LOAD(it2, tvb);
        CE_STORE(it, tva);
        if (it2 < N_IT) { if (it3 < N_IT) CE_LOAD(it3, tva); CE_STORE(it2, tvb); }
        it = it3;
    }
#undef CE_LOAD
#undef CE_STORE
}
__device__ __forceinline__ void norm_mod_row(const float* xrow, const float* g, const float* sh, const float* sc, int lane, f32x4 (&v)[4]) {
    float s = 0.f;
#pragma unroll
    for (int j = 0; j < 4; ++j) { v[j] = *(const f32x4*)(xrow + 4 * lane + 256 * j); s += (v[j][0] * v[j][0] + v[j][1] * v[j][1]) + (v[j][2] * v[j][2] + v[j][3] * v[j][3]); }
    const float rstd = 1.0f / sqrtf(wave_sum(s) * (1.f / DM) + NORM_EPS);
#pragma unroll
    for (int j = 0; j < 4; ++j) { const int c = 4 * lane + 256 * j; const f32x4 gg = *(const f32x4*)(g + c), s1 = *(const f32x4*)(sc + c), s0 = *(const f32x4*)(sh + c);
        v[j] = (v[j] * rstd * gg) * (s1 + 1.0f) + s0; }
}
__device__ __forceinline__ void store_row_bf16(bf16_t* orow, int lane, const f32x4 (&v)[4]) {
#pragma unroll
    for (int j = 0; j < 4; ++j) { u32x2 o; o.x = cvt_pk_bf16(v[j][0], v[j][1]); o.y = cvt_pk_bf16(v[j][2], v[j][3]); *(u32x2*)(orow + 4 * lane + 256 * j) = o; }
}
template <bool F8> __device__ __forceinline__ void store_row_act(void* orow, int lane, const f32x4 (&v)[4]) {
    if constexpr (F8) {
#pragma unroll
        for (int j = 0; j < 4; ++j) *(unsigned*)((char*)orow + 4 * lane + 256 * j) = pk4_fp8(v[j][0], v[j][1], v[j][2], v[j][3]);
    } else store_row_bf16((bf16_t*)orow, lane, v);
}
__device__ __forceinline__ void p1_h(const Frame& F, const float* x, const float* g, const float* mod, bf16_t* H) {
    const int tid = opaque_tid(F.wave), lane = tid & 63; (void)tid; (void)lane;
    f32x4 gg[4], vn[4], shn[4], scn[4];
    int t = F.gw;
#pragma unroll
    for (int j = 0; j < 4; ++j) { const int c = 4 * lane + 256 * j; gg[j] = *(const f32x4*)(g + c);
        if (t < NTOK) { const int b = t / SEQ; vn[j] = *(const f32x4*)(x + (size_t)t * DM + c); shn[j] = *(const f32x4*)(mod + b * 6144 + c); scn[j] = *(const f32x4*)(mod + b * 6144 + 1024 + c); } }
#pragma unroll 1
    for (; t < NTOK; t += F.NGW) { f32x4 v[4], sh[4], sc[4];
#pragma unroll
        for (int j = 0; j < 4; ++j) { v[j] = vn[j]; sh[j] = shn[j]; sc[j] = scn[j]; }
        const int tn = t + F.NGW;
        if (tn < NTOK) { const int bn = tn / SEQ;
#pragma unroll
            for (int j = 0; j < 4; ++j) { const int c = 4 * lane + 256 * j; vn[j] = *(const f32x4*)(x + (size_t)tn * DM + c); shn[j] = *(const f32x4*)(mod + bn * 6144 + c); scn[j] = *(const f32x4*)(mod + bn * 6144 + 1024 + c); } }
        float ss = 0.f;
#pragma unroll
        for (int j = 0; j < 4; ++j) ss += (v[j][0] * v[j][0] + v[j][1] * v[j][1]) + (v[j][2] * v[j][2] + v[j][3] * v[j][3]);
        const float rstd = 1.0f / sqrtf(wave_sum(ss) * (1.f / DM) + NORM_EPS);
#pragma unroll
        for (int j = 0; j < 4; ++j) v[j] = (v[j] * rstd * gg[j]) * (sc[j] + 1.0f) + sh[j];
        store_row_act<(FP8_G1 != 0)>((char*)H + (size_t)t * DM * (FP8_G1 ? 1 : 2), lane, v); }
}
__device__ __forceinline__ void lb_latent(const Frame& F, const bf16_t* P, const float* gq, const float* gkv, const float* cs, bf16_t* CQN, bf16_t* CKVN, bf16_t* KB) {
    const int tid = opaque_tid(F.wave), lane = tid & 63; (void)tid; (void)lane;
    f32x4 gq0 = {}, gq1 = {}, gk0 = {}, gk1 = {};
    if (lane < 48) { gq0 = *(const f32x4*)(gq + 8 * lane); gq1 = *(const f32x4*)(gq + 8 * lane + 4); }
    if (lane < 32) { gk0 = *(const f32x4*)(gkv + 8 * lane); gk1 = *(const f32x4*)(gkv + 8 * lane + 4); }
#pragma unroll 1
    for (int tb = F.gw; tb < SEQ; tb += 4 * F.NGW) {
        u32x4 wq[4], wk[4]; float xa[4], xb[4]; f32x2 cc[4];
#pragma unroll
        for (int i = 0; i < 4; ++i) { const int t = tb + i * F.NGW; wq[i] = (u32x4){0u, 0u, 0u, 0u}; wk[i] = wq[i]; xa[i] = 0.f; xb[i] = 0.f; cc[i] = (f32x2){0.f, 0.f};
            if (t < SEQ) { const bf16_t* pr = (const bf16_t*)((const char*)P + (size_t)t * PROW);
                if (lane < 48) wq[i] = *(const u32x4*)(pr + C_CQ + 8 * lane);
                if (lane < 32) { wk[i] = *(const u32x4*)(pr + C_CKV + 8 * lane); xa[i] = bf2f(pr[C_KPE + lane]); xb[i] = bf2f(pr[C_KPE + 32 + lane]); cc[i] = *(const f32x2*)(cs + ((size_t)t * 32 + lane) * 2); } } }
#pragma unroll
        for (int i = 0; i < 4; ++i) { const int t = tb + i * F.NGW; if (t >= SEQ) break;
            float q[8], s = 0.f;
            { const u32x4 w = wq[i]; q[0] = bflo(w.x); q[1] = bfhi(w.x); q[2] = bflo(w.y); q[3] = bfhi(w.y); q[4] = bflo(w.z); q[5] = bfhi(w.z); q[6] = bflo(w.w); q[7] = bfhi(w.w);
#pragma unroll
              for (int e = 0; e < 8; ++e) s += q[e] * q[e]; }
            const float rq = 1.0f / sqrtf(wave_sum(s) * (1.f / 384.f) + NORM_EPS);
            if (lane < 48) { u32x4 o; o.x = cvt_pk_bf16(q[0] * rq * gq0[0], q[1] * rq * gq0[1]); o.y = cvt_pk_bf16(q[2] * rq * gq0[2], q[3] * rq * gq0[3]);
                o.z = cvt_pk_bf16(q[4] * rq * gq1[0], q[5] * rq * gq1[1]); o.w = cvt_pk_bf16(q[6] * rq * gq1[2], q[7] * rq * gq1[3]);
                *(u32x4*)(CQN + (size_t)t * 384 + 8 * lane) = o; }
            float s2 = 0.f;
            { const u32x4 w = wk[i]; q[0] = bflo(w.x); q[1] = bfhi(w.x); q[2] = bflo(w.y); q[3] = bfhi(w.y); q[4] = bflo(w.z); q[5] = bfhi(w.z); q[6] = bflo(w.w); q[7] = bfhi(w.w);
#pragma unroll
              for (int e = 0; e < 8; ++e) s2 += q[e] * q[e]; }
            const float rk = 1.0f / sqrtf(wave_sum(s2) * (1.f / 256.f) + NORM_EPS);
            if (lane < 32) { u32x4 o; o.x = cvt_pk_bf16(q[0] * rk * gk0[0], q[1] * rk * gk0[1]); o.y = cvt_pk_bf16(q[2] * rk * gk0[2], q[3] * rk * gk0[3]);
                o.z = cvt_pk_bf16(q[4] * rk * gk1[0], q[5] * rk * gk1[1]); o.w = cvt_pk_bf16(q[6] * rk * gk1[2], q[7] * rk * gk1[3]);
                *(u32x4*)(CKVN + (size_t)t * 256 + 8 * lane) = o;
                const float x1 = xa[i], x2 = xb[i]; const f32x2 c = cc[i];
                if constexpr (MLA_FP8) { const unsigned short pk8 = (unsigned short)(__builtin_amdgcn_cvt_pk_fp8_f32(x1 * c.x - x2 * c.y, x1 * c.y + x2 * c.x, 0, false) & 0xffff);
#pragma unroll
                    for (int h = 0; h < 8; ++h) *(unsigned short*)((unsigned char*)KB + ((size_t)h * SEQ + t) * 192 + 128 + 2 * lane) = pk8; }
                else { const unsigned pk = cvt_pk_bf16(x1 * c.x - x2 * c.y, x1 * c.y + x2 * c.x);
#pragma unroll
                    for (int h = 0; h < 8; ++h) *(unsigned*)(KB + ((size_t)h * SEQ + t) * 192 + 128 + 2 * lane) = pk; } }
        }
    }
}
__device__ __forceinline__ void lb_combine(const Frame& F, const bf16_t* P, const bf16_t* OA, const bf16_t* OG, const float* LSE, bf16_t* U) {
    const int tid = opaque_tid(F.wave), lane = tid & 63; (void)tid; (void)lane;
#pragma unroll 2
    for (int t = F.gw; t < SEQ; t += F.NGW) {
#pragma unroll
        for (int j = 0; j < 2; ++j) { const int c0 = 8 * lane + 512 * j, hd = c0 >> 7;
            const float l0 = LSE[((size_t)0 * SEQ + t) * 8 + hd], l1 = LSE[((size_t)1 * SEQ + t) * 8 + hd], l2 = LSE[((size_t)2 * SEQ + t) * 8 + hd];
            const float mx = fmaxf(l0, fmaxf(l1, l2)); float w0 = __builtin_amdgcn_exp2f(l0 - mx), w1 = __builtin_amdgcn_exp2f(l1 - mx), w2 = __builtin_amdgcn_exp2f(l2 - mx);
            const float inv = 1.0f / (w0 + w1 + w2); w0 *= inv; w1 *= inv; w2 *= inv;
            const u32x4 oa = *(const u32x4*)(OA + (size_t)t * DM + c0), g0 = *(const u32x4*)(OG + ((size_t)0 * SEQ + t) * DM + c0), g1 = *(const u32x4*)(OG + ((size_t)1 * SEQ + t) * DM + c0),
                        g2 = *(const u32x4*)(OG + ((size_t)2 * SEQ + t) * DM + c0), ga = *(const u32x4*)((const char*)P + (size_t)t * PROW + P_OFF_GATE + 2 * c0), gb = *(const u32x4*)((const char*)P + (size_t)t * PROW + P_OFF_GATE + 2048 + 2 * c0);
            u32x4 o; float uf[8];
#pragma unroll
            for (int e = 0; e < 4; ++e) {
                const float ob_lo = w0 * bflo(g0[e]) + w1 * bflo(g1[e]) + w2 * bflo(g2[e]), ob_hi = w0 * bfhi(g0[e]) + w1 * bfhi(g1[e]) + w2 * bfhi(g2[e]);
                const float u_lo = fast_sigmoid(bflo(ga[e])) * bflo(oa[e]) + fast_sigmoid(bflo(gb[e])) * ob_lo;
                const float u_hi = fast_sigmoid(bfhi(ga[e])) * bfhi(oa[e]) + fast_sigmoid(bfhi(gb[e])) * ob_hi;
                if constexpr (FP8_WO) { uf[2 * e] = u_lo * U8_SCALE; uf[2 * e + 1] = u_hi * U8_SCALE; } else o[e] = cvt_pk_bf16(u_lo, u_hi); }
            if constexpr (FP8_WO) { u32x2 o8; o8.x = pk4_fp8(uf[0], uf[1], uf[2], uf[3]); o8.y = pk4_fp8(uf[4], uf[5], uf[6], uf[7]); *(u32x2*)((unsigned char*)U + (size_t)t * DM + c0) = o8; }
            else *(u32x4*)(U + (size_t)t * DM + c0) = o; }
    }
}
__device__ __forceinline__ void pg_h2_router(const Frame& F, const float* x1, const float* g, const float* mod, const float* w_router, bf16_t* H2, float* AFFT) {
    const int tid = opaque_tid(F.wave), lane = tid & 63; (void)tid;
    LAS float* wr = (LAS float*)F.lds;
    LAS float* ab = (LAS float*)(F.lds + 65536) + F.wave * 256;
    for (int i = tid; i < 1024 * 16 / 4; i += 512) { const int c = i >> 2, k = i & 3, rho = (c & 3) * 256 + (c >> 2);
        ((LAS f32x4*)wr)[rho * 4 + ((k + (rho >> 2)) & 3)] = ((const f32x4*)w_router)[i]; }
    __syncthreads();
    int roff[4];
#pragma unroll
    for (int k = 0; k < 4; ++k) roff[k] = ((k + (lane >> 2)) & 3) * 4;
    const bool b4 = (lane >> 4) & 1, b3 = (lane >> 3) & 1, b2 = (lane >> 2) & 1; const int el = 8 * (lane >> 5) + 4 * ((lane >> 4) & 1) + 2 * ((lane >> 3) & 1) + ((lane >> 2) & 1);
    for (int ch = F.gw; ch < NTOK / 16; ch += F.NGW) {
        const int t0 = ch * 16, b = t0 / SEQ, s0 = t0 % SEQ;
        f32x4 vn[4], gg[4], sc1[4], sh0[4];
#pragma unroll
        for (int j = 0; j < 4; ++j) { const int c = 4 * lane + 256 * j; vn[j] = *(const f32x4*)(x1 + (size_t)t0 * DM + c);
            gg[j] = *(const f32x4*)(g + c); sh0[j] = *(const f32x4*)(mod + b * 6144 + 3072 + c); sc1[j] = *(const f32x4*)(mod + b * 6144 + 4096 + c); }
#pragma unroll 1
        for (int ti = 0; ti < 16; ++ti) { const int t = t0 + ti; f32x4 v[4];
#pragma unroll
            for (int j = 0; j < 4; ++j) v[j] = vn[j];
            if (ti + 1 < 16) {
#pragma unroll
                for (int j = 0; j < 4; ++j) vn[j] = *(const f32x4*)(x1 + (size_t)(t + 1) * DM + 4 * lane + 256 * j); }
            { float ss = 0.f;
#pragma unroll
              for (int j = 0; j < 4; ++j) ss += (v[j][0] * v[j][0] + v[j][1] * v[j][1]) + (v[j][2] * v[j][2] + v[j][3] * v[j][3]);
              const float rstd = 1.0f / sqrtf(wave_sum(ss) * (1.f / DM) + NORM_EPS);
#pragma unroll
              for (int j = 0; j < 4; ++j) v[j] = (v[j] * rstd * gg[j]) * (sc1[j] + 1.0f) + sh0[j]; }
            store_row_act<(FP8_EX != 0)>((char*)H2 + (size_t)t * DM * (FP8_EX ? 1 : 2), lane, v);
            float lg[16];
#pragma unroll
            for (int e = 0; e < 16; ++e) lg[e] = 0.f;
#pragma unroll
            for (int j = 0; j < 4; ++j)
#pragma unroll
                for (int q = 0; q < 4; ++q) { const LAS float* wp = wr + (q * 256 + lane + 64 * j) * 16; const float hv = v[j][q];
#pragma unroll
                    for (int e4 = 0; e4 < 4; ++e4) { const f32x4 w = *(const LAS f32x4*)(wp + roff[e4]); lg[4 * e4 + 0] += hv * w[0]; lg[4 * e4 + 1] += hv * w[1]; lg[4 * e4 + 2] += hv * w[2]; lg[4 * e4 + 3] += hv * w[3]; } }
            float s8[8], s4[4], s2[2], s1;
#pragma unroll
            for (int e = 0; e < 8; ++e) { auto rr = __builtin_amdgcn_permlane32_swap(__float_as_uint(lg[e]), __float_as_uint(lg[e + 8]), false, false); s8[e] = __uint_as_float(rr[0]) + __uint_as_float(rr[1]); }
#pragma unroll
            for (int i = 0; i < 4; ++i) { const float keep = b4 ? s8[i + 4] : s8[i], send = b4 ? s8[i] : s8[i + 4]; s4[i] = keep + __int_as_float(__builtin_amdgcn_ds_swizzle(__float_as_int(send), SWZ_XOR(16))); }
#pragma unroll
            for (int i = 0; i < 2; ++i) { const float keep = b3 ? s4[i + 2] : s4[i], send = b3 ? s4[i] : s4[i + 2]; s2[i] = keep + __int_as_float(__builtin_amdgcn_ds_swizzle(__float_as_int(send), SWZ_XOR(8))); }
            { const float keep = b2 ? s2[1] : s2[0], send = b2 ? s2[0] : s2[1]; s1 = keep + __int_as_float(__builtin_amdgcn_ds_swizzle(__float_as_int(send), SWZ_XOR(4))); }
            s1 += __int_as_float(__builtin_amdgcn_ds_swizzle(__float_as_int(s1), SWZ_XOR(2)));
            s1 += __int_as_float(__builtin_amdgcn_ds_swizzle(__float_as_int(s1), SWZ_XOR(1)));
            const float mx = wave_max(s1), ex = __expf(s1 - mx), sum = wave_sum(ex) * 0.25f;
            if ((lane & 3) == 0) ab[el * 16 + ti] = ex * (1.0f / sum);
        }
        LDS_WAIT();
        { const int e = lane >> 2, q4 = (lane & 3) * 4; const f32x4 w = *(const LAS f32x4*)(ab + e * 16 + q4);
          *(f32x4*)(AFFT + ((size_t)b * NE + e) * SEQ + s0 + q4) = w; }
        LDS_WAIT();
    }
    __syncthreads();
}
__device__ __forceinline__ void ph_topk(const Frame& F, const float* AFFT, int* TOPI, float* TOPG, int* SLOT) {
    const int tid = opaque_tid(F.wave), lane = tid & 63;
    LAS unsigned* cnt = (LAS unsigned*)F.lds;
    LAS unsigned* wtot = cnt + 64;
    for (int p = blockIdx.x; p < NB * NE; p += F.G) {
        const float* src = AFFT + (size_t)p * SEQ + 16 * tid;
        unsigned key[16];
#pragma unroll
        for (int j = 0; j < 4; ++j) { const u32x4 w = *(const u32x4*)(src + 4 * j); key[4 * j] = w.x; key[4 * j + 1] = w.y; key[4 * j + 2] = w.z; key[4 * j + 3] = w.w; }
        unsigned thr = 0u;
#pragma unroll 1
        for (int bit = 30; bit >= 0; --bit) { const unsigned cand = thr | (1u << bit); unsigned c = 0;
#pragma unroll
            for (int i = 0; i < 16; ++i) c += (unsigned)__builtin_popcountll(__ballot(key[i] >= cand));
            LAS unsigned* slot = cnt + ((bit & 1) << 3);
            if (lane == 0) slot[F.wave] = c;
            __syncthreads();
            unsigned tot = 0;
#pragma unroll
            for (int w = 0; w < 8; ++w) tot += slot[w];
            if (tot >= (unsigned)CAP) thr = cand; }
        unsigned ngt = 0, neq = 0;
#pragma unroll
        for (int i = 0; i < 16; ++i) { ngt += key[i] > thr ? 1u : 0u; neq += key[i] == thr ? 1u : 0u; }
        unsigned pk = ngt | (neq << 16), inc = pk;
#pragma unroll
        for (int o = 1; o < 64; o <<= 1) { const unsigned v = (unsigned)__builtin_amdgcn_ds_bpermute((lane - o) << 2, (int)inc); if (lane >= o) inc += v; }
        __syncthreads();
        if (lane == 63) wtot[F.wave] = inc;
        __syncthreads();
        unsigned base = 0, all = 0;
        for (int w = 0; w < 8; ++w) { const unsigned v = wtot[w]; all += v; if (w < F.wave) base += v; }
        const unsigned tot_gt = all & 0xffffu, need = (unsigned)CAP - tot_gt;
        const unsigned excl = base + inc - pk; unsigned g_before = excl & 0xffffu, e_before = excl >> 16;
#pragma unroll
        for (int i = 0; i < 16; ++i) { const int s = 16 * tid + i; int slot = -1;
            if (key[i] > thr) { slot = (int)g_before; ++g_before; }
            else if (key[i] == thr) { if (e_before < need) slot = (int)(tot_gt + e_before); ++e_before; }
            SLOT[(size_t)p * SEQ + s] = slot;
            if (slot >= 0) { TOPI[p * CAP + slot] = (p >> 4) * SEQ + s; TOPG[p * CAP + slot] = __uint_as_float(key[i]); } }
        __syncthreads();
    }
}
__device__ __forceinline__ void p_final(const Frame& F, float* out, const float* mod, const int* SLOT, const bf16_t* Y, const float* gfin, float oscale) {
    const int tid = opaque_tid(F.wave), lane = tid & 63; (void)tid;
    f32x4 gf[4], xn[4], gtn[4]; int sln = -1;
#pragma unroll
    for (int j = 0; j < 4; ++j) gf[j] = *(const f32x4*)(gfin + 4 * lane + 256 * j);
    int r = F.gw;
    if (r < NTOK) { const int b = r / SEQ, s = r % SEQ; if (lane < NE) sln = SLOT[((size_t)b * NE + lane) * SEQ + s];
#pragma unroll
        for (int j = 0; j < 4; ++j) { const int c = 4 * lane + 256 * j; xn[j] = *(const f32x4*)(out + (size_t)r * DM + c); gtn[j] = *(const f32x4*)(mod + b * 6144 + 5120 + c); } }
#pragma unroll 1
    for (; r < NTOK; r += F.NGW) { const int b = r / SEQ; float* row = out + (size_t)r * DM;
        const int sl = sln; f32x4 x[4], gt[4];
#pragma unroll
        for (int j = 0; j < 4; ++j) { x[j] = xn[j]; gt[j] = gtn[j]; }
        const int rn = r + F.NGW;
        if (rn < NTOK) { const int bn = rn / SEQ, sn = rn % SEQ; sln = -1; if (lane < NE) sln = SLOT[((size_t)bn * NE + lane) * SEQ + sn];
#pragma unroll
            for (int j = 0; j < 4; ++j) { const int c = 4 * lane + 256 * j; xn[j] = *(const f32x4*)(out + (size_t)rn * DM + c); gtn[j] = *(const f32x4*)(mod + bn * 6144 + 5120 + c); } }
        unsigned long long m = __ballot(sl >= 0);
        f32x4 acc[4];
#pragma unroll
        for (int j = 0; j < 4; ++j) acc[j] = (f32x4){0.f, 0.f, 0.f, 0.f};
        while (m) { const int e = __builtin_ctzll(m); m &= m - 1; const int slot = __builtin_amdgcn_readlane(sl, e);
            const bf16_t* yr = Y + (((size_t)b * NE + e) * CAP + slot) * DM;
#pragma unroll
            for (int j = 0; j < 4; ++j) { const u32x2 w = *(const u32x2*)(yr + 4 * lane + 256 * j); acc[j][0] += bflo(w.x); acc[j][1] += bfhi(w.x); acc[j][2] += bflo(w.y); acc[j][3] += bfhi(w.y); } }
        f32x4 v[4]; float ss = 0.f;
#pragma unroll
        for (int j = 0; j < 4; ++j) { v[j] = x[j] + gt[j] * acc[j]; ss += (v[j][0] * v[j][0] + v[j][1] * v[j][1]) + (v[j][2] * v[j][2] + v[j][3] * v[j][3]); }
        const float rstd = 1.0f / sqrtf(wave_sum(ss) * (1.f / DM) + NORM_EPS);
#pragma unroll
        for (int j = 0; j < 4; ++j) { const int c = 4 * lane + 256 * j; f32x4 ov = v[j] * (rstd * oscale) * gf[j];
#if defined(MK_CHECK) && MK_CHECK
#pragma unroll
            for (int e = 0; e < 4; ++e) if (!(ov[e] == ov[e]) || fabsf(ov[e]) > 1e6f) ov[e] = 0.f;
#endif
            *(f32x4*)(row + c) = ov; }
    }
}

__global__ void __launch_bounds__(NWAVES * 64, 2) fwd_kernel(Args args) {
    extern __shared__ __attribute__((aligned(16))) unsigned char lds_raw[];
    Frame F;
    F.lds = (LAS unsigned char*)lds_raw;
    F.wave = __builtin_amdgcn_readfirstlane((int)threadIdx.x >> 6); F.tid = opaque_tid(F.wave); F.lane = F.tid & 63;
    F.G = gridDim.x; { const int bx = blockIdx.x; F.vcu = (F.G % 8 == 0) ? (bx % 8) * (F.G / 8) + bx / 8 : bx; }
    F.gw = F.vcu * NWAVES + F.wave; F.NGW = F.G * NWAVES;
    unsigned char* ws = args.ws;
    volatile LAS unsigned* MISC = (volatile LAS unsigned*)(F.lds + MISC_OFF);
    for (int u = F.tid; u < (LDS_BYTES - RING_BYTES) / 4; u += NWAVES * 64) ((LAS unsigned*)(F.lds + RING_BYTES))[u] = 0u;
    __syncthreads();
    unsigned* ctl = (unsigned*)(ws + WS_CTL);
    XcdBarrier bar = xcd_barrier_post(ctl + CW_BAR, MISC + 8); bar.wv = F.wave;

#define IN_F(k) ((const float*)args.in[k])
#define in_x IN_F(0)
#define cin IN_F(1)
#define positions ((const int*)args.in[2])
#define w_ada IN_F(3)
#define b_ada IN_F(4)
#define g_mix IN_F(5)
#define w_in IN_F(6)
#define g_q IN_F(7)
#define g_kv IN_F(8)
#define w_uq IN_F(9)
#define w_ukv IN_F(10)
#define rel_bias IN_F(11)
#define w_out IN_F(12)
#define g_ffn IN_F(13)
#define w_router IN_F(14)
#define w_gate IN_F(15)
#define w_up IN_F(16)
#define w_down IN_F(17)
#define g_final IN_F(18)
#define t_out (args.out)
#define WSP(T, off) ((T*)(args.ws + (off)))
#define MOD WSP(float, WS_MOD)
#define CS WSP(float, WS_CS)
#define WIN WSP(bf16_t, WS_WIN)
#define WUQ WSP(bf16_t, WS_WUQ)
#define WUKV WSP(bf16_t, WS_WUKV)
#define WOUT WSP(bf16_t, WS_WOUT)
#define t_H WSP(bf16_t, WS_H)
#define t_U WSP(bf16_t, WS_U)
#define t_P WSP(bf16_t, WS_P)
#define CQN WSP(bf16_t, WS_CQN)
#define CKVN WSP(bf16_t, WS_CKVN)
#define QB WSP(bf16_t, WS_QB)
#define KB WSP(bf16_t, WS_KB)
#define VB WSP(bf16_t, WS_VB)
#define OA WSP(bf16_t, WS_OA)
#define OG WSP(bf16_t, WS_OG)
#define LSE WSP(float, WS_LSE)
#define WGU WSP(bf16_t, WS_WGU)
#define WD WSP(bf16_t, WS_WD)
#define HID WSP(bf16_t, WS_HID)
#define t_Y WSP(bf16_t, WS_Y)
#define AFFT WSP(float, WS_AFFT)
#define TOPI WSP(int, WS_TOPI)
#define TOPG WSP(float, WS_TOPG)
#define SLOT WSP(int, WS_SLOT)

#ifndef PH_MASK
#define PH_MASK 0xFFFFFFFFu
#endif
#define PH_ON(k) constexpr (((PH_MASK) >> (k)) & 1u)
#ifndef DUP_MASK
#define DUP_MASK 0u
#endif
#define PH_REP(k) for (int rep_ = 0; rep_ < ((((DUP_MASK) >> (k)) & 1u) ? 2 : 1); ++rep_)
#if defined(PROBE_TIMING)
#define DBG_SCALE() (1.0f + __uint_as_float(__hip_atomic_load(ctl + CW_DBG + 1, RLX_AGENT)))
#elif defined(MK_CHECK) && MK_CHECK
#define DBG_SCALE() ([&]() -> float { const unsigned f_ = __hip_atomic_load(ctl + CW_DBG, RLX_AGENT); return f_ ? 1.0f + 0.05f * (float)(1 + __builtin_ctz(f_)) : 1.0f; }())
#else
#define DBG_SCALE() 1.0f
#endif
    int step = 0; const int lo = args.st_lo, hi = args.st_hi;
#if defined(PROBE_STEP)
#define STEP_BEGIN if (step >= lo && step < hi) { const unsigned long long rt0_ = __builtin_amdgcn_s_memrealtime();
#define STEP_END if (step + 1 < hi) xcd_barrier(bar); if (step == PROBE_STEP && blockIdx.x == 0 && F.wave == 0 && opaque_tid(0) == 0) { \
        const float us_ = (float)(__builtin_amdgcn_s_memrealtime() - rt0_) * 0.01f; *(float*)(ctl + CW_DBG + 1) = __builtin_rintf((us_ + PROBE_QOFF) * (1.f / 16.f)) * 8e-3f; } } ++step;
#else
#define STEP_BEGIN if (step >= lo && step < hi) {
#endif
#if defined(PROBE_STEP)
#elif defined(PROBE_DBLBAR)
#define STEP_END if (step + 1 < hi) { xcd_barrier(bar); xcd_barrier(bar); } } ++step;
#else
#define STEP_END if (step + 1 < hi) xcd_barrier(bar); } ++step;
#endif

    STEP_BEGIN
        if PH_ON(0) PH_REP(0) { p0_mod(F, cin, w_ada, b_ada, MOD);
        p0_cs(F, positions, CS);
        p0_lut(F, rel_bias, (float*)(ws + WS_LUT));
        p0_weights(F, w_in, w_uq, w_ukv, w_out, ws); }
    STEP_END
    STEP_BEGIN
        if PH_ON(1) PH_REP(1) p1_h(F, in_x, g_mix, MOD, t_H);
    STEP_END
    for (int b = 0; b < NB; ++b) {
        STEP_BEGIN
            pg8::Gemm g{(const bf16_t*)((const char*)t_H + (size_t)b * SEQ * DM * (FP8_G1 ? 1 : 2)), WIN, DM, DM, DM, 0, 0, nullptr, 0, 0}; pg8::StaticOrder S; S.init(SEQ, NP, F.G, (int)blockIdx.x);
            pg8::EpiP E{(unsigned char*)t_P, FP8_G1 ? W8_INV : 1.0f, 0};
            if PH_ON(2) PH_REP(2) {
#if defined(PROBE_NOSTORE)
                E.nostore = (rep_ == 0);
#endif
                pg8::gemm_phase<pg8::EpiP, pg8::StaticOrder, false, (FP8_G1 != 0)>(F.lds, F.wave, g, S, E); __syncthreads(); }
        STEP_END
        STEP_BEGIN
            if PH_ON(3) PH_REP(3) lb_latent(F, t_P, g_q, g_kv, CS + (size_t)b * SEQ * 64, CQN, CKVN, KB);
        STEP_END
        STEP_BEGIN
#if MLA_FP8
            { pg8::Gemm g{CQN, WUQ, 384, 384, 384, 0, 0, nullptr, 0, 0}; pg8::StaticOrder S; S.init(SEQ, 1536, F.G, (int)blockIdx.x);
              pg8::EpiQ8 E{(unsigned char*)QB, CS + (size_t)b * SEQ * 64};
              if PH_ON(4) PH_REP(4) { pg8::gemm_phase<pg8::EpiQ8, pg8::StaticOrder, false>(F.lds, F.wave, g, S, E); __syncthreads(); } }
            { pg8::Gemm g{CKVN, WUKV, 256, 256, 256, 0, 0, nullptr, 0, 0}; pg8::StaticOrder S; S.init(SEQ, 1024, F.G, (int)blockIdx.x);
              pg8::EpiK8 E{(unsigned char*)KB};
              if PH_ON(5) PH_REP(5) { pg8::gemm_phase<pg8::EpiK8, pg8::StaticOrder, false>(F.lds, F.wave, g, S, E); __syncthreads(); } }
            { pg8::Gemm g{WUKV + (size_t)1024 * 256, CKVN, 256, 256, 256, 0, 0, nullptr, 0, 0}; pg8::StaticOrder S; S.init(1024, SEQ, F.G, (int)((blockIdx.x + 128) % F.G));
              pg8::EpiVT8 E{(unsigned char*)VB};
              if PH_ON(5) PH_REP(5) { pg8::gemm_phase<pg8::EpiVT8, pg8::StaticOrder, false>(F.lds, F.wave, g, S, E); __syncthreads(); } }
#else
            { pg8::Gemm g{CQN, WUQ, 384, 384, 384, 0, 0, nullptr, 0, 0}; pg8::StaticOrder S; S.init(SEQ, 1536, F.G, (int)blockIdx.x);
              pg8::EpiQ E{QB, CS + (size_t)b * SEQ * 64};
              if PH_ON(4) PH_REP(4) { pg8::gemm_phase<pg8::EpiQ, pg8::StaticOrder, false>(F.lds, F.wave, g, S, E); __syncthreads(); } }
            __syncthreads();
            { pg8::Gemm g{CKVN, WUKV, 256, 256, 256, 0, 0, nullptr, 0, 0}; pg8::StaticOrder S; S.init(SEQ, 2048, F.G, (int)blockIdx.x);
              pg8::EpiKV E{KB, VB};
              if PH_ON(5) PH_REP(5) { pg8::gemm_phase<pg8::EpiKV, pg8::StaticOrder, false>(F.lds, F.wave, g, S, E); __syncthreads(); } }
#endif
        STEP_END
        STEP_BEGIN
            for (int u = blockIdx.x; u < 256; u += F.G) { const int hd = u & 7, qb = u >> 3;
#if MLA_FP8
                att::Unit8 a8{(const unsigned char*)QB + ((size_t)hd * SEQ + 256 * qb) * 192, (const unsigned char*)KB + (size_t)hd * SEQ * 192, (const unsigned char*)VB + (size_t)hd * SEQ * 128,
                              OA + (size_t)(256 * qb) * DM + hd * 128, DM, SEQ / 64, nullptr};
#if defined(PROBE_TIMING)
                a8.dbg = (blockIdx.x == PROBE_BLOCK && b == 3) ? (float*)(ctl + CW_DBG + 1) : nullptr;
#endif
                if PH_ON(6) PH_REP(6) att::attn_mla8_unit(a8, (LAS char*)F.lds, F.wave);
#else
                att::Unit a{};
                a.Q = QB + ((size_t)hd * SEQ + 256 * qb) * 192; a.qs = 192; a.K = KB + (size_t)hd * SEQ * 192; a.ks = 192; a.V = VB + (size_t)hd * SEQ * 128; a.vs = 128;
                a.O = OA + (size_t)(256 * qb) * DM + hd * 128; a.os = DM; a.nt = SEQ / 64;
#if defined(BREAK_MLA) && BREAK_MLA
                a.nt = SEQ / 64 - 2;
#endif
                a.tmul = 1;
#if defined(PROBE_TIMING)
                a.dbg = (blockIdx.x == PROBE_BLOCK && b == 3) ? (float*)(ctl + CW_DBG + 1) : nullptr;
#endif
#if defined(PROBE_SAMETILE)
                a.tmul = 0; att::attn_unit<false>(a, (LAS char*)F.lds, F.wave); a.tmul = 1;
#endif
                if PH_ON(6) PH_REP(6) att::attn_unit<false>(a, (LAS char*)F.lds, F.wave);
#endif
            }

            for (int u = blockIdx.x; u < 768; u += F.G) { const int grp = u >> 8, w = u & 255, hd = w & 7, rest = w >> 3, d = grp == 0 ? 1 : (grp == 1 ? 4 : 16), cl = rest % d, qb = rest / d;
                att::Unit a{};
                const size_t tok0 = (size_t)256 * qb * d + cl; const char* gbase = (const char*)t_P + P_OFF_DIL + grp * P_GRP;
                a.Q = (const bf16_t*)(gbase + tok0 * PROW + hd * 128 * P_QK_ESZ); a.qs = d * (PROW / 2);
                a.K = (const bf16_t*)(gbase + (size_t)cl * PROW + 1024 * P_QK_ESZ + hd * 128 * P_QK_ESZ); a.ks = d * (PROW / 2);
                a.V = (const bf16_t*)(gbase + (size_t)cl * PROW + 2048 * P_QK_ESZ + hd * 256); a.vs = d * (PROW / 2);
                a.O = OG + ((size_t)grp * SEQ + tok0) * DM + hd * 128; a.os = d * DM; a.nt = 6; a.tmul = 1;
#if defined(PROBE_TIMING)
                a.dbg = (blockIdx.x == PROBE_BLOCK && b == 3 && grp == PROBE_GRP) ? (float*)(ctl + CW_DBG + 1) : nullptr;
#endif
                a.kt0 = 4 * qb - 1; a.ktn = (SEQ / d) / 64; a.l0 = 256 * qb; a.pos = positions + (size_t)b * SEQ + cl; a.ps = d;
                a.lse = LSE + ((size_t)grp * SEQ + tok0) * 8 + hd; a.ls = d * 8; a.bias = rel_bias + grp * 8 + hd; a.lutg = (const float*)(ws + WS_LUT) + (grp * 8 + hd) * 2304;
                if PH_ON(7) PH_REP(7) att::attn_unit<true>(a, (LAS char*)F.lds, F.wave); }
        STEP_END
        STEP_BEGIN
            if PH_ON(8) PH_REP(8) lb_combine(F, t_P, OA, OG, LSE, (bf16_t*)((char*)t_U + (size_t)b * SEQ * DM * (FP8_WO ? 1 : 2)));
        STEP_END
#if defined(MK_CHECK) && MK_CHECK
        STEP_BEGIN
#if !defined(CHK_MEASURE) && !defined(CHK_ONLY_DIL)
            chk::check_proj(F, b, ctl, t_P, CQN, CKVN, QB, KB, VB, g_q, g_kv, w_uq, w_ukv, positions);
            chk::check_dil(F, b, ctl, t_P, positions, rel_bias, OG, LSE);
            chk::check_u(F, b, ctl, t_P, OA, OG, LSE, t_U + (size_t)b * SEQ * DM);
#endif
#if defined(CHK_ONLY_DIL)
            chk::check_dil(F, b, ctl, t_P, positions, rel_bias, OG, LSE);
#else
            chk::check_mla(F, b, ctl, QB, KB, VB, OA);
#endif
        STEP_END
#endif
    }
    STEP_BEGIN
        { pg8::Gemm g{t_U, WOUT, DM, DM, DM, 0, 0, nullptr, 0, 0}; pg8::StaticOrder S; S.init(NTOK, DM, F.G, (int)blockIdx.x);
          pg8::EpiRes E{in_x, t_out, MOD, FP8_WO ? W8_INV * (1.0f / U8_SCALE) : 1.0f};
          if PH_ON(9) PH_REP(9) { pg8::gemm_phase<pg8::EpiRes, pg8::StaticOrder, false, (FP8_WO != 0)>(F.lds, F.wave, g, S, E); __syncthreads(); } }
        __syncthreads();
        if PH_ON(10) PH_REP(10) conv_experts(F, w_gate, w_up, w_down, ws);
    STEP_END
    STEP_BEGIN
        if PH_ON(11) PH_REP(11) pg_h2_router(F, t_out, g_ffn, MOD, w_router, t_H, AFFT);
    STEP_END
    STEP_BEGIN
        if PH_ON(12) PH_REP(12) ph_topk(F, AFFT, TOPI, TOPG, SLOT);
    STEP_END
    static_assert(FP8_EX != 0, "the all-batch FFN workspace map assumes fp8 expert operands");
    STEP_BEGIN
        { pg8::Gemm g{t_H, WGU, DM, DM, DM, 0, (long)4096 * 1024, TOPI, CAP, NE}; pg8::GroupOrder S; S.init(4, 16, NB * NE, F.G, (int)blockIdx.x);
          pg8::EpiSwiGLU E{(void*)HID, W8_INV};
          if PH_ON(13) PH_REP(13) { pg8::gemm_phase<pg8::EpiSwiGLU, pg8::GroupOrder, true, true>(F.lds, F.wave, g, S, E); __syncthreads(); } }
    STEP_END
    STEP_BEGIN
        { pg8::Gemm g{HID, WD, DFF, DFF, DFF, (long)CAP * DFF, (long)DM * DFF, nullptr, 0, NE}; pg8::GroupOrder S; S.init(4, 4, NB * NE, F.G, (int)blockIdx.x);
          pg8::EpiDown E{t_Y, TOPG, W8_INV};
          if PH_ON(14) PH_REP(14) { pg8::gemm_phase<pg8::EpiDown, pg8::GroupOrder, false, true>(F.lds, F.wave, g, S, E); __syncthreads(); } }
    STEP_END
    STEP_BEGIN
        if PH_ON(15) p_final(F, t_out, MOD, SLOT, t_Y, g_final, DBG_SCALE());
    STEP_END
#undef STEP_BEGIN
#undef STEP_END
}
#undef IN_F
#undef in_x
#undef cin
#undef positions
#undef w_ada
#undef b_ada
#undef g_mix
#undef w_in
#undef g_q
#undef g_kv
#undef w_uq
#undef w_ukv
#undef rel_bias
#undef w_out
#undef g_ffn
#undef w_router
#undef w_gate
#undef w_up
#undef w_down
#undef g_final
#undef t_out
#undef WSP
#undef MOD
#undef CS
#undef WIN
#undef WUQ
#undef WUKV
#undef WOUT
#undef t_H
#undef t_U
#undef t_P
#undef CQN
#undef CKVN
#undef QB
#undef KB
#undef VB
#undef OA
#undef OG
#undef LSE
#undef WGU
#undef WD
#undef HID
#undef t_Y
#undef AFFT
#undef TOPI
#undef TOPG
#undef SLOT
constexpr int STEPS_MIX = 5
#if defined(MK_CHECK) && MK_CHECK
    + 1
#endif
    ;
constexpr int N_STEPS = 2 + NB * STEPS_MIX + 3 + 3;

#ifndef MK_PER_STEP
#define MK_PER_STEP 0
#endif
extern "C" void kernel_launch(void* const* d_in, const int* in_sizes, int n_in, void* d_out, int out_size, void* d_ws, size_t ws_size, hipStream_t stream) {
    static int grid = 0;
    if (grid == 0) {
        if (n_in != 19 || out_size != NTOK * DM || ws_size < WS_END) { fprintf(stderr, "kernel_launch: unexpected shapes (n_in %d out %d ws %zu need %zu)\n", n_in, out_size, ws_size, (size_t)WS_END); grid = -1; return; }
        int dev = 0, cus = 0;
        if (hipGetDevice(&dev) != hipSuccess || hipDeviceGetAttribute(&cus, hipDeviceAttributeMultiprocessorCount, dev) != hipSuccess) { grid = -1; return; }
        if (hipFuncSetAttribute((const void*)fwd_kernel, hipFuncAttributeMaxDynamicSharedMemorySize, LDS_BYTES) != hipSuccess) { grid = -1; return; }
        int per_cu = 0;
        if (hipOccupancyMaxActiveBlocksPerMultiprocessor(&per_cu, (const void*)fwd_kernel, NWAVES * 64, LDS_BYTES) != hipSuccess || per_cu < 1) { fprintf(stderr, "kernel_launch: occupancy query says %d\n", per_cu); }
        (void)hipGetLastError();
        grid = cus;
    }
    if (grid < 0) return;
    if (hipMemsetAsync((char*)d_ws + WS_CTL, 0, CTL_ZERO_BYTES, stream) != hipSuccess) return;
    Args a{};
    for (int i = 0; i < 19; ++i) a.in[i] = d_in[i];
    a.out = (float*)d_out; a.ws = (unsigned char*)d_ws;
#if MK_PER_STEP
    for (int s = 0; s < N_STEPS; ++s) { a.st_lo = s; a.st_hi = s + 1; hipLaunchKernelGGL(fwd_kernel, dim3(grid), dim3(NWAVES * 64), LDS_BYTES, stream, a); }
#else
    a.st_lo = 0; a.st_hi = N_STEPS;
    hipLaunchKernelGGL(fwd_kernel, dim3(grid), dim3(NWAVES * 64), LDS_BYTES, stream, a);
#endif
    const hipError_t le = hipPeekAtLastError();
    if (le != hipSuccess) fprintf(stderr, "kernel_launch: launch failed: %s\n", hipGetErrorName(le));
}
```

```cpp
#include <hip/hip_runtime.h>
#include <cstdio>
#include <cstdint>

#define LAS __attribute__((address_space(3)))
#define GAS __attribute__((address_space(1)))
typedef unsigned short bf16_t;
typedef short bf16x8 __attribute__((ext_vector_type(8)));
typedef short s16x4 __attribute__((ext_vector_type(4)));
typedef float f32x2 __attribute__((ext_vector_type(2)));
typedef float f32x4 __attribute__((ext_vector_type(4)));
typedef float f32x16 __attribute__((ext_vector_type(16)));
typedef unsigned u32x2 __attribute__((ext_vector_type(2)));
typedef unsigned u32x4 __attribute__((ext_vector_type(4)));
typedef int i32x4 __attribute__((ext_vector_type(4)));

#ifndef MK_FP8
#define MK_FP8 1
#endif
#ifndef DIL_FP8
#define DIL_FP8 1
#endif
constexpr int NB = 4, SEQ = 8192, DM = 1024, NTOK = NB * SEQ;
constexpr int NP = 12032;
constexpr int C_CQ = 0, C_CKV = 384, C_KPE = 640, C_DIL = 704, C_GATE = 9920, D_IN = 11968;
constexpr int NE = 16, CAP = 1024, DFF = 2048;
constexpr int P_QK_ESZ = DIL_FP8 ? 1 : 2, P_GRP = 2 * 1024 * P_QK_ESZ + 2048, P_OFF_DIL = 1408, P_OFF_GATE = P_OFF_DIL + 3 * P_GRP, PROW = P_OFF_GATE + 2 * (2048 + 64);
__host__ __device__ constexpr int p_col_off(int c) {
    return c < C_DIL ? 2 * c : (c < C_GATE ? (P_OFF_DIL + ((c - C_DIL) / 3072) * P_GRP + ((((c - C_DIL) % 3072) >> 10) == 2 ? 2048 * P_QK_ESZ + 2 * (((c - C_DIL) % 3072) & 1023) : ((((c - C_DIL) % 3072) >> 10) * 1024 + (((c - C_DIL) % 3072) & 1023)) * P_QK_ESZ)) : P_OFF_GATE + 2 * (c - C_GATE)); }
__host__ __device__ constexpr bool p_col_f8(int c) { return DIL_FP8 && c >= C_DIL && c < C_GATE && ((((c - C_DIL) % 3072) >> 10) != 2); }
constexpr float NORM_EPS = 1e-6f;
constexpr float LOG2E = 1.4426950408889634f;

constexpr size_t MiB = 1u << 20;
constexpr size_t WS_CTL = 0, CTL_ZERO_BYTES = 1 * MiB;
constexpr size_t WS_MOD = 1 * MiB;
constexpr size_t WS_CS = 2 * MiB;
constexpr size_t WS_WIN = 10 * MiB;
constexpr size_t WS_WUQ = 34 * MiB;
constexpr size_t WS_WUKV = 36 * MiB;
constexpr size_t WS_WOUT = 37 * MiB;
constexpr size_t WS_H = 40 * MiB;
constexpr size_t WS_U = 104 * MiB;
constexpr size_t WS_R = 168 * MiB;
constexpr size_t WS_P = WS_R;
constexpr size_t WS_CQN = WS_R + 188 * MiB;
constexpr size_t WS_CKVN = WS_R + 194 * MiB;
constexpr size_t WS_QB = WS_R + 198 * MiB;
constexpr size_t WS_KB = WS_R + 222 * MiB;
constexpr size_t WS_VB = WS_R + 246 * MiB;
constexpr size_t WS_OA = WS_R + 262 * MiB;
constexpr size_t WS_OG = WS_R + 278 * MiB;
constexpr size_t WS_LSE = WS_R + 326 * MiB;
constexpr size_t WS_WGU = WS_R + 358 * MiB;
constexpr size_t WS_WD = WS_U + 32 * MiB;
constexpr size_t WS_HID = WS_R + 96 * MiB;
constexpr size_t WS_Y = WS_R + 224 * MiB;
constexpr size_t WS_AFFT = WS_R + 352 * MiB;
constexpr size_t WS_TOPI = WS_R + 354 * MiB;
constexpr size_t WS_TOPG = WS_R + 355 * MiB;
constexpr size_t WS_SLOT = WS_R + 356 * MiB;
constexpr size_t WS_END = WS_R + 422 * MiB;
constexpr size_t WS_LUT = 1 * MiB + 512 * 1024;
constexpr int CW_TMO = 0, CW_DBG = 16, CW_BAR = 4096;

constexpr int RING_BYTES = 131072;
constexpr int MISC_OFF = RING_BYTES + 320;
constexpr int LDS_BYTES = 147456;
constexpr int NWAVES = 8;

#define RLX_AGENT __ATOMIC_RELAXED, __HIP_MEMORY_SCOPE_AGENT
#define LDS_WAIT() asm volatile("s_waitcnt lgkmcnt(0)" ::: "memory")
#define VM_WAIT() asm volatile("s_waitcnt vmcnt(0)" ::: "memory")

__device__ __forceinline__ unsigned cvt_pk_bf16(float lo, float hi) { unsigned r; asm volatile("v_cvt_pk_bf16_f32 %0, %1, %2" : "=v"(r) : "v"(lo), "v"(hi)); return r; }
__device__ __forceinline__ float bf2f(unsigned short v) { return __uint_as_float(((unsigned)v) << 16); }
__device__ __forceinline__ float bflo(unsigned w) { return __uint_as_float(w << 16); }
__device__ __forceinline__ float bfhi(unsigned w) { return __uint_as_float(w & 0xffff0000u); }
#define SWZ_XOR(k) (((k) << 10) | 0x1f)
#if defined(OLD_WAVE_SUM)
__device__ __forceinline__ float wave_sum(float v) { for (int o = 1; o < 64; o <<= 1) v += __shfl_xor(v, o); return v; }
#else
__device__ __forceinline__ float wave_sum(float v) {
    v += __int_as_float(__builtin_amdgcn_ds_swizzle(__float_as_int(v), SWZ_XOR(1)));
    v += __int_as_float(__builtin_amdgcn_ds_swizzle(__float_as_int(v), SWZ_XOR(2)));
    v += __int_as_float(__builtin_amdgcn_ds_swizzle(__float_as_int(v), SWZ_XOR(4)));
    v += __int_as_float(__builtin_amdgcn_ds_swizzle(__float_as_int(v), SWZ_XOR(8)));
    v += __int_as_float(__builtin_amdgcn_ds_swizzle(__float_as_int(v), SWZ_XOR(16)));
    { auto rr = __builtin_amdgcn_permlane32_swap(__float_as_uint(v), __float_as_uint(v), false, false); v = __uint_as_float(rr[0]) + __uint_as_float(rr[1]); }
    return v;
}
#endif
__device__ __forceinline__ float wave_max(float v) {
    v = fmaxf(v, __int_as_float(__builtin_amdgcn_ds_swizzle(__float_as_int(v), SWZ_XOR(1))));
    v = fmaxf(v, __int_as_float(__builtin_amdgcn_ds_swizzle(__float_as_int(v), SWZ_XOR(2))));
    v = fmaxf(v, __int_as_float(__builtin_amdgcn_ds_swizzle(__float_as_int(v), SWZ_XOR(4))));
    v = fmaxf(v, __int_as_float(__builtin_amdgcn_ds_swizzle(__float_as_int(v), SWZ_XOR(8))));
    v = fmaxf(v, __int_as_float(__builtin_amdgcn_ds_swizzle(__float_as_int(v), SWZ_XOR(16))));
    { auto rr = __builtin_amdgcn_permlane32_swap(__float_as_uint(v), __float_as_uint(v), false, false); v = fmaxf(__uint_as_float(rr[0]), __uint_as_float(rr[1])); }
    return v;
}
__device__ __forceinline__ float fast_sigmoid(float x) { return __builtin_amdgcn_rcpf(1.f + __builtin_amdgcn_exp2f(-x * LOG2E)); }
#ifndef MK_FP8
#define MK_FP8 1
#endif
#ifndef MLA_NM16
#define MLA_NM16 1
#endif
#ifndef MLA_PKADD
#define MLA_PKADD 0
#endif
#ifndef MLA_PKOLD
#define MLA_PKOLD 0
#endif
#ifndef MLA_PRE
#define MLA_PRE 1
#endif
#ifndef MLA_2T
#define MLA_2T 0
#endif
#ifndef MLA_LSUM
#define MLA_LSUM 1
#endif
#ifndef MLA_FP8
#define MLA_FP8 1
#endif
#ifndef FP8_G1
#define FP8_G1 MK_FP8
#endif
#ifndef FP8_EX
#define FP8_EX MK_FP8
#endif
#ifndef FP8_WO
#define FP8_WO 1
#endif
constexpr float QK_LOG2_SCALE = 0.072168783648703220f * LOG2E;
constexpr float W8_SCALE = 64.0f, W8_INV = 1.0f / 64.0f;
constexpr float U8_SCALE = 16.0f;
typedef int v8i __attribute__((ext_vector_type(8)));
__device__ __forceinline__ unsigned pk4_fp8(float a, float b, float c, float d) { int w = __builtin_amdgcn_cvt_pk_fp8_f32(a, b, 0, false); w = __builtin_amdgcn_cvt_pk_fp8_f32(c, d, w, true); return (unsigned)w; }
#if defined(OLD_TID)
__device__ __forceinline__ int opaque_tid(int wv) { int t = (int)threadIdx.x; asm volatile("" : "+v"(t)); return t; }
#else
__device__ __forceinline__ int opaque_tid(int wv) { int l; asm volatile("v_mbcnt_lo_u32_b32 %0, -1, 0\n\tv_mbcnt_hi_u32_b32 %0, -1, %0" : "=v"(l)); return (wv << 6) | l; }
#endif
struct Frame {
    LAS unsigned char* lds;
    int tid, lane, wave, vcu, G, gw, NGW;
};
struct Args { const void* in[19]; float* out; unsigned char* ws; int st_lo, st_hi; };

#define XB_TMO      128
#define XB_XCNT(j)  (256  + 64 * (j))
#define XB_XSUB(j)  (1280 + 64 * (j))
#define XB_XGEN(j)  (2304 + 64 * (j))
#define XB_TOP      3328
#define XB_TOPGEN   3392
#define XCD_BAR_WORDS 3456
#define XB_SPIN_CAP (1u << 18)

__device__ __forceinline__ unsigned xb_ld(unsigned* p)              { return __hip_atomic_load(p, __ATOMIC_RELAXED, __HIP_MEMORY_SCOPE_AGENT); }
__device__ __forceinline__ unsigned xb_add(unsigned* p, unsigned v) { return __hip_atomic_fetch_add(p, v, __ATOMIC_RELAXED, __HIP_MEMORY_SCOPE_AGENT); }
__device__ __forceinline__ unsigned xb_xcc_id() { return (unsigned)__builtin_amdgcn_s_getreg((3 << 11) | 20) & 0xFu; }
#define XB_SPIN(cond, bar) do { unsigned _sp = 0; while (cond) { __builtin_amdgcn_s_sleep(1); \
    if ((++_sp & 255u) == 0u) { if (xb_ld(&(bar)[XB_TMO])) break; if (_sp > XB_SPIN_CAP) { atomicAdd(&(bar)[XB_TMO], 1u); break; } } } } while (0)

struct XcdBarrier {
    unsigned* bar; unsigned x;
    int wv;
    volatile LAS unsigned* st;
};

__device__ __forceinline__ XcdBarrier xcd_barrier_post(unsigned* bar, volatile LAS unsigned* st) {
    XcdBarrier b; b.bar = bar; b.x = xb_xcc_id(); b.st = st;
    if (threadIdx.x == 0) (void)xb_add(&bar[XB_XCNT(b.x)], 1u);
    return b;
}
__device__ __forceinline__ void xcd_barrier_complete(unsigned* bar, unsigned x, unsigned& nloc, unsigned& nx) {
    const unsigned G = gridDim.x * gridDim.y * gridDim.z;
    unsigned sum, cnt, mine, sp = 0u;
    for (;;) {
        sum = 0u; cnt = 0u; mine = 0u;
#pragma unroll
        for (unsigned j = 0; j < 16; ++j) { const unsigned c = xb_ld(&bar[XB_XCNT(j)]); sum += c; cnt += (c > 0u) ? 1u : 0u; mine = (j == x) ? c : mine; }
        if (sum == G) break;
        __builtin_amdgcn_s_sleep(1);
        if ((++sp & 255u) == 0u) { if (xb_ld(&bar[XB_TMO])) break; if (sp > XB_SPIN_CAP) { atomicAdd(&bar[XB_TMO], 1u); break; } }
    }
    nloc = mine > 0u ? mine : 1u; nx = cnt > 0u ? cnt : 1u;
}

__device__ __forceinline__ void xcd_barrier(const XcdBarrier& b) {
    asm volatile("s_waitcnt vmcnt(0)" ::: "memory");
    __syncthreads();
    if (b.wv == 0 && opaque_tid(0) == 0) {
        unsigned* bar = b.bar;
        __builtin_amdgcn_s_waitcnt(0);
        unsigned nloc = b.st[0], nx = b.st[1];
        if (nloc == 0u) { xcd_barrier_complete(bar, b.x, nloc, nx); b.st[0] = nloc; b.st[1] = nx; }
        const unsigned old = xb_add(&bar[XB_XSUB(b.x)], 1u);
        const unsigned gen = old / nloc;
        if (old + 1u == (gen + 1u) * nloc) {
            __builtin_amdgcn_fence(__ATOMIC_RELEASE, "agent");
            asm volatile("s_waitcnt vmcnt(0)" ::: "memory");
            const unsigned og = xb_add(&bar[XB_TOP], 1u);
            const unsigned tg = og / nx;
            if (og + 1u == (tg + 1u) * nx) xb_add(&bar[XB_TOPGEN], 1u);
            else XB_SPIN(xb_ld(&bar[XB_TOPGEN]) == tg, bar);
            __builtin_amdgcn_fence(__ATOMIC_ACQUIRE, "agent");
            xb_add(&bar[XB_XGEN(b.x)], 1u);
            asm volatile("s_waitcnt vmcnt(0)" ::: "memory");
        } else {
            XB_SPIN(xb_ld(&bar[XB_XGEN(b.x)]) == gen, bar);
            __builtin_amdgcn_fence(__ATOMIC_ACQUIRE, "agent");
            asm volatile("s_waitcnt vmcnt(0)" ::: "memory");
        }
    }
    __syncthreads();
}

namespace pg8 {
constexpr int BM = 256, BK = 64, HALF = 128, HTB = HALF * BK * 2  , STAGE_BYTES = 8 * HTB, NXCD = 8, WGM = 8;

__host__ __device__ __forceinline__ int lds_byte(int r, int c) { const int st = (r >> 4) * 2 + (c >> 5), rr = r & 15, cc = c & 31, ob = rr * 64 + cc * 2; return st * 1024 + (ob ^ (((ob >> 9) & 1) << 5)); }
__host__ __device__ __forceinline__ void stage_rc(int b, int& R, int& C) { const int st = b / 1024, sb = b % 1024, swz = sb ^ (((sb >> 9) & 1) << 5); R = (st >> 1) * 16 + swz / 64; C = (st & 1) * 32 + (swz % 64) / 2; }
__host__ __device__ __forceinline__ int perm32(int rho) { const int n = rho >> 4, i = rho & 15; return 8 * (i >> 2) + 4 * n + (i & 3); }

struct Unit { int pm, pn, g; };
struct Gemm { const bf16_t* A; const bf16_t* Bt; int lda, ldb, K; long a_gs, b_gs; const int* idx; int idx_gs; int b_gmod; };

struct StaticOrder {
    int nM, nN, nwg, G, c;
    __device__ __forceinline__ void init(int M, int N, int G_, int c_) { nM = M / BM; nN = N / BM; nwg = nM * nN; G = G_; c = c_; }
    __device__ __forceinline__ bool next(int i, Unit& u) const {
        const long L = (long)i * G + c; if (L >= nwg) return false;
        int wgid = (int)L; { const int q = nwg / NXCD, r = nwg % NXCD, xcd = wgid % NXCD, off = wgid / NXCD; wgid = (xcd < r ? xcd * (q + 1) : r * (q + 1) + (xcd - r) * q) + off; }
        const int nig = WGM * nN, gid = wgid / nig, fm = gid * WGM, gsz = (nM - fm) < WGM ? (nM - fm) : WGM;
        u.pm = fm + ((wgid % nig) % gsz); u.pn = (wgid % nig) / gsz; u.g = 0; return true;
    }
};
struct GroupOrder {
    int nM, nN, nwg, G, v, gperm;
    __device__ __forceinline__ void init(int nM_, int nN_, int nG, int G_, int c_) { nM = nM_; nN = nN_; nwg = nM_ * nN_ * nG; G = G_; gperm = (nG == 64); v = (G_ % 8 == 0) ? (c_ % 8) * (G_ / 8) + c_ / 8 : c_; }
    __device__ __forceinline__ bool next(int i, Unit& u) const {
        const long L = (long)i * G + v; if (L >= nwg) return false;
        const int w = (int)L, gi = w / (nM * nN); u.pm = w % nM; u.pn = (w / nM) % nN;
        u.g = gperm ? (gi & 3) * 16 + (gi >> 2) : gi;
        return true;
    }
};

template <class Epi, class Sched, bool GATHER, bool FP8 = false>
__device__ __forceinline__ void gemm_phase(LAS unsigned char* lds, int wv, const Gemm g, const Sched& S, const Epi& E) {
    const int tid = opaque_tid(wv), wid = __builtin_amdgcn_readfirstlane(tid >> 6), lane = tid & 63, wr = wid >> 2, wc = wid & 3, fr = lane & 15, fq = lane >> 4;
    constexpr int ESZ = FP8 ? 1 : 2;
    const int K = g.K, nt = K * ESZ / (BK * 2);
    int Rr[2], Cc[2]; unsigned voffB[2];
#pragma unroll
    for (int i = 0; i < 2; ++i) { int R, C; stage_rc(tid * 16 + i * 8192, R, C); Rr[i] = R; Cc[i] = C; const int Rb = (Epi::PERM && !Epi::BPRE) ? ((R & ~31) + perm32(R & 31)) : R;
        voffB[i] = (unsigned)(Rb * g.ldb * ESZ + C * 2); }
    const unsigned kstep = (unsigned)(BK * 2);
    const unsigned hstepA = (unsigned)(HALF * g.lda * ESZ), hstepB = (unsigned)(HALF * g.ldb * ESZ);
    const unsigned ldsw = (unsigned)wid * 1024u;
    const int aoff = lds_byte(wr * 64 + fr, fq * 8), boff = lds_byte(wc * 32 + fr, fq * 8);
#define PG8_SA(b, h) (((b) * 2 + (h)) * HTB)
#define PG8_SB(b, h) ((4 + (b) * 2 + (h)) * HTB)
    const __amdgpu_buffer_rsrc_t rsA = __builtin_amdgcn_make_buffer_rsrc((void*)g.A, 0, 0x7fffffff, 0x00020000), rsB = __builtin_amdgcn_make_buffer_rsrc((void*)g.Bt, 0, 0x7fffffff, 0x00020000);
#ifndef PG8_BUFFER_DMA
#define PG8_BUFFER_DMA 1
#endif
#if PG8_BUFFER_DMA
#define PG8_STAGE(bufoff, rs, so, v0, v1) do { \
        __builtin_amdgcn_raw_ptr_buffer_load_lds(rs, (LAS void*)(lds + (bufoff) + ldsw), 16, (v0), (so), 0, 0); \
        __builtin_amdgcn_raw_ptr_buffer_load_lds(rs, (LAS void*)(lds + (bufoff) + ldsw + 8192), 16, (v1), (so), 0, 0); } while (0)
#else
#define PG8_GBASE(rs) ((const char*)(__builtin_bit_cast(u32x4, rs).x | ((unsigned long long)(__builtin_bit_cast(u32x4, rs).y & 0xffffu) << 32)))
#define PG8_STAGE(bufoff, rs, so, v0, v1) do { const char* gb_ = (&rs == &rsA ? (const char*)g.A : (const char*)g.Bt) + (so); \
        __builtin_amdgcn_global_load_lds((const unsigned*)(gb_ + (v0)), (LAS unsigned*)(lds + (bufoff) + ldsw), 16, 0, 0); \
        __builtin_amdgcn_global_load_lds((const unsigned*)(gb_ + (v1)), (LAS unsigned*)(lds + (bufoff) + ldsw + 8192), 16, 0, 0); } while (0)
#endif
#define PG8_STAGEB(bufoff, so) PG8_STAGE(bufoff, rsB, so, voffB[0], voffB[1])
#define PG8_CAT(x_, y_) __builtin_shufflevector(__builtin_bit_cast(i32x4, x_), __builtin_bit_cast(i32x4, y_), 0, 1, 2, 3, 4, 5, 6, 7)
#define PG8_LO(v_) __builtin_bit_cast(bf16x8, __builtin_shufflevector(v_, v_, 0, 1, 2, 3))
#define PG8_HI(v_) __builtin_bit_cast(bf16x8, __builtin_shufflevector(v_, v_, 4, 5, 6, 7))
#define PG8_LDA(dst, b, h) do { _Pragma("unroll") for (int m = 0; m < 4; ++m) dst[m] = PG8_CAT(*(const LAS bf16x8*)(lds + PG8_SA(b, h) + aoff + m * 2048), *(const LAS bf16x8*)(lds + PG8_SA(b, h) + aoff + m * 2048 + 1024)); } while (0)
#define PG8_LDB(dst, b, h) do { _Pragma("unroll") for (int n = 0; n < 2; ++n) dst[n] = PG8_CAT(*(const LAS bf16x8*)(lds + PG8_SB(b, h) + boff + n * 2048), *(const LAS bf16x8*)(lds + PG8_SB(b, h) + boff + n * 2048 + 1024)); } while (0)
#define PG8_MMA(ai, bj, At, Bt) do { __builtin_amdgcn_s_setprio(1); _Pragma("unroll") for (int m = 0; m < 4; ++m) _Pragma("unroll") for (int n = 0; n < 2; ++n) { \
        if constexpr (FP8) acc[ai][bj][m][n] = __builtin_amdgcn_mfma_scale_f32_16x16x128_f8f6f4(Bt[n], At[m], acc[ai][bj][m][n], 0, 0, 0, 0, 0, 0);   \
        else { acc[ai][bj][m][n] = __builtin_amdgcn_mfma_f32_16x16x32_bf16(PG8_LO(Bt[n]), PG8_LO(At[m]), acc[ai][bj][m][n], 0, 0, 0); \
               acc[ai][bj][m][n] = __builtin_amdgcn_mfma_f32_16x16x32_bf16(PG8_HI(Bt[n]), PG8_HI(At[m]), acc[ai][bj][m][n], 0, 0, 0); } } \
        __builtin_amdgcn_s_setprio(0); } while (0)
#define PG8_WAIT_V(n) asm volatile("s_waitcnt vmcnt(" #n ")" ::: "memory")
#define PG8_WAIT_L(n) asm volatile("s_waitcnt lgkmcnt(" #n ")" ::: "memory")
#define PG8_BAR __builtin_amdgcn_s_barrier()
#define PG8_SCHED __builtin_amdgcn_sched_barrier(0)
    Unit cur, nxt; int ui = 0;
    if (!S.next(0, cur)) return;
    f32x4 acc[2][2][4][2];
#pragma unroll
    for (int a = 0; a < 2; ++a)
#pragma unroll
        for (int b = 0; b < 2; ++b)
#pragma unroll
            for (int m = 0; m < 4; ++m)
#pragma unroll
                for (int n = 0; n < 2; ++n) acc[a][b][m][n] = (f32x4){0.f, 0.f, 0.f, 0.f};
    v8i At[4], B0[2], B1[2];
    unsigned voffA[2]; unsigned oc[2][2], on[2][2];
#pragma unroll
    for (int i = 0; i < 2; ++i) voffA[i] = (unsigned)(Rr[i] * g.lda * ESZ + Cc[i] * 2);
    unsigned cA, cB;
#define PG8_UNIT_PTRS(u, pA, pB, o) do { \
        pB = (unsigned)(((size_t)(g.b_gmod ? (u).g % g.b_gmod : (u).g) * g.b_gs + (size_t)(u).pn * BM * g.ldb) * ESZ); \
        if constexpr (GATHER) { \
            pA = 0u; \
            const int* ix_ = g.idx + (size_t)(u).g * g.idx_gs + (u).pm * BM; const int t_ = opaque_tid(wv); \
            _Pragma("unroll") for (int i = 0; i < 2; ++i) { int R_, C_; stage_rc(t_ * 16 + i * 8192, R_, C_); \
                _Pragma("unroll") for (int h = 0; h < 2; ++h) o[h][i] = (unsigned)ix_[h * HALF + R_] * (unsigned)(g.lda * ESZ) + (unsigned)C_ * 2u; } \
        } else { \
            pA = (unsigned)(((size_t)(u).g * g.a_gs + (size_t)(u).pm * BM * g.lda) * ESZ); \
        } } while (0)
#define PG8_STAGEA(bufoff, p, o, h) do { if constexpr (GATHER) PG8_STAGE(bufoff, rsA, p, o[h][0], o[h][1]); else PG8_STAGE(bufoff, rsA, (p) + (h) * hstepA, voffA[0], voffA[1]); } while (0)
    PG8_UNIT_PTRS(cur, cA, cB, oc);
    PG8_STAGEB(PG8_SB(0, 0), cB); PG8_STAGEB(PG8_SB(0, 1), cB + hstepB); PG8_STAGEA(PG8_SA(0, 0), cA, oc, 0); PG8_STAGEA(PG8_SA(0, 1), cA, oc, 1);
    if (wr == 1) PG8_BAR;
    PG8_WAIT_V(2); PG8_BAR;
    PG8_STAGEB(PG8_SB(1, 0), cB + kstep); PG8_STAGEA(PG8_SA(1, 0), cA + kstep, oc, 0); PG8_STAGEB(PG8_SB(1, 1), cB + hstepB + kstep);
    PG8_WAIT_V(6); PG8_BAR;
    for (;;) {
        const bool has_next = S.next(ui + 1, nxt);
        unsigned nA = cA, nB = cB;
        if constexpr (GATHER) {
#pragma unroll
            for (int h = 0; h < 2; ++h)
#pragma unroll
                for (int i = 0; i < 2; ++i) on[h][i] = oc[h][i];
        }
        if (has_next) PG8_UNIT_PTRS(nxt, nA, nB, on);
#pragma unroll 1
        for (int t = 0; t < nt; t += 2) {
            const bool last = (t == nt - 2);
            const unsigned a1 = cA + (unsigned)(t + 1) * kstep;
            const unsigned a2 = last ? nA : cA + (unsigned)(t + 2) * kstep, b2 = last ? nB : cB + (unsigned)(t + 2) * kstep;
            const unsigned a3 = a2 + kstep, b3 = b2 + kstep;
#define PG8_STAGEA2(bufoff, p, h) do { if constexpr (GATHER) { if (last) PG8_STAGEA(bufoff, p, on, h); else PG8_STAGEA(bufoff, p, oc, h); } else PG8_STAGEA(bufoff, p, oc, h); } while (0)
            PG8_LDB(B0, 0, 0); PG8_LDB(B1, 0, 1); PG8_SCHED; PG8_LDA(At, 0, 0); PG8_STAGEA(PG8_SA(1, 1), a1, oc, 1);
            PG8_WAIT_V(8); PG8_WAIT_L(0); PG8_BAR; PG8_MMA(0, 0, At, B0); PG8_MMA(0, 1, At, B1); PG8_BAR; PG8_SCHED;
            PG8_LDA(At, 0, 1); PG8_STAGEB(PG8_SB(0, 0), b2); PG8_STAGEB(PG8_SB(0, 1), b2 + hstepB); PG8_STAGEA2(PG8_SA(0, 0), a2, 0);
            PG8_WAIT_V(8); PG8_WAIT_L(0); PG8_BAR; PG8_MMA(1, 0, At, B0); PG8_MMA(1, 1, At, B1); PG8_BAR; PG8_SCHED;
            PG8_LDB(B0, 1, 0); PG8_LDB(B1, 1, 1); PG8_SCHED; PG8_LDA(At, 1, 0); PG8_STAGEA2(PG8_SA(0, 1), a2, 1);
            PG8_WAIT_V(8); PG8_WAIT_L(0); PG8_BAR; PG8_MMA(0, 0, At, B0); PG8_MMA(0, 1, At, B1); PG8_BAR; PG8_SCHED;
            PG8_LDA(At, 1, 1); PG8_STAGEB(PG8_SB(1, 0), b3); PG8_STAGEB(PG8_SB(1, 1), b3 + hstepB); PG8_STAGEA2(PG8_SA(1, 0), a3, 0);
            PG8_WAIT_V(8); PG8_WAIT_L(0); PG8_BAR; PG8_MMA(1, 0, At, B0); PG8_MMA(1, 1, At, B1); PG8_BAR; PG8_SCHED;
        }
        if (wr == 0) PG8_BAR;
        { const int l_ = opaque_tid(wv) & 63; E(acc, cur, wr, wc, l_ & 15, l_ >> 4); }
        if (!has_next) break;
#pragma unroll
        for (int a = 0; a < 2; ++a)
#pragma unroll
            for (int b = 0; b < 2; ++b)
#pragma unroll
                for (int m = 0; m < 4; ++m)
#pragma unroll
                    for (int n = 0; n < 2; ++n) acc[a][b][m][n] = (f32x4){0.f, 0.f, 0.f, 0.f};
        cur = nxt; cA = nA; cB = nB; ++ui;
        if constexpr (GATHER) {
#pragma unroll
            for (int h = 0; h < 2; ++h)
#pragma unroll
                for (int i = 0; i < 2; ++i) oc[h][i] = on[h][i];
        }
        if (wr == 1) PG8_BAR;
    }
    PG8_WAIT_V(0);
    PG8_BAR;
#undef PG8_UNIT_PTRS
#undef PG8_STAGEA
#undef PG8_STAGEA2
#undef PG8_SA
#undef PG8_SB
#undef PG8_STAGE
#undef PG8_STAGEB
#undef PG8_LDA
#undef PG8_LDB
#undef PG8_MMA
#undef PG8_CAT
#undef PG8_LO
#undef PG8_HI
#undef PG8_WAIT_V
#undef PG8_WAIT_L
#undef PG8_BAR
#undef PG8_SCHED
}

#define EPI_ROWLOOP for (int ai = 0; ai < 2; ++ai) _Pragma("unroll") for (int m = 0; m < 4; ++m)
__device__ __forceinline__ u32x4 pack8(const f32x4 v0, const f32x4 v1) { u32x4 w; w.x = cvt_pk_bf16(v0[0], v0[1]); w.y = cvt_pk_bf16(v0[2], v0[3]); w.z = cvt_pk_bf16(v1[0], v1[1]); w.w = cvt_pk_bf16(v1[2], v1[3]); return w; }
struct EpiBf16 {
    static constexpr bool PERM = true, BPRE = true;
    bf16_t* O; int ldc; float sc; int nostore;
    __device__ __forceinline__ void operator()(const f32x4 (&acc)[2][2][4][2], const Unit& u, int wr, int wc, int fr, int fq) const {
        const __amdgpu_buffer_rsrc_t rs = __builtin_amdgcn_make_buffer_rsrc((void*)O, 0, 0x7fffffff, 0x00020000);
        const unsigned lo = (unsigned)(fr * ldc + 8 * fq) * 2u, so = (unsigned)(((u.pm * BM + wr * 64) * ldc + u.pn * BM + wc * 32) * 2);
        if (nostore) return;
#pragma unroll
        EPI_ROWLOOP {
#pragma unroll
            for (int bj = 0; bj < 2; ++bj) {
#if !defined(EPI_BUF_STORES)
#if defined(EPI_NT_STORES_PROBE)
                __builtin_nontemporal_store(pack8(acc[ai][bj][m][0] * sc, acc[ai][bj][m][1] * sc), (u32x4*)((char*)O + (size_t)(so + (unsigned)((ai * HALF + m * 16) * ldc + bj * HALF) * 2u) + lo));
#else
                *(u32x4*)((char*)O + (size_t)(so + (unsigned)((ai * HALF + m * 16) * ldc + bj * HALF) * 2u) + lo) = pack8(acc[ai][bj][m][0] * sc, acc[ai][bj][m][1] * sc);
#endif
#else
                __builtin_amdgcn_raw_buffer_store_b128(pack8(acc[ai][bj][m][0] * sc, acc[ai][bj][m][1] * sc), rs, lo, so + (unsigned)((ai * HALF + m * 16) * ldc + bj * HALF) * 2u, 0);
#endif
            } }
    }
};
struct EpiP {
    static constexpr bool PERM = true, BPRE = true;
    unsigned char* P; float sc; int nostore;
    __device__ __forceinline__ void operator()(const f32x4 (&acc)[2][2][4][2], const Unit& u, int wr, int wc, int fr, int fq) const {
        if (nostore) return;
        const size_t rowb = (size_t)(u.pm * BM + wr * 64) * PROW;
#pragma unroll
        for (int bj = 0; bj < 2; ++bj) { const int c32 = u.pn * BM + bj * HALF + wc * 32; const bool f8 = p_col_f8(c32);
            char* ub = (char*)P + rowb + p_col_off(c32); const unsigned lo = (unsigned)(fr * PROW + (f8 ? 8 : 16) * fq);
#pragma unroll
            EPI_ROWLOOP { char* dst = ub + (size_t)(ai * HALF + m * 16) * PROW + lo; const f32x4 v0 = acc[ai][bj][m][0] * sc, v1 = acc[ai][bj][m][1] * sc;
                if (f8) { u32x2 o; o.x = pk4_fp8(v0[0], v0[1], v0[2], v0[3]); o.y = pk4_fp8(v1[0], v1[1], v1[2], v1[3]); *(u32x2*)dst = o; }
                else *(u32x4*)dst = pack8(v0, v1); } }
    }
};
struct EpiQ {
    static constexpr bool PERM = true, BPRE = false;
    bf16_t* QB; const float* cs;
    __device__ __forceinline__ void operator()(const f32x4 (&acc)[2][2][4][2], const Unit& u, int wr, int wc, int fr, int fq) const {
        const unsigned lo = (unsigned)(fr * 192 + 8 * fq) * 2u, lcs = (unsigned)(fr * 64 + 8 * fq) * 4u;
        const int rowU = u.pm * BM + wr * 64;
#pragma unroll
        for (int bj = 0; bj < 2; ++bj) { const int c32 = u.pn * BM + bj * HALF + wc * 32, hd = c32 / 192, w32 = c32 - hd * 192;
            char* ub = (char*)(QB + ((size_t)hd * SEQ + rowU) * 192 + w32);
            const char* cb = (const char*)(cs + (size_t)rowU * 64 + (w32 >= 128 ? (w32 - 128) : 0));
#pragma unroll
            EPI_ROWLOOP { const int rr = ai * HALF + m * 16; f32x4 v0 = acc[ai][bj][m][0], v1 = acc[ai][bj][m][1];
                if (w32 >= 128) { const f32x4 ca = *(const f32x4*)(cb + (size_t)rr * 256 + lcs), cc = *(const f32x4*)(cb + (size_t)rr * 256 + 16 + lcs);
                    const f32x4 a = v0, b = v1;
                    v0[0] = a[0] * ca[0] - a[1] * ca[1]; v0[1] = a[0] * ca[1] + a[1] * ca[0]; v0[2] = a[2] * ca[2] - a[3] * ca[3]; v0[3] = a[2] * ca[3] + a[3] * ca[2];
                    v1[0] = b[0] * cc[0] - b[1] * cc[1]; v1[1] = b[0] * cc[1] + b[1] * cc[0]; v1[2] = b[2] * cc[2] - b[3] * cc[3]; v1[3] = b[2] * cc[3] + b[3] * cc[2]; }
                *(u32x4*)(ub + (size_t)rr * 384 + lo) = pack8(v0, v1);
                if (m & 1) asm volatile("" ::: "memory"); } }
    }
};
struct EpiKV {
    static constexpr bool PERM = true, BPRE = false;
    bf16_t* KB; bf16_t* VB;
    __device__ __forceinline__ void operator()(const f32x4 (&acc)[2][2][4][2], const Unit& u, int wr, int wc, int fr, int fq) const {
        const int rowU = u.pm * BM + wr * 64;
#pragma unroll
        for (int bj = 0; bj < 2; ++bj) { const int c32 = u.pn * BM + bj * HALF + wc * 32, hd = c32 >> 8, w32 = c32 & 255; const bool isk = w32 < 128;
            const int ld = isk ? 192 : 128;
            char* ub = (char*)(isk ? KB + ((size_t)hd * SEQ + rowU) * 192 + w32 : VB + ((size_t)hd * SEQ + rowU) * 128 + (w32 - 128));
            const unsigned lo = (unsigned)(fr * ld + 8 * fq) * 2u;
#pragma unroll
            EPI_ROWLOOP { *(u32x4*)(ub + (size_t)(ai * HALF + m * 16) * ld * 2 + lo) = pack8(acc[ai][bj][m][0], acc[ai][bj][m][1]); } }
    }
};
struct EpiQ8 {
    static constexpr bool PERM = true, BPRE = false;
    unsigned char* Q8; const float* cs;
    __device__ __forceinline__ void operator()(const f32x4 (&acc)[2][2][4][2], const Unit& u, int wr, int wc, int fr, int fq) const {
        const unsigned lo = (unsigned)(fr * 192 + 8 * fq), lcs = (unsigned)(fr * 64 + 8 * fq) * 4u;
        const int rowU = u.pm * BM + wr * 64;
#pragma unroll
        for (int bj = 0; bj < 2; ++bj) { const int c32 = u.pn * BM + bj * HALF + wc * 32, hd = c32 / 192, w32 = c32 - hd * 192;
            char* ub = (char*)(Q8 + ((size_t)hd * SEQ + rowU) * 192 + w32);
            const char* cb = (const char*)(cs + (size_t)rowU * 64 + (w32 >= 128 ? (w32 - 128) : 0));
#pragma unroll
            EPI_ROWLOOP { const int rr = ai * HALF + m * 16; f32x4 v0 = acc[ai][bj][m][0], v1 = acc[ai][bj][m][1];
                if (w32 >= 128) { const f32x4 ca = *(const f32x4*)(cb + (size_t)rr * 256 + lcs), cc = *(const f32x4*)(cb + (size_t)rr * 256 + 16 + lcs);
                    const f32x4 a = v0, b = v1;
                    v0[0] = a[0] * ca[0] - a[1] * ca[1]; v0[1] = a[0] * ca[1] + a[1] * ca[0]; v0[2] = a[2] * ca[2] - a[3] * ca[3]; v0[3] = a[2] * ca[3] + a[3] * ca[2];
                    v1[0] = b[0] * cc[0] - b[1] * cc[1]; v1[1] = b[0] * cc[1] + b[1] * cc[0]; v1[2] = b[2] * cc[2] - b[3] * cc[3]; v1[3] = b[2] * cc[3] + b[3] * cc[2]; }
                v0 = v0 * QK_LOG2_SCALE; v1 = v1 * QK_LOG2_SCALE;
                u32x2 o; o.x = pk4_fp8(v0[0], v0[1], v0[2], v0[3]); o.y = pk4_fp8(v1[0], v1[1], v1[2], v1[3]);
                *(u32x2*)(ub + (size_t)rr * 192 + lo) = o;
                if (m & 1) asm volatile("" ::: "memory"); } }
    }
};
struct EpiK8 {
    static constexpr bool PERM = true, BPRE = false;
    unsigned char* K8;
    __device__ __forceinline__ void operator()(const f32x4 (&acc)[2][2][4][2], const Unit& u, int wr, int wc, int fr, int fq) const {
        const int rowU = u.pm * BM + wr * 64; const unsigned lo = (unsigned)(fr * 192 + 8 * fq);
#pragma unroll
        for (int bj = 0; bj < 2; ++bj) { const int c32 = u.pn * BM + bj * HALF + wc * 32, hd = c32 >> 7, w32 = c32 & 127;
            char* ub = (char*)(K8 + ((size_t)hd * SEQ + rowU) * 192 + w32);
#pragma unroll
            EPI_ROWLOOP { const f32x4 v0 = acc[ai][bj][m][0], v1 = acc[ai][bj][m][1];
                u32x2 o; o.x = pk4_fp8(v0[0], v0[1], v0[2], v0[3]); o.y = pk4_fp8(v1[0], v1[1], v1[2], v1[3]);
                *(u32x2*)(ub + (size_t)(ai * HALF + m * 16) * 192 + lo) = o; } }
    }
};
struct EpiVT8 {
    static constexpr bool PERM = true, BPRE = false;
    unsigned char* VT8;
    __device__ __forceinline__ void operator()(const f32x4 (&acc)[2][2][4][2], const Unit& u, int wr, int wc, int fr, int fq) const {
#pragma unroll
        for (int bj = 0; bj < 2; ++bj) { const int T0 = u.pn * BM + bj * HALF + wc * 32 + 8 * fq, tile = T0 >> 6, G0 = (T0 & 63) >> 2, half = G0 >> 3, a = (G0 & 7) >> 1;
            const int p0 = 4 * (4 * half + a), p1 = 4 * (8 + 4 * half + a);
#pragma unroll
            EPI_ROWLOOP { const int r = u.pm * BM + ai * HALF + wr * 64 + m * 16 + fr, hd = r >> 7, col = r & 127;
                unsigned char* dst = VT8 + (((size_t)hd * (SEQ / 64) + tile) * 128 + col) * 64;
                const f32x4 v0 = acc[ai][bj][m][0], v1 = acc[ai][bj][m][1];
                *(unsigned*)(dst + p0) = pk4_fp8(v0[0], v0[1], v0[2], v0[3]); *(unsigned*)(dst + p1) = pk4_fp8(v1[0], v1[1], v1[2], v1[3]); } }
    }
};
struct EpiRes {
    static constexpr bool PERM = false, BPRE = false;
    const float* x; float* out; const float* mod; float sc;
    __device__ __forceinline__ void operator()(const f32x4 (&acc)[2][2][4][2], const Unit& u, int wr, int wc, int fr, int fq) const {
        const int col0 = u.pn * BM + wc * 32 + 4 * fq;
        const int b = (u.pm * BM) / SEQ;
        f32x4 gt[2][2];
#pragma unroll
        for (int bj = 0; bj < 2; ++bj)
#pragma unroll
            for (int n = 0; n < 2; ++n) gt[bj][n] = *(const f32x4*)(mod + b * 6144 + 2048 + col0 + bj * HALF + n * 16) * sc;
        const unsigned lo = (unsigned)(fr * DM + 4 * fq) * 4u;
        const size_t ubo = ((size_t)(u.pm * BM + wr * 64) * DM + u.pn * BM + wc * 32) * 4;
#pragma unroll
        EPI_ROWLOOP { const size_t ro = ubo + (size_t)(ai * HALF + m * 16) * DM * 4;
#pragma unroll
            for (int bj = 0; bj < 2; ++bj)
#pragma unroll
                for (int n = 0; n < 2; ++n) { const size_t o = ro + (bj * HALF + n * 16) * 4; const f32x4 xv = *(const f32x4*)((const char*)x + o + lo);
                    *(f32x4*)((char*)out + o + lo) = xv + gt[bj][n] * acc[ai][bj][m][n]; }
            if (m & 1) asm volatile("" ::: "memory"); }
    }
};
struct EpiSwiGLU {
    static constexpr bool PERM = true, BPRE = true;
    void* HID; float sc;
    __device__ __forceinline__ void operator()(const f32x4 (&acc)[2][2][4][2], const Unit& u, int wr, int wc, int fr, int fq) const {
        constexpr int HE = FP8_EX ? 1 : 2;
        const __amdgpu_buffer_rsrc_t rs = __builtin_amdgcn_make_buffer_rsrc(HID, 0, 0x7fffffff, 0x00020000);
        const unsigned lo = (unsigned)(fr * DFF + 4 * fq) * HE, so = (unsigned)(((u.g * CAP + u.pm * BM + wr * 64) * DFF + ((u.pn * BM + wc * 32) >> 1)) * HE);
#pragma unroll
        EPI_ROWLOOP {
#pragma unroll
            for (int bj = 0; bj < 2; ++bj) { const f32x4 gv = acc[ai][bj][m][0] * sc, uv = acc[ai][bj][m][1] * sc; f32x4 h;
#pragma unroll
                for (int e = 0; e < 4; ++e) h[e] = gv[e] * fast_sigmoid(gv[e]) * uv[e];
                const unsigned ro = so + (unsigned)((ai * HALF + m * 16) * DFF + bj * (HALF / 2)) * HE;
#if !defined(EPI_BUF_STORES)
                if constexpr (FP8_EX) *(unsigned*)((char*)HID + (size_t)ro + lo) = pk4_fp8(h[0], h[1], h[2], h[3]);
                else { u32x2 o; o.x = cvt_pk_bf16(h[0], h[1]); o.y = cvt_pk_bf16(h[2], h[3]); *(u32x2*)((char*)HID + (size_t)ro + lo) = o; }
#else
                if constexpr (FP8_EX) __builtin_amdgcn_raw_buffer_store_b32(pk4_fp8(h[0], h[1], h[2], h[3]), rs, lo, ro, 0);
                else { u32x2 o; o.x = cvt_pk_bf16(h[0], h[1]); o.y = cvt_pk_bf16(h[2], h[3]); __builtin_amdgcn_raw_buffer_store_b64(o, rs, lo, ro, 0); }
#endif
            } }
    }
};
struct EpiDown {
    static constexpr bool PERM = true, BPRE = true;
    bf16_t* Y; const float* gate; float sc;
    __device__ __forceinline__ void operator()(const f32x4 (&acc)[2][2][4][2], const Unit& u, int wr, int wc, int fr, int fq) const {
        const int rowU = u.g * CAP + u.pm * BM + wr * 64;
        const __amdgpu_buffer_rsrc_t rs = __builtin_amdgcn_make_buffer_rsrc((void*)Y, 0, 0x7fffffff, 0x00020000), rg = __builtin_amdgcn_make_buffer_rsrc((void*)gate, 0, 0x7fffffff, 0x00020000);
        const unsigned lo = (unsigned)(fr * DM + 8 * fq) * 2u, so = (unsigned)((rowU * DM + u.pn * BM + wc * 32) * 2);
#pragma unroll
        EPI_ROWLOOP { const int rr = ai * HALF + m * 16;
#if !defined(EPI_BUF_STORES)
            const float gs = gate[rowU + rr + fr] * sc;
#pragma unroll
            for (int bj = 0; bj < 2; ++bj) *(u32x4*)((char*)Y + (size_t)(so + (unsigned)(rr * DM + bj * HALF) * 2u) + lo) = pack8(acc[ai][bj][m][0] * gs, acc[ai][bj][m][1] * gs);
#else
            const float gs = __uint_as_float(__builtin_amdgcn_raw_buffer_load_b32(rg, (unsigned)fr * 4u, (unsigned)(rowU + rr) * 4u, 0)) * sc;
#pragma unroll
            for (int bj = 0; bj < 2; ++bj) __builtin_amdgcn_raw_buffer_store_b128(pack8(acc[ai][bj][m][0] * gs, acc[ai][bj][m][1] * gs), rs, lo, so + (unsigned)(rr * DM + bj * HALF) * 2u, 0);
#endif
        }
    }
};
#undef EPI_ROWLOOP
}
namespace att {
__device__ __forceinline__ int crow(int r, int hi) { return (r & 3) + 8 * (r >> 2) + 4 * hi; }
__device__ __forceinline__ int v_st(int k, int c) { const int kk = (k & ~0xC) | ((k & 4) << 1) | ((k & 8) >> 1); return ((kk >> 3) * 4 + (c >> 5)) * 512 + ((kk & 7) * 32 + (c & 31)) * 2; }
__device__ __forceinline__ int v_rd_base(int lane) { return ((lane & 3) << 3) | (((lane >> 2) & 3) << 6) | (((lane >> 4) & 1) << 5) | (((lane >> 5) & 1) << 8); }
constexpr int v_rd_off(int d0, int ks, int half) { return d0 * 512 + ks * 4096 + half * 2048; }
template <int OFF> __device__ __forceinline__ s16x4 tr_read(int vb) {
    s16x4 r; asm volatile("ds_read_b64_tr_b16 %0, %1 offset:%2" : "=&v"(r) : "v"(vb), "i"(OFF) : "memory"); return r;
}
#define ATT_SBAR() __builtin_amdgcn_sched_barrier(0)
template <int D0> __device__ __forceinline__ void pv_one(f32x16& od, int vb, bf16x8 pa0, bf16x8 pa1, bf16x8 pa2, bf16x8 pa3) {
    const s16x4 l0 = tr_read<v_rd_off(D0, 0, 0)>(vb), h0 = tr_read<v_rd_off(D0, 0, 1)>(vb), l1 = tr_read<v_rd_off(D0, 1, 0)>(vb), h1 = tr_read<v_rd_off(D0, 1, 1)>(vb);
    const s16x4 l2 = tr_read<v_rd_off(D0, 2, 0)>(vb), h2 = tr_read<v_rd_off(D0, 2, 1)>(vb), l3 = tr_read<v_rd_off(D0, 3, 0)>(vb), h3 = tr_read<v_rd_off(D0, 3, 1)>(vb);
    asm volatile("s_waitcnt lgkmcnt(0)" ::: "memory"); ATT_SBAR();
#define ATT_PK(L, H) (bf16x8){L[0], L[1], L[2], L[3], H[0], H[1], H[2], H[3]}
    od = __builtin_amdgcn_mfma_f32_32x32x16_bf16(pa0, ATT_PK(l0, h0), od, 0, 0, 0);
    od = __builtin_amdgcn_mfma_f32_32x32x16_bf16(pa1, ATT_PK(l1, h1), od, 0, 0, 0);
    od = __builtin_amdgcn_mfma_f32_32x32x16_bf16(pa2, ATT_PK(l2, h2), od, 0, 0, 0);
    od = __builtin_amdgcn_mfma_f32_32x32x16_bf16(pa3, ATT_PK(l3, h3), od, 0, 0, 0);
#undef ATT_PK
}
__device__ __forceinline__ void pv_d0(f32x16* o, int vb, bf16x8 pa0, bf16x8 pa1, bf16x8 pa2, bf16x8 pa3) {
    pv_one<0>(o[0], vb, pa0, pa1, pa2, pa3); pv_one<1>(o[1], vb, pa0, pa1, pa2, pa3); pv_one<2>(o[2], vb, pa0, pa1, pa2, pa3); pv_one<3>(o[3], vb, pa0, pa1, pa2, pa3);
}
__device__ __forceinline__ void finishSM(f32x16& p0, f32x16& p1, float alpha, float& l_reg, bf16x8& pa0, bf16x8& pa1, bf16x8& pa2, bf16x8& pa3) {
#pragma unroll
    for (int r = 0; r < 16; ++r) p1[r] = __builtin_amdgcn_exp2f(p1[r]);
    float ps = 0;
#pragma unroll
    for (int r = 0; r < 16; ++r) ps += p0[r];
#pragma unroll
    for (int r = 0; r < 16; ++r) ps += p1[r];
    { auto rr = __builtin_amdgcn_permlane32_swap(__float_as_uint(ps), __float_as_uint(ps), false, false);
      ps = __uint_as_float(rr[0]) + __uint_as_float(rr[1]); }
    l_reg = l_reg * alpha + ps;
#define ATT_PK4(P, BASE, OUT) do { unsigned a0 = cvt_pk_bf16(P[BASE + 0], P[BASE + 1]), a1 = cvt_pk_bf16(P[BASE + 2], P[BASE + 3]);   \
    unsigned b0 = cvt_pk_bf16(P[BASE + 4], P[BASE + 5]), b1 = cvt_pk_bf16(P[BASE + 6], P[BASE + 7]);                              \
    auto r0 = __builtin_amdgcn_permlane32_swap(a0, b0, false, false); auto r1 = __builtin_amdgcn_permlane32_swap(a1, b1, false, false); \
    u32x4 w = {r0[0], r1[0], r0[1], r1[1]}; OUT = *reinterpret_cast<bf16x8*>(&w); } while (0)
    ATT_PK4(p0, 0, pa0); ATT_PK4(p0, 8, pa1); ATT_PK4(p1, 0, pa2); ATT_PK4(p1, 8, pa3);
#undef ATT_PK4
}

struct Unit {
    const bf16_t* Q; int qs;
    const bf16_t* K; int ks;
    const bf16_t* V; int vs;
    bf16_t* O; int os;
    int nt;
    int tmul;
    float* dbg;
    const float* lutg;
    int kt0, ktn;
    int l0;
    const int* pos; int ps;
    float* lse; int ls;
    const float* bias;
};

template <bool DIL> struct Cfg {
    static constexpr bool K8 = DIL && (DIL_FP8 != 0);
    static constexpr int DQK = DIL ? 128 : 192, ND = K8 ? 4 : DQK / 16, KROWB = (K8 ? DQK : DQK * 2) + 16, SHM_K = 64 * KROWB, SHM_V = 16384;
    static constexpr int NKC = DQK / 64;
    static constexpr int OFF_V = 0, OFF_K = 2 * SHM_V, OFF_WS = (OFF_K + 2 * SHM_K > 8 * 8448 ? OFF_K + 2 * SHM_K : 8 * 8448)  , OFF_POS = OFF_WS + NWAVES * 64 * 4, OFF_LUT = OFF_POS + 2 * 64 * 4, END = OFF_LUT + 9216;
    static constexpr float SCALE = DIL ? 0.088388347648318440f : 0.072168783648703220f;
};

template <bool DIL>
__device__ __forceinline__ void qkt(f32x16& p0, f32x16& p1, const LAS char* Ks, const bf16x8* qr, int r32, int hi) {
    using C = Cfg<DIL>;
    p0 = f32x16{}; p1 = f32x16{};
    const LAS char* k0 = Ks + r32 * C::KROWB + hi * 16; const LAS char* k1 = k0 + 32 * C::KROWB;
#pragma unroll
    for (int d0 = 0; d0 < C::ND; ++d0) {
        const bf16x8 b0 = *(const LAS bf16x8*)(k0 + d0 * 32);
        const bf16x8 b1 = *(const LAS bf16x8*)(k1 + d0 * 32);
        p0 = __builtin_amdgcn_mfma_f32_32x32x16_bf16(b0, qr[d0], p0, 0, 0, 0);
        p1 = __builtin_amdgcn_mfma_f32_32x32x16_bf16(b1, qr[d0], p1, 0, 0, 0); }
}

template <bool DIL>
__device__ __forceinline__ void xstage(bool pv, bool qk, f32x16* o, int vb, bf16x8 pa0, bf16x8 pa1, bf16x8 pa2, bf16x8 pa3, f32x16& p0, f32x16& p1, const LAS char* Ks, const bf16x8* qr, int r32, int hi) {
    using C = Cfg<DIL>;
    constexpr int NG = C::ND / 2;
    const LAS char* k0 = Ks + r32 * C::KROWB + hi * (C::K8 ? 32 : 16);
    bf16x8 f[2][4];
    const int ka = (int)(unsigned)(size_t)k0;
#define ATT_KR1(dst_, off_) asm volatile("ds_read_b128 %0, %1 offset:%2" : "=&v"(dst_) : "v"(ka), "i"(off_) : "memory")
#define ATT_KRD(s_, g_) do { if constexpr (C::K8) { ATT_KR1(f[s_][0], 64 * (g_)); ATT_KR1(f[s_][1], 64 * (g_) + 16); ATT_KR1(f[s_][2], 32 * C::KROWB + 64 * (g_)); ATT_KR1(f[s_][3], 32 * C::KROWB + 64 * (g_) + 16); } \
        else { ATT_KR1(f[s_][0], (2 * (g_)) * 32); ATT_KR1(f[s_][1], 32 * C::KROWB + (2 * (g_)) * 32); ATT_KR1(f[s_][2], (2 * (g_) + 1) * 32); ATT_KR1(f[s_][3], 32 * C::KROWB + (2 * (g_) + 1) * 32); } } while (0)
#define ATT_PK(L, H) (bf16x8){L[0], L[1], L[2], L[3], H[0], H[1], H[2], H[3]}
#define ATT_VRD1(B_, s_, ks_) do { const s16x4 l_ = tr_read<v_rd_off(B_, ks_, 0)>(vb), h_ = tr_read<v_rd_off(B_, ks_, 1)>(vb); f[s_][ks_] = ATT_PK(l_, h_); } while (0)
#define ATT_VRD(B_, s_) do { ATT_VRD1(B_, s_, 0); ATT_VRD1(B_, s_, 1); ATT_VRD1(B_, s_, 2); ATT_VRD1(B_, s_, 3); } while (0)
#define ATT_VMMA(B_, s_) do { o[B_] = __builtin_amdgcn_mfma_f32_32x32x16_bf16(pa0, f[s_][0], o[B_], 0, 0, 0); o[B_] = __builtin_amdgcn_mfma_f32_32x32x16_bf16(pa1, f[s_][1], o[B_], 0, 0, 0); \
        o[B_] = __builtin_amdgcn_mfma_f32_32x32x16_bf16(pa2, f[s_][2], o[B_], 0, 0, 0); o[B_] = __builtin_amdgcn_mfma_f32_32x32x16_bf16(pa3, f[s_][3], o[B_], 0, 0, 0); } while (0)
#define ATT_LW(n) asm volatile("s_waitcnt lgkmcnt(" #n ")" ::: "memory")
    if (pv) {
        ATT_VRD(0, 0); ATT_SBAR();
        ATT_VRD(1, 1); ATT_LW(8); ATT_SBAR(); ATT_VMMA(0, 0); ATT_SBAR();
        ATT_VRD(2, 0); ATT_LW(8); ATT_SBAR(); ATT_VMMA(1, 1); ATT_SBAR();
        ATT_VRD(3, 1); ATT_LW(8); ATT_SBAR(); ATT_VMMA(2, 0); ATT_SBAR();
        ATT_KRD(0, 0); ATT_LW(4); ATT_SBAR(); ATT_VMMA(3, 1); ATT_SBAR();
    } else { ATT_KRD(0, 0); ATT_SBAR(); }
    if (!qk) { ATT_LW(0); return; }
    p0 = f32x16{}; p1 = f32x16{};
    if constexpr (C::K8) {
#define ATT_CAT(x_, y_) __builtin_shufflevector(__builtin_bit_cast(i32x4, x_), __builtin_bit_cast(i32x4, y_), 0, 1, 2, 3, 4, 5, 6, 7)
        ATT_KRD(1, 1); ATT_LW(4); ATT_SBAR();
        p0 = __builtin_amdgcn_mfma_scale_f32_32x32x64_f8f6f4(ATT_CAT(f[0][0], f[0][1]), ATT_CAT(qr[0], qr[1]), p0, 0, 0, 0, 0, 0, 0);
        p1 = __builtin_amdgcn_mfma_scale_f32_32x32x64_f8f6f4(ATT_CAT(f[0][2], f[0][3]), ATT_CAT(qr[0], qr[1]), p1, 0, 0, 0, 0, 0, 0);
        ATT_SBAR(); ATT_LW(0); ATT_SBAR();
        p0 = __builtin_amdgcn_mfma_scale_f32_32x32x64_f8f6f4(ATT_CAT(f[1][0], f[1][1]), ATT_CAT(qr[2], qr[3]), p0, 0, 0, 0, 0, 0, 0);
        p1 = __builtin_amdgcn_mfma_scale_f32_32x32x64_f8f6f4(ATT_CAT(f[1][2], f[1][3]), ATT_CAT(qr[2], qr[3]), p1, 0, 0, 0, 0, 0, 0);
        ATT_SBAR();
#undef ATT_CAT
    } else {
#pragma unroll
    for (int g = 0; g < NG; ++g) { const int sg = g & 1;
        if (g + 1 < NG) { ATT_KRD(sg ^ 1, g + 1); ATT_LW(4); } else { ATT_LW(0); }
        ATT_SBAR();
        p0 = __builtin_amdgcn_mfma_f32_32x32x16_bf16(f[sg][0], qr[2 * g], p0, 0, 0, 0);
        p1 = __builtin_amdgcn_mfma_f32_32x32x16_bf16(f[sg][1], qr[2 * g], p1, 0, 0, 0);
        p0 = __builtin_amdgcn_mfma_f32_32x32x16_bf16(f[sg][2], qr[2 * g + 1], p0, 0, 0, 0);
        p1 = __builtin_amdgcn_mfma_f32_32x32x16_bf16(f[sg][3], qr[2 * g + 1], p1, 0, 0, 0);
        ATT_SBAR(); } }
#undef ATT_VRD1
#undef ATT_KRD
#undef ATT_KR1
#undef ATT_VRD
#undef ATT_PK
#undef ATT_VMMA
#undef ATT_LW
}

template <bool DIL>
__device__ __forceinline__ void partialSM(f32x16& p0, f32x16& p1, float& m_reg, float& mn, float& alpha,
                                          const LAS int* posb, int qoff, int lutlo, int dl0, bool masked, int hi) {
    using C = Cfg<DIL>;
    constexpr float CC = C::SCALE * LOG2E;
    constexpr float THR = 8.f;
    float mnC;
    if constexpr (DIL) {
        const LAS float* lutp = (const LAS float*)(size_t)(unsigned)lutlo;
#define ATT_LUT(pk_) ({ int u_ = (pk_) + qoff; u_ = u_ < 0 ? 0 : (u_ > 2048 ? 2048 : u_); lutp[u_ + (u_ >> 5)]; })
        float bz0[16], bz1[16];
#pragma unroll
        for (int a = 0; a < 4; ++a) {
            const i32x4 pk0 = *(const LAS i32x4*)(posb + 8 * a + 4 * hi), pk1 = *(const LAS i32x4*)(posb + 32 + 8 * a + 4 * hi);
#pragma unroll
            for (int b = 0; b < 4; ++b) { bz0[4 * a + b] = ATT_LUT(pk0[b]); bz1[4 * a + b] = ATT_LUT(pk1[b]); }
        }
        ATT_SBAR();
        if (masked) {
#pragma unroll
            for (int r = 0; r < 16; ++r) { const int dl = dl0 + 8 * (r >> 2) + (r & 3);
                p0[r] = ((unsigned)(dl + 64) <= 128u) ? fmaf(p0[r], CC, bz0[r]) : -1e30f;
                p1[r] = ((unsigned)(dl + 32 + 64) <= 128u) ? fmaf(p1[r], CC, bz1[r]) : -1e30f; }
        } else {
#pragma unroll
            for (int r = 0; r < 16; ++r) { p0[r] = fmaf(p0[r], CC, bz0[r]); p1[r] = fmaf(p1[r], CC, bz1[r]); }
        }
#undef ATT_LUT
        float pmax = p0[0];
#pragma unroll
        for (int r = 1; r < 16; ++r) pmax = fmaxf(pmax, p0[r]);
#pragma unroll
        for (int r = 0; r < 16; ++r) pmax = fmaxf(pmax, p1[r]);
        { auto rr = __builtin_amdgcn_permlane32_swap(__float_as_uint(pmax), __float_as_uint(pmax), false, false);
          pmax = fmaxf(__uint_as_float(rr[0]), __uint_as_float(rr[1])); }
        if (__builtin_expect(__all(pmax - m_reg <= THR * LOG2E), 1)) { mn = m_reg; alpha = 1.f; }
        else { mn = fmaxf(m_reg, pmax); alpha = __builtin_amdgcn_exp2f(m_reg - mn); m_reg = mn; }
        mnC = -fmaxf(mn, -1e29f);
#pragma unroll
        for (int r = 0; r < 16; ++r) p0[r] = p0[r] + mnC;
#pragma unroll
        for (int r = 0; r < 16; ++r) p1[r] = p1[r] + mnC;
    } else {
        float pmax = p0[0];
#pragma unroll
        for (int r = 1; r < 16; ++r) pmax = fmaxf(pmax, p0[r]);
#pragma unroll
        for (int r = 0; r < 16; ++r) pmax = fmaxf(pmax, p1[r]);
        { auto rr = __builtin_amdgcn_permlane32_swap(__float_as_uint(pmax), __float_as_uint(pmax), false, false);
          pmax = fmaxf(__uint_as_float(rr[0]), __uint_as_float(rr[1])); }
        if (__builtin_expect(__all(pmax - m_reg <= THR / C::SCALE), 1)) { mn = m_reg; alpha = 1.f; }
        else { mn = fmaxf(m_reg, pmax); alpha = __builtin_amdgcn_exp2f((m_reg - mn) * CC); m_reg = mn; }
        mnC = -mn * CC;
#pragma unroll
        for (int r = 0; r < 16; ++r) p0[r] = fmaf(p0[r], CC, mnC);
#pragma unroll
        for (int r = 0; r < 16; ++r) p1[r] = fmaf(p1[r], CC, mnC);
    }
#pragma unroll
    for (int r = 0; r < 16; ++r) p0[r] = __builtin_amdgcn_exp2f(p0[r]);
}

__device__ __forceinline__ int t5_bucket(int rel) {
    const int n = rel < 0 ? -rel : rel;
    const float nf = (float)(n > 1 ? n : 1);
    int large = 8 + (int)(logf(nf / 8.f) / 4.852030263919617f * 8.f);
    large = large < 15 ? large : 15;
    return (rel > 0 ? 16 : 0) + (n < 8 ? n : large);
}

template <bool DIL>
__device__ __forceinline__ void attn_unit(const Unit& a, LAS char* lds, int wv) {
    using C = Cfg<DIL>;
    constexpr int SD = 1;
    const int tid = opaque_tid(wv), wid = __builtin_amdgcn_readfirstlane(tid >> 6), lane = tid & 63, r32 = lane & 31, hi = lane >> 5;
#if defined(PROBE_TIMING)
    const unsigned long long t_entry = __builtin_amdgcn_s_memtime();
#endif
    LAS char* V_lds = lds + C::OFF_V; LAS char* K_lds = lds + C::OFF_K;
    LAS float* ws = (LAS float*)(lds + C::OFF_WS) + wid * 64; LAS float* li_l = ws; LAS float* al_l = ws + 32;
    LAS int* pos_l = (LAS int*)(lds + C::OFF_POS); LAS float* lut = (LAS float*)(lds + C::OFF_LUT);
    float m_reg = -1e30f, l_reg = 0; f32x16 o[4] = {}; bf16x8 qr[C::ND];
    if constexpr (C::K8) { const char* Qw = (const char*)(a.Q + (size_t)(wid * 32 + r32) * a.qs) + hi * 32;
#pragma unroll
      for (int i = 0; i < 4; ++i) qr[i] = *(const bf16x8*)(Qw + 64 * (i >> 1) + 16 * (i & 1)); }
    else { const bf16_t* Qw = a.Q + (size_t)(wid * 32 + r32) * a.qs + hi * 8;
#pragma unroll
      for (int d0 = 0; d0 < C::ND; ++d0) qr[d0] = *(const bf16x8*)(Qw + d0 * 16); }
    int pq = 0, lq = 0;
    if constexpr (DIL) {
        lq = a.l0 + wid * 32 + r32; pq = a.pos[(size_t)lq * a.ps];
        pq = 1024 - pq;
        { const char* ls = (const char*)a.lutg + lane * 16; LAS char* ld = (LAS char*)lut;
          __builtin_amdgcn_global_load_lds((const unsigned*)(ls + wid * 1024), (LAS unsigned*)(ld + wid * 1024), 16, 0, 0);
          if (wid == 0) __builtin_amdgcn_global_load_lds((const unsigned*)(ls + 8192), (LAS unsigned*)(ld + 8192), 16, 0, 0); }
    }
    constexpr int CPR = C::KROWB / 16, NKP = C::SHM_K / 1024, NKI = (NKP + 7) / 8;
    unsigned kgo[NKI];
#pragma unroll
    for (int i = 0; i < NKI; ++i) { const int pch = (wid + 8 * i) * 64 + lane, kr = pch / CPR, kc = pch % CPR; kgo[i] = (unsigned)(kr * a.ks + (kc == CPR - 1 ? 0 : kc) * 8) * 2u; }
    unsigned vgo[2];
#pragma unroll
    for (int i = 0; i < 2; ++i) { const int pch = (wid + 8 * i) * 64 + lane, sub = pch >> 5, within = pch & 31, kk = (sub >> 2) * 8 + (within >> 2), cc = (sub & 3) * 32 + (within & 3) * 8;
        const int k = (kk & ~0xC) | ((kk & 4) << 1) | ((kk & 8) >> 1); vgo[i] = (unsigned)(k * a.vs + cc) * 2u; }
    const int vb0 = (int)(unsigned)(size_t)V_lds + v_rd_base(lane);
    int ppos = 0, ppos_n = 0;
#define ATT_KROW0(j) (DIL ? (((a.kt0 + (j)) < 0 ? 0 : ((a.kt0 + (j)) >= a.ktn ? a.ktn - 1 : (a.kt0 + (j)))) * 64) : (j) * 64 * a.tmul)
#define ATT_DMAK(j) do { const int k0_ = ATT_KROW0(j); const char* kt_ = (const char*)(a.K + (size_t)k0_ * a.ks); LAS char* kd_ = K_lds + ((j) & 1) * C::SHM_K + wid * 1024; \
        _Pragma("unroll") for (int q_ = 0; q_ < NKI; ++q_) if (wid + 8 * q_ < NKP) \
            __builtin_amdgcn_global_load_lds((const unsigned*)(kt_ + kgo[q_]), (LAS unsigned*)(kd_ + q_ * 8192), 16, 0, 0); } while (0)
#define ATT_DMAV(j) do { const int k0_ = ATT_KROW0(j); const char* vt_ = (const char*)(a.V + (size_t)k0_ * a.vs); LAS char* vd_ = V_lds + ((j) & 1) * C::SHM_V + wid * 1024; \
        __builtin_amdgcn_global_load_lds((const unsigned*)(vt_ + vgo[0]), (LAS unsigned*)(vd_), 16, 0, 0); \
        __builtin_amdgcn_global_load_lds((const unsigned*)(vt_ + vgo[1]), (LAS unsigned*)(vd_ + 8192), 16, 0, 0); } while (0)
#define ATT_LOADPOS(dst_, j) do { if constexpr (DIL) { if (tid < 64) dst_ = a.pos[(size_t)(ATT_KROW0(j) + tid) * a.ps]; } } while (0)
#define ATT_WRITEPOS(j) do { if constexpr (DIL) { if (tid < 64) pos_l[((j) & 1) * 64 + tid] = ppos; } } while (0)
#define ATT_VMW() asm volatile("s_waitcnt vmcnt(0)" ::: "memory")
#define ATT_BAR() do { asm volatile("s_waitcnt lgkmcnt(0)" ::: "memory"); __builtin_amdgcn_s_barrier(); asm volatile("" ::: "memory"); } while (0)
#define ATT_RESC(al) do { if (__any((al) < 1.f)) { if (hi == 0) al_l[r32] = (al); asm volatile("s_waitcnt lgkmcnt(0)" ::: "memory"); \
        _Pragma("unroll") for (int d = 0; d < 4; ++d) _Pragma("unroll") for (int r = 0; r < 16; ++r) o[d][r] *= al_l[crow(r, hi)]; } } while (0)
#define ATT_DL0(j) (DIL ? (ATT_TV(j) ? (64 * (a.kt0 + (j)) - lq + 4 * hi) : 0x20000000) : 0)
#define ATT_TV(j) (DIL ? ((a.kt0 + (j)) >= 0 && (a.kt0 + (j)) < a.ktn) : true)
#define ATT_MASKED(j) (DIL ? ((j) != (wid >> 1) + 1) : false)
    f32x16 p0, p1; float mn, al; bf16x8 pa0, pa1, pa2, pa3; const int NT = a.nt;
    const bool grpB = wid >= 4;
    ATT_DMAK(0); ATT_DMAK(1); ATT_DMAV(0); ATT_LOADPOS(ppos, 0); ATT_VMW(); ATT_WRITEPOS(0); ATT_LOADPOS(ppos, 1);
    __syncthreads();
    if (grpB) ATT_BAR();
#if defined(PROBE_TIMING)
    unsigned long long tacc = 0, tt0 = 0; const unsigned long long tstart = __builtin_amdgcn_s_memtime(), rstart = __builtin_amdgcn_s_memrealtime();
#define TSTAMP() __builtin_amdgcn_s_memtime()
#else
#define TSTAMP() 0ull
#endif
#pragma unroll 1
    for (int j = 0; j < NT; ++j) {
        const int cur = j & 1;
#if defined(PROBE_TIMING)
        tt0 = TSTAMP();
#endif
        if (!grpB && j >= 1) { if (j + 1 < NT) ATT_DMAK(j + 1); ATT_DMAV(j); }
        if constexpr (DIL) { if (!grpB && j + 2 < NT) ATT_LOADPOS(ppos_n, j + 2); }
        ATT_SBAR();
        const bool act = !DIL || (j >= (wid >> 1) && j <= (wid >> 1) + 2), actp = !DIL || (j - 1 >= (wid >> 1) && j - 1 <= (wid >> 1) + 2);
        xstage<DIL>(j > 0 && actp, act, o, vb0 + (cur ^ 1) * (int)C::SHM_V, pa0, pa1, pa2, pa3, p0, p1, K_lds + cur * C::SHM_K, qr, r32, hi);
        ATT_SBAR();
#if defined(PROBE_TIMING) && PROBE_TIMING == 2
        tacc += TSTAMP() - tt0;
#endif
#if defined(PROBE_TIMING) && PROBE_TIMING == 6
        tt0 = TSTAMP();
#endif
        if (grpB) ATT_VMW();
#if defined(PROBE_TIMING) && PROBE_TIMING == 6
        tacc += TSTAMP() - tt0;
#endif
#if defined(PROBE_TIMING) && PROBE_TIMING == 5
        tt0 = TSTAMP();
#endif
        ATT_BAR();
#if defined(PROBE_TIMING) && PROBE_TIMING == 5
        tacc += TSTAMP() - tt0;
#endif
#if defined(PROBE_TIMING) && PROBE_TIMING == 3
        tt0 = TSTAMP();
#endif
        if (grpB) { if (j + 2 < NT) ATT_DMAK(j + 2); if (j + 1 < NT) ATT_DMAV(j + 1); }
        if (act) {
        partialSM<DIL>(p0, p1, m_reg, mn, al, pos_l + cur * 64, pq, (int)(unsigned)(size_t)lut, ATT_DL0(j), ATT_MASKED(j), hi);
        ATT_RESC(al);
        finishSM(p0, p1, al, l_reg, pa0, pa1, pa2, pa3);
        }
        if constexpr (DIL) { if (!grpB && j + 1 < NT) { ATT_WRITEPOS(j + 1); ppos = ppos_n; } }
        ATT_SBAR();
#if defined(PROBE_TIMING) && PROBE_TIMING == 3
        tacc += TSTAMP() - tt0;
#endif
#if defined(PROBE_TIMING) && PROBE_TIMING == 6
        tt0 = TSTAMP();
#endif
        if (!grpB) ATT_VMW();
#if defined(PROBE_TIMING) && PROBE_TIMING == 6
        tacc += TSTAMP() - tt0;
#endif
        ATT_BAR();
    }
#if defined(PROBE_TIMING)
    if (DIL && a.dbg && tid == PROBE_TID && PROBE_TIMING == 8) *a.dbg = (float)(TSTAMP() - tstart) * 1e-6f;
    if (a.dbg && tid == PROBE_TID && PROBE_TIMING < 7) { const unsigned long long tend = TSTAMP(), rend = __builtin_amdgcn_s_memrealtime(); float v;
        if (PROBE_TIMING == 1) v = (float)(tend - tstart) / (float)NT * 1e-5f;
        else if (PROBE_TIMING == 4) v = (float)(tend - tstart) / (float)(rend - rstart) * 1e-3f;
        else v = (float)tacc / (float)NT * 1e-5f;
        *a.dbg = v; }
#endif
    if (!DIL || (NT - 1 <= (wid >> 1) + 2)) pv_d0(o, vb0 + ((NT - 1) & 1) * (int)C::SHM_V, pa0, pa1, pa2, pa3);
    if (!grpB) ATT_BAR();
    ATT_BAR();
    if (hi == 0) li_l[r32] = l_reg; asm volatile("s_waitcnt lgkmcnt(0)" ::: "memory");
    { LAS char* ot = lds + wid * 8448;
#pragma unroll
      for (int r = 0; r < 16; ++r) { const int orow = crow(r, hi); const float rl = __builtin_amdgcn_rcpf(li_l[orow]);
#pragma unroll
          for (int d0 = 0; d0 < 4; ++d0) { const float v = o[d0][r] * rl; *(LAS bf16_t*)(ot + orow * 264 + (d0 * 32 + r32) * 2) = (bf16_t)(cvt_pk_bf16(v, v) & 0xffffu); } }
      asm volatile("s_waitcnt lgkmcnt(0)" ::: "memory");
      char* Ow = (char*)(a.O + (size_t)(wid * 32) * a.os);
      const int orow0 = lane >> 4, ocol = (lane & 15) * 16;
#pragma unroll
      for (int i = 0; i < 8; ++i) { const int orow = orow0 + 4 * i; const u32x2 w0 = *(const LAS u32x2*)(ot + orow * 264 + ocol), w1 = *(const LAS u32x2*)(ot + orow * 264 + ocol + 8);
          u32x4 w; w.x = w0.x; w.y = w0.y; w.z = w1.x; w.w = w1.y;
          *(u32x4*)(Ow + (size_t)orow * a.os * 2 + ocol) = w; } }
    if constexpr (DIL) { if (hi == 0) a.lse[(size_t)(wid * 32 + r32) * a.ls] = m_reg + __builtin_amdgcn_logf(l_reg); }
    __syncthreads();
#if defined(PROBE_TIMING)
    if (DIL && a.dbg && tid == PROBE_TID && PROBE_TIMING == 7) *a.dbg = (float)(__builtin_amdgcn_s_memtime() - t_entry) * 1e-6f;
#endif
#undef ATT_KROW0
#undef ATT_BAR
#undef ATT_DMAK
#undef ATT_DMAV
#undef ATT_LOADPOS
#undef ATT_WRITEPOS
#undef ATT_VMW
#undef ATT_RESC
#undef ATT_DL0
#undef ATT_TV
#undef ATT_MASKED
}
struct Unit8 { const unsigned char* Q; const unsigned char* K; const unsigned char* VT; bf16_t* O; int os, nt; float* dbg; };
__device__ __forceinline__ v8i ld32(const LAS char* p) { return __builtin_shufflevector(*(const LAS i32x4*)p, *(const LAS i32x4*)(p + 16), 0, 1, 2, 3, 4, 5, 6, 7); }
#define ATT8_MFMA(a_, b_, c_) __builtin_amdgcn_mfma_scale_f32_32x32x64_f8f6f4(a_, b_, c_, 0, 0, 0, 0, 0, 0)
__device__ __forceinline__ void attn_mla8_unit(const Unit8& a, LAS char* lds, int wv) {
    constexpr int KROWB = 208, SHM_K = 64 * KROWB  , VROWB = 80, SHM_V = 128 * VROWB  , NKP = 13, NVP = 10;
    constexpr int NSLOT = MLA_2T ? 4 : 3;
    constexpr int OFF_V = 0, OFF_K = NSLOT * SHM_V, OFF_WS = OFF_K + NSLOT * SHM_K;
    static_assert(OFF_WS + 8 * 64 * 4 <= RING_BYTES, "rings and per-wave words inside the ring area");
    static_assert(!(MLA_2T && MLA_PRE), "the fragment prefetch is written for the one-tile interval");
    static_assert(8 * 8448 <= OFF_WS, "output staging images below the per-wave words");
    constexpr float THR2 = 5.0f * LOG2E;
    const int tid = opaque_tid(wv), wid = __builtin_amdgcn_readfirstlane(tid >> 6), lane = tid & 63, r32 = lane & 31, hi = lane >> 5;
    LAS char* V_lds = lds + OFF_V; LAS char* K_lds = lds + OFF_K;
    LAS float* li_l = (LAS float*)(lds + OFF_WS) + wid * 64; LAS float* al_l = li_l + 32;
    float m2 = 0.f, l_reg = 0.f; f32x16 o[4] = {}; v8i qr[3];
    { const unsigned char* Qw = a.Q + (size_t)(wid * 32 + r32) * 192 + hi * 32;
#pragma unroll
      for (int c = 0; c < 3; ++c) qr[c] = __builtin_shufflevector(*(const i32x4*)(Qw + 64 * c), *(const i32x4*)(Qw + 64 * c + 16), 0, 1, 2, 3, 4, 5, 6, 7); }
    unsigned kgo[2], vgo[2];
#pragma unroll
    for (int i = 0; i < 2; ++i) { const int p = (wid + 8 * i) * 64 + lane, kr = p / 13, kc = p % 13; kgo[i] = (unsigned)(kr * 192 + (kc == 12 ? 0 : kc) * 16);
        const int vr = p / 5, vc = p % 5; vgo[i] = (unsigned)(vr * 64 + (vc == 4 ? 0 : vc) * 16); }
#define ATT8_DMAK(j, slot) do { const char* kt_ = (const char*)a.K + (size_t)(j) * 64 * 192; LAS char* kd_ = K_lds + (slot) * SHM_K + wid * 1024; \
        __builtin_amdgcn_global_load_lds((const unsigned*)(kt_ + kgo[0]), (LAS unsigned*)(kd_), 16, 0, 0); \
        if (wid + 8 < NKP) __builtin_amdgcn_global_load_lds((const unsigned*)(kt_ + kgo[1]), (LAS unsigned*)(kd_ + 8192), 16, 0, 0); } while (0)
#define ATT8_DMAV(j, slot) do { const char* vt_ = (const char*)a.VT + (size_t)(j) * 8192; LAS char* vd_ = V_lds + (slot) * SHM_V + wid * 1024; \
        __builtin_amdgcn_global_load_lds((const unsigned*)(vt_ + vgo[0]), (LAS unsigned*)(vd_), 16, 0, 0); \
        if (wid + 8 < NVP) __builtin_amdgcn_global_load_lds((const unsigned*)(vt_ + vgo[1]), (LAS unsigned*)(vd_ + 8192), 16, 0, 0); } while (0)
#define ATT8_VMW() asm volatile("s_waitcnt vmcnt(0)" ::: "memory")
#define ATT8_BAR() do { asm volatile("s_waitcnt lgkmcnt(0)" ::: "memory"); __builtin_amdgcn_s_barrier(); asm volatile("" ::: "memory"); } while (0)
#define ATT8_RD(dst_, addr_, off_) do { i32x4 lo_, hi_; asm volatile("ds_read_b128 %0, %1 offset:%2" : "=&v"(lo_) : "v"(addr_), "i"(off_) : "memory"); \
        asm volatile("ds_read_b128 %0, %1 offset:%2" : "=&v"(hi_) : "v"(addr_), "i"((off_) + 16) : "memory"); dst_ = __builtin_shufflevector(lo_, hi_, 0, 1, 2, 3, 4, 5, 6, 7); } while (0)
#define ATT8_LW(n) asm volatile("s_waitcnt lgkmcnt(" #n ")" ::: "memory")
    const int koff = r32 * KROWB + hi * 32, voff = r32 * VROWB + hi * 32;
    f32x16 p0, p1, nm16; v8i pa = {}; const int NT = a.nt;
#if MLA_LSUM
    f32x16 lacc = {}; v8i ones8; { int c_ = 0x38383838; asm volatile("" : "+v"(c_)); _Pragma("unroll") for (int i = 0; i < 8; ++i) ones8[i] = c_; }
#endif
    const bool grpB = wid >= 4;
    ATT8_DMAK(0, 0); ATT8_DMAK(1, 1); ATT8_DMAV(0, 0); ATT8_VMW();
    __syncthreads();
    int s0 = 0, s1 = 1, s2 = 2;
#define ATT8_ISSUE() do { if (j + 2 < NT) ATT8_DMAK(j + 2, s2); if (j + 1 < NT) ATT8_DMAV(j + 1, s1); } while (0)
#define ATT8_QK6(kb_, G0_, G1_, G2_, C0_, C1_) do { \
        ATT8_RD(G2_, kb_, 64); ATT8_LW(4); ATT_SBAR(); p0 = ATT8_MFMA(G0_, qr[0], C0_); ATT_SBAR(); \
        ATT8_RD(G0_, kb_, 32 * KROWB + 64); ATT8_LW(4); ATT_SBAR(); p1 = ATT8_MFMA(G1_, qr[0], C1_); ATT_SBAR(); \
        ATT8_RD(G1_, kb_, 128); ATT8_LW(4); ATT_SBAR(); p0 = ATT8_MFMA(G2_, qr[1], p0); ATT_SBAR(); \
        ATT8_RD(G2_, kb_, 32 * KROWB + 128); ATT8_LW(4); ATT_SBAR(); p1 = ATT8_MFMA(G0_, qr[1], p1); ATT_SBAR(); \
        ATT8_LW(2); ATT_SBAR(); p0 = ATT8_MFMA(G1_, qr[2], p0); ATT_SBAR(); \
        ATT8_LW(0); ATT_SBAR(); p1 = ATT8_MFMA(G2_, qr[2], p1); ATT_SBAR(); } while (0)
#if MLA_PKOLD
#define ATT8_PK4(w_, P_, q_) do { w_ = __builtin_amdgcn_cvt_pk_fp8_f32(P_[4 * (q_)], P_[4 * (q_) + 1], w_, false); w_ = __builtin_amdgcn_cvt_pk_fp8_f32(P_[4 * (q_) + 2], P_[4 * (q_) + 3], w_, true); } while (0)
#else
#define ATT8_PK4(w_, P_, q_) do { w_ = (int)pk4_fp8(P_[4 * (q_)], P_[4 * (q_) + 1], P_[4 * (q_) + 2], P_[4 * (q_) + 3]); } while (0)
#endif
#define ATT8_PACK() do { _Pragma("unroll") for (int q = 0; q < 4; ++q) { ATT8_PK4(pa[q], p0, q); ATT8_PK4(pa[4 + q], p1, q); } } while (0)
#define ATT8_PAIR(P_, i_) (f32x2){P_[2 * (i_)], P_[2 * (i_) + 1]}
#if MLA_PKADD
#define ATT8_SUM32(ps_) f32x2 pp_ = ATT8_PAIR(p0, 0); _Pragma("unroll") for (int r = 1; r < 8; ++r) pp_ += ATT8_PAIR(p0, r); _Pragma("unroll") for (int r = 0; r < 8; ++r) pp_ += ATT8_PAIR(p1, r); float ps_ = pp_[0] + pp_[1]
#else
#define ATT8_SUM32(ps_) float ps_ = 0.f; _Pragma("unroll") for (int r = 0; r < 16; ++r) ps_ += p0[r]; _Pragma("unroll") for (int r = 0; r < 16; ++r) ps_ += p1[r]
#endif
#if MLA_LSUM
#define ATT8_ROWSUM(al_) do { } while (0)
#define ATT8_LMFMA() lacc = ATT8_MFMA(pa, ones8, lacc)
#define ATT8_LRESC() do { _Pragma("unroll") for (int r = 0; r < 16; ++r) lacc[r] *= al_l[crow(r, hi)]; } while (0)
#else
#define ATT8_LMFMA() do { } while (0)
#define ATT8_LRESC() do { } while (0)
#define ATT8_ROWSUM(al_) do { ATT8_SUM32(ps_); \
        { auto rr = __builtin_amdgcn_permlane32_swap(__float_as_uint(ps_), __float_as_uint(ps_), false, false); ps_ = __uint_as_float(rr[0]) + __uint_as_float(rr[1]); } l_reg = l_reg * (al_) + ps_; } while (0)
#endif
#if MLA_NM16
#define ATT8_INIT() do { const float nm_ = -m2; _Pragma("unroll") for (int r = 0; r < 16; ++r) nm16[r] = nm_; } while (0)
#define ATT8_INIT_SLOW() nm16 -= dl
#define ATT8_INIT_TILE() do { } while (0)
#define ATT8_C0 nm16
#define ATT8_C1 nm16
#else
#define ATT8_INIT() do { } while (0)
#define ATT8_INIT_SLOW() do { } while (0)
#define ATT8_INIT_TILE() do { const float nm_ = -m2; _Pragma("unroll") for (int r = 0; r < 16; ++r) { p0[r] = nm_; p1[r] = nm_; } } while (0)
#define ATT8_C0 p0
#define ATT8_C1 p1
#endif
#define ATT8_ROWMAX(pm_) do { pm_ = p0[0]; _Pragma("unroll") for (int r = 1; r < 16; ++r) pm_ = fmaxf(pm_, p0[r]); _Pragma("unroll") for (int r = 0; r < 16; ++r) pm_ = fmaxf(pm_, p1[r]); \
        { auto rr = __builtin_amdgcn_permlane32_swap(__float_as_uint(pm_), __float_as_uint(pm_), false, false); pm_ = fmaxf(__uint_as_float(rr[0]), __uint_as_float(rr[1])); } } while (0)
#define ATT8_X0() ATT8_X0_(s0)
#define ATT8_X() ATT8_X_(s0, s2)
#define ATT8_X0_(ks_) do { const int kb = (int)(unsigned)(size_t)(K_lds + (ks_) * SHM_K + koff); v8i g0, g1, g2; ATT8_RD(g0, kb, 0); ATT8_RD(g1, kb, 32 * KROWB); ATT8_QK6(kb, g0, g1, g2, f32x16{}, f32x16{}); } while (0)
#if MLA_PRE
#define ATT8_XPRE(vs_) do { const int vb = (int)(unsigned)(size_t)(V_lds + (vs_) * SHM_V + voff); ATT8_RD(g0, vb, 0); ATT8_RD(g1, vb, 32 * VROWB); } while (0)
#define ATT8_XHEAD() do { } while (0)
    v8i g0, g1;
#define ATT8_XDECL() v8i g2
#else
#define ATT8_XPRE(vs_) do { } while (0)
#define ATT8_XHEAD() do { ATT8_RD(g0, vb, 0); ATT8_RD(g1, vb, 32 * VROWB); } while (0)
#define ATT8_XDECL() v8i g0, g1, g2
#endif
#define ATT8_X_(ks_, vs_) do { const int vb = (int)(unsigned)(size_t)(V_lds + (vs_) * SHM_V + voff), kb = (int)(unsigned)(size_t)(K_lds + (ks_) * SHM_K + koff); ATT8_XDECL(); \
        ATT8_XM(); ATT8_XHEAD(); ATT_SBAR(); \
        ATT8_RD(g2, vb, 64 * VROWB); ATT8_LW(4); ATT_SBAR(); o[0] = ATT8_MFMA(pa, g0, o[0]); ATT_SBAR(); \
        ATT8_RD(g0, vb, 96 * VROWB); ATT8_LW(4); ATT_SBAR(); o[1] = ATT8_MFMA(pa, g1, o[1]); ATT_SBAR(); \
        ATT8_RD(g1, kb, 0); ATT8_LW(4); ATT_SBAR(); o[2] = ATT8_MFMA(pa, g2, o[2]); ATT_SBAR(); \
        ATT8_RD(g2, kb, 32 * KROWB); ATT8_LW(4); ATT_SBAR(); o[3] = ATT8_MFMA(pa, g0, o[3]); ATT8_LMFMA(); ATT_SBAR(); \
        ATT8_QK6(kb, g1, g2, g0, ATT8_C0, ATT8_C1); ATT8_XM_END(); } while (0)
#define ATT8_S0() do { float pmax; ATT8_ROWMAX(pmax); m2 = pmax; \
        _Pragma("unroll") for (int r = 0; r < 16; ++r) { p0[r] = __builtin_amdgcn_exp2f(p0[r] - m2); p1[r] = __builtin_amdgcn_exp2f(p1[r] - m2); } \
        ATT8_ROWSUM(1.f); ATT8_PACK(); ATT8_INIT(); ATT8_INIT_TILE(); } while (0)
#if defined(MLA_XVALU)
#define ATT8_XV() do { _Pragma("unroll") for (int r = 0; r < MLA_XVALU; ++r) { float d_; asm volatile("v_exp_f32 %0, %1" : "=v"(d_) : "v"(p0[r & 15])); } } while (0)
#elif defined(MLA_XADD)
#define ATT8_XV() do { _Pragma("unroll") for (int r = 0; r < MLA_XADD; ++r) { float d_; asm volatile("v_add_f32 %0, %1, %1" : "=v"(d_) : "v"(p0[r & 15])); } } while (0)
#else
#define ATT8_XV() do { } while (0)
#endif
#if defined(MLA_XMFMA)
#define ATT8_XM() f32x16 dacc_ = ATT8_MFMA(qr[0], qr[1], f32x16{}); _Pragma("unroll") for (int r = 1; r < MLA_XMFMA; ++r) dacc_ = ATT8_MFMA(qr[0], qr[1], dacc_)
#define ATT8_XM_END() asm volatile("" :: "v"(dacc_))
#else
#define ATT8_XM() do { } while (0)
#define ATT8_XM_END() do { } while (0)
#endif
#define ATT8_S() do { float pmax, al = 1.f; ATT8_XV(); ATT8_ROWMAX(pmax); \
        if (__builtin_expect(!__all(pmax <= THR2), 0)) { \
            const float dl = fmaxf(pmax, 0.f); al = __builtin_amdgcn_exp2f(-dl); m2 += dl; \
            if (hi == 0) al_l[r32] = al; asm volatile("s_waitcnt lgkmcnt(0)" ::: "memory"); \
            _Pragma("unroll") for (int d = 0; d < 4; ++d) _Pragma("unroll") for (int r = 0; r < 16; ++r) o[d][r] *= al_l[crow(r, hi)]; ATT8_LRESC(); \
            _Pragma("unroll") for (int r = 0; r < 16; ++r) { p0[r] -= dl; p1[r] -= dl; } ATT8_INIT_SLOW(); } \
        _Pragma("unroll") for (int r = 0; r < 16; ++r) { p0[r] = __builtin_amdgcn_exp2f(p0[r]); p1[r] = __builtin_amdgcn_exp2f(p1[r]); } \
        ATT8_ROWSUM(al); ATT8_PACK(); ATT8_INIT_TILE(); } while (0)
#define ATT8_ROT() do { const int t_ = s0; s0 = s1; s1 = s2; s2 = t_; } while (0)
#if defined(PROBE_TIMING)
    const unsigned long long tstart8 = __builtin_amdgcn_s_memtime(), rstart8 = __builtin_amdgcn_s_memrealtime(); __builtin_amdgcn_s_waitcnt(0xC07F);
#endif
#if MLA_2T
#define ATT8_ISSUE2(i_) do { const int t_ = 2 * (i_); if (t_ + 2 < NT) { ATT8_DMAK(t_ + 2, (t_ + 2) & 3); ATT8_DMAK(t_ + 3, (t_ + 3) & 3); ATT8_DMAV(t_ + 2, (t_ + 2) & 3); } ATT8_DMAV(t_ + 1, (t_ + 1) & 3); } while (0)
    if (!grpB) {
        { ATT8_ISSUE2(0); ATT_SBAR(); ATT8_X0_(0); ATT_SBAR(); ATT8_S0(); ATT_SBAR(); }
#pragma unroll 1
        for (int j = 1; j < NT; ++j) { if (!(j & 1)) ATT8_ISSUE2(j >> 1); ATT_SBAR(); ATT8_X_(j & 3, (j - 1) & 3); ATT_SBAR(); ATT8_S(); ATT_SBAR(); if (j & 1) { ATT8_VMW(); ATT8_BAR(); } }
    } else {
        { ATT8_ISSUE2(0); ATT_SBAR(); ATT8_X0_(0); ATT_SBAR(); ATT8_S0(); ATT_SBAR(); ATT8_X_(1, 0); ATT_SBAR(); ATT8_VMW(); ATT8_BAR(); }
#pragma unroll 1
        for (int j = 2; j < NT; ++j) { if (!(j & 1)) ATT8_ISSUE2(j >> 1); ATT_SBAR(); ATT8_S(); ATT_SBAR(); ATT8_X_(j & 3, (j - 1) & 3); ATT_SBAR(); if (j & 1) { ATT8_VMW(); ATT8_BAR(); } }
        ATT8_S();
    }
    s2 = (NT - 1) & 3;
#undef ATT8_ISSUE2
#else
    if (!grpB) {
        { const int j = 0; ATT8_ISSUE(); ATT_SBAR(); ATT8_X0(); ATT_SBAR(); ATT8_S0(); ATT_SBAR(); ATT8_XPRE(s0); ATT8_VMW(); ATT8_BAR(); ATT8_ROT(); }
#pragma unroll 1
        for (int j = 1; j < NT; ++j) { ATT8_ISSUE(); ATT_SBAR(); ATT8_X(); ATT_SBAR(); ATT8_S(); ATT_SBAR(); if (j + 1 < NT) ATT8_XPRE(s0); ATT8_VMW(); ATT8_BAR(); ATT8_ROT(); }
    } else {
        { const int j = 0; ATT8_ISSUE(); ATT_SBAR(); ATT8_X0(); ATT_SBAR(); ATT8_VMW(); ATT8_BAR(); ATT8_ROT(); }
        { const int j = 1; ATT8_ISSUE(); ATT8_XPRE(s2); ATT_SBAR(); ATT8_S0(); ATT_SBAR(); ATT8_X(); ATT_SBAR(); ATT8_VMW(); ATT8_BAR(); ATT8_ROT(); }
#pragma unroll 1
        for (int j = 2; j < NT; ++j) { ATT8_ISSUE(); ATT8_XPRE(s2); ATT_SBAR(); ATT8_S(); ATT_SBAR(); ATT8_X(); ATT_SBAR(); ATT8_VMW(); ATT8_BAR(); ATT8_ROT(); }
        ATT8_S();
    }
#endif
#if defined(PROBE_TIMING)
    if (a.dbg && tid == PROBE_TID) { const unsigned long long tend = __builtin_amdgcn_s_memtime(), rend = __builtin_amdgcn_s_memrealtime();
        *a.dbg = PROBE_TIMING == 4 ? __builtin_floorf(((float)(tend - tstart8) / (float)(rend - rstart8) + PROBE_QOFF) * 0.25f) * 4e-2f
                                   : __builtin_rintf((float)(tend - tstart8) / (float)NT * (1.f / 256.f)) * 256e-4f; }
#endif
    { const LAS char* vb = V_lds + s2 * SHM_V + voff;
      o[0] = ATT8_MFMA(pa, ld32(vb), o[0]); o[1] = ATT8_MFMA(pa, ld32(vb + 32 * VROWB), o[1]); o[2] = ATT8_MFMA(pa, ld32(vb + 64 * VROWB), o[2]); o[3] = ATT8_MFMA(pa, ld32(vb + 96 * VROWB), o[3]); ATT8_LMFMA(); }
    ATT8_BAR();
#if !MLA_LSUM
    if (hi == 0) li_l[r32] = l_reg; asm volatile("s_waitcnt lgkmcnt(0)" ::: "memory");
#endif
    { LAS char* ot = lds + wid * 8448;
#pragma unroll
      for (int r = 0; r < 16; ++r) { const int orow = crow(r, hi);
#if MLA_LSUM
          const float rl = __builtin_amdgcn_rcpf(lacc[r]);
#else
          const float rl = __builtin_amdgcn_rcpf(li_l[orow]);
#endif
#pragma unroll
          for (int d0 = 0; d0 < 4; ++d0) { const float v = o[d0][r] * rl; *(LAS bf16_t*)(ot + orow * 264 + (d0 * 32 + r32) * 2) = (bf16_t)(cvt_pk_bf16(v, v) & 0xffffu); } }
      asm volatile("s_waitcnt lgkmcnt(0)" ::: "memory");
      char* Ow = (char*)(a.O + (size_t)(wid * 32) * a.os);
      const int orow0 = lane >> 4, ocol = (lane & 15) * 16;
#pragma unroll
      for (int i = 0; i < 8; ++i) { const int orow = orow0 + 4 * i; const u32x2 w0 = *(const LAS u32x2*)(ot + orow * 264 + ocol), w1 = *(const LAS u32x2*)(ot + orow * 264 + ocol + 8);
          u32x4 w; w.x = w0.x; w.y = w0.y; w.z = w1.x; w.w = w1.y;
          *(u32x4*)(Ow + (size_t)orow * a.os * 2 + ocol) = w; } }
    __syncthreads();
#undef ATT8_DMAK
#undef ATT8_DMAV
#undef ATT8_VMW
#undef ATT8_BAR
#undef ATT8_RD
#undef ATT8_LW
#undef ATT8_ISSUE
#undef ATT8_QK6
#undef ATT8_PACK
#undef ATT8_ROWMAX
#undef ATT8_ROT
#undef ATT8_S
#undef ATT8_S0
#undef ATT8_X
#undef ATT8_X0
#undef ATT8_XPRE
#undef ATT8_XHEAD
#undef ATT8_XDECL
#undef ATT8_X0_
#undef ATT8_X_
#undef ATT8_ROWSUM
#undef ATT8_LMFMA
#undef ATT8_LRESC
#undef ATT8_SUM32
#undef ATT8_INIT_SLOW
#undef ATT8_INIT_TILE
#undef ATT8_C0
#undef ATT8_C1
#undef ATT8_PAIR
#undef ATT8_PK4
#undef ATT8_INIT
}
}
#if defined(MK_CHECK) && MK_CHECK
#ifndef CHK_XOR_ROW
#define CHK_XOR_ROW 0
#endif
namespace chk {
__device__ __forceinline__ float f8(const void* base, size_t idx) { return __builtin_amdgcn_cvt_f32_fp8((int)((const unsigned char*)base)[idx], 0); }
__device__ __forceinline__ float ldQK(const bf16_t* B, int hd, int t, int w) {
    return MLA_FP8 ? f8(B, ((size_t)hd * SEQ + t) * 192 + w) : bf2f(B[((size_t)hd * SEQ + t) * 192 + w]); }
__device__ __forceinline__ float ldV(const bf16_t* B, int hd, int t, int c) {
    if (!MLA_FP8) return bf2f(B[((size_t)hd * SEQ + t) * 128 + c]);
    const int k = t & 63, half = k >> 5, kp = k & 31, kg = (kp >> 2) & 1, r = (kp & 3) + 4 * (kp >> 3), e = r + 16 * half;
    return f8(B, (((size_t)hd * (SEQ / 64) + (t >> 6)) * 128 + c) * 64 + 32 * kg + e); }

__device__ __forceinline__ unsigned hash32(unsigned x) { x ^= x >> 16; x *= 0x7feb352du; x ^= x >> 15; x *= 0x846ca68bu; x ^= x >> 16; return x; }
__device__ __forceinline__ void flag(unsigned* ctl, int bit) { atomicOr(ctl + CW_DBG, 1u << bit); }
__device__ __forceinline__ bool bad_l2(float err2, float ref2, float tol) { err2 = wave_sum(err2); ref2 = wave_sum(ref2); return !(err2 <= tol * tol * ref2 + 1e-12f); }
__device__ __forceinline__ void ref_cos_sin(int pos, int j, float& c, float& s) {
    const float inv = powf(10000.0f, -(float)(2 * j) / 64.0f); const float ang = (float)pos * inv;
    c = (float)cos((double)ang); s = (float)sin((double)ang);
}
__device__ __forceinline__ int ref_bucket(int rel) {
    int ret = rel > 0 ? 16 : 0; int n = rel < 0 ? -rel : rel; float nf = (float)(n < 1 ? 1 : n);
    float v = logf(nf / 8.0f) / 4.852030263919617f * 8.0f; int large = 8 + (int)v; if (large > 15) large = 15;
    return ret + (n < 8 ? n : large);
}
__device__ __forceinline__ void check_proj(const Frame& F, int b, unsigned* ctl, const bf16_t* P, const bf16_t* CQN, const bf16_t* CKVN, const bf16_t* QB, const bf16_t* KB, const bf16_t* VB,
                                           const float* gq, const float* gkv, const float* w_uq, const float* w_ukv, const int* positions) {
    const int lane = opaque_tid(F.wave) & 63;
    for (int smp = F.gw; smp < 4096; smp += F.NGW) {
        const unsigned hsh = hash32(smp * 2654435761u + b * 97u + 12345u);
        const int t = hsh % SEQ, hd = (hsh >> 13) & 7, kind = smp & 3;
        const bf16_t* pr = (const bf16_t*)((const char*)P + (size_t)t * PROW);
        if (kind == 0) {
            float ss = 0.f; for (int k = lane; k < 384; k += 64) { const float v = bf2f(pr[C_CQ + k]); ss += v * v; }
            const float rq = 1.0f / sqrtf(wave_sum(ss) / 384.f + NORM_EPS); float e2 = 0.f, r2 = 0.f;
            for (int k = lane; k < 384; k += 64) { const float ref = bf2f(pr[C_CQ + k]) * rq * gq[k], got = bf2f(CQN[(size_t)t * 384 + k]); e2 += (ref - got) * (ref - got); r2 += ref * ref; }
            if (bad_l2(e2, r2, 0.01f)) flag(ctl, 0);
            ss = 0.f; for (int k = lane; k < 256; k += 64) { const float v = bf2f(pr[C_CKV + k]); ss += v * v; }
            const float rk = 1.0f / sqrtf(wave_sum(ss) / 256.f + NORM_EPS); e2 = 0.f; r2 = 0.f;
            for (int k = lane; k < 256; k += 64) { const float ref = bf2f(pr[C_CKV + k]) * rk * gkv[k], got = bf2f(CKVN[(size_t)t * 256 + k]); e2 += (ref - got) * (ref - got); r2 += ref * ref; }
            if (bad_l2(e2, r2, 0.01f)) flag(ctl, 0);
        } else if (kind == 1) {
            float q[3] = {0.f, 0.f, 0.f};
            for (int k = 0; k < 384; ++k) { const float a = bf2f(CQN[(size_t)t * 384 + k]);
#pragma unroll
                for (int i = 0; i < 3; ++i) q[i] += a * w_uq[(size_t)k * 1536 + hd * 192 + lane + 64 * i]; }
            if (MLA_FP8) { q[0] *= QK_LOG2_SCALE; q[1] *= QK_LOG2_SCALE; q[2] *= QK_LOG2_SCALE; }
            float e2 = 0.f, r2 = 0.f;
#pragma unroll
            for (int i = 0; i < 2; ++i) { const float got = ldQK(QB, hd, t, lane + 64 * i); e2 += (q[i] - got) * (q[i] - got); r2 += q[i] * q[i]; }
            float other; { auto rr = __builtin_amdgcn_permlane32_swap(__float_as_uint(q[2]), __float_as_uint(q[2]), false, false); other = lane < 32 ? __uint_as_float(rr[1]) : __uint_as_float(rr[0]); } float c, s; ref_cos_sin(positions[(size_t)b * SEQ + t], lane & 31, c, s);
            const float x1 = lane < 32 ? q[2] : other, x2 = lane < 32 ? other : q[2];
            const float ref = lane < 32 ? x1 * c - x2 * s : x1 * s + x2 * c;
            const float got = ldQK(QB, hd, t, 128 + 2 * (lane & 31) + (lane >> 5)); e2 += (ref - got) * (ref - got); r2 += ref * ref;
            if (bad_l2(e2, r2, MLA_FP8 ? 0.06f : 0.015f)) flag(ctl, 1);
        } else if (kind == 2) {
            float kk[2] = {0.f, 0.f};
            for (int k = 0; k < 256; ++k) { const float a = bf2f(CKVN[(size_t)t * 256 + k]); kk[0] += a * w_ukv[(size_t)k * 2048 + hd * 256 + lane]; kk[1] += a * w_ukv[(size_t)k * 2048 + hd * 256 + 64 + lane]; }
            float e2 = 0.f, r2 = 0.f;
#pragma unroll
            for (int i = 0; i < 2; ++i) { const float got = ldQK(KB, hd, t, lane + 64 * i); e2 += (kk[i] - got) * (kk[i] - got); r2 += kk[i] * kk[i]; }
            float c, s; ref_cos_sin(positions[(size_t)b * SEQ + t], lane & 31, c, s);
            const float x1 = bf2f(pr[C_KPE + (lane & 31)]), x2 = bf2f(pr[C_KPE + 32 + (lane & 31)]);
            const float ref = lane < 32 ? x1 * c - x2 * s : x1 * s + x2 * c;
            const float got = ldQK(KB, hd, t, 128 + 2 * (lane & 31) + (lane >> 5)); e2 += (ref - got) * (ref - got); r2 += ref * ref;
            if (bad_l2(e2, r2, MLA_FP8 ? 0.06f : 0.015f)) flag(ctl, 2);
        } else {
            float vv[2] = {0.f, 0.f};
            for (int k = 0; k < 256; ++k) { const float a = bf2f(CKVN[(size_t)t * 256 + k]); vv[0] += a * w_ukv[(size_t)k * 2048 + hd * 256 + 128 + lane]; vv[1] += a * w_ukv[(size_t)k * 2048 + hd * 256 + 192 + lane]; }
            float e2 = 0.f, r2 = 0.f;
#pragma unroll
            for (int i = 0; i < 2; ++i) { const float got = ldV(VB, hd, t, lane + 64 * i); e2 += (vv[i] - got) * (vv[i] - got); r2 += vv[i] * vv[i]; }
            if (bad_l2(e2, r2, MLA_FP8 ? 0.06f : 0.015f)) flag(ctl, 3);
        }
    }
}
__device__ __forceinline__ void check_mla(const Frame& F, int b, unsigned* ctl, const bf16_t* QB, const bf16_t* KB, const bf16_t* VB, const bf16_t* OA) {
    const int tid = opaque_tid(F.wave), lane = tid & 63, wave = tid >> 6;
    LAS float* qf = (LAS float*)F.lds;
    LAS float* red = qf + 192;
    LAS float* pp = red + 64;
    LAS float* oacc = pp + SEQ;
    const unsigned hsh = hash32(blockIdx.x * 40503u + b * 977u + 777u);
    const int t = hsh % SEQ, hd = (hsh >> 13) & 7;
#if defined(FORCE_FLAG)
    if (blockIdx.x == 100 && tid == 5 && b == 2) flag(ctl, FORCE_FLAG);
#endif
    __syncthreads();
    if (tid < 192) qf[tid] = ldQK(QB, hd, t, tid);
    __syncthreads();
    float mx = -1e30f;
    for (int k = tid; k < SEQ; k += 512) { float s = 0.f;
        for (int d = 0; d < 192; ++d) s += qf[d] * ldQK(KB, hd, k, d);
        s *= MLA_FP8 ? 0.6931471805599453f : 0.07216878364870322f; pp[k] = s; mx = fmaxf(mx, s); }
    mx = wave_max(mx);
    if (lane == 0) red[wave] = mx;
    __syncthreads();
    mx = red[0]; for (int w = 1; w < 8; ++w) mx = fmaxf(mx, red[w]);
    __syncthreads();
    float sm = 0.f;
    for (int k = tid; k < SEQ; k += 512) { const float p = expf(pp[k] - mx); pp[k] = p; sm += p; }
    sm = wave_sum(sm); if (lane == 0) red[wave] = sm;
    __syncthreads();
    sm = 0.f; for (int w = 0; w < 8; ++w) sm += red[w];
    const int c = tid & 127, part = tid >> 7; float acc = 0.f;
    for (int k = part * 2048; k < part * 2048 + 2048; ++k) acc += pp[k] * ldV(VB, hd, k, c);
    oacc[part * 128 + c] = acc;
    __syncthreads();
    if (tid < 64) { float e2 = 0.f, r2 = 0.f;
#pragma unroll
        for (int i = 0; i < 2; ++i) { const int cc = tid + 64 * i; const float ref = (oacc[cc] + oacc[128 + cc] + oacc[256 + cc] + oacc[384 + cc]) / sm, got = bf2f(OA[(size_t)(t ^ CHK_XOR_ROW) * DM + hd * 128 + cc]);
            e2 += (ref - got) * (ref - got); r2 += ref * ref; }
#if defined(CHK_MEASURE) && CHK_MEASURE == 4
        { const float re = sqrtf(wave_sum(e2) / wave_sum(r2)); int k = (int)floorf(-log2f(re)); k = k < 0 ? 0 : (k > 15 ? 15 : k); flag(ctl, k); }
#else
        if (bad_l2(e2, r2, 0.03f)) flag(ctl, 4);
#endif
    }
    __syncthreads();
}
__device__ __forceinline__ void check_dil(const Frame& F, int b, unsigned* ctl, const bf16_t* P, const int* positions, const float* rel_bias, const bf16_t* OG, const float* LSE) {
    const int tid = opaque_tid(F.wave), lane = tid & 63, wave = tid >> 6;
    LAS float* pw = (LAS float*)F.lds + wave * 256;
    for (int smp = F.gw; smp < 4096; smp += F.NGW) {
        const unsigned hsh = hash32(smp * 2246822519u + b * 131u + 999u);
        int t = hsh % SEQ; const int hd = (hsh >> 13) & 7, grp = (hsh >> 16) % 3, d = grp == 0 ? 1 : (grp == 1 ? 4 : 16);
        if ((smp & 7) == 0) t = (smp >> 3) % 40;
        if ((smp & 7) == 1) t = SEQ - 1 - ((smp >> 3) % 40);
        const char* gb = (const char*)P + P_OFF_DIL + grp * P_GRP;
#define CHK_QK(tok_, part_, e_) (DIL_FP8 ? f8(gb + (size_t)(tok_) * PROW + (part_) * 1024 + hd * 128, (e_)) : bf2f(((const bf16_t*)(gb + (size_t)(tok_) * PROW + (part_) * 2048 + hd * 256))[e_]))
        const int pq = positions[(size_t)b * SEQ + t];
        float sc[3]; float mx = -1e30f;
#pragma unroll
        for (int i = 0; i < 3; ++i) { const int j = lane + 64 * i - 64, tk = t + j * d; sc[i] = -1e30f;
            if (j <= 64 && tk >= 0 && tk < SEQ) { float s = 0.f;
                for (int e = 0; e < 128; ++e) s += CHK_QK(t, 0, e) * CHK_QK(tk, 1, e);
                s = s * 0.08838834764831845f + rel_bias[ref_bucket(positions[(size_t)b * SEQ + tk] - pq) * 24 + grp * 8 + hd]; sc[i] = s; }
            mx = fmaxf(mx, sc[i]); }
        mx = wave_max(mx);
        float sm = 0.f;
#pragma unroll
        for (int i = 0; i < 3; ++i) { const int j = lane + 64 * i; const float p = sc[i] > -1e29f ? expf(sc[i] - mx) : 0.f; if (j < 129) pw[j] = p; sm += p; }
        sm = wave_sum(sm);
        LDS_WAIT();
        float o0 = 0.f, o1 = 0.f;
        for (int j = 0; j < 129; ++j) { const int tk = t + (j - 64) * d; if (tk < 0 || tk >= SEQ) continue; const float p = pw[j]; const bf16_t* vr = (const bf16_t*)(gb + (size_t)tk * PROW + 2048 * P_QK_ESZ + hd * 256);
            o0 += p * bf2f(vr[lane]); o1 += p * bf2f(vr[64 + lane]); }
        o0 /= sm; o1 /= sm;
        const float g0 = bf2f(OG[((size_t)grp * SEQ + t) * DM + hd * 128 + lane]), g1 = bf2f(OG[((size_t)grp * SEQ + t) * DM + hd * 128 + 64 + lane]);
        if (bad_l2((o0 - g0) * (o0 - g0) + (o1 - g1) * (o1 - g1), o0 * o0 + o1 * o1, 0.03f)) flag(ctl, 5);
        const float lse2 = (mx + logf(sm)) * LOG2E, got = LSE[((size_t)grp * SEQ + t) * 8 + hd];
        if (!(fabsf(lse2 - got) <= 0.05f)) flag(ctl, 6);
        LDS_WAIT();
    }
}
__device__ __forceinline__ void check_u(const Frame& F, int b, unsigned* ctl, const bf16_t* P, const bf16_t* OA, const bf16_t* OG, const float* LSE, const bf16_t* Ub) {
    const int lane = opaque_tid(F.wave) & 63;
    for (int smp = F.gw; smp < 2048; smp += F.NGW) {
        const int t = hash32(smp * 374761393u + b * 31u + 5u) % SEQ; float e2 = 0.f, r2 = 0.f;
        for (int c = lane; c < DM; c += 64) { const int hd = c >> 7;
            const float l0 = LSE[((size_t)0 * SEQ + t) * 8 + hd], l1 = LSE[((size_t)1 * SEQ + t) * 8 + hd], l2 = LSE[((size_t)2 * SEQ + t) * 8 + hd], mx = fmaxf(l0, fmaxf(l1, l2));
            const float w0 = exp2f(l0 - mx), w1 = exp2f(l1 - mx), w2 = exp2f(l2 - mx), ws_ = w0 + w1 + w2;
            const float ob = (w0 * bf2f(OG[((size_t)0 * SEQ + t) * DM + c]) + w1 * bf2f(OG[((size_t)1 * SEQ + t) * DM + c]) + w2 * bf2f(OG[((size_t)2 * SEQ + t) * DM + c])) / ws_;
            const bf16_t* gr = (const bf16_t*)((const char*)P + (size_t)t * PROW + P_OFF_GATE); const float ga = 1.f / (1.f + expf(-bf2f(gr[c]))), gb = 1.f / (1.f + expf(-bf2f(gr[1024 + c])));
            const float ref = ga * bf2f(OA[(size_t)t * DM + c]) + gb * ob, got = bf2f(Ub[(size_t)t * DM + c]); e2 += (ref - got) * (ref - got); r2 += ref * ref; }
        if (bad_l2(e2, r2, 0.01f)) flag(ctl, 7);
    }
}
}
#endif
template <bool F8, class F>
__device__ __forceinline__ void transpose_item(F colptr, int ldn, void* WT, int ldk, int k0, int n0, LAS float* scr, int lane) {
    const float* cp = colptr(n0 + (lane & 31));
    float tv[32];
    const float* cpk = cp ? cp + (size_t)(k0 + (lane >> 5)) * ldn : nullptr;
#pragma unroll
    for (int i = 0; i < 32; ++i) tv[i] = cpk ? cpk[(size_t)(2 * i) * ldn] : 0.f;
#pragma unroll
    for (int i = 0; i < 32; ++i) scr[(2 * i + (lane >> 5)) * 33 + (lane & 31)] = tv[i];
    LDS_WAIT(); asm volatile("" ::: "memory");
    const int c = lane & 7;
#pragma unroll
    for (int j = 0; j < 4; ++j) { const int n = (lane >> 3) + 8 * j; const LAS float* s = scr + (8 * c) * 33 + n;
        if constexpr (F8) { u32x2 o; o.x = pk4_fp8(s[0 * 33] * W8_SCALE, s[1 * 33] * W8_SCALE, s[2 * 33] * W8_SCALE, s[3 * 33] * W8_SCALE); o.y = pk4_fp8(s[4 * 33] * W8_SCALE, s[5 * 33] * W8_SCALE, s[6 * 33] * W8_SCALE, s[7 * 33] * W8_SCALE);
            *(u32x2*)((char*)WT + (size_t)(n0 + n) * ldk + k0 + 8 * c) = o; }
        else { u32x4 o; o.x = cvt_pk_bf16(s[0 * 33], s[1 * 33]); o.y = cvt_pk_bf16(s[2 * 33], s[3 * 33]); o.z = cvt_pk_bf16(s[4 * 33], s[5 * 33]); o.w = cvt_pk_bf16(s[6 * 33], s[7 * 33]);
            *(u32x4*)((bf16_t*)WT + (size_t)(n0 + n) * ldk + k0 + 8 * c) = o; } }
    LDS_WAIT(); asm volatile("" ::: "memory");
}

__device__ __forceinline__ void p0_mod(const Frame& F, const float* c, const float* w_ada, const float* b_ada, float* mod) {
    const int tid = opaque_tid(F.wave), lane = tid & 63; (void)tid; (void)lane;
    LAS float* red = (LAS float*)F.lds;
    LAS float* sl = (LAS float*)(F.lds + 8192);
    if ((int)blockIdx.x < 96) {
        for (int i = tid; i < 4096; i += 512) { const float cv = c[i]; sl[i] = cv * fast_sigmoid(cv); }
        __syncthreads();
    }
    for (int blk = blockIdx.x; blk < 96; blk += F.G) {
        const int col = blk * 64 + (tid & 63), ks = tid >> 6;
        float a0 = 0.f, a1 = 0.f, a2 = 0.f, a3 = 0.f;
#pragma unroll 1
        for (int k0 = ks * 128; k0 < ks * 128 + 128; k0 += 16) { float w[16];
#pragma unroll
            for (int i = 0; i < 16; ++i) w[i] = w_ada[(size_t)(k0 + i) * 6144 + col];
#pragma unroll
            for (int i = 0; i < 16; ++i) { const int k = k0 + i; a0 += sl[k] * w[i]; a1 += sl[1024 + k] * w[i]; a2 += sl[2048 + k] * w[i]; a3 += sl[3072 + k] * w[i]; } }
        red[(ks * 4 + 0) * 64 + (tid & 63)] = a0; red[(ks * 4 + 1) * 64 + (tid & 63)] = a1; red[(ks * 4 + 2) * 64 + (tid & 63)] = a2; red[(ks * 4 + 3) * 64 + (tid & 63)] = a3;
        __syncthreads();
        if (tid < 256) { const int b = tid >> 6, cc = tid & 63; float s = 0.f;
#pragma unroll
            for (int q = 0; q < 8; ++q) s += red[(q * 4 + b) * 64 + cc];
            mod[b * 6144 + blk * 64 + cc] = s + b_ada[blk * 64 + cc]; }
        __syncthreads();
    }
}
__device__ __forceinline__ void p0_cs(const Frame& F, const int* pos, float* cs) {
    const int tid = opaque_tid(F.wave), lane = tid & 63; (void)tid; (void)lane;
    for (int i = (int)blockIdx.x * 512 + tid; i < NTOK * 32; i += F.G * 512) {
        const int t = i >> 5, j = i & 31;
        const float inv = __builtin_amdgcn_exp2f(-(float)(2 * j) / 64.f * 13.287712379549449f);
        const float ang = (float)pos[t] * inv;
        const double rev = (double)ang * 0.15915494309189535; const double fr = rev - __builtin_rint(rev);
        const float f = (float)fr;
        f32x2 o; o.x = __builtin_amdgcn_cosf(f); o.y = __builtin_amdgcn_sinf(f);
        *(f32x2*)(cs + (size_t)i * 2) = o;
    }
}
__device__ __forceinline__ void p0_lut(const Frame& F, const float* rel_bias, float* lutg) {
    const int tid = opaque_tid(F.wave);
    for (int i = (int)blockIdx.x * 512 + tid; i < 24 * 2049; i += F.G * 512) { const int l = i / 2049, u = i - l * 2049;
        lutg[l * 2304 + u + (u >> 5)] = rel_bias[att::t5_bucket(u - 1024) * 24 + l] * LOG2E; }
}
__device__ __forceinline__ void p0_weights(const Frame& F, const float* w_in, const float* w_uq, const float* w_ukv, const float* w_out, unsigned char* ws) {
    const int tid = opaque_tid(F.wave), lane = tid & 63; (void)tid; (void)lane;
    LAS float* scr = (LAS float*)(F.lds + F.wave * 16384);
    constexpr int I_IN = 16 * 376, I_UQ = 6 * 48, I_UKV = 4 * 64, I_OUT = 16 * 32;
    for (int it = F.gw; it < I_IN + I_UQ + I_UKV + I_OUT; it += F.NGW) {
        int r = it;
        if (r < I_IN) { const int kb = r / 376, nb = r % 376;
            transpose_item<(FP8_G1 != 0)>([=](int np) -> const float* { const int n = (np & ~31) + pg8::perm32(np & 31); return n < D_IN ? w_in + n : nullptr; }, D_IN, (void*)(ws + WS_WIN), 1024, kb * 64, nb * 32, scr, lane); continue; }
        r -= I_IN;
        if (r < I_UQ) { const int kb = r / 48, nb = r % 48;
            transpose_item<false>([=](int n) -> const float* { const int hd = n / 192, w = n - hd * 192; const int sc = w < 128 ? w : 128 + ((w - 128) >> 1) + 32 * ((w - 128) & 1); return w_uq + hd * 192 + sc; },
                           1536, (bf16_t*)(ws + WS_WUQ), 384, kb * 64, nb * 32, scr, lane); continue; }
        r -= I_UQ;
        if (r < I_UKV) { const int kb = r / 64, nb = r % 64;
            transpose_item<false>([=](int n) -> const float* { const int m = n & 1023; return w_ukv + (MLA_FP8 ? ((m >> 7) * 256 + (n >> 10) * 128 + (m & 127)) : n); }, 2048, (bf16_t*)(ws + WS_WUKV), 256, kb * 64, nb * 32, scr, lane); continue; }
        r -= I_UKV;
        { const int kb = r / 32, nb = r % 32;
            transpose_item<(FP8_WO != 0)>([=](int n) -> const float* { return w_out + n; }, 1024, (void*)(ws + WS_WOUT), 1024, kb * 64, nb * 32, scr, lane); }
    }
}
__device__ __forceinline__ void conv_experts(const Frame& F, const float* w_gate, const float* w_up, const float* w_down, unsigned char* ws, int part) {
    static_assert(FP8_EX != 0 && FP8_WO != 0, "fp8 expert operands; WS_WD sits in the half of the U region that the fp8 u leaves free");
    const int tid = opaque_tid(F.wave), lane = tid & 63; (void)tid;
    LAS float* scr = (LAS float*)(F.lds + F.wave * 16384);
    constexpr int N_IT = NE * 1536;
    const long du = (const char*)w_up - (const char*)w_gate;
    const int lr = lane >> 4, lf = lane & 15;
#define CE_LOAD(it_, tv_) do { const int e_ = (it_) / 1536, r_ = (it_) % 1536; const float* p_; int ldn_; \
        if (r_ < 1024) { const int a_ = r_ >> 9, kb_ = (r_ >> 5) & 15, cb_ = r_ & 31; \
            p_ = (const float*)((const char*)w_gate + (a_ ? du : 0L)) + (size_t)e_ * DM * DFF + (size_t)(kb_ * 64 + lr) * DFF + cb_ * 64 + 4 * lf; ldn_ = DFF; } \
        else { const int r2_ = r_ - 1024, kb_ = r2_ >> 4, cb_ = r2_ & 15; p_ = w_down + (size_t)e_ * DFF * DM + (size_t)(kb_ * 64 + lr) * DM + cb_ * 64 + 4 * lf; ldn_ = DM; } \
        _Pragma("unroll") for (int i = 0; i < 16; ++i) tv_[i] = *(const f32x4*)(p_ + (size_t)(4 * i) * ldn_); } while (0)
#define CE_STORE(it_, tv_) do { const int e_ = (it_) / 1536, r_ = (it_) % 1536; unsigned char* wt_; int ldk_; \
        _Pragma("unroll") for (int i = 0; i < 16; ++i) { LAS float* d_ = scr + (lr + 4 * i) * 64 + ((4 * lf) ^ (4 * ((i >> 1) & 7))); d_[0 ^ lr] = tv_[i][0]; d_[1 ^ lr] = tv_[i][1]; d_[2 ^ lr] = tv_[i][2]; d_[3 ^ lr] = tv_[i][3]; } \
        LDS_WAIT(); asm volatile("" ::: "memory"); \
        const int c_ = lane & 7; int rowb_, a16_; bool dn_; \
        if (r_ < 1024) { const int a_ = r_ >> 9, kb_ = (r_ >> 5) & 15, cb_ = r_ & 31; wt_ = ws + WS_WGU + (size_t)e_ * 4096 * 1024 + kb_ * 64 + 8 * c_; ldk_ = 1024; rowb_ = 128 * cb_; a16_ = 16 * a_; dn_ = false; } \
        else { const int r2_ = r_ - 1024, kb_ = r2_ >> 4, cb_ = r2_ & 15; wt_ = ws + WS_WD + (size_t)e_ * 1024 * 2048 + kb_ * 64 + 8 * c_; ldk_ = 2048; rowb_ = 64 * cb_; a16_ = 0; dn_ = true; } \
        _Pragma("unroll") for (int j = 0; j < 8; ++j) { const int cc_ = (lane >> 3) + 8 * j; const LAS float* s_ = scr + (8 * c_) * 64; const int x0_ = cc_ ^ (4 * c_); u32x2 o_; \
            const int s5_ = cc_ & 31; \
            const int row_ = dn_ ? rowb_ + (cc_ & 32) + 16 * ((s5_ >> 2) & 1) + 4 * (s5_ >> 3) + (s5_ & 3) : rowb_ + 32 * (cc_ >> 4) + a16_ + (cc_ & 15); \
            o_.x = pk4_fp8(s_[0 * 64 + (x0_ ^ 0)] * W8_SCALE, s_[1 * 64 + (x0_ ^ 1)] * W8_SCALE, s_[2 * 64 + (x0_ ^ 2)] * W8_SCALE, s_[3 * 64 + (x0_ ^ 3)] * W8_SCALE); \
            o_.y = pk4_fp8(s_[4 * 64 + (x0_ ^ 0)] * W8_SCALE, s_[5 * 64 + (x0_ ^ 1)] * W8_SCALE, s_[6 * 64 + (x0_ ^ 2)] * W8_SCALE, s_[7 * 64 + (x0_ ^ 3)] * W8_SCALE); \
            *(u32x2*)(wt_ + (size_t)row_ * ldk_) = o_; } \
        LDS_WAIT(); asm volatile("" ::: "memory"); } while (0)
    f32x4 tva[16], tvb[16];
    const int it_end = (part + 1) * (N_IT / NB);
    int it = part * (N_IT / NB) + F.gw;
    if (it < it_end) CE_LOAD(it, tva);
#pragma unroll 1
    while (it < it_end) {
        const int it2 = it + F.NGW, it3 = it2 + F.NGW;
        if (it2 < it_end) CE_LOAD(it2, tvb);
        CE_STORE(it, tva);
        if (it2 < it_end) { if (it3 < it_end) CE_LOAD(it3, tva); CE_STORE(it2, tvb); }
        it = it3;
    }
    __syncthreads();
#undef CE_LOAD
#undef CE_STORE
}
__device__ __forceinline__ void norm_mod_row(const float* xrow, const float* g, const float* sh, const float* sc, int lane, f32x4 (&v)[4]) {
    float s = 0.f;
#pragma unroll
    for (int j = 0; j < 4; ++j) { v[j] = *(const f32x4*)(xrow + 4 * lane + 256 * j); s += (v[j][0] * v[j][0] + v[j][1] * v[j][1]) + (v[j][2] * v[j][2] + v[j][3] * v[j][3]); }
    const float rstd = 1.0f / sqrtf(wave_sum(s) * (1.f / DM) + NORM_EPS);
#pragma unroll
    for (int j = 0; j < 4; ++j) { const int c = 4 * lane + 256 * j; const f32x4 gg = *(const f32x4*)(g + c), s1 = *(const f32x4*)(sc + c), s0 = *(const f32x4*)(sh + c);
        v[j] = (v[j] * rstd * gg) * (s1 + 1.0f) + s0; }
}
__device__ __forceinline__ void store_row_bf16(bf16_t* orow, int lane, const f32x4 (&v)[4]) {
#pragma unroll
    for (int j = 0; j < 4; ++j) { u32x2 o; o.x = cvt_pk_bf16(v[j][0], v[j][1]); o.y = cvt_pk_bf16(v[j][2], v[j][3]); *(u32x2*)(orow + 4 * lane + 256 * j) = o; }
}
template <bool F8> __device__ __forceinline__ void store_row_act(void* orow, int lane, const f32x4 (&v)[4]) {
    if constexpr (F8) {
#pragma unroll
        for (int j = 0; j < 4; ++j) *(unsigned*)((char*)orow + 4 * lane + 256 * j) = pk4_fp8(v[j][0], v[j][1], v[j][2], v[j][3]);
    } else store_row_bf16((bf16_t*)orow, lane, v);
}
__device__ __forceinline__ void p1_h(const Frame& F, const float* x, const float* g, const float* mod, bf16_t* H) {
    const int tid = opaque_tid(F.wave), lane = tid & 63; (void)tid; (void)lane;
    f32x4 gg[4], vn[4], shn[4], scn[4];
    int t = F.gw;
#pragma unroll
    for (int j = 0; j < 4; ++j) { const int c = 4 * lane + 256 * j; gg[j] = *(const f32x4*)(g + c);
        if (t < NTOK) { const int b = t / SEQ; vn[j] = *(const f32x4*)(x + (size_t)t * DM + c); shn[j] = *(const f32x4*)(mod + b * 6144 + c); scn[j] = *(const f32x4*)(mod + b * 6144 + 1024 + c); } }
#pragma unroll 1
    for (; t < NTOK; t += F.NGW) { f32x4 v[4], sh[4], sc[4];
#pragma unroll
        for (int j = 0; j < 4; ++j) { v[j] = vn[j]; sh[j] = shn[j]; sc[j] = scn[j]; }
        const int tn = t + F.NGW;
        if (tn < NTOK) { const int bn = tn / SEQ;
#pragma unroll
            for (int j = 0; j < 4; ++j) { const int c = 4 * lane + 256 * j; vn[j] = *(const f32x4*)(x + (size_t)tn * DM + c); shn[j] = *(const f32x4*)(mod + bn * 6144 + c); scn[j] = *(const f32x4*)(mod + bn * 6144 + 1024 + c); } }
        float ss = 0.f;
#pragma unroll
        for (int j = 0; j < 4; ++j) ss += (v[j][0] * v[j][0] + v[j][1] * v[j][1]) + (v[j][2] * v[j][2] + v[j][3] * v[j][3]);
        const float rstd = 1.0f / sqrtf(wave_sum(ss) * (1.f / DM) + NORM_EPS);
#pragma unroll
        for (int j = 0; j < 4; ++j) v[j] = (v[j] * rstd * gg[j]) * (sc[j] + 1.0f) + sh[j];
        store_row_act<(FP8_G1 != 0)>((char*)H + (size_t)t * DM * (FP8_G1 ? 1 : 2), lane, v); }
}
__device__ __forceinline__ void lb_latent(const Frame& F, const bf16_t* P, const float* gq, const float* gkv, const float* cs, bf16_t* CQN, bf16_t* CKVN, bf16_t* KB) {
    const int tid = opaque_tid(F.wave), lane = tid & 63; (void)tid; (void)lane;
    f32x4 gq0 = {}, gq1 = {}, gk0 = {}, gk1 = {};
    if (lane < 48) { gq0 = *(const f32x4*)(gq + 8 * lane); gq1 = *(const f32x4*)(gq + 8 * lane + 4); }
    if (lane < 32) { gk0 = *(const f32x4*)(gkv + 8 * lane); gk1 = *(const f32x4*)(gkv + 8 * lane + 4); }
#pragma unroll 1
    for (int tb = F.gw; tb < SEQ; tb += 4 * F.NGW) {
        u32x4 wq[4], wk[4]; float xa[4], xb[4]; f32x2 cc[4];
#pragma unroll
        for (int i = 0; i < 4; ++i) { const int t = tb + i * F.NGW; wq[i] = (u32x4){0u, 0u, 0u, 0u}; wk[i] = wq[i]; xa[i] = 0.f; xb[i] = 0.f; cc[i] = (f32x2){0.f, 0.f};
            if (t < SEQ) { const bf16_t* pr = (const bf16_t*)((const char*)P + (size_t)t * PROW);
                if (lane < 48) wq[i] = *(const u32x4*)(pr + C_CQ + 8 * lane);
                if (lane < 32) { wk[i] = *(const u32x4*)(pr + C_CKV + 8 * lane); xa[i] = bf2f(pr[C_KPE + lane]); xb[i] = bf2f(pr[C_KPE + 32 + lane]); cc[i] = *(const f32x2*)(cs + ((size_t)t * 32 + lane) * 2); } } }
#pragma unroll
        for (int i = 0; i < 4; ++i) { const int t = tb + i * F.NGW; if (t >= SEQ) break;
            float q[8], s = 0.f;
            { const u32x4 w = wq[i]; q[0] = bflo(w.x); q[1] = bfhi(w.x); q[2] = bflo(w.y); q[3] = bfhi(w.y); q[4] = bflo(w.z); q[5] = bfhi(w.z); q[6] = bflo(w.w); q[7] = bfhi(w.w);
#pragma unroll
              for (int e = 0; e < 8; ++e) s += q[e] * q[e]; }
            const float rq = 1.0f / sqrtf(wave_sum(s) * (1.f / 384.f) + NORM_EPS);
            if (lane < 48) { u32x4 o; o.x = cvt_pk_bf16(q[0] * rq * gq0[0], q[1] * rq * gq0[1]); o.y = cvt_pk_bf16(q[2] * rq * gq0[2], q[3] * rq * gq0[3]);
                o.z = cvt_pk_bf16(q[4] * rq * gq1[0], q[5] * rq * gq1[1]); o.w = cvt_pk_bf16(q[6] * rq * gq1[2], q[7] * rq * gq1[3]);
                *(u32x4*)(CQN + (size_t)t * 384 + 8 * lane) = o; }
            float s2 = 0.f;
            { const u32x4 w = wk[i]; q[0] = bflo(w.x); q[1] = bfhi(w.x); q[2] = bflo(w.y); q[3] = bfhi(w.y); q[4] = bflo(w.z); q[5] = bfhi(w.z); q[6] = bflo(w.w); q[7] = bfhi(w.w);
#pragma unroll
              for (int e = 0; e < 8; ++e) s2 += q[e] * q[e]; }
            const float rk = 1.0f / sqrtf(wave_sum(s2) * (1.f / 256.f) + NORM_EPS);
            if (lane < 32) { u32x4 o; o.x = cvt_pk_bf16(q[0] * rk * gk0[0], q[1] * rk * gk0[1]); o.y = cvt_pk_bf16(q[2] * rk * gk0[2], q[3] * rk * gk0[3]);
                o.z = cvt_pk_bf16(q[4] * rk * gk1[0], q[5] * rk * gk1[1]); o.w = cvt_pk_bf16(q[6] * rk * gk1[2], q[7] * rk * gk1[3]);
                *(u32x4*)(CKVN + (size_t)t * 256 + 8 * lane) = o;
                const float x1 = xa[i], x2 = xb[i]; const f32x2 c = cc[i];
                if constexpr (MLA_FP8) { const unsigned short pk8 = (unsigned short)(__builtin_amdgcn_cvt_pk_fp8_f32(x1 * c.x - x2 * c.y, x1 * c.y + x2 * c.x, 0, false) & 0xffff);
#pragma unroll
                    for (int h = 0; h < 8; ++h) *(unsigned short*)((unsigned char*)KB + ((size_t)h * SEQ + t) * 192 + 128 + 2 * lane) = pk8; }
                else { const unsigned pk = cvt_pk_bf16(x1 * c.x - x2 * c.y, x1 * c.y + x2 * c.x);
#pragma unroll
                    for (int h = 0; h < 8; ++h) *(unsigned*)(KB + ((size_t)h * SEQ + t) * 192 + 128 + 2 * lane) = pk; } }
        }
    }
}
__device__ __forceinline__ void lb_combine(const Frame& F, const bf16_t* P, const bf16_t* OA, const bf16_t* OG, const float* LSE, bf16_t* U) {
    const int tid = opaque_tid(F.wave), lane = tid & 63; (void)tid; (void)lane;
#pragma unroll 2
    for (int t = F.gw; t < SEQ; t += F.NGW) {
#pragma unroll
        for (int j = 0; j < 2; ++j) { const int c0 = 8 * lane + 512 * j, hd = c0 >> 7;
            const float l0 = LSE[((size_t)0 * SEQ + t) * 8 + hd], l1 = LSE[((size_t)1 * SEQ + t) * 8 + hd], l2 = LSE[((size_t)2 * SEQ + t) * 8 + hd];
            const float mx = fmaxf(l0, fmaxf(l1, l2)); float w0 = __builtin_amdgcn_exp2f(l0 - mx), w1 = __builtin_amdgcn_exp2f(l1 - mx), w2 = __builtin_amdgcn_exp2f(l2 - mx);
            const float inv = 1.0f / (w0 + w1 + w2); w0 *= inv; w1 *= inv; w2 *= inv;
            const u32x4 oa = *(const u32x4*)(OA + (size_t)t * DM + c0), g0 = *(const u32x4*)(OG + ((size_t)0 * SEQ + t) * DM + c0), g1 = *(const u32x4*)(OG + ((size_t)1 * SEQ + t) * DM + c0),
                        g2 = *(const u32x4*)(OG + ((size_t)2 * SEQ + t) * DM + c0), ga = *(const u32x4*)((const char*)P + (size_t)t * PROW + P_OFF_GATE + 2 * c0), gb = *(const u32x4*)((const char*)P + (size_t)t * PROW + P_OFF_GATE + 2048 + 2 * c0);
            u32x4 o; float uf[8];
#pragma unroll
            for (int e = 0; e < 4; ++e) {
                const float ob_lo = w0 * bflo(g0[e]) + w1 * bflo(g1[e]) + w2 * bflo(g2[e]), ob_hi = w0 * bfhi(g0[e]) + w1 * bfhi(g1[e]) + w2 * bfhi(g2[e]);
                const float u_lo = fast_sigmoid(bflo(ga[e])) * bflo(oa[e]) + fast_sigmoid(bflo(gb[e])) * ob_lo;
                const float u_hi = fast_sigmoid(bfhi(ga[e])) * bfhi(oa[e]) + fast_sigmoid(bfhi(gb[e])) * ob_hi;
                if constexpr (FP8_WO) { uf[2 * e] = u_lo * U8_SCALE; uf[2 * e + 1] = u_hi * U8_SCALE; } else o[e] = cvt_pk_bf16(u_lo, u_hi); }
            if constexpr (FP8_WO) { u32x2 o8; o8.x = pk4_fp8(uf[0], uf[1], uf[2], uf[3]); o8.y = pk4_fp8(uf[4], uf[5], uf[6], uf[7]); *(u32x2*)((unsigned char*)U + (size_t)t * DM + c0) = o8; }
            else *(u32x4*)(U + (size_t)t * DM + c0) = o; }
    }
}
__device__ __forceinline__ void pg_h2_router(const Frame& F, const float* x1, const float* g, const float* mod, const float* w_router, bf16_t* H2, float* AFFT) {
    const int tid = opaque_tid(F.wave), lane = tid & 63; (void)tid;
    LAS float* wr = (LAS float*)F.lds;
    LAS float* ab = (LAS float*)(F.lds + 65536) + F.wave * 256;
    for (int i = tid; i < 1024 * 16 / 4; i += 512) { const int c = i >> 2, k = i & 3, rho = (c & 3) * 256 + (c >> 2);
        ((LAS f32x4*)wr)[rho * 4 + ((k + (rho >> 2)) & 3)] = ((const f32x4*)w_router)[i]; }
    __syncthreads();
    int roff[4];
#pragma unroll
    for (int k = 0; k < 4; ++k) roff[k] = ((k + (lane >> 2)) & 3) * 4;
    const bool b4 = (lane >> 4) & 1, b3 = (lane >> 3) & 1, b2 = (lane >> 2) & 1; const int el = 8 * (lane >> 5) + 4 * ((lane >> 4) & 1) + 2 * ((lane >> 3) & 1) + ((lane >> 2) & 1);
    for (int ch = F.gw; ch < NTOK / 16; ch += F.NGW) {
        const int t0 = ch * 16, b = t0 / SEQ, s0 = t0 % SEQ;
        f32x4 vn[4], gg[4], sc1[4], sh0[4];
#pragma unroll
        for (int j = 0; j < 4; ++j) { const int c = 4 * lane + 256 * j; vn[j] = *(const f32x4*)(x1 + (size_t)t0 * DM + c);
            gg[j] = *(const f32x4*)(g + c); sh0[j] = *(const f32x4*)(mod + b * 6144 + 3072 + c); sc1[j] = *(const f32x4*)(mod + b * 6144 + 4096 + c); }
#pragma unroll 1
        for (int ti = 0; ti < 16; ++ti) { const int t = t0 + ti; f32x4 v[4];
#pragma unroll
            for (int j = 0; j < 4; ++j) v[j] = vn[j];
            if (ti + 1 < 16) {
#pragma unroll
                for (int j = 0; j < 4; ++j) vn[j] = *(const f32x4*)(x1 + (size_t)(t + 1) * DM + 4 * lane + 256 * j); }
            { float ss = 0.f;
#pragma unroll
              for (int j = 0; j < 4; ++j) ss += (v[j][0] * v[j][0] + v[j][1] * v[j][1]) + (v[j][2] * v[j][2] + v[j][3] * v[j][3]);
              const float rstd = 1.0f / sqrtf(wave_sum(ss) * (1.f / DM) + NORM_EPS);
#pragma unroll
              for (int j = 0; j < 4; ++j) v[j] = (v[j] * rstd * gg[j]) * (sc1[j] + 1.0f) + sh0[j]; }
            store_row_act<(FP8_EX != 0)>((char*)H2 + (size_t)t * DM * (FP8_EX ? 1 : 2), lane, v);
            float lg[16];
#pragma unroll
            for (int e = 0; e < 16; ++e) lg[e] = 0.f;
#pragma unroll
            for (int j = 0; j < 4; ++j)
#pragma unroll
                for (int q = 0; q < 4; ++q) { const LAS float* wp = wr + (q * 256 + lane + 64 * j) * 16; const float hv = v[j][q];
#pragma unroll
                    for (int e4 = 0; e4 < 4; ++e4) { const f32x4 w = *(const LAS f32x4*)(wp + roff[e4]); lg[4 * e4 + 0] += hv * w[0]; lg[4 * e4 + 1] += hv * w[1]; lg[4 * e4 + 2] += hv * w[2]; lg[4 * e4 + 3] += hv * w[3]; } }
            float s8[8], s4[4], s2[2], s1;
#pragma unroll
            for (int e = 0; e < 8; ++e) { auto rr = __builtin_amdgcn_permlane32_swap(__float_as_uint(lg[e]), __float_as_uint(lg[e + 8]), false, false); s8[e] = __uint_as_float(rr[0]) + __uint_as_float(rr[1]); }
#pragma unroll
            for (int i = 0; i < 4; ++i) { const float keep = b4 ? s8[i + 4] : s8[i], send = b4 ? s8[i] : s8[i + 4]; s4[i] = keep + __int_as_float(__builtin_amdgcn_ds_swizzle(__float_as_int(send), SWZ_XOR(16))); }
#pragma unroll
            for (int i = 0; i < 2; ++i) { const float keep = b3 ? s4[i + 2] : s4[i], send = b3 ? s4[i] : s4[i + 2]; s2[i] = keep + __int_as_float(__builtin_amdgcn_ds_swizzle(__float_as_int(send), SWZ_XOR(8))); }
            { const float keep = b2 ? s2[1] : s2[0], send = b2 ? s2[0] : s2[1]; s1 = keep + __int_as_float(__builtin_amdgcn_ds_swizzle(__float_as_int(send), SWZ_XOR(4))); }
            s1 += __int_as_float(__builtin_amdgcn_ds_swizzle(__float_as_int(s1), SWZ_XOR(2)));
            s1 += __int_as_float(__builtin_amdgcn_ds_swizzle(__float_as_int(s1), SWZ_XOR(1)));
            const float mx = wave_max(s1), ex = __expf(s1 - mx), sum = wave_sum(ex) * 0.25f;
            if ((lane & 3) == 0) ab[el * 16 + ti] = ex * (1.0f / sum);
        }
        LDS_WAIT();
        { const int e = lane >> 2, q4 = (lane & 3) * 4; const f32x4 w = *(const LAS f32x4*)(ab + e * 16 + q4);
          *(f32x4*)(AFFT + ((size_t)b * NE + e) * SEQ + s0 + q4) = w; }
        LDS_WAIT();
    }
    __syncthreads();
}
__device__ __forceinline__ void ph_topk(const Frame& F, const float* AFFT, int* TOPI, float* TOPG, int* SLOT) {
    const int tid = opaque_tid(F.wave), lane = tid & 63;
    LAS unsigned* cnt = (LAS unsigned*)F.lds;
    LAS unsigned* wtot = cnt + 64;
    for (int p = blockIdx.x; p < NB * NE; p += F.G) {
        const float* src = AFFT + (size_t)p * SEQ + 16 * tid;
        unsigned key[16];
#pragma unroll
        for (int j = 0; j < 4; ++j) { const u32x4 w = *(const u32x4*)(src + 4 * j); key[4 * j] = w.x; key[4 * j + 1] = w.y; key[4 * j + 2] = w.z; key[4 * j + 3] = w.w; }
        unsigned thr = 0u;
#pragma unroll 1
        for (int bit = 30; bit >= 0; --bit) { const unsigned cand = thr | (1u << bit); unsigned c = 0;
#pragma unroll
            for (int i = 0; i < 16; ++i) c += (unsigned)__builtin_popcountll(__ballot(key[i] >= cand));
            LAS unsigned* slot = cnt + ((bit & 1) << 3);
            if (lane == 0) slot[F.wave] = c;
            __syncthreads();
            unsigned tot = 0;
#pragma unroll
            for (int w = 0; w < 8; ++w) tot += slot[w];
            if (tot >= (unsigned)CAP) thr = cand; }
        unsigned ngt = 0, neq = 0;
#pragma unroll
        for (int i = 0; i < 16; ++i) { ngt += key[i] > thr ? 1u : 0u; neq += key[i] == thr ? 1u : 0u; }
        unsigned pk = ngt | (neq << 16), inc = pk;
#pragma unroll
        for (int o = 1; o < 64; o <<= 1) { const unsigned v = (unsigned)__builtin_amdgcn_ds_bpermute((lane - o) << 2, (int)inc); if (lane >= o) inc += v; }
        __syncthreads();
        if (lane == 63) wtot[F.wave] = inc;
        __syncthreads();
        unsigned base = 0, all = 0;
        for (int w = 0; w < 8; ++w) { const unsigned v = wtot[w]; all += v; if (w < F.wave) base += v; }
        const unsigned tot_gt = all & 0xffffu, need = (unsigned)CAP - tot_gt;
        const unsigned excl = base + inc - pk; unsigned g_before = excl & 0xffffu, e_before = excl >> 16;
#pragma unroll
        for (int i = 0; i < 16; ++i) { const int s = 16 * tid + i; int slot = -1;
            if (key[i] > thr) { slot = (int)g_before; ++g_before; }
            else if (key[i] == thr) { if (e_before < need) slot = (int)(tot_gt + e_before); ++e_before; }
            SLOT[(size_t)p * SEQ + s] = slot;
            if (slot >= 0) { TOPI[p * CAP + slot] = (p >> 4) * SEQ + s; TOPG[p * CAP + slot] = __uint_as_float(key[i]); } }
        __syncthreads();
    }
}
__device__ __forceinline__ void p_final(const Frame& F, float* out, const float* mod, const int* SLOT, const bf16_t* Y, const float* gfin, float oscale) {
    const int tid = opaque_tid(F.wave), lane = tid & 63; (void)tid;
    f32x4 gf[4], xn[4], gtn[4]; int sln = -1;
#pragma unroll
    for (int j = 0; j < 4; ++j) gf[j] = *(const f32x4*)(gfin + 4 * lane + 256 * j);
    int r = F.gw;
    if (r < NTOK) { const int b = r / SEQ, s = r % SEQ; if (lane < NE) sln = SLOT[((size_t)b * NE + lane) * SEQ + s];
#pragma unroll
        for (int j = 0; j < 4; ++j) { const int c = 4 * lane + 256 * j; xn[j] = *(const f32x4*)(out + (size_t)r * DM + c); gtn[j] = *(const f32x4*)(mod + b * 6144 + 5120 + c); } }
#pragma unroll 1
    for (; r < NTOK; r += F.NGW) { const int b = r / SEQ; float* row = out + (size_t)r * DM;
        const int sl = sln; f32x4 x[4], gt[4];
#pragma unroll
        for (int j = 0; j < 4; ++j) { x[j] = xn[j]; gt[j] = gtn[j]; }
        const int rn = r + F.NGW;
        if (rn < NTOK) { const int bn = rn / SEQ, sn = rn % SEQ; sln = -1; if (lane < NE) sln = SLOT[((size_t)bn * NE + lane) * SEQ + sn];
#pragma unroll
            for (int j = 0; j < 4; ++j) { const int c = 4 * lane + 256 * j; xn[j] = *(const f32x4*)(out + (size_t)rn * DM + c); gtn[j] = *(const f32x4*)(mod + bn * 6144 + 5120 + c); } }
        unsigned long long m = __ballot(sl >= 0);
        f32x4 acc[4];
#pragma unroll
        for (int j = 0; j < 4; ++j) acc[j] = (f32x4){0.f, 0.f, 0.f, 0.f};
        while (m) { const int e = __builtin_ctzll(m); m &= m - 1; const int slot = __builtin_amdgcn_readlane(sl, e);
            const bf16_t* yr = Y + (((size_t)b * NE + e) * CAP + slot) * DM;
#pragma unroll
            for (int j = 0; j < 4; ++j) { const u32x2 w = *(const u32x2*)(yr + 4 * lane + 256 * j); acc[j][0] += bflo(w.x); acc[j][1] += bfhi(w.x); acc[j][2] += bflo(w.y); acc[j][3] += bfhi(w.y); } }
        f32x4 v[4]; float ss = 0.f;
#pragma unroll
        for (int j = 0; j < 4; ++j) { v[j] = x[j] + gt[j] * acc[j]; ss += (v[j][0] * v[j][0] + v[j][1] * v[j][1]) + (v[j][2] * v[j][2] + v[j][3] * v[j][3]); }
        const float rstd = 1.0f / sqrtf(wave_sum(ss) * (1.f / DM) + NORM_EPS);
#pragma unroll
        for (int j = 0; j < 4; ++j) { const int c = 4 * lane + 256 * j; f32x4 ov = v[j] * (rstd * oscale) * gf[j];
#if defined(MK_CHECK) && MK_CHECK
#pragma unroll
            for (int e = 0; e < 4; ++e) if (!(ov[e] == ov[e]) || fabsf(ov[e]) > 1e6f) ov[e] = 0.f;
#endif
            *(f32x4*)(row + c) = ov; }
    }
}

__global__ void __launch_bounds__(NWAVES * 64, 2) fwd_kernel(Args args) {
    extern __shared__ __attribute__((aligned(16))) unsigned char lds_raw[];
    Frame F;
    F.lds = (LAS unsigned char*)lds_raw;
    F.wave = __builtin_amdgcn_readfirstlane((int)threadIdx.x >> 6); F.tid = opaque_tid(F.wave); F.lane = F.tid & 63;
    F.G = gridDim.x; { const int bx = blockIdx.x; F.vcu = (F.G % 8 == 0) ? (bx % 8) * (F.G / 8) + bx / 8 : bx; }
    F.gw = F.vcu * NWAVES + F.wave; F.NGW = F.G * NWAVES;
    unsigned char* ws = args.ws;
    volatile LAS unsigned* MISC = (volatile LAS unsigned*)(F.lds + MISC_OFF);
    for (int u = F.tid; u < (LDS_BYTES - RING_BYTES) / 4; u += NWAVES * 64) ((LAS unsigned*)(F.lds + RING_BYTES))[u] = 0u;
    __syncthreads();
    unsigned* ctl = (unsigned*)(ws + WS_CTL);
    XcdBarrier bar = xcd_barrier_post(ctl + CW_BAR, MISC + 8); bar.wv = F.wave;

#define IN_F(k) ((const float*)args.in[k])
#define in_x IN_F(0)
#define cin IN_F(1)
#define positions ((const int*)args.in[2])
#define w_ada IN_F(3)
#define b_ada IN_F(4)
#define g_mix IN_F(5)
#define w_in IN_F(6)
#define g_q IN_F(7)
#define g_kv IN_F(8)
#define w_uq IN_F(9)
#define w_ukv IN_F(10)
#define rel_bias IN_F(11)
#define w_out IN_F(12)
#define g_ffn IN_F(13)
#define w_router IN_F(14)
#define w_gate IN_F(15)
#define w_up IN_F(16)
#define w_down IN_F(17)
#define g_final IN_F(18)
#define t_out (args.out)
#define WSP(T, off) ((T*)(args.ws + (off)))
#define MOD WSP(float, WS_MOD)
#define CS WSP(float, WS_CS)
#define WIN WSP(bf16_t, WS_WIN)
#define WUQ WSP(bf16_t, WS_WUQ)
#define WUKV WSP(bf16_t, WS_WUKV)
#define WOUT WSP(bf16_t, WS_WOUT)
#define t_H WSP(bf16_t, WS_H)
#define t_U WSP(bf16_t, WS_U)
#define t_P WSP(bf16_t, WS_P)
#define CQN WSP(bf16_t, WS_CQN)
#define CKVN WSP(bf16_t, WS_CKVN)
#define QB WSP(bf16_t, WS_QB)
#define KB WSP(bf16_t, WS_KB)
#define VB WSP(bf16_t, WS_VB)
#define OA WSP(bf16_t, WS_OA)
#define OG WSP(bf16_t, WS_OG)
#define LSE WSP(float, WS_LSE)
#define WGU WSP(bf16_t, WS_WGU)
#define WD WSP(bf16_t, WS_WD)
#define HID WSP(bf16_t, WS_HID)
#define t_Y WSP(bf16_t, WS_Y)
#define AFFT WSP(float, WS_AFFT)
#define TOPI WSP(int, WS_TOPI)
#define TOPG WSP(float, WS_TOPG)
#define SLOT WSP(int, WS_SLOT)

#ifndef PH_MASK
#define PH_MASK 0xFFFFFFFFu
#endif
#define PH_ON(k) constexpr (((PH_MASK) >> (k)) & 1u)
#ifndef DUP_MASK
#define DUP_MASK 0u
#endif
#define PH_REP(k) for (int rep_ = 0; rep_ < ((((DUP_MASK) >> (k)) & 1u) ? 2 : 1); ++rep_)
#if defined(PROBE_TIMING)
#define DBG_SCALE() (1.0f + __uint_as_float(__hip_atomic_load(ctl + CW_DBG + 1, RLX_AGENT)))
#elif defined(MK_CHECK) && MK_CHECK
#define DBG_SCALE() ([&]() -> float { const unsigned f_ = __hip_atomic_load(ctl + CW_DBG, RLX_AGENT); return f_ ? 1.0f + 0.05f * (float)(1 + __builtin_ctz(f_)) : 1.0f; }())
#else
#define DBG_SCALE() 1.0f
#endif
    int step = 0; const int lo = args.st_lo, hi = args.st_hi;
#if defined(PROBE_STEP)
#define STEP_BEGIN if (step >= lo && step < hi) { const unsigned long long rt0_ = __builtin_amdgcn_s_memrealtime();
#define STEP_END if (step + 1 < hi) xcd_barrier(bar); if (step == PROBE_STEP && blockIdx.x == 0 && F.wave == 0 && opaque_tid(0) == 0) { \
        const float us_ = (float)(__builtin_amdgcn_s_memrealtime() - rt0_) * 0.01f; *(float*)(ctl + CW_DBG + 1) = __builtin_rintf((us_ + PROBE_QOFF) * (1.f / 16.f)) * 8e-3f; } } ++step;
#else
#define STEP_BEGIN if (step >= lo && step < hi) {
#endif
#if defined(PROBE_STEP)
#elif defined(PROBE_DBLBAR)
#define STEP_END if (step + 1 < hi) { xcd_barrier(bar); xcd_barrier(bar); } } ++step;
#else
#define STEP_END if (step + 1 < hi) xcd_barrier(bar); } ++step;
#endif

    STEP_BEGIN
        if PH_ON(0) PH_REP(0) { p0_mod(F, cin, w_ada, b_ada, MOD);
        p0_cs(F, positions, CS);
        p0_lut(F, rel_bias, (float*)(ws + WS_LUT));
        p0_weights(F, w_in, w_uq, w_ukv, w_out, ws); }
    STEP_END
    STEP_BEGIN
        if PH_ON(1) PH_REP(1) p1_h(F, in_x, g_mix, MOD, t_H);
    STEP_END
    for (int b = 0; b < NB; ++b) {
        STEP_BEGIN
            pg8::Gemm g{(const bf16_t*)((const char*)t_H + (size_t)b * SEQ * DM * (FP8_G1 ? 1 : 2)), WIN, DM, DM, DM, 0, 0, nullptr, 0, 0}; pg8::StaticOrder S; S.init(SEQ, NP, F.G, (int)blockIdx.x);
            pg8::EpiP E{(unsigned char*)t_P, FP8_G1 ? W8_INV : 1.0f, 0};
            if PH_ON(2) PH_REP(2) {
#if defined(PROBE_NOSTORE)
                E.nostore = (rep_ == 0);
#endif
                pg8::gemm_phase<pg8::EpiP, pg8::StaticOrder, false, (FP8_G1 != 0)>(F.lds, F.wave, g, S, E); __syncthreads(); }
        STEP_END
        STEP_BEGIN
            if PH_ON(3) PH_REP(3) lb_latent(F, t_P, g_q, g_kv, CS + (size_t)b * SEQ * 64, CQN, CKVN, KB);
        STEP_END
        STEP_BEGIN
#if MLA_FP8
            { pg8::Gemm g{CQN, WUQ, 384, 384, 384, 0, 0, nullptr, 0, 0}; pg8::StaticOrder S; S.init(SEQ, 1536, F.G, (int)blockIdx.x);
              pg8::EpiQ8 E{(unsigned char*)QB, CS + (size_t)b * SEQ * 64};
              if PH_ON(4) PH_REP(4) { pg8::gemm_phase<pg8::EpiQ8, pg8::StaticOrder, false>(F.lds, F.wave, g, S, E); __syncthreads(); } }
            { pg8::Gemm g{CKVN, WUKV, 256, 256, 256, 0, 0, nullptr, 0, 0}; pg8::StaticOrder S; S.init(SEQ, 1024, F.G, (int)blockIdx.x);
              pg8::EpiK8 E{(unsigned char*)KB};
              if PH_ON(5) PH_REP(5) { pg8::gemm_phase<pg8::EpiK8, pg8::StaticOrder, false>(F.lds, F.wave, g, S, E); __syncthreads(); } }
            { pg8::Gemm g{WUKV + (size_t)1024 * 256, CKVN, 256, 256, 256, 0, 0, nullptr, 0, 0}; pg8::StaticOrder S; S.init(1024, SEQ, F.G, (int)((blockIdx.x + 128) % F.G));
              pg8::EpiVT8 E{(unsigned char*)VB};
              if PH_ON(5) PH_REP(5) { pg8::gemm_phase<pg8::EpiVT8, pg8::StaticOrder, false>(F.lds, F.wave, g, S, E); __syncthreads(); } }
#else
            { pg8::Gemm g{CQN, WUQ, 384, 384, 384, 0, 0, nullptr, 0, 0}; pg8::StaticOrder S; S.init(SEQ, 1536, F.G, (int)blockIdx.x);
              pg8::EpiQ E{QB, CS + (size_t)b * SEQ * 64};
              if PH_ON(4) PH_REP(4) { pg8::gemm_phase<pg8::EpiQ, pg8::StaticOrder, false>(F.lds, F.wave, g, S, E); __syncthreads(); } }
            __syncthreads();
            { pg8::Gemm g{CKVN, WUKV, 256, 256, 256, 0, 0, nullptr, 0, 0}; pg8::StaticOrder S; S.init(SEQ, 2048, F.G, (int)blockIdx.x);
              pg8::EpiKV E{KB, VB};
              if PH_ON(5) PH_REP(5) { pg8::gemm_phase<pg8::EpiKV, pg8::StaticOrder, false>(F.lds, F.wave, g, S, E); __syncthreads(); } }
#endif
        STEP_END
        STEP_BEGIN
            const bool conv_first = (((int)blockIdx.x >> 3) & 1) == 0;
            if (conv_first) { if PH_ON(10) PH_REP(10) conv_experts(F, w_gate, w_up, w_down, ws, b); }
            for (int u = blockIdx.x; u < 256; u += F.G) { const int hd = u & 7, qb = u >> 3;
#if MLA_FP8
                att::Unit8 a8{(const unsigned char*)QB + ((size_t)hd * SEQ + 256 * qb) * 192, (const unsigned char*)KB + (size_t)hd * SEQ * 192, (const unsigned char*)VB + (size_t)hd * SEQ * 128,
                              OA + (size_t)(256 * qb) * DM + hd * 128, DM, SEQ / 64, nullptr};
#if defined(PROBE_TIMING)
                a8.dbg = (blockIdx.x == PROBE_BLOCK && b == 3) ? (float*)(ctl + CW_DBG + 1) : nullptr;
#endif
                if PH_ON(6) PH_REP(6) att::attn_mla8_unit(a8, (LAS char*)F.lds, F.wave);
#else
                att::Unit a{};
                a.Q = QB + ((size_t)hd * SEQ + 256 * qb) * 192; a.qs = 192; a.K = KB + (size_t)hd * SEQ * 192; a.ks = 192; a.V = VB + (size_t)hd * SEQ * 128; a.vs = 128;
                a.O = OA + (size_t)(256 * qb) * DM + hd * 128; a.os = DM; a.nt = SEQ / 64;
#if defined(BREAK_MLA) && BREAK_MLA
                a.nt = SEQ / 64 - 2;
#endif
                a.tmul = 1;
#if defined(PROBE_TIMING)
                a.dbg = (blockIdx.x == PROBE_BLOCK && b == 3) ? (float*)(ctl + CW_DBG + 1) : nullptr;
#endif
#if defined(PROBE_SAMETILE)
                a.tmul = 0; att::attn_unit<false>(a, (LAS char*)F.lds, F.wave); a.tmul = 1;
#endif
                if PH_ON(6) PH_REP(6) att::attn_unit<false>(a, (LAS char*)F.lds, F.wave);
#endif
            }

            for (int u = blockIdx.x; u < 768; u += F.G) { const int grp = u >> 8, w = u & 255, hd = w & 7, rest = w >> 3, d = grp == 0 ? 1 : (grp == 1 ? 4 : 16), cl = rest % d, qb = rest / d;
                att::Unit a{};
                const size_t tok0 = (size_t)256 * qb * d + cl; const char* gbase = (const char*)t_P + P_OFF_DIL + grp * P_GRP;
                a.Q = (const bf16_t*)(gbase + tok0 * PROW + hd * 128 * P_QK_ESZ); a.qs = d * (PROW / 2);
                a.K = (const bf16_t*)(gbase + (size_t)cl * PROW + 1024 * P_QK_ESZ + hd * 128 * P_QK_ESZ); a.ks = d * (PROW / 2);
                a.V = (const bf16_t*)(gbase + (size_t)cl * PROW + 2048 * P_QK_ESZ + hd * 256); a.vs = d * (PROW / 2);
                a.O = OG + ((size_t)grp * SEQ + tok0) * DM + hd * 128; a.os = d * DM; a.nt = 6; a.tmul = 1;
#if defined(PROBE_TIMING)
                a.dbg = (blockIdx.x == PROBE_BLOCK && b == 3 && grp == PROBE_GRP) ? (float*)(ctl + CW_DBG + 1) : nullptr;
#endif
                a.kt0 = 4 * qb - 1; a.ktn = (SEQ / d) / 64; a.l0 = 256 * qb; a.pos = positions + (size_t)b * SEQ + cl; a.ps = d;
                a.lse = LSE + ((size_t)grp * SEQ + tok0) * 8 + hd; a.ls = d * 8; a.bias = rel_bias + grp * 8 + hd; a.lutg = (const float*)(ws + WS_LUT) + (grp * 8 + hd) * 2304;
                if PH_ON(7) PH_REP(7) att::attn_unit<true>(a, (LAS char*)F.lds, F.wave); }
            if (!conv_first) { if PH_ON(10) PH_REP(10) conv_experts(F, w_gate, w_up, w_down, ws, b); }
        STEP_END
        STEP_BEGIN
            if PH_ON(8) PH_REP(8) lb_combine(F, t_P, OA, OG, LSE, (bf16_t*)((char*)t_U + (size_t)b * SEQ * DM * (FP8_WO ? 1 : 2)));
        STEP_END
#if defined(MK_CHECK) && MK_CHECK
        STEP_BEGIN
#if !defined(CHK_MEASURE) && !defined(CHK_ONLY_DIL)
            chk::check_proj(F, b, ctl, t_P, CQN, CKVN, QB, KB, VB, g_q, g_kv, w_uq, w_ukv, positions);
            chk::check_dil(F, b, ctl, t_P, positions, rel_bias, OG, LSE);
            chk::check_u(F, b, ctl, t_P, OA, OG, LSE, t_U + (size_t)b * SEQ * DM);
#endif
#if defined(CHK_ONLY_DIL)
            chk::check_dil(F, b, ctl, t_P, positions, rel_bias, OG, LSE);
#else
            chk::check_mla(F, b, ctl, QB, KB, VB, OA);
#endif
        STEP_END
#endif
    }
    STEP_BEGIN
        { pg8::Gemm g{t_U, WOUT, DM, DM, DM, 0, 0, nullptr, 0, 0}; pg8::StaticOrder S; S.init(NTOK, DM, F.G, (int)blockIdx.x);
          pg8::EpiRes E{in_x, t_out, MOD, FP8_WO ? W8_INV * (1.0f / U8_SCALE) : 1.0f};
          if PH_ON(9) PH_REP(9) { pg8::gemm_phase<pg8::EpiRes, pg8::StaticOrder, false, (FP8_WO != 0)>(F.lds, F.wave, g, S, E); __syncthreads(); } }
    STEP_END
    STEP_BEGIN
        if PH_ON(11) PH_REP(11) pg_h2_router(F, t_out, g_ffn, MOD, w_router, t_H, AFFT);
    STEP_END
    STEP_BEGIN
        if PH_ON(12) PH_REP(12) ph_topk(F, AFFT, TOPI, TOPG, SLOT);
    STEP_END
    static_assert(FP8_EX != 0, "the all-batch FFN workspace map assumes fp8 expert operands");
    STEP_BEGIN
        { pg8::Gemm g{t_H, WGU, DM, DM, DM, 0, (long)4096 * 1024, TOPI, CAP, NE}; pg8::GroupOrder S; S.init(4, 16, NB * NE, F.G, (int)blockIdx.x);
          pg8::EpiSwiGLU E{(void*)HID, W8_INV};
          if PH_ON(13) PH_REP(13) { pg8::gemm_phase<pg8::EpiSwiGLU, pg8::GroupOrder, true, true>(F.lds, F.wave, g, S, E); __syncthreads(); } }
    STEP_END
    STEP_BEGIN
        { pg8::Gemm g{HID, WD, DFF, DFF, DFF, (long)CAP * DFF, (long)DM * DFF, nullptr, 0, NE}; pg8::GroupOrder S; S.init(4, 4, NB * NE, F.G, (int)blockIdx.x);
          pg8::EpiDown E{t_Y, TOPG, W8_INV};
          if PH_ON(14) PH_REP(14) { pg8::gemm_phase<pg8::EpiDown, pg8::GroupOrder, false, true>(F.lds, F.wave, g, S, E); __syncthreads(); } }
    STEP_END
    STEP_BEGIN
        if PH_ON(15) PH_REP(15) p_final(F, t_out, MOD, SLOT, t_Y, g_final, DBG_SCALE());
    STEP_END
#undef STEP_BEGIN
#undef STEP_END
}
#undef IN_F
#undef in_x
#undef cin
#undef positions
#undef w_ada
#undef b_ada
#undef g_mix
#undef w_in
#undef g_q
#undef g_kv
#undef w_uq
#undef w_ukv
#undef rel_bias
#undef w_out
#undef g_ffn
#undef w_router
#undef w_gate
#undef w_up
#undef w_down
#undef g_final
#undef t_out
#undef WSP
#undef MOD
#undef CS
#undef WIN
#undef WUQ
#undef WUKV
#undef WOUT
#undef t_H
#undef t_U
#undef t_P
#undef CQN
#undef CKVN
#undef QB
#undef KB
#undef VB
#undef OA
#undef OG
#undef LSE
#undef WGU
#undef WD
#undef HID
#undef t_Y
#undef AFFT
#undef TOPI
#undef TOPG
#undef SLOT
constexpr int STEPS_MIX = 5
#if defined(MK_CHECK) && MK_CHECK
    + 1
#endif
    ;
constexpr int N_STEPS = 2 + NB * STEPS_MIX + 3 + 3;

#ifndef MK_PER_STEP
#define MK_PER_STEP 0
#endif
extern "C" void kernel_launch(void* const* d_in, const int* in_sizes, int n_in, void* d_out, int out_size, void* d_ws, size_t ws_size, hipStream_t stream) {
    static int grid = 0;
    if (grid == 0) {
        if (n_in != 19 || out_size != NTOK * DM || ws_size < WS_END) { fprintf(stderr, "kernel_launch: unexpected shapes (n_in %d out %d ws %zu need %zu)\n", n_in, out_size, ws_size, (size_t)WS_END); grid = -1; return; }
        int dev = 0, cus = 0;
        if (hipGetDevice(&dev) != hipSuccess || hipDeviceGetAttribute(&cus, hipDeviceAttributeMultiprocessorCount, dev) != hipSuccess) { grid = -1; return; }
        if (hipFuncSetAttribute((const void*)fwd_kernel, hipFuncAttributeMaxDynamicSharedMemorySize, LDS_BYTES) != hipSuccess) { grid = -1; return; }
        int per_cu = 0;
        if (hipOccupancyMaxActiveBlocksPerMultiprocessor(&per_cu, (const void*)fwd_kernel, NWAVES * 64, LDS_BYTES) != hipSuccess || per_cu < 1) { fprintf(stderr, "kernel_launch: occupancy query says %d\n", per_cu); }
        (void)hipGetLastError();
        grid = cus;
    }
    if (grid < 0) return;
    if (hipMemsetAsync((char*)d_ws + WS_CTL, 0, CTL_ZERO_BYTES, stream) != hipSuccess) return;
    Args a{};
    for (int i = 0; i < 19; ++i) a.in[i] = d_in[i];
    a.out = (float*)d_out; a.ws = (unsigned char*)d_ws;
#if MK_PER_STEP
    for (int s = 0; s < N_STEPS; ++s) { a.st_lo = s; a.st_hi = s + 1; hipLaunchKernelGGL(fwd_kernel, dim3(grid), dim3(NWAVES * 64), LDS_BYTES, stream, a); }
#else
    a.st_lo = 0; a.st_hi = N_STEPS;
    hipLaunchKernelGGL(fwd_kernel, dim3(grid), dim3(NWAVES * 64), LDS_BYTES, stream, a);
#endif
    const hipError_t le = hipPeekAtLastError();
    if (le != hipSuccess) fprintf(stderr, "kernel_launch: launch failed: %s\n", hipGetErrorName(le));
}
```

```cpp
#include <hip/hip_runtime.h>
#include <cstdio>
#include <cstdint>

#define LAS __attribute__((address_space(3)))
#define GAS __attribute__((address_space(1)))
typedef unsigned short bf16_t;
typedef short bf16x8 __attribute__((ext_vector_type(8)));
typedef short s16x4 __attribute__((ext_vector_type(4)));
typedef float f32x2 __attribute__((ext_vector_type(2)));
typedef float f32x4 __attribute__((ext_vector_type(4)));
typedef float f32x16 __attribute__((ext_vector_type(16)));
typedef unsigned u32x2 __attribute__((ext_vector_type(2)));
typedef unsigned u32x4 __attribute__((ext_vector_type(4)));
typedef int i32x4 __attribute__((ext_vector_type(4)));

#ifndef MK_FP8
#define MK_FP8 1
#endif
#ifndef DIL_FP8
#define DIL_FP8 1
#endif
constexpr int NB = 4, SEQ = 8192, DM = 1024, NTOK = NB * SEQ;
constexpr int NP = 12032;
constexpr int C_CQ = 0, C_CKV = 384, C_KPE = 640, C_DIL = 704, C_GATE = 9920, D_IN = 11968;
constexpr int NE = 16, CAP = 1024, DFF = 2048;
constexpr int P_QK_ESZ = DIL_FP8 ? 1 : 2, P_GRP = 2 * 1024 * P_QK_ESZ + 2048, P_OFF_DIL = 1408, P_OFF_GATE = P_OFF_DIL + 3 * P_GRP, PROW = P_OFF_GATE + 2 * (2048 + 64);
__host__ __device__ constexpr int p_col_off(int c) {
    return c < C_DIL ? 2 * c : (c < C_GATE ? (P_OFF_DIL + ((c - C_DIL) / 3072) * P_GRP + ((((c - C_DIL) % 3072) >> 10) == 2 ? 2048 * P_QK_ESZ + 2 * (((c - C_DIL) % 3072) & 1023) : ((((c - C_DIL) % 3072) >> 10) * 1024 + (((c - C_DIL) % 3072) & 1023)) * P_QK_ESZ)) : P_OFF_GATE + 2 * (c - C_GATE)); }
__host__ __device__ constexpr bool p_col_f8(int c) { return DIL_FP8 && c >= C_DIL && c < C_GATE && ((((c - C_DIL) % 3072) >> 10) != 2); }
constexpr float NORM_EPS = 1e-6f;
constexpr float LOG2E = 1.4426950408889634f;

constexpr size_t MiB = 1u << 20;
constexpr size_t WS_CTL = 0, CTL_ZERO_BYTES = 1 * MiB;
constexpr size_t WS_MOD = 1 * MiB;
constexpr size_t WS_CS = 2 * MiB;
constexpr size_t WS_WIN = 10 * MiB;
constexpr size_t WS_WUQ = 34 * MiB;
constexpr size_t WS_WUKV = 36 * MiB;
constexpr size_t WS_WOUT = 37 * MiB;
constexpr size_t WS_H = 40 * MiB;
constexpr size_t WS_U = 104 * MiB;
constexpr size_t WS_R = 168 * MiB;
constexpr size_t WS_P = WS_R;
constexpr size_t WS_CQN = WS_R + 188 * MiB;
constexpr size_t WS_CKVN = WS_R + 194 * MiB;
constexpr size_t WS_QB = WS_R + 198 * MiB;
constexpr size_t WS_KB = WS_R + 222 * MiB;
constexpr size_t WS_VB = WS_R + 246 * MiB;
constexpr size_t WS_OA = WS_R + 262 * MiB;
constexpr size_t WS_OG = WS_R + 278 * MiB;
constexpr size_t WS_LSE = WS_R + 326 * MiB;
constexpr size_t WS_WGU = WS_R + 358 * MiB;
constexpr size_t WS_WD = WS_U + 32 * MiB;
constexpr size_t WS_HID = WS_R + 96 * MiB;
constexpr size_t WS_Y = WS_R + 224 * MiB;
constexpr size_t WS_AFFT = WS_R + 352 * MiB;
constexpr size_t WS_TOPI = WS_R + 354 * MiB;
constexpr size_t WS_TOPG = WS_R + 355 * MiB;
constexpr size_t WS_SLOT = WS_R + 356 * MiB;
constexpr size_t WS_END = WS_R + 422 * MiB;
constexpr size_t WS_LUT = 1 * MiB + 512 * 1024;
constexpr int CW_TMO = 0, CW_DBG = 16, CW_BAR = 4096;

constexpr int RING_BYTES = 131072;
constexpr int MISC_OFF = RING_BYTES + 320;
constexpr int LDS_BYTES = 147456;
constexpr int NWAVES = 8;

#define RLX_AGENT __ATOMIC_RELAXED, __HIP_MEMORY_SCOPE_AGENT
#define LDS_WAIT() asm volatile("s_waitcnt lgkmcnt(0)" ::: "memory")
#define VM_WAIT() asm volatile("s_waitcnt vmcnt(0)" ::: "memory")

__device__ __forceinline__ unsigned cvt_pk_bf16(float lo, float hi) { unsigned r; asm volatile("v_cvt_pk_bf16_f32 %0, %1, %2" : "=v"(r) : "v"(lo), "v"(hi)); return r; }
__device__ __forceinline__ float bf2f(unsigned short v) { return __uint_as_float(((unsigned)v) << 16); }
__device__ __forceinline__ float bflo(unsigned w) { return __uint_as_float(w << 16); }
__device__ __forceinline__ float bfhi(unsigned w) { return __uint_as_float(w & 0xffff0000u); }
#define SWZ_XOR(k) (((k) << 10) | 0x1f)
#if defined(OLD_WAVE_SUM)
__device__ __forceinline__ float wave_sum(float v) { for (int o = 1; o < 64; o <<= 1) v += __shfl_xor(v, o); return v; }
#else
__device__ __forceinline__ float wave_sum(float v) {
    v += __int_as_float(__builtin_amdgcn_ds_swizzle(__float_as_int(v), SWZ_XOR(1)));
    v += __int_as_float(__builtin_amdgcn_ds_swizzle(__float_as_int(v), SWZ_XOR(2)));
    v += __int_as_float(__builtin_amdgcn_ds_swizzle(__float_as_int(v), SWZ_XOR(4)));
    v += __int_as_float(__builtin_amdgcn_ds_swizzle(__float_as_int(v), SWZ_XOR(8)));
    v += __int_as_float(__builtin_amdgcn_ds_swizzle(__float_as_int(v), SWZ_XOR(16)));
    { auto rr = __builtin_amdgcn_permlane32_swap(__float_as_uint(v), __float_as_uint(v), false, false); v = __uint_as_float(rr[0]) + __uint_as_float(rr[1]); }
    return v;
}
#endif
__device__ __forceinline__ float wave_max(float v) {
    v = fmaxf(v, __int_as_float(__builtin_amdgcn_ds_swizzle(__float_as_int(v), SWZ_XOR(1))));
    v = fmaxf(v, __int_as_float(__builtin_amdgcn_ds_swizzle(__float_as_int(v), SWZ_XOR(2))));
    v = fmaxf(v, __int_as_float(__builtin_amdgcn_ds_swizzle(__float_as_int(v), SWZ_XOR(4))));
    v = fmaxf(v, __int_as_float(__builtin_amdgcn_ds_swizzle(__float_as_int(v), SWZ_XOR(8))));
    v = fmaxf(v, __int_as_float(__builtin_amdgcn_ds_swizzle(__float_as_int(v), SWZ_XOR(16))));
    { auto rr = __builtin_amdgcn_permlane32_swap(__float_as_uint(v), __float_as_uint(v), false, false); v = fmaxf(__uint_as_float(rr[0]), __uint_as_float(rr[1])); }
    return v;
}
__device__ __forceinline__ float fast_sigmoid(float x) { return __builtin_amdgcn_rcpf(1.f + __builtin_amdgcn_exp2f(-x * LOG2E)); }
#ifndef MK_FP8
#define MK_FP8 1
#endif
#ifndef MLA_NM16
#define MLA_NM16 1
#endif
#ifndef MLA_PKADD
#define MLA_PKADD 0
#endif
#ifndef MLA_PKOLD
#define MLA_PKOLD 0
#endif
#ifndef MLA_PRE
#define MLA_PRE 1
#endif
#ifndef MLA_2T
#define MLA_2T 0
#endif
#ifndef MLA_LSUM
#define MLA_LSUM 1
#endif
#ifndef MLA_FP8
#define MLA_FP8 1
#endif
#ifndef FP8_G1
#define FP8_G1 MK_FP8
#endif
#ifndef FP8_EX
#define FP8_EX MK_FP8
#endif
#ifndef FP8_WO
#define FP8_WO 1
#endif
constexpr float QK_LOG2_SCALE = 0.072168783648703220f * LOG2E;
constexpr float W8_SCALE = 64.0f, W8_INV = 1.0f / 64.0f;
constexpr float U8_SCALE = 16.0f;
typedef int v8i __attribute__((ext_vector_type(8)));
__device__ __forceinline__ unsigned pk4_fp8(float a, float b, float c, float d) { int w = __builtin_amdgcn_cvt_pk_fp8_f32(a, b, 0, false); w = __builtin_amdgcn_cvt_pk_fp8_f32(c, d, w, true); return (unsigned)w; }
#if defined(OLD_TID)
__device__ __forceinline__ int opaque_tid(int wv) { int t = (int)threadIdx.x; asm volatile("" : "+v"(t)); return t; }
#else
__device__ __forceinline__ int opaque_tid(int wv) { int l; asm volatile("v_mbcnt_lo_u32_b32 %0, -1, 0\n\tv_mbcnt_hi_u32_b32 %0, -1, %0" : "=v"(l)); return (wv << 6) | l; }
#endif
struct Frame {
    LAS unsigned char* lds;
    int tid, lane, wave, vcu, G, gw, NGW;
};
struct Args { const void* in[19]; float* out; unsigned char* ws; int st_lo, st_hi; };

#define XB_TMO      128
#define XB_XCNT(j)  (256  + 64 * (j))
#define XB_XSUB(j)  (1280 + 64 * (j))
#define XB_XGEN(j)  (2304 + 64 * (j))
#define XB_TOP      3328
#define XB_TOPGEN   3392
#define XCD_BAR_WORDS 3456
#define XB_SPIN_CAP (1u << 18)

__device__ __forceinline__ unsigned xb_ld(unsigned* p)              { return __hip_atomic_load(p, __ATOMIC_RELAXED, __HIP_MEMORY_SCOPE_AGENT); }
__device__ __forceinline__ unsigned xb_add(unsigned* p, unsigned v) { return __hip_atomic_fetch_add(p, v, __ATOMIC_RELAXED, __HIP_MEMORY_SCOPE_AGENT); }
__device__ __forceinline__ unsigned xb_xcc_id() { return (unsigned)__builtin_amdgcn_s_getreg((3 << 11) | 20) & 0xFu; }
#define XB_SPIN(cond, bar) do { unsigned _sp = 0; while (cond) { __builtin_amdgcn_s_sleep(1); \
    if ((++_sp & 255u) == 0u) { if (xb_ld(&(bar)[XB_TMO])) break; if (_sp > XB_SPIN_CAP) { atomicAdd(&(bar)[XB_TMO], 1u); break; } } } } while (0)

struct XcdBarrier {
    unsigned* bar; unsigned x;
    int wv;
    volatile LAS unsigned* st;
};

__device__ __forceinline__ XcdBarrier xcd_barrier_post(unsigned* bar, volatile LAS unsigned* st) {
    XcdBarrier b; b.bar = bar; b.x = xb_xcc_id(); b.st = st;
    if (threadIdx.x == 0) (void)xb_add(&bar[XB_XCNT(b.x)], 1u);
    return b;
}
__device__ __forceinline__ void xcd_barrier_complete(unsigned* bar, unsigned x, unsigned& nloc, unsigned& nx) {
    const unsigned G = gridDim.x * gridDim.y * gridDim.z;
    unsigned sum, cnt, mine, sp = 0u;
    for (;;) {
        sum = 0u; cnt = 0u; mine = 0u;
#pragma unroll
        for (unsigned j = 0; j < 16; ++j) { const unsigned c = xb_ld(&bar[XB_XCNT(j)]); sum += c; cnt += (c > 0u) ? 1u : 0u; mine = (j == x) ? c : mine; }
        if (sum == G) break;
        __builtin_amdgcn_s_sleep(1);
        if ((++sp & 255u) == 0u) { if (xb_ld(&bar[XB_TMO])) break; if (sp > XB_SPIN_CAP) { atomicAdd(&bar[XB_TMO], 1u); break; } }
    }
    nloc = mine > 0u ? mine : 1u; nx = cnt > 0u ? cnt : 1u;
}

__device__ __forceinline__ void xcd_barrier(const XcdBarrier& b) {
    asm volatile("s_waitcnt vmcnt(0)" ::: "memory");
    __syncthreads();
    if (b.wv == 0 && opaque_tid(0) == 0) {
        unsigned* bar = b.bar;
        __builtin_amdgcn_s_waitcnt(0);
        unsigned nloc = b.st[0], nx = b.st[1];
        if (nloc == 0u) { xcd_barrier_complete(bar, b.x, nloc, nx); b.st[0] = nloc; b.st[1] = nx; }
        const unsigned old = xb_add(&bar[XB_XSUB(b.x)], 1u);
        const unsigned gen = old / nloc;
        if (old + 1u == (gen + 1u) * nloc) {
            __builtin_amdgcn_fence(__ATOMIC_RELEASE, "agent");
            asm volatile("s_waitcnt vmcnt(0)" ::: "memory");
            const unsigned og = xb_add(&bar[XB_TOP], 1u);
            const unsigned tg = og / nx;
            if (og + 1u == (tg + 1u) * nx) xb_add(&bar[XB_TOPGEN], 1u);
            else XB_SPIN(xb_ld(&bar[XB_TOPGEN]) == tg, bar);
            __builtin_amdgcn_fence(__ATOMIC_ACQUIRE, "agent");
            xb_add(&bar[XB_XGEN(b.x)], 1u);
            asm volatile("s_waitcnt vmcnt(0)" ::: "memory");
        } else {
            XB_SPIN(xb_ld(&bar[XB_XGEN(b.x)]) == gen, bar);
            __builtin_amdgcn_fence(__ATOMIC_ACQUIRE, "agent");
            asm volatile("s_waitcnt vmcnt(0)" ::: "memory");
        }
    }
    __syncthreads();
}

namespace pg8 {
constexpr int BM = 256, BK = 64, HALF = 128, HTB = HALF * BK * 2  , STAGE_BYTES = 8 * HTB, NXCD = 8, WGM = 8;

__host__ __device__ __forceinline__ int lds_byte(int r, int c) { const int st = (r >> 4) * 2 + (c >> 5), rr = r & 15, cc = c & 31, ob = rr * 64 + cc * 2; return st * 1024 + (ob ^ (((ob >> 9) & 1) << 5)); }
__host__ __device__ __forceinline__ void stage_rc(int b, int& R, int& C) { const int st = b / 1024, sb = b % 1024, swz = sb ^ (((sb >> 9) & 1) << 5); R = (st >> 1) * 16 + swz / 64; C = (st & 1) * 32 + (swz % 64) / 2; }
__host__ __device__ __forceinline__ int perm32(int rho) { const int n = rho >> 4, i = rho & 15; return 8 * (i >> 2) + 4 * n + (i & 3); }

struct Unit { int pm, pn, g; };
struct Gemm { const bf16_t* A; const bf16_t* Bt; int lda, ldb, K; long a_gs, b_gs; const int* idx; int idx_gs; int b_gmod; };

struct StaticOrder {
    int nM, nN, nwg, G, c;
    __device__ __forceinline__ void init(int M, int N, int G_, int c_) { nM = M / BM; nN = N / BM; nwg = nM * nN; G = G_; c = c_; }
    __device__ __forceinline__ bool next(int i, Unit& u) const {
        const long L = (long)i * G + c; if (L >= nwg) return false;
        int wgid = (int)L; { const int q = nwg / NXCD, r = nwg % NXCD, xcd = wgid % NXCD, off = wgid / NXCD; wgid = (xcd < r ? xcd * (q + 1) : r * (q + 1) + (xcd - r) * q) + off; }
        const int nig = WGM * nN, gid = wgid / nig, fm = gid * WGM, gsz = (nM - fm) < WGM ? (nM - fm) : WGM;
        u.pm = fm + ((wgid % nig) % gsz); u.pn = (wgid % nig) / gsz; u.g = 0; return true;
    }
};
struct GroupOrder {
    int nM, nN, nwg, G, v, gperm;
    __device__ __forceinline__ void init(int nM_, int nN_, int nG, int G_, int c_) { nM = nM_; nN = nN_; nwg = nM_ * nN_ * nG; G = G_; gperm = (nG == 64); v = (G_ % 8 == 0) ? (c_ % 8) * (G_ / 8) + c_ / 8 : c_; }
    __device__ __forceinline__ bool next(int i, Unit& u) const {
        const long L = (long)i * G + v; if (L >= nwg) return false;
        const int w = (int)L, gi = w / (nM * nN); u.pm = w % nM; u.pn = (w / nM) % nN;
        u.g = gperm ? (gi & 3) * 16 + (gi >> 2) : gi;
        return true;
    }
};

template <class Epi, class Sched, bool GATHER, bool FP8 = false>
__device__ __forceinline__ void gemm_phase(LAS unsigned char* lds, int wv, const Gemm g, const Sched& S, const Epi& E) {
    const int tid = opaque_tid(wv), wid = __builtin_amdgcn_readfirstlane(tid >> 6), lane = tid & 63, wr = wid >> 2, wc = wid & 3, fr = lane & 15, fq = lane >> 4;
    constexpr int ESZ = FP8 ? 1 : 2;
    const int K = g.K, nt = K * ESZ / (BK * 2);
    int Rr[2], Cc[2]; unsigned voffB[2];
#pragma unroll
    for (int i = 0; i < 2; ++i) { int R, C; stage_rc(tid * 16 + i * 8192, R, C); Rr[i] = R; Cc[i] = C; const int Rb = (Epi::PERM && !Epi::BPRE) ? ((R & ~31) + perm32(R & 31)) : R;
        voffB[i] = (unsigned)(Rb * g.ldb * ESZ + C * 2); }
    const unsigned kstep = (unsigned)(BK * 2);
    const unsigned hstepA = (unsigned)(HALF * g.lda * ESZ), hstepB = (unsigned)(HALF * g.ldb * ESZ);
    const unsigned ldsw = (unsigned)wid * 1024u;
    const int aoff = lds_byte(wr * 64 + fr, fq * 8), boff = lds_byte(wc * 32 + fr, fq * 8);
#define PG8_SA(b, h) (((b) * 2 + (h)) * HTB)
#define PG8_SB(b, h) ((4 + (b) * 2 + (h)) * HTB)
    const __amdgpu_buffer_rsrc_t rsA = __builtin_amdgcn_make_buffer_rsrc((void*)g.A, 0, 0x7fffffff, 0x00020000), rsB = __builtin_amdgcn_make_buffer_rsrc((void*)g.Bt, 0, 0x7fffffff, 0x00020000);
#ifndef PG8_BUFFER_DMA
#define PG8_BUFFER_DMA 1
#endif
#if PG8_BUFFER_DMA
#define PG8_STAGE(bufoff, rs, so, v0, v1) do { \
        __builtin_amdgcn_raw_ptr_buffer_load_lds(rs, (LAS void*)(lds + (bufoff) + ldsw), 16, (v0), (so), 0, 0); \
        __builtin_amdgcn_raw_ptr_buffer_load_lds(rs, (LAS void*)(lds + (bufoff) + ldsw + 8192), 16, (v1), (so), 0, 0); } while (0)
#else
#define PG8_GBASE(rs) ((const char*)(__builtin_bit_cast(u32x4, rs).x | ((unsigned long long)(__builtin_bit_cast(u32x4, rs).y & 0xffffu) << 32)))
#define PG8_STAGE(bufoff, rs, so, v0, v1) do { const char* gb_ = (&rs == &rsA ? (const char*)g.A : (const char*)g.Bt) + (so); \
        __builtin_amdgcn_global_load_lds((const unsigned*)(gb_ + (v0)), (LAS unsigned*)(lds + (bufoff) + ldsw), 16, 0, 0); \
        __builtin_amdgcn_global_load_lds((const unsigned*)(gb_ + (v1)), (LAS unsigned*)(lds + (bufoff) + ldsw + 8192), 16, 0, 0); } while (0)
#endif
#define PG8_STAGEB(bufoff, so) PG8_STAGE(bufoff, rsB, so, voffB[0], voffB[1])
#define PG8_CAT(x_, y_) __builtin_shufflevector(__builtin_bit_cast(i32x4, x_), __builtin_bit_cast(i32x4, y_), 0, 1, 2, 3, 4, 5, 6, 7)
#define PG8_LO(v_) __builtin_bit_cast(bf16x8, __builtin_shufflevector(v_, v_, 0, 1, 2, 3))
#define PG8_HI(v_) __builtin_bit_cast(bf16x8, __builtin_shufflevector(v_, v_, 4, 5, 6, 7))
#define PG8_LDA(dst, b, h) do { _Pragma("unroll") for (int m = 0; m < 4; ++m) dst[m] = PG8_CAT(*(const LAS bf16x8*)(lds + PG8_SA(b, h) + aoff + m * 2048), *(const LAS bf16x8*)(lds + PG8_SA(b, h) + aoff + m * 2048 + 1024)); } while (0)
#define PG8_LDB(dst, b, h) do { _Pragma("unroll") for (int n = 0; n < 2; ++n) dst[n] = PG8_CAT(*(const LAS bf16x8*)(lds + PG8_SB(b, h) + boff + n * 2048), *(const LAS bf16x8*)(lds + PG8_SB(b, h) + boff + n * 2048 + 1024)); } while (0)
#define PG8_MMA(ai, bj, At, Bt) do { __builtin_amdgcn_s_setprio(1); _Pragma("unroll") for (int m = 0; m < 4; ++m) _Pragma("unroll") for (int n = 0; n < 2; ++n) { \
        if constexpr (FP8) acc[ai][bj][m][n] = __builtin_amdgcn_mfma_scale_f32_16x16x128_f8f6f4(Bt[n], At[m], acc[ai][bj][m][n], 0, 0, 0, 0, 0, 0);   \
        else { acc[ai][bj][m][n] = __builtin_amdgcn_mfma_f32_16x16x32_bf16(PG8_LO(Bt[n]), PG8_LO(At[m]), acc[ai][bj][m][n], 0, 0, 0); \
               acc[ai][bj][m][n] = __builtin_amdgcn_mfma_f32_16x16x32_bf16(PG8_HI(Bt[n]), PG8_HI(At[m]), acc[ai][bj][m][n], 0, 0, 0); } } \
        __builtin_amdgcn_s_setprio(0); } while (0)
#define PG8_WAIT_V(n) asm volatile("s_waitcnt vmcnt(" #n ")" ::: "memory")
#define PG8_WAIT_L(n) asm volatile("s_waitcnt lgkmcnt(" #n ")" ::: "memory")
#define PG8_BAR __builtin_amdgcn_s_barrier()
#define PG8_SCHED __builtin_amdgcn_sched_barrier(0)
    Unit cur, nxt; int ui = 0;
    if (!S.next(0, cur)) return;
    f32x4 acc[2][2][4][2];
#pragma unroll
    for (int a = 0; a < 2; ++a)
#pragma unroll
        for (int b = 0; b < 2; ++b)
#pragma unroll
            for (int m = 0; m < 4; ++m)
#pragma unroll
                for (int n = 0; n < 2; ++n) acc[a][b][m][n] = (f32x4){0.f, 0.f, 0.f, 0.f};
    v8i At[4], B0[2], B1[2];
    unsigned voffA[2]; unsigned oc[2][2], on[2][2];
#pragma unroll
    for (int i = 0; i < 2; ++i) voffA[i] = (unsigned)(Rr[i] * g.lda * ESZ + Cc[i] * 2);
    unsigned cA, cB;
#define PG8_UNIT_PTRS(u, pA, pB, o) do { \
        pB = (unsigned)(((size_t)(g.b_gmod ? (u).g % g.b_gmod : (u).g) * g.b_gs + (size_t)(u).pn * BM * g.ldb) * ESZ); \
        if constexpr (GATHER) { \
            pA = 0u; \
            const int* ix_ = g.idx + (size_t)(u).g * g.idx_gs + (u).pm * BM; const int t_ = opaque_tid(wv); \
            _Pragma("unroll") for (int i = 0; i < 2; ++i) { int R_, C_; stage_rc(t_ * 16 + i * 8192, R_, C_); \
                _Pragma("unroll") for (int h = 0; h < 2; ++h) o[h][i] = (unsigned)ix_[h * HALF + R_] * (unsigned)(g.lda * ESZ) + (unsigned)C_ * 2u; } \
        } else { \
            pA = (unsigned)(((size_t)(u).g * g.a_gs + (size_t)(u).pm * BM * g.lda) * ESZ); \
        } } while (0)
#define PG8_STAGEA(bufoff, p, o, h) do { if constexpr (GATHER) PG8_STAGE(bufoff, rsA, p, o[h][0], o[h][1]); else PG8_STAGE(bufoff, rsA, (p) + (h) * hstepA, voffA[0], voffA[1]); } while (0)
    PG8_UNIT_PTRS(cur, cA, cB, oc);
    PG8_STAGEB(PG8_SB(0, 0), cB); PG8_STAGEB(PG8_SB(0, 1), cB + hstepB); PG8_STAGEA(PG8_SA(0, 0), cA, oc, 0); PG8_STAGEA(PG8_SA(0, 1), cA, oc, 1);
    if (wr == 1) PG8_BAR;
    PG8_WAIT_V(2); PG8_BAR;
    PG8_STAGEB(PG8_SB(1, 0), cB + kstep); PG8_STAGEA(PG8_SA(1, 0), cA + kstep, oc, 0); PG8_STAGEB(PG8_SB(1, 1), cB + hstepB + kstep);
    PG8_WAIT_V(6); PG8_BAR;
    for (;;) {
        const bool has_next = S.next(ui + 1, nxt);
        unsigned nA = cA, nB = cB;
        if constexpr (GATHER) {
#pragma unroll
            for (int h = 0; h < 2; ++h)
#pragma unroll
                for (int i = 0; i < 2; ++i) on[h][i] = oc[h][i];
        }
        if (has_next) PG8_UNIT_PTRS(nxt, nA, nB, on);
#pragma unroll 1
        for (int t = 0; t < nt; t += 2) {
            const bool last = (t == nt - 2);
            const unsigned a1 = cA + (unsigned)(t + 1) * kstep;
            const unsigned a2 = last ? nA : cA + (unsigned)(t + 2) * kstep, b2 = last ? nB : cB + (unsigned)(t + 2) * kstep;
            const unsigned a3 = a2 + kstep, b3 = b2 + kstep;
#define PG8_STAGEA2(bufoff, p, h) do { if constexpr (GATHER) { if (last) PG8_STAGEA(bufoff, p, on, h); else PG8_STAGEA(bufoff, p, oc, h); } else PG8_STAGEA(bufoff, p, oc, h); } while (0)
            PG8_LDB(B0, 0, 0); PG8_LDB(B1, 0, 1); PG8_SCHED; PG8_LDA(At, 0, 0); PG8_STAGEA(PG8_SA(1, 1), a1, oc, 1);
            PG8_WAIT_V(8); PG8_WAIT_L(0); PG8_BAR; PG8_MMA(0, 0, At, B0); PG8_MMA(0, 1, At, B1); PG8_BAR; PG8_SCHED;
            PG8_LDA(At, 0, 1); PG8_STAGEB(PG8_SB(0, 0), b2); PG8_STAGEB(PG8_SB(0, 1), b2 + hstepB); PG8_STAGEA2(PG8_SA(0, 0), a2, 0);
            PG8_WAIT_V(8); PG8_WAIT_L(0); PG8_BAR; PG8_MMA(1, 0, At, B0); PG8_MMA(1, 1, At, B1); PG8_BAR; PG8_SCHED;
            PG8_LDB(B0, 1, 0); PG8_LDB(B1, 1, 1); PG8_SCHED; PG8_LDA(At, 1, 0); PG8_STAGEA2(PG8_SA(0, 1), a2, 1);
            PG8_WAIT_V(8); PG8_WAIT_L(0); PG8_BAR; PG8_MMA(0, 0, At, B0); PG8_MMA(0, 1, At, B1); PG8_BAR; PG8_SCHED;
            PG8_LDA(At, 1, 1); PG8_STAGEB(PG8_SB(1, 0), b3); PG8_STAGEB(PG8_SB(1, 1), b3 + hstepB); PG8_STAGEA2(PG8_SA(1, 0), a3, 0);
            PG8_WAIT_V(8); PG8_WAIT_L(0); PG8_BAR; PG8_MMA(1, 0, At, B0); PG8_MMA(1, 1, At, B1); PG8_BAR; PG8_SCHED;
        }
        if (wr == 0) PG8_BAR;
        { const int l_ = opaque_tid(wv) & 63; E(acc, cur, wr, wc, l_ & 15, l_ >> 4); }
        if (!has_next) break;
#pragma unroll
        for (int a = 0; a < 2; ++a)
#pragma unroll
            for (int b = 0; b < 2; ++b)
#pragma unroll
                for (int m = 0; m < 4; ++m)
#pragma unroll
                    for (int n = 0; n < 2; ++n) acc[a][b][m][n] = (f32x4){0.f, 0.f, 0.f, 0.f};
        cur = nxt; cA = nA; cB = nB; ++ui;
        if constexpr (GATHER) {
#pragma unroll
            for (int h = 0; h < 2; ++h)
#pragma unroll
                for (int i = 0; i < 2; ++i) oc[h][i] = on[h][i];
        }
        if (wr == 1) PG8_BAR;
    }
    PG8_WAIT_V(0);
    PG8_BAR;
#undef PG8_UNIT_PTRS
#undef PG8_STAGEA
#undef PG8_STAGEA2
#undef PG8_SA
#undef PG8_SB
#undef PG8_STAGE
#undef PG8_STAGEB
#undef PG8_LDA
#undef PG8_LDB
#undef PG8_MMA
#undef PG8_CAT
#undef PG8_LO
#undef PG8_HI
#undef PG8_WAIT_V
#undef PG8_WAIT_L
#undef PG8_BAR
#undef PG8_SCHED
}

#define EPI_ROWLOOP for (int ai = 0; ai < 2; ++ai) _Pragma("unroll") for (int m = 0; m < 4; ++m)
__device__ __forceinline__ u32x4 pack8(const f32x4 v0, const f32x4 v1) { u32x4 w; w.x = cvt_pk_bf16(v0[0], v0[1]); w.y = cvt_pk_bf16(v0[2], v0[3]); w.z = cvt_pk_bf16(v1[0], v1[1]); w.w = cvt_pk_bf16(v1[2], v1[3]); return w; }
struct EpiBf16 {
    static constexpr bool PERM = true, BPRE = true;
    bf16_t* O; int ldc; float sc; int nostore;
    __device__ __forceinline__ void operator()(const f32x4 (&acc)[2][2][4][2], const Unit& u, int wr, int wc, int fr, int fq) const {
        const __amdgpu_buffer_rsrc_t rs = __builtin_amdgcn_make_buffer_rsrc((void*)O, 0, 0x7fffffff, 0x00020000);
        const unsigned lo = (unsigned)(fr * ldc + 8 * fq) * 2u, so = (unsigned)(((u.pm * BM + wr * 64) * ldc + u.pn * BM + wc * 32) * 2);
        if (nostore) return;
#pragma unroll
        EPI_ROWLOOP {
#pragma unroll
            for (int bj = 0; bj < 2; ++bj) {
#if !defined(EPI_BUF_STORES)
#if defined(EPI_NT_STORES_PROBE)
                __builtin_nontemporal_store(pack8(acc[ai][bj][m][0] * sc, acc[ai][bj][m][1] * sc), (u32x4*)((char*)O + (size_t)(so + (unsigned)((ai * HALF + m * 16) * ldc + bj * HALF) * 2u) + lo));
#else
                *(u32x4*)((char*)O + (size_t)(so + (unsigned)((ai * HALF + m * 16) * ldc + bj * HALF) * 2u) + lo) = pack8(acc[ai][bj][m][0] * sc, acc[ai][bj][m][1] * sc);
#endif
#else
                __builtin_amdgcn_raw_buffer_store_b128(pack8(acc[ai][bj][m][0] * sc, acc[ai][bj][m][1] * sc), rs, lo, so + (unsigned)((ai * HALF + m * 16) * ldc + bj * HALF) * 2u, 0);
#endif
            } }
    }
};
struct EpiP {
    static constexpr bool PERM = true, BPRE = true;
    unsigned char* P; float sc; int nostore;
    __device__ __forceinline__ void operator()(const f32x4 (&acc)[2][2][4][2], const Unit& u, int wr, int wc, int fr, int fq) const {
        if (nostore) return;
        const size_t rowb = (size_t)(u.pm * BM + wr * 64) * PROW;
#pragma unroll
        for (int bj = 0; bj < 2; ++bj) { const int c32 = u.pn * BM + bj * HALF + wc * 32; const bool f8 = p_col_f8(c32);
            char* ub = (char*)P + rowb + p_col_off(c32); const unsigned lo = (unsigned)(fr * PROW + (f8 ? 8 : 16) * fq);
#pragma unroll
            EPI_ROWLOOP { char* dst = ub + (size_t)(ai * HALF + m * 16) * PROW + lo; const f32x4 v0 = acc[ai][bj][m][0] * sc, v1 = acc[ai][bj][m][1] * sc;
                if (f8) { u32x2 o; o.x = pk4_fp8(v0[0], v0[1], v0[2], v0[3]); o.y = pk4_fp8(v1[0], v1[1], v1[2], v1[3]); *(u32x2*)dst = o; }
                else *(u32x4*)dst = pack8(v0, v1); } }
    }
};
struct EpiQ {
    static constexpr bool PERM = true, BPRE = false;
    bf16_t* QB; const float* cs;
    __device__ __forceinline__ void operator()(const f32x4 (&acc)[2][2][4][2], const Unit& u, int wr, int wc, int fr, int fq) const {
        const unsigned lo = (unsigned)(fr * 192 + 8 * fq) * 2u, lcs = (unsigned)(fr * 64 + 8 * fq) * 4u;
        const int rowU = u.pm * BM + wr * 64;
#pragma unroll
        for (int bj = 0; bj < 2; ++bj) { const int c32 = u.pn * BM + bj * HALF + wc * 32, hd = c32 / 192, w32 = c32 - hd * 192;
            char* ub = (char*)(QB + ((size_t)hd * SEQ + rowU) * 192 + w32);
            const char* cb = (const char*)(cs + (size_t)rowU * 64 + (w32 >= 128 ? (w32 - 128) : 0));
#pragma unroll
            EPI_ROWLOOP { const int rr = ai * HALF + m * 16; f32x4 v0 = acc[ai][bj][m][0], v1 = acc[ai][bj][m][1];
                if (w32 >= 128) { const f32x4 ca = *(const f32x4*)(cb + (size_t)rr * 256 + lcs), cc = *(const f32x4*)(cb + (size_t)rr * 256 + 16 + lcs);
                    const f32x4 a = v0, b = v1;
                    v0[0] = a[0] * ca[0] - a[1] * ca[1]; v0[1] = a[0] * ca[1] + a[1] * ca[0]; v0[2] = a[2] * ca[2] - a[3] * ca[3]; v0[3] = a[2] * ca[3] + a[3] * ca[2];
                    v1[0] = b[0] * cc[0] - b[1] * cc[1]; v1[1] = b[0] * cc[1] + b[1] * cc[0]; v1[2] = b[2] * cc[2] - b[3] * cc[3]; v1[3] = b[2] * cc[3] + b[3] * cc[2]; }
                *(u32x4*)(ub + (size_t)rr * 384 + lo) = pack8(v0, v1);
                if (m & 1) asm volatile("" ::: "memory"); } }
    }
};
struct EpiKV {
    static constexpr bool PERM = true, BPRE = false;
    bf16_t* KB; bf16_t* VB;
    __device__ __forceinline__ void operator()(const f32x4 (&acc)[2][2][4][2], const Unit& u, int wr, int wc, int fr, int fq) const {
        const int rowU = u.pm * BM + wr * 64;
#pragma unroll
        for (int bj = 0; bj < 2; ++bj) { const int c32 = u.pn * BM + bj * HALF + wc * 32, hd = c32 >> 8, w32 = c32 & 255; const bool isk = w32 < 128;
            const int ld = isk ? 192 : 128;
            char* ub = (char*)(isk ? KB + ((size_t)hd * SEQ + rowU) * 192 + w32 : VB + ((size_t)hd * SEQ + rowU) * 128 + (w32 - 128));
            const unsigned lo = (unsigned)(fr * ld + 8 * fq) * 2u;
#pragma unroll
            EPI_ROWLOOP { *(u32x4*)(ub + (size_t)(ai * HALF + m * 16) * ld * 2 + lo) = pack8(acc[ai][bj][m][0], acc[ai][bj][m][1]); } }
    }
};
struct EpiQ8 {
    static constexpr bool PERM = true, BPRE = false;
    unsigned char* Q8; const float* cs;
    __device__ __forceinline__ void operator()(const f32x4 (&acc)[2][2][4][2], const Unit& u, int wr, int wc, int fr, int fq) const {
        const unsigned lo = (unsigned)(fr * 192 + 8 * fq), lcs = (unsigned)(fr * 64 + 8 * fq) * 4u;
        const int rowU = u.pm * BM + wr * 64;
#pragma unroll
        for (int bj = 0; bj < 2; ++bj) { const int c32 = u.pn * BM + bj * HALF + wc * 32, hd = c32 / 192, w32 = c32 - hd * 192;
            char* ub = (char*)(Q8 + ((size_t)hd * SEQ + rowU) * 192 + w32);
            const char* cb = (const char*)(cs + (size_t)rowU * 64 + (w32 >= 128 ? (w32 - 128) : 0));
#pragma unroll
            EPI_ROWLOOP { const int rr = ai * HALF + m * 16; f32x4 v0 = acc[ai][bj][m][0], v1 = acc[ai][bj][m][1];
                if (w32 >= 128) { const f32x4 ca = *(const f32x4*)(cb + (size_t)rr * 256 + lcs), cc = *(const f32x4*)(cb + (size_t)rr * 256 + 16 + lcs);
                    const f32x4 a = v0, b = v1;
                    v0[0] = a[0] * ca[0] - a[1] * ca[1]; v0[1] = a[0] * ca[1] + a[1] * ca[0]; v0[2] = a[2] * ca[2] - a[3] * ca[3]; v0[3] = a[2] * ca[3] + a[3] * ca[2];
                    v1[0] = b[0] * cc[0] - b[1] * cc[1]; v1[1] = b[0] * cc[1] + b[1] * cc[0]; v1[2] = b[2] * cc[2] - b[3] * cc[3]; v1[3] = b[2] * cc[3] + b[3] * cc[2]; }
                v0 = v0 * QK_LOG2_SCALE; v1 = v1 * QK_LOG2_SCALE;
                u32x2 o; o.x = pk4_fp8(v0[0], v0[1], v0[2], v0[3]); o.y = pk4_fp8(v1[0], v1[1], v1[2], v1[3]);
                *(u32x2*)(ub + (size_t)rr * 192 + lo) = o;
                if (m & 1) asm volatile("" ::: "memory"); } }
    }
};
struct EpiK8 {
    static constexpr bool PERM = true, BPRE = false;
    unsigned char* K8;
    __device__ __forceinline__ void operator()(const f32x4 (&acc)[2][2][4][2], const Unit& u, int wr, int wc, int fr, int fq) const {
        const int rowU = u.pm * BM + wr * 64; const unsigned lo = (unsigned)(fr * 192 + 8 * fq);
#pragma unroll
        for (int bj = 0; bj < 2; ++bj) { const int c32 = u.pn * BM + bj * HALF + wc * 32, hd = c32 >> 7, w32 = c32 & 127;
            char* ub = (char*)(K8 + ((size_t)hd * SEQ + rowU) * 192 + w32);
#pragma unroll
            EPI_ROWLOOP { const f32x4 v0 = acc[ai][bj][m][0], v1 = acc[ai][bj][m][1];
                u32x2 o; o.x = pk4_fp8(v0[0], v0[1], v0[2], v0[3]); o.y = pk4_fp8(v1[0], v1[1], v1[2], v1[3]);
                *(u32x2*)(ub + (size_t)(ai * HALF + m * 16) * 192 + lo) = o; } }
    }
};
struct EpiVT8 {
    static constexpr bool PERM = true, BPRE = false;
    unsigned char* VT8;
    __device__ __forceinline__ void operator()(const f32x4 (&acc)[2][2][4][2], const Unit& u, int wr, int wc, int fr, int fq) const {
#pragma unroll
        for (int bj = 0; bj < 2; ++bj) { const int T0 = u.pn * BM + bj * HALF + wc * 32 + 8 * fq, tile = T0 >> 6, G0 = (T0 & 63) >> 2, half = G0 >> 3, a = (G0 & 7) >> 1;
            const int p0 = 4 * (4 * half + a), p1 = 4 * (8 + 4 * half + a);
#pragma unroll
            EPI_ROWLOOP { const int r = u.pm * BM + ai * HALF + wr * 64 + m * 16 + fr, hd = r >> 7, col = r & 127;
                unsigned char* dst = VT8 + (((size_t)hd * (SEQ / 64) + tile) * 128 + col) * 64;
                const f32x4 v0 = acc[ai][bj][m][0], v1 = acc[ai][bj][m][1];
                *(unsigned*)(dst + p0) = pk4_fp8(v0[0], v0[1], v0[2], v0[3]); *(unsigned*)(dst + p1) = pk4_fp8(v1[0], v1[1], v1[2], v1[3]); } }
    }
};
struct EpiRes {
    static constexpr bool PERM = false, BPRE = false;
    const float* x; float* out; const float* mod; float sc;
    __device__ __forceinline__ void operator()(const f32x4 (&acc)[2][2][4][2], const Unit& u, int wr, int wc, int fr, int fq) const {
        const int col0 = u.pn * BM + wc * 32 + 4 * fq;
        const int b = (u.pm * BM) / SEQ;
        f32x4 gt[2][2];
#pragma unroll
        for (int bj = 0; bj < 2; ++bj)
#pragma unroll
            for (int n = 0; n < 2; ++n) gt[bj][n] = *(const f32x4*)(mod + b * 6144 + 2048 + col0 + bj * HALF + n * 16) * sc;
        const unsigned lo = (unsigned)(fr * DM + 4 * fq) * 4u;
        const size_t ubo = ((size_t)(u.pm * BM + wr * 64) * DM + u.pn * BM + wc * 32) * 4;
#pragma unroll
        EPI_ROWLOOP { const size_t ro = ubo + (size_t)(ai * HALF + m * 16) * DM * 4;
#pragma unroll
            for (int bj = 0; bj < 2; ++bj)
#pragma unroll
                for (int n = 0; n < 2; ++n) { const size_t o = ro + (bj * HALF + n * 16) * 4; const f32x4 xv = *(const f32x4*)((const char*)x + o + lo);
                    *(f32x4*)((char*)out + o + lo) = xv + gt[bj][n] * acc[ai][bj][m][n]; }
            if (m & 1) asm volatile("" ::: "memory"); }
    }
};
struct EpiSwiGLU {
    static constexpr bool PERM = true, BPRE = true;
    void* HID; float sc;
    __device__ __forceinline__ void operator()(const f32x4 (&acc)[2][2][4][2], const Unit& u, int wr, int wc, int fr, int fq) const {
        constexpr int HE = FP8_EX ? 1 : 2;
        const __amdgpu_buffer_rsrc_t rs = __builtin_amdgcn_make_buffer_rsrc(HID, 0, 0x7fffffff, 0x00020000);
        const unsigned lo = (unsigned)(fr * DFF + 4 * fq) * HE, so = (unsigned)(((u.g * CAP + u.pm * BM + wr * 64) * DFF + ((u.pn * BM + wc * 32) >> 1)) * HE);
#pragma unroll
        EPI_ROWLOOP {
#pragma unroll
            for (int bj = 0; bj < 2; ++bj) { const f32x4 gv = acc[ai][bj][m][0] * sc, uv = acc[ai][bj][m][1] * sc; f32x4 h;
#pragma unroll
                for (int e = 0; e < 4; ++e) h[e] = gv[e] * fast_sigmoid(gv[e]) * uv[e];
                const unsigned ro = so + (unsigned)((ai * HALF + m * 16) * DFF + bj * (HALF / 2)) * HE;
#if !defined(EPI_BUF_STORES)
                if constexpr (FP8_EX) *(unsigned*)((char*)HID + (size_t)ro + lo) = pk4_fp8(h[0], h[1], h[2], h[3]);
                else { u32x2 o; o.x = cvt_pk_bf16(h[0], h[1]); o.y = cvt_pk_bf16(h[2], h[3]); *(u32x2*)((char*)HID + (size_t)ro + lo) = o; }
#else
                if constexpr (FP8_EX) __builtin_amdgcn_raw_buffer_store_b32(pk4_fp8(h[0], h[1], h[2], h[3]), rs, lo, ro, 0);
                else { u32x2 o; o.x = cvt_pk_bf16(h[0], h[1]); o.y = cvt_pk_bf16(h[2], h[3]); __builtin_amdgcn_raw_buffer_store_b64(o, rs, lo, ro, 0); }
#endif
            } }
    }
};
struct EpiDown {
    static constexpr bool PERM = true, BPRE = true;
    bf16_t* Y; const float* gate; float sc;
    __device__ __forceinline__ void operator()(const f32x4 (&acc)[2][2][4][2], const Unit& u, int wr, int wc, int fr, int fq) const {
        const int rowU = u.g * CAP + u.pm * BM + wr * 64;
        const __amdgpu_buffer_rsrc_t rs = __builtin_amdgcn_make_buffer_rsrc((void*)Y, 0, 0x7fffffff, 0x00020000), rg = __builtin_amdgcn_make_buffer_rsrc((void*)gate, 0, 0x7fffffff, 0x00020000);
        const unsigned lo = (unsigned)(fr * DM + 8 * fq) * 2u, so = (unsigned)((rowU * DM + u.pn * BM + wc * 32) * 2);
#pragma unroll
        EPI_ROWLOOP { const int rr = ai * HALF + m * 16;
#if !defined(EPI_BUF_STORES)
            const float gs = gate[rowU + rr + fr] * sc;
#pragma unroll
            for (int bj = 0; bj < 2; ++bj) *(u32x4*)((char*)Y + (size_t)(so + (unsigned)(rr * DM + bj * HALF) * 2u) + lo) = pack8(acc[ai][bj][m][0] * gs, acc[ai][bj][m][1] * gs);
#else
            const float gs = __uint_as_float(__builtin_amdgcn_raw_buffer_load_b32(rg, (unsigned)fr * 4u, (unsigned)(rowU + rr) * 4u, 0)) * sc;
#pragma unroll
            for (int bj = 0; bj < 2; ++bj) __builtin_amdgcn_raw_buffer_store_b128(pack8(acc[ai][bj][m][0] * gs, acc[ai][bj][m][1] * gs), rs, lo, so + (unsigned)(rr * DM + bj * HALF) * 2u, 0);
#endif
        }
    }
};
#undef EPI_ROWLOOP
}
namespace att {
__device__ __forceinline__ int crow(int r, int hi) { return (r & 3) + 8 * (r >> 2) + 4 * hi; }
__device__ __forceinline__ int v_st(int k, int c) { const int kk = (k & ~0xC) | ((k & 4) << 1) | ((k & 8) >> 1); return ((kk >> 3) * 4 + (c >> 5)) * 512 + ((kk & 7) * 32 + (c & 31)) * 2; }
__device__ __forceinline__ int v_rd_base(int lane) { return ((lane & 3) << 3) | (((lane >> 2) & 3) << 6) | (((lane >> 4) & 1) << 5) | (((lane >> 5) & 1) << 8); }
constexpr int v_rd_off(int d0, int ks, int half) { return d0 * 512 + ks * 4096 + half * 2048; }
template <int OFF> __device__ __forceinline__ s16x4 tr_read(int vb) {
    s16x4 r; asm volatile("ds_read_b64_tr_b16 %0, %1 offset:%2" : "=&v"(r) : "v"(vb), "i"(OFF) : "memory"); return r;
}
#define ATT_SBAR() __builtin_amdgcn_sched_barrier(0)
template <int D0> __device__ __forceinline__ void pv_one(f32x16& od, int vb, bf16x8 pa0, bf16x8 pa1, bf16x8 pa2, bf16x8 pa3) {
    const s16x4 l0 = tr_read<v_rd_off(D0, 0, 0)>(vb), h0 = tr_read<v_rd_off(D0, 0, 1)>(vb), l1 = tr_read<v_rd_off(D0, 1, 0)>(vb), h1 = tr_read<v_rd_off(D0, 1, 1)>(vb);
    const s16x4 l2 = tr_read<v_rd_off(D0, 2, 0)>(vb), h2 = tr_read<v_rd_off(D0, 2, 1)>(vb), l3 = tr_read<v_rd_off(D0, 3, 0)>(vb), h3 = tr_read<v_rd_off(D0, 3, 1)>(vb);
    asm volatile("s_waitcnt lgkmcnt(0)" ::: "memory"); ATT_SBAR();
#define ATT_PK(L, H) (bf16x8){L[0], L[1], L[2], L[3], H[0], H[1], H[2], H[3]}
    od = __builtin_amdgcn_mfma_f32_32x32x16_bf16(pa0, ATT_PK(l0, h0), od, 0, 0, 0);
    od = __builtin_amdgcn_mfma_f32_32x32x16_bf16(pa1, ATT_PK(l1, h1), od, 0, 0, 0);
    od = __builtin_amdgcn_mfma_f32_32x32x16_bf16(pa2, ATT_PK(l2, h2), od, 0, 0, 0);
    od = __builtin_amdgcn_mfma_f32_32x32x16_bf16(pa3, ATT_PK(l3, h3), od, 0, 0, 0);
#undef ATT_PK
}
__device__ __forceinline__ void pv_d0(f32x16* o, int vb, bf16x8 pa0, bf16x8 pa1, bf16x8 pa2, bf16x8 pa3) {
    pv_one<0>(o[0], vb, pa0, pa1, pa2, pa3); pv_one<1>(o[1], vb, pa0, pa1, pa2, pa3); pv_one<2>(o[2], vb, pa0, pa1, pa2, pa3); pv_one<3>(o[3], vb, pa0, pa1, pa2, pa3);
}
__device__ __forceinline__ void finishSM(f32x16& p0, f32x16& p1, float alpha, float& l_reg, bf16x8& pa0, bf16x8& pa1, bf16x8& pa2, bf16x8& pa3) {
#pragma unroll
    for (int r = 0; r < 16; ++r) p1[r] = __builtin_amdgcn_exp2f(p1[r]);
    float ps = 0;
#pragma unroll
    for (int r = 0; r < 16; ++r) ps += p0[r];
#pragma unroll
    for (int r = 0; r < 16; ++r) ps += p1[r];
    { auto rr = __builtin_amdgcn_permlane32_swap(__float_as_uint(ps), __float_as_uint(ps), false, false);
      ps = __uint_as_float(rr[0]) + __uint_as_float(rr[1]); }
    l_reg = l_reg * alpha + ps;
#define ATT_PK4(P, BASE, OUT) do { unsigned a0 = cvt_pk_bf16(P[BASE + 0], P[BASE + 1]), a1 = cvt_pk_bf16(P[BASE + 2], P[BASE + 3]);   \
    unsigned b0 = cvt_pk_bf16(P[BASE + 4], P[BASE + 5]), b1 = cvt_pk_bf16(P[BASE + 6], P[BASE + 7]);                              \
    auto r0 = __builtin_amdgcn_permlane32_swap(a0, b0, false, false); auto r1 = __builtin_amdgcn_permlane32_swap(a1, b1, false, false); \
    u32x4 w = {r0[0], r1[0], r0[1], r1[1]}; OUT = *reinterpret_cast<bf16x8*>(&w); } while (0)
    ATT_PK4(p0, 0, pa0); ATT_PK4(p0, 8, pa1); ATT_PK4(p1, 0, pa2); ATT_PK4(p1, 8, pa3);
#undef ATT_PK4
}

struct Unit {
    const bf16_t* Q; int qs;
    const bf16_t* K; int ks;
    const bf16_t* V; int vs;
    bf16_t* O; int os;
    int nt;
    int tmul;
    float* dbg;
    const float* lutg;
    int kt0, ktn;
    int l0;
    const int* pos; int ps;
    float* lse; int ls;
    const float* bias;
};

template <bool DIL> struct Cfg {
    static constexpr bool K8 = DIL && (DIL_FP8 != 0);
    static constexpr int DQK = DIL ? 128 : 192, ND = K8 ? 4 : DQK / 16, KROWB = (K8 ? DQK : DQK * 2) + 16, SHM_K = 64 * KROWB, SHM_V = 16384;
    static constexpr int NKC = DQK / 64;
    static constexpr int OFF_V = 0, OFF_K = 2 * SHM_V, OFF_WS = (OFF_K + 2 * SHM_K > 8 * 8448 ? OFF_K + 2 * SHM_K : 8 * 8448)  , OFF_POS = OFF_WS + NWAVES * 64 * 4, OFF_LUT = OFF_POS + 2 * 64 * 4, END = OFF_LUT + 9216;
    static constexpr float SCALE = DIL ? 0.088388347648318440f : 0.072168783648703220f;
};

template <bool DIL>
__device__ __forceinline__ void qkt(f32x16& p0, f32x16& p1, const LAS char* Ks, const bf16x8* qr, int r32, int hi) {
    using C = Cfg<DIL>;
    p0 = f32x16{}; p1 = f32x16{};
    const LAS char* k0 = Ks + r32 * C::KROWB + hi * 16; const LAS char* k1 = k0 + 32 * C::KROWB;
#pragma unroll
    for (int d0 = 0; d0 < C::ND; ++d0) {
        const bf16x8 b0 = *(const LAS bf16x8*)(k0 + d0 * 32);
        const bf16x8 b1 = *(const LAS bf16x8*)(k1 + d0 * 32);
        p0 = __builtin_amdgcn_mfma_f32_32x32x16_bf16(b0, qr[d0], p0, 0, 0, 0);
        p1 = __builtin_amdgcn_mfma_f32_32x32x16_bf16(b1, qr[d0], p1, 0, 0, 0); }
}

template <bool DIL>
__device__ __forceinline__ void xstage(bool pv, bool qk, f32x16* o, int vb, bf16x8 pa0, bf16x8 pa1, bf16x8 pa2, bf16x8 pa3, f32x16& p0, f32x16& p1, const LAS char* Ks, const bf16x8* qr, int r32, int hi) {
    using C = Cfg<DIL>;
    constexpr int NG = C::ND / 2;
    const LAS char* k0 = Ks + r32 * C::KROWB + hi * (C::K8 ? 32 : 16);
    bf16x8 f[2][4];
    const int ka = (int)(unsigned)(size_t)k0;
#define ATT_KR1(dst_, off_) asm volatile("ds_read_b128 %0, %1 offset:%2" : "=&v"(dst_) : "v"(ka), "i"(off_) : "memory")
#define ATT_KRD(s_, g_) do { if constexpr (C::K8) { ATT_KR1(f[s_][0], 64 * (g_)); ATT_KR1(f[s_][1], 64 * (g_) + 16); ATT_KR1(f[s_][2], 32 * C::KROWB + 64 * (g_)); ATT_KR1(f[s_][3], 32 * C::KROWB + 64 * (g_) + 16); } \
        else { ATT_KR1(f[s_][0], (2 * (g_)) * 32); ATT_KR1(f[s_][1], 32 * C::KROWB + (2 * (g_)) * 32); ATT_KR1(f[s_][2], (2 * (g_) + 1) * 32); ATT_KR1(f[s_][3], 32 * C::KROWB + (2 * (g_) + 1) * 32); } } while (0)
#define ATT_PK(L, H) (bf16x8){L[0], L[1], L[2], L[3], H[0], H[1], H[2], H[3]}
#define ATT_VRD1(B_, s_, ks_) do { const s16x4 l_ = tr_read<v_rd_off(B_, ks_, 0)>(vb), h_ = tr_read<v_rd_off(B_, ks_, 1)>(vb); f[s_][ks_] = ATT_PK(l_, h_); } while (0)
#define ATT_VRD(B_, s_) do { ATT_VRD1(B_, s_, 0); ATT_VRD1(B_, s_, 1); ATT_VRD1(B_, s_, 2); ATT_VRD1(B_, s_, 3); } while (0)
#define ATT_VMMA(B_, s_) do { o[B_] = __builtin_amdgcn_mfma_f32_32x32x16_bf16(pa0, f[s_][0], o[B_], 0, 0, 0); o[B_] = __builtin_amdgcn_mfma_f32_32x32x16_bf16(pa1, f[s_][1], o[B_], 0, 0, 0); \
        o[B_] = __builtin_amdgcn_mfma_f32_32x32x16_bf16(pa2, f[s_][2], o[B_], 0, 0, 0); o[B_] = __builtin_amdgcn_mfma_f32_32x32x16_bf16(pa3, f[s_][3], o[B_], 0, 0, 0); } while (0)
#define ATT_LW(n) asm volatile("s_waitcnt lgkmcnt(" #n ")" ::: "memory")
    if (pv) {
        ATT_VRD(0, 0); ATT_SBAR();
        ATT_VRD(1, 1); ATT_LW(8); ATT_SBAR(); ATT_VMMA(0, 0); ATT_SBAR();
        ATT_VRD(2, 0); ATT_LW(8); ATT_SBAR(); ATT_VMMA(1, 1); ATT_SBAR();
        ATT_VRD(3, 1); ATT_LW(8); ATT_SBAR(); ATT_VMMA(2, 0); ATT_SBAR();
        ATT_KRD(0, 0); ATT_LW(4); ATT_SBAR(); ATT_VMMA(3, 1); ATT_SBAR();
    } else { ATT_KRD(0, 0); ATT_SBAR(); }
    if (!qk) { ATT_LW(0); return; }
    p0 = f32x16{}; p1 = f32x16{};
    if constexpr (C::K8) {
#define ATT_CAT(x_, y_) __builtin_shufflevector(__builtin_bit_cast(i32x4, x_), __builtin_bit_cast(i32x4, y_), 0, 1, 2, 3, 4, 5, 6, 7)
        ATT_KRD(1, 1); ATT_LW(4); ATT_SBAR();
        p0 = __builtin_amdgcn_mfma_scale_f32_32x32x64_f8f6f4(ATT_CAT(f[0][0], f[0][1]), ATT_CAT(qr[0], qr[1]), p0, 0, 0, 0, 0, 0, 0);
        p1 = __builtin_amdgcn_mfma_scale_f32_32x32x64_f8f6f4(ATT_CAT(f[0][2], f[0][3]), ATT_CAT(qr[0], qr[1]), p1, 0, 0, 0, 0, 0, 0);
        ATT_SBAR(); ATT_LW(0); ATT_SBAR();
        p0 = __builtin_amdgcn_mfma_scale_f32_32x32x64_f8f6f4(ATT_CAT(f[1][0], f[1][1]), ATT_CAT(qr[2], qr[3]), p0, 0, 0, 0, 0, 0, 0);
        p1 = __builtin_amdgcn_mfma_scale_f32_32x32x64_f8f6f4(ATT_CAT(f[1][2], f[1][3]), ATT_CAT(qr[2], qr[3]), p1, 0, 0, 0, 0, 0, 0);
        ATT_SBAR();
#undef ATT_CAT
    } else {
#pragma unroll
    for (int g = 0; g < NG; ++g) { const int sg = g & 1;
        if (g + 1 < NG) { ATT_KRD(sg ^ 1, g + 1); ATT_LW(4); } else { ATT_LW(0); }
        ATT_SBAR();
        p0 = __builtin_amdgcn_mfma_f32_32x32x16_bf16(f[sg][0], qr[2 * g], p0, 0, 0, 0);
        p1 = __builtin_amdgcn_mfma_f32_32x32x16_bf16(f[sg][1], qr[2 * g], p1, 0, 0, 0);
        p0 = __builtin_amdgcn_mfma_f32_32x32x16_bf16(f[sg][2], qr[2 * g + 1], p0, 0, 0, 0);
        p1 = __builtin_amdgcn_mfma_f32_32x32x16_bf16(f[sg][3], qr[2 * g + 1], p1, 0, 0, 0);
        ATT_SBAR(); } }
#undef ATT_VRD1
#undef ATT_KRD
#undef ATT_KR1
#undef ATT_VRD
#undef ATT_PK
#undef ATT_VMMA
#undef ATT_LW
}

template <bool DIL>
__device__ __forceinline__ void partialSM(f32x16& p0, f32x16& p1, float& m_reg, float& mn, float& alpha,
                                          const LAS int* posb, int qoff, int lutlo, int dl0, bool masked, int hi) {
    using C = Cfg<DIL>;
    constexpr float CC = C::SCALE * LOG2E;
    constexpr float THR = 8.f;
    float mnC;
    if constexpr (DIL) {
        const LAS float* lutp = (const LAS float*)(size_t)(unsigned)lutlo;
#define ATT_LUT(pk_) ({ int u_ = (pk_) + qoff; u_ = u_ < 0 ? 0 : (u_ > 2048 ? 2048 : u_); lutp[u_ + (u_ >> 5)]; })
        float bz0[16], bz1[16];
#pragma unroll
        for (int a = 0; a < 4; ++a) {
            const i32x4 pk0 = *(const LAS i32x4*)(posb + 8 * a + 4 * hi), pk1 = *(const LAS i32x4*)(posb + 32 + 8 * a + 4 * hi);
#pragma unroll
            for (int b = 0; b < 4; ++b) { bz0[4 * a + b] = ATT_LUT(pk0[b]); bz1[4 * a + b] = ATT_LUT(pk1[b]); }
        }
        ATT_SBAR();
        if (masked) {
#pragma unroll
            for (int r = 0; r < 16; ++r) { const int dl = dl0 + 8 * (r >> 2) + (r & 3);
                p0[r] = ((unsigned)(dl + 64) <= 128u) ? fmaf(p0[r], CC, bz0[r]) : -1e30f;
                p1[r] = ((unsigned)(dl + 32 + 64) <= 128u) ? fmaf(p1[r], CC, bz1[r]) : -1e30f; }
        } else {
#pragma unroll
            for (int r = 0; r < 16; ++r) { p0[r] = fmaf(p0[r], CC, bz0[r]); p1[r] = fmaf(p1[r], CC, bz1[r]); }
        }
#undef ATT_LUT
        float pmax = p0[0];
#pragma unroll
        for (int r = 1; r < 16; ++r) pmax = fmaxf(pmax, p0[r]);
#pragma unroll
        for (int r = 0; r < 16; ++r) pmax = fmaxf(pmax, p1[r]);
        { auto rr = __builtin_amdgcn_permlane32_swap(__float_as_uint(pmax), __float_as_uint(pmax), false, false);
          pmax = fmaxf(__uint_as_float(rr[0]), __uint_as_float(rr[1])); }
        if (__builtin_expect(__all(pmax - m_reg <= THR * LOG2E), 1)) { mn = m_reg; alpha = 1.f; }
        else { mn = fmaxf(m_reg, pmax); alpha = __builtin_amdgcn_exp2f(m_reg - mn); m_reg = mn; }
        mnC = -fmaxf(mn, -1e29f);
#pragma unroll
        for (int r = 0; r < 16; ++r) p0[r] = p0[r] + mnC;
#pragma unroll
        for (int r = 0; r < 16; ++r) p1[r] = p1[r] + mnC;
    } else {
        float pmax = p0[0];
#pragma unroll
        for (int r = 1; r < 16; ++r) pmax = fmaxf(pmax, p0[r]);
#pragma unroll
        for (int r = 0; r < 16; ++r) pmax = fmaxf(pmax, p1[r]);
        { auto rr = __builtin_amdgcn_permlane32_swap(__float_as_uint(pmax), __float_as_uint(pmax), false, false);
          pmax = fmaxf(__uint_as_float(rr[0]), __uint_as_float(rr[1])); }
        if (__builtin_expect(__all(pmax - m_reg <= THR / C::SCALE), 1)) { mn = m_reg; alpha = 1.f; }
        else { mn = fmaxf(m_reg, pmax); alpha = __builtin_amdgcn_exp2f((m_reg - mn) * CC); m_reg = mn; }
        mnC = -mn * CC;
#pragma unroll
        for (int r = 0; r < 16; ++r) p0[r] = fmaf(p0[r], CC, mnC);
#pragma unroll
        for (int r = 0; r < 16; ++r) p1[r] = fmaf(p1[r], CC, mnC);
    }
#pragma unroll
    for (int r = 0; r < 16; ++r) p0[r] = __builtin_amdgcn_exp2f(p0[r]);
}

__device__ __forceinline__ int t5_bucket(int rel) {
    const int n = rel < 0 ? -rel : rel;
    const float nf = (float)(n > 1 ? n : 1);
    int large = 8 + (int)(logf(nf / 8.f) / 4.852030263919617f * 8.f);
    large = large < 15 ? large : 15;
    return (rel > 0 ? 16 : 0) + (n < 8 ? n : large);
}

template <bool DIL>
__device__ __forceinline__ void attn_unit(const Unit& a, LAS char* lds, int wv) {
    using C = Cfg<DIL>;
    constexpr int SD = 1;
    const int tid = opaque_tid(wv), wid = __builtin_amdgcn_readfirstlane(tid >> 6), lane = tid & 63, r32 = lane & 31, hi = lane >> 5;
#if defined(PROBE_TIMING)
    const unsigned long long t_entry = __builtin_amdgcn_s_memtime();
#endif
    LAS char* V_lds = lds + C::OFF_V; LAS char* K_lds = lds + C::OFF_K;
    LAS float* ws = (LAS float*)(lds + C::OFF_WS) + wid * 64; LAS float* li_l = ws; LAS float* al_l = ws + 32;
    LAS int* pos_l = (LAS int*)(lds + C::OFF_POS); LAS float* lut = (LAS float*)(lds + C::OFF_LUT);
    float m_reg = -1e30f, l_reg = 0; f32x16 o[4] = {}; bf16x8 qr[C::ND];
    if constexpr (C::K8) { const char* Qw = (const char*)(a.Q + (size_t)(wid * 32 + r32) * a.qs) + hi * 32;
#pragma unroll
      for (int i = 0; i < 4; ++i) qr[i] = *(const bf16x8*)(Qw + 64 * (i >> 1) + 16 * (i & 1)); }
    else { const bf16_t* Qw = a.Q + (size_t)(wid * 32 + r32) * a.qs + hi * 8;
#pragma unroll
      for (int d0 = 0; d0 < C::ND; ++d0) qr[d0] = *(const bf16x8*)(Qw + d0 * 16); }
    int pq = 0, lq = 0;
    if constexpr (DIL) {
        lq = a.l0 + wid * 32 + r32; pq = a.pos[(size_t)lq * a.ps];
        pq = 1024 - pq;
        { const char* ls = (const char*)a.lutg + lane * 16; LAS char* ld = (LAS char*)lut;
          __builtin_amdgcn_global_load_lds((const unsigned*)(ls + wid * 1024), (LAS unsigned*)(ld + wid * 1024), 16, 0, 0);
          if (wid == 0) __builtin_amdgcn_global_load_lds((const unsigned*)(ls + 8192), (LAS unsigned*)(ld + 8192), 16, 0, 0); }
    }
    constexpr int CPR = C::KROWB / 16, NKP = C::SHM_K / 1024, NKI = (NKP + 7) / 8;
    unsigned kgo[NKI];
#pragma unroll
    for (int i = 0; i < NKI; ++i) { const int pch = (wid + 8 * i) * 64 + lane, kr = pch / CPR, kc = pch % CPR; kgo[i] = (unsigned)(kr * a.ks + (kc == CPR - 1 ? 0 : kc) * 8) * 2u; }
    unsigned vgo[2];
#pragma unroll
    for (int i = 0; i < 2; ++i) { const int pch = (wid + 8 * i) * 64 + lane, sub = pch >> 5, within = pch & 31, kk = (sub >> 2) * 8 + (within >> 2), cc = (sub & 3) * 32 + (within & 3) * 8;
        const int k = (kk & ~0xC) | ((kk & 4) << 1) | ((kk & 8) >> 1); vgo[i] = (unsigned)(k * a.vs + cc) * 2u; }
    const int vb0 = (int)(unsigned)(size_t)V_lds + v_rd_base(lane);
    int ppos = 0, ppos_n = 0;
#define ATT_KROW0(j) (DIL ? (((a.kt0 + (j)) < 0 ? 0 : ((a.kt0 + (j)) >= a.ktn ? a.ktn - 1 : (a.kt0 + (j)))) * 64) : (j) * 64 * a.tmul)
#define ATT_DMAK(j) do { const int k0_ = ATT_KROW0(j); const char* kt_ = (const char*)(a.K + (size_t)k0_ * a.ks); LAS char* kd_ = K_lds + ((j) & 1) * C::SHM_K + wid * 1024; \
        _Pragma("unroll") for (int q_ = 0; q_ < NKI; ++q_) if (wid + 8 * q_ < NKP) \
            __builtin_amdgcn_global_load_lds((const unsigned*)(kt_ + kgo[q_]), (LAS unsigned*)(kd_ + q_ * 8192), 16, 0, 0); } while (0)
#define ATT_DMAV(j) do { const int k0_ = ATT_KROW0(j); const char* vt_ = (const char*)(a.V + (size_t)k0_ * a.vs); LAS char* vd_ = V_lds + ((j) & 1) * C::SHM_V + wid * 1024; \
        __builtin_amdgcn_global_load_lds((const unsigned*)(vt_ + vgo[0]), (LAS unsigned*)(vd_), 16, 0, 0); \
        __builtin_amdgcn_global_load_lds((const unsigned*)(vt_ + vgo[1]), (LAS unsigned*)(vd_ + 8192), 16, 0, 0); } while (0)
#define ATT_LOADPOS(dst_, j) do { if constexpr (DIL) { if (tid < 64) dst_ = a.pos[(size_t)(ATT_KROW0(j) + tid) * a.ps]; } } while (0)
#define ATT_WRITEPOS(j) do { if constexpr (DIL) { if (tid < 64) pos_l[((j) & 1) * 64 + tid] = ppos; } } while (0)
#define ATT_VMW() asm volatile("s_waitcnt vmcnt(0)" ::: "memory")
#define ATT_BAR() do { asm volatile("s_waitcnt lgkmcnt(0)" ::: "memory"); __builtin_amdgcn_s_barrier(); asm volatile("" ::: "memory"); } while (0)
#define ATT_RESC(al) do { if (__any((al) < 1.f)) { if (hi == 0) al_l[r32] = (al); asm volatile("s_waitcnt lgkmcnt(0)" ::: "memory"); \
        _Pragma("unroll") for (int d = 0; d < 4; ++d) _Pragma("unroll") for (int r = 0; r < 16; ++r) o[d][r] *= al_l[crow(r, hi)]; } } while (0)
#define ATT_DL0(j) (DIL ? (ATT_TV(j) ? (64 * (a.kt0 + (j)) - lq + 4 * hi) : 0x20000000) : 0)
#define ATT_TV(j) (DIL ? ((a.kt0 + (j)) >= 0 && (a.kt0 + (j)) < a.ktn) : true)
#define ATT_MASKED(j) (DIL ? ((j) != (wid >> 1) + 1) : false)
    f32x16 p0, p1; float mn, al; bf16x8 pa0, pa1, pa2, pa3; const int NT = a.nt;
    const bool grpB = wid >= 4;
    ATT_DMAK(0); ATT_DMAK(1); ATT_DMAV(0); ATT_LOADPOS(ppos, 0); ATT_VMW(); ATT_WRITEPOS(0); ATT_LOADPOS(ppos, 1);
    __syncthreads();
    if (grpB) ATT_BAR();
#if defined(PROBE_TIMING)
    unsigned long long tacc = 0, tt0 = 0; const unsigned long long tstart = __builtin_amdgcn_s_memtime(), rstart = __builtin_amdgcn_s_memrealtime();
#define TSTAMP() __builtin_amdgcn_s_memtime()
#else
#define TSTAMP() 0ull
#endif
#pragma unroll 1
    for (int j = 0; j < NT; ++j) {
        const int cur = j & 1;
#if defined(PROBE_TIMING)
        tt0 = TSTAMP();
#endif
        if (!grpB && j >= 1) { if (j + 1 < NT) ATT_DMAK(j + 1); ATT_DMAV(j); }
        if constexpr (DIL) { if (!grpB && j + 2 < NT) ATT_LOADPOS(ppos_n, j + 2); }
        ATT_SBAR();
        const bool act = !DIL || (j >= (wid >> 1) && j <= (wid >> 1) + 2), actp = !DIL || (j - 1 >= (wid >> 1) && j - 1 <= (wid >> 1) + 2);
        xstage<DIL>(j > 0 && actp, act, o, vb0 + (cur ^ 1) * (int)C::SHM_V, pa0, pa1, pa2, pa3, p0, p1, K_lds + cur * C::SHM_K, qr, r32, hi);
        ATT_SBAR();
#if defined(PROBE_TIMING) && PROBE_TIMING == 2
        tacc += TSTAMP() - tt0;
#endif
#if defined(PROBE_TIMING) && PROBE_TIMING == 6
        tt0 = TSTAMP();
#endif
        if (grpB) ATT_VMW();
#if defined(PROBE_TIMING) && PROBE_TIMING == 6
        tacc += TSTAMP() - tt0;
#endif
#if defined(PROBE_TIMING) && PROBE_TIMING == 5
        tt0 = TSTAMP();
#endif
        ATT_BAR();
#if defined(PROBE_TIMING) && PROBE_TIMING == 5
        tacc += TSTAMP() - tt0;
#endif
#if defined(PROBE_TIMING) && PROBE_TIMING == 3
        tt0 = TSTAMP();
#endif
        if (grpB) { if (j + 2 < NT) ATT_DMAK(j + 2); if (j + 1 < NT) ATT_DMAV(j + 1); }
        if (act) {
        partialSM<DIL>(p0, p1, m_reg, mn, al, pos_l + cur * 64, pq, (int)(unsigned)(size_t)lut, ATT_DL0(j), ATT_MASKED(j), hi);
        ATT_RESC(al);
        finishSM(p0, p1, al, l_reg, pa0, pa1, pa2, pa3);
        }
        if constexpr (DIL) { if (!grpB && j + 1 < NT) { ATT_WRITEPOS(j + 1); ppos = ppos_n; } }
        ATT_SBAR();
#if defined(PROBE_TIMING) && PROBE_TIMING == 3
        tacc += TSTAMP() - tt0;
#endif
#if defined(PROBE_TIMING) && PROBE_TIMING == 6
        tt0 = TSTAMP();
#endif
        if (!grpB) ATT_VMW();
#if defined(PROBE_TIMING) && PROBE_TIMING == 6
        tacc += TSTAMP() - tt0;
#endif
        ATT_BAR();
    }
#if defined(PROBE_TIMING)
    if (DIL && a.dbg && tid == PROBE_TID && PROBE_TIMING == 8) *a.dbg = (float)(TSTAMP() - tstart) * 1e-6f;
    if (a.dbg && tid == PROBE_TID && PROBE_TIMING < 7) { const unsigned long long tend = TSTAMP(), rend = __builtin_amdgcn_s_memrealtime(); float v;
        if (PROBE_TIMING == 1) v = (float)(tend - tstart) / (float)NT * 1e-5f;
        else if (PROBE_TIMING == 4) v = (float)(tend - tstart) / (float)(rend - rstart) * 1e-3f;
        else v = (float)tacc / (float)NT * 1e-5f;
        *a.dbg = v; }
#endif
    if (!DIL || (NT - 1 <= (wid >> 1) + 2)) pv_d0(o, vb0 + ((NT - 1) & 1) * (int)C::SHM_V, pa0, pa1, pa2, pa3);
    if (!grpB) ATT_BAR();
    ATT_BAR();
    if (hi == 0) li_l[r32] = l_reg; asm volatile("s_waitcnt lgkmcnt(0)" ::: "memory");
    { LAS char* ot = lds + wid * 8448;
#pragma unroll
      for (int r = 0; r < 16; ++r) { const int orow = crow(r, hi); const float rl = __builtin_amdgcn_rcpf(li_l[orow]);
#pragma unroll
          for (int d0 = 0; d0 < 4; ++d0) { const float v = o[d0][r] * rl; *(LAS bf16_t*)(ot + orow * 264 + (d0 * 32 + r32) * 2) = (bf16_t)(cvt_pk_bf16(v, v) & 0xffffu); } }
      asm volatile("s_waitcnt lgkmcnt(0)" ::: "memory");
      char* Ow = (char*)(a.O + (size_t)(wid * 32) * a.os);
      const int orow0 = lane >> 4, ocol = (lane & 15) * 16;
#pragma unroll
      for (int i = 0; i < 8; ++i) { const int orow = orow0 + 4 * i; const u32x2 w0 = *(const LAS u32x2*)(ot + orow * 264 + ocol), w1 = *(const LAS u32x2*)(ot + orow * 264 + ocol + 8);
          u32x4 w; w.x = w0.x; w.y = w0.y; w.z = w1.x; w.w = w1.y;
          *(u32x4*)(Ow + (size_t)orow * a.os * 2 + ocol) = w; } }
    if constexpr (DIL) { if (hi == 0) a.lse[(size_t)(wid * 32 + r32) * a.ls] = m_reg + __builtin_amdgcn_logf(l_reg); }
    __syncthreads();
#if defined(PROBE_TIMING)
    if (DIL && a.dbg && tid == PROBE_TID && PROBE_TIMING == 7) *a.dbg = (float)(__builtin_amdgcn_s_memtime() - t_entry) * 1e-6f;
#endif
#undef ATT_KROW0
#undef ATT_BAR
#undef ATT_DMAK
#undef ATT_DMAV
#undef ATT_LOADPOS
#undef ATT_WRITEPOS
#undef ATT_VMW
#undef ATT_RESC
#undef ATT_DL0
#undef ATT_TV
#undef ATT_MASKED
}
struct Unit8 { const unsigned char* Q; const unsigned char* K; const unsigned char* VT; bf16_t* O; int os, nt; float* dbg; };
__device__ __forceinline__ v8i ld32(const LAS char* p) { return __builtin_shufflevector(*(const LAS i32x4*)p, *(const LAS i32x4*)(p + 16), 0, 1, 2, 3, 4, 5, 6, 7); }
#define ATT8_MFMA(a_, b_, c_) __builtin_amdgcn_mfma_scale_f32_32x32x64_f8f6f4(a_, b_, c_, 0, 0, 0, 0, 0, 0)
__device__ __forceinline__ void attn_mla8_unit(const Unit8& a, LAS char* lds, int wv) {
    constexpr int KROWB = 208, SHM_K = 64 * KROWB  , VROWB = 80, SHM_V = 128 * VROWB  , NKP = 13, NVP = 10;
    constexpr int NSLOT = MLA_2T ? 4 : 3;
    constexpr int OFF_V = 0, OFF_K = NSLOT * SHM_V, OFF_WS = OFF_K + NSLOT * SHM_K;
    static_assert(OFF_WS + 8 * 64 * 4 <= RING_BYTES, "rings and per-wave words inside the ring area");
    static_assert(!(MLA_2T && MLA_PRE), "the fragment prefetch is written for the one-tile interval");
    static_assert(8 * 8448 <= OFF_WS, "output staging images below the per-wave words");
    constexpr float THR2 = 5.0f * LOG2E;
    const int tid = opaque_tid(wv), wid = __builtin_amdgcn_readfirstlane(tid >> 6), lane = tid & 63, r32 = lane & 31, hi = lane >> 5;
    LAS char* V_lds = lds + OFF_V; LAS char* K_lds = lds + OFF_K;
    LAS float* li_l = (LAS float*)(lds + OFF_WS) + wid * 64; LAS float* al_l = li_l + 32;
    float m2 = 0.f, l_reg = 0.f; f32x16 o[4] = {}; v8i qr[3];
    { const unsigned char* Qw = a.Q + (size_t)(wid * 32 + r32) * 192 + hi * 32;
#pragma unroll
      for (int c = 0; c < 3; ++c) qr[c] = __builtin_shufflevector(*(const i32x4*)(Qw + 64 * c), *(const i32x4*)(Qw + 64 * c + 16), 0, 1, 2, 3, 4, 5, 6, 7); }
    unsigned kgo[2], vgo[2];
#pragma unroll
    for (int i = 0; i < 2; ++i) { const int p = (wid + 8 * i) * 64 + lane, kr = p / 13, kc = p % 13; kgo[i] = (unsigned)(kr * 192 + (kc == 12 ? 0 : kc) * 16);
        const int vr = p / 5, vc = p % 5; vgo[i] = (unsigned)(vr * 64 + (vc == 4 ? 0 : vc) * 16); }
#define ATT8_DMAK(j, slot) do { const char* kt_ = (const char*)a.K + (size_t)(j) * 64 * 192; LAS char* kd_ = K_lds + (slot) * SHM_K + wid * 1024; \
        __builtin_amdgcn_global_load_lds((const unsigned*)(kt_ + kgo[0]), (LAS unsigned*)(kd_), 16, 0, 0); \
        if (wid + 8 < NKP) __builtin_amdgcn_global_load_lds((const unsigned*)(kt_ + kgo[1]), (LAS unsigned*)(kd_ + 8192), 16, 0, 0); } while (0)
#define ATT8_DMAV(j, slot) do { const char* vt_ = (const char*)a.VT + (size_t)(j) * 8192; LAS char* vd_ = V_lds + (slot) * SHM_V + wid * 1024; \
        __builtin_amdgcn_global_load_lds((const unsigned*)(vt_ + vgo[0]), (LAS unsigned*)(vd_), 16, 0, 0); \
        if (wid + 8 < NVP) __builtin_amdgcn_global_load_lds((const unsigned*)(vt_ + vgo[1]), (LAS unsigned*)(vd_ + 8192), 16, 0, 0); } while (0)
#define ATT8_VMW() asm volatile("s_waitcnt vmcnt(0)" ::: "memory")
#define ATT8_BAR() do { asm volatile("s_waitcnt lgkmcnt(0)" ::: "memory"); __builtin_amdgcn_s_barrier(); asm volatile("" ::: "memory"); } while (0)
#define ATT8_RD(dst_, addr_, off_) do { i32x4 lo_, hi_; asm volatile("ds_read_b128 %0, %1 offset:%2" : "=&v"(lo_) : "v"(addr_), "i"(off_) : "memory"); \
        asm volatile("ds_read_b128 %0, %1 offset:%2" : "=&v"(hi_) : "v"(addr_), "i"((off_) + 16) : "memory"); dst_ = __builtin_shufflevector(lo_, hi_, 0, 1, 2, 3, 4, 5, 6, 7); } while (0)
#define ATT8_LW(n) asm volatile("s_waitcnt lgkmcnt(" #n ")" ::: "memory")
    const int koff = r32 * KROWB + hi * 32, voff = r32 * VROWB + hi * 32;
    f32x16 p0, p1, nm16; v8i pa = {}; const int NT = a.nt;
#if MLA_LSUM
    f32x16 lacc = {}; v8i ones8; { int c_ = 0x38383838; asm volatile("" : "+v"(c_)); _Pragma("unroll") for (int i = 0; i < 8; ++i) ones8[i] = c_; }
#endif
    const bool grpB = wid >= 4;
    ATT8_DMAK(0, 0); ATT8_DMAK(1, 1); ATT8_DMAV(0, 0); ATT8_VMW();
    __syncthreads();
    int s0 = 0, s1 = 1, s2 = 2;
#define ATT8_ISSUE() do { if (j + 2 < NT) ATT8_DMAK(j + 2, s2); if (j + 1 < NT) ATT8_DMAV(j + 1, s1); } while (0)
#define ATT8_QK6(kb_, G0_, G1_, G2_, C0_, C1_) do { \
        ATT8_RD(G2_, kb_, 64); ATT8_LW(4); ATT_SBAR(); p0 = ATT8_MFMA(G0_, qr[0], C0_); ATT_SBAR(); \
        ATT8_RD(G0_, kb_, 32 * KROWB + 64); ATT8_LW(4); ATT_SBAR(); p1 = ATT8_MFMA(G1_, qr[0], C1_); ATT_SBAR(); \
        ATT8_RD(G1_, kb_, 128); ATT8_LW(4); ATT_SBAR(); p0 = ATT8_MFMA(G2_, qr[1], p0); ATT_SBAR(); \
        ATT8_RD(G2_, kb_, 32 * KROWB + 128); ATT8_LW(4); ATT_SBAR(); p1 = ATT8_MFMA(G0_, qr[1], p1); ATT_SBAR(); \
        ATT8_LW(2); ATT_SBAR(); p0 = ATT8_MFMA(G1_, qr[2], p0); ATT_SBAR(); \
        ATT8_LW(0); ATT_SBAR(); p1 = ATT8_MFMA(G2_, qr[2], p1); ATT_SBAR(); } while (0)
#if MLA_PKOLD
#define ATT8_PK4(w_, P_, q_) do { w_ = __builtin_amdgcn_cvt_pk_fp8_f32(P_[4 * (q_)], P_[4 * (q_) + 1], w_, false); w_ = __builtin_amdgcn_cvt_pk_fp8_f32(P_[4 * (q_) + 2], P_[4 * (q_) + 3], w_, true); } while (0)
#else
#define ATT8_PK4(w_, P_, q_) do { w_ = (int)pk4_fp8(P_[4 * (q_)], P_[4 * (q_) + 1], P_[4 * (q_) + 2], P_[4 * (q_) + 3]); } while (0)
#endif
#define ATT8_PACK() do { _Pragma("unroll") for (int q = 0; q < 4; ++q) { ATT8_PK4(pa[q], p0, q); ATT8_PK4(pa[4 + q], p1, q); } } while (0)
#define ATT8_PAIR(P_, i_) (f32x2){P_[2 * (i_)], P_[2 * (i_) + 1]}
#if MLA_PKADD
#define ATT8_SUM32(ps_) f32x2 pp_ = ATT8_PAIR(p0, 0); _Pragma("unroll") for (int r = 1; r < 8; ++r) pp_ += ATT8_PAIR(p0, r); _Pragma("unroll") for (int r = 0; r < 8; ++r) pp_ += ATT8_PAIR(p1, r); float ps_ = pp_[0] + pp_[1]
#else
#define ATT8_SUM32(ps_) float ps_ = 0.f; _Pragma("unroll") for (int r = 0; r < 16; ++r) ps_ += p0[r]; _Pragma("unroll") for (int r = 0; r < 16; ++r) ps_ += p1[r]
#endif
#if MLA_LSUM
#define ATT8_ROWSUM(al_) do { } while (0)
#define ATT8_LMFMA() lacc = ATT8_MFMA(pa, ones8, lacc)
#define ATT8_LRESC() do { _Pragma("unroll") for (int r = 0; r < 16; ++r) lacc[r] *= al_l[crow(r, hi)]; } while (0)
#else
#define ATT8_LMFMA() do { } while (0)
#define ATT8_LRESC() do { } while (0)
#define ATT8_ROWSUM(al_) do { ATT8_SUM32(ps_); \
        { auto rr = __builtin_amdgcn_permlane32_swap(__float_as_uint(ps_), __float_as_uint(ps_), false, false); ps_ = __uint_as_float(rr[0]) + __uint_as_float(rr[1]); } l_reg = l_reg * (al_) + ps_; } while (0)
#endif
#if MLA_NM16
#define ATT8_INIT() do { const float nm_ = -m2; _Pragma("unroll") for (int r = 0; r < 16; ++r) nm16[r] = nm_; } while (0)
#define ATT8_INIT_SLOW() nm16 -= dl
#define ATT8_INIT_TILE() do { } while (0)
#define ATT8_C0 nm16
#define ATT8_C1 nm16
#else
#define ATT8_INIT() do { } while (0)
#define ATT8_INIT_SLOW() do { } while (0)
#define ATT8_INIT_TILE() do { const float nm_ = -m2; _Pragma("unroll") for (int r = 0; r < 16; ++r) { p0[r] = nm_; p1[r] = nm_; } } while (0)
#define ATT8_C0 p0
#define ATT8_C1 p1
#endif
#define ATT8_ROWMAX(pm_) do { pm_ = p0[0]; _Pragma("unroll") for (int r = 1; r < 16; ++r) pm_ = fmaxf(pm_, p0[r]); _Pragma("unroll") for (int r = 0; r < 16; ++r) pm_ = fmaxf(pm_, p1[r]); \
        { auto rr = __builtin_amdgcn_permlane32_swap(__float_as_uint(pm_), __float_as_uint(pm_), false, false); pm_ = fmaxf(__uint_as_float(rr[0]), __uint_as_float(rr[1])); } } while (0)
#define ATT8_X0() ATT8_X0_(s0)
#define ATT8_X() ATT8_X_(s0, s2)
#define ATT8_X0_(ks_) do { const int kb = (int)(unsigned)(size_t)(K_lds + (ks_) * SHM_K + koff); v8i g0, g1, g2; ATT8_RD(g0, kb, 0); ATT8_RD(g1, kb, 32 * KROWB); ATT8_QK6(kb, g0, g1, g2, f32x16{}, f32x16{}); } while (0)
#if MLA_PRE
#define ATT8_XPRE(vs_) do { const int vb = (int)(unsigned)(size_t)(V_lds + (vs_) * SHM_V + voff); ATT8_RD(g0, vb, 0); ATT8_RD(g1, vb, 32 * VROWB); } while (0)
#define ATT8_XHEAD() do { } while (0)
    v8i g0, g1;
#define ATT8_XDECL() v8i g2
#else
#define ATT8_XPRE(vs_) do { } while (0)
#define ATT8_XHEAD() do { ATT8_RD(g0, vb, 0); ATT8_RD(g1, vb, 32 * VROWB); } while (0)
#define ATT8_XDECL() v8i g0, g1, g2
#endif
#define ATT8_X_(ks_, vs_) do { const int vb = (int)(unsigned)(size_t)(V_lds + (vs_) * SHM_V + voff), kb = (int)(unsigned)(size_t)(K_lds + (ks_) * SHM_K + koff); ATT8_XDECL(); \
        ATT8_XM(); ATT8_XHEAD(); ATT_SBAR(); \
        ATT8_RD(g2, vb, 64 * VROWB); ATT8_LW(4); ATT_SBAR(); o[0] = ATT8_MFMA(pa, g0, o[0]); ATT_SBAR(); \
        ATT8_RD(g0, vb, 96 * VROWB); ATT8_LW(4); ATT_SBAR(); o[1] = ATT8_MFMA(pa, g1, o[1]); ATT_SBAR(); \
        ATT8_RD(g1, kb, 0); ATT8_LW(4); ATT_SBAR(); o[2] = ATT8_MFMA(pa, g2, o[2]); ATT_SBAR(); \
        ATT8_RD(g2, kb, 32 * KROWB); ATT8_LW(4); ATT_SBAR(); o[3] = ATT8_MFMA(pa, g0, o[3]); ATT8_LMFMA(); ATT_SBAR(); \
        ATT8_QK6(kb, g1, g2, g0, ATT8_C0, ATT8_C1); ATT8_XM_END(); } while (0)
#define ATT8_S0() do { float pmax; ATT8_ROWMAX(pmax); m2 = pmax; \
        _Pragma("unroll") for (int r = 0; r < 16; ++r) { p0[r] = __builtin_amdgcn_exp2f(p0[r] - m2); p1[r] = __builtin_amdgcn_exp2f(p1[r] - m2); } \
        ATT8_ROWSUM(1.f); ATT8_PACK(); ATT8_INIT(); ATT8_INIT_TILE(); } while (0)
#if defined(MLA_XVALU)
#define ATT8_XV() do { _Pragma("unroll") for (int r = 0; r < MLA_XVALU; ++r) { float d_; asm volatile("v_exp_f32 %0, %1" : "=v"(d_) : "v"(p0[r & 15])); } } while (0)
#elif defined(MLA_XADD)
#define ATT8_XV() do { _Pragma("unroll") for (int r = 0; r < MLA_XADD; ++r) { float d_; asm volatile("v_add_f32 %0, %1, %1" : "=v"(d_) : "v"(p0[r & 15])); } } while (0)
#else
#define ATT8_XV() do { } while (0)
#endif
#if defined(MLA_XMFMA)
#define ATT8_XM() f32x16 dacc_ = ATT8_MFMA(qr[0], qr[1], f32x16{}); _Pragma("unroll") for (int r = 1; r < MLA_XMFMA; ++r) dacc_ = ATT8_MFMA(qr[0], qr[1], dacc_)
#define ATT8_XM_END() asm volatile("" :: "v"(dacc_))
#else
#define ATT8_XM() do { } while (0)
#define ATT8_XM_END() do { } while (0)
#endif
#define ATT8_S() do { float pmax, al = 1.f; ATT8_XV(); ATT8_ROWMAX(pmax); \
        if (__builtin_expect(!__all(pmax <= THR2), 0)) { \
            const float dl = fmaxf(pmax, 0.f); al = __builtin_amdgcn_exp2f(-dl); m2 += dl; \
            if (hi == 0) al_l[r32] = al; asm volatile("s_waitcnt lgkmcnt(0)" ::: "memory"); \
            _Pragma("unroll") for (int d = 0; d < 4; ++d) _Pragma("unroll") for (int r = 0; r < 16; ++r) o[d][r] *= al_l[crow(r, hi)]; ATT8_LRESC(); \
            _Pragma("unroll") for (int r = 0; r < 16; ++r) { p0[r] -= dl; p1[r] -= dl; } ATT8_INIT_SLOW(); } \
        _Pragma("unroll") for (int r = 0; r < 16; ++r) { p0[r] = __builtin_amdgcn_exp2f(p0[r]); p1[r] = __builtin_amdgcn_exp2f(p1[r]); } \
        ATT8_ROWSUM(al); ATT8_PACK(); ATT8_INIT_TILE(); } while (0)
#define ATT8_ROT() do { const int t_ = s0; s0 = s1; s1 = s2; s2 = t_; } while (0)
#if defined(PROBE_TIMING)
    const unsigned long long tstart8 = __builtin_amdgcn_s_memtime(), rstart8 = __builtin_amdgcn_s_memrealtime(); __builtin_amdgcn_s_waitcnt(0xC07F);
#endif
#if MLA_2T
#define ATT8_ISSUE2(i_) do { const int t_ = 2 * (i_); if (t_ + 2 < NT) { ATT8_DMAK(t_ + 2, (t_ + 2) & 3); ATT8_DMAK(t_ + 3, (t_ + 3) & 3); ATT8_DMAV(t_ + 2, (t_ + 2) & 3); } ATT8_DMAV(t_ + 1, (t_ + 1) & 3); } while (0)
    if (!grpB) {
        { ATT8_ISSUE2(0); ATT_SBAR(); ATT8_X0_(0); ATT_SBAR(); ATT8_S0(); ATT_SBAR(); }
#pragma unroll 1
        for (int j = 1; j < NT; ++j) { if (!(j & 1)) ATT8_ISSUE2(j >> 1); ATT_SBAR(); ATT8_X_(j & 3, (j - 1) & 3); ATT_SBAR(); ATT8_S(); ATT_SBAR(); if (j & 1) { ATT8_VMW(); ATT8_BAR(); } }
    } else {
        { ATT8_ISSUE2(0); ATT_SBAR(); ATT8_X0_(0); ATT_SBAR(); ATT8_S0(); ATT_SBAR(); ATT8_X_(1, 0); ATT_SBAR(); ATT8_VMW(); ATT8_BAR(); }
#pragma unroll 1
        for (int j = 2; j < NT; ++j) { if (!(j & 1)) ATT8_ISSUE2(j >> 1); ATT_SBAR(); ATT8_S(); ATT_SBAR(); ATT8_X_(j & 3, (j - 1) & 3); ATT_SBAR(); if (j & 1) { ATT8_VMW(); ATT8_BAR(); } }
        ATT8_S();
    }
    s2 = (NT - 1) & 3;
#undef ATT8_ISSUE2
#else
    if (!grpB) {
        { const int j = 0; ATT8_ISSUE(); ATT_SBAR(); ATT8_X0(); ATT_SBAR(); ATT8_S0(); ATT_SBAR(); ATT8_XPRE(s0); ATT8_VMW(); ATT8_BAR(); ATT8_ROT(); }
#pragma unroll 1
        for (int j = 1; j < NT; ++j) { ATT8_ISSUE(); ATT_SBAR(); ATT8_X(); ATT_SBAR(); ATT8_S(); ATT_SBAR(); if (j + 1 < NT) ATT8_XPRE(s0); ATT8_VMW(); ATT8_BAR(); ATT8_ROT(); }
    } else {
        { const int j = 0; ATT8_ISSUE(); ATT_SBAR(); ATT8_X0(); ATT_SBAR(); ATT8_VMW(); ATT8_BAR(); ATT8_ROT(); }
        { const int j = 1; ATT8_ISSUE(); ATT8_XPRE(s2); ATT_SBAR(); ATT8_S0(); ATT_SBAR(); ATT8_X(); ATT_SBAR(); ATT8_VMW(); ATT8_BAR(); ATT8_ROT(); }
#pragma unroll 1
        for (int j = 2; j < NT; ++j) { ATT8_ISSUE(); ATT8_XPRE(s2); ATT_SBAR(); ATT8_S(); ATT_SBAR(); ATT8_X(); ATT_SBAR(); ATT8_VMW(); ATT8_BAR(); ATT8_ROT(); }
        ATT8_S();
    }
#endif
#if defined(PROBE_TIMING)
    if (a.dbg && tid == PROBE_TID) { const unsigned long long tend = __builtin_amdgcn_s_memtime(), rend = __builtin_amdgcn_s_memrealtime();
        *a.dbg = PROBE_TIMING == 4 ? __builtin_floorf(((float)(tend - tstart8) / (float)(rend - rstart8) + PROBE_QOFF) * 0.25f) * 4e-2f
                                   : __builtin_rintf((float)(tend - tstart8) / (float)NT * (1.f / 256.f)) * 256e-4f; }
#endif
    { const LAS char* vb = V_lds + s2 * SHM_V + voff;
      o[0] = ATT8_MFMA(pa, ld32(vb), o[0]); o[1] = ATT8_MFMA(pa, ld32(vb + 32 * VROWB), o[1]); o[2] = ATT8_MFMA(pa, ld32(vb + 64 * VROWB), o[2]); o[3] = ATT8_MFMA(pa, ld32(vb + 96 * VROWB), o[3]); ATT8_LMFMA(); }
    ATT8_BAR();
#if !MLA_LSUM
    if (hi == 0) li_l[r32] = l_reg; asm volatile("s_waitcnt lgkmcnt(0)" ::: "memory");
#endif
    { LAS char* ot = lds + wid * 8448;
#pragma unroll
      for (int r = 0; r < 16; ++r) { const int orow = crow(r, hi);
#if MLA_LSUM
          const float rl = __builtin_amdgcn_rcpf(lacc[r]);
#else
          const float rl = __builtin_amdgcn_rcpf(li_l[orow]);
#endif
#pragma unroll
          for (int d0 = 0; d0 < 4; ++d0) { const float v = o[d0][r] * rl; *(LAS bf16_t*)(ot + orow * 264 + (d0 * 32 + r32) * 2) = (bf16_t)(cvt_pk_bf16(v, v) & 0xffffu); } }
      asm volatile("s_waitcnt lgkmcnt(0)" ::: "memory");
      char* Ow = (char*)(a.O + (size_t)(wid * 32) * a.os);
      const int orow0 = lane >> 4, ocol = (lane & 15) * 16;
#pragma unroll
      for (int i = 0; i < 8; ++i) { const int orow = orow0 + 4 * i; const u32x2 w0 = *(const LAS u32x2*)(ot + orow * 264 + ocol), w1 = *(const LAS u32x2*)(ot + orow * 264 + ocol + 8);
          u32x4 w; w.x = w0.x; w.y = w0.y; w.z = w1.x; w.w = w1.y;
          *(u32x4*)(Ow + (size_t)orow * a.os * 2 + ocol) = w; } }
    __syncthreads();
#undef ATT8_DMAK
#undef ATT8_DMAV
#undef ATT8_VMW
#undef ATT8_BAR
#undef ATT8_RD
#undef ATT8_LW
#undef ATT8_ISSUE
#undef ATT8_QK6
#undef ATT8_PACK
#undef ATT8_ROWMAX
#undef ATT8_ROT
#undef ATT8_S
#undef ATT8_S0
#undef ATT8_X
#undef ATT8_X0
#undef ATT8_XPRE
#undef ATT8_XHEAD
#undef ATT8_XDECL
#undef ATT8_X0_
#undef ATT8_X_
#undef ATT8_ROWSUM
#undef ATT8_LMFMA
#undef ATT8_LRESC
#undef ATT8_SUM32
#undef ATT8_INIT_SLOW
#undef ATT8_INIT_TILE
#undef ATT8_C0
#undef ATT8_C1
#undef ATT8_PAIR
#undef ATT8_PK4
#undef ATT8_INIT
}
}
#if defined(MK_CHECK) && MK_CHECK
#ifndef CHK_XOR_ROW
#define CHK_XOR_ROW 0
#endif
namespace chk {
__device__ __forceinline__ float f8(const void* base, size_t idx) { return __builtin_amdgcn_cvt_f32_fp8((int)((const unsigned char*)base)[idx], 0); }
__device__ __forceinline__ float ldQK(const bf16_t* B, int hd, int t, int w) {
    return MLA_FP8 ? f8(B, ((size_t)hd * SEQ + t) * 192 + w) : bf2f(B[((size_t)hd * SEQ + t) * 192 + w]); }
__device__ __forceinline__ float ldV(const bf16_t* B, int hd, int t, int c) {
    if (!MLA_FP8) return bf2f(B[((size_t)hd * SEQ + t) * 128 + c]);
    const int k = t & 63, half = k >> 5, kp = k & 31, kg = (kp >> 2) & 1, r = (kp & 3) + 4 * (kp >> 3), e = r + 16 * half;
    return f8(B, (((size_t)hd * (SEQ / 64) + (t >> 6)) * 128 + c) * 64 + 32 * kg + e); }

__device__ __forceinline__ unsigned hash32(unsigned x) { x ^= x >> 16; x *= 0x7feb352du; x ^= x >> 15; x *= 0x846ca68bu; x ^= x >> 16; return x; }
__device__ __forceinline__ void flag(unsigned* ctl, int bit) { atomicOr(ctl + CW_DBG, 1u << bit); }
__device__ __forceinline__ bool bad_l2(float err2, float ref2, float tol) { err2 = wave_sum(err2); ref2 = wave_sum(ref2); return !(err2 <= tol * tol * ref2 + 1e-12f); }
__device__ __forceinline__ void ref_cos_sin(int pos, int j, float& c, float& s) {
    const float inv = powf(10000.0f, -(float)(2 * j) / 64.0f); const float ang = (float)pos * inv;
    c = (float)cos((double)ang); s = (float)sin((double)ang);
}
__device__ __forceinline__ int ref_bucket(int rel) {
    int ret = rel > 0 ? 16 : 0; int n = rel < 0 ? -rel : rel; float nf = (float)(n < 1 ? 1 : n);
    float v = logf(nf / 8.0f) / 4.852030263919617f * 8.0f; int large = 8 + (int)v; if (large > 15) large = 15;
    return ret + (n < 8 ? n : large);
}
__device__ __forceinline__ void check_proj(const Frame& F, int b, unsigned* ctl, const bf16_t* P, const bf16_t* CQN, const bf16_t* CKVN, const bf16_t* QB, const bf16_t* KB, const bf16_t* VB,
                                           const float* gq, const float* gkv, const float* w_uq, const float* w_ukv, const int* positions) {
    const int lane = opaque_tid(F.wave) & 63;
    for (int smp = F.gw; smp < 4096; smp += F.NGW) {
        const unsigned hsh = hash32(smp * 2654435761u + b * 97u + 12345u);
        const int t = hsh % SEQ, hd = (hsh >> 13) & 7, kind = smp & 3;
        const bf16_t* pr = (const bf16_t*)((const char*)P + (size_t)t * PROW);
        if (kind == 0) {
            float ss = 0.f; for (int k = lane; k < 384; k += 64) { const float v = bf2f(pr[C_CQ + k]); ss += v * v; }
            const float rq = 1.0f / sqrtf(wave_sum(ss) / 384.f + NORM_EPS); float e2 = 0.f, r2 = 0.f;
            for (int k = lane; k < 384; k += 64) { const float ref = bf2f(pr[C_CQ + k]) * rq * gq[k], got = bf2f(CQN[(size_t)t * 384 + k]); e2 += (ref - got) * (ref - got); r2 += ref * ref; }
            if (bad_l2(e2, r2, 0.01f)) flag(ctl, 0);
            ss = 0.f; for (int k = lane; k < 256; k += 64) { const float v = bf2f(pr[C_CKV + k]); ss += v * v; }
            const float rk = 1.0f / sqrtf(wave_sum(ss) / 256.f + NORM_EPS); e2 = 0.f; r2 = 0.f;
            for (int k = lane; k < 256; k += 64) { const float ref = bf2f(pr[C_CKV + k]) * rk * gkv[k], got = bf2f(CKVN[(size_t)t * 256 + k]); e2 += (ref - got) * (ref - got); r2 += ref * ref; }
            if (bad_l2(e2, r2, 0.01f)) flag(ctl, 0);
        } else if (kind == 1) {
            float q[3] = {0.f, 0.f, 0.f};
            for (int k = 0; k < 384; ++k) { const float a = bf2f(CQN[(size_t)t * 384 + k]);
#pragma unroll
                for (int i = 0; i < 3; ++i) q[i] += a * w_uq[(size_t)k * 1536 + hd * 192 + lane + 64 * i]; }
            if (MLA_FP8) { q[0] *= QK_LOG2_SCALE; q[1] *= QK_LOG2_SCALE; q[2] *= QK_LOG2_SCALE; }
            float e2 = 0.f, r2 = 0.f;
#pragma unroll
            for (int i = 0; i < 2; ++i) { const float got = ldQK(QB, hd, t, lane + 64 * i); e2 += (q[i] - got) * (q[i] - got); r2 += q[i] * q[i]; }
            float other; { auto rr = __builtin_amdgcn_permlane32_swap(__float_as_uint(q[2]), __float_as_uint(q[2]), false, false); other = lane < 32 ? __uint_as_float(rr[1]) : __uint_as_float(rr[0]); } float c, s; ref_cos_sin(positions[(size_t)b * SEQ + t], lane & 31, c, s);
            const float x1 = lane < 32 ? q[2] : other, x2 = lane < 32 ? other : q[2];
            const float ref = lane < 32 ? x1 * c - x2 * s : x1 * s + x2 * c;
            const float got = ldQK(QB, hd, t, 128 + 2 * (lane & 31) + (lane >> 5)); e2 += (ref - got) * (ref - got); r2 += ref * ref;
            if (bad_l2(e2, r2, MLA_FP8 ? 0.06f : 0.015f)) flag(ctl, 1);
        } else if (kind == 2) {
            float kk[2] = {0.f, 0.f};
            for (int k = 0; k < 256; ++k) { const float a = bf2f(CKVN[(size_t)t * 256 + k]); kk[0] += a * w_ukv[(size_t)k * 2048 + hd * 256 + lane]; kk[1] += a * w_ukv[(size_t)k * 2048 + hd * 256 + 64 + lane]; }
            float e2 = 0.f, r2 = 0.f;
#pragma unroll
            for (int i = 0; i < 2; ++i) { const float got = ldQK(KB, hd, t, lane + 64 * i); e2 += (kk[i] - got) * (kk[i] - got); r2 += kk[i] * kk[i]; }
            float c, s; ref_cos_sin(positions[(size_t)b * SEQ + t], lane & 31, c, s);
            const float x1 = bf2f(pr[C_KPE + (lane & 31)]), x2 = bf2f(pr[C_KPE + 32 + (lane & 31)]);
            const float ref = lane < 32 ? x1 * c - x2 * s : x1 * s + x2 * c;
            const float got = ldQK(KB, hd, t, 128 + 2 * (lane & 31) + (lane >> 5)); e2 += (ref - got) * (ref - got); r2 += ref * ref;
            if (bad_l2(e2, r2, MLA_FP8 ? 0.06f : 0.015f)) flag(ctl, 2);
        } else {
            float vv[2] = {0.f, 0.f};
            for (int k = 0; k < 256; ++k) { const float a = bf2f(CKVN[(size_t)t * 256 + k]); vv[0] += a * w_ukv[(size_t)k * 2048 + hd * 256 + 128 + lane]; vv[1] += a * w_ukv[(size_t)k * 2048 + hd * 256 + 192 + lane]; }
            float e2 = 0.f, r2 = 0.f;
#pragma unroll
            for (int i = 0; i < 2; ++i) { const float got = ldV(VB, hd, t, lane + 64 * i); e2 += (vv[i] - got) * (vv[i] - got); r2 += vv[i] * vv[i]; }
            if (bad_l2(e2, r2, MLA_FP8 ? 0.06f : 0.015f)) flag(ctl, 3);
        }
    }
}
__device__ __forceinline__ void check_mla(const Frame& F, int b, unsigned* ctl, const bf16_t* QB, const bf16_t* KB, const bf16_t* VB, const bf16_t* OA) {
    const int tid = opaque_tid(F.wave), lane = tid & 63, wave = tid >> 6;
    LAS float* qf = (LAS float*)F.lds;
    LAS float* red = qf + 192;
    LAS float* pp = red + 64;
    LAS float* oacc = pp + SEQ;
    const unsigned hsh = hash32(blockIdx.x * 40503u + b * 977u + 777u);
    const int t = hsh % SEQ, hd = (hsh >> 13) & 7;
#if defined(FORCE_FLAG)
    if (blockIdx.x == 100 && tid == 5 && b == 2) flag(ctl, FORCE_FLAG);
#endif
    __syncthreads();
    if (tid < 192) qf[tid] = ldQK(QB, hd, t, tid);
    __syncthreads();
    float mx = -1e30f;
    for (int k = tid; k < SEQ; k += 512) { float s = 0.f;
        for (int d = 0; d < 192; ++d) s += qf[d] * ldQK(KB, hd, k, d);
        s *= MLA_FP8 ? 0.6931471805599453f : 0.07216878364870322f; pp[k] = s; mx = fmaxf(mx, s); }
    mx = wave_max(mx);
    if (lane == 0) red[wave] = mx;
    __syncthreads();
    mx = red[0]; for (int w = 1; w < 8; ++w) mx = fmaxf(mx, red[w]);
    __syncthreads();
    float sm = 0.f;
    for (int k = tid; k < SEQ; k += 512) { const float p = expf(pp[k] - mx); pp[k] = p; sm += p; }
    sm = wave_sum(sm); if (lane == 0) red[wave] = sm;
    __syncthreads();
    sm = 0.f; for (int w = 0; w < 8; ++w) sm += red[w];
    const int c = tid & 127, part = tid >> 7; float acc = 0.f;
    for (int k = part * 2048; k < part * 2048 + 2048; ++k) acc += pp[k] * ldV(VB, hd, k, c);
    oacc[part * 128 + c] = acc;
    __syncthreads();
    if (tid < 64) { float e2 = 0.f, r2 = 0.f;
#pragma unroll
        for (int i = 0; i < 2; ++i) { const int cc = tid + 64 * i; const float ref = (oacc[cc] + oacc[128 + cc] + oacc[256 + cc] + oacc[384 + cc]) / sm, got = bf2f(OA[(size_t)(t ^ CHK_XOR_ROW) * DM + hd * 128 + cc]);
            e2 += (ref - got) * (ref - got); r2 += ref * ref; }
#if defined(CHK_MEASURE) && CHK_MEASURE == 4
        { const float re = sqrtf(wave_sum(e2) / wave_sum(r2)); int k = (int)floorf(-log2f(re)); k = k < 0 ? 0 : (k > 15 ? 15 : k); flag(ctl, k); }
#else
        if (bad_l2(e2, r2, 0.03f)) flag(ctl, 4);
#endif
    }
    __syncthreads();
}
__device__ __forceinline__ void check_dil(const Frame& F, int b, unsigned* ctl, const bf16_t* P, const int* positions, const float* rel_bias, const bf16_t* OG, const float* LSE) {
    const int tid = opaque_tid(F.wave), lane = tid & 63, wave = tid >> 6;
    LAS float* pw = (LAS float*)F.lds + wave * 256;
    for (int smp = F.gw; smp < 4096; smp += F.NGW) {
        const unsigned hsh = hash32(smp * 2246822519u + b * 131u + 999u);
        int t = hsh % SEQ; const int hd = (hsh >> 13) & 7, grp = (hsh >> 16) % 3, d = grp == 0 ? 1 : (grp == 1 ? 4 : 16);
        if ((smp & 7) == 0) t = (smp >> 3) % 40;
        if ((smp & 7) == 1) t = SEQ - 1 - ((smp >> 3) % 40);
        const char* gb = (const char*)P + P_OFF_DIL + grp * P_GRP;
#define CHK_QK(tok_, part_, e_) (DIL_FP8 ? f8(gb + (size_t)(tok_) * PROW + (part_) * 1024 + hd * 128, (e_)) : bf2f(((const bf16_t*)(gb + (size_t)(tok_) * PROW + (part_) * 2048 + hd * 256))[e_]))
        const int pq = positions[(size_t)b * SEQ + t];
        float sc[3]; float mx = -1e30f;
#pragma unroll
        for (int i = 0; i < 3; ++i) { const int j = lane + 64 * i - 64, tk = t + j * d; sc[i] = -1e30f;
            if (j <= 64 && tk >= 0 && tk < SEQ) { float s = 0.f;
                for (int e = 0; e < 128; ++e) s += CHK_QK(t, 0, e) * CHK_QK(tk, 1, e);
                s = s * 0.08838834764831845f + rel_bias[ref_bucket(positions[(size_t)b * SEQ + tk] - pq) * 24 + grp * 8 + hd]; sc[i] = s; }
            mx = fmaxf(mx, sc[i]); }
        mx = wave_max(mx);
        float sm = 0.f;
#pragma unroll
        for (int i = 0; i < 3; ++i) { const int j = lane + 64 * i; const float p = sc[i] > -1e29f ? expf(sc[i] - mx) : 0.f; if (j < 129) pw[j] = p; sm += p; }
        sm = wave_sum(sm);
        LDS_WAIT();
        float o0 = 0.f, o1 = 0.f;
        for (int j = 0; j < 129; ++j) { const int tk = t + (j - 64) * d; if (tk < 0 || tk >= SEQ) continue; const float p = pw[j]; const bf16_t* vr = (const bf16_t*)(gb + (size_t)tk * PROW + 2048 * P_QK_ESZ + hd * 256);
            o0 += p * bf2f(vr[lane]); o1 += p * bf2f(vr[64 + lane]); }
        o0 /= sm; o1 /= sm;
        const float g0 = bf2f(OG[((size_t)grp * SEQ + t) * DM + hd * 128 + lane]), g1 = bf2f(OG[((size_t)grp * SEQ + t) * DM + hd * 128 + 64 + lane]);
        if (bad_l2((o0 - g0) * (o0 - g0) + (o1 - g1) * (o1 - g1), o0 * o0 + o1 * o1, 0.03f)) flag(ctl, 5);
        const float lse2 = (mx + logf(sm)) * LOG2E, got = LSE[((size_t)grp * SEQ + t) * 8 + hd];
        if (!(fabsf(lse2 - got) <= 0.05f)) flag(ctl, 6);
        LDS_WAIT();
    }
}
__device__ __forceinline__ void check_u(const Frame& F, int b, unsigned* ctl, const bf16_t* P, const bf16_t* OA, const bf16_t* OG, const float* LSE, const bf16_t* Ub) {
    const int lane = opaque_tid(F.wave) & 63;
    for (int smp = F.gw; smp < 2048; smp += F.NGW) {
        const int t = hash32(smp * 374761393u + b * 31u + 5u) % SEQ; float e2 = 0.f, r2 = 0.f;
        for (int c = lane; c < DM; c += 64) { const int hd = c >> 7;
            const float l0 = LSE[((size_t)0 * SEQ + t) * 8 + hd], l1 = LSE[((size_t)1 * SEQ + t) * 8 + hd], l2 = LSE[((size_t)2 * SEQ + t) * 8 + hd], mx = fmaxf(l0, fmaxf(l1, l2));
            const float w0 = exp2f(l0 - mx), w1 = exp2f(l1 - mx), w2 = exp2f(l2 - mx), ws_ = w0 + w1 + w2;
            const float ob = (w0 * bf2f(OG[((size_t)0 * SEQ + t) * DM + c]) + w1 * bf2f(OG[((size_t)1 * SEQ + t) * DM + c]) + w2 * bf2f(OG[((size_t)2 * SEQ + t) * DM + c])) / ws_;
            const bf16_t* gr = (const bf16_t*)((const char*)P + (size_t)t * PROW + P_OFF_GATE); const float ga = 1.f / (1.f + expf(-bf2f(gr[c]))), gb = 1.f / (1.f + expf(-bf2f(gr[1024 + c])));
            const float ref = ga * bf2f(OA[(size_t)t * DM + c]) + gb * ob, got = bf2f(Ub[(size_t)t * DM + c]); e2 += (ref - got) * (ref - got); r2 += ref * ref; }
        if (bad_l2(e2, r2, 0.01f)) flag(ctl, 7);
    }
}
}
#endif
template <bool F8, class F>
__device__ __forceinline__ void transpose_item(F colptr, int ldn, void* WT, int ldk, int k0, int n0, LAS float* scr, int lane) {
    const float* cp = colptr(n0 + (lane & 31));
    float tv[32];
    const float* cpk = cp ? cp + (size_t)(k0 + (lane >> 5)) * ldn : nullptr;
#pragma unroll
    for (int i = 0; i < 32; ++i) tv[i] = cpk ? cpk[(size_t)(2 * i) * ldn] : 0.f;
#pragma unroll
    for (int i = 0; i < 32; ++i) scr[(2 * i + (lane >> 5)) * 33 + (lane & 31)] = tv[i];
    LDS_WAIT(); asm volatile("" ::: "memory");
    const int c = lane & 7;
#pragma unroll
    for (int j = 0; j < 4; ++j) { const int n = (lane >> 3) + 8 * j; const LAS float* s = scr + (8 * c) * 33 + n;
        if constexpr (F8) { u32x2 o; o.x = pk4_fp8(s[0 * 33] * W8_SCALE, s[1 * 33] * W8_SCALE, s[2 * 33] * W8_SCALE, s[3 * 33] * W8_SCALE); o.y = pk4_fp8(s[4 * 33] * W8_SCALE, s[5 * 33] * W8_SCALE, s[6 * 33] * W8_SCALE, s[7 * 33] * W8_SCALE);
            *(u32x2*)((char*)WT + (size_t)(n0 + n) * ldk + k0 + 8 * c) = o; }
        else { u32x4 o; o.x = cvt_pk_bf16(s[0 * 33], s[1 * 33]); o.y = cvt_pk_bf16(s[2 * 33], s[3 * 33]); o.z = cvt_pk_bf16(s[4 * 33], s[5 * 33]); o.w = cvt_pk_bf16(s[6 * 33], s[7 * 33]);
            *(u32x4*)((bf16_t*)WT + (size_t)(n0 + n) * ldk + k0 + 8 * c) = o; } }
    LDS_WAIT(); asm volatile("" ::: "memory");
}

__device__ __forceinline__ void p0_mod(const Frame& F, const float* c, const float* w_ada, const float* b_ada, float* mod) {
    const int tid = opaque_tid(F.wave), lane = tid & 63; (void)tid; (void)lane;
    LAS float* red = (LAS float*)F.lds;
    LAS float* sl = (LAS float*)(F.lds + 8192);
    if ((int)blockIdx.x < 96) {
        for (int i = tid; i < 4096; i += 512) { const float cv = c[i]; sl[i] = cv * fast_sigmoid(cv); }
        __syncthreads();
    }
    for (int blk = blockIdx.x; blk < 96; blk += F.G) {
        const int col = blk * 64 + (tid & 63), ks = tid >> 6;
        float a0 = 0.f, a1 = 0.f, a2 = 0.f, a3 = 0.f;
#pragma unroll 1
        for (int k0 = ks * 128; k0 < ks * 128 + 128; k0 += 16) { float w[16];
#pragma unroll
            for (int i = 0; i < 16; ++i) w[i] = w_ada[(size_t)(k0 + i) * 6144 + col];
#pragma unroll
            for (int i = 0; i < 16; ++i) { const int k = k0 + i; a0 += sl[k] * w[i]; a1 += sl[1024 + k] * w[i]; a2 += sl[2048 + k] * w[i]; a3 += sl[3072 + k] * w[i]; } }
        red[(ks * 4 + 0) * 64 + (tid & 63)] = a0; red[(ks * 4 + 1) * 64 + (tid & 63)] = a1; red[(ks * 4 + 2) * 64 + (tid & 63)] = a2; red[(ks * 4 + 3) * 64 + (tid & 63)] = a3;
        __syncthreads();
        if (tid < 256) { const int b = tid >> 6, cc = tid & 63; float s = 0.f;
#pragma unroll
            for (int q = 0; q < 8; ++q) s += red[(q * 4 + b) * 64 + cc];
            mod[b * 6144 + blk * 64 + cc] = s + b_ada[blk * 64 + cc]; }
        __syncthreads();
    }
}
__device__ __forceinline__ void p0_cs(const Frame& F, const int* pos, float* cs) {
    const int tid = opaque_tid(F.wave), lane = tid & 63; (void)tid; (void)lane;
    for (int i = (int)blockIdx.x * 512 + tid; i < NTOK * 32; i += F.G * 512) {
        const int t = i >> 5, j = i & 31;
        const float inv = __builtin_amdgcn_exp2f(-(float)(2 * j) / 64.f * 13.287712379549449f);
        const float ang = (float)pos[t] * inv;
        const double rev = (double)ang * 0.15915494309189535; const double fr = rev - __builtin_rint(rev);
        const float f = (float)fr;
        f32x2 o; o.x = __builtin_amdgcn_cosf(f); o.y = __builtin_amdgcn_sinf(f);
        *(f32x2*)(cs + (size_t)i * 2) = o;
    }
}
__device__ __forceinline__ void p0_lut(const Frame& F, const float* rel_bias, float* lutg) {
    const int tid = opaque_tid(F.wave);
    for (int i = (int)blockIdx.x * 512 + tid; i < 24 * 2049; i += F.G * 512) { const int l = i / 2049, u = i - l * 2049;
        lutg[l * 2304 + u + (u >> 5)] = rel_bias[att::t5_bucket(u - 1024) * 24 + l] * LOG2E; }
}
__device__ __forceinline__ void p0_weights(const Frame& F, const float* w_in, const float* w_uq, const float* w_ukv, const float* w_out, unsigned char* ws) {
    const int tid = opaque_tid(F.wave), lane = tid & 63; (void)tid; (void)lane;
    LAS float* scr = (LAS float*)(F.lds + F.wave * 16384);
    constexpr int I_IN = 16 * 376, I_UQ = 6 * 48, I_UKV = 4 * 64, I_OUT = 16 * 32;
    for (int it = F.gw; it < I_IN + I_UQ + I_UKV + I_OUT; it += F.NGW) {
        int r = it;
        if (r < I_IN) { const int kb = r / 376, nb = r % 376;
            transpose_item<(FP8_G1 != 0)>([=](int np) -> const float* { const int n = (np & ~31) + pg8::perm32(np & 31); return n < D_IN ? w_in + n : nullptr; }, D_IN, (void*)(ws + WS_WIN), 1024, kb * 64, nb * 32, scr, lane); continue; }
        r -= I_IN;
        if (r < I_UQ) { const int kb = r / 48, nb = r % 48;
            transpose_item<false>([=](int n) -> const float* { const int hd = n / 192, w = n - hd * 192; const int sc = w < 128 ? w : 128 + ((w - 128) >> 1) + 32 * ((w - 128) & 1); return w_uq + hd * 192 + sc; },
                           1536, (bf16_t*)(ws + WS_WUQ), 384, kb * 64, nb * 32, scr, lane); continue; }
        r -= I_UQ;
        if (r < I_UKV) { const int kb = r / 64, nb = r % 64;
            transpose_item<false>([=](int n) -> const float* { const int m = n & 1023; return w_ukv + (MLA_FP8 ? ((m >> 7) * 256 + (n >> 10) * 128 + (m & 127)) : n); }, 2048, (bf16_t*)(ws + WS_WUKV), 256, kb * 64, nb * 32, scr, lane); continue; }
        r -= I_UKV;
        { const int kb = r / 32, nb = r % 32;
            transpose_item<(FP8_WO != 0)>([=](int n) -> const float* { return w_out + n; }, 1024, (void*)(ws + WS_WOUT), 1024, kb * 64, nb * 32, scr, lane); }
    }
}
__device__ __forceinline__ void conv_experts(const Frame& F, const float* w_gate, const float* w_up, const float* w_down, unsigned char* ws, int part) {
    static_assert(FP8_EX != 0 && FP8_WO != 0, "fp8 expert operands; WS_WD sits in the half of the U region that the fp8 u leaves free");
    const int tid = opaque_tid(F.wave), lane = tid & 63; (void)tid;
    LAS float* scr = (LAS float*)(F.lds + F.wave * 16384);
    constexpr int N_IT = NE * 1536;
    const long du = (const char*)w_up - (const char*)w_gate;
    const int lr = lane >> 4, lf = lane & 15;
#define CE_LOAD(it_, tv_) do { const int e_ = (it_) / 1536, r_ = (it_) % 1536; const float* p_; int ldn_; \
        if (r_ < 1024) { const int a_ = r_ >> 9, kb_ = (r_ >> 5) & 15, cb_ = r_ & 31; \
            p_ = (const float*)((const char*)w_gate + (a_ ? du : 0L)) + (size_t)e_ * DM * DFF + (size_t)(kb_ * 64 + lr) * DFF + cb_ * 64 + 4 * lf; ldn_ = DFF; } \
        else { const int r2_ = r_ - 1024, kb_ = r2_ >> 4, cb_ = r2_ & 15; p_ = w_down + (size_t)e_ * DFF * DM + (size_t)(kb_ * 64 + lr) * DM + cb_ * 64 + 4 * lf; ldn_ = DM; } \
        _Pragma("unroll") for (int i = 0; i < 16; ++i) tv_[i] = *(const f32x4*)(p_ + (size_t)(4 * i) * ldn_); } while (0)
#define CE_STORE(it_, tv_) do { const int e_ = (it_) / 1536, r_ = (it_) % 1536; unsigned char* wt_; int ldk_; \
        _Pragma("unroll") for (int i = 0; i < 16; ++i) { LAS float* d_ = scr + (lr + 4 * i) * 64 + ((4 * lf) ^ (4 * ((i >> 1) & 7))); d_[0 ^ lr] = tv_[i][0]; d_[1 ^ lr] = tv_[i][1]; d_[2 ^ lr] = tv_[i][2]; d_[3 ^ lr] = tv_[i][3]; } \
        LDS_WAIT(); asm volatile("" ::: "memory"); \
        const int c_ = lane & 7; int rowb_, a16_; bool dn_; \
        if (r_ < 1024) { const int a_ = r_ >> 9, kb_ = (r_ >> 5) & 15, cb_ = r_ & 31; wt_ = ws + WS_WGU + (size_t)e_ * 4096 * 1024 + kb_ * 64 + 8 * c_; ldk_ = 1024; rowb_ = 128 * cb_; a16_ = 16 * a_; dn_ = false; } \
        else { const int r2_ = r_ - 1024, kb_ = r2_ >> 4, cb_ = r2_ & 15; wt_ = ws + WS_WD + (size_t)e_ * 1024 * 2048 + kb_ * 64 + 8 * c_; ldk_ = 2048; rowb_ = 64 * cb_; a16_ = 0; dn_ = true; } \
        _Pragma("unroll") for (int j = 0; j < 8; ++j) { const int cc_ = (lane >> 3) + 8 * j; const LAS float* s_ = scr + (8 * c_) * 64; const int x0_ = cc_ ^ (4 * c_); u32x2 o_; \
            const int s5_ = cc_ & 31; \
            const int row_ = dn_ ? rowb_ + (cc_ & 32) + 16 * ((s5_ >> 2) & 1) + 4 * (s5_ >> 3) + (s5_ & 3) : rowb_ + 32 * (cc_ >> 4) + a16_ + (cc_ & 15); \
            o_.x = pk4_fp8(s_[0 * 64 + (x0_ ^ 0)] * W8_SCALE, s_[1 * 64 + (x0_ ^ 1)] * W8_SCALE, s_[2 * 64 + (x0_ ^ 2)] * W8_SCALE, s_[3 * 64 + (x0_ ^ 3)] * W8_SCALE); \
            o_.y = pk4_fp8(s_[4 * 64 + (x0_ ^ 0)] * W8_SCALE, s_[5 * 64 + (x0_ ^ 1)] * W8_SCALE, s_[6 * 64 + (x0_ ^ 2)] * W8_SCALE, s_[7 * 64 + (x0_ ^ 3)] * W8_SCALE); \
            *(u32x2*)(wt_ + (size_t)row_ * ldk_) = o_; } \
        LDS_WAIT(); asm volatile("" ::: "memory"); } while (0)
    f32x4 tva[16], tvb[16];
    const int it_end = (part + 1) * (N_IT / NB);
    int it = part * (N_IT / NB) + F.gw;
    if (it < it_end) CE_LOAD(it, tva);
#pragma unroll 1
    while (it < it_end) {
        const int it2 = it + F.NGW, it3 = it2 + F.NGW;
        if (it2 < it_end) CE_LOAD(it2, tvb);
        CE_STORE(it, tva);
        if (it2 < it_end) { if (it3 < it_end) CE_LOAD(it3, tva); CE_STORE(it2, tvb); }
        it = it3;
    }
    __syncthreads();
#undef CE_LOAD
#undef CE_STORE
}
__device__ __forceinline__ void norm_mod_row(const float* xrow, const float* g, const float* sh, const float* sc, int lane, f32x4 (&v)[4]) {
    float s = 0.f;
#pragma unroll
    for (int j = 0; j < 4; ++j) { v[j] = *(const f32x4*)(xrow + 4 * lane + 256 * j); s += (v[j][0] * v[j][0] + v[j][1] * v[j][1]) + (v[j][2] * v[j][2] + v[j][3] * v[j][3]); }
    const float rstd = 1.0f / sqrtf(wave_sum(s) * (1.f / DM) + NORM_EPS);
#pragma unroll
    for (int j = 0; j < 4; ++j) { const int c = 4 * lane + 256 * j; const f32x4 gg = *(const f32x4*)(g + c), s1 = *(const f32x4*)(sc + c), s0 = *(const f32x4*)(sh + c);
        v[j] = (v[j] * rstd * gg) * (s1 + 1.0f) + s0; }
}
__device__ __forceinline__ void store_row_bf16(bf16_t* orow, int lane, const f32x4 (&v)[4]) {
#pragma unroll
    for (int j = 0; j < 4; ++j) { u32x2 o; o.x = cvt_pk_bf16(v[j][0], v[j][1]); o.y = cvt_pk_bf16(v[j][2], v[j][3]); *(u32x2*)(orow + 4 * lane + 256 * j) = o; }
}
template <bool F8> __device__ __forceinline__ void store_row_act(void* orow, int lane, const f32x4 (&v)[4]) {
    if constexpr (F8) {
#pragma unroll
        for (int j = 0; j < 4; ++j) *(unsigned*)((char*)orow + 4 * lane + 256 * j) = pk4_fp8(v[j][0], v[j][1], v[j][2], v[j][3]);
    } else store_row_bf16((bf16_t*)orow, lane, v);
}
__device__ __forceinline__ void p1_h(const Frame& F, const float* x, const float* g, const float* mod, bf16_t* H) {
    const int tid = opaque_tid(F.wave), lane = tid & 63; (void)tid; (void)lane;
    f32x4 gg[4], vn[4], shn[4], scn[4];
    int t = F.gw;
#pragma unroll
    for (int j = 0; j < 4; ++j) { const int c = 4 * lane + 256 * j; gg[j] = *(const f32x4*)(g + c);
        if (t < NTOK) { const int b = t / SEQ; vn[j] = *(const f32x4*)(x + (size_t)t * DM + c); shn[j] = *(const f32x4*)(mod + b * 6144 + c); scn[j] = *(const f32x4*)(mod + b * 6144 + 1024 + c); } }
#pragma unroll 1
    for (; t < NTOK; t += F.NGW) { f32x4 v[4], sh[4], sc[4];
#pragma unroll
        for (int j = 0; j < 4; ++j) { v[j] = vn[j]; sh[j] = shn[j]; sc[j] = scn[j]; }
        const int tn = t + F.NGW;
        if (tn < NTOK) { const int bn = tn / SEQ;
#pragma unroll
            for (int j = 0; j < 4; ++j) { const int c = 4 * lane + 256 * j; vn[j] = *(const f32x4*)(x + (size_t)tn * DM + c); shn[j] = *(const f32x4*)(mod + bn * 6144 + c); scn[j] = *(const f32x4*)(mod + bn * 6144 + 1024 + c); } }
        float ss = 0.f;
#pragma unroll
        for (int j = 0; j < 4; ++j) ss += (v[j][0] * v[j][0] + v[j][1] * v[j][1]) + (v[j][2] * v[j][2] + v[j][3] * v[j][3]);
        const float rstd = 1.0f / sqrtf(wave_sum(ss) * (1.f / DM) + NORM_EPS);
#pragma unroll
        for (int j = 0; j < 4; ++j) v[j] = (v[j] * rstd * gg[j]) * (sc[j] + 1.0f) + sh[j];
        store_row_act<(FP8_G1 != 0)>((char*)H + (size_t)t * DM * (FP8_G1 ? 1 : 2), lane, v); }
}
__device__ __forceinline__ void lb_latent(const Frame& F, const bf16_t* P, const float* gq, const float* gkv, const float* cs, bf16_t* CQN, bf16_t* CKVN, bf16_t* KB) {
    const int tid = opaque_tid(F.wave), lane = tid & 63; (void)tid; (void)lane;
    f32x4 gq0 = {}, gq1 = {}, gk0 = {}, gk1 = {};
    if (lane < 48) { gq0 = *(const f32x4*)(gq + 8 * lane); gq1 = *(const f32x4*)(gq + 8 * lane + 4); }
    if (lane < 32) { gk0 = *(const f32x4*)(gkv + 8 * lane); gk1 = *(const f32x4*)(gkv + 8 * lane + 4); }
#pragma unroll 1
    for (int tb = F.gw; tb < SEQ; tb += 4 * F.NGW) {
        u32x4 wq[4], wk[4]; float xa[4], xb[4]; f32x2 cc[4];
#pragma unroll
        for (int i = 0; i < 4; ++i) { const int t = tb + i * F.NGW; wq[i] = (u32x4){0u, 0u, 0u, 0u}; wk[i] = wq[i]; xa[i] = 0.f; xb[i] = 0.f; cc[i] = (f32x2){0.f, 0.f};
            if (t < SEQ) { const bf16_t* pr = (const bf16_t*)((const char*)P + (size_t)t * PROW);
                if (lane < 48) wq[i] = *(const u32x4*)(pr + C_CQ + 8 * lane);
                if (lane < 32) { wk[i] = *(const u32x4*)(pr + C_CKV + 8 * lane); xa[i] = bf2f(pr[C_KPE + lane]); xb[i] = bf2f(pr[C_KPE + 32 + lane]); cc[i] = *(const f32x2*)(cs + ((size_t)t * 32 + lane) * 2); } } }
#pragma unroll
        for (int i = 0; i < 4; ++i) { const int t = tb + i * F.NGW; if (t >= SEQ) break;
            float q[8], s = 0.f;
            { const u32x4 w = wq[i]; q[0] = bflo(w.x); q[1] = bfhi(w.x); q[2] = bflo(w.y); q[3] = bfhi(w.y); q[4] = bflo(w.z); q[5] = bfhi(w.z); q[6] = bflo(w.w); q[7] = bfhi(w.w);
#pragma unroll
              for (int e = 0; e < 8; ++e) s += q[e] * q[e]; }
            const float rq = 1.0f / sqrtf(wave_sum(s) * (1.f / 384.f) + NORM_EPS);
            if (lane < 48) { u32x4 o; o.x = cvt_pk_bf16(q[0] * rq * gq0[0], q[1] * rq * gq0[1]); o.y = cvt_pk_bf16(q[2] * rq * gq0[2], q[3] * rq * gq0[3]);
                o.z = cvt_pk_bf16(q[4] * rq * gq1[0], q[5] * rq * gq1[1]); o.w = cvt_pk_bf16(q[6] * rq * gq1[2], q[7] * rq * gq1[3]);
                *(u32x4*)(CQN + (size_t)t * 384 + 8 * lane) = o; }
            float s2 = 0.f;
            { const u32x4 w = wk[i]; q[0] = bflo(w.x); q[1] = bfhi(w.x); q[2] = bflo(w.y); q[3] = bfhi(w.y); q[4] = bflo(w.z); q[5] = bfhi(w.z); q[6] = bflo(w.w); q[7] = bfhi(w.w);
#pragma unroll
              for (int e = 0; e < 8; ++e) s2 += q[e] * q[e]; }
            const float rk = 1.0f / sqrtf(wave_sum(s2) * (1.f / 256.f) + NORM_EPS);
            if (lane < 32) { u32x4 o; o.x = cvt_pk_bf16(q[0] * rk * gk0[0], q[1] * rk * gk0[1]); o.y = cvt_pk_bf16(q[2] * rk * gk0[2], q[3] * rk * gk0[3]);
                o.z = cvt_pk_bf16(q[4] * rk * gk1[0], q[5] * rk * gk1[1]); o.w = cvt_pk_bf16(q[6] * rk * gk1[2], q[7] * rk * gk1[3]);
                *(u32x4*)(CKVN + (size_t)t * 256 + 8 * lane) = o;
                const float x1 = xa[i], x2 = xb[i]; const f32x2 c = cc[i];
                if constexpr (MLA_FP8) { const unsigned short pk8 = (unsigned short)(__builtin_amdgcn_cvt_pk_fp8_f32(x1 * c.x - x2 * c.y, x1 * c.y + x2 * c.x, 0, false) & 0xffff);
#pragma unroll
                    for (int h = 0; h < 8; ++h) *(unsigned short*)((unsigned char*)KB + ((size_t)h * SEQ + t) * 192 + 128 + 2 * lane) = pk8; }
                else { const unsigned pk = cvt_pk_bf16(x1 * c.x - x2 * c.y, x1 * c.y + x2 * c.x);
#pragma unroll
                    for (int h = 0; h < 8; ++h) *(unsigned*)(KB + ((size_t)h * SEQ + t) * 192 + 128 + 2 * lane) = pk; } }
        }
    }
}
__device__ __forceinline__ void lb_combine(const Frame& F, const bf16_t* P, const bf16_t* OA, const bf16_t* OG, const float* LSE, bf16_t* U) {
    const int tid = opaque_tid(F.wave), lane = tid & 63; (void)tid; (void)lane;
#pragma unroll 2
    for (int t = F.gw; t < SEQ; t += F.NGW) {
#pragma unroll
        for (int j = 0; j < 2; ++j) { const int c0 = 8 * lane + 512 * j, hd = c0 >> 7;
            const float l0 = LSE[((size_t)0 * SEQ + t) * 8 + hd], l1 = LSE[((size_t)1 * SEQ + t) * 8 + hd], l2 = LSE[((size_t)2 * SEQ + t) * 8 + hd];
            const float mx = fmaxf(l0, fmaxf(l1, l2)); float w0 = __builtin_amdgcn_exp2f(l0 - mx), w1 = __builtin_amdgcn_exp2f(l1 - mx), w2 = __builtin_amdgcn_exp2f(l2 - mx);
            const float inv = 1.0f / (w0 + w1 + w2); w0 *= inv; w1 *= inv; w2 *= inv;
            const u32x4 oa = *(const u32x4*)(OA + (size_t)t * DM + c0), g0 = *(const u32x4*)(OG + ((size_t)0 * SEQ + t) * DM + c0), g1 = *(const u32x4*)(OG + ((size_t)1 * SEQ + t) * DM + c0),
                        g2 = *(const u32x4*)(OG + ((size_t)2 * SEQ + t) * DM + c0), ga = *(const u32x4*)((const char*)P + (size_t)t * PROW + P_OFF_GATE + 2 * c0), gb = *(const u32x4*)((const char*)P + (size_t)t * PROW + P_OFF_GATE + 2048 + 2 * c0);
            u32x4 o; float uf[8];
#pragma unroll
            for (int e = 0; e < 4; ++e) {
                const float ob_lo = w0 * bflo(g0[e]) + w1 * bflo(g1[e]) + w2 * bflo(g2[e]), ob_hi = w0 * bfhi(g0[e]) + w1 * bfhi(g1[e]) + w2 * bfhi(g2[e]);
                const float u_lo = fast_sigmoid(bflo(ga[e])) * bflo(oa[e]) + fast_sigmoid(bflo(gb[e])) * ob_lo;
                const float u_hi = fast_sigmoid(bfhi(ga[e])) * bfhi(oa[e]) + fast_sigmoid(bfhi(gb[e])) * ob_hi;
                if constexpr (FP8_WO) { uf[2 * e] = u_lo * U8_SCALE; uf[2 * e + 1] = u_hi * U8_SCALE; } else o[e] = cvt_pk_bf16(u_lo, u_hi); }
            if constexpr (FP8_WO) { u32x2 o8; o8.x = pk4_fp8(uf[0], uf[1], uf[2], uf[3]); o8.y = pk4_fp8(uf[4], uf[5], uf[6], uf[7]); *(u32x2*)((unsigned char*)U + (size_t)t * DM + c0) = o8; }
            else *(u32x4*)(U + (size_t)t * DM + c0) = o; }
    }
}
__device__ __forceinline__ void pg_h2_router(const Frame& F, const float* x1, const float* g, const float* mod, const float* w_router, bf16_t* H2, float* AFFT) {
    const int tid = opaque_tid(F.wave), lane = tid & 63; (void)tid;
    LAS float* wr = (LAS float*)F.lds;
    LAS float* ab = (LAS float*)(F.lds + 65536) + F.wave * 256;
    for (int i = tid; i < 1024 * 16 / 4; i += 512) { const int c = i >> 2, k = i & 3, rho = (c & 3) * 256 + (c >> 2);
        ((LAS f32x4*)wr)[rho * 4 + ((k + (rho >> 2)) & 3)] = ((const f32x4*)w_router)[i]; }
    __syncthreads();
    int roff[4];
#pragma unroll
    for (int k = 0; k < 4; ++k) roff[k] = ((k + (lane >> 2)) & 3) * 4;
    const bool b4 = (lane >> 4) & 1, b3 = (lane >> 3) & 1, b2 = (lane >> 2) & 1; const int el = 8 * (lane >> 5) + 4 * ((lane >> 4) & 1) + 2 * ((lane >> 3) & 1) + ((lane >> 2) & 1);
    for (int ch = F.gw; ch < NTOK / 16; ch += F.NGW) {
        const int t0 = ch * 16, b = t0 / SEQ, s0 = t0 % SEQ;
        f32x4 vn[4], gg[4], sc1[4], sh0[4];
#pragma unroll
        for (int j = 0; j < 4; ++j) { const int c = 4 * lane + 256 * j; vn[j] = *(const f32x4*)(x1 + (size_t)t0 * DM + c);
            gg[j] = *(const f32x4*)(g + c); sh0[j] = *(const f32x4*)(mod + b * 6144 + 3072 + c); sc1[j] = *(const f32x4*)(mod + b * 6144 + 4096 + c); }
#pragma unroll 1
        for (int ti = 0; ti < 16; ++ti) { const int t = t0 + ti; f32x4 v[4];
#pragma unroll
            for (int j = 0; j < 4; ++j) v[j] = vn[j];
            if (ti + 1 < 16) {
#pragma unroll
                for (int j = 0; j < 4; ++j) vn[j] = *(const f32x4*)(x1 + (size_t)(t + 1) * DM + 4 * lane + 256 * j); }
            { float ss = 0.f;
#pragma unroll
              for (int j = 0; j < 4; ++j) ss += (v[j][0] * v[j][0] + v[j][1] * v[j][1]) + (v[j][2] * v[j][2] + v[j][3] * v[j][3]);
              const float rstd = 1.0f / sqrtf(wave_sum(ss) * (1.f / DM) + NORM_EPS);
#pragma unroll
              for (int j = 0; j < 4; ++j) v[j] = (v[j] * rstd * gg[j]) * (sc1[j] + 1.0f) + sh0[j]; }
            store_row_act<(FP8_EX != 0)>((char*)H2 + (size_t)t * DM * (FP8_EX ? 1 : 2), lane, v);
            float lg[16];
#pragma unroll
            for (int e = 0; e < 16; ++e) lg[e] = 0.f;
#pragma unroll
            for (int j = 0; j < 4; ++j)
#pragma unroll
                for (int q = 0; q < 4; ++q) { const LAS float* wp = wr + (q * 256 + lane + 64 * j) * 16; const float hv = v[j][q];
#pragma unroll
                    for (int e4 = 0; e4 < 4; ++e4) { const f32x4 w = *(const LAS f32x4*)(wp + roff[e4]); lg[4 * e4 + 0] += hv * w[0]; lg[4 * e4 + 1] += hv * w[1]; lg[4 * e4 + 2] += hv * w[2]; lg[4 * e4 + 3] += hv * w[3]; } }
            float s8[8], s4[4], s2[2], s1;
#pragma unroll
            for (int e = 0; e < 8; ++e) { auto rr = __builtin_amdgcn_permlane32_swap(__float_as_uint(lg[e]), __float_as_uint(lg[e + 8]), false, false); s8[e] = __uint_as_float(rr[0]) + __uint_as_float(rr[1]); }
#pragma unroll
            for (int i = 0; i < 4; ++i) { const float keep = b4 ? s8[i + 4] : s8[i], send = b4 ? s8[i] : s8[i + 4]; s4[i] = keep + __int_as_float(__builtin_amdgcn_ds_swizzle(__float_as_int(send), SWZ_XOR(16))); }
#pragma unroll
            for (int i = 0; i < 2; ++i) { const float keep = b3 ? s4[i + 2] : s4[i], send = b3 ? s4[i] : s4[i + 2]; s2[i] = keep + __int_as_float(__builtin_amdgcn_ds_swizzle(__float_as_int(send), SWZ_XOR(8))); }
            { const float keep = b2 ? s2[1] : s2[0], send = b2 ? s2[0] : s2[1]; s1 = keep + __int_as_float(__builtin_amdgcn_ds_swizzle(__float_as_int(send), SWZ_XOR(4))); }
            s1 += __int_as_float(__builtin_amdgcn_ds_swizzle(__float_as_int(s1), SWZ_XOR(2)));
            s1 += __int_as_float(__builtin_amdgcn_ds_swizzle(__float_as_int(s1), SWZ_XOR(1)));
            const float mx = wave_max(s1), ex = __expf(s1 - mx), sum = wave_sum(ex) * 0.25f;
            if ((lane & 3) == 0) ab[el * 16 + ti] = ex * (1.0f / sum);
        }
        LDS_WAIT();
        { const int e = lane >> 2, q4 = (lane & 3) * 4; const f32x4 w = *(const LAS f32x4*)(ab + e * 16 + q4);
          *(f32x4*)(AFFT + ((size_t)b * NE + e) * SEQ + s0 + q4) = w; }
        LDS_WAIT();
    }
    __syncthreads();
}
__device__ __forceinline__ void ph_topk(const Frame& F, const float* AFFT, int* TOPI, float* TOPG, int* SLOT) {
    const int tid = opaque_tid(F.wave), lane = tid & 63;
    LAS unsigned* cnt = (LAS unsigned*)F.lds;
    LAS unsigned* wtot = cnt + 64;
    for (int p = blockIdx.x; p < NB * NE; p += F.G) {
        const float* src = AFFT + (size_t)p * SEQ + 16 * tid;
        unsigned key[16];
#pragma unroll
        for (int j = 0; j < 4; ++j) { const u32x4 w = *(const u32x4*)(src + 4 * j); key[4 * j] = w.x; key[4 * j + 1] = w.y; key[4 * j + 2] = w.z; key[4 * j + 3] = w.w; }
        unsigned thr = 0u;
#pragma unroll 1
        for (int bit = 30; bit >= 0; --bit) { const unsigned cand = thr | (1u << bit); unsigned c = 0;
#pragma unroll
            for (int i = 0; i < 16; ++i) c += (unsigned)__builtin_popcountll(__ballot(key[i] >= cand));
            LAS unsigned* slot = cnt + ((bit & 1) << 3);
            if (lane == 0) slot[F.wave] = c;
            __syncthreads();
            unsigned tot = 0;
#pragma unroll
            for (int w = 0; w < 8; ++w) tot += slot[w];
            if (tot >= (unsigned)CAP) thr = cand; }
        unsigned ngt = 0, neq = 0;
#pragma unroll
        for (int i = 0; i < 16; ++i) { ngt += key[i] > thr ? 1u : 0u; neq += key[i] == thr ? 1u : 0u; }
        unsigned pk = ngt | (neq << 16), inc = pk;
#pragma unroll
        for (int o = 1; o < 64; o <<= 1) { const unsigned v = (unsigned)__builtin_amdgcn_ds_bpermute((lane - o) << 2, (int)inc); if (lane >= o) inc += v; }
        __syncthreads();
        if (lane == 63) wtot[F.wave] = inc;
        __syncthreads();
        unsigned base = 0, all = 0;
        for (int w = 0; w < 8; ++w) { const unsigned v = wtot[w]; all += v; if (w < F.wave) base += v; }
        const unsigned tot_gt = all & 0xffffu, need = (unsigned)CAP - tot_gt;
        const unsigned excl = base + inc - pk; unsigned g_before = excl & 0xffffu, e_before = excl >> 16;
#pragma unroll
        for (int i = 0; i < 16; ++i) { const int s = 16 * tid + i; int slot = -1;
            if (key[i] > thr) { slot = (int)g_before; ++g_before; }
            else if (key[i] == thr) { if (e_before < need) slot = (int)(tot_gt + e_before); ++e_before; }
            SLOT[(size_t)p * SEQ + s] = slot;
            if (slot >= 0) { TOPI[p * CAP + slot] = (p >> 4) * SEQ + s; TOPG[p * CAP + slot] = __uint_as_float(key[i]); } }
        __syncthreads();
    }
}
__device__ __forceinline__ void p_final(const Frame& F, float* out, const float* mod, const int* SLOT, const bf16_t* Y, const float* gfin, float oscale) {
    const int tid = opaque_tid(F.wave), lane = tid & 63; (void)tid;
    f32x4 gf[4], xn[4], gtn[4]; int sln = -1;
#pragma unroll
    for (int j = 0; j < 4; ++j) gf[j] = *(const f32x4*)(gfin + 4 * lane + 256 * j);
    int r = F.gw;
    if (r < NTOK) { const int b = r / SEQ, s = r % SEQ; if (lane < NE) sln = SLOT[((size_t)b * NE + lane) * SEQ + s];
#pragma unroll
        for (int j = 0; j < 4; ++j) { const int c = 4 * lane + 256 * j; xn[j] = *(const f32x4*)(out + (size_t)r * DM + c); gtn[j] = *(const f32x4*)(mod + b * 6144 + 5120 + c); } }
#pragma unroll 1
    for (; r < NTOK; r += F.NGW) { const int b = r / SEQ; float* row = out + (size_t)r * DM;
        const int sl = sln; f32x4 x[4], gt[4];
#pragma unroll
        for (int j = 0; j < 4; ++j) { x[j] = xn[j]; gt[j] = gtn[j]; }
        const int rn = r + F.NGW;
        if (rn < NTOK) { const int bn = rn / SEQ, sn = rn % SEQ; sln = -1; if (lane < NE) sln = SLOT[((size_t)bn * NE + lane) * SEQ + sn];
#pragma unroll
            for (int j = 0; j < 4; ++j) { const int c = 4 * lane + 256 * j; xn[j] = *(const f32x4*)(out + (size_t)rn * DM + c); gtn[j] = *(const f32x4*)(mod + bn * 6144 + 5120 + c); } }
        unsigned long long m = __ballot(sl >= 0);
        f32x4 acc[4];
#pragma unroll
        for (int j = 0; j < 4; ++j) acc[j] = (f32x4){0.f, 0.f, 0.f, 0.f};
        while (m) { const int e = __builtin_ctzll(m); m &= m - 1; const int slot = __builtin_amdgcn_readlane(sl, e);
            const bf16_t* yr = Y + (((size_t)b * NE + e) * CAP + slot) * DM;
#pragma unroll
            for (int j = 0; j < 4; ++j) { const u32x2 w = *(const u32x2*)(yr + 4 * lane + 256 * j); acc[j][0] += bflo(w.x); acc[j][1] += bfhi(w.x); acc[j][2] += bflo(w.y); acc[j][3] += bfhi(w.y); } }
        f32x4 v[4]; float ss = 0.f;
#pragma unroll
        for (int j = 0; j < 4; ++j) { v[j] = x[j] + gt[j] * acc[j]; ss += (v[j][0] * v[j][0] + v[j][1] * v[j][1]) + (v[j][2] * v[j][2] + v[j][3] * v[j][3]); }
        const float rstd = 1.0f / sqrtf(wave_sum(ss) * (1.f / DM) + NORM_EPS);
#pragma unroll
        for (int j = 0; j < 4; ++j) { const int c = 4 * lane + 256 * j; f32x4 ov = v[j] * (rstd * oscale) * gf[j];
#if defined(MK_CHECK) && MK_CHECK
#pragma unroll
            for (int e = 0; e < 4; ++e) if (!(ov[e] == ov[e]) || fabsf(ov[e]) > 1e6f) ov[e] = 0.f;
#endif
            *(f32x4*)(row + c) = ov; }
    }
}

__global__ void __launch_bounds__(NWAVES * 64, 2) fwd_kernel(Args args) {
    extern __shared__ __attribute__((aligned(16))) unsigned char lds_raw[];
    Frame F;
    F.lds = (LAS unsigned char*)lds_raw;
    F.wave = __builtin_amdgcn_readfirstlane((int)threadIdx.x >> 6); F.tid = opaque_tid(F.wave); F.lane = F.tid & 63;
    F.G = gridDim.x; { const int bx = blockIdx.x; F.vcu = (F.G % 8 == 0) ? (bx % 8) * (F.G / 8) + bx / 8 : bx; }
    F.gw = F.vcu * NWAVES + F.wave; F.NGW = F.G * NWAVES;
    unsigned char* ws = args.ws;
    volatile LAS unsigned* MISC = (volatile LAS unsigned*)(F.lds + MISC_OFF);
    for (int u = F.tid; u < (LDS_BYTES - RING_BYTES) / 4; u += NWAVES * 64) ((LAS unsigned*)(F.lds + RING_BYTES))[u] = 0u;
    __syncthreads();
    unsigned* ctl = (unsigned*)(ws + WS_CTL);
    XcdBarrier bar = xcd_barrier_post(ctl + CW_BAR, MISC + 8); bar.wv = F.wave;

#define IN_F(k) ((const float*)args.in[k])
#define in_x IN_F(0)
#define cin IN_F(1)
#define positions ((const int*)args.in[2])
#define w_ada IN_F(3)
#define b_ada IN_F(4)
#define g_mix IN_F(5)
#define w_in IN_F(6)
#define g_q IN_F(7)
#define g_kv IN_F(8)
#define w_uq IN_F(9)
#define w_ukv IN_F(10)
#define rel_bias IN_F(11)
#define w_out IN_F(12)
#define g_ffn IN_F(13)
#define w_router IN_F(14)
#define w_gate IN_F(15)
#define w_up IN_F(16)
#define w_down IN_F(17)
#define g_final IN_F(18)
#define t_out (args.out)
#define WSP(T, off) ((T*)(args.ws + (off)))
#define MOD WSP(float, WS_MOD)
#define CS WSP(float, WS_CS)
#define WIN WSP(bf16_t, WS_WIN)
#define WUQ WSP(bf16_t, WS_WUQ)
#define WUKV WSP(bf16_t, WS_WUKV)
#define WOUT WSP(bf16_t, WS_WOUT)
#define t_H WSP(bf16_t, WS_H)
#define t_U WSP(bf16_t, WS_U)
#define t_P WSP(bf16_t, WS_P)
#define CQN WSP(bf16_t, WS_CQN)
#define CKVN WSP(bf16_t, WS_CKVN)
#define QB WSP(bf16_t, WS_QB)
#define KB WSP(bf16_t, WS_KB)
#define VB WSP(bf16_t, WS_VB)
#define OA WSP(bf16_t, WS_OA)
#define OG WSP(bf16_t, WS_OG)
#define LSE WSP(float, WS_LSE)
#define WGU WSP(bf16_t, WS_WGU)
#define WD WSP(bf16_t, WS_WD)
#define HID WSP(bf16_t, WS_HID)
#define t_Y WSP(bf16_t, WS_Y)
#define AFFT WSP(float, WS_AFFT)
#define TOPI WSP(int, WS_TOPI)
#define TOPG WSP(float, WS_TOPG)
#define SLOT WSP(int, WS_SLOT)

#ifndef PH_MASK
#define PH_MASK 0xFFFFFFFFu
#endif
#define PH_ON(k) constexpr (((PH_MASK) >> (k)) & 1u)
#ifndef DUP_MASK
#define DUP_MASK 0u
#endif
#define PH_REP(k) for (int rep_ = 0; rep_ < ((((DUP_MASK) >> (k)) & 1u) ? 2 : 1); ++rep_)
#if defined(PROBE_TIMING)
#define DBG_SCALE() (1.0f + __uint_as_float(__hip_atomic_load(ctl + CW_DBG + 1, RLX_AGENT)))
#elif defined(MK_CHECK) && MK_CHECK
#define DBG_SCALE() ([&]() -> float { const unsigned f_ = __hip_atomic_load(ctl + CW_DBG, RLX_AGENT); return f_ ? 1.0f + 0.05f * (float)(1 + __builtin_ctz(f_)) : 1.0f; }())
#else
#define DBG_SCALE() 1.0f
#endif
    int step = 0; const int lo = args.st_lo, hi = args.st_hi;
#if defined(PROBE_STEP)
#define STEP_BEGIN if (step >= lo && step < hi) { const unsigned long long rt0_ = __builtin_amdgcn_s_memrealtime();
#define STEP_END if (step + 1 < hi) xcd_barrier(bar); if (step == PROBE_STEP && blockIdx.x == 0 && F.wave == 0 && opaque_tid(0) == 0) { \
        const float us_ = (float)(__builtin_amdgcn_s_memrealtime() - rt0_) * 0.01f; *(float*)(ctl + CW_DBG + 1) = __builtin_rintf((us_ + PROBE_QOFF) * (1.f / 16.f)) * 8e-3f; } } ++step;
#else
#define STEP_BEGIN if (step >= lo && step < hi) {
#endif
#if defined(PROBE_STEP)
#elif defined(PROBE_DBLBAR)
#define STEP_END if (step + 1 < hi) { xcd_barrier(bar); xcd_barrier(bar); } } ++step;
#else
#define STEP_END if (step + 1 < hi) xcd_barrier(bar); } ++step;
#endif

    STEP_BEGIN
        if PH_ON(0) PH_REP(0) { p0_mod(F, cin, w_ada, b_ada, MOD);
        p0_cs(F, positions, CS);
        p0_lut(F, rel_bias, (float*)(ws + WS_LUT));
        p0_weights(F, w_in, w_uq, w_ukv, w_out, ws); }
    STEP_END
    STEP_BEGIN
        if PH_ON(1) PH_REP(1) p1_h(F, in_x, g_mix, MOD, t_H);
    STEP_END
    for (int b = 0; b < NB; ++b) {
        STEP_BEGIN
            pg8::Gemm g{(const bf16_t*)((const char*)t_H + (size_t)b * SEQ * DM * (FP8_G1 ? 1 : 2)), WIN, DM, DM, DM, 0, 0, nullptr, 0, 0}; pg8::StaticOrder S; S.init(SEQ, NP, F.G, (int)blockIdx.x);
            pg8::EpiP E{(unsigned char*)t_P, FP8_G1 ? W8_INV : 1.0f, 0};
            if PH_ON(2) PH_REP(2) {
#if defined(PROBE_NOSTORE)
                E.nostore = (rep_ == 0);
#endif
                pg8::gemm_phase<pg8::EpiP, pg8::StaticOrder, false, (FP8_G1 != 0)>(F.lds, F.wave, g, S, E); __syncthreads(); }
        STEP_END
        STEP_BEGIN
            if PH_ON(3) PH_REP(3) lb_latent(F, t_P, g_q, g_kv, CS + (size_t)b * SEQ * 64, CQN, CKVN, KB);
        STEP_END
        STEP_BEGIN
#if MLA_FP8
            { pg8::Gemm g{CQN, WUQ, 384, 384, 384, 0, 0, nullptr, 0, 0}; pg8::StaticOrder S; S.init(SEQ, 1536, F.G, (int)blockIdx.x);
              pg8::EpiQ8 E{(unsigned char*)QB, CS + (size_t)b * SEQ * 64};
              if PH_ON(4) PH_REP(4) { pg8::gemm_phase<pg8::EpiQ8, pg8::StaticOrder, false>(F.lds, F.wave, g, S, E); __syncthreads(); } }
            { pg8::Gemm g{CKVN, WUKV, 256, 256, 256, 0, 0, nullptr, 0, 0}; pg8::StaticOrder S; S.init(SEQ, 1024, F.G, (int)blockIdx.x);
              pg8::EpiK8 E{(unsigned char*)KB};
              if PH_ON(5) PH_REP(5) { pg8::gemm_phase<pg8::EpiK8, pg8::StaticOrder, false>(F.lds, F.wave, g, S, E); __syncthreads(); } }
            { pg8::Gemm g{WUKV + (size_t)1024 * 256, CKVN, 256, 256, 256, 0, 0, nullptr, 0, 0}; pg8::StaticOrder S; S.init(1024, SEQ, F.G, (int)((blockIdx.x + 128) % F.G));
              pg8::EpiVT8 E{(unsigned char*)VB};
              if PH_ON(5) PH_REP(5) { pg8::gemm_phase<pg8::EpiVT8, pg8::StaticOrder, false>(F.lds, F.wave, g, S, E); __syncthreads(); } }
#else
            { pg8::Gemm g{CQN, WUQ, 384, 384, 384, 0, 0, nullptr, 0, 0}; pg8::StaticOrder S; S.init(SEQ, 1536, F.G, (int)blockIdx.x);
              pg8::EpiQ E{QB, CS + (size_t)b * SEQ * 64};
              if PH_ON(4) PH_REP(4) { pg8::gemm_phase<pg8::EpiQ, pg8::StaticOrder, false>(F.lds, F.wave, g, S, E); __syncthreads(); } }
            __syncthreads();
            { pg8::Gemm g{CKVN, WUKV, 256, 256, 256, 0, 0, nullptr, 0, 0}; pg8::StaticOrder S; S.init(SEQ, 2048, F.G, (int)blockIdx.x);
              pg8::EpiKV E{KB, VB};
              if PH_ON(5) PH_REP(5) { pg8::gemm_phase<pg8::EpiKV, pg8::StaticOrder, false>(F.lds, F.wave, g, S, E); __syncthreads(); } }
#endif
        STEP_END
        STEP_BEGIN
            const int conv_at = ((int)blockIdx.x >> 3) & 3;
            if (conv_at == 0) { if PH_ON(10) PH_REP(10) conv_experts(F, w_gate, w_up, w_down, ws, b); }
            for (int u = blockIdx.x; u < 256; u += F.G) { const int hd = u & 7, qb = u >> 3;
#if MLA_FP8
                att::Unit8 a8{(const unsigned char*)QB + ((size_t)hd * SEQ + 256 * qb) * 192, (const unsigned char*)KB + (size_t)hd * SEQ * 192, (const unsigned char*)VB + (size_t)hd * SEQ * 128,
                              OA + (size_t)(256 * qb) * DM + hd * 128, DM, SEQ / 64, nullptr};
#if defined(PROBE_TIMING)
                a8.dbg = (blockIdx.x == PROBE_BLOCK && b == 3) ? (float*)(ctl + CW_DBG + 1) : nullptr;
#endif
                if PH_ON(6) PH_REP(6) att::attn_mla8_unit(a8, (LAS char*)F.lds, F.wave);
#else
                att::Unit a{};
                a.Q = QB + ((size_t)hd * SEQ + 256 * qb) * 192; a.qs = 192; a.K = KB + (size_t)hd * SEQ * 192; a.ks = 192; a.V = VB + (size_t)hd * SEQ * 128; a.vs = 128;
                a.O = OA + (size_t)(256 * qb) * DM + hd * 128; a.os = DM; a.nt = SEQ / 64;
#if defined(BREAK_MLA) && BREAK_MLA
                a.nt = SEQ / 64 - 2;
#endif
                a.tmul = 1;
#if defined(PROBE_TIMING)
                a.dbg = (blockIdx.x == PROBE_BLOCK && b == 3) ? (float*)(ctl + CW_DBG + 1) : nullptr;
#endif
#if defined(PROBE_SAMETILE)
                a.tmul = 0; att::attn_unit<false>(a, (LAS char*)F.lds, F.wave); a.tmul = 1;
#endif
                if PH_ON(6) PH_REP(6) att::attn_unit<false>(a, (LAS char*)F.lds, F.wave);
#endif
            }

            if (conv_at == 1) { if PH_ON(10) PH_REP(10) conv_experts(F, w_gate, w_up, w_down, ws, b); }
            for (int u = blockIdx.x; u < 768; u += F.G) { const int grp = u >> 8, w = u & 255, hd = w & 7, rest = w >> 3, d = grp == 0 ? 1 : (grp == 1 ? 4 : 16), cl = rest % d, qb = rest / d;
                att::Unit a{};
                const size_t tok0 = (size_t)256 * qb * d + cl; const char* gbase = (const char*)t_P + P_OFF_DIL + grp * P_GRP;
                a.Q = (const bf16_t*)(gbase + tok0 * PROW + hd * 128 * P_QK_ESZ); a.qs = d * (PROW / 2);
                a.K = (const bf16_t*)(gbase + (size_t)cl * PROW + 1024 * P_QK_ESZ + hd * 128 * P_QK_ESZ); a.ks = d * (PROW / 2);
                a.V = (const bf16_t*)(gbase + (size_t)cl * PROW + 2048 * P_QK_ESZ + hd * 256); a.vs = d * (PROW / 2);
                a.O = OG + ((size_t)grp * SEQ + tok0) * DM + hd * 128; a.os = d * DM; a.nt = 6; a.tmul = 1;
#if defined(PROBE_TIMING)
                a.dbg = (blockIdx.x == PROBE_BLOCK && b == 3 && grp == PROBE_GRP) ? (float*)(ctl + CW_DBG + 1) : nullptr;
#endif
                a.kt0 = 4 * qb - 1; a.ktn = (SEQ / d) / 64; a.l0 = 256 * qb; a.pos = positions + (size_t)b * SEQ + cl; a.ps = d;
                a.lse = LSE + ((size_t)grp * SEQ + tok0) * 8 + hd; a.ls = d * 8; a.bias = rel_bias + grp * 8 + hd; a.lutg = (const float*)(ws + WS_LUT) + (grp * 8 + hd) * 2304;
                if PH_ON(7) PH_REP(7) att::attn_unit<true>(a, (LAS char*)F.lds, F.wave);
                if (conv_at == 2 && u == (int)blockIdx.x) { if PH_ON(10) PH_REP(10) conv_experts(F, w_gate, w_up, w_down, ws, b); } }
            if (conv_at == 3) { if PH_ON(10) PH_REP(10) conv_experts(F, w_gate, w_up, w_down, ws, b); }
        STEP_END
        STEP_BEGIN
            if PH_ON(8) PH_REP(8) lb_combine(F, t_P, OA, OG, LSE, (bf16_t*)((char*)t_U + (size_t)b * SEQ * DM * (FP8_WO ? 1 : 2)));
        STEP_END
#if defined(MK_CHECK) && MK_CHECK
        STEP_BEGIN
#if !defined(CHK_MEASURE) && !defined(CHK_ONLY_DIL)
            chk::check_proj(F, b, ctl, t_P, CQN, CKVN, QB, KB, VB, g_q, g_kv, w_uq, w_ukv, positions);
            chk::check_dil(F, b, ctl, t_P, positions, rel_bias, OG, LSE);
            chk::check_u(F, b, ctl, t_P, OA, OG, LSE, t_U + (size_t)b * SEQ * DM);
#endif
#if defined(CHK_ONLY_DIL)
            chk::check_dil(F, b, ctl, t_P, positions, rel_bias, OG, LSE);
#else
            chk::check_mla(F, b, ctl, QB, KB, VB, OA);
#endif
        STEP_END
#endif
    }
    STEP_BEGIN
        { pg8::Gemm g{t_U, WOUT, DM, DM, DM, 0, 0, nullptr, 0, 0}; pg8::StaticOrder S; S.init(NTOK, DM, F.G, (int)blockIdx.x);
          pg8::EpiRes E{in_x, t_out, MOD, FP8_WO ? W8_INV * (1.0f / U8_SCALE) : 1.0f};
          if PH_ON(9) PH_REP(9) { pg8::gemm_phase<pg8::EpiRes, pg8::StaticOrder, false, (FP8_WO != 0)>(F.lds, F.wave, g, S, E); __syncthreads(); } }
    STEP_END
    STEP_BEGIN
        if PH_ON(11) PH_REP(11) pg_h2_router(F, t_out, g_ffn, MOD, w_router, t_H, AFFT);
    STEP_END
    STEP_BEGIN
        if PH_ON(12) PH_REP(12) ph_topk(F, AFFT, TOPI, TOPG, SLOT);
    STEP_END
    static_assert(FP8_EX != 0, "the all-batch FFN workspace map assumes fp8 expert operands");
    STEP_BEGIN
        { pg8::Gemm g{t_H, WGU, DM, DM, DM, 0, (long)4096 * 1024, TOPI, CAP, NE}; pg8::GroupOrder S; S.init(4, 16, NB * NE, F.G, (int)blockIdx.x);
          pg8::EpiSwiGLU E{(void*)HID, W8_INV};
          if PH_ON(13) PH_REP(13) { pg8::gemm_phase<pg8::EpiSwiGLU, pg8::GroupOrder, true, true>(F.lds, F.wave, g, S, E); __syncthreads(); } }
    STEP_END
    STEP_BEGIN
        { pg8::Gemm g{HID, WD, DFF, DFF, DFF, (long)CAP * DFF, (long)DM * DFF, nullptr, 0, NE}; pg8::GroupOrder S; S.init(4, 4, NB * NE, F.G, (int)blockIdx.x);
          pg8::EpiDown E{t_Y, TOPG, W8_INV};
          if PH_ON(14) PH_REP(14) { pg8::gemm_phase<pg8::EpiDown, pg8::GroupOrder, false, true>(F.lds, F.wave, g, S, E); __syncthreads(); } }
    STEP_END
    STEP_BEGIN
        if PH_ON(15) PH_REP(15) p_final(F, t_out, MOD, SLOT, t_Y, g_final, DBG_SCALE());
    STEP_END
#undef STEP_BEGIN
#undef STEP_END
}
#undef IN_F
#undef in_x
#undef cin
#undef positions
#undef w_ada
#undef b_ada
#undef g_mix
#undef w_in
#undef g_q
#undef g_kv
#undef w_uq
#undef w_ukv
#undef rel_bias
#undef w_out
#undef g_ffn
#undef w_router
#undef w_gate
#undef w_up
#undef w_down
#undef g_final
#undef t_out
#undef WSP
#undef MOD
#undef CS
#undef WIN
#undef WUQ
#undef WUKV
#undef WOUT
#undef t_H
#undef t_U
#undef t_P
#undef CQN
#undef CKVN
#undef QB
#undef KB
#undef VB
#undef OA
#undef OG
#undef LSE
#undef WGU
#undef WD
#undef HID
#undef t_Y
#undef AFFT
#undef TOPI
#undef TOPG
#undef SLOT
constexpr int STEPS_MIX = 5
#if defined(MK_CHECK) && MK_CHECK
    + 1
#endif
    ;
constexpr int N_STEPS = 2 + NB * STEPS_MIX + 3 + 3;

#ifndef MK_PER_STEP
#define MK_PER_STEP 0
#endif
extern "C" void kernel_launch(void* const* d_in, const int* in_sizes, int n_in, void* d_out, int out_size, void* d_ws, size_t ws_size, hipStream_t stream) {
    static int grid = 0;
    if (grid == 0) {
        if (n_in != 19 || out_size != NTOK * DM || ws_size < WS_END) { fprintf(stderr, "kernel_launch: unexpected shapes (n_in %d out %d ws %zu need %zu)\n", n_in, out_size, ws_size, (size_t)WS_END); grid = -1; return; }
        int dev = 0, cus = 0;
        if (hipGetDevice(&dev) != hipSuccess || hipDeviceGetAttribute(&cus, hipDeviceAttributeMultiprocessorCount, dev) != hipSuccess) { grid = -1; return; }
        if (hipFuncSetAttribute((const void*)fwd_kernel, hipFuncAttributeMaxDynamicSharedMemorySize, LDS_BYTES) != hipSuccess) { grid = -1; return; }
        int per_cu = 0;
        if (hipOccupancyMaxActiveBlocksPerMultiprocessor(&per_cu, (const void*)fwd_kernel, NWAVES * 64, LDS_BYTES) != hipSuccess || per_cu < 1) { fprintf(stderr, "kernel_launch: occupancy query says %d\n", per_cu); }
        (void)hipGetLastError();
        grid = cus;
    }
    if (grid < 0) return;
    if (hipMemsetAsync((char*)d_ws + WS_CTL, 0, CTL_ZERO_BYTES, stream) != hipSuccess) return;
    Args a{};
    for (int i = 0; i < 19; ++i) a.in[i] = d_in[i];
    a.out = (float*)d_out; a.ws = (unsigned char*)d_ws;
#if MK_PER_STEP
    for (int s = 0; s < N_STEPS; ++s) { a.st_lo = s; a.st_hi = s + 1; hipLaunchKernelGGL(fwd_kernel, dim3(grid), dim3(NWAVES * 64), LDS_BYTES, stream, a); }
#else
    a.st_lo = 0; a.st_hi = N_STEPS;
    hipLaunchKernelGGL(fwd_kernel, dim3(grid), dim3(NWAVES * 64), LDS_BYTES, stream, a);
#endif
    const hipError_t le = hipPeekAtLastError();
    if (le != hipSuccess) fprintf(stderr, "kernel_launch: launch failed: %s\n", hipGetErrorName(le));
}
```

```cpp
#include <hip/hip_runtime.h>
#include <cstdio>
#include <cstdint>

#define LAS __attribute__((address_space(3)))
#define GAS __attribute__((address_space(1)))
typedef unsigned short bf16_t;
typedef short bf16x8 __attribute__((ext_vector_type(8)));
typedef short s16x4 __attribute__((ext_vector_type(4)));
typedef float f32x2 __attribute__((ext_vector_type(2)));
typedef float f32x4 __attribute__((ext_vector_type(4)));
typedef float f32x16 __attribute__((ext_vector_type(16)));
typedef unsigned u32x2 __attribute__((ext_vector_type(2)));
typedef unsigned u32x4 __attribute__((ext_vector_type(4)));
typedef int i32x4 __attribute__((ext_vector_type(4)));

#ifndef MK_FP8
#define MK_FP8 1
#endif
#ifndef DIL_FP8
#define DIL_FP8 1
#endif
constexpr int NB = 4, SEQ = 8192, DM = 1024, NTOK = NB * SEQ;
constexpr int NP = 12032;
constexpr int C_CQ = 0, C_CKV = 384, C_KPE = 640, C_DIL = 704, C_GATE = 9920, D_IN = 11968;
constexpr int NE = 16, CAP = 1024, DFF = 2048;
constexpr int P_QK_ESZ = DIL_FP8 ? 1 : 2, P_GRP = 2 * 1024 * P_QK_ESZ + 2048, P_OFF_DIL = 1408, P_OFF_GATE = P_OFF_DIL + 3 * P_GRP, PROW = P_OFF_GATE + 2 * (2048 + 64);
__host__ __device__ constexpr int p_col_off(int c) {
    return c < C_DIL ? 2 * c : (c < C_GATE ? (P_OFF_DIL + ((c - C_DIL) / 3072) * P_GRP + ((((c - C_DIL) % 3072) >> 10) == 2 ? 2048 * P_QK_ESZ + 2 * (((c - C_DIL) % 3072) & 1023) : ((((c - C_DIL) % 3072) >> 10) * 1024 + (((c - C_DIL) % 3072) & 1023)) * P_QK_ESZ)) : P_OFF_GATE + 2 * (c - C_GATE)); }
__host__ __device__ constexpr bool p_col_f8(int c) { return DIL_FP8 && c >= C_DIL && c < C_GATE && ((((c - C_DIL) % 3072) >> 10) != 2); }
constexpr float NORM_EPS = 1e-6f;
constexpr float LOG2E = 1.4426950408889634f;

constexpr size_t MiB = 1u << 20;
constexpr size_t WS_CTL = 0, CTL_ZERO_BYTES = 1 * MiB;
constexpr size_t WS_MOD = 1 * MiB;
constexpr size_t WS_CS = 2 * MiB;
constexpr size_t WS_WIN = 10 * MiB;
constexpr size_t WS_WUQ = 34 * MiB;
constexpr size_t WS_WUKV = 36 * MiB;
constexpr size_t WS_WOUT = 37 * MiB;
constexpr size_t WS_H = 40 * MiB;
constexpr size_t WS_U = 104 * MiB;
constexpr size_t WS_R = 168 * MiB;
constexpr size_t WS_P = WS_R;
constexpr size_t WS_CQN = WS_R + 188 * MiB;
constexpr size_t WS_CKVN = WS_R + 194 * MiB;
constexpr size_t WS_QB = WS_R + 198 * MiB;
constexpr size_t WS_KB = WS_R + 222 * MiB;
constexpr size_t WS_VB = WS_R + 246 * MiB;
constexpr size_t WS_OA = WS_R + 262 * MiB;
constexpr size_t WS_OG = WS_R + 278 * MiB;
constexpr size_t WS_LSE = WS_R + 326 * MiB;
constexpr size_t WS_WGU = WS_R + 358 * MiB;
constexpr size_t WS_WD = WS_U + 32 * MiB;
constexpr size_t WS_X1 = WS_R;
constexpr size_t WS_HID = WS_R + 96 * MiB;
constexpr size_t WS_Y = WS_R + 224 * MiB;
constexpr size_t WS_AFFT = WS_R + 352 * MiB;
constexpr size_t WS_TOPI = WS_R + 354 * MiB;
constexpr size_t WS_TOPG = WS_R + 355 * MiB;
constexpr size_t WS_SLOT = WS_R + 356 * MiB;
constexpr size_t WS_END = WS_R + 422 * MiB;
constexpr size_t WS_LUT = 1 * MiB + 512 * 1024;
constexpr int CW_TMO = 0, CW_DBG = 16, CW_BAR = 4096;

constexpr int RING_BYTES = 131072;
constexpr int MISC_OFF = RING_BYTES + 320;
constexpr int LDS_BYTES = 147456;
constexpr int NWAVES = 8;

#define RLX_AGENT __ATOMIC_RELAXED, __HIP_MEMORY_SCOPE_AGENT
#define LDS_WAIT() asm volatile("s_waitcnt lgkmcnt(0)" ::: "memory")
#define VM_WAIT() asm volatile("s_waitcnt vmcnt(0)" ::: "memory")

__device__ __forceinline__ unsigned cvt_pk_bf16(float lo, float hi) { unsigned r; asm volatile("v_cvt_pk_bf16_f32 %0, %1, %2" : "=v"(r) : "v"(lo), "v"(hi)); return r; }
__device__ __forceinline__ float bf2f(unsigned short v) { return __uint_as_float(((unsigned)v) << 16); }
__device__ __forceinline__ float bflo(unsigned w) { return __uint_as_float(w << 16); }
__device__ __forceinline__ float bfhi(unsigned w) { return __uint_as_float(w & 0xffff0000u); }
#define SWZ_XOR(k) (((k) << 10) | 0x1f)
#if defined(OLD_WAVE_SUM)
__device__ __forceinline__ float wave_sum(float v) { for (int o = 1; o < 64; o <<= 1) v += __shfl_xor(v, o); return v; }
#else
__device__ __forceinline__ float wave_sum(float v) {
    v += __int_as_float(__builtin_amdgcn_ds_swizzle(__float_as_int(v), SWZ_XOR(1)));
    v += __int_as_float(__builtin_amdgcn_ds_swizzle(__float_as_int(v), SWZ_XOR(2)));
    v += __int_as_float(__builtin_amdgcn_ds_swizzle(__float_as_int(v), SWZ_XOR(4)));
    v += __int_as_float(__builtin_amdgcn_ds_swizzle(__float_as_int(v), SWZ_XOR(8)));
    v += __int_as_float(__builtin_amdgcn_ds_swizzle(__float_as_int(v), SWZ_XOR(16)));
    { auto rr = __builtin_amdgcn_permlane32_swap(__float_as_uint(v), __float_as_uint(v), false, false); v = __uint_as_float(rr[0]) + __uint_as_float(rr[1]); }
    return v;
}
#endif
__device__ __forceinline__ float wave_max(float v) {
    v = fmaxf(v, __int_as_float(__builtin_amdgcn_ds_swizzle(__float_as_int(v), SWZ_XOR(1))));
    v = fmaxf(v, __int_as_float(__builtin_amdgcn_ds_swizzle(__float_as_int(v), SWZ_XOR(2))));
    v = fmaxf(v, __int_as_float(__builtin_amdgcn_ds_swizzle(__float_as_int(v), SWZ_XOR(4))));
    v = fmaxf(v, __int_as_float(__builtin_amdgcn_ds_swizzle(__float_as_int(v), SWZ_XOR(8))));
    v = fmaxf(v, __int_as_float(__builtin_amdgcn_ds_swizzle(__float_as_int(v), SWZ_XOR(16))));
    { auto rr = __builtin_amdgcn_permlane32_swap(__float_as_uint(v), __float_as_uint(v), false, false); v = fmaxf(__uint_as_float(rr[0]), __uint_as_float(rr[1])); }
    return v;
}
__device__ __forceinline__ float fast_sigmoid(float x) { return __builtin_amdgcn_rcpf(1.f + __builtin_amdgcn_exp2f(-x * LOG2E)); }
#ifndef MK_FP8
#define MK_FP8 1
#endif
#ifndef MLA_NM16
#define MLA_NM16 1
#endif
#ifndef MLA_PKADD
#define MLA_PKADD 0
#endif
#ifndef MLA_PKOLD
#define MLA_PKOLD 0
#endif
#ifndef MLA_XPRIO
#define MLA_XPRIO 0
#endif
#ifndef MLA_XPRIO_B
#define MLA_XPRIO_B 0
#endif
#ifndef MLA_SWAP_ROLES
#define MLA_SWAP_ROLES 0
#endif
#ifndef PG8_PRIO_WIDE
#define PG8_PRIO_WIDE 1
#endif
#ifndef DIL_XPRIO
#define DIL_XPRIO 0
#endif
#ifndef PG8_PRIO
#define PG8_PRIO 1
#endif
#ifndef CONV_NT
#define CONV_NT 0
#endif
#ifndef EPIP_SC1
#define EPIP_SC1 0
#endif
#ifndef GEMM_RELAX
#define GEMM_RELAX 0
#endif
#ifndef DIL_2S
#define DIL_2S 0
#endif
#ifndef MLA_STATIC_PRIO_A
#define MLA_STATIC_PRIO_A 1
#endif
#ifndef MLA_STATIC_PRIO
#define MLA_STATIC_PRIO 0
#endif
#ifndef MLA_T15
#define MLA_T15 0
#endif
#ifndef MLA_ILV
#define MLA_ILV 0
#endif
#ifndef MLA_SPRIO
#define MLA_SPRIO 0
#endif
#ifndef MLA_SPRIO_A
#define MLA_SPRIO_A 0
#endif
#ifndef MLA_LEAD3
#define MLA_LEAD3 1
#endif
#ifndef MLA_DIL_HOOK
#define MLA_DIL_HOOK 0
#endif
#ifndef MLA_PRE
#define MLA_PRE 1
#endif
#ifndef MLA_2T
#define MLA_2T 0
#endif
#ifndef MLA_LSUM
#define MLA_LSUM 1
#endif
#ifndef MLA_FP8
#define MLA_FP8 1
#endif
#ifndef FP8_G1
#define FP8_G1 MK_FP8
#endif
#ifndef FP8_EX
#define FP8_EX MK_FP8
#endif
#ifndef FP8_WO
#define FP8_WO 1
#endif
constexpr float QK_LOG2_SCALE = 0.072168783648703220f * LOG2E;
constexpr float W8_SCALE = 64.0f, W8_INV = 1.0f / 64.0f;
constexpr float U8_SCALE = 16.0f;
typedef int v8i __attribute__((ext_vector_type(8)));
__device__ __forceinline__ unsigned pk4_fp8(float a, float b, float c, float d) { int w = __builtin_amdgcn_cvt_pk_fp8_f32(a, b, 0, false); w = __builtin_amdgcn_cvt_pk_fp8_f32(c, d, w, true); return (unsigned)w; }
#if defined(OLD_TID)
__device__ __forceinline__ int opaque_tid(int wv) { int t = (int)threadIdx.x; asm volatile("" : "+v"(t)); return t; }
#else
__device__ __forceinline__ int opaque_tid(int wv) { int l; asm volatile("v_mbcnt_lo_u32_b32 %0, -1, 0\n\tv_mbcnt_hi_u32_b32 %0, -1, %0" : "=v"(l)); return (wv << 6) | l; }
#endif
struct Frame {
    LAS unsigned char* lds;
    int tid, lane, wave, vcu, G, gw, NGW;
};
struct Args { const void* in[19]; float* out; unsigned char* ws; int st_lo, st_hi; };

#define XB_TMO      128
#define XB_XCNT(j)  (256  + 64 * (j))
#define XB_XSUB(j)  (1280 + 64 * (j))
#define XB_XGEN(j)  (2304 + 64 * (j))
#define XB_TOP      3328
#define XB_TOPGEN   3392
#define XCD_BAR_WORDS 3456
#define XB_SPIN_CAP (1u << 18)

__device__ __forceinline__ unsigned xb_ld(unsigned* p)              { return __hip_atomic_load(p, __ATOMIC_RELAXED, __HIP_MEMORY_SCOPE_AGENT); }
__device__ __forceinline__ unsigned xb_add(unsigned* p, unsigned v) { return __hip_atomic_fetch_add(p, v, __ATOMIC_RELAXED, __HIP_MEMORY_SCOPE_AGENT); }
__device__ __forceinline__ unsigned xb_xcc_id() { return (unsigned)__builtin_amdgcn_s_getreg((3 << 11) | 20) & 0xFu; }
#define XB_SPIN(cond, bar) do { unsigned _sp = 0; while (cond) { __builtin_amdgcn_s_sleep(1); \
    if ((++_sp & 255u) == 0u) { if (xb_ld(&(bar)[XB_TMO])) break; if (_sp > XB_SPIN_CAP) { atomicAdd(&(bar)[XB_TMO], 1u); break; } } } } while (0)

struct XcdBarrier {
    unsigned* bar; unsigned x;
    int wv;
    volatile LAS unsigned* st;
};

__device__ __forceinline__ XcdBarrier xcd_barrier_post(unsigned* bar, volatile LAS unsigned* st) {
    XcdBarrier b; b.bar = bar; b.x = xb_xcc_id(); b.st = st;
    if (threadIdx.x == 0) (void)xb_add(&bar[XB_XCNT(b.x)], 1u);
    return b;
}
__device__ __forceinline__ void xcd_barrier_complete(unsigned* bar, unsigned x, unsigned& nloc, unsigned& nx) {
    const unsigned G = gridDim.x * gridDim.y * gridDim.z;
    unsigned sum, cnt, mine, sp = 0u;
    for (;;) {
        sum = 0u; cnt = 0u; mine = 0u;
#pragma unroll
        for (unsigned j = 0; j < 16; ++j) { const unsigned c = xb_ld(&bar[XB_XCNT(j)]); sum += c; cnt += (c > 0u) ? 1u : 0u; mine = (j == x) ? c : mine; }
        if (sum == G) break;
        __builtin_amdgcn_s_sleep(1);
        if ((++sp & 255u) == 0u) { if (xb_ld(&bar[XB_TMO])) break; if (sp > XB_SPIN_CAP) { atomicAdd(&bar[XB_TMO], 1u); break; } }
    }
    nloc = mine > 0u ? mine : 1u; nx = cnt > 0u ? cnt : 1u;
}

__device__ __forceinline__ void xcd_barrier(const XcdBarrier& b) {
    asm volatile("s_waitcnt vmcnt(0)" ::: "memory");
    __syncthreads();
    if (b.wv == 0 && opaque_tid(0) == 0) {
        unsigned* bar = b.bar;
        __builtin_amdgcn_s_waitcnt(0);
        unsigned nloc = b.st[0], nx = b.st[1];
        if (nloc == 0u) { xcd_barrier_complete(bar, b.x, nloc, nx); b.st[0] = nloc; b.st[1] = nx; }
        const unsigned old = xb_add(&bar[XB_XSUB(b.x)], 1u);
        const unsigned gen = old / nloc;
        if (old + 1u == (gen + 1u) * nloc) {
            __builtin_amdgcn_fence(__ATOMIC_RELEASE, "agent");
            asm volatile("s_waitcnt vmcnt(0)" ::: "memory");
            const unsigned og = xb_add(&bar[XB_TOP], 1u);
            const unsigned tg = og / nx;
            if (og + 1u == (tg + 1u) * nx) xb_add(&bar[XB_TOPGEN], 1u);
            else XB_SPIN(xb_ld(&bar[XB_TOPGEN]) == tg, bar);
            __builtin_amdgcn_fence(__ATOMIC_ACQUIRE, "agent");
            xb_add(&bar[XB_XGEN(b.x)], 1u);
            asm volatile("s_waitcnt vmcnt(0)" ::: "memory");
        } else {
            XB_SPIN(xb_ld(&bar[XB_XGEN(b.x)]) == gen, bar);
            __builtin_amdgcn_fence(__ATOMIC_ACQUIRE, "agent");
            asm volatile("s_waitcnt vmcnt(0)" ::: "memory");
        }
    }
    __syncthreads();
}

namespace pg8 {
constexpr int BM = 256, BK = 64, HALF = 128, HTB = HALF * BK * 2  , STAGE_BYTES = 8 * HTB, NXCD = 8, WGM = 8;

__host__ __device__ __forceinline__ int lds_byte(int r, int c) { const int st = (r >> 4) * 2 + (c >> 5), rr = r & 15, cc = c & 31, ob = rr * 64 + cc * 2; return st * 1024 + (ob ^ (((ob >> 9) & 1) << 5)); }
__host__ __device__ __forceinline__ void stage_rc(int b, int& R, int& C) { const int st = b / 1024, sb = b % 1024, swz = sb ^ (((sb >> 9) & 1) << 5); R = (st >> 1) * 16 + swz / 64; C = (st & 1) * 32 + (swz % 64) / 2; }
__host__ __device__ __forceinline__ int perm32(int rho) { const int n = rho >> 4, i = rho & 15; return 8 * (i >> 2) + 4 * n + (i & 3); }

struct Unit { int pm, pn, g; };
struct Gemm { const bf16_t* A; const bf16_t* Bt; int lda, ldb, K; long a_gs, b_gs; const int* idx; int idx_gs; int b_gmod; };

struct StaticOrder {
    int nM, nN, nwg, G, c;
    __device__ __forceinline__ void init(int M, int N, int G_, int c_) { nM = M / BM; nN = N / BM; nwg = nM * nN; G = G_; c = c_; }
    __device__ __forceinline__ bool next(int i, Unit& u) const {
        const long L = (long)i * G + c; if (L >= nwg) return false;
        int wgid = (int)L; { const int q = nwg / NXCD, r = nwg % NXCD, xcd = wgid % NXCD, off = wgid / NXCD; wgid = (xcd < r ? xcd * (q + 1) : r * (q + 1) + (xcd - r) * q) + off; }
        const int nig = WGM * nN, gid = wgid / nig, fm = gid * WGM, gsz = (nM - fm) < WGM ? (nM - fm) : WGM;
        u.pm = fm + ((wgid % nig) % gsz); u.pn = (wgid % nig) / gsz; u.g = 0; return true;
    }
};
struct GroupOrder {
    int nM, nN, nwg, G, v, gperm;
    __device__ __forceinline__ void init(int nM_, int nN_, int nG, int G_, int c_) { nM = nM_; nN = nN_; nwg = nM_ * nN_ * nG; G = G_; gperm = (nG == 64); v = (G_ % 8 == 0) ? (c_ % 8) * (G_ / 8) + c_ / 8 : c_; }
    __device__ __forceinline__ bool next(int i, Unit& u) const {
        const long L = (long)i * G + v; if (L >= nwg) return false;
        const int w = (int)L, gi = w / (nM * nN); u.pm = w % nM; u.pn = (w / nM) % nN;
        u.g = gperm ? (gi & 3) * 16 + (gi >> 2) : gi;
        return true;
    }
};

template <class Epi, class Sched, bool GATHER, bool FP8 = false>
__device__ __forceinline__ void gemm_phase(LAS unsigned char* lds, int wv, const Gemm g, const Sched& S, const Epi& E) {
    const int tid = opaque_tid(wv), wid = __builtin_amdgcn_readfirstlane(tid >> 6), lane = tid & 63, wr = wid >> 2, wc = wid & 3, fr = lane & 15, fq = lane >> 4;
    constexpr int ESZ = FP8 ? 1 : 2;
    const int K = g.K, nt = K * ESZ / (BK * 2);
    int Rr[2], Cc[2]; unsigned voffB[2];
#pragma unroll
    for (int i = 0; i < 2; ++i) { int R, C; stage_rc(tid * 16 + i * 8192, R, C); Rr[i] = R; Cc[i] = C; const int Rb = (Epi::PERM && !Epi::BPRE) ? ((R & ~31) + perm32(R & 31)) : R;
        voffB[i] = (unsigned)(Rb * g.ldb * ESZ + C * 2); }
    const unsigned kstep = (unsigned)(BK * 2);
    const unsigned hstepA = (unsigned)(HALF * g.lda * ESZ), hstepB = (unsigned)(HALF * g.ldb * ESZ);
    const unsigned ldsw = (unsigned)wid * 1024u;
    const int aoff = lds_byte(wr * 64 + fr, fq * 8), boff = lds_byte(wc * 32 + fr, fq * 8);
#define PG8_SA(b, h) (((b) * 2 + (h)) * HTB)
#define PG8_SB(b, h) ((4 + (b) * 2 + (h)) * HTB)
    const __amdgpu_buffer_rsrc_t rsA = __builtin_amdgcn_make_buffer_rsrc((void*)g.A, 0, 0x7fffffff, 0x00020000), rsB = __builtin_amdgcn_make_buffer_rsrc((void*)g.Bt, 0, 0x7fffffff, 0x00020000);
#ifndef PG8_BUFFER_DMA
#define PG8_BUFFER_DMA 1
#endif
#if PG8_BUFFER_DMA
#define PG8_STAGE(bufoff, rs, so, v0, v1) do { \
        __builtin_amdgcn_raw_ptr_buffer_load_lds(rs, (LAS void*)(lds + (bufoff) + ldsw), 16, (v0), (so), 0, 0); \
        __builtin_amdgcn_raw_ptr_buffer_load_lds(rs, (LAS void*)(lds + (bufoff) + ldsw + 8192), 16, (v1), (so), 0, 0); } while (0)
#else
#define PG8_GBASE(rs) ((const char*)(__builtin_bit_cast(u32x4, rs).x | ((unsigned long long)(__builtin_bit_cast(u32x4, rs).y & 0xffffu) << 32)))
#define PG8_STAGE(bufoff, rs, so, v0, v1) do { const char* gb_ = (&rs == &rsA ? (const char*)g.A : (const char*)g.Bt) + (so); \
        __builtin_amdgcn_global_load_lds((const unsigned*)(gb_ + (v0)), (LAS unsigned*)(lds + (bufoff) + ldsw), 16, 0, 0); \
        __builtin_amdgcn_global_load_lds((const unsigned*)(gb_ + (v1)), (LAS unsigned*)(lds + (bufoff) + ldsw + 8192), 16, 0, 0); } while (0)
#endif
#define PG8_STAGEB(bufoff, so) PG8_STAGE(bufoff, rsB, so, voffB[0], voffB[1])
#define PG8_CAT(x_, y_) __builtin_shufflevector(__builtin_bit_cast(i32x4, x_), __builtin_bit_cast(i32x4, y_), 0, 1, 2, 3, 4, 5, 6, 7)
#define PG8_LO(v_) __builtin_bit_cast(bf16x8, __builtin_shufflevector(v_, v_, 0, 1, 2, 3))
#define PG8_HI(v_) __builtin_bit_cast(bf16x8, __builtin_shufflevector(v_, v_, 4, 5, 6, 7))
#define PG8_LDA(dst, b, h) do { _Pragma("unroll") for (int m = 0; m < 4; ++m) dst[m] = PG8_CAT(*(const LAS bf16x8*)(lds + PG8_SA(b, h) + aoff + m * 2048), *(const LAS bf16x8*)(lds + PG8_SA(b, h) + aoff + m * 2048 + 1024)); } while (0)
#define PG8_LDB(dst, b, h) do { _Pragma("unroll") for (int n = 0; n < 2; ++n) dst[n] = PG8_CAT(*(const LAS bf16x8*)(lds + PG8_SB(b, h) + boff + n * 2048), *(const LAS bf16x8*)(lds + PG8_SB(b, h) + boff + n * 2048 + 1024)); } while (0)
#define PG8_MMA(ai, bj, At, Bt) do { if (PG8_PRIO) __builtin_amdgcn_s_setprio(PG8_PRIO); _Pragma("unroll") for (int m = 0; m < 4; ++m) _Pragma("unroll") for (int n = 0; n < 2; ++n) { \
        if constexpr (FP8) acc[ai][bj][m][n] = __builtin_amdgcn_mfma_scale_f32_16x16x128_f8f6f4(Bt[n], At[m], acc[ai][bj][m][n], 0, 0, 0, 0, 0, 0);   \
        else { acc[ai][bj][m][n] = __builtin_amdgcn_mfma_f32_16x16x32_bf16(PG8_LO(Bt[n]), PG8_LO(At[m]), acc[ai][bj][m][n], 0, 0, 0); \
               acc[ai][bj][m][n] = __builtin_amdgcn_mfma_f32_16x16x32_bf16(PG8_HI(Bt[n]), PG8_HI(At[m]), acc[ai][bj][m][n], 0, 0, 0); } } \
        if (PG8_PRIO) __builtin_amdgcn_s_setprio(0); } while (0)
#define PG8_WAIT_V(n) asm volatile("s_waitcnt vmcnt(" #n ")" ::: "memory")
#define PG8_WAIT_VN(n_) asm volatile("s_waitcnt vmcnt(%0)" :: "n"(n_) : "memory")
#define PG8_WV(k_) do { if (GEMM_RELAX && Epi::NST > 0 && relax) { if ((k_) < 2) PG8_WAIT_VN(8 + Epi::NST); else if ((k_) == 2) PG8_WAIT_VN(10 + Epi::NST); else PG8_WAIT_VN(14); } else PG8_WAIT_V(8); } while (0)
#define PG8_WAIT_L(n) asm volatile("s_waitcnt lgkmcnt(" #n ")" ::: "memory")
#define PG8_PHI() do { if (PG8_PRIO_WIDE) __builtin_amdgcn_s_setprio(1); } while (0)
#define PG8_BAR __builtin_amdgcn_s_barrier()
#define PG8_SCHED __builtin_amdgcn_sched_barrier(0)
    Unit cur, nxt; int ui = 0;
    if (!S.next(0, cur)) return;
    f32x4 acc[2][2][4][2];
#pragma unroll
    for (int a = 0; a < 2; ++a)
#pragma unroll
        for (int b = 0; b < 2; ++b)
#pragma unroll
            for (int m = 0; m < 4; ++m)
#pragma unroll
                for (int n = 0; n < 2; ++n) acc[a][b][m][n] = (f32x4){0.f, 0.f, 0.f, 0.f};
    v8i At[4], B0[2], B1[2];
    unsigned voffA[2]; unsigned oc[2][2], on[2][2];
#pragma unroll
    for (int i = 0; i < 2; ++i) voffA[i] = (unsigned)(Rr[i] * g.lda * ESZ + Cc[i] * 2);
    unsigned cA, cB;
#define PG8_UNIT_PTRS(u, pA, pB, o) do { \
        pB = (unsigned)(((size_t)(g.b_gmod ? (u).g % g.b_gmod : (u).g) * g.b_gs + (size_t)(u).pn * BM * g.ldb) * ESZ); \
        if constexpr (GATHER) { \
            pA = 0u; \
            const int* ix_ = g.idx + (size_t)(u).g * g.idx_gs + (u).pm * BM; const int t_ = opaque_tid(wv); \
            _Pragma("unroll") for (int i = 0; i < 2; ++i) { int R_, C_; stage_rc(t_ * 16 + i * 8192, R_, C_); \
                _Pragma("unroll") for (int h = 0; h < 2; ++h) o[h][i] = (unsigned)ix_[h * HALF + R_] * (unsigned)(g.lda * ESZ) + (unsigned)C_ * 2u; } \
        } else { \
            pA = (unsigned)(((size_t)(u).g * g.a_gs + (size_t)(u).pm * BM * g.lda) * ESZ); \
        } } while (0)
#define PG8_STAGEA(bufoff, p, o, h) do { if constexpr (GATHER) PG8_STAGE(bufoff, rsA, p, o[h][0], o[h][1]); else PG8_STAGE(bufoff, rsA, (p) + (h) * hstepA, voffA[0], voffA[1]); } while (0)
    PG8_UNIT_PTRS(cur, cA, cB, oc);
    PG8_STAGEB(PG8_SB(0, 0), cB); PG8_STAGEB(PG8_SB(0, 1), cB + hstepB); PG8_STAGEA(PG8_SA(0, 0), cA, oc, 0); PG8_STAGEA(PG8_SA(0, 1), cA, oc, 1);
    if (wr == 1) PG8_BAR;
    PG8_WAIT_V(2); PG8_BAR;
    PG8_STAGEB(PG8_SB(1, 0), cB + kstep); PG8_STAGEA(PG8_SA(1, 0), cA + kstep, oc, 0); PG8_STAGEB(PG8_SB(1, 1), cB + hstepB + kstep);
    PG8_WAIT_V(6); PG8_BAR;
    for (;;) {
        const bool has_next = S.next(ui + 1, nxt);
        unsigned nA = cA, nB = cB;
        if constexpr (GATHER) {
#pragma unroll
            for (int h = 0; h < 2; ++h)
#pragma unroll
                for (int i = 0; i < 2; ++i) on[h][i] = oc[h][i];
        }
        if (has_next) PG8_UNIT_PTRS(nxt, nA, nB, on);
#pragma unroll 1
        for (int t = 0; t < nt; t += 2) {
            const bool last = (t == nt - 2), relax = (t == 0 && ui > 0);
            const unsigned a1 = cA + (unsigned)(t + 1) * kstep;
            const unsigned a2 = last ? nA : cA + (unsigned)(t + 2) * kstep, b2 = last ? nB : cB + (unsigned)(t + 2) * kstep;
            const unsigned a3 = a2 + kstep, b3 = b2 + kstep;
#define PG8_STAGEA2(bufoff, p, h) do { if constexpr (GATHER) { if (last) PG8_STAGEA(bufoff, p, on, h); else PG8_STAGEA(bufoff, p, oc, h); } else PG8_STAGEA(bufoff, p, oc, h); } while (0)
            PG8_PHI(); PG8_LDB(B0, 0, 0); PG8_LDB(B1, 0, 1); PG8_SCHED; PG8_LDA(At, 0, 0); PG8_STAGEA(PG8_SA(1, 1), a1, oc, 1);
            PG8_WV(0); PG8_WAIT_L(0); PG8_BAR; PG8_MMA(0, 0, At, B0); PG8_MMA(0, 1, At, B1); PG8_BAR; PG8_SCHED;
            PG8_PHI(); PG8_LDA(At, 0, 1); PG8_STAGEB(PG8_SB(0, 0), b2); PG8_STAGEB(PG8_SB(0, 1), b2 + hstepB); PG8_STAGEA2(PG8_SA(0, 0), a2, 0);
            PG8_WV(1); PG8_WAIT_L(0); PG8_BAR; PG8_MMA(1, 0, At, B0); PG8_MMA(1, 1, At, B1); PG8_BAR; PG8_SCHED;
            PG8_PHI(); PG8_LDB(B0, 1, 0); PG8_LDB(B1, 1, 1); PG8_SCHED; PG8_LDA(At, 1, 0); PG8_STAGEA2(PG8_SA(0, 1), a2, 1);
            PG8_WV(2); PG8_WAIT_L(0); PG8_BAR; PG8_MMA(0, 0, At, B0); PG8_MMA(0, 1, At, B1); PG8_BAR; PG8_SCHED;
            PG8_PHI(); PG8_LDA(At, 1, 1); PG8_STAGEB(PG8_SB(1, 0), b3); PG8_STAGEB(PG8_SB(1, 1), b3 + hstepB); PG8_STAGEA2(PG8_SA(1, 0), a3, 0);
            PG8_WV(3); PG8_WAIT_L(0); PG8_BAR; PG8_MMA(1, 0, At, B0); PG8_MMA(1, 1, At, B1); PG8_BAR; PG8_SCHED;
        }
        if (wr == 0) PG8_BAR;
        { const int l_ = opaque_tid(wv) & 63; E(acc, cur, wr, wc, l_ & 15, l_ >> 4); }
        if (!has_next) break;
#pragma unroll
        for (int a = 0; a < 2; ++a)
#pragma unroll
            for (int b = 0; b < 2; ++b)
#pragma unroll
                for (int m = 0; m < 4; ++m)
#pragma unroll
                    for (int n = 0; n < 2; ++n) acc[a][b][m][n] = (f32x4){0.f, 0.f, 0.f, 0.f};
        cur = nxt; cA = nA; cB = nB; ++ui;
        if constexpr (GATHER) {
#pragma unroll
            for (int h = 0; h < 2; ++h)
#pragma unroll
                for (int i = 0; i < 2; ++i) oc[h][i] = on[h][i];
        }
        if (wr == 1) PG8_BAR;
    }
    PG8_WAIT_V(0);
    PG8_BAR;
#undef PG8_UNIT_PTRS
#undef PG8_STAGEA
#undef PG8_STAGEA2
#undef PG8_SA
#undef PG8_SB
#undef PG8_STAGE
#undef PG8_STAGEB
#undef PG8_LDA
#undef PG8_LDB
#undef PG8_MMA
#undef PG8_CAT
#undef PG8_LO
#undef PG8_HI
#undef PG8_WAIT_V
#undef PG8_WAIT_L
#undef PG8_BAR
#undef PG8_SCHED
}

#define EPI_ROWLOOP for (int ai = 0; ai < 2; ++ai) _Pragma("unroll") for (int m = 0; m < 4; ++m)
__device__ __forceinline__ u32x4 pack8(const f32x4 v0, const f32x4 v1) { u32x4 w; w.x = cvt_pk_bf16(v0[0], v0[1]); w.y = cvt_pk_bf16(v0[2], v0[3]); w.z = cvt_pk_bf16(v1[0], v1[1]); w.w = cvt_pk_bf16(v1[2], v1[3]); return w; }
struct EpiBf16 {
    static constexpr bool PERM = true, BPRE = true; static constexpr int NST = 0;
    bf16_t* O; int ldc; float sc; int nostore;
    __device__ __forceinline__ void operator()(const f32x4 (&acc)[2][2][4][2], const Unit& u, int wr, int wc, int fr, int fq) const {
        const __amdgpu_buffer_rsrc_t rs = __builtin_amdgcn_make_buffer_rsrc((void*)O, 0, 0x7fffffff, 0x00020000);
        const unsigned lo = (unsigned)(fr * ldc + 8 * fq) * 2u, so = (unsigned)(((u.pm * BM + wr * 64) * ldc + u.pn * BM + wc * 32) * 2);
        if (nostore) return;
#pragma unroll
        EPI_ROWLOOP {
#pragma unroll
            for (int bj = 0; bj < 2; ++bj) {
#if !defined(EPI_BUF_STORES)
#if defined(EPI_NT_STORES_PROBE)
                __builtin_nontemporal_store(pack8(acc[ai][bj][m][0] * sc, acc[ai][bj][m][1] * sc), (u32x4*)((char*)O + (size_t)(so + (unsigned)((ai * HALF + m * 16) * ldc + bj * HALF) * 2u) + lo));
#else
                *(u32x4*)((char*)O + (size_t)(so + (unsigned)((ai * HALF + m * 16) * ldc + bj * HALF) * 2u) + lo) = pack8(acc[ai][bj][m][0] * sc, acc[ai][bj][m][1] * sc);
#endif
#else
                __builtin_amdgcn_raw_buffer_store_b128(pack8(acc[ai][bj][m][0] * sc, acc[ai][bj][m][1] * sc), rs, lo, so + (unsigned)((ai * HALF + m * 16) * ldc + bj * HALF) * 2u, 0);
#endif
            } }
    }
};
struct EpiP {
    static constexpr bool PERM = true, BPRE = true; static constexpr int NST = 16;
    unsigned char* P; float sc; int nostore;
    __device__ __forceinline__ void operator()(const f32x4 (&acc)[2][2][4][2], const Unit& u, int wr, int wc, int fr, int fq) const {
        if (nostore) return;
        const size_t rowb = (size_t)(u.pm * BM + wr * 64) * PROW;
#pragma unroll
        for (int bj = 0; bj < 2; ++bj) { const int c32 = u.pn * BM + bj * HALF + wc * 32; const bool f8 = p_col_f8(c32);
            char* ub = (char*)P + rowb + p_col_off(c32); const unsigned lo = (unsigned)(fr * PROW + (f8 ? 8 : 16) * fq);
#pragma unroll
            EPI_ROWLOOP { char* dst = ub + (size_t)(ai * HALF + m * 16) * PROW + lo; const f32x4 v0 = acc[ai][bj][m][0] * sc, v1 = acc[ai][bj][m][1] * sc;
#if EPIP_SC1
                if (f8) { u32x2 o; o.x = pk4_fp8(v0[0], v0[1], v0[2], v0[3]); o.y = pk4_fp8(v1[0], v1[1], v1[2], v1[3]); asm volatile("global_store_dwordx2 %0, %1, off sc1\n\ts_nop 1" :: "v"(dst), "v"(o) : "memory"); }
                else { const u32x4 w = pack8(v0, v1); asm volatile("global_store_dwordx4 %0, %1, off sc1\n\ts_nop 1" :: "v"(dst), "v"(w) : "memory"); }
#else
                if (f8) { u32x2 o; o.x = pk4_fp8(v0[0], v0[1], v0[2], v0[3]); o.y = pk4_fp8(v1[0], v1[1], v1[2], v1[3]); *(u32x2*)dst = o; }
                else *(u32x4*)dst = pack8(v0, v1);
#endif
                } }
    }
};
struct EpiQ {
    static constexpr bool PERM = true, BPRE = false; static constexpr int NST = 0;
    bf16_t* QB; const float* cs;
    __device__ __forceinline__ void operator()(const f32x4 (&acc)[2][2][4][2], const Unit& u, int wr, int wc, int fr, int fq) const {
        const unsigned lo = (unsigned)(fr * 192 + 8 * fq) * 2u, lcs = (unsigned)(fr * 64 + 8 * fq) * 4u;
        const int rowU = u.pm * BM + wr * 64;
#pragma unroll
        for (int bj = 0; bj < 2; ++bj) { const int c32 = u.pn * BM + bj * HALF + wc * 32, hd = c32 / 192, w32 = c32 - hd * 192;
            char* ub = (char*)(QB + ((size_t)hd * SEQ + rowU) * 192 + w32);
            const char* cb = (const char*)(cs + (size_t)rowU * 64 + (w32 >= 128 ? (w32 - 128) : 0));
#pragma unroll
            EPI_ROWLOOP { const int rr = ai * HALF + m * 16; f32x4 v0 = acc[ai][bj][m][0], v1 = acc[ai][bj][m][1];
                if (w32 >= 128) { const f32x4 ca = *(const f32x4*)(cb + (size_t)rr * 256 + lcs), cc = *(const f32x4*)(cb + (size_t)rr * 256 + 16 + lcs);
                    const f32x4 a = v0, b = v1;
                    v0[0] = a[0] * ca[0] - a[1] * ca[1]; v0[1] = a[0] * ca[1] + a[1] * ca[0]; v0[2] = a[2] * ca[2] - a[3] * ca[3]; v0[3] = a[2] * ca[3] + a[3] * ca[2];
                    v1[0] = b[0] * cc[0] - b[1] * cc[1]; v1[1] = b[0] * cc[1] + b[1] * cc[0]; v1[2] = b[2] * cc[2] - b[3] * cc[3]; v1[3] = b[2] * cc[3] + b[3] * cc[2]; }
                *(u32x4*)(ub + (size_t)rr * 384 + lo) = pack8(v0, v1);
                if (m & 1) asm volatile("" ::: "memory"); } }
    }
};
struct EpiKV {
    static constexpr bool PERM = true, BPRE = false; static constexpr int NST = 0;
    bf16_t* KB; bf16_t* VB;
    __device__ __forceinline__ void operator()(const f32x4 (&acc)[2][2][4][2], const Unit& u, int wr, int wc, int fr, int fq) const {
        const int rowU = u.pm * BM + wr * 64;
#pragma unroll
        for (int bj = 0; bj < 2; ++bj) { const int c32 = u.pn * BM + bj * HALF + wc * 32, hd = c32 >> 8, w32 = c32 & 255; const bool isk = w32 < 128;
            const int ld = isk ? 192 : 128;
            char* ub = (char*)(isk ? KB + ((size_t)hd * SEQ + rowU) * 192 + w32 : VB + ((size_t)hd * SEQ + rowU) * 128 + (w32 - 128));
            const unsigned lo = (unsigned)(fr * ld + 8 * fq) * 2u;
#pragma unroll
            EPI_ROWLOOP { *(u32x4*)(ub + (size_t)(ai * HALF + m * 16) * ld * 2 + lo) = pack8(acc[ai][bj][m][0], acc[ai][bj][m][1]); } }
    }
};
struct EpiQ8 {
    static constexpr bool PERM = true, BPRE = false; static constexpr int NST = 0;
    unsigned char* Q8; const float* cs;
    __device__ __forceinline__ void operator()(const f32x4 (&acc)[2][2][4][2], const Unit& u, int wr, int wc, int fr, int fq) const {
        const unsigned lo = (unsigned)(fr * 192 + 8 * fq), lcs = (unsigned)(fr * 64 + 8 * fq) * 4u;
        const int rowU = u.pm * BM + wr * 64;
#pragma unroll
        for (int bj = 0; bj < 2; ++bj) { const int c32 = u.pn * BM + bj * HALF + wc * 32, hd = c32 / 192, w32 = c32 - hd * 192;
            char* ub = (char*)(Q8 + ((size_t)hd * SEQ + rowU) * 192 + w32);
            const char* cb = (const char*)(cs + (size_t)rowU * 64 + (w32 >= 128 ? (w32 - 128) : 0));
#pragma unroll
            EPI_ROWLOOP { const int rr = ai * HALF + m * 16; f32x4 v0 = acc[ai][bj][m][0], v1 = acc[ai][bj][m][1];
                if (w32 >= 128) { const f32x4 ca = *(const f32x4*)(cb + (size_t)rr * 256 + lcs), cc = *(const f32x4*)(cb + (size_t)rr * 256 + 16 + lcs);
                    const f32x4 a = v0, b = v1;
                    v0[0] = a[0] * ca[0] - a[1] * ca[1]; v0[1] = a[0] * ca[1] + a[1] * ca[0]; v0[2] = a[2] * ca[2] - a[3] * ca[3]; v0[3] = a[2] * ca[3] + a[3] * ca[2];
                    v1[0] = b[0] * cc[0] - b[1] * cc[1]; v1[1] = b[0] * cc[1] + b[1] * cc[0]; v1[2] = b[2] * cc[2] - b[3] * cc[3]; v1[3] = b[2] * cc[3] + b[3] * cc[2]; }
                v0 = v0 * QK_LOG2_SCALE; v1 = v1 * QK_LOG2_SCALE;
                u32x2 o; o.x = pk4_fp8(v0[0], v0[1], v0[2], v0[3]); o.y = pk4_fp8(v1[0], v1[1], v1[2], v1[3]);
                *(u32x2*)(ub + (size_t)rr * 192 + lo) = o;
                if (m & 1) asm volatile("" ::: "memory"); } }
    }
};
struct EpiK8 {
    static constexpr bool PERM = true, BPRE = false; static constexpr int NST = 0;
    unsigned char* K8;
    __device__ __forceinline__ void operator()(const f32x4 (&acc)[2][2][4][2], const Unit& u, int wr, int wc, int fr, int fq) const {
        const int rowU = u.pm * BM + wr * 64; const unsigned lo = (unsigned)(fr * 192 + 8 * fq);
#pragma unroll
        for (int bj = 0; bj < 2; ++bj) { const int c32 = u.pn * BM + bj * HALF + wc * 32, hd = c32 >> 7, w32 = c32 & 127;
            char* ub = (char*)(K8 + ((size_t)hd * SEQ + rowU) * 192 + w32);
#pragma unroll
            EPI_ROWLOOP { const f32x4 v0 = acc[ai][bj][m][0], v1 = acc[ai][bj][m][1];
                u32x2 o; o.x = pk4_fp8(v0[0], v0[1], v0[2], v0[3]); o.y = pk4_fp8(v1[0], v1[1], v1[2], v1[3]);
                *(u32x2*)(ub + (size_t)(ai * HALF + m * 16) * 192 + lo) = o; } }
    }
};
struct EpiVT8 {
    static constexpr bool PERM = true, BPRE = false; static constexpr int NST = 0;
    unsigned char* VT8;
    __device__ __forceinline__ void operator()(const f32x4 (&acc)[2][2][4][2], const Unit& u, int wr, int wc, int fr, int fq) const {
#pragma unroll
        for (int bj = 0; bj < 2; ++bj) { const int T0 = u.pn * BM + bj * HALF + wc * 32 + 8 * fq, tile = T0 >> 6, G0 = (T0 & 63) >> 2, half = G0 >> 3, a = (G0 & 7) >> 1;
            const int p0 = 4 * (4 * half + a), p1 = 4 * (8 + 4 * half + a);
#pragma unroll
            EPI_ROWLOOP { const int r = u.pm * BM + ai * HALF + wr * 64 + m * 16 + fr, hd = r >> 7, col = r & 127;
                unsigned char* dst = VT8 + (((size_t)hd * (SEQ / 64) + tile) * 128 + col) * 64;
                const f32x4 v0 = acc[ai][bj][m][0], v1 = acc[ai][bj][m][1];
                *(unsigned*)(dst + p0) = pk4_fp8(v0[0], v0[1], v0[2], v0[3]); *(unsigned*)(dst + p1) = pk4_fp8(v1[0], v1[1], v1[2], v1[3]); } }
    }
};
struct EpiRes {
    static constexpr bool PERM = false, BPRE = false; static constexpr int NST = 32;
    const float* x; float* out; const float* mod; float sc;
    __device__ __forceinline__ void operator()(const f32x4 (&acc)[2][2][4][2], const Unit& u, int wr, int wc, int fr, int fq) const {
        const int col0 = u.pn * BM + wc * 32 + 4 * fq;
        const int b = (u.pm * BM) / SEQ;
        f32x4 gt[2][2];
#pragma unroll
        for (int bj = 0; bj < 2; ++bj)
#pragma unroll
            for (int n = 0; n < 2; ++n) gt[bj][n] = *(const f32x4*)(mod + b * 6144 + 2048 + col0 + bj * HALF + n * 16) * sc;
        const unsigned lo = (unsigned)(fr * DM + 4 * fq) * 4u;
        const size_t ubo = ((size_t)(u.pm * BM + wr * 64) * DM + u.pn * BM + wc * 32) * 4;
#pragma unroll
        for (int ai = 0; ai < 2; ++ai) { f32x4 xv[4][2][2];
#pragma unroll
            for (int m = 0; m < 4; ++m)
#pragma unroll
                for (int bj = 0; bj < 2; ++bj)
#pragma unroll
                    for (int n = 0; n < 2; ++n) xv[m][bj][n] = *(const f32x4*)((const char*)x + ubo + (size_t)(ai * HALF + m * 16) * DM * 4 + (bj * HALF + n * 16) * 4 + lo);
#pragma unroll
            for (int m = 0; m < 4; ++m) { const size_t ro = ubo + (size_t)(ai * HALF + m * 16) * DM * 4;
#pragma unroll
                for (int bj = 0; bj < 2; ++bj)
#pragma unroll
                    for (int n = 0; n < 2; ++n) { const size_t o = ro + (bj * HALF + n * 16) * 4;
                        *(f32x4*)((char*)out + o + lo) = xv[m][bj][n] + gt[bj][n] * acc[ai][bj][m][n]; } }
            asm volatile("" ::: "memory"); }
    }
};
struct EpiSwiGLU {
    static constexpr bool PERM = true, BPRE = true; static constexpr int NST = 16;
    void* HID; float sc;
    __device__ __forceinline__ void operator()(const f32x4 (&acc)[2][2][4][2], const Unit& u, int wr, int wc, int fr, int fq) const {
        constexpr int HE = FP8_EX ? 1 : 2;
        const __amdgpu_buffer_rsrc_t rs = __builtin_amdgcn_make_buffer_rsrc(HID, 0, 0x7fffffff, 0x00020000);
        const unsigned lo = (unsigned)(fr * DFF + 4 * fq) * HE, so = (unsigned)(((u.g * CAP + u.pm * BM + wr * 64) * DFF + ((u.pn * BM + wc * 32) >> 1)) * HE);
#pragma unroll
        EPI_ROWLOOP {
#pragma unroll
            for (int bj = 0; bj < 2; ++bj) { const f32x4 gv = acc[ai][bj][m][0] * sc, uv = acc[ai][bj][m][1] * sc; f32x4 h;
#pragma unroll
                for (int e = 0; e < 4; ++e) h[e] = gv[e] * fast_sigmoid(gv[e]) * uv[e];
                const unsigned ro = so + (unsigned)((ai * HALF + m * 16) * DFF + bj * (HALF / 2)) * HE;
#if !defined(EPI_BUF_STORES)
                if constexpr (FP8_EX) *(unsigned*)((char*)HID + (size_t)ro + lo) = pk4_fp8(h[0], h[1], h[2], h[3]);
                else { u32x2 o; o.x = cvt_pk_bf16(h[0], h[1]); o.y = cvt_pk_bf16(h[2], h[3]); *(u32x2*)((char*)HID + (size_t)ro + lo) = o; }
#else
                if constexpr (FP8_EX) __builtin_amdgcn_raw_buffer_store_b32(pk4_fp8(h[0], h[1], h[2], h[3]), rs, lo, ro, 0);
                else { u32x2 o; o.x = cvt_pk_bf16(h[0], h[1]); o.y = cvt_pk_bf16(h[2], h[3]); __builtin_amdgcn_raw_buffer_store_b64(o, rs, lo, ro, 0); }
#endif
            } }
    }
};
struct EpiDown {
    static constexpr bool PERM = true, BPRE = true; static constexpr int NST = 16;
    bf16_t* Y; const float* gate; float sc;
    __device__ __forceinline__ void operator()(const f32x4 (&acc)[2][2][4][2], const Unit& u, int wr, int wc, int fr, int fq) const {
        const int rowU = u.g * CAP + u.pm * BM + wr * 64;
        const __amdgpu_buffer_rsrc_t rs = __builtin_amdgcn_make_buffer_rsrc((void*)Y, 0, 0x7fffffff, 0x00020000), rg = __builtin_amdgcn_make_buffer_rsrc((void*)gate, 0, 0x7fffffff, 0x00020000);
        const unsigned lo = (unsigned)(fr * DM + 8 * fq) * 2u, so = (unsigned)((rowU * DM + u.pn * BM + wc * 32) * 2);
#pragma unroll
        for (int ai = 0; ai < 2; ++ai) { float gsv[4];
#pragma unroll
          for (int m = 0; m < 4; ++m) gsv[m] = gate[rowU + ai * HALF + m * 16 + fr];
#pragma unroll
          for (int m = 0; m < 4; ++m) { const int rr = ai * HALF + m * 16;
#if !defined(EPI_BUF_STORES)
            const float gs = gsv[m] * sc;
#pragma unroll
            for (int bj = 0; bj < 2; ++bj) *(u32x4*)((char*)Y + (size_t)(so + (unsigned)(rr * DM + bj * HALF) * 2u) + lo) = pack8(acc[ai][bj][m][0] * gs, acc[ai][bj][m][1] * gs);
#else
            const float gs = __uint_as_float(__builtin_amdgcn_raw_buffer_load_b32(rg, (unsigned)fr * 4u, (unsigned)(rowU + rr) * 4u, 0)) * sc;
#pragma unroll
            for (int bj = 0; bj < 2; ++bj) __builtin_amdgcn_raw_buffer_store_b128(pack8(acc[ai][bj][m][0] * gs, acc[ai][bj][m][1] * gs), rs, lo, so + (unsigned)(rr * DM + bj * HALF) * 2u, 0);
#endif
          } }
    }
};
#undef EPI_ROWLOOP
}
namespace att {
__device__ __forceinline__ int crow(int r, int hi) { return (r & 3) + 8 * (r >> 2) + 4 * hi; }
__device__ __forceinline__ int v_st(int k, int c) { const int kk = (k & ~0xC) | ((k & 4) << 1) | ((k & 8) >> 1); return ((kk >> 3) * 4 + (c >> 5)) * 512 + ((kk & 7) * 32 + (c & 31)) * 2; }
__device__ __forceinline__ int v_rd_base(int lane) { return ((lane & 3) << 3) | (((lane >> 2) & 3) << 6) | (((lane >> 4) & 1) << 5) | (((lane >> 5) & 1) << 8); }
constexpr int v_rd_off(int d0, int ks, int half) { return d0 * 512 + ks * 4096 + half * 2048; }
template <int OFF> __device__ __forceinline__ s16x4 tr_read(int vb) {
    s16x4 r; asm volatile("ds_read_b64_tr_b16 %0, %1 offset:%2" : "=&v"(r) : "v"(vb), "i"(OFF) : "memory"); return r;
}
#define ATT_SBAR() __builtin_amdgcn_sched_barrier(0)
template <int D0> __device__ __forceinline__ void pv_one(f32x16& od, int vb, bf16x8 pa0, bf16x8 pa1, bf16x8 pa2, bf16x8 pa3) {
    const s16x4 l0 = tr_read<v_rd_off(D0, 0, 0)>(vb), h0 = tr_read<v_rd_off(D0, 0, 1)>(vb), l1 = tr_read<v_rd_off(D0, 1, 0)>(vb), h1 = tr_read<v_rd_off(D0, 1, 1)>(vb);
    const s16x4 l2 = tr_read<v_rd_off(D0, 2, 0)>(vb), h2 = tr_read<v_rd_off(D0, 2, 1)>(vb), l3 = tr_read<v_rd_off(D0, 3, 0)>(vb), h3 = tr_read<v_rd_off(D0, 3, 1)>(vb);
    asm volatile("s_waitcnt lgkmcnt(0)" ::: "memory"); ATT_SBAR();
#define ATT_PK(L, H) (bf16x8){L[0], L[1], L[2], L[3], H[0], H[1], H[2], H[3]}
    od = __builtin_amdgcn_mfma_f32_32x32x16_bf16(pa0, ATT_PK(l0, h0), od, 0, 0, 0);
    od = __builtin_amdgcn_mfma_f32_32x32x16_bf16(pa1, ATT_PK(l1, h1), od, 0, 0, 0);
    od = __builtin_amdgcn_mfma_f32_32x32x16_bf16(pa2, ATT_PK(l2, h2), od, 0, 0, 0);
    od = __builtin_amdgcn_mfma_f32_32x32x16_bf16(pa3, ATT_PK(l3, h3), od, 0, 0, 0);
#undef ATT_PK
}
__device__ __forceinline__ void pv_d0(f32x16* o, int vb, bf16x8 pa0, bf16x8 pa1, bf16x8 pa2, bf16x8 pa3) {
    pv_one<0>(o[0], vb, pa0, pa1, pa2, pa3); pv_one<1>(o[1], vb, pa0, pa1, pa2, pa3); pv_one<2>(o[2], vb, pa0, pa1, pa2, pa3); pv_one<3>(o[3], vb, pa0, pa1, pa2, pa3);
}
__device__ __forceinline__ void finishSM(f32x16& p0, f32x16& p1, float alpha, float& l_reg, bf16x8& pa0, bf16x8& pa1, bf16x8& pa2, bf16x8& pa3) {
#pragma unroll
    for (int r = 0; r < 16; ++r) p1[r] = __builtin_amdgcn_exp2f(p1[r]);
    float ps = 0;
#pragma unroll
    for (int r = 0; r < 16; ++r) ps += p0[r];
#pragma unroll
    for (int r = 0; r < 16; ++r) ps += p1[r];
    { auto rr = __builtin_amdgcn_permlane32_swap(__float_as_uint(ps), __float_as_uint(ps), false, false);
      ps = __uint_as_float(rr[0]) + __uint_as_float(rr[1]); }
    l_reg = l_reg * alpha + ps;
#define ATT_PK4(P, BASE, OUT) do { unsigned a0 = cvt_pk_bf16(P[BASE + 0], P[BASE + 1]), a1 = cvt_pk_bf16(P[BASE + 2], P[BASE + 3]);   \
    unsigned b0 = cvt_pk_bf16(P[BASE + 4], P[BASE + 5]), b1 = cvt_pk_bf16(P[BASE + 6], P[BASE + 7]);                              \
    auto r0 = __builtin_amdgcn_permlane32_swap(a0, b0, false, false); auto r1 = __builtin_amdgcn_permlane32_swap(a1, b1, false, false); \
    u32x4 w = {r0[0], r1[0], r0[1], r1[1]}; OUT = *reinterpret_cast<bf16x8*>(&w); } while (0)
    ATT_PK4(p0, 0, pa0); ATT_PK4(p0, 8, pa1); ATT_PK4(p1, 0, pa2); ATT_PK4(p1, 8, pa3);
#undef ATT_PK4
}

struct Unit {
    const bf16_t* Q; int qs;
    const bf16_t* K; int ks;
    const bf16_t* V; int vs;
    bf16_t* O; int os;
    int nt;
    int tmul;
    float* dbg;
    const float* lutg;
    int kt0, ktn;
    int l0;
    const int* pos; int ps;
    float* lse; int ls;
    const float* bias;
};

template <bool DIL> struct Cfg {
    static constexpr bool K8 = DIL && (DIL_FP8 != 0);
    static constexpr int DQK = DIL ? 128 : 192, ND = K8 ? 4 : DQK / 16, KROWB = (K8 ? DQK : DQK * 2) + 16, SHM_K = 64 * KROWB, SHM_V = 16384;
    static constexpr int NKC = DQK / 64;
#if DIL_2S
    static constexpr int NRING = DIL ? 4 : 2;
    static constexpr int OFF_K0 = 2 * SHM_V, OFF_K = DIL ? 0 : OFF_K0, OFF_V = DIL ? 4 * SHM_K : 0,
                         OFF_WS = DIL ? (OFF_V + 4 * SHM_V > 8 * 8448 ? OFF_V + 4 * SHM_V : 8 * 8448) : (OFF_K0 + 2 * SHM_K > 8 * 8448 ? OFF_K0 + 2 * SHM_K : 8 * 8448),
                         OFF_POS = OFF_WS + NWAVES * 64 * 4, OFF_LUT = OFF_POS + 6 * 64 * 4, END = OFF_LUT + 9216;
#else
    static constexpr int NRING = 2;
    static constexpr int OFF_K0 = 2 * SHM_V, OFF_WS = DIL ? 8 * 8448 : (OFF_K0 + 2 * SHM_K > 8 * 8448 ? OFF_K0 + 2 * SHM_K : 8 * 8448), OFF_POS = OFF_WS + NWAVES * 64 * 4, OFF_LUT = OFF_POS + 2 * 64 * 4,
                         OFF_K = DIL ? OFF_LUT + 9216 : OFF_K0, OFF_V = DIL ? OFF_K + 2 * SHM_K : 0, END = DIL ? OFF_V + 2 * SHM_V : OFF_LUT + 9216;
#endif
    static_assert(END <= RING_BYTES, "inside the ring area");
    static constexpr float SCALE = DIL ? 0.088388347648318440f : 0.072168783648703220f;
};

template <bool DIL>
__device__ __forceinline__ void qkt(f32x16& p0, f32x16& p1, const LAS char* Ks, const bf16x8* qr, int r32, int hi) {
    using C = Cfg<DIL>;
    p0 = f32x16{}; p1 = f32x16{};
    const LAS char* k0 = Ks + r32 * C::KROWB + hi * 16; const LAS char* k1 = k0 + 32 * C::KROWB;
#pragma unroll
    for (int d0 = 0; d0 < C::ND; ++d0) {
        const bf16x8 b0 = *(const LAS bf16x8*)(k0 + d0 * 32);
        const bf16x8 b1 = *(const LAS bf16x8*)(k1 + d0 * 32);
        p0 = __builtin_amdgcn_mfma_f32_32x32x16_bf16(b0, qr[d0], p0, 0, 0, 0);
        p1 = __builtin_amdgcn_mfma_f32_32x32x16_bf16(b1, qr[d0], p1, 0, 0, 0); }
}

template <bool DIL>
__device__ __forceinline__ void xstage(bool pv, bool qk, f32x16* o, int vb, bf16x8 pa0, bf16x8 pa1, bf16x8 pa2, bf16x8 pa3, f32x16& p0, f32x16& p1, const LAS char* Ks, const bf16x8* qr, int r32, int hi) {
    using C = Cfg<DIL>;
    constexpr int NG = C::ND / 2;
    const LAS char* k0 = Ks + r32 * C::KROWB + hi * (C::K8 ? 32 : 16);
    bf16x8 f[2][4];
    const int ka = (int)(unsigned)(size_t)k0;
#define ATT_KR1(dst_, off_) asm volatile("ds_read_b128 %0, %1 offset:%2" : "=&v"(dst_) : "v"(ka), "i"(off_) : "memory")
#define ATT_KRD(s_, g_) do { if constexpr (C::K8) { ATT_KR1(f[s_][0], 64 * (g_)); ATT_KR1(f[s_][1], 64 * (g_) + 16); ATT_KR1(f[s_][2], 32 * C::KROWB + 64 * (g_)); ATT_KR1(f[s_][3], 32 * C::KROWB + 64 * (g_) + 16); } \
        else { ATT_KR1(f[s_][0], (2 * (g_)) * 32); ATT_KR1(f[s_][1], 32 * C::KROWB + (2 * (g_)) * 32); ATT_KR1(f[s_][2], (2 * (g_) + 1) * 32); ATT_KR1(f[s_][3], 32 * C::KROWB + (2 * (g_) + 1) * 32); } } while (0)
#define ATT_PK(L, H) (bf16x8){L[0], L[1], L[2], L[3], H[0], H[1], H[2], H[3]}
#define ATT_VRD1(B_, s_, ks_) do { const s16x4 l_ = tr_read<v_rd_off(B_, ks_, 0)>(vb), h_ = tr_read<v_rd_off(B_, ks_, 1)>(vb); f[s_][ks_] = ATT_PK(l_, h_); } while (0)
#define ATT_VRD(B_, s_) do { ATT_VRD1(B_, s_, 0); ATT_VRD1(B_, s_, 1); ATT_VRD1(B_, s_, 2); ATT_VRD1(B_, s_, 3); } while (0)
#define ATT_VMMA(B_, s_) do { o[B_] = __builtin_amdgcn_mfma_f32_32x32x16_bf16(pa0, f[s_][0], o[B_], 0, 0, 0); o[B_] = __builtin_amdgcn_mfma_f32_32x32x16_bf16(pa1, f[s_][1], o[B_], 0, 0, 0); \
        o[B_] = __builtin_amdgcn_mfma_f32_32x32x16_bf16(pa2, f[s_][2], o[B_], 0, 0, 0); o[B_] = __builtin_amdgcn_mfma_f32_32x32x16_bf16(pa3, f[s_][3], o[B_], 0, 0, 0); } while (0)
#define ATT_LW(n) asm volatile("s_waitcnt lgkmcnt(" #n ")" ::: "memory")
    if (pv) {
        ATT_VRD(0, 0); ATT_SBAR();
        ATT_VRD(1, 1); ATT_LW(8); ATT_SBAR(); ATT_VMMA(0, 0); ATT_SBAR();
        ATT_VRD(2, 0); ATT_LW(8); ATT_SBAR(); ATT_VMMA(1, 1); ATT_SBAR();
        ATT_VRD(3, 1); ATT_LW(8); ATT_SBAR(); ATT_VMMA(2, 0); ATT_SBAR();
        ATT_KRD(0, 0); ATT_LW(4); ATT_SBAR(); ATT_VMMA(3, 1); ATT_SBAR();
    } else { ATT_KRD(0, 0); ATT_SBAR(); }
    if (!qk) { ATT_LW(0); return; }
    p0 = f32x16{}; p1 = f32x16{};
    if constexpr (C::K8) {
#define ATT_CAT(x_, y_) __builtin_shufflevector(__builtin_bit_cast(i32x4, x_), __builtin_bit_cast(i32x4, y_), 0, 1, 2, 3, 4, 5, 6, 7)
        ATT_KRD(1, 1); ATT_LW(4); ATT_SBAR();
        p0 = __builtin_amdgcn_mfma_scale_f32_32x32x64_f8f6f4(ATT_CAT(f[0][0], f[0][1]), ATT_CAT(qr[0], qr[1]), p0, 0, 0, 0, 0, 0, 0);
        p1 = __builtin_amdgcn_mfma_scale_f32_32x32x64_f8f6f4(ATT_CAT(f[0][2], f[0][3]), ATT_CAT(qr[0], qr[1]), p1, 0, 0, 0, 0, 0, 0);
        ATT_SBAR(); ATT_LW(0); ATT_SBAR();
        p0 = __builtin_amdgcn_mfma_scale_f32_32x32x64_f8f6f4(ATT_CAT(f[1][0], f[1][1]), ATT_CAT(qr[2], qr[3]), p0, 0, 0, 0, 0, 0, 0);
        p1 = __builtin_amdgcn_mfma_scale_f32_32x32x64_f8f6f4(ATT_CAT(f[1][2], f[1][3]), ATT_CAT(qr[2], qr[3]), p1, 0, 0, 0, 0, 0, 0);
        ATT_SBAR();
#undef ATT_CAT
    } else {
#pragma unroll
    for (int g = 0; g < NG; ++g) { const int sg = g & 1;
        if (g + 1 < NG) { ATT_KRD(sg ^ 1, g + 1); ATT_LW(4); } else { ATT_LW(0); }
        ATT_SBAR();
        p0 = __builtin_amdgcn_mfma_f32_32x32x16_bf16(f[sg][0], qr[2 * g], p0, 0, 0, 0);
        p1 = __builtin_amdgcn_mfma_f32_32x32x16_bf16(f[sg][1], qr[2 * g], p1, 0, 0, 0);
        p0 = __builtin_amdgcn_mfma_f32_32x32x16_bf16(f[sg][2], qr[2 * g + 1], p0, 0, 0, 0);
        p1 = __builtin_amdgcn_mfma_f32_32x32x16_bf16(f[sg][3], qr[2 * g + 1], p1, 0, 0, 0);
        ATT_SBAR(); } }
#undef ATT_VRD1
#undef ATT_KRD
#undef ATT_KR1
#undef ATT_VRD
#undef ATT_PK
#undef ATT_VMMA
#undef ATT_LW
}

template <bool DIL>
__device__ __forceinline__ void partialSM(f32x16& p0, f32x16& p1, float& m_reg, float& mn, float& alpha,
                                          const LAS int* posb, int qoff, int lutlo, int dl0, bool masked, int hi) {
    using C = Cfg<DIL>;
    constexpr float CC = C::SCALE * LOG2E;
    constexpr float THR = 8.f;
    float mnC;
    if constexpr (DIL) {
        const LAS float* lutp = (const LAS float*)(size_t)(unsigned)lutlo;
#define ATT_LUT(pk_) ({ int u_ = (pk_) + qoff; u_ = u_ < 0 ? 0 : (u_ > 2048 ? 2048 : u_); lutp[u_ + (u_ >> 5)]; })
        float bz0[16], bz1[16];
#pragma unroll
        for (int a = 0; a < 4; ++a) {
            const i32x4 pk0 = *(const LAS i32x4*)(posb + 8 * a + 4 * hi), pk1 = *(const LAS i32x4*)(posb + 32 + 8 * a + 4 * hi);
#pragma unroll
            for (int b = 0; b < 4; ++b) { bz0[4 * a + b] = ATT_LUT(pk0[b]); bz1[4 * a + b] = ATT_LUT(pk1[b]); }
        }
        ATT_SBAR();
        if (masked) {
#pragma unroll
            for (int r = 0; r < 16; ++r) { const int dl = dl0 + 8 * (r >> 2) + (r & 3);
                p0[r] = ((unsigned)(dl + 64) <= 128u) ? fmaf(p0[r], CC, bz0[r]) : -1e30f;
                p1[r] = ((unsigned)(dl + 32 + 64) <= 128u) ? fmaf(p1[r], CC, bz1[r]) : -1e30f; }
        } else {
#pragma unroll
            for (int r = 0; r < 16; ++r) { p0[r] = fmaf(p0[r], CC, bz0[r]); p1[r] = fmaf(p1[r], CC, bz1[r]); }
        }
#undef ATT_LUT
        float pmax = p0[0];
#pragma unroll
        for (int r = 1; r < 16; ++r) pmax = fmaxf(pmax, p0[r]);
#pragma unroll
        for (int r = 0; r < 16; ++r) pmax = fmaxf(pmax, p1[r]);
        { auto rr = __builtin_amdgcn_permlane32_swap(__float_as_uint(pmax), __float_as_uint(pmax), false, false);
          pmax = fmaxf(__uint_as_float(rr[0]), __uint_as_float(rr[1])); }
        if (__builtin_expect(__all(pmax - m_reg <= THR * LOG2E), 1)) { mn = m_reg; alpha = 1.f; }
        else { mn = fmaxf(m_reg, pmax); alpha = __builtin_amdgcn_exp2f(m_reg - mn); m_reg = mn; }
        mnC = -fmaxf(mn, -1e29f);
#pragma unroll
        for (int r = 0; r < 16; ++r) p0[r] = p0[r] + mnC;
#pragma unroll
        for (int r = 0; r < 16; ++r) p1[r] = p1[r] + mnC;
    } else {
        float pmax = p0[0];
#pragma unroll
        for (int r = 1; r < 16; ++r) pmax = fmaxf(pmax, p0[r]);
#pragma unroll
        for (int r = 0; r < 16; ++r) pmax = fmaxf(pmax, p1[r]);
        { auto rr = __builtin_amdgcn_permlane32_swap(__float_as_uint(pmax), __float_as_uint(pmax), false, false);
          pmax = fmaxf(__uint_as_float(rr[0]), __uint_as_float(rr[1])); }
        if (__builtin_expect(__all(pmax - m_reg <= THR / C::SCALE), 1)) { mn = m_reg; alpha = 1.f; }
        else { mn = fmaxf(m_reg, pmax); alpha = __builtin_amdgcn_exp2f((m_reg - mn) * CC); m_reg = mn; }
        mnC = -mn * CC;
#pragma unroll
        for (int r = 0; r < 16; ++r) p0[r] = fmaf(p0[r], CC, mnC);
#pragma unroll
        for (int r = 0; r < 16; ++r) p1[r] = fmaf(p1[r], CC, mnC);
    }
#pragma unroll
    for (int r = 0; r < 16; ++r) p0[r] = __builtin_amdgcn_exp2f(p0[r]);
}

__device__ __forceinline__ int t5_bucket(int rel) {
    const int n = rel < 0 ? -rel : rel;
    const float nf = (float)(n > 1 ? n : 1);
    int large = 8 + (int)(logf(nf / 8.f) / 4.852030263919617f * 8.f);
    large = large < 15 ? large : 15;
    return (rel > 0 ? 16 : 0) + (n < 8 ? n : large);
}

__device__ __forceinline__ void dil_prefetch(const Unit& n, LAS char* lds, int tid, int wid, int lane, int r32, int hi, bf16x8& pre_q0, bf16x8& pre_q1, bf16x8& pre_q2, bf16x8& pre_q3, int& pre_pq, int& pre_ppos) {
    using C = Cfg<true>;
    constexpr int CPR = C::KROWB / 16, NKP = C::SHM_K / 1024, NKI = (NKP + 7) / 8;
    LAS char* V_lds = lds + C::OFF_V; LAS char* K_lds = lds + C::OFF_K; LAS float* lut = (LAS float*)(lds + C::OFF_LUT);
    { const char* Qw = (const char*)(n.Q + (size_t)(wid * 32 + r32) * n.qs) + hi * 32;
      pre_q0 = *(const bf16x8*)(Qw); pre_q1 = *(const bf16x8*)(Qw + 16); pre_q2 = *(const bf16x8*)(Qw + 64); pre_q3 = *(const bf16x8*)(Qw + 80); }
    pre_pq = n.pos[(size_t)(n.l0 + wid * 32 + r32) * n.ps];
    { const char* ls = (const char*)n.lutg + lane * 16; LAS char* ld = (LAS char*)lut;
      __builtin_amdgcn_global_load_lds((const unsigned*)(ls + wid * 1024), (LAS unsigned*)(ld + wid * 1024), 16, 0, 0);
      if (wid == 0) __builtin_amdgcn_global_load_lds((const unsigned*)(ls + 8192), (LAS unsigned*)(ld + 8192), 16, 0, 0); }
#define ATT_NROW0(j) ((((n.kt0 + (j)) < 0 ? 0 : ((n.kt0 + (j)) >= n.ktn ? n.ktn - 1 : (n.kt0 + (j)))) * 64))
#pragma unroll
    for (int j = 0; j < 2; ++j) { const char* kt_ = (const char*)(n.K + (size_t)ATT_NROW0(j) * n.ks); LAS char* kd_ = K_lds + j * C::SHM_K + wid * 1024;
#pragma unroll
        for (int q_ = 0; q_ < NKI; ++q_) if (wid + 8 * q_ < NKP) { const int pch = (wid + 8 * q_) * 64 + lane, kr = pch / CPR, kc = pch % CPR;
            __builtin_amdgcn_global_load_lds((const unsigned*)(kt_ + (unsigned)(kr * n.ks + (kc == CPR - 1 ? 0 : kc) * 8) * 2u), (LAS unsigned*)(kd_ + q_ * 8192), 16, 0, 0); } }
    { const char* vt_ = (const char*)(n.V + (size_t)ATT_NROW0(0) * n.vs); LAS char* vd_ = V_lds + wid * 1024;
#pragma unroll
      for (int i = 0; i < 2; ++i) { const int pch = (wid + 8 * i) * 64 + lane, sub = pch >> 5, within = pch & 31, kk = (sub >> 2) * 8 + (within >> 2), cc = (sub & 3) * 32 + (within & 3) * 8;
          const int k = (kk & ~0xC) | ((kk & 4) << 1) | ((kk & 8) >> 1);
          __builtin_amdgcn_global_load_lds((const unsigned*)(vt_ + (unsigned)(k * n.vs + cc) * 2u), (LAS unsigned*)(vd_ + i * 8192), 16, 0, 0); } }
    pre_ppos = 0; if (tid < 64) pre_ppos = n.pos[(size_t)(ATT_NROW0(0) + tid) * n.ps];
#undef ATT_NROW0
}
struct DilPre { bf16x8 q0, q1, q2, q3; int pq; int ppos; int valid; };
template <bool DIL>
__device__ __forceinline__ void attn_unit(const Unit& a, LAS char* lds, int wv, bf16x8& pre_q0, bf16x8& pre_q1, bf16x8& pre_q2, bf16x8& pre_q3, int& pre_pq, int& pre_ppos, int& pre_valid, const Unit& n, bool has_next) {
    using C = Cfg<DIL>;
    constexpr int SD = 1;
    const int tid = opaque_tid(wv), wid = __builtin_amdgcn_readfirstlane(tid >> 6), lane = tid & 63, r32 = lane & 31, hi = lane >> 5;
#if defined(PROBE_TIMING)
    const unsigned long long t_entry = __builtin_amdgcn_s_memtime();
#endif
    LAS char* V_lds = lds + C::OFF_V; LAS char* K_lds = lds + C::OFF_K;
    LAS float* ws = (LAS float*)(lds + C::OFF_WS) + wid * 64; LAS float* li_l = ws; LAS float* al_l = ws + 32;
    LAS int* pos_l = (LAS int*)(lds + C::OFF_POS); LAS float* lut = (LAS float*)(lds + C::OFF_LUT);
    float m_reg = -1e30f, l_reg = 0; f32x16 o[4] = {}; bf16x8 qr[C::ND];
    const bool pref = DIL && !(DIL_2S) && pre_valid != 0;
    if (pref) { qr[0] = pre_q0; qr[1] = pre_q1; qr[2] = pre_q2; qr[3] = pre_q3; }
    else if constexpr (C::K8) { const char* Qw = (const char*)(a.Q + (size_t)(wid * 32 + r32) * a.qs) + hi * 32;
#pragma unroll
      for (int i = 0; i < 4; ++i) qr[i] = *(const bf16x8*)(Qw + 64 * (i >> 1) + 16 * (i & 1)); }
    else { const bf16_t* Qw = a.Q + (size_t)(wid * 32 + r32) * a.qs + hi * 8;
#pragma unroll
      for (int d0 = 0; d0 < C::ND; ++d0) qr[d0] = *(const bf16x8*)(Qw + d0 * 16); }
    int pq = 0, lq = 0;
    if constexpr (DIL) {
        lq = a.l0 + wid * 32 + r32; pq = pref ? pre_pq : a.pos[(size_t)lq * a.ps];
        pq = 1024 - pq;
        if (!pref)
        { const char* ls = (const char*)a.lutg + lane * 16; LAS char* ld = (LAS char*)lut;
          __builtin_amdgcn_global_load_lds((const unsigned*)(ls + wid * 1024), (LAS unsigned*)(ld + wid * 1024), 16, 0, 0);
          if (wid == 0) __builtin_amdgcn_global_load_lds((const unsigned*)(ls + 8192), (LAS unsigned*)(ld + 8192), 16, 0, 0); }
    }
    constexpr int CPR = C::KROWB / 16, NKP = C::SHM_K / 1024, NKI = (NKP + 7) / 8;
    unsigned kgo[NKI];
#pragma unroll
    for (int i = 0; i < NKI; ++i) { const int pch = (wid + 8 * i) * 64 + lane, kr = pch / CPR, kc = pch % CPR; kgo[i] = (unsigned)(kr * a.ks + (kc == CPR - 1 ? 0 : kc) * 8) * 2u; }
    unsigned vgo[2];
#pragma unroll
    for (int i = 0; i < 2; ++i) { const int pch = (wid + 8 * i) * 64 + lane, sub = pch >> 5, within = pch & 31, kk = (sub >> 2) * 8 + (within >> 2), cc = (sub & 3) * 32 + (within & 3) * 8;
        const int k = (kk & ~0xC) | ((kk & 4) << 1) | ((kk & 8) >> 1); vgo[i] = (unsigned)(k * a.vs + cc) * 2u; }
    const int vb0 = (int)(unsigned)(size_t)V_lds + v_rd_base(lane);
    int ppos = 0, ppos_n = 0;
#define ATT_KROW0(j) (DIL ? (((a.kt0 + (j)) < 0 ? 0 : ((a.kt0 + (j)) >= a.ktn ? a.ktn - 1 : (a.kt0 + (j)))) * 64) : (j) * 64 * a.tmul)
#define ATT_DMAK(j) do { const int k0_ = ATT_KROW0(j); const char* kt_ = (const char*)(a.K + (size_t)k0_ * a.ks); LAS char* kd_ = K_lds + ((j) & (C::NRING - 1)) * C::SHM_K + wid * 1024; \
        _Pragma("unroll") for (int q_ = 0; q_ < NKI; ++q_) if (wid + 8 * q_ < NKP) \
            __builtin_amdgcn_global_load_lds((const unsigned*)(kt_ + kgo[q_]), (LAS unsigned*)(kd_ + q_ * 8192), 16, 0, 0); } while (0)
#define ATT_DMAV(j) do { const int k0_ = ATT_KROW0(j); const char* vt_ = (const char*)(a.V + (size_t)k0_ * a.vs); LAS char* vd_ = V_lds + ((j) & (C::NRING - 1)) * C::SHM_V + wid * 1024; \
        __builtin_amdgcn_global_load_lds((const unsigned*)(vt_ + vgo[0]), (LAS unsigned*)(vd_), 16, 0, 0); \
        __builtin_amdgcn_global_load_lds((const unsigned*)(vt_ + vgo[1]), (LAS unsigned*)(vd_ + 8192), 16, 0, 0); } while (0)
#define ATT_LOADPOS(dst_, j) do { if constexpr (DIL) { if (tid < 64) dst_ = a.pos[(size_t)(ATT_KROW0(j) + tid) * a.ps]; } } while (0)
#define ATT_WRITEPOS(j) do { if constexpr (DIL) { if (tid < 64) pos_l[((j) & 1) * 64 + tid] = ppos; } } while (0)
#define ATT_VMW() asm volatile("s_waitcnt vmcnt(0)" ::: "memory")
#define ATT_BAR() do { asm volatile("s_waitcnt lgkmcnt(0)" ::: "memory"); __builtin_amdgcn_s_barrier(); asm volatile("" ::: "memory"); } while (0)
#define ATT_RESC(al) do { if (__any((al) < 1.f)) { if (hi == 0) al_l[r32] = (al); asm volatile("s_waitcnt lgkmcnt(0)" ::: "memory"); \
        _Pragma("unroll") for (int d = 0; d < 4; ++d) _Pragma("unroll") for (int r = 0; r < 16; ++r) o[d][r] *= al_l[crow(r, hi)]; } } while (0)
#define ATT_DL0(j) (DIL ? (ATT_TV(j) ? (64 * (a.kt0 + (j)) - lq + 4 * hi) : 0x20000000) : 0)
#define ATT_TV(j) (DIL ? ((a.kt0 + (j)) >= 0 && (a.kt0 + (j)) < a.ktn) : true)
#define ATT_MASKED(j) (DIL ? ((j) != (wid >> 1) + 1) : false)
    f32x16 p0, p1; float mn, al; bf16x8 pa0, pa1, pa2, pa3; const int NT = a.nt;
    const bool grpB = wid >= 4;
#if DIL_2S
    static_assert(DIL, "DIL_2S is the dilated unit's loop");
    (void)ppos; (void)ppos_n;
    ATT_DMAK(0); ATT_DMAK(1); ATT_DMAK(2); ATT_DMAV(0); ATT_DMAV(1);
    if (wid < 6) pos_l[wid * 64 + lane] = a.pos[(size_t)(ATT_KROW0(wid) + lane) * a.ps];
    ATT_VMW();
    __syncthreads();
    if (grpB) ATT_BAR();
#pragma unroll 1
    for (int j = 0; j < 4; ++j) {
        const int tw = j + (grpB ? 2 : 0);
        if (j + 3 < 6) ATT_DMAK(j + 3);
        ATT_DMAV(j + 2);
        ATT_SBAR();
        const bool act = tw >= (wid >> 1) && tw <= (wid >> 1) + 2, actp = tw - 1 >= (wid >> 1) && tw - 1 <= (wid >> 1) + 2;
        xstage<DIL>(j > 0 && actp, act, o, vb0 + ((tw - 1) & 3) * (int)C::SHM_V, pa0, pa1, pa2, pa3, p0, p1, K_lds + (tw & 3) * C::SHM_K, qr, r32, hi);
        ATT_SBAR();
        ATT_BAR();
        if (act) {
            partialSM<DIL>(p0, p1, m_reg, mn, al, pos_l + tw * 64, pq, (int)(unsigned)(size_t)lut, ATT_DL0(tw), ATT_MASKED(tw), hi);
            ATT_RESC(al);
            finishSM(p0, p1, al, l_reg, pa0, pa1, pa2, pa3);
        }
        ATT_SBAR();
        ATT_VMW();
        ATT_BAR();
    }
    { const int tl = 3 + (grpB ? 2 : 0); if (tl <= (wid >> 1) + 2) pv_d0(o, vb0 + (tl & 3) * (int)C::SHM_V, pa0, pa1, pa2, pa3); }
    if (!grpB) ATT_BAR();
#else
    if (!pref) { ATT_DMAK(0); ATT_DMAK(1); ATT_DMAV(0); ATT_LOADPOS(ppos, 0); } else ppos = pre_ppos;
    ATT_VMW(); ATT_WRITEPOS(0); ATT_LOADPOS(ppos, 1);
    __syncthreads();
    if (grpB) ATT_BAR();
#if defined(PROBE_TIMING)
    unsigned long long tacc = 0, tt0 = 0; const unsigned long long tstart = __builtin_amdgcn_s_memtime(), rstart = __builtin_amdgcn_s_memrealtime();
#define TSTAMP() __builtin_amdgcn_s_memtime()
#else
#define TSTAMP() 0ull
#endif
#pragma unroll 1
    for (int j = 0; j < NT; ++j) {
        const int cur = j & 1;
#if defined(PROBE_TIMING)
        tt0 = TSTAMP();
#endif
        if (!grpB && j >= 1) { if (j + 1 < NT) ATT_DMAK(j + 1); ATT_DMAV(j); }
        if constexpr (DIL) { if (!grpB && j + 2 < NT) ATT_LOADPOS(ppos_n, j + 2); }
        ATT_SBAR();
        const bool act = !DIL || (j >= (wid >> 1) && j <= (wid >> 1) + 2), actp = !DIL || (j - 1 >= (wid >> 1) && j - 1 <= (wid >> 1) + 2);
        if (DIL && DIL_XPRIO) __builtin_amdgcn_s_setprio(DIL_XPRIO);
        xstage<DIL>(j > 0 && actp, act, o, vb0 + (cur ^ 1) * (int)C::SHM_V, pa0, pa1, pa2, pa3, p0, p1, K_lds + cur * C::SHM_K, qr, r32, hi);
        if (DIL && DIL_XPRIO) __builtin_amdgcn_s_setprio(0);
        ATT_SBAR();
#if defined(PROBE_TIMING) && PROBE_TIMING == 2
        tacc += TSTAMP() - tt0;
#endif
#if defined(PROBE_TIMING) && PROBE_TIMING == 6
        tt0 = TSTAMP();
#endif
        if (grpB) ATT_VMW();
#if defined(PROBE_TIMING) && PROBE_TIMING == 6
        tacc += TSTAMP() - tt0;
#endif
#if defined(PROBE_TIMING) && PROBE_TIMING == 5
        tt0 = TSTAMP();
#endif
        ATT_BAR();
#if defined(PROBE_TIMING) && PROBE_TIMING == 5
        tacc += TSTAMP() - tt0;
#endif
#if defined(PROBE_TIMING) && PROBE_TIMING == 3
        tt0 = TSTAMP();
#endif
        if (grpB) { if (j + 2 < NT) ATT_DMAK(j + 2); if (j + 1 < NT) ATT_DMAV(j + 1); }
        if (act) {
        partialSM<DIL>(p0, p1, m_reg, mn, al, pos_l + cur * 64, pq, (int)(unsigned)(size_t)lut, ATT_DL0(j), ATT_MASKED(j), hi);
        ATT_RESC(al);
        finishSM(p0, p1, al, l_reg, pa0, pa1, pa2, pa3);
        }
        if constexpr (DIL) { if (!grpB && j + 1 < NT) { ATT_WRITEPOS(j + 1); ppos = ppos_n; } }
        ATT_SBAR();
#if defined(PROBE_TIMING) && PROBE_TIMING == 3
        tacc += TSTAMP() - tt0;
#endif
#if defined(PROBE_TIMING) && PROBE_TIMING == 6
        tt0 = TSTAMP();
#endif
        if (!grpB) ATT_VMW();
#if defined(PROBE_TIMING) && PROBE_TIMING == 6
        tacc += TSTAMP() - tt0;
#endif
        ATT_BAR();
    }
#if defined(PROBE_TIMING)
    if (DIL && a.dbg && tid == PROBE_TID && PROBE_TIMING == 8) *a.dbg = (float)(TSTAMP() - tstart) * 1e-6f;
    if (a.dbg && tid == PROBE_TID && PROBE_TIMING < 7) { const unsigned long long tend = TSTAMP(), rend = __builtin_amdgcn_s_memrealtime(); float v;
        if (PROBE_TIMING == 1) v = (float)(tend - tstart) / (float)NT * 1e-5f;
        else if (PROBE_TIMING == 4) v = (float)(tend - tstart) / (float)(rend - rstart) * 1e-3f;
        else v = (float)tacc / (float)NT * 1e-5f;
        *a.dbg = v; }
#endif
    if (!DIL || (NT - 1 <= (wid >> 1) + 2)) pv_d0(o, vb0 + ((NT - 1) & 1) * (int)C::SHM_V, pa0, pa1, pa2, pa3);
    if (!grpB) ATT_BAR();
#endif
    ATT_BAR();
    if constexpr (DIL) { {
        if (has_next && !(DIL_2S)) { dil_prefetch(n, lds, tid, wid, lane, r32, hi, pre_q0, pre_q1, pre_q2, pre_q3, pre_pq, pre_ppos);
            pre_valid = 1; }
        else { pre_valid = 0; pre_pq = 0; pre_ppos = 0;
            pre_q0 = (bf16x8){0, 0, 0, 0, 0, 0, 0, 0}; pre_q1 = pre_q0; pre_q2 = pre_q0; pre_q3 = pre_q0; } } }
    if (hi == 0) li_l[r32] = l_reg; asm volatile("s_waitcnt lgkmcnt(0)" ::: "memory");
    { LAS char* ot = lds + wid * 8448;
#pragma unroll
      for (int r = 0; r < 16; ++r) { const int orow = crow(r, hi); const float rl = __builtin_amdgcn_rcpf(li_l[orow]);
#pragma unroll
          for (int d0 = 0; d0 < 4; ++d0) { const float v = o[d0][r] * rl; *(LAS bf16_t*)(ot + orow * 264 + (d0 * 32 + r32) * 2) = (bf16_t)(cvt_pk_bf16(v, v) & 0xffffu); } }
      asm volatile("s_waitcnt lgkmcnt(0)" ::: "memory");
      char* Ow = (char*)(a.O + (size_t)(wid * 32) * a.os);
      const int orow0 = lane >> 4, ocol = (lane & 15) * 16;
#pragma unroll
      for (int i = 0; i < 8; ++i) { const int orow = orow0 + 4 * i; const u32x2 w0 = *(const LAS u32x2*)(ot + orow * 264 + ocol), w1 = *(const LAS u32x2*)(ot + orow * 264 + ocol + 8);
          u32x4 w; w.x = w0.x; w.y = w0.y; w.z = w1.x; w.w = w1.y;
          *(u32x4*)(Ow + (size_t)orow * a.os * 2 + ocol) = w; } }
    if constexpr (DIL) { if (hi == 0) a.lse[(size_t)(wid * 32 + r32) * a.ls] = m_reg + __builtin_amdgcn_logf(l_reg); }
    __syncthreads();
#if defined(PROBE_TIMING)
    if (DIL && a.dbg && tid == PROBE_TID && PROBE_TIMING == 7) *a.dbg = (float)(__builtin_amdgcn_s_memtime() - t_entry) * 1e-6f;
#endif
#undef ATT_KROW0
#undef ATT_BAR
#undef ATT_DMAK
#undef ATT_DMAV
#undef ATT_LOADPOS
#undef ATT_WRITEPOS
#undef ATT_VMW
#undef ATT_RESC
#undef ATT_DL0
#undef ATT_TV
#undef ATT_MASKED
}
struct Unit8 { const unsigned char* Q; const unsigned char* K; const unsigned char* VT; bf16_t* O; int os, nt; float* dbg; };
__device__ __forceinline__ v8i ld32(const LAS char* p) { return __builtin_shufflevector(*(const LAS i32x4*)p, *(const LAS i32x4*)(p + 16), 0, 1, 2, 3, 4, 5, 6, 7); }
#define ATT8_MFMA(a_, b_, c_) __builtin_amdgcn_mfma_scale_f32_32x32x64_f8f6f4(a_, b_, c_, 0, 0, 0, 0, 0, 0)
__device__ __forceinline__ void attn_mla8_unit(const Unit8& a, LAS char* lds, int wv, bf16x8& pre_q0, bf16x8& pre_q1, bf16x8& pre_q2, bf16x8& pre_q3, int& pre_pq, int& pre_ppos, int& pre_valid, const Unit& dn, bool dil_next) {
    constexpr int KROWB = 208, SHM_K = 64 * KROWB  , VROWB = 80, SHM_V = 128 * VROWB  , NKP = 13, NVP = 10;
    constexpr int NSLOT = MLA_2T ? 4 : 3;
    constexpr int OFF_V = 0, OFF_K = NSLOT * SHM_V, OFF_WS = OFF_K + NSLOT * SHM_K;
    static_assert(OFF_WS + 8 * 64 * 4 <= RING_BYTES, "rings and per-wave words inside the ring area");
    static_assert(!(MLA_2T && MLA_PRE), "the fragment prefetch is written for the one-tile interval");
    static_assert(8 * 8448 <= OFF_WS, "output staging images below the per-wave words");
    constexpr float THR2 = 5.0f * LOG2E;
    const int tid = opaque_tid(wv), wid = __builtin_amdgcn_readfirstlane(tid >> 6), lane = tid & 63, r32 = lane & 31, hi = lane >> 5;
    LAS char* V_lds = lds + OFF_V; LAS char* K_lds = lds + OFF_K;
    LAS float* li_l = (LAS float*)(lds + OFF_WS) + wid * 64; LAS float* al_l = li_l + 32;
    float m2 = 0.f, l_reg = 0.f; f32x16 o[4] = {}; v8i qr[3];
    { const unsigned char* Qw = a.Q + (size_t)(wid * 32 + r32) * 192 + hi * 32;
#pragma unroll
      for (int c = 0; c < 3; ++c) qr[c] = __builtin_shufflevector(*(const i32x4*)(Qw + 64 * c), *(const i32x4*)(Qw + 64 * c + 16), 0, 1, 2, 3, 4, 5, 6, 7); }
    unsigned kgo[2], vgo[2];
#pragma unroll
    for (int i = 0; i < 2; ++i) { const int p = (wid + 8 * i) * 64 + lane, kr = p / 13, kc = p % 13; kgo[i] = (unsigned)(kr * 192 + (kc == 12 ? 0 : kc) * 16);
        const int vr = p / 5, vc = p % 5; vgo[i] = (unsigned)(vr * 64 + (vc == 4 ? 0 : vc) * 16); }
#define ATT8_DMAK(j, slot) do { const char* kt_ = (const char*)a.K + (size_t)(j) * 64 * 192; LAS char* kd_ = K_lds + (slot) * SHM_K + wid * 1024; \
        __builtin_amdgcn_global_load_lds((const unsigned*)(kt_ + kgo[0]), (LAS unsigned*)(kd_), 16, 0, 0); \
        if (wid + 8 < NKP) __builtin_amdgcn_global_load_lds((const unsigned*)(kt_ + kgo[1]), (LAS unsigned*)(kd_ + 8192), 16, 0, 0); } while (0)
#define ATT8_DMAV(j, slot) do { const char* vt_ = (const char*)a.VT + (size_t)(j) * 8192; LAS char* vd_ = V_lds + (slot) * SHM_V + wid * 1024; \
        __builtin_amdgcn_global_load_lds((const unsigned*)(vt_ + vgo[0]), (LAS unsigned*)(vd_), 16, 0, 0); \
        if (wid + 8 < NVP) __builtin_amdgcn_global_load_lds((const unsigned*)(vt_ + vgo[1]), (LAS unsigned*)(vd_ + 8192), 16, 0, 0); } while (0)
#define ATT8_VMW() asm volatile("s_waitcnt vmcnt(0)" ::: "memory")
#define ATT8_BAR() do { asm volatile("s_waitcnt lgkmcnt(0)" ::: "memory"); __builtin_amdgcn_s_barrier(); asm volatile("" ::: "memory"); } while (0)
#define ATT8_RD(dst_, addr_, off_) do { i32x4 lo_, hi_; asm volatile("ds_read_b128 %0, %1 offset:%2" : "=&v"(lo_) : "v"(addr_), "i"(off_) : "memory"); \
        asm volatile("ds_read_b128 %0, %1 offset:%2" : "=&v"(hi_) : "v"(addr_), "i"((off_) + 16) : "memory"); dst_ = __builtin_shufflevector(lo_, hi_, 0, 1, 2, 3, 4, 5, 6, 7); } while (0)
#define ATT8_LW(n) asm volatile("s_waitcnt lgkmcnt(" #n ")" ::: "memory")
    const int koff = r32 * KROWB + hi * 32, voff = r32 * VROWB + hi * 32;
    f32x16 p0, p1, nm16; v8i pa = {}; const int NT = a.nt;
#if MLA_LSUM
    f32x16 lacc = {}; v8i ones8; { int c_ = 0x38383838; asm volatile("" : "+v"(c_)); _Pragma("unroll") for (int i = 0; i < 8; ++i) ones8[i] = c_; }
#endif
    const bool grpB = MLA_SWAP_ROLES ? (wid < 4) : (wid >= 4);
    ATT8_DMAK(0, 0); ATT8_DMAK(1, 1); ATT8_DMAV(0, 0); ATT8_VMW();
    __syncthreads();
    int s0 = 0, s1 = 1, s2 = 2;
#define ATT8_ISSUE() do { if (j + 2 < NT) ATT8_DMAK(j + 2, s2); if (j + 1 < NT) ATT8_DMAV(j + 1, s1); } while (0)
#define ATT8_QK6(kb_, G0_, G1_, G2_, C0_, C1_) do { \
        ATT8_RD(G2_, kb_, 64); ATT8_LW(4); ATT_SBAR(); p0 = ATT8_MFMA(G0_, qr[0], C0_); ATT_SBAR(); \
        ATT8_RD(G0_, kb_, 32 * KROWB + 64); ATT8_LW(4); ATT_SBAR(); p1 = ATT8_MFMA(G1_, qr[0], C1_); ATT_SBAR(); \
        ATT8_RD(G1_, kb_, 128); ATT8_LW(4); ATT_SBAR(); p0 = ATT8_MFMA(G2_, qr[1], p0); ATT_SBAR(); \
        ATT8_RD(G2_, kb_, 32 * KROWB + 128); ATT8_LW(4); ATT_SBAR(); p1 = ATT8_MFMA(G0_, qr[1], p1); ATT_SBAR(); \
        ATT8_LW(2); ATT_SBAR(); p0 = ATT8_MFMA(G1_, qr[2], p0); ATT_SBAR(); \
        ATT8_LW(0); ATT_SBAR(); p1 = ATT8_MFMA(G2_, qr[2], p1); ATT_SBAR(); } while (0)
#if MLA_PKOLD
#define ATT8_PK4(w_, P_, q_) do { w_ = __builtin_amdgcn_cvt_pk_fp8_f32(P_[4 * (q_)], P_[4 * (q_) + 1], w_, false); w_ = __builtin_amdgcn_cvt_pk_fp8_f32(P_[4 * (q_) + 2], P_[4 * (q_) + 3], w_, true); } while (0)
#else
#define ATT8_PK4(w_, P_, q_) do { w_ = (int)pk4_fp8(P_[4 * (q_)], P_[4 * (q_) + 1], P_[4 * (q_) + 2], P_[4 * (q_) + 3]); } while (0)
#endif
#define ATT8_PACK() do { _Pragma("unroll") for (int q = 0; q < 4; ++q) { ATT8_PK4(pa[q], p0, q); ATT8_PK4(pa[4 + q], p1, q); } } while (0)
#define ATT8_PAIR(P_, i_) (f32x2){P_[2 * (i_)], P_[2 * (i_) + 1]}
#if MLA_PKADD
#define ATT8_SUM32(ps_) f32x2 pp_ = ATT8_PAIR(p0, 0); _Pragma("unroll") for (int r = 1; r < 8; ++r) pp_ += ATT8_PAIR(p0, r); _Pragma("unroll") for (int r = 0; r < 8; ++r) pp_ += ATT8_PAIR(p1, r); float ps_ = pp_[0] + pp_[1]
#else
#define ATT8_SUM32(ps_) float ps_ = 0.f; _Pragma("unroll") for (int r = 0; r < 16; ++r) ps_ += p0[r]; _Pragma("unroll") for (int r = 0; r < 16; ++r) ps_ += p1[r]
#endif
#if MLA_LSUM
#define ATT8_ROWSUM(al_) do { } while (0)
#define ATT8_LMFMA() lacc = ATT8_MFMA(pa, ones8, lacc)
#define ATT8_LRESC() do { _Pragma("unroll") for (int r = 0; r < 16; ++r) lacc[r] *= al_l[crow(r, hi)]; } while (0)
#else
#define ATT8_LMFMA() do { } while (0)
#define ATT8_LRESC() do { } while (0)
#define ATT8_ROWSUM(al_) do { ATT8_SUM32(ps_); \
        { auto rr = __builtin_amdgcn_permlane32_swap(__float_as_uint(ps_), __float_as_uint(ps_), false, false); ps_ = __uint_as_float(rr[0]) + __uint_as_float(rr[1]); } l_reg = l_reg * (al_) + ps_; } while (0)
#endif
#if MLA_NM16
#define ATT8_INIT() do { const float nm_ = -m2; _Pragma("unroll") for (int r = 0; r < 16; ++r) nm16[r] = nm_; } while (0)
#define ATT8_INIT_SLOW() nm16 -= dl
#define ATT8_INIT_TILE() do { } while (0)
#define ATT8_C0 nm16
#define ATT8_C1 nm16
#else
#define ATT8_INIT() do { } while (0)
#define ATT8_INIT_SLOW() do { } while (0)
#define ATT8_INIT_TILE() do { const float nm_ = -m2; _Pragma("unroll") for (int r = 0; r < 16; ++r) { p0[r] = nm_; p1[r] = nm_; } } while (0)
#define ATT8_C0 p0
#define ATT8_C1 p1
#endif
#define ATT8_ROWMAX(pm_) do { pm_ = p0[0]; _Pragma("unroll") for (int r = 1; r < 16; ++r) pm_ = fmaxf(pm_, p0[r]); _Pragma("unroll") for (int r = 0; r < 16; ++r) pm_ = fmaxf(pm_, p1[r]); \
        { auto rr = __builtin_amdgcn_permlane32_swap(__float_as_uint(pm_), __float_as_uint(pm_), false, false); pm_ = fmaxf(__uint_as_float(rr[0]), __uint_as_float(rr[1])); } } while (0)
#define ATT8_X0() ATT8_X0_(s0)
#define ATT8_X() ATT8_X_(s0, s2)
#define ATT8_X0_(ks_) do { const int kb = (int)(unsigned)(size_t)(K_lds + (ks_) * SHM_K + koff); v8i g0, g1, g2; ATT8_RD(g0, kb, 0); ATT8_RD(g1, kb, 32 * KROWB); ATT8_QK6(kb, g0, g1, g2, f32x16{}, f32x16{}); } while (0)
#if MLA_PRE
#define ATT8_XPRE(vs_) do { const int vb = (int)(unsigned)(size_t)(V_lds + (vs_) * SHM_V + voff); ATT8_RD(g0, vb, 0); ATT8_RD(g1, vb, 32 * VROWB); } while (0)
#define ATT8_XHEAD() do { } while (0)
    v8i g0, g1;
#define ATT8_XDECL() v8i g2
#else
#define ATT8_XPRE(vs_) do { } while (0)
#define ATT8_XHEAD() do { ATT8_RD(g0, vb, 0); ATT8_RD(g1, vb, 32 * VROWB); } while (0)
#define ATT8_XDECL() v8i g0, g1, g2
#endif
#if MLA_LEAD3
#define ATT8_X_(ks_, vs_) do { const int vb = (int)(unsigned)(size_t)(V_lds + (vs_) * SHM_V + voff), kb = (int)(unsigned)(size_t)(K_lds + (ks_) * SHM_K + koff); ATT8_XDECL(); v8i g3; \
        ATT8_XM(); ATT8_XHEAD(); ATT8_RD(g2, vb, 64 * VROWB); ATT_SBAR(); \
        ATT8_RD(g3, vb, 96 * VROWB); ATT8_LW(6); ATT_SBAR(); o[0] = ATT8_MFMA(pa, g0, o[0]); ATT_SBAR(); \
        ATT8_RD(g0, kb, 0); ATT8_LW(6); ATT_SBAR(); o[1] = ATT8_MFMA(pa, g1, o[1]); ATT_SBAR(); \
        ATT8_RD(g1, kb, 32 * KROWB); ATT8_LW(6); ATT_SBAR(); o[2] = ATT8_MFMA(pa, g2, o[2]); ATT_SBAR(); \
        ATT8_RD(g2, kb, 64); ATT8_LW(6); ATT_SBAR(); o[3] = ATT8_MFMA(pa, g3, o[3]); ATT8_LMFMA(); ATT_SBAR(); \
        ATT8_RD(g3, kb, 32 * KROWB + 64); ATT8_LW(6); ATT_SBAR(); p0 = ATT8_MFMA(g0, qr[0], ATT8_C0); ATT_SBAR(); \
        ATT8_RD(g0, kb, 128); ATT8_LW(6); ATT_SBAR(); p1 = ATT8_MFMA(g1, qr[0], ATT8_C1); ATT_SBAR(); \
        ATT8_RD(g1, kb, 32 * KROWB + 128); ATT8_LW(6); ATT_SBAR(); p0 = ATT8_MFMA(g2, qr[1], p0); ATT_SBAR(); \
        ATT8_LW(4); ATT_SBAR(); p1 = ATT8_MFMA(g3, qr[1], p1); ATT_SBAR(); \
        ATT8_LW(2); ATT_SBAR(); p0 = ATT8_MFMA(g0, qr[2], p0); ATT_SBAR(); \
        ATT8_LW(0); ATT_SBAR(); p1 = ATT8_MFMA(g1, qr[2], p1); ATT_SBAR(); ATT8_XM_END(); } while (0)
#else
#define ATT8_X_(ks_, vs_) do { const int vb = (int)(unsigned)(size_t)(V_lds + (vs_) * SHM_V + voff), kb = (int)(unsigned)(size_t)(K_lds + (ks_) * SHM_K + koff); ATT8_XDECL(); \
        ATT8_XM(); ATT8_XHEAD(); ATT_SBAR(); \
        ATT8_RD(g2, vb, 64 * VROWB); ATT8_LW(4); ATT_SBAR(); o[0] = ATT8_MFMA(pa, g0, o[0]); ATT_SBAR(); \
        ATT8_RD(g0, vb, 96 * VROWB); ATT8_LW(4); ATT_SBAR(); o[1] = ATT8_MFMA(pa, g1, o[1]); ATT_SBAR(); \
        ATT8_RD(g1, kb, 0); ATT8_LW(4); ATT_SBAR(); o[2] = ATT8_MFMA(pa, g2, o[2]); ATT_SBAR(); \
        ATT8_RD(g2, kb, 32 * KROWB); ATT8_LW(4); ATT_SBAR(); o[3] = ATT8_MFMA(pa, g0, o[3]); ATT8_LMFMA(); ATT_SBAR(); \
        ATT8_QK6(kb, g1, g2, g0, ATT8_C0, ATT8_C1); ATT8_XM_END(); } while (0)
#endif
#define ATT8_S0() do { float pmax; ATT8_ROWMAX(pmax); m2 = pmax; \
        _Pragma("unroll") for (int r = 0; r < 16; ++r) { p0[r] = __builtin_amdgcn_exp2f(p0[r] - m2); p1[r] = __builtin_amdgcn_exp2f(p1[r] - m2); } \
        ATT8_ROWSUM(1.f); ATT8_PACK(); ATT8_INIT(); ATT8_INIT_TILE(); } while (0)
#if defined(MLA_XVALU)
#define ATT8_XV() do { _Pragma("unroll") for (int r = 0; r < MLA_XVALU; ++r) { float d_; asm volatile("v_exp_f32 %0, %1" : "=v"(d_) : "v"(p0[r & 15])); } } while (0)
#elif defined(MLA_XADD)
#define ATT8_XV() do { _Pragma("unroll") for (int r = 0; r < MLA_XADD; ++r) { float d_; asm volatile("v_add_f32 %0, %1, %1" : "=v"(d_) : "v"(p0[r & 15])); } } while (0)
#else
#define ATT8_XV() do { } while (0)
#endif
#if defined(MLA_XMFMA)
#define ATT8_XM() f32x16 dacc_ = ATT8_MFMA(qr[0], qr[1], f32x16{}); _Pragma("unroll") for (int r = 1; r < MLA_XMFMA; ++r) dacc_ = ATT8_MFMA(qr[0], qr[1], dacc_)
#define ATT8_XM_END() asm volatile("" :: "v"(dacc_))
#else
#define ATT8_XM() do { } while (0)
#define ATT8_XM_END() do { } while (0)
#endif
#if MLA_ILV && MLA_LSUM
#define ATT8_E2(P_, i_) do { P_[i_] = __builtin_amdgcn_exp2f(P_[i_]); P_[(i_) + 1] = __builtin_amdgcn_exp2f(P_[(i_) + 1]); } while (0)
#define ATT8_CLO(w_, P_, q_) w_ = __builtin_amdgcn_cvt_pk_fp8_f32(P_[4 * (q_)], P_[4 * (q_) + 1], w_, false)
#define ATT8_CHI(w_, P_, q_) w_ = __builtin_amdgcn_cvt_pk_fp8_f32(P_[4 * (q_) + 2], P_[4 * (q_) + 3], w_, true)
#define ATT8_EW(P_, q_, PP_, qp_, wp_) do { ATT8_E2(P_, 4 * (q_)); ATT8_CLO(wp_, PP_, qp_); ATT_SBAR(); ATT8_E2(P_, 4 * (q_) + 2); ATT8_CHI(wp_, PP_, qp_); ATT_SBAR(); } while (0)
#define ATT8_EXPPACK() do { _Pragma("unroll") for (int q = 0; q < 8; ++q) pa[q] = 0; \
        ATT8_E2(p0, 0); ATT8_E2(p0, 2); ATT_SBAR(); \
        ATT8_EW(p0, 1, p0, 0, pa[0]); ATT8_EW(p0, 2, p0, 1, pa[1]); ATT8_EW(p0, 3, p0, 2, pa[2]); ATT8_EW(p1, 0, p0, 3, pa[3]); \
        ATT8_EW(p1, 1, p1, 0, pa[4]); ATT8_EW(p1, 2, p1, 1, pa[5]); ATT8_EW(p1, 3, p1, 2, pa[6]); \
        ATT8_CLO(pa[7], p1, 3); ATT8_CHI(pa[7], p1, 3); } while (0)
#else
#define ATT8_EXPPACK() do { _Pragma("unroll") for (int r = 0; r < 16; ++r) { p0[r] = __builtin_amdgcn_exp2f(p0[r]); p1[r] = __builtin_amdgcn_exp2f(p1[r]); } ATT8_ROWSUM(al); ATT8_PACK(); } while (0)
#endif
#define ATT8_S() do { float pmax, al = 1.f; ATT8_XV(); ATT8_ROWMAX(pmax); \
        if (__builtin_expect(!__all(pmax <= THR2), 0)) { \
            const float dl = fmaxf(pmax, 0.f); al = __builtin_amdgcn_exp2f(-dl); m2 += dl; \
            if (hi == 0) al_l[r32] = al; asm volatile("s_waitcnt lgkmcnt(0)" ::: "memory"); \
            _Pragma("unroll") for (int d = 0; d < 4; ++d) _Pragma("unroll") for (int r = 0; r < 16; ++r) o[d][r] *= al_l[crow(r, hi)]; ATT8_LRESC(); \
            _Pragma("unroll") for (int r = 0; r < 16; ++r) { p0[r] -= dl; p1[r] -= dl; } ATT8_INIT_SLOW(); } \
        ATT8_EXPPACK(); ATT8_INIT_TILE(); } while (0)
#define ATT8_ROT() do { const int t_ = s0; s0 = s1; s1 = s2; s2 = t_; } while (0)
#define ATT8_PRIO(p_) do { if ((MLA_SPRIO) != 0 || (MLA_SPRIO_A) != 0) __builtin_amdgcn_s_setprio(p_); } while (0)
#define ATT8_XPRIO(p_) do { if ((MLA_XPRIO) != 0 || (MLA_XPRIO_B) != 0) __builtin_amdgcn_s_setprio(p_); } while (0)
#if defined(PROBE_TIMING)
    const unsigned long long tstart8 = __builtin_amdgcn_s_memtime(), rstart8 = __builtin_amdgcn_s_memrealtime(); __builtin_amdgcn_s_waitcnt(0xC07F);
#endif
#if MLA_T15
    static_assert(MLA_LSUM != 0 && MLA_NM16 != 0 && MLA_2T == 0, "the two-tile pipeline is written for MFMA row sums and the -m C operand");
    f32x16 q0, q1;
#if MLA_PRE
    v8i g2;
#else
    v8i g0, g1, g2;
#endif
#define T15_EP(P_, q_, w_) do { P_[4 * (q_)] = __builtin_amdgcn_exp2f(P_[4 * (q_)]); P_[4 * (q_) + 1] = __builtin_amdgcn_exp2f(P_[4 * (q_) + 1]); P_[4 * (q_) + 2] = __builtin_amdgcn_exp2f(P_[4 * (q_) + 2]); \
        P_[4 * (q_) + 3] = __builtin_amdgcn_exp2f(P_[4 * (q_) + 3]); pa[w_] = (int)pk4_fp8(P_[4 * (q_)], P_[4 * (q_) + 1], P_[4 * (q_) + 2], P_[4 * (q_) + 3]); } while (0)
#define T15_EPALL(X0_, X1_) do { T15_EP(X0_, 0, 0); T15_EP(X0_, 1, 1); T15_EP(X0_, 2, 2); T15_EP(X0_, 3, 3); T15_EP(X1_, 0, 4); T15_EP(X1_, 1, 5); T15_EP(X1_, 2, 6); T15_EP(X1_, 3, 7); } while (0)
#define T15_Q(X0_, X1_, Y0_, Y1_, C_) do { const int kb = (int)(unsigned)(size_t)(K_lds + s0 * SHM_K + koff), vb = (int)(unsigned)(size_t)(V_lds + s2 * SHM_V + voff); \
        ATT8_RD(g2, kb, 64); ATT8_LW(4); ATT_SBAR(); Y0_ = ATT8_MFMA(g0, qr[0], C_); ATT_SBAR(); T15_EP(X0_, 0, 0); T15_EP(X0_, 1, 1); ATT_SBAR(); \
        ATT8_RD(g0, kb, 32 * KROWB + 64); ATT8_LW(4); ATT_SBAR(); Y1_ = ATT8_MFMA(g1, qr[0], C_); ATT_SBAR(); T15_EP(X0_, 2, 2); ATT_SBAR(); \
        ATT8_RD(g1, kb, 128); ATT8_LW(4); ATT_SBAR(); Y0_ = ATT8_MFMA(g2, qr[1], Y0_); ATT_SBAR(); T15_EP(X0_, 3, 3); ATT_SBAR(); \
        ATT8_RD(g2, kb, 32 * KROWB + 128); ATT8_LW(4); ATT_SBAR(); Y1_ = ATT8_MFMA(g0, qr[1], Y1_); ATT_SBAR(); T15_EP(X1_, 0, 4); T15_EP(X1_, 1, 5); ATT_SBAR(); \
        ATT8_RD(g0, vb, 0); ATT8_LW(4); ATT_SBAR(); Y0_ = ATT8_MFMA(g1, qr[2], Y0_); ATT_SBAR(); T15_EP(X1_, 2, 6); ATT_SBAR(); \
        ATT8_RD(g1, vb, 32 * VROWB); ATT8_LW(4); ATT_SBAR(); Y1_ = ATT8_MFMA(g2, qr[2], Y1_); ATT_SBAR(); T15_EP(X1_, 3, 7); ATT_SBAR(); } while (0)
#define T15_P(Y0_, Y1_, pm_) do { const int vb = (int)(unsigned)(size_t)(V_lds + s2 * SHM_V + voff), kn = (int)(unsigned)(size_t)(K_lds + s1 * SHM_K + koff); \
        ATT8_RD(g2, vb, 64 * VROWB); ATT8_LW(4); ATT_SBAR(); o[0] = ATT8_MFMA(pa, g0, o[0]); ATT_SBAR(); \
        ATT8_RD(g0, vb, 96 * VROWB); ATT8_LW(4); ATT_SBAR(); o[1] = ATT8_MFMA(pa, g1, o[1]); ATT_SBAR(); \
        ATT8_RD(g1, kn, 32 * KROWB); ATT8_LW(4); ATT_SBAR(); o[2] = ATT8_MFMA(pa, g2, o[2]); ATT_SBAR(); \
        { pm_ = Y0_[0]; _Pragma("unroll") for (int r = 1; r < 16; ++r) pm_ = fmaxf(pm_, Y0_[r]); } ATT_SBAR(); \
        ATT8_LW(2); ATT_SBAR(); o[3] = ATT8_MFMA(pa, g0, o[3]); ATT_SBAR(); \
        ATT8_RD(g0, kn, 0); ATT_SBAR(); \
        { _Pragma("unroll") for (int r = 0; r < 16; ++r) pm_ = fmaxf(pm_, Y1_[r]); } ATT_SBAR(); \
        lacc = ATT8_MFMA(pa, ones8, lacc); ATT_SBAR(); \
        { auto rr = __builtin_amdgcn_permlane32_swap(__float_as_uint(pm_), __float_as_uint(pm_), false, false); pm_ = fmaxf(__uint_as_float(rr[0]), __uint_as_float(rr[1])); } } while (0)
#define T15_DEC(Y0_, Y1_, pm_) do { if (__builtin_expect(!__all(pm_ <= THR2), 0)) { \
            const float dl = fmaxf(pm_, 0.f), al = __builtin_amdgcn_exp2f(-dl); m2 += dl; \
            if (hi == 0) al_l[r32] = al; asm volatile("s_waitcnt lgkmcnt(0)" ::: "memory"); \
            _Pragma("unroll") for (int d = 0; d < 4; ++d) _Pragma("unroll") for (int r = 0; r < 16; ++r) o[d][r] *= al_l[crow(r, hi)]; ATT8_LRESC(); \
            _Pragma("unroll") for (int r = 0; r < 16; ++r) { Y0_[r] -= dl; Y1_[r] -= dl; } nm16 -= dl; } } while (0)
#define T15_BODY(X0_, X1_, Y0_, Y1_) do { float pm_; ATT8_ISSUE(); ATT_SBAR(); T15_Q(X0_, X1_, Y0_, Y1_, nm16); T15_P(Y0_, Y1_, pm_); ATT_SBAR(); T15_DEC(Y0_, Y1_, pm_); ATT_SBAR(); ATT8_VMW(); ATT8_BAR(); ATT8_ROT(); } while (0)
    { const int j = 0; ATT8_ISSUE(); ATT_SBAR(); ATT8_X0(); ATT_SBAR();
      float pmax; ATT8_ROWMAX(pmax); m2 = pmax;
#pragma unroll
      for (int r = 0; r < 16; ++r) { p0[r] -= m2; p1[r] -= m2; }
      ATT8_INIT(); ATT_SBAR();
      { const int kn = (int)(unsigned)(size_t)(K_lds + s1 * SHM_K + koff); ATT8_RD(g0, kn, 0); ATT8_RD(g1, kn, 32 * KROWB); }
      ATT8_VMW(); ATT8_BAR(); ATT8_ROT(); }
#pragma unroll 1
    for (int j = 1; j + 1 < NT; j += 2) { T15_BODY(p0, p1, q0, q1); { const int j_ = j; const int j = j_ + 1; T15_BODY(q0, q1, p0, p1); } }
    { const int j = NT - 1; T15_BODY(p0, p1, q0, q1); }
    T15_EPALL(q0, q1);
#undef T15_EP
#undef T15_EPALL
#undef T15_Q
#undef T15_P
#undef T15_DEC
#undef T15_BODY
#elif MLA_2T
#define ATT8_ISSUE2(i_) do { const int t_ = 2 * (i_); if (t_ + 2 < NT) { ATT8_DMAK(t_ + 2, (t_ + 2) & 3); ATT8_DMAK(t_ + 3, (t_ + 3) & 3); ATT8_DMAV(t_ + 2, (t_ + 2) & 3); } ATT8_DMAV(t_ + 1, (t_ + 1) & 3); } while (0)
    if (!grpB) {
        { ATT8_ISSUE2(0); ATT_SBAR(); ATT8_X0_(0); ATT_SBAR(); ATT8_S0(); ATT_SBAR(); }
#pragma unroll 1
        for (int j = 1; j < NT; ++j) { if (!(j & 1)) ATT8_ISSUE2(j >> 1); ATT_SBAR(); ATT8_X_(j & 3, (j - 1) & 3); ATT_SBAR(); ATT8_S(); ATT_SBAR(); if (j & 1) { ATT8_VMW(); ATT8_BAR(); } }
    } else {
        { ATT8_ISSUE2(0); ATT_SBAR(); ATT8_X0_(0); ATT_SBAR(); ATT8_S0(); ATT_SBAR(); ATT8_X_(1, 0); ATT_SBAR(); ATT8_VMW(); ATT8_BAR(); }
#pragma unroll 1
        for (int j = 2; j < NT; ++j) { if (!(j & 1)) ATT8_ISSUE2(j >> 1); ATT_SBAR(); ATT8_S(); ATT_SBAR(); ATT8_X_(j & 3, (j - 1) & 3); ATT_SBAR(); if (j & 1) { ATT8_VMW(); ATT8_BAR(); } }
        ATT8_S();
    }
    s2 = (NT - 1) & 3;
#undef ATT8_ISSUE2
#else
#if MLA_STATIC_PRIO
    if (MLA_STATIC_PRIO_A ? !grpB : grpB) __builtin_amdgcn_s_setprio(MLA_STATIC_PRIO);
#endif
    if (!grpB) {
        { const int j = 0; ATT8_ISSUE(); ATT_SBAR(); ATT8_X0(); ATT_SBAR(); ATT8_S0(); ATT_SBAR(); ATT8_XPRE(s0); ATT8_VMW(); ATT8_BAR(); ATT8_ROT(); }
#pragma unroll 1
        for (int j = 1; j < NT; ++j) { ATT8_ISSUE(); ATT_SBAR(); ATT8_XPRIO(MLA_XPRIO); ATT8_X(); ATT8_XPRIO(0); ATT_SBAR(); ATT8_PRIO(MLA_SPRIO_A); ATT8_S(); ATT8_PRIO(0); ATT_SBAR(); if (j + 1 < NT) ATT8_XPRE(s0); ATT8_VMW(); ATT8_BAR(); ATT8_ROT(); }
    } else {
        { const int j = 0; ATT8_ISSUE(); ATT_SBAR(); ATT8_X0(); ATT_SBAR(); ATT8_VMW(); ATT8_BAR(); ATT8_ROT(); }
        { const int j = 1; ATT8_ISSUE(); ATT8_XPRE(s2); ATT_SBAR(); ATT8_S0(); ATT_SBAR(); ATT8_X(); ATT_SBAR(); ATT8_VMW(); ATT8_BAR(); ATT8_ROT(); }
#pragma unroll 1
        for (int j = 2; j < NT; ++j) { ATT8_ISSUE(); ATT8_XPRE(s2); ATT_SBAR(); ATT8_PRIO(MLA_SPRIO); ATT8_S(); ATT8_PRIO(0); ATT_SBAR(); ATT8_XPRIO(MLA_XPRIO_B); ATT8_X(); ATT8_XPRIO(0); ATT_SBAR(); ATT8_VMW(); ATT8_BAR(); ATT8_ROT(); }
        ATT8_S();
    }
#if MLA_STATIC_PRIO
    __builtin_amdgcn_s_setprio(0);
#endif
#endif
#if defined(PROBE_TIMING)
    if (a.dbg && tid == PROBE_TID) { const unsigned long long tend = __builtin_amdgcn_s_memtime(), rend = __builtin_amdgcn_s_memrealtime();
        *a.dbg = PROBE_TIMING == 4 ? __builtin_floorf(((float)(tend - tstart8) / (float)(rend - rstart8) + PROBE_QOFF) * 0.25f) * 4e-2f
                                   : __builtin_rintf((float)(tend - tstart8) / (float)NT * (1.f / 256.f)) * 256e-4f; }
#endif
    { const LAS char* vb = V_lds + s2 * SHM_V + voff;
      o[0] = ATT8_MFMA(pa, ld32(vb), o[0]); o[1] = ATT8_MFMA(pa, ld32(vb + 32 * VROWB), o[1]); o[2] = ATT8_MFMA(pa, ld32(vb + 64 * VROWB), o[2]); o[3] = ATT8_MFMA(pa, ld32(vb + 96 * VROWB), o[3]); ATT8_LMFMA(); }
    ATT8_BAR();
    static_assert(MLA_LSUM != 0, "the hook below lets the dilated unit's bias table land over this unit's per-wave words: they must be dead here");
    if (dil_next) { dil_prefetch(dn, lds, tid, wid, lane, r32, hi, pre_q0, pre_q1, pre_q2, pre_q3, pre_pq, pre_ppos); pre_valid = 1; }
#if !MLA_LSUM
    if (hi == 0) li_l[r32] = l_reg; asm volatile("s_waitcnt lgkmcnt(0)" ::: "memory");
#endif
    { LAS char* ot = lds + wid * 8448;
#pragma unroll
      for (int r = 0; r < 16; ++r) { const int orow = crow(r, hi);
#if MLA_LSUM
          const float rl = __builtin_amdgcn_rcpf(lacc[r]);
#else
          const float rl = __builtin_amdgcn_rcpf(li_l[orow]);
#endif
#pragma unroll
          for (int d0 = 0; d0 < 4; ++d0) { const float v = o[d0][r] * rl; *(LAS bf16_t*)(ot + orow * 264 + (d0 * 32 + r32) * 2) = (bf16_t)(cvt_pk_bf16(v, v) & 0xffffu); } }
      asm volatile("s_waitcnt lgkmcnt(0)" ::: "memory");
      char* Ow = (char*)(a.O + (size_t)(wid * 32) * a.os);
      const int orow0 = lane >> 4, ocol = (lane & 15) * 16;
#pragma unroll
      for (int i = 0; i < 8; ++i) { const int orow = orow0 + 4 * i; const u32x2 w0 = *(const LAS u32x2*)(ot + orow * 264 + ocol), w1 = *(const LAS u32x2*)(ot + orow * 264 + ocol + 8);
          u32x4 w; w.x = w0.x; w.y = w0.y; w.z = w1.x; w.w = w1.y;
          *(u32x4*)(Ow + (size_t)orow * a.os * 2 + ocol) = w; } }
    __syncthreads();
#undef ATT8_DMAK
#undef ATT8_DMAV
#undef ATT8_VMW
#undef ATT8_BAR
#undef ATT8_RD
#undef ATT8_LW
#undef ATT8_ISSUE
#undef ATT8_QK6
#undef ATT8_PACK
#undef ATT8_ROWMAX
#undef ATT8_ROT
#undef ATT8_S
#undef ATT8_S0
#undef ATT8_X
#undef ATT8_X0
#undef ATT8_XPRE
#undef ATT8_XHEAD
#undef ATT8_XDECL
#undef ATT8_X0_
#undef ATT8_X_
#undef ATT8_ROWSUM
#undef ATT8_LMFMA
#undef ATT8_LRESC
#undef ATT8_SUM32
#undef ATT8_INIT_SLOW
#undef ATT8_INIT_TILE
#undef ATT8_C0
#undef ATT8_C1
#undef ATT8_PAIR
#undef ATT8_PK4
#undef ATT8_INIT
}
}
#if defined(MK_CHECK) && MK_CHECK
#ifndef CHK_XOR_ROW
#define CHK_XOR_ROW 0
#endif
namespace chk {
__device__ __forceinline__ float f8(const void* base, size_t idx) { return __builtin_amdgcn_cvt_f32_fp8((int)((const unsigned char*)base)[idx], 0); }
__device__ __forceinline__ float ldQK(const bf16_t* B, int hd, int t, int w) {
    return MLA_FP8 ? f8(B, ((size_t)hd * SEQ + t) * 192 + w) : bf2f(B[((size_t)hd * SEQ + t) * 192 + w]); }
__device__ __forceinline__ float ldV(const bf16_t* B, int hd, int t, int c) {
    if (!MLA_FP8) return bf2f(B[((size_t)hd * SEQ + t) * 128 + c]);
    const int k = t & 63, half = k >> 5, kp = k & 31, kg = (kp >> 2) & 1, r = (kp & 3) + 4 * (kp >> 3), e = r + 16 * half;
    return f8(B, (((size_t)hd * (SEQ / 64) + (t >> 6)) * 128 + c) * 64 + 32 * kg + e); }

__device__ __forceinline__ unsigned hash32(unsigned x) { x ^= x >> 16; x *= 0x7feb352du; x ^= x >> 15; x *= 0x846ca68bu; x ^= x >> 16; return x; }
__device__ __forceinline__ void flag(unsigned* ctl, int bit) { atomicOr(ctl + CW_DBG, 1u << bit); }
__device__ __forceinline__ bool bad_l2(float err2, float ref2, float tol) { err2 = wave_sum(err2); ref2 = wave_sum(ref2); return !(err2 <= tol * tol * ref2 + 1e-12f); }
__device__ __forceinline__ void ref_cos_sin(int pos, int j, float& c, float& s) {
    const float inv = powf(10000.0f, -(float)(2 * j) / 64.0f); const float ang = (float)pos * inv;
    c = (float)cos((double)ang); s = (float)sin((double)ang);
}
__device__ __forceinline__ int ref_bucket(int rel) {
    int ret = rel > 0 ? 16 : 0; int n = rel < 0 ? -rel : rel; float nf = (float)(n < 1 ? 1 : n);
    float v = logf(nf / 8.0f) / 4.852030263919617f * 8.0f; int large = 8 + (int)v; if (large > 15) large = 15;
    return ret + (n < 8 ? n : large);
}
__device__ __forceinline__ void check_proj(const Frame& F, int b, unsigned* ctl, const bf16_t* P, const bf16_t* CQN, const bf16_t* CKVN, const bf16_t* QB, const bf16_t* KB, const bf16_t* VB,
                                           const float* gq, const float* gkv, const float* w_uq, const float* w_ukv, const int* positions) {
    const int lane = opaque_tid(F.wave) & 63;
    for (int smp = F.gw; smp < 4096; smp += F.NGW) {
        const unsigned hsh = hash32(smp * 2654435761u + b * 97u + 12345u);
        const int t = hsh % SEQ, hd = (hsh >> 13) & 7, kind = smp & 3;
        const bf16_t* pr = (const bf16_t*)((const char*)P + (size_t)t * PROW);
        if (kind == 0) {
            float ss = 0.f; for (int k = lane; k < 384; k += 64) { const float v = bf2f(pr[C_CQ + k]); ss += v * v; }
            const float rq = 1.0f / sqrtf(wave_sum(ss) / 384.f + NORM_EPS); float e2 = 0.f, r2 = 0.f;
            for (int k = lane; k < 384; k += 64) { const float ref = bf2f(pr[C_CQ + k]) * rq * gq[k], got = bf2f(CQN[(size_t)t * 384 + k]); e2 += (ref - got) * (ref - got); r2 += ref * ref; }
            if (bad_l2(e2, r2, 0.01f)) flag(ctl, 0);
            ss = 0.f; for (int k = lane; k < 256; k += 64) { const float v = bf2f(pr[C_CKV + k]); ss += v * v; }
            const float rk = 1.0f / sqrtf(wave_sum(ss) / 256.f + NORM_EPS); e2 = 0.f; r2 = 0.f;
            for (int k = lane; k < 256; k += 64) { const float ref = bf2f(pr[C_CKV + k]) * rk * gkv[k], got = bf2f(CKVN[(size_t)t * 256 + k]); e2 += (ref - got) * (ref - got); r2 += ref * ref; }
            if (bad_l2(e2, r2, 0.01f)) flag(ctl, 0);
        } else if (kind == 1) {
            float q[3] = {0.f, 0.f, 0.f};
            for (int k = 0; k < 384; ++k) { const float a = bf2f(CQN[(size_t)t * 384 + k]);
#pragma unroll
                for (int i = 0; i < 3; ++i) q[i] += a * w_uq[(size_t)k * 1536 + hd * 192 + lane + 64 * i]; }
            if (MLA_FP8) { q[0] *= QK_LOG2_SCALE; q[1] *= QK_LOG2_SCALE; q[2] *= QK_LOG2_SCALE; }
            float e2 = 0.f, r2 = 0.f;
#pragma unroll
            for (int i = 0; i < 2; ++i) { const float got = ldQK(QB, hd, t, lane + 64 * i); e2 += (q[i] - got) * (q[i] - got); r2 += q[i] * q[i]; }
            float other; { auto rr = __builtin_amdgcn_permlane32_swap(__float_as_uint(q[2]), __float_as_uint(q[2]), false, false); other = lane < 32 ? __uint_as_float(rr[1]) : __uint_as_float(rr[0]); } float c, s; ref_cos_sin(positions[(size_t)b * SEQ + t], lane & 31, c, s);
            const float x1 = lane < 32 ? q[2] : other, x2 = lane < 32 ? other : q[2];
            const float ref = lane < 32 ? x1 * c - x2 * s : x1 * s + x2 * c;
            const float got = ldQK(QB, hd, t, 128 + 2 * (lane & 31) + (lane >> 5)); e2 += (ref - got) * (ref - got); r2 += ref * ref;
            if (bad_l2(e2, r2, MLA_FP8 ? 0.06f : 0.015f)) flag(ctl, 1);
        } else if (kind == 2) {
            float kk[2] = {0.f, 0.f};
            for (int k = 0; k < 256; ++k) { const float a = bf2f(CKVN[(size_t)t * 256 + k]); kk[0] += a * w_ukv[(size_t)k * 2048 + hd * 256 + lane]; kk[1] += a * w_ukv[(size_t)k * 2048 + hd * 256 + 64 + lane]; }
            float e2 = 0.f, r2 = 0.f;
#pragma unroll
            for (int i = 0; i < 2; ++i) { const float got = ldQK(KB, hd, t, lane + 64 * i); e2 += (kk[i] - got) * (kk[i] - got); r2 += kk[i] * kk[i]; }
            float c, s; ref_cos_sin(positions[(size_t)b * SEQ + t], lane & 31, c, s);
            const float x1 = bf2f(pr[C_KPE + (lane & 31)]), x2 = bf2f(pr[C_KPE + 32 + (lane & 31)]);
            const float ref = lane < 32 ? x1 * c - x2 * s : x1 * s + x2 * c;
            const float got = ldQK(KB, hd, t, 128 + 2 * (lane & 31) + (lane >> 5)); e2 += (ref - got) * (ref - got); r2 += ref * ref;
            if (bad_l2(e2, r2, MLA_FP8 ? 0.06f : 0.015f)) flag(ctl, 2);
        } else {
            float vv[2] = {0.f, 0.f};
            for (int k = 0; k < 256; ++k) { const float a = bf2f(CKVN[(size_t)t * 256 + k]); vv[0] += a * w_ukv[(size_t)k * 2048 + hd * 256 + 128 + lane]; vv[1] += a * w_ukv[(size_t)k * 2048 + hd * 256 + 192 + lane]; }
            float e2 = 0.f, r2 = 0.f;
#pragma unroll
            for (int i = 0; i < 2; ++i) { const float got = ldV(VB, hd, t, lane + 64 * i); e2 += (vv[i] - got) * (vv[i] - got); r2 += vv[i] * vv[i]; }
            if (bad_l2(e2, r2, MLA_FP8 ? 0.06f : 0.015f)) flag(ctl, 3);
        }
    }
}
__device__ __forceinline__ void check_mla(const Frame& F, int b, unsigned* ctl, const bf16_t* QB, const bf16_t* KB, const bf16_t* VB, const bf16_t* OA) {
    const int tid = opaque_tid(F.wave), lane = tid & 63, wave = tid >> 6;
    LAS float* qf = (LAS float*)F.lds;
    LAS float* red = qf + 192;
    LAS float* pp = red + 64;
    LAS float* oacc = pp + SEQ;
    const unsigned hsh = hash32(blockIdx.x * 40503u + b * 977u + 777u);
    const int t = hsh % SEQ, hd = (hsh >> 13) & 7;
#if defined(FORCE_FLAG)
    if (blockIdx.x == 100 && tid == 5 && b == 2) flag(ctl, FORCE_FLAG);
#endif
    __syncthreads();
    if (tid < 192) qf[tid] = ldQK(QB, hd, t, tid);
    __syncthreads();
    float mx = -1e30f;
    for (int k = tid; k < SEQ; k += 512) { float s = 0.f;
        for (int d = 0; d < 192; ++d) s += qf[d] * ldQK(KB, hd, k, d);
        s *= MLA_FP8 ? 0.6931471805599453f : 0.07216878364870322f; pp[k] = s; mx = fmaxf(mx, s); }
    mx = wave_max(mx);
    if (lane == 0) red[wave] = mx;
    __syncthreads();
    mx = red[0]; for (int w = 1; w < 8; ++w) mx = fmaxf(mx, red[w]);
    __syncthreads();
    float sm = 0.f;
    for (int k = tid; k < SEQ; k += 512) { const float p = expf(pp[k] - mx); pp[k] = p; sm += p; }
    sm = wave_sum(sm); if (lane == 0) red[wave] = sm;
    __syncthreads();
    sm = 0.f; for (int w = 0; w < 8; ++w) sm += red[w];
    const int c = tid & 127, part = tid >> 7; float acc = 0.f;
    for (int k = part * 2048; k < part * 2048 + 2048; ++k) acc += pp[k] * ldV(VB, hd, k, c);
    oacc[part * 128 + c] = acc;
    __syncthreads();
    if (tid < 64) { float e2 = 0.f, r2 = 0.f;
#pragma unroll
        for (int i = 0; i < 2; ++i) { const int cc = tid + 64 * i; const float ref = (oacc[cc] + oacc[128 + cc] + oacc[256 + cc] + oacc[384 + cc]) / sm, got = bf2f(OA[(size_t)(t ^ CHK_XOR_ROW) * DM + hd * 128 + cc]);
            e2 += (ref - got) * (ref - got); r2 += ref * ref; }
#if defined(CHK_MEASURE) && CHK_MEASURE == 4
        { const float re = sqrtf(wave_sum(e2) / wave_sum(r2)); int k = (int)floorf(-log2f(re)); k = k < 0 ? 0 : (k > 15 ? 15 : k); flag(ctl, k); }
#else
        if (bad_l2(e2, r2, 0.03f)) flag(ctl, 4);
#endif
    }
    __syncthreads();
}
__device__ __forceinline__ void check_dil(const Frame& F, int b, unsigned* ctl, const bf16_t* P, const int* positions, const float* rel_bias, const bf16_t* OG, const float* LSE) {
    const int tid = opaque_tid(F.wave), lane = tid & 63, wave = tid >> 6;
    LAS float* pw = (LAS float*)F.lds + wave * 256;
    for (int smp = F.gw; smp < 4096; smp += F.NGW) {
        const unsigned hsh = hash32(smp * 2246822519u + b * 131u + 999u);
        int t = hsh % SEQ; const int hd = (hsh >> 13) & 7, grp = (hsh >> 16) % 3, d = grp == 0 ? 1 : (grp == 1 ? 4 : 16);
        if ((smp & 7) == 0) t = (smp >> 3) % 40;
        if ((smp & 7) == 1) t = SEQ - 1 - ((smp >> 3) % 40);
        const char* gb = (const char*)P + P_OFF_DIL + grp * P_GRP;
#define CHK_QK(tok_, part_, e_) (DIL_FP8 ? f8(gb + (size_t)(tok_) * PROW + (part_) * 1024 + hd * 128, (e_)) : bf2f(((const bf16_t*)(gb + (size_t)(tok_) * PROW + (part_) * 2048 + hd * 256))[e_]))
        const int pq = positions[(size_t)b * SEQ + t];
        float sc[3]; float mx = -1e30f;
#pragma unroll
        for (int i = 0; i < 3; ++i) { const int j = lane + 64 * i - 64, tk = t + j * d; sc[i] = -1e30f;
            if (j <= 64 && tk >= 0 && tk < SEQ) { float s = 0.f;
                for (int e = 0; e < 128; ++e) s += CHK_QK(t, 0, e) * CHK_QK(tk, 1, e);
                s = s * 0.08838834764831845f + rel_bias[ref_bucket(positions[(size_t)b * SEQ + tk] - pq) * 24 + grp * 8 + hd]; sc[i] = s; }
            mx = fmaxf(mx, sc[i]); }
        mx = wave_max(mx);
        float sm = 0.f;
#pragma unroll
        for (int i = 0; i < 3; ++i) { const int j = lane + 64 * i; const float p = sc[i] > -1e29f ? expf(sc[i] - mx) : 0.f; if (j < 129) pw[j] = p; sm += p; }
        sm = wave_sum(sm);
        LDS_WAIT();
        float o0 = 0.f, o1 = 0.f;
        for (int j = 0; j < 129; ++j) { const int tk = t + (j - 64) * d; if (tk < 0 || tk >= SEQ) continue; const float p = pw[j]; const bf16_t* vr = (const bf16_t*)(gb + (size_t)tk * PROW + 2048 * P_QK_ESZ + hd * 256);
            o0 += p * bf2f(vr[lane]); o1 += p * bf2f(vr[64 + lane]); }
        o0 /= sm; o1 /= sm;
        const float g0 = bf2f(OG[((size_t)grp * SEQ + t) * DM + hd * 128 + lane]), g1 = bf2f(OG[((size_t)grp * SEQ + t) * DM + hd * 128 + 64 + lane]);
        if (bad_l2((o0 - g0) * (o0 - g0) + (o1 - g1) * (o1 - g1), o0 * o0 + o1 * o1, 0.03f)) flag(ctl, 5);
        const float lse2 = (mx + logf(sm)) * LOG2E, got = LSE[((size_t)grp * SEQ + t) * 8 + hd];
        if (!(fabsf(lse2 - got) <= 0.05f)) flag(ctl, 6);
        LDS_WAIT();
    }
}
__device__ __forceinline__ void check_u(const Frame& F, int b, unsigned* ctl, const bf16_t* P, const bf16_t* OA, const bf16_t* OG, const float* LSE, const bf16_t* Ub) {
    const int lane = opaque_tid(F.wave) & 63;
    for (int smp = F.gw; smp < 2048; smp += F.NGW) {
        const int t = hash32(smp * 374761393u + b * 31u + 5u) % SEQ; float e2 = 0.f, r2 = 0.f;
        for (int c = lane; c < DM; c += 64) { const int hd = c >> 7;
            const float l0 = LSE[((size_t)0 * SEQ + t) * 8 + hd], l1 = LSE[((size_t)1 * SEQ + t) * 8 + hd], l2 = LSE[((size_t)2 * SEQ + t) * 8 + hd], mx = fmaxf(l0, fmaxf(l1, l2));
            const float w0 = exp2f(l0 - mx), w1 = exp2f(l1 - mx), w2 = exp2f(l2 - mx), ws_ = w0 + w1 + w2;
            const float ob = (w0 * bf2f(OG[((size_t)0 * SEQ + t) * DM + c]) + w1 * bf2f(OG[((size_t)1 * SEQ + t) * DM + c]) + w2 * bf2f(OG[((size_t)2 * SEQ + t) * DM + c])) / ws_;
            const bf16_t* gr = (const bf16_t*)((const char*)P + (size_t)t * PROW + P_OFF_GATE); const float ga = 1.f / (1.f + expf(-bf2f(gr[c]))), gb = 1.f / (1.f + expf(-bf2f(gr[1024 + c])));
            const float ref = ga * bf2f(OA[(size_t)t * DM + c]) + gb * ob, got = bf2f(Ub[(size_t)t * DM + c]); e2 += (ref - got) * (ref - got); r2 += ref * ref; }
        if (bad_l2(e2, r2, 0.01f)) flag(ctl, 7);
    }
}
}
#endif
template <bool F8, class F>
__device__ __forceinline__ void transpose_item(F colptr, int ldn, void* WT, int ldk, int k0, int n0, LAS float* scr, int lane) {
    const float* cp = colptr(n0 + (lane & 31));
    float tv[32];
    const float* cpk = cp ? cp + (size_t)(k0 + (lane >> 5)) * ldn : nullptr;
#pragma unroll
    for (int i = 0; i < 32; ++i) tv[i] = cpk ? cpk[(size_t)(2 * i) * ldn] : 0.f;
#pragma unroll
    for (int i = 0; i < 32; ++i) scr[(2 * i + (lane >> 5)) * 33 + (lane & 31)] = tv[i];
    LDS_WAIT(); asm volatile("" ::: "memory");
    const int c = lane & 7;
#pragma unroll
    for (int j = 0; j < 4; ++j) { const int n = (lane >> 3) + 8 * j; const LAS float* s = scr + (8 * c) * 33 + n;
        if constexpr (F8) { u32x2 o; o.x = pk4_fp8(s[0 * 33] * W8_SCALE, s[1 * 33] * W8_SCALE, s[2 * 33] * W8_SCALE, s[3 * 33] * W8_SCALE); o.y = pk4_fp8(s[4 * 33] * W8_SCALE, s[5 * 33] * W8_SCALE, s[6 * 33] * W8_SCALE, s[7 * 33] * W8_SCALE);
            *(u32x2*)((char*)WT + (size_t)(n0 + n) * ldk + k0 + 8 * c) = o; }
        else { u32x4 o; o.x = cvt_pk_bf16(s[0 * 33], s[1 * 33]); o.y = cvt_pk_bf16(s[2 * 33], s[3 * 33]); o.z = cvt_pk_bf16(s[4 * 33], s[5 * 33]); o.w = cvt_pk_bf16(s[6 * 33], s[7 * 33]);
            *(u32x4*)((bf16_t*)WT + (size_t)(n0 + n) * ldk + k0 + 8 * c) = o; } }
    LDS_WAIT(); asm volatile("" ::: "memory");
}

__device__ __forceinline__ void p0_mod(const Frame& F, const float* c, const float* w_ada, const float* b_ada, float* mod) {
    const int tid = opaque_tid(F.wave), lane = tid & 63; (void)tid; (void)lane;
    LAS float* red = (LAS float*)F.lds;
    LAS float* sl = (LAS float*)(F.lds + 8192);
    if ((int)blockIdx.x < 96) {
        for (int i = tid; i < 4096; i += 512) { const float cv = c[i]; sl[i] = cv * fast_sigmoid(cv); }
        __syncthreads();
    }
    for (int blk = blockIdx.x; blk < 96; blk += F.G) {
        const int col = blk * 64 + (tid & 63), ks = tid >> 6;
        float a0 = 0.f, a1 = 0.f, a2 = 0.f, a3 = 0.f;
#pragma unroll 1
        for (int k0 = ks * 128; k0 < ks * 128 + 128; k0 += 16) { float w[16];
#pragma unroll
            for (int i = 0; i < 16; ++i) w[i] = w_ada[(size_t)(k0 + i) * 6144 + col];
#pragma unroll
            for (int i = 0; i < 16; ++i) { const int k = k0 + i; a0 += sl[k] * w[i]; a1 += sl[1024 + k] * w[i]; a2 += sl[2048 + k] * w[i]; a3 += sl[3072 + k] * w[i]; } }
        red[(ks * 4 + 0) * 64 + (tid & 63)] = a0; red[(ks * 4 + 1) * 64 + (tid & 63)] = a1; red[(ks * 4 + 2) * 64 + (tid & 63)] = a2; red[(ks * 4 + 3) * 64 + (tid & 63)] = a3;
        __syncthreads();
        if (tid < 256) { const int b = tid >> 6, cc = tid & 63; float s = 0.f;
#pragma unroll
            for (int q = 0; q < 8; ++q) s += red[(q * 4 + b) * 64 + cc];
            mod[b * 6144 + blk * 64 + cc] = s + b_ada[blk * 64 + cc]; }
        __syncthreads();
    }
}
__device__ __forceinline__ void p0_cs(const Frame& F, const int* pos, float* cs) {
    const int tid = opaque_tid(F.wave), lane = tid & 63; (void)tid; (void)lane;
#pragma unroll 4
    for (int i = (int)blockIdx.x * 512 + tid; i < NTOK * 32; i += F.G * 512) {
        const int t = i >> 5, j = i & 31;
        const float inv = __builtin_amdgcn_exp2f(-(float)(2 * j) / 64.f * 13.287712379549449f);
        const float ang = (float)pos[t] * inv;
        const double rev = (double)ang * 0.15915494309189535; const double fr = rev - __builtin_rint(rev);
        const float f = (float)fr;
        f32x2 o; o.x = __builtin_amdgcn_cosf(f); o.y = __builtin_amdgcn_sinf(f);
        *(f32x2*)(cs + (size_t)i * 2) = o;
    }
}
__device__ __forceinline__ void p0_lut(const Frame& F, const float* rel_bias, float* lutg) {
    const int tid = opaque_tid(F.wave);
    for (int i = (int)blockIdx.x * 512 + tid; i < 24 * 2049; i += F.G * 512) { const int l = i / 2049, u = i - l * 2049;
        lutg[l * 2304 + u + (u >> 5)] = rel_bias[att::t5_bucket(u - 1024) * 24 + l] * LOG2E; }
}
__device__ __forceinline__ void p0_weights(const Frame& F, const float* w_in, const float* w_uq, const float* w_ukv, const float* w_out, unsigned char* ws) {
    const int tid = opaque_tid(F.wave), lane = tid & 63; (void)tid; (void)lane;
    LAS float* scr = (LAS float*)(F.lds + F.wave * 16384);
    constexpr int I_IN = 16 * 376, I_UQ = 6 * 48, I_UKV = 4 * 64, I_OUT = 16 * 32;
    for (int it = F.gw; it < I_IN + I_UQ + I_UKV + I_OUT; it += F.NGW) {
        int r = it;
        if (r < I_IN) { const int kb = r / 376, nb = r % 376;
            transpose_item<(FP8_G1 != 0)>([=](int np) -> const float* { const int n = (np & ~31) + pg8::perm32(np & 31); return n < D_IN ? w_in + n : nullptr; }, D_IN, (void*)(ws + WS_WIN), 1024, kb * 64, nb * 32, scr, lane); continue; }
        r -= I_IN;
        if (r < I_UQ) { const int kb = r / 48, nb = r % 48;
            transpose_item<false>([=](int n) -> const float* { const int hd = n / 192, w = n - hd * 192; const int sc = w < 128 ? w : 128 + ((w - 128) >> 1) + 32 * ((w - 128) & 1); return w_uq + hd * 192 + sc; },
                           1536, (bf16_t*)(ws + WS_WUQ), 384, kb * 64, nb * 32, scr, lane); continue; }
        r -= I_UQ;
        if (r < I_UKV) { const int kb = r / 64, nb = r % 64;
            transpose_item<false>([=](int n) -> const float* { const int m = n & 1023; return w_ukv + (MLA_FP8 ? ((m >> 7) * 256 + (n >> 10) * 128 + (m & 127)) : n); }, 2048, (bf16_t*)(ws + WS_WUKV), 256, kb * 64, nb * 32, scr, lane); continue; }
        r -= I_UKV;
        { const int kb = r / 32, nb = r % 32;
            transpose_item<(FP8_WO != 0)>([=](int n) -> const float* { return w_out + n; }, 1024, (void*)(ws + WS_WOUT), 1024, kb * 64, nb * 32, scr, lane); }
    }
}
__device__ __forceinline__ void conv_experts(const Frame& F, const float* w_gate, const float* w_up, const float* w_down, unsigned char* ws, int part) {
    static_assert(FP8_EX != 0 && FP8_WO != 0, "fp8 expert operands; WS_WD sits in the half of the U region that the fp8 u leaves free");
    const int tid = opaque_tid(F.wave), lane = tid & 63; (void)tid;
    LAS float* scr = (LAS float*)(F.lds + F.wave * 16384);
    constexpr int N_IT = NE * 1536;
    const long du = (const char*)w_up - (const char*)w_gate;
    const int lr = lane >> 4, lf = lane & 15;
#define CE_LOAD(it_, tv_) do { const int e_ = (it_) / 1536, r_ = (it_) % 1536; const float* p_; int ldn_; \
        if (r_ < 1024) { const int a_ = r_ >> 9, kb_ = (r_ >> 5) & 15, cb_ = r_ & 31; \
            p_ = (const float*)((const char*)w_gate + (a_ ? du : 0L)) + (size_t)e_ * DM * DFF + (size_t)(kb_ * 64 + lr) * DFF + cb_ * 64 + 4 * lf; ldn_ = DFF; } \
        else { const int r2_ = r_ - 1024, kb_ = r2_ >> 4, cb_ = r2_ & 15; p_ = w_down + (size_t)e_ * DFF * DM + (size_t)(kb_ * 64 + lr) * DM + cb_ * 64 + 4 * lf; ldn_ = DM; } \
        _Pragma("unroll") for (int i = 0; i < 16; ++i) tv_[i] = CONV_NT ? __builtin_nontemporal_load((const f32x4*)(p_ + (size_t)(4 * i) * ldn_)) : *(const f32x4*)(p_ + (size_t)(4 * i) * ldn_);     } while (0)
#define CE_STORE(it_, tv_) do { const int e_ = (it_) / 1536, r_ = (it_) % 1536; unsigned char* wt_; int ldk_; \
        _Pragma("unroll") for (int i = 0; i < 16; ++i) { LAS float* d_ = scr + (lr + 4 * i) * 64 + ((4 * lf) ^ (4 * ((i >> 1) & 7))); d_[0 ^ lr] = tv_[i][0]; d_[1 ^ lr] = tv_[i][1]; d_[2 ^ lr] = tv_[i][2]; d_[3 ^ lr] = tv_[i][3]; } \
        LDS_WAIT(); asm volatile("" ::: "memory"); \
        const int c_ = lane & 7; int rowb_, a16_; bool dn_; \
        if (r_ < 1024) { const int a_ = r_ >> 9, kb_ = (r_ >> 5) & 15, cb_ = r_ & 31; wt_ = ws + WS_WGU + (size_t)e_ * 4096 * 1024 + kb_ * 64 + 8 * c_; ldk_ = 1024; rowb_ = 128 * cb_; a16_ = 16 * a_; dn_ = false; } \
        else { const int r2_ = r_ - 1024, kb_ = r2_ >> 4, cb_ = r2_ & 15; wt_ = ws + WS_WD + (size_t)e_ * 1024 * 2048 + kb_ * 64 + 8 * c_; ldk_ = 2048; rowb_ = 64 * cb_; a16_ = 0; dn_ = true; } \
        _Pragma("unroll") for (int j = 0; j < 8; ++j) { const int cc_ = (lane >> 3) + 8 * j; const LAS float* s_ = scr + (8 * c_) * 64; const int x0_ = cc_ ^ (4 * c_); u32x2 o_; \
            const int s5_ = cc_ & 31; \
            const int row_ = dn_ ? rowb_ + (cc_ & 32) + 16 * ((s5_ >> 2) & 1) + 4 * (s5_ >> 3) + (s5_ & 3) : rowb_ + 32 * (cc_ >> 4) + a16_ + (cc_ & 15); \
            o_.x = pk4_fp8(s_[0 * 64 + (x0_ ^ 0)] * W8_SCALE, s_[1 * 64 + (x0_ ^ 1)] * W8_SCALE, s_[2 * 64 + (x0_ ^ 2)] * W8_SCALE, s_[3 * 64 + (x0_ ^ 3)] * W8_SCALE); \
            o_.y = pk4_fp8(s_[4 * 64 + (x0_ ^ 0)] * W8_SCALE, s_[5 * 64 + (x0_ ^ 1)] * W8_SCALE, s_[6 * 64 + (x0_ ^ 2)] * W8_SCALE, s_[7 * 64 + (x0_ ^ 3)] * W8_SCALE); \
            *(u32x2*)(wt_ + (size_t)row_ * ldk_) = o_; } \
        LDS_WAIT(); asm volatile("" ::: "memory"); } while (0)
    f32x4 tva[16], tvb[16];
    const int it_end = (part + 1) * (N_IT / NB);
    int it = part * (N_IT / NB) + F.gw;
    if (it < it_end) CE_LOAD(it, tva);
#pragma unroll 1
    while (it < it_end) {
        const int it2 = it + F.NGW, it3 = it2 + F.NGW;
        if (it2 < it_end) CE_LOAD(it2, tvb);
        CE_STORE(it, tva);
        if (it2 < it_end) { if (it3 < it_end) CE_LOAD(it3, tva); CE_STORE(it2, tvb); }
        it = it3;
    }
    __syncthreads();
#undef CE_LOAD
#undef CE_STORE
}
__device__ __forceinline__ void norm_mod_row(const float* xrow, const float* g, const float* sh, const float* sc, int lane, f32x4 (&v)[4]) {
    float s = 0.f;
#pragma unroll
    for (int j = 0; j < 4; ++j) { v[j] = *(const f32x4*)(xrow + 4 * lane + 256 * j); s += (v[j][0] * v[j][0] + v[j][1] * v[j][1]) + (v[j][2] * v[j][2] + v[j][3] * v[j][3]); }
    const float rstd = 1.0f / sqrtf(wave_sum(s) * (1.f / DM) + NORM_EPS);
#pragma unroll
    for (int j = 0; j < 4; ++j) { const int c = 4 * lane + 256 * j; const f32x4 gg = *(const f32x4*)(g + c), s1 = *(const f32x4*)(sc + c), s0 = *(const f32x4*)(sh + c);
        v[j] = (v[j] * rstd * gg) * (s1 + 1.0f) + s0; }
}
__device__ __forceinline__ void store_row_bf16(bf16_t* orow, int lane, const f32x4 (&v)[4]) {
#pragma unroll
    for (int j = 0; j < 4; ++j) { u32x2 o; o.x = cvt_pk_bf16(v[j][0], v[j][1]); o.y = cvt_pk_bf16(v[j][2], v[j][3]); *(u32x2*)(orow + 4 * lane + 256 * j) = o; }
}
template <bool F8> __device__ __forceinline__ void store_row_act(void* orow, int lane, const f32x4 (&v)[4]) {
    if constexpr (F8) {
#pragma unroll
        for (int j = 0; j < 4; ++j) *(unsigned*)((char*)orow + 4 * lane + 256 * j) = pk4_fp8(v[j][0], v[j][1], v[j][2], v[j][3]);
    } else store_row_bf16((bf16_t*)orow, lane, v);
}
__device__ __forceinline__ void p1_h(const Frame& F, const float* x, const float* g, const float* mod, bf16_t* H) {
    const int tid = opaque_tid(F.wave), lane = tid & 63; (void)tid; (void)lane;
    f32x4 gg[4], vn[4], shn[4], scn[4];
    int t = F.gw;
#pragma unroll
    for (int j = 0; j < 4; ++j) { const int c = 4 * lane + 256 * j; gg[j] = *(const f32x4*)(g + c);
        if (t < NTOK) { const int b = t / SEQ; vn[j] = *(const f32x4*)(x + (size_t)t * DM + c); shn[j] = *(const f32x4*)(mod + b * 6144 + c); scn[j] = *(const f32x4*)(mod + b * 6144 + 1024 + c); } }
#pragma unroll 1
    for (; t < NTOK; t += F.NGW) { f32x4 v[4], sh[4], sc[4];
#pragma unroll
        for (int j = 0; j < 4; ++j) { v[j] = vn[j]; sh[j] = shn[j]; sc[j] = scn[j]; }
        const int tn = t + F.NGW;
        if (tn < NTOK) { const int bn = tn / SEQ;
#pragma unroll
            for (int j = 0; j < 4; ++j) { const int c = 4 * lane + 256 * j; vn[j] = *(const f32x4*)(x + (size_t)tn * DM + c); shn[j] = *(const f32x4*)(mod + bn * 6144 + c); scn[j] = *(const f32x4*)(mod + bn * 6144 + 1024 + c); } }
        float ss = 0.f;
#pragma unroll
        for (int j = 0; j < 4; ++j) ss += (v[j][0] * v[j][0] + v[j][1] * v[j][1]) + (v[j][2] * v[j][2] + v[j][3] * v[j][3]);
        const float rstd = 1.0f / sqrtf(wave_sum(ss) * (1.f / DM) + NORM_EPS);
#pragma unroll
        for (int j = 0; j < 4; ++j) v[j] = (v[j] * rstd * gg[j]) * (sc[j] + 1.0f) + sh[j];
        store_row_act<(FP8_G1 != 0)>((char*)H + (size_t)t * DM * (FP8_G1 ? 1 : 2), lane, v); }
}
__device__ __forceinline__ void lb_latent(const Frame& F, const bf16_t* P, const float* gq, const float* gkv, const float* cs, bf16_t* CQN, bf16_t* CKVN, bf16_t* KB) {
    const int tid = opaque_tid(F.wave), lane = tid & 63; (void)tid; (void)lane;
    f32x4 gq0 = {}, gq1 = {}, gk0 = {}, gk1 = {};
    if (lane < 48) { gq0 = *(const f32x4*)(gq + 8 * lane); gq1 = *(const f32x4*)(gq + 8 * lane + 4); }
    if (lane < 32) { gk0 = *(const f32x4*)(gkv + 8 * lane); gk1 = *(const f32x4*)(gkv + 8 * lane + 4); }
#pragma unroll 1
    for (int tb = F.gw; tb < SEQ; tb += 4 * F.NGW) {
        u32x4 wq[4], wk[4]; float xa[4], xb[4]; f32x2 cc[4];
#pragma unroll
        for (int i = 0; i < 4; ++i) { const int t = tb + i * F.NGW; wq[i] = (u32x4){0u, 0u, 0u, 0u}; wk[i] = wq[i]; xa[i] = 0.f; xb[i] = 0.f; cc[i] = (f32x2){0.f, 0.f};
            if (t < SEQ) { const bf16_t* pr = (const bf16_t*)((const char*)P + (size_t)t * PROW);
                if (lane < 48) wq[i] = *(const u32x4*)(pr + C_CQ + 8 * lane);
                if (lane < 32) { wk[i] = *(const u32x4*)(pr + C_CKV + 8 * lane); xa[i] = bf2f(pr[C_KPE + lane]); xb[i] = bf2f(pr[C_KPE + 32 + lane]); cc[i] = *(const f32x2*)(cs + ((size_t)t * 32 + lane) * 2); } } }
#pragma unroll
        for (int i = 0; i < 4; ++i) { const int t = tb + i * F.NGW; if (t >= SEQ) break;
            float q[8], s = 0.f;
            { const u32x4 w = wq[i]; q[0] = bflo(w.x); q[1] = bfhi(w.x); q[2] = bflo(w.y); q[3] = bfhi(w.y); q[4] = bflo(w.z); q[5] = bfhi(w.z); q[6] = bflo(w.w); q[7] = bfhi(w.w);
#pragma unroll
              for (int e = 0; e < 8; ++e) s += q[e] * q[e]; }
            const float rq = 1.0f / sqrtf(wave_sum(s) * (1.f / 384.f) + NORM_EPS);
            if (lane < 48) { u32x4 o; o.x = cvt_pk_bf16(q[0] * rq * gq0[0], q[1] * rq * gq0[1]); o.y = cvt_pk_bf16(q[2] * rq * gq0[2], q[3] * rq * gq0[3]);
                o.z = cvt_pk_bf16(q[4] * rq * gq1[0], q[5] * rq * gq1[1]); o.w = cvt_pk_bf16(q[6] * rq * gq1[2], q[7] * rq * gq1[3]);
                *(u32x4*)(CQN + (size_t)t * 384 + 8 * lane) = o; }
            float s2 = 0.f;
            { const u32x4 w = wk[i]; q[0] = bflo(w.x); q[1] = bfhi(w.x); q[2] = bflo(w.y); q[3] = bfhi(w.y); q[4] = bflo(w.z); q[5] = bfhi(w.z); q[6] = bflo(w.w); q[7] = bfhi(w.w);
#pragma unroll
              for (int e = 0; e < 8; ++e) s2 += q[e] * q[e]; }
            const float rk = 1.0f / sqrtf(wave_sum(s2) * (1.f / 256.f) + NORM_EPS);
            if (lane < 32) { u32x4 o; o.x = cvt_pk_bf16(q[0] * rk * gk0[0], q[1] * rk * gk0[1]); o.y = cvt_pk_bf16(q[2] * rk * gk0[2], q[3] * rk * gk0[3]);
                o.z = cvt_pk_bf16(q[4] * rk * gk1[0], q[5] * rk * gk1[1]); o.w = cvt_pk_bf16(q[6] * rk * gk1[2], q[7] * rk * gk1[3]);
                *(u32x4*)(CKVN + (size_t)t * 256 + 8 * lane) = o;
                const float x1 = xa[i], x2 = xb[i]; const f32x2 c = cc[i];
                if constexpr (MLA_FP8) { const unsigned short pk8 = (unsigned short)(__builtin_amdgcn_cvt_pk_fp8_f32(x1 * c.x - x2 * c.y, x1 * c.y + x2 * c.x, 0, false) & 0xffff);
#pragma unroll
                    for (int h = 0; h < 8; ++h) *(unsigned short*)((unsigned char*)KB + ((size_t)h * SEQ + t) * 192 + 128 + 2 * lane) = pk8; }
                else { const unsigned pk = cvt_pk_bf16(x1 * c.x - x2 * c.y, x1 * c.y + x2 * c.x);
#pragma unroll
                    for (int h = 0; h < 8; ++h) *(unsigned*)(KB + ((size_t)h * SEQ + t) * 192 + 128 + 2 * lane) = pk; } }
        }
    }
}
__device__ __forceinline__ void lb_combine(const Frame& F, const bf16_t* P, const bf16_t* OA, const bf16_t* OG, const float* LSE, bf16_t* U) {
    const int tid = opaque_tid(F.wave), lane = tid & 63; (void)tid; (void)lane;
#pragma unroll 2
    for (int t = F.gw; t < SEQ; t += F.NGW) {
#pragma unroll
        for (int j = 0; j < 2; ++j) { const int c0 = 8 * lane + 512 * j, hd = c0 >> 7;
            const float l0 = LSE[((size_t)0 * SEQ + t) * 8 + hd], l1 = LSE[((size_t)1 * SEQ + t) * 8 + hd], l2 = LSE[((size_t)2 * SEQ + t) * 8 + hd];
            const float mx = fmaxf(l0, fmaxf(l1, l2)); float w0 = __builtin_amdgcn_exp2f(l0 - mx), w1 = __builtin_amdgcn_exp2f(l1 - mx), w2 = __builtin_amdgcn_exp2f(l2 - mx);
            const float inv = 1.0f / (w0 + w1 + w2); w0 *= inv; w1 *= inv; w2 *= inv;
            const u32x4 oa = *(const u32x4*)(OA + (size_t)t * DM + c0), g0 = *(const u32x4*)(OG + ((size_t)0 * SEQ + t) * DM + c0), g1 = *(const u32x4*)(OG + ((size_t)1 * SEQ + t) * DM + c0),
                        g2 = *(const u32x4*)(OG + ((size_t)2 * SEQ + t) * DM + c0), ga = *(const u32x4*)((const char*)P + (size_t)t * PROW + P_OFF_GATE + 2 * c0), gb = *(const u32x4*)((const char*)P + (size_t)t * PROW + P_OFF_GATE + 2048 + 2 * c0);
            u32x4 o; float uf[8];
#pragma unroll
            for (int e = 0; e < 4; ++e) {
                const float ob_lo = w0 * bflo(g0[e]) + w1 * bflo(g1[e]) + w2 * bflo(g2[e]), ob_hi = w0 * bfhi(g0[e]) + w1 * bfhi(g1[e]) + w2 * bfhi(g2[e]);
                const float u_lo = fast_sigmoid(bflo(ga[e])) * bflo(oa[e]) + fast_sigmoid(bflo(gb[e])) * ob_lo;
                const float u_hi = fast_sigmoid(bfhi(ga[e])) * bfhi(oa[e]) + fast_sigmoid(bfhi(gb[e])) * ob_hi;
                if constexpr (FP8_WO) { uf[2 * e] = u_lo * U8_SCALE; uf[2 * e + 1] = u_hi * U8_SCALE; } else o[e] = cvt_pk_bf16(u_lo, u_hi); }
            if constexpr (FP8_WO) { u32x2 o8; o8.x = pk4_fp8(uf[0], uf[1], uf[2], uf[3]); o8.y = pk4_fp8(uf[4], uf[5], uf[6], uf[7]); *(u32x2*)((unsigned char*)U + (size_t)t * DM + c0) = o8; }
            else *(u32x4*)(U + (size_t)t * DM + c0) = o; }
    }
}
__device__ __forceinline__ void pg_h2_router(const Frame& F, const float* x1, const float* g, const float* mod, const float* w_router, bf16_t* H2, float* AFFT) {
    const int tid = opaque_tid(F.wave), lane = tid & 63; (void)tid;
    LAS float* wr = (LAS float*)F.lds;
    LAS float* ab = (LAS float*)(F.lds + 65536) + F.wave * 256;
    for (int i = tid; i < 1024 * 16 / 4; i += 512) { const int c = i >> 2, k = i & 3, rho = (c & 3) * 256 + (c >> 2);
        ((LAS f32x4*)wr)[rho * 4 + ((k + (rho >> 2)) & 3)] = ((const f32x4*)w_router)[i]; }
    __syncthreads();
    int roff[4];
#pragma unroll
    for (int k = 0; k < 4; ++k) roff[k] = ((k + (lane >> 2)) & 3) * 4;
    const bool b4 = (lane >> 4) & 1, b3 = (lane >> 3) & 1, b2 = (lane >> 2) & 1; const int el = 8 * (lane >> 5) + 4 * ((lane >> 4) & 1) + 2 * ((lane >> 3) & 1) + ((lane >> 2) & 1);
    for (int ch = F.gw; ch < NTOK / 16; ch += F.NGW) {
        const int t0 = ch * 16, b = t0 / SEQ, s0 = t0 % SEQ;
        f32x4 vn[4], gg[4], sc1[4], sh0[4];
#pragma unroll
        for (int j = 0; j < 4; ++j) { const int c = 4 * lane + 256 * j; vn[j] = *(const f32x4*)(x1 + (size_t)t0 * DM + c);
            gg[j] = *(const f32x4*)(g + c); sh0[j] = *(const f32x4*)(mod + b * 6144 + 3072 + c); sc1[j] = *(const f32x4*)(mod + b * 6144 + 4096 + c); }
#pragma unroll 1
        for (int ti = 0; ti < 16; ++ti) { const int t = t0 + ti; f32x4 v[4];
#pragma unroll
            for (int j = 0; j < 4; ++j) v[j] = vn[j];
            if (ti + 1 < 16) {
#pragma unroll
                for (int j = 0; j < 4; ++j) vn[j] = *(const f32x4*)(x1 + (size_t)(t + 1) * DM + 4 * lane + 256 * j); }
            { float ss = 0.f;
#pragma unroll
              for (int j = 0; j < 4; ++j) ss += (v[j][0] * v[j][0] + v[j][1] * v[j][1]) + (v[j][2] * v[j][2] + v[j][3] * v[j][3]);
              const float rstd = 1.0f / sqrtf(wave_sum(ss) * (1.f / DM) + NORM_EPS);
#pragma unroll
              for (int j = 0; j < 4; ++j) v[j] = (v[j] * rstd * gg[j]) * (sc1[j] + 1.0f) + sh0[j]; }
            store_row_act<(FP8_EX != 0)>((char*)H2 + (size_t)t * DM * (FP8_EX ? 1 : 2), lane, v);
            float lg[16];
#pragma unroll
            for (int e = 0; e < 16; ++e) lg[e] = 0.f;
#pragma unroll
            for (int j = 0; j < 4; ++j)
#pragma unroll
                for (int q = 0; q < 4; ++q) { const LAS float* wp = wr + (q * 256 + lane + 64 * j) * 16; const float hv = v[j][q];
#pragma unroll
                    for (int e4 = 0; e4 < 4; ++e4) { const f32x4 w = *(const LAS f32x4*)(wp + roff[e4]); lg[4 * e4 + 0] += hv * w[0]; lg[4 * e4 + 1] += hv * w[1]; lg[4 * e4 + 2] += hv * w[2]; lg[4 * e4 + 3] += hv * w[3]; } }
            float s8[8], s4[4], s2[2], s1;
#pragma unroll
            for (int e = 0; e < 8; ++e) { auto rr = __builtin_amdgcn_permlane32_swap(__float_as_uint(lg[e]), __float_as_uint(lg[e + 8]), false, false); s8[e] = __uint_as_float(rr[0]) + __uint_as_float(rr[1]); }
#pragma unroll
            for (int i = 0; i < 4; ++i) { const float keep = b4 ? s8[i + 4] : s8[i], send = b4 ? s8[i] : s8[i + 4]; s4[i] = keep + __int_as_float(__builtin_amdgcn_ds_swizzle(__float_as_int(send), SWZ_XOR(16))); }
#pragma unroll
            for (int i = 0; i < 2; ++i) { const float keep = b3 ? s4[i + 2] : s4[i], send = b3 ? s4[i] : s4[i + 2]; s2[i] = keep + __int_as_float(__builtin_amdgcn_ds_swizzle(__float_as_int(send), SWZ_XOR(8))); }
            { const float keep = b2 ? s2[1] : s2[0], send = b2 ? s2[0] : s2[1]; s1 = keep + __int_as_float(__builtin_amdgcn_ds_swizzle(__float_as_int(send), SWZ_XOR(4))); }
            s1 += __int_as_float(__builtin_amdgcn_ds_swizzle(__float_as_int(s1), SWZ_XOR(2)));
            s1 += __int_as_float(__builtin_amdgcn_ds_swizzle(__float_as_int(s1), SWZ_XOR(1)));
            const float mx = wave_max(s1), ex = __expf(s1 - mx), sum = wave_sum(ex) * 0.25f;
            if ((lane & 3) == 0) ab[el * 16 + ti] = ex * (1.0f / sum);
        }
        LDS_WAIT();
        { const int e = lane >> 2, q4 = (lane & 3) * 4; const f32x4 w = *(const LAS f32x4*)(ab + e * 16 + q4);
          *(f32x4*)(AFFT + ((size_t)b * NE + e) * SEQ + s0 + q4) = w; }
        LDS_WAIT();
    }
    __syncthreads();
}
__device__ __forceinline__ void ph_topk(const Frame& F, const float* AFFT, int* TOPI, float* TOPG, int* SLOT) {
    const int tid = opaque_tid(F.wave), lane = tid & 63;
    LAS unsigned* cnt = (LAS unsigned*)F.lds;
    LAS unsigned* wtot = cnt + 64;
    for (int p = blockIdx.x; p < NB * NE; p += F.G) {
        const float* src = AFFT + (size_t)p * SEQ + 16 * tid;
        unsigned key[16];
#pragma unroll
        for (int j = 0; j < 4; ++j) { const u32x4 w = *(const u32x4*)(src + 4 * j); key[4 * j] = w.x; key[4 * j + 1] = w.y; key[4 * j + 2] = w.z; key[4 * j + 3] = w.w; }
        unsigned thr = 0u;
#pragma unroll 1
        for (int bit = 30; bit >= 0; --bit) { const unsigned cand = thr | (1u << bit); unsigned c = 0;
#pragma unroll
            for (int i = 0; i < 16; ++i) c += (unsigned)__builtin_popcountll(__ballot(key[i] >= cand));
            LAS unsigned* slot = cnt + ((bit & 1) << 3);
            if (lane == 0) slot[F.wave] = c;
            __syncthreads();
            unsigned tot = 0;
#pragma unroll
            for (int w = 0; w < 8; ++w) tot += slot[w];
            if (tot >= (unsigned)CAP) thr = cand; }
        unsigned ngt = 0, neq = 0;
#pragma unroll
        for (int i = 0; i < 16; ++i) { ngt += key[i] > thr ? 1u : 0u; neq += key[i] == thr ? 1u : 0u; }
        unsigned pk = ngt | (neq << 16), inc = pk;
#pragma unroll
        for (int o = 1; o < 64; o <<= 1) { const unsigned v = (unsigned)__builtin_amdgcn_ds_bpermute((lane - o) << 2, (int)inc); if (lane >= o) inc += v; }
        __syncthreads();
        if (lane == 63) wtot[F.wave] = inc;
        __syncthreads();
        unsigned base = 0, all = 0;
        for (int w = 0; w < 8; ++w) { const unsigned v = wtot[w]; all += v; if (w < F.wave) base += v; }
        const unsigned tot_gt = all & 0xffffu, need = (unsigned)CAP - tot_gt;
        const unsigned excl = base + inc - pk; unsigned g_before = excl & 0xffffu, e_before = excl >> 16;
#pragma unroll
        for (int i = 0; i < 16; ++i) { const int s = 16 * tid + i; int slot = -1;
            if (key[i] > thr) { slot = (int)g_before; ++g_before; }
            else if (key[i] == thr) { if (e_before < need) slot = (int)(tot_gt + e_before); ++e_before; }
            SLOT[(size_t)p * SEQ + s] = slot;
            if (slot >= 0) { TOPI[p * CAP + slot] = (p >> 4) * SEQ + s; TOPG[p * CAP + slot] = __uint_as_float(key[i]); } }
        __syncthreads();
    }
}
__device__ __forceinline__ void p_final(const Frame& F, float* out, const float* mod, const int* SLOT, const bf16_t* Y, const float* gfin, float oscale) {
    const int tid = opaque_tid(F.wave), lane = tid & 63; (void)tid;
    f32x4 gf[4], xn[4], gtn[4]; int sln = -1;
#pragma unroll
    for (int j = 0; j < 4; ++j) gf[j] = *(const f32x4*)(gfin + 4 * lane + 256 * j);
    int r = F.gw;
    if (r < NTOK) { const int b = r / SEQ, s = r % SEQ; if (lane < NE) sln = SLOT[((size_t)b * NE + lane) * SEQ + s];
#pragma unroll
        for (int j = 0; j < 4; ++j) { const int c = 4 * lane + 256 * j; xn[j] = *(const f32x4*)(out + (size_t)r * DM + c); gtn[j] = *(const f32x4*)(mod + b * 6144 + 5120 + c); } }
#pragma unroll 1
    for (; r < NTOK; r += F.NGW) { const int b = r / SEQ; float* row = out + (size_t)r * DM;
        const int sl = sln; f32x4 x[4], gt[4];
#pragma unroll
        for (int j = 0; j < 4; ++j) { x[j] = xn[j]; gt[j] = gtn[j]; }
        const int rn = r + F.NGW;
        if (rn < NTOK) { const int bn = rn / SEQ, sn = rn % SEQ; sln = -1; if (lane < NE) sln = SLOT[((size_t)bn * NE + lane) * SEQ + sn];
#pragma unroll
            for (int j = 0; j < 4; ++j) { const int c = 4 * lane + 256 * j; xn[j] = *(const f32x4*)(out + (size_t)rn * DM + c); gtn[j] = *(const f32x4*)(mod + bn * 6144 + 5120 + c); } }
        unsigned long long m = __ballot(sl >= 0);
        f32x4 acc[4];
#pragma unroll
        for (int j = 0; j < 4; ++j) acc[j] = (f32x4){0.f, 0.f, 0.f, 0.f};
        while (m) { const int e0 = __builtin_ctzll(m); m &= m - 1; const bool two = m != 0ull; const int e1 = two ? __builtin_ctzll(m) : e0; if (two) m &= m - 1;
            const int slot0 = __builtin_amdgcn_readlane(sl, e0), slot1 = __builtin_amdgcn_readlane(sl, e1);
            const bf16_t* yr0 = Y + (((size_t)b * NE + e0) * CAP + slot0) * DM; const bf16_t* yr1 = Y + (((size_t)b * NE + e1) * CAP + slot1) * DM;
            u32x2 w0[4], w1[4];
#pragma unroll
            for (int j = 0; j < 4; ++j) { w0[j] = *(const u32x2*)(yr0 + 4 * lane + 256 * j); w1[j] = *(const u32x2*)(yr1 + 4 * lane + 256 * j); }
            const float k1 = two ? 1.0f : 0.0f;
#pragma unroll
            for (int j = 0; j < 4; ++j) { acc[j][0] += bflo(w0[j].x) + k1 * bflo(w1[j].x); acc[j][1] += bfhi(w0[j].x) + k1 * bfhi(w1[j].x); acc[j][2] += bflo(w0[j].y) + k1 * bflo(w1[j].y); acc[j][3] += bfhi(w0[j].y) + k1 * bfhi(w1[j].y); } }
        f32x4 v[4]; float ss = 0.f;
#pragma unroll
        for (int j = 0; j < 4; ++j) { v[j] = x[j] + gt[j] * acc[j]; ss += (v[j][0] * v[j][0] + v[j][1] * v[j][1]) + (v[j][2] * v[j][2] + v[j][3] * v[j][3]); }
        const float rstd = 1.0f / sqrtf(wave_sum(ss) * (1.f / DM) + NORM_EPS);
#pragma unroll
        for (int j = 0; j < 4; ++j) { const int c = 4 * lane + 256 * j; f32x4 ov = v[j] * (rstd * oscale) * gf[j];
#if defined(MK_CHECK) && MK_CHECK
#pragma unroll
            for (int e = 0; e < 4; ++e) if (!(ov[e] == ov[e]) || fabsf(ov[e]) > 1e6f) ov[e] = 0.f;
#endif
            *(f32x4*)(row + c) = ov; }
    }
}

__global__ void __launch_bounds__(NWAVES * 64, 2) fwd_kernel(Args args) {
    extern __shared__ __attribute__((aligned(16))) unsigned char lds_raw[];
    Frame F;
    F.lds = (LAS unsigned char*)lds_raw;
    F.wave = __builtin_amdgcn_readfirstlane((int)threadIdx.x >> 6); F.tid = opaque_tid(F.wave); F.lane = F.tid & 63;
    F.G = gridDim.x; { const int bx = blockIdx.x; F.vcu = (F.G % 8 == 0) ? (bx % 8) * (F.G / 8) + bx / 8 : bx; }
    F.gw = F.vcu * NWAVES + F.wave; F.NGW = F.G * NWAVES;
    unsigned char* ws = args.ws;
    volatile LAS unsigned* MISC = (volatile LAS unsigned*)(F.lds + MISC_OFF);
    for (int u = F.tid; u < (LDS_BYTES - RING_BYTES) / 4; u += NWAVES * 64) ((LAS unsigned*)(F.lds + RING_BYTES))[u] = 0u;
    __syncthreads();
    unsigned* ctl = (unsigned*)(ws + WS_CTL);
    XcdBarrier bar = xcd_barrier_post(ctl + CW_BAR, MISC + 8); bar.wv = F.wave;

#define IN_F(k) ((const float*)args.in[k])
#define in_x IN_F(0)
#define cin IN_F(1)
#define positions ((const int*)args.in[2])
#define w_ada IN_F(3)
#define b_ada IN_F(4)
#define g_mix IN_F(5)
#define w_in IN_F(6)
#define g_q IN_F(7)
#define g_kv IN_F(8)
#define w_uq IN_F(9)
#define w_ukv IN_F(10)
#define rel_bias IN_F(11)
#define w_out IN_F(12)
#define g_ffn IN_F(13)
#define w_router IN_F(14)
#define w_gate IN_F(15)
#define w_up IN_F(16)
#define w_down IN_F(17)
#define g_final IN_F(18)
#define t_out (args.out)
#define WSP(T, off) ((T*)(args.ws + (off)))
#define MOD WSP(float, WS_MOD)
#define CS WSP(float, WS_CS)
#define WIN WSP(bf16_t, WS_WIN)
#define WUQ WSP(bf16_t, WS_WUQ)
#define WUKV WSP(bf16_t, WS_WUKV)
#define WOUT WSP(bf16_t, WS_WOUT)
#define t_H WSP(bf16_t, WS_H)
#define t_U WSP(bf16_t, WS_U)
#define t_P WSP(bf16_t, WS_P)
#define CQN WSP(bf16_t, WS_CQN)
#define CKVN WSP(bf16_t, WS_CKVN)
#define QB WSP(bf16_t, WS_QB)
#define KB WSP(bf16_t, WS_KB)
#define VB WSP(bf16_t, WS_VB)
#define OA WSP(bf16_t, WS_OA)
#define OG WSP(bf16_t, WS_OG)
#define LSE WSP(float, WS_LSE)
#define WGU WSP(bf16_t, WS_WGU)
#define WD WSP(bf16_t, WS_WD)
#define HID WSP(bf16_t, WS_HID)
#define t_Y WSP(bf16_t, WS_Y)
#define AFFT WSP(float, WS_AFFT)
#define TOPI WSP(int, WS_TOPI)
#define TOPG WSP(float, WS_TOPG)
#define SLOT WSP(int, WS_SLOT)

#ifndef PH_MASK
#define PH_MASK 0xFFFFFFFFu
#endif
#define PH_ON(k) constexpr (((PH_MASK) >> (k)) & 1u)
#ifndef DUP_MASK
#define DUP_MASK 0u
#endif
#define PH_REP(k) for (int rep_ = 0; rep_ < ((((DUP_MASK) >> (k)) & 1u) ? 2 : 1); ++rep_)
#if defined(PROBE_TIMING)
#define DBG_SCALE() (1.0f + __uint_as_float(__hip_atomic_load(ctl + CW_DBG + 1, RLX_AGENT)))
#elif defined(MK_CHECK) && MK_CHECK
#define DBG_SCALE() ([&]() -> float { const unsigned f_ = __hip_atomic_load(ctl + CW_DBG, RLX_AGENT); return f_ ? 1.0f + 0.05f * (float)(1 + __builtin_ctz(f_)) : 1.0f; }())
#else
#define DBG_SCALE() 1.0f
#endif
    int step = 0; const int lo = args.st_lo, hi = args.st_hi;
#if defined(PROBE_STEP)
#define STEP_BEGIN if (step >= lo && step < hi) { const unsigned long long rt0_ = __builtin_amdgcn_s_memrealtime();
#define STEP_END if (step + 1 < hi) xcd_barrier(bar); if (step == PROBE_STEP && blockIdx.x == 0 && F.wave == 0 && opaque_tid(0) == 0) { \
        const float us_ = (float)(__builtin_amdgcn_s_memrealtime() - rt0_) * 0.01f; *(float*)(ctl + CW_DBG + 1) = __builtin_rintf((us_ + PROBE_QOFF) * (1.f / 16.f)) * 8e-3f; } } ++step;
#else
#define STEP_BEGIN if (step >= lo && step < hi) {
#endif
#if defined(PROBE_STEP)
#elif defined(PROBE_DBLBAR)
#define STEP_END if (step + 1 < hi) { xcd_barrier(bar); xcd_barrier(bar); } } ++step;
#else
#define STEP_END if (step + 1 < hi) xcd_barrier(bar); } ++step;
#endif

    STEP_BEGIN
        if PH_ON(0) PH_REP(0) { p0_mod(F, cin, w_ada, b_ada, MOD);
        p0_cs(F, positions, CS);
        p0_lut(F, rel_bias, (float*)(ws + WS_LUT));
        p0_weights(F, w_in, w_uq, w_ukv, w_out, ws); }
    STEP_END
    STEP_BEGIN
        if PH_ON(1) PH_REP(1) p1_h(F, in_x, g_mix, MOD, t_H);
    STEP_END
    for (int b = 0; b < NB; ++b) {
        STEP_BEGIN
            pg8::Gemm g{(const bf16_t*)((const char*)t_H + (size_t)b * SEQ * DM * (FP8_G1 ? 1 : 2)), WIN, DM, DM, DM, 0, 0, nullptr, 0, 0}; pg8::StaticOrder S; S.init(SEQ, NP, F.G, (int)blockIdx.x);
            pg8::EpiP E{(unsigned char*)t_P, FP8_G1 ? W8_INV : 1.0f, 0};
            if PH_ON(2) PH_REP(2) {
#if defined(PROBE_NOSTORE)
                E.nostore = (rep_ == 0);
#endif
                pg8::gemm_phase<pg8::EpiP, pg8::StaticOrder, false, (FP8_G1 != 0)>(F.lds, F.wave, g, S, E); __syncthreads(); }
        STEP_END
        STEP_BEGIN
            if PH_ON(3) PH_REP(3) lb_latent(F, t_P, g_q, g_kv, CS + (size_t)b * SEQ * 64, CQN, CKVN, KB);
        STEP_END
        STEP_BEGIN
#if MLA_FP8
            { pg8::Gemm g{CQN, WUQ, 384, 384, 384, 0, 0, nullptr, 0, 0}; pg8::StaticOrder S; S.init(SEQ, 1536, F.G, (int)blockIdx.x);
              pg8::EpiQ8 E{(unsigned char*)QB, CS + (size_t)b * SEQ * 64};
              if PH_ON(4) PH_REP(4) { pg8::gemm_phase<pg8::EpiQ8, pg8::StaticOrder, false>(F.lds, F.wave, g, S, E); __syncthreads(); } }
            { pg8::Gemm g{CKVN, WUKV, 256, 256, 256, 0, 0, nullptr, 0, 0}; pg8::StaticOrder S; S.init(SEQ, 1024, F.G, (int)blockIdx.x);
              pg8::EpiK8 E{(unsigned char*)KB};
              if PH_ON(5) PH_REP(5) { pg8::gemm_phase<pg8::EpiK8, pg8::StaticOrder, false>(F.lds, F.wave, g, S, E); __syncthreads(); } }
            { pg8::Gemm g{WUKV + (size_t)1024 * 256, CKVN, 256, 256, 256, 0, 0, nullptr, 0, 0}; pg8::StaticOrder S; S.init(1024, SEQ, F.G, (int)((blockIdx.x + 128) % F.G));
              pg8::EpiVT8 E{(unsigned char*)VB};
              if PH_ON(5) PH_REP(5) { pg8::gemm_phase<pg8::EpiVT8, pg8::StaticOrder, false>(F.lds, F.wave, g, S, E); __syncthreads(); } }
#else
            { pg8::Gemm g{CQN, WUQ, 384, 384, 384, 0, 0, nullptr, 0, 0}; pg8::StaticOrder S; S.init(SEQ, 1536, F.G, (int)blockIdx.x);
              pg8::EpiQ E{QB, CS + (size_t)b * SEQ * 64};
              if PH_ON(4) PH_REP(4) { pg8::gemm_phase<pg8::EpiQ, pg8::StaticOrder, false>(F.lds, F.wave, g, S, E); __syncthreads(); } }
            __syncthreads();
            { pg8::Gemm g{CKVN, WUKV, 256, 256, 256, 0, 0, nullptr, 0, 0}; pg8::StaticOrder S; S.init(SEQ, 2048, F.G, (int)blockIdx.x);
              pg8::EpiKV E{KB, VB};
              if PH_ON(5) PH_REP(5) { pg8::gemm_phase<pg8::EpiKV, pg8::StaticOrder, false>(F.lds, F.wave, g, S, E); __syncthreads(); } }
#endif
        STEP_END
        STEP_BEGIN
            const int conv_at = (((int)blockIdx.x >> 3) & 3) == 2 ? 3 : (((int)blockIdx.x >> 3) & 3);
            if (conv_at == 0) { if PH_ON(10) PH_REP(10) conv_experts(F, w_gate, w_up, w_down, ws, b); }
#if defined(PROBE_TIMING)
#define DIL_DBG(a_, grp_) a_.dbg = (blockIdx.x == PROBE_BLOCK && b == 3 && (grp_) == PROBE_GRP) ? (float*)(ctl + CW_DBG + 1) : nullptr
#else
#define DIL_DBG(a_, grp_) do { } while (0)
#endif
#define DIL_UNIT(a_, u_) do { const int grp = (u_) >> 8, w = (u_) & 255, hd = w & 7, rest = w >> 3, d = grp == 0 ? 1 : (grp == 1 ? 4 : 16), cl = rest % d, qb = rest / d; \
                const size_t tok0 = (size_t)256 * qb * d + cl; const char* gbase = (const char*)t_P + P_OFF_DIL + grp * P_GRP;       \
                  \
                a_ = att::Unit{}; \
                a_.Q = (const bf16_t*)(gbase + tok0 * PROW + hd * 128 * P_QK_ESZ); a_.qs = d * (PROW / 2); \
                a_.K = (const bf16_t*)(gbase + (size_t)cl * PROW + 1024 * P_QK_ESZ + hd * 128 * P_QK_ESZ); a_.ks = d * (PROW / 2); \
                a_.V = (const bf16_t*)(gbase + (size_t)cl * PROW + 2048 * P_QK_ESZ + hd * 256); a_.vs = d * (PROW / 2); \
                a_.O = OG + ((size_t)grp * SEQ + tok0) * DM + hd * 128; a_.os = d * DM; a_.nt = 6; a_.tmul = 1; DIL_DBG(a_, grp); \
                a_.kt0 = 4 * qb - 1; a_.ktn = (SEQ / d) / 64; a_.l0 = 256 * qb; a_.pos = positions + (size_t)b * SEQ + cl; a_.ps = d; \
                a_.lse = LSE + ((size_t)grp * SEQ + tok0) * 8 + hd; a_.ls = d * 8; a_.bias = rel_bias + grp * 8 + hd; a_.lutg = (const float*)(ws + WS_LUT) + (grp * 8 + hd) * 2304; } while (0)
            int pre_valid = 0, pre_pq = 0, pre_ppos = 0;
            bf16x8 pre_q0 = (bf16x8){0, 0, 0, 0, 0, 0, 0, 0}, pre_q1 = pre_q0, pre_q2 = pre_q0, pre_q3 = pre_q0;
            for (int u = blockIdx.x; u < 256; u += F.G) { const int hd = u & 7, qb = u >> 3;
#if MLA_FP8
                att::Unit8 a8{(const unsigned char*)QB + ((size_t)hd * SEQ + 256 * qb) * 192, (const unsigned char*)KB + (size_t)hd * SEQ * 192, (const unsigned char*)VB + (size_t)hd * SEQ * 128,
                              OA + (size_t)(256 * qb) * DM + hd * 128, DM, SEQ / 64, nullptr};
#if defined(PROBE_TIMING)
                a8.dbg = (blockIdx.x == PROBE_BLOCK && b == 3) ? (float*)(ctl + CW_DBG + 1) : nullptr;
#endif
                att::Unit d0; DIL_UNIT(d0, (int)blockIdx.x);
                const bool dil_next = MLA_DIL_HOOK && (u + (int)F.G >= 256) && conv_at != 1 && (int)blockIdx.x < 768 && (((DUP_MASK) >> 6) & 3u) == 0u;
                if PH_ON(6) PH_REP(6) att::attn_mla8_unit(a8, (LAS char*)F.lds, F.wave, pre_q0, pre_q1, pre_q2, pre_q3, pre_pq, pre_ppos, pre_valid, d0, dil_next);
#else
                att::Unit a{};
                a.Q = QB + ((size_t)hd * SEQ + 256 * qb) * 192; a.qs = 192; a.K = KB + (size_t)hd * SEQ * 192; a.ks = 192; a.V = VB + (size_t)hd * SEQ * 128; a.vs = 128;
                a.O = OA + (size_t)(256 * qb) * DM + hd * 128; a.os = DM; a.nt = SEQ / 64;
#if defined(BREAK_MLA) && BREAK_MLA
                a.nt = SEQ / 64 - 2;
#endif
                a.tmul = 1;
#if defined(PROBE_TIMING)
                a.dbg = (blockIdx.x == PROBE_BLOCK && b == 3) ? (float*)(ctl + CW_DBG + 1) : nullptr;
#endif
#if defined(PROBE_SAMETILE)
                a.tmul = 0; att::attn_unit<false>(a, (LAS char*)F.lds, F.wave); a.tmul = 1;
#endif
                if PH_ON(6) PH_REP(6) att::attn_unit<false>(a, (LAS char*)F.lds, F.wave);
#endif
            }

            if (conv_at == 1) { if PH_ON(10) PH_REP(10) conv_experts(F, w_gate, w_up, w_down, ws, b); }
            {
#pragma unroll 1
              for (int u = blockIdx.x; u < 768; u += F.G) {
                att::Unit a, an; DIL_UNIT(a, u);
                const int un = u + (int)F.G;
                const bool conv_here = (conv_at == 2 && u == (int)blockIdx.x);
                const bool has_next = un < 768 && !conv_here && (((DUP_MASK) >> 7) & 1u) == 0u;
                DIL_UNIT(an, (has_next ? un : u));
                if PH_ON(7) PH_REP(7) att::attn_unit<true>(a, (LAS char*)F.lds, F.wave, pre_q0, pre_q1, pre_q2, pre_q3, pre_pq, pre_ppos, pre_valid, an, has_next);
                if (conv_here) { if PH_ON(10) PH_REP(10) conv_experts(F, w_gate, w_up, w_down, ws, b); } } }
#undef DIL_UNIT
#undef DIL_DBG
            if (conv_at == 3) { if PH_ON(10) PH_REP(10) conv_experts(F, w_gate, w_up, w_down, ws, b); }
        STEP_END
        STEP_BEGIN
            if PH_ON(8) PH_REP(8) lb_combine(F, t_P, OA, OG, LSE, (bf16_t*)((char*)t_U + (size_t)b * SEQ * DM * (FP8_WO ? 1 : 2)));
        STEP_END
#if defined(MK_CHECK) && MK_CHECK
        STEP_BEGIN
#if !defined(CHK_MEASURE) && !defined(CHK_ONLY_DIL)
            chk::check_proj(F, b, ctl, t_P, CQN, CKVN, QB, KB, VB, g_q, g_kv, w_uq, w_ukv, positions);
            chk::check_dil(F, b, ctl, t_P, positions, rel_bias, OG, LSE);
            chk::check_u(F, b, ctl, t_P, OA, OG, LSE, t_U + (size_t)b * SEQ * DM);
#endif
#if defined(CHK_ONLY_DIL)
            chk::check_dil(F, b, ctl, t_P, positions, rel_bias, OG, LSE);
#else
            chk::check_mla(F, b, ctl, QB, KB, VB, OA);
#endif
        STEP_END
#endif
    }
    STEP_BEGIN
        { pg8::Gemm g{t_U, WOUT, DM, DM, DM, 0, 0, nullptr, 0, 0}; pg8::StaticOrder S; S.init(NTOK, DM, F.G, (int)blockIdx.x);
          pg8::EpiRes E{in_x, t_out, MOD, FP8_WO ? W8_INV * (1.0f / U8_SCALE) : 1.0f};
          if PH_ON(9) PH_REP(9) { pg8::gemm_phase<pg8::EpiRes, pg8::StaticOrder, false, (FP8_WO != 0)>(F.lds, F.wave, g, S, E); __syncthreads(); } }
    STEP_END
    STEP_BEGIN
        if PH_ON(11) PH_REP(11) pg_h2_router(F, t_out, g_ffn, MOD, w_router, t_H, AFFT);
    STEP_END
    STEP_BEGIN
        if PH_ON(12) PH_REP(12) ph_topk(F, AFFT, TOPI, TOPG, SLOT);
    STEP_END
    static_assert(FP8_EX != 0, "the all-batch FFN workspace map assumes fp8 expert operands");
    STEP_BEGIN
        { pg8::Gemm g{t_H, WGU, DM, DM, DM, 0, (long)4096 * 1024, TOPI, CAP, NE}; pg8::GroupOrder S; S.init(4, 16, NB * NE, F.G, (int)blockIdx.x);
          pg8::EpiSwiGLU E{(void*)HID, W8_INV};
          if PH_ON(13) PH_REP(13) { pg8::gemm_phase<pg8::EpiSwiGLU, pg8::GroupOrder, true, true>(F.lds, F.wave, g, S, E); __syncthreads(); } }
    STEP_END
    STEP_BEGIN
        { pg8::Gemm g{HID, WD, DFF, DFF, DFF, (long)CAP * DFF, (long)DM * DFF, nullptr, 0, NE}; pg8::GroupOrder S; S.init(4, 4, NB * NE, F.G, (int)blockIdx.x);
          pg8::EpiDown E{t_Y, TOPG, W8_INV};
          if PH_ON(14) PH_REP(14) { pg8::gemm_phase<pg8::EpiDown, pg8::GroupOrder, false, true>(F.lds, F.wave, g, S, E); __syncthreads(); } }
    STEP_END
    STEP_BEGIN
        if PH_ON(15) PH_REP(15) p_final(F, t_out, MOD, SLOT, t_Y, g_final, DBG_SCALE());
    STEP_END
#undef STEP_BEGIN
#undef STEP_END
}
#undef IN_F
#undef in_x
#undef cin
#undef positions
#undef w_ada
#undef b_ada
#undef g_mix
#undef w_in
#undef g_q
#undef g_kv
#undef w_uq
#undef w_ukv
#undef rel_bias
#undef w_out
#undef g_ffn
#undef w_router
#undef w_gate
#undef w_up
#undef w_down
#undef g_final
#undef t_out
#undef WSP
#undef MOD
#undef CS
#undef WIN
#undef WUQ
#undef WUKV
#undef WOUT
#undef t_H
#undef t_U
#undef t_P
#undef CQN
#undef CKVN
#undef QB
#undef KB
#undef VB
#undef OA
#undef OG
#undef LSE
#undef WGU
#undef WD
#undef HID
#undef t_Y
#undef AFFT
#undef TOPI
#undef TOPG
#undef SLOT
constexpr int STEPS_MIX = 5
#if defined(MK_CHECK) && MK_CHECK
    + 1
#endif
    ;
constexpr int N_STEPS = 2 + NB * STEPS_MIX + 3 + 3;

#ifndef MK_PER_STEP
#define MK_PER_STEP 0
#endif
extern "C" void kernel_launch(void* const* d_in, const int* in_sizes, int n_in, void* d_out, int out_size, void* d_ws, size_t ws_size, hipStream_t stream) {
    static int grid = 0;
    if (grid == 0) {
        if (n_in != 19 || out_size != NTOK * DM || ws_size < WS_END) { fprintf(stderr, "kernel_launch: unexpected shapes (n_in %d out %d ws %zu need %zu)\n", n_in, out_size, ws_size, (size_t)WS_END); grid = -1; return; }
        int dev = 0, cus = 0;
        if (hipGetDevice(&dev) != hipSuccess || hipDeviceGetAttribute(&cus, hipDeviceAttributeMultiprocessorCount, dev) != hipSuccess) { grid = -1; return; }
        if (hipFuncSetAttribute((const void*)fwd_kernel, hipFuncAttributeMaxDynamicSharedMemorySize, LDS_BYTES) != hipSuccess) { grid = -1; return; }
        int per_cu = 0;
        if (hipOccupancyMaxActiveBlocksPerMultiprocessor(&per_cu, (const void*)fwd_kernel, NWAVES * 64, LDS_BYTES) != hipSuccess || per_cu < 1) { fprintf(stderr, "kernel_launch: occupancy query says %d\n", per_cu); }
        (void)hipGetLastError();
        grid = cus;
    }
    if (grid < 0) return;
    if (hipMemsetAsync((char*)d_ws + WS_CTL, 0, CTL_ZERO_BYTES, stream) != hipSuccess) return;
    Args a{};
    for (int i = 0; i < 19; ++i) a.in[i] = d_in[i];
    a.out = (float*)d_out; a.ws = (unsigned char*)d_ws;
#if MK_PER_STEP
    for (int s = 0; s < N_STEPS; ++s) { a.st_lo = s; a.st_hi = s + 1; hipLaunchKernelGGL(fwd_kernel, dim3(grid), dim3(NWAVES * 64), LDS_BYTES, stream, a); }
#else
    a.st_lo = 0; a.st_hi = N_STEPS;
    hipLaunchKernelGGL(fwd_kernel, dim3(grid), dim3(NWAVES * 64), LDS_BYTES, stream, a);
#endif
    const hipError_t le = hipPeekAtLastError();
    if (le != hipSuccess) fprintf(stderr, "kernel_launch: launch failed: %s\n", hipGetErrorName(le));
}
```
